# Optimizing an MI355X kernel written in HIP

```python
import jax, jax.numpy as jnp
from jax import lax
import numpy as np

D_MODEL = 1024
BATCH = 4
SEQ = 4096
DEPTH = 2

GRID_W = 64
CTX_LEN = 256
N_MOD = 9
D_FF = 2752
EPS = 1e-6
ATTN_HEADS = 4
Q_LORA = 256
KV_LORA = 128
NOPE_DIM = 128
ROPE_DIM = 64
AXIS_FREQS = ROPE_DIM // 4
V_DIM = 128
ATTN_WIDTH = ATTN_HEADS * V_DIM
ROPE_BASE = 10000.0
SM_SCALE = (NOPE_DIM + ROPE_DIM) ** -0.5
Q_BLOCK = 128
MLSTM_HEADS = 4
MLSTM_DH = 128
MLSTM_WIDTH = MLSTM_HEADS * MLSTM_DH
MLSTM_CHUNK = 64
CONV_K = 3
N_GATES = 4 * MLSTM_HEADS
IN_SIZES = (Q_LORA, KV_LORA, ROPE_DIM, 2 * MLSTM_WIDTH, MLSTM_WIDTH, MLSTM_WIDTH, N_GATES)
D_IN = Q_LORA + KV_LORA + ROPE_DIM + 4 * MLSTM_WIDTH + N_GATES
MIX_WIDTH = ATTN_WIDTH + MLSTM_WIDTH

kernel_name = 'hybrid_mla_mlstm_dit_block'


def rms_norm(x, g):
    xf = x.astype(jnp.float32)
    y = xf * lax.rsqrt(jnp.mean(xf * xf, axis=-1, keepdims=True) + EPS)
    return (y * g.astype(jnp.float32)).astype(x.dtype)


def head_layer_norm(h, g):
    mu = jnp.mean(h, axis=-1, keepdims=True)
    var = jnp.mean(jnp.square(h - mu), axis=-1, keepdims=True)
    y = (h - mu) * lax.rsqrt(var + EPS)
    return y.reshape(h.shape[:2] + (-1,)) * g.astype(jnp.float32)


def swiglu(h, wg, wu, wd):
    return (jax.nn.silu(h @ wg) * (h @ wu)) @ wd


def split_in(p):
    offs = [int(o) for o in np.cumsum(IN_SIZES)[:-1]]
    return jnp.split(p, offs, axis=-1)


def conv_centred(u, w, b):
    pad = CONV_K // 2
    t = u.shape[1]
    up = jnp.pad(u, ((0, 0), (pad, pad), (0, 0)))
    out = up[:, 0:t] * w[0]
    for j in range(1, CONV_K):
        out = out + up[:, j:j + t] * w[j]
    return out + b


def axial_rope_tables(n_tokens):
    rows = n_tokens // GRID_W
    t_row = jnp.repeat(jnp.arange(rows), GRID_W).astype(jnp.float32)
    t_col = jnp.tile(jnp.arange(GRID_W), rows).astype(jnp.float32)
    inv = ROPE_BASE ** (-jnp.arange(AXIS_FREQS, dtype=jnp.float32) / AXIS_FREQS)
    ang = jnp.stack([t_row[:, None] * inv, t_col[:, None] * inv], axis=1)
    return jnp.cos(ang)[:, None], jnp.sin(ang)[:, None]


def apply_axial_rope(x, cos, sin):
    sh = x.shape
    xr = x.reshape(sh[:-1] + (2, 2, AXIS_FREQS))
    x1, x2 = xr[..., 0, :], xr[..., 1, :]
    cos = cos.astype(x.dtype)
    sin = sin.astype(x.dtype)
    out = jnp.stack([x1 * cos - x2 * sin, x2 * cos + x1 * sin], axis=-2)
    return out.reshape(sh)


def mla_query(cq, q_norm, w_uq):
    b, t, _ = cq.shape
    return (rms_norm(cq, q_norm) @ w_uq).reshape(b, t, ATTN_HEADS, NOPE_DIM + ROPE_DIM)


def mla_keys(ckv, k_rope, kv_norm, w_ukv):
    b, t, _ = ckv.shape
    kv = (rms_norm(ckv, kv_norm) @ w_ukv).reshape(b, t, ATTN_HEADS, NOPE_DIM + V_DIM)
    k = jnp.concatenate([kv[..., :NOPE_DIM],
                         jnp.broadcast_to(k_rope, (b, t, ATTN_HEADS, ROPE_DIM)).astype(kv.dtype)], axis=-1)
    return k, kv[..., NOPE_DIM:]


def softmax_attend(q, k, v):
    s = jnp.einsum('bqhd,bkhd->bhqk', q, k).astype(jnp.float32) * SM_SCALE
    p = jax.nn.softmax(s, axis=-1).astype(v.dtype)
    return jnp.einsum('bhqk,bkhd->bqhd', p, v)


def blocked_attention(q, k, v):
    b, s, h, dk = q.shape
    nb = s // Q_BLOCK
    qb = jnp.swapaxes(q.reshape(b, nb, Q_BLOCK, h, dk), 0, 1)
    ob = lax.map(lambda qq: softmax_attend(qq, k, v), qb)
    return jnp.swapaxes(ob, 0, 1).reshape(b, s, h * v.shape[-1])


def mlstm_state_update(state, k, v, ig, b):
    C, n, m = state
    b_last = b[..., -1]
    log_w = b_last[..., None] - b + ig
    m_new = jnp.maximum(b_last + m, jnp.max(log_w, axis=-1))
    w = jnp.exp(log_w - m_new[..., None])
    decay = jnp.exp(b_last + m - m_new)
    C = decay[..., None, None] * C + jnp.einsum('bhsd,bhse->bhde', w[..., None] * k, v)
    n = decay[..., None] * n + jnp.einsum('bhs,bhsd->bhd', w, k)
    return (C, n, m_new)


def mlstm_chunkwise(q, k, v, ig, lf, state):
    bq, h, t, dh = q.shape
    nc = t // MLSTM_CHUNK
    tri = jnp.tril(jnp.ones((MLSTM_CHUNK, MLSTM_CHUNK), dtype=bool))

    def chunks(a):
        a = a.reshape((bq, h, nc, MLSTM_CHUNK) + a.shape[3:])
        return jnp.moveaxis(a, 2, 0)

    def step(carry, inp):
        C, n, m = carry
        qc, kc, vc, igc, lfc = inp
        b = jnp.cumsum(lfc, axis=-1)
        log_d = jnp.where(tri, b[..., :, None] - b[..., None, :] + igc[..., None, :], -jnp.inf)
        log_inter = b + m[..., None]
        m_t = jnp.maximum(log_inter, jnp.max(log_d, axis=-1))
        s = jnp.einsum('bhtd,bhsd->bhts', qc, kc) * jnp.exp(log_d - m_t[..., None])
        inter = jnp.exp(log_inter - m_t)
        num = jnp.einsum('bhts,bhsd->bhtd', s, vc) + inter[..., None] * jnp.einsum('bhtd,bhde->bhte', qc, C)
        den = jnp.sum(s, axis=-1) + inter * jnp.einsum('bhtd,bhd->bht', qc, n)
        hc = num / jnp.maximum(jnp.abs(den), jnp.exp(-m_t))[..., None]
        return mlstm_state_update(carry, kc, vc, igc, b), hc

    state, hs = lax.scan(step, state, (chunks(q), chunks(k), chunks(v), chunks(ig), chunks(lf)))
    return jnp.moveaxis(hs, 0, 2).reshape(bq, h, t, dh), state


def mlstm_inputs(qk_pre, v, gates, conv_w, conv_b, gate_b):
    b, t, _ = v.shape
    u = jax.nn.silu(conv_centred(qk_pre, conv_w, conv_b))
    q, k = jnp.split(u, 2, axis=-1)

    def heads(a):
        return a.reshape(b, t, MLSTM_HEADS, MLSTM_DH).transpose(0, 2, 1, 3).astype(jnp.float32)

    g = gates.astype(jnp.float32) + gate_b.reshape(-1).astype(jnp.float32)
    g = g.reshape(b, t, 4, MLSTM_HEADS).transpose(2, 0, 3, 1)
    return heads(q), heads(k) * (MLSTM_DH ** -0.5), heads(v), g


def mlstm_bidirectional(lat, ctx, need_ctx_out):
    qx, kx, vx, gx = lat
    qc, kc, vc, gc = ctx
    bq = qx.shape[0]
    zero = (jnp.zeros((bq, MLSTM_HEADS, MLSTM_DH, MLSTM_DH), jnp.float32),
            jnp.zeros((bq, MLSTM_HEADS, MLSTM_DH), jnp.float32),
            jnp.zeros((bq, MLSTM_HEADS), jnp.float32))
    hx_tot = jnp.zeros(qx.shape, jnp.float32)
    hc_tot = jnp.zeros(qc.shape, jnp.float32)
    for d in range(2):
        sx = [qx, kx, vx, gx[2 * d], jax.nn.log_sigmoid(gx[2 * d + 1])]
        sc = [qc, kc, vc, gc[2 * d], jax.nn.log_sigmoid(gc[2 * d + 1])]
        if d == 1:
            sx = [jnp.flip(a, axis=2) for a in sx]
            sc = [jnp.flip(a, axis=2) for a in sc]
        if need_ctx_out:
            hc, st = mlstm_chunkwise(sc[0], sc[1], sc[2], sc[3], sc[4], zero)
            hc_tot = hc_tot + (jnp.flip(hc, axis=2) if d == 1 else hc)
        else:
            st = mlstm_state_update(zero, sc[1], sc[2], sc[3], jnp.cumsum(sc[4], axis=-1))
        hx, _ = mlstm_chunkwise(sx[0], sx[1], sx[2], sx[3], sx[4], st)
        hx_tot = hx_tot + (jnp.flip(hx, axis=2) if d == 1 else hx)
    return hx_tot, hc_tot


def merge_groups(a, hm, o, p):
    b, t, _ = o.shape
    hm = jnp.swapaxes(hm, 1, 2) * jax.nn.sigmoid(o.astype(jnp.float32)).reshape(b, t, MLSTM_HEADS, MLSTM_DH)
    hm = head_layer_norm(hm, p['mlstm_norm']).astype(a.dtype)
    return jnp.concatenate([rms_norm(a, p['attn_out_norm']), hm], axis=-1) @ p['w_out']


def mixer(hx, hc, cos, sin, p, need_ctx_out):
    b, s, _ = hx.shape
    cq_x, ckv_x, kr_x, qk_x, v_x, o_x, g_x = split_in(hx @ p['w_in'])
    cq_c, ckv_c, kr_c, qk_c, v_c, o_c, g_c = split_in(hc @ p['w_in'])
    k_c, va_c = mla_keys(ckv_c, kr_c[:, :, None, :], p['kv_norm'], p['w_ukv'])
    k_x, va_x = mla_keys(ckv_x, apply_axial_rope(kr_x[:, :, None, :], cos, sin), p['kv_norm'], p['w_ukv'])
    q_x = mla_query(cq_x, p['q_norm'], p['w_uq'])
    q_x = jnp.concatenate([q_x[..., :NOPE_DIM], apply_axial_rope(q_x[..., NOPE_DIM:], cos, sin)], axis=-1)
    k_all = jnp.concatenate([k_c, k_x], axis=1)
    v_all = jnp.concatenate([va_c, va_x], axis=1)
    a_x = blocked_attention(q_x, k_all, v_all)
    lat = mlstm_inputs(qk_x, v_x, g_x, p['conv_w'], p['conv_b'], p['gate_b'])
    ctm = mlstm_inputs(qk_c, v_c, g_c, p['conv_w'], p['conv_b'], p['gate_b'])
    m_x, m_c = mlstm_bidirectional(lat, ctm, need_ctx_out)
    y_x = merge_groups(a_x, m_x, o_x, p)
    if not need_ctx_out:
        return y_x, None
    q_c = mla_query(cq_c, p['q_norm'], p['w_uq'])
    a_c = softmax_attend(q_c, k_c, va_c).reshape(b, hc.shape[1], ATTN_WIDTH)
    return y_x, merge_groups(a_c, m_c, o_c, p)


def sandwich_in(h, m, sub, p):
    return rms_norm(h, p['norm_pre'][sub]) * (1 + m[:, 3 * sub + 1]) + m[:, 3 * sub]


def sandwich_out(h, y, m, sub, p, weight):
    return h + weight * m[:, 3 * sub + 2] * rms_norm(y, p['norm_post'][sub])


def ffn_sub(h, m, sub, j, p):
    y = swiglu(sandwich_in(h, m, sub, p), p['w_gate'][j], p['w_up'][j], p['w_down'][j])
    return sandwich_out(h, y, m, sub, p, 0.5)


def trunk_layer(x, xc, mod_x, mod_c, cos, sin, p, need_ctx_out):
    x = ffn_sub(x, mod_x, 0, 0, p)
    xc = ffn_sub(xc, mod_c, 0, 0, p)
    y_x, y_c = mixer(sandwich_in(x, mod_x, 1, p), sandwich_in(xc, mod_c, 1, p), cos, sin, p, need_ctx_out)
    x = sandwich_out(x, y_x, mod_x, 1, p, 1.0)
    x = ffn_sub(x, mod_x, 2, 1, p)
    if need_ctx_out:
        xc = sandwich_out(xc, y_c, mod_c, 1, p, 1.0)
        xc = ffn_sub(xc, mod_c, 2, 1, p)
    return x, xc


def setup_inputs(seed: int = 0) -> dict:
    key = jax.random.key(seed)
    ks = jax.random.split(key, 26)
    f32 = jnp.float32
    L, D = DEPTH, D_MODEL

    def nrm(k, shape, fan):
        return jax.random.normal(k, shape, f32) * (fan ** -0.5)

    def gain(k, shape):
        return 1.0 + 0.05 * jax.random.normal(k, shape, f32)

    i_bias = 0.1 * jax.random.normal(ks[20], (L, 2, MLSTM_HEADS), f32)
    f_bias = jnp.linspace(3.0, 6.0, MLSTM_HEADS, dtype=f32) + 0.1 * jax.random.normal(ks[21], (L, 2, MLSTM_HEADS), f32)
    return {
        'x': jax.random.normal(ks[0], (BATCH, SEQ, D), f32),
        'c': jax.random.normal(ks[1], (BATCH, D), f32),
        'ctx': jax.random.normal(ks[2], (BATCH, CTX_LEN, D), f32),
        'c_ctx': jax.random.normal(ks[3], (D,), f32),
        'w_mod': 0.5 * nrm(ks[4], (L, D, N_MOD * D), D),
        'b_mod': 0.02 * jax.random.normal(ks[5], (L, N_MOD * D), f32),
        'norm_pre': gain(ks[6], (L, 3, D)),
        'norm_post': gain(ks[7], (L, 3, D)),
        'ffn_w_gate': nrm(ks[8], (L, 2, D, D_FF), D),
        'ffn_w_up': nrm(ks[9], (L, 2, D, D_FF), D),
        'ffn_w_down': nrm(ks[10], (L, 2, D_FF, D), D_FF),
        'w_in': nrm(ks[11], (L, D, D_IN), D),
        'q_norm': gain(ks[12], (L, Q_LORA)),
        'w_uq': nrm(ks[13], (L, Q_LORA, ATTN_HEADS * (NOPE_DIM + ROPE_DIM)), Q_LORA),
        'kv_norm': gain(ks[14], (L, KV_LORA)),
        'w_ukv': nrm(ks[15], (L, KV_LORA, ATTN_HEADS * (NOPE_DIM + V_DIM)), KV_LORA),
        'attn_out_norm': gain(ks[16], (L, ATTN_WIDTH)),
        'conv_w': nrm(ks[17], (L, CONV_K, 2 * MLSTM_WIDTH), CONV_K),
        'conv_b': 0.02 * jax.random.normal(ks[18], (L, 2 * MLSTM_WIDTH), f32),
        'gate_b': jnp.stack([i_bias, f_bias], axis=2).reshape(L, 4, MLSTM_HEADS),
        'mlstm_norm': gain(ks[19], (L, MLSTM_WIDTH)),
        'w_out': nrm(ks[22], (L, MIX_WIDTH, D), MIX_WIDTH),
    }


def reference(x, c, ctx, c_ctx, w_mod, b_mod, norm_pre, norm_post, ffn_w_gate, ffn_w_up, ffn_w_down,
              w_in, q_norm, w_uq, kv_norm, w_ukv, attn_out_norm, conv_w, conv_b, gate_b, mlstm_norm, w_out):
    bsz, n_tok, d = x.shape
    cos, sin = axial_rope_tables(n_tok)
    xc = ctx
    for l in range(DEPTH):
        p = {'norm_pre': norm_pre[l], 'norm_post': norm_post[l], 'w_gate': ffn_w_gate[l],
             'w_up': ffn_w_up[l], 'w_down': ffn_w_down[l], 'w_in': w_in[l], 'q_norm': q_norm[l],
             'w_uq': w_uq[l], 'kv_norm': kv_norm[l], 'w_ukv': w_ukv[l],
             'attn_out_norm': attn_out_norm[l], 'conv_w': conv_w[l], 'conv_b': conv_b[l],
             'gate_b': gate_b[l], 'mlstm_norm': mlstm_norm[l], 'w_out': w_out[l]}
        mod_x = (jax.nn.silu(c) @ w_mod[l] + b_mod[l]).reshape(bsz, N_MOD, 1, d)
        mod_c = (jax.nn.silu(c_ctx) @ w_mod[l] + b_mod[l]).reshape(1, N_MOD, 1, d)
        x, xc = trunk_layer(x, xc, mod_x, mod_c, cos, sin, p, l < DEPTH - 1)
    return x
```

```cpp
#include <hip/hip_runtime.h>
#include <hip/hip_cooperative_groups.h>
#include <cstdio>
#include <cstdint>
namespace cg = cooperative_groups;
namespace pg8 {
#define PG8_LAS __attribute__((address_space(3)))
typedef unsigned short bf16_t;
typedef short bf16x8 __attribute__((ext_vector_type(8)));
typedef float f32x4 __attribute__((ext_vector_type(4)));
typedef unsigned u32x4 __attribute__((ext_vector_type(4)));
constexpr int BM = 256, BK = 64, HALF = 128, HTB = HALF * BK * 2  , STAGE_BYTES = 8 * HTB, NXCD = 8, WGM = 8;

__host__ __device__ __forceinline__ int lds_byte(int r, int c) { const int st = (r >> 4) * 2 + (c >> 5), rr = r & 15, cc = c & 31, ob = rr * 64 + cc * 2; return st * 1024 + (ob ^ (((ob >> 9) & 1) << 5)); }
__host__ __device__ __forceinline__ void stage_rc(int b, int& R, int& C) { const int st = b / 1024, sb = b % 1024, swz = sb ^ (((sb >> 9) & 1) << 5); R = (st >> 1) * 16 + swz / 64; C = (st & 1) * 32 + (swz % 64) / 2; }
__host__ __device__ __forceinline__ int perm32(int rho) { const int n = rho >> 4, i = rho & 15; return 8 * (i >> 2) + 4 * n + (i & 3); }

struct Unit { int pm, pn, kt0, nkt; };
struct Gemm { const bf16_t* A; const bf16_t* Bt; int M, N, K; };

struct StaticOrder {
    int nM, nN, nwg, G, c, nkt;
    __host__ __device__ void init(int M, int N, int K, int G_, int c_) { nM = M / BM; nN = N / BM; nwg = nM * nN; G = G_; c = c_; nkt = K / BK; }
    __host__ __device__ bool next(int i, Unit& u) const {
        const long L = (long)i * G + c; if (L >= nwg) return false;
        int wgid = (int)L; { const int q = nwg / NXCD, r = nwg % NXCD, xcd = wgid % NXCD, off = wgid / NXCD; wgid = (xcd < r ? xcd * (q + 1) : r * (q + 1) + (xcd - r) * q) + off; }
        const int nig = WGM * nN, gid = wgid / nig, fm = gid * WGM, gsz = (nM - fm) < WGM ? (nM - fm) : WGM;
        u.pm = fm + ((wgid % nig) % gsz); u.pn = (wgid % nig) / gsz; u.kt0 = 0; u.nkt = nkt; return true;
    }
    __device__ __forceinline__ void a_ready(const Unit&) const {}
    __device__ __forceinline__ void done(const Unit&) const {}
};

__device__ __forceinline__ unsigned cvt_pk_bf16(float lo, float hi) { unsigned r; asm volatile("v_cvt_pk_bf16_f32 %0, %1, %2" : "=v"(r) : "v"(lo), "v"(hi)); return r; }
typedef float f32x2 __attribute__((ext_vector_type(2)));
__device__ __forceinline__ f32x2 gelu_pk(f32x2 v) {
    const f32x2 av = __builtin_elementwise_abs(v), d = av * 0.2316418882f + 1.0f;
    f32x2 t; t.x = __builtin_amdgcn_rcpf(d.x); t.y = __builtin_amdgcn_rcpf(d.y);
    f32x2 q = t * 0.5307027145f + (-0.7265760135f); q = q * t + 0.7107068705f; q = q * t + (-0.142248368f); q = q * t + 0.127414796f; q = q * t;
    const f32x2 s = (v * v) * (-0.72134752044f);
    f32x2 e; e.x = __builtin_amdgcn_exp2f(s.x); e.y = __builtin_amdgcn_exp2f(s.y);
    const f32x2 m = v * (q * e), r = v - m;
    f32x2 o; o.x = v.x < 0.f ? m.x : r.x; o.y = v.y < 0.f ? m.y : r.y; return o;
}
__device__ __forceinline__ float silu_f(float x) { return x * __builtin_amdgcn_rcpf(1.0f + __builtin_amdgcn_exp2f(-1.4426950408889634f * x)); }
__device__ __forceinline__ void st8(bf16_t* p, f32x4 v0, f32x4 v1) { u32x4 w; w.x = cvt_pk_bf16(v0[0], v0[1]); w.y = cvt_pk_bf16(v0[2], v0[3]); w.z = cvt_pk_bf16(v1[0], v1[1]); w.w = cvt_pk_bf16(v1[2], v1[3]); *(u32x4*)p = w; }
struct EpiStore {
    static constexpr bool PERM = true, AFTER_DRAIN = false;
    bf16_t* O; int ldc;
    __device__ __forceinline__ void operator()(const f32x4 (&acc)[2][2][4][2], const Unit& u, int wr, int wc, int fr, int fq) const {
        const int row0 = u.pm * BM + wr * 64 + fr, col0 = u.pn * BM + wc * 32 + 8 * fq;
#pragma unroll
        for (int ai = 0; ai < 2; ++ai)
#pragma unroll
            for (int m = 0; m < 4; ++m) { bf16_t* rowp = O + (size_t)(row0 + ai * HALF + m * 16) * ldc + col0;
#pragma unroll
                for (int bj = 0; bj < 2; ++bj) st8(rowp + bj * HALF, acc[ai][bj][m][0], acc[ai][bj][m][1]); }
    }
};
struct EpiSwiGLU {
    static constexpr bool PERM = true, AFTER_DRAIN = false;
    bf16_t* O; int ldc;
    __device__ __forceinline__ void operator()(const f32x4 (&acc)[2][2][4][2], const Unit& u, int wr, int wc, int fr, int fq) const {
        const int row0 = u.pm * BM + wr * 64 + fr, col0 = u.pn * HALF + wc * 32 + 8 * fq;
#pragma unroll
        for (int ai = 0; ai < 2; ++ai)
#pragma unroll
            for (int m = 0; m < 4; ++m) { bf16_t* rowp = O + (size_t)(row0 + ai * HALF + m * 16) * ldc + col0;
                f32x4 v0, v1;
#pragma unroll
                for (int j = 0; j < 4; ++j) { v0[j] = silu_f(acc[ai][0][m][0][j]) * acc[ai][1][m][0][j]; v1[j] = silu_f(acc[ai][0][m][1][j]) * acc[ai][1][m][1][j]; }
                st8(rowp, v0, v1); }
    }
};
struct EpiP {
    static constexpr bool PERM = true, AFTER_DRAIN = false;
    bf16_t* O; int ldc; float* G;
    __device__ __forceinline__ void operator()(const f32x4 (&acc)[2][2][4][2], const Unit& u, int wr, int wc, int fr, int fq) const {
        const int row0 = u.pm * BM + wr * 64 + fr, col0 = u.pn * BM + wc * 32 + 8 * fq;
        const bool gt = (u.pn == 9) && (wc == 2) && (fq < 2);
#pragma unroll
        for (int ai = 0; ai < 2; ++ai)
#pragma unroll
            for (int m = 0; m < 4; ++m) { const int row = row0 + ai * HALF + m * 16; bf16_t* rowp = O + (size_t)row * ldc + col0;
#pragma unroll
                for (int bj = 0; bj < 2; ++bj) st8(rowp + bj * HALF, acc[ai][bj][m][0], acc[ai][bj][m][1]);
                if (gt) { *(f32x4*)(G + (size_t)row * 16 + 8 * fq) = acc[ai][1][m][0]; *(f32x4*)(G + (size_t)row * 16 + 8 * fq + 4) = acc[ai][1][m][1]; } }
    }
};
struct EpiSlab {
    static constexpr bool PERM = false, AFTER_DRAIN = false;
    float* S;
    __device__ __forceinline__ void operator()(const f32x4 (&acc)[2][2][4][2], const Unit& u, int wr, int wc, int fr, int fq) const {
        const int row0 = (u.pm / 17) * BM + wr * 64 + fr, col0 = u.pn * BM + wc * 32 + 4 * fq; const int slice = u.kt0 / u.nkt;
        float* base = S + (size_t)slice * 1024 * 1024;
#pragma unroll
        for (int ai = 0; ai < 2; ++ai)
#pragma unroll
            for (int m = 0; m < 4; ++m) { float* rowp = base + (size_t)(row0 + ai * HALF + m * 16) * 1024 + col0;
#pragma unroll
                for (int bj = 0; bj < 2; ++bj)
#pragma unroll
                    for (int n = 0; n < 2; ++n) *(f32x4*)(rowp + bj * HALF + n * 16) = acc[ai][bj][m][n]; }
    }
};
struct TileOrder {
    int mode, nM, nN, nwg, G, c, nkt, nsl;
    __device__ void init(int mode_, int N, int K, int G_, int c_, int nsl_) { mode = mode_; nN = N / BM; G = G_; c = c_; nsl = nsl_;
        if (mode == 2) { nM = 4; nwg = 4 * nN * nsl; nkt = (K / BK) / nsl; } else { nM = mode == 1 ? 64 : 68; nwg = nM * nN; nkt = K / BK; } }
    __device__ bool next(int i, Unit& u) const {
        const long L = (long)i * G + c; if (L >= nwg) return false;
        if (mode == 2) { const int sl = (int)L % nsl, t = (int)L / nsl; u.pn = t % nN; u.pm = 17 * (t / nN); u.kt0 = sl * nkt; u.nkt = nkt; return true; }
        int wgid = (int)L; { const int q = nwg / NXCD, r = nwg % NXCD, xcd = wgid % NXCD, off = wgid / NXCD; wgid = (xcd < r ? xcd * (q + 1) : r * (q + 1) + (xcd - r) * q) + off; }
        const int nig = WGM * nN, gid = wgid / nig, fm = gid * WGM, gsz = (nM - fm) < WGM ? (nM - fm) : WGM;
        int pm = fm + ((wgid % nig) % gsz); u.pn = (wgid % nig) / gsz; if (mode == 1) pm += (pm >> 4) + 1;
        u.pm = pm; u.kt0 = 0; u.nkt = nkt;
        if (mode == 3) { if (u.pn < 3) { u.kt0 = 0; u.nkt = 4; } else { u.kt0 = 4; u.nkt = 2; } }
        return true;
    }
    __device__ __forceinline__ void a_ready(const Unit&) const {}
    __device__ __forceinline__ void done(const Unit&) const {}
};

struct PanelSS {
    unsigned* xbuf;
    unsigned* cnt;
    __device__ __forceinline__ void run(const f32x4 (&v)[2][2][4][2], const Unit& u, int wr, int wc, int fr, int fq, PG8_LAS unsigned char* lds, int wid, int lane) const {
        PG8_LAS float* P = (PG8_LAS float*)lds;
        PG8_LAS float* S = (PG8_LAS float*)(lds + 8192);
#pragma unroll
        for (int ai = 0; ai < 2; ++ai)
#pragma unroll
            for (int m = 0; m < 4; ++m) { float s = 0.f;
#pragma unroll
                for (int bj = 0; bj < 2; ++bj)
#pragma unroll
                    for (int n = 0; n < 2; ++n) { const f32x4 x = v[ai][bj][m][n]; s += (x[0] * x[0] + x[1] * x[1]) + (x[2] * x[2] + x[3] * x[3]); }
                s += __shfl_xor(s, 16); s += __shfl_xor(s, 32);
                if (fq == 0) P[(ai * HALF + wr * 64 + m * 16 + fr) * 4 + wc] = s; }
        asm volatile("s_waitcnt lgkmcnt(0)" ::: "memory"); __builtin_amdgcn_s_barrier(); asm volatile("" ::: "memory");
        const int row = wid * 32 + (lane & 31);
        if (lane < 32) { const float t = (P[row * 4 + 0] + P[row * 4 + 1]) + (P[row * 4 + 2] + P[row * 4 + 3]);
            __hip_atomic_store(xbuf + (size_t)(u.pm * BM + row) * 4 + u.pn, __float_as_uint(t), __ATOMIC_RELAXED, __HIP_MEMORY_SCOPE_AGENT); }
        asm volatile("s_waitcnt vmcnt(0)" ::: "memory");
        if (lane == 0) __hip_atomic_fetch_add(cnt + 64 * u.pm, 1u, __ATOMIC_RELAXED, __HIP_MEMORY_SCOPE_AGENT);
        if (wid == 0) { unsigned sp = 0;
            while ((unsigned)__builtin_amdgcn_readfirstlane(__hip_atomic_load(cnt + 64 * u.pm, __ATOMIC_RELAXED, __HIP_MEMORY_SCOPE_AGENT)) < 32u) { __builtin_amdgcn_s_sleep(2); if (++sp > (1u << 22)) break; }
            __builtin_amdgcn_fence(__ATOMIC_ACQUIRE, "agent"); }
        asm volatile("s_waitcnt vmcnt(0) lgkmcnt(0)" ::: "memory"); __builtin_amdgcn_s_barrier(); asm volatile("" ::: "memory");
        if (lane < 32) { const unsigned* slot = xbuf + (size_t)(u.pm * BM + row) * 4; float t = 0.f;
#pragma unroll
            for (int q = 0; q < 4; ++q) t += __uint_as_float(__hip_atomic_load(slot + q, __ATOMIC_RELAXED, __HIP_MEMORY_SCOPE_AGENT));
            S[row] = t; }
        asm volatile("s_waitcnt lgkmcnt(0)" ::: "memory"); __builtin_amdgcn_s_barrier(); asm volatile("" ::: "memory");
    }
};
struct EpiNormRes {
    static constexpr bool PERM = false, AFTER_DRAIN = true;
    const float* xsrc; float* xdst;
    bf16_t* H;
    const float* gate; const float* gpost;
    const float* gpre; const float* sc; const float* sh;
    float wgt; PanelSS st1, st2;
    __device__ __forceinline__ void fused(f32x4 (&acc)[2][2][4][2], const Unit& u, int wr, int wc, int fr, int fq, PG8_LAS unsigned char* lds, int wid, int lane) const {
        const PG8_LAS float* S = (const PG8_LAS float*)(lds + 8192);
        const int b = u.pm / 17, tp = (u.pm - 17 * b - 1) * BM;
        const int col0 = u.pn * BM + wc * 32 + 4 * fq; const size_t mo = (size_t)b * 9 * 1024;
        st1.run(acc, u, wr, wc, fr, fq, lds, wid, lane);
        {   f32x4 cg[2][2];
#pragma unroll
            for (int bj = 0; bj < 2; ++bj)
#pragma unroll
                for (int n = 0; n < 2; ++n) cg[bj][n] = *(const f32x4*)(gate + mo + col0 + bj * HALF + n * 16) * *(const f32x4*)(gpost + col0 + bj * HALF + n * 16) * wgt;
#pragma unroll
            for (int ai = 0; ai < 2; ++ai)
#pragma unroll
                for (int m = 0; m < 4; ++m) { const int r = ai * HALF + wr * 64 + m * 16 + fr; const float rs = 1.0f / sqrtf(S[r] * (1.0f / 1024.0f) + 1e-6f);
                    const size_t off = ((size_t)b * 4096 + tp + r) * 1024 + col0;
#pragma unroll
                    for (int bj = 0; bj < 2; ++bj)
#pragma unroll
                        for (int n = 0; n < 2; ++n) { const f32x4 xo = *(const f32x4*)(xsrc + off + bj * HALF + n * 16); const f32x4 xn = xo + cg[bj][n] * (acc[ai][bj][m][n] * rs);
                            acc[ai][bj][m][n] = xn; *(f32x4*)(xdst + off + bj * HALF + n * 16) = xn; }
                    asm volatile("" : "+v"(acc[ai][0][m][0]), "+v"(acc[ai][0][m][1]), "+v"(acc[ai][1][m][0]), "+v"(acc[ai][1][m][1]));
                    if (m & 1) asm volatile("" ::: "memory"); } }
        if (H == nullptr) return;
        asm volatile("s_waitcnt lgkmcnt(0)" ::: "memory"); __builtin_amdgcn_s_barrier(); asm volatile("" ::: "memory");
        st2.run(acc, u, wr, wc, fr, fq, lds, wid, lane);
        {   typedef unsigned u32x2v __attribute__((ext_vector_type(2)));
            f32x4 ca[2][2], cs[2][2];
#pragma unroll
            for (int bj = 0; bj < 2; ++bj)
#pragma unroll
                for (int n = 0; n < 2; ++n) { const int c = col0 + bj * HALF + n * 16; ca[bj][n] = *(const f32x4*)(gpre + c) * (*(const f32x4*)(sc + mo + c) + 1.0f); cs[bj][n] = *(const f32x4*)(sh + mo + c); }
#pragma unroll
            for (int ai = 0; ai < 2; ++ai)
#pragma unroll
                for (int m = 0; m < 4; ++m) { const int r = ai * HALF + wr * 64 + m * 16 + fr; const float rs = 1.0f / sqrtf(S[r] * (1.0f / 1024.0f) + 1e-6f);
                    bf16_t* hp = H + (size_t)(u.pm * BM + r) * 1024 + col0;
#pragma unroll
                    for (int bj = 0; bj < 2; ++bj)
#pragma unroll
                        for (int n = 0; n < 2; ++n) { const f32x4 o = acc[ai][bj][m][n] * rs * ca[bj][n] + cs[bj][n]; u32x2v w; w.x = cvt_pk_bf16(o[0], o[1]); w.y = cvt_pk_bf16(o[2], o[3]);
                            *(u32x2v*)(hp + bj * HALF + n * 16) = w; } } }
    }
};

template <class Epi, class Sched, bool ALIGN_EPI = false, bool SP2 = false>
__device__ __forceinline__ void gemm_phase(PG8_LAS unsigned char* lds, const Gemm g, const Sched& S, const Epi& E) {
    int tid_ = threadIdx.x; asm volatile("" : "+v"(tid_));
    const int tid = tid_, wid = __builtin_amdgcn_readfirstlane(tid >> 6), lane = tid & 63, wr = wid >> 2, wc = wid & 3, fr = lane & 15, fq = lane >> 4;
    const int K = g.K;
    unsigned voffA[2], voffB[2];
#pragma unroll
    for (int i = 0; i < 2; ++i) { int R, C; stage_rc(tid * 16 + i * 8192, R, C); const int Rb = Epi::PERM ? ((R & ~31) + perm32(R & 31)) : R;
        voffA[i] = (unsigned)(R * K + C) * 2u; voffB[i] = (unsigned)(Rb * K + C) * 2u; }
    const size_t kstep = (size_t)(BK * 2);
    const size_t hstep = (size_t)HALF * K * 2;
    const size_t tstep = 2 * hstep;
    const unsigned ldsw = (unsigned)wid * 1024u;
    const int aoff = lds_byte(wr * 64 + fr, fq * 8), boff = lds_byte(wc * 32 + fr, fq * 8);
#define PG8_SA(b, h) (((b) * 2 + (h)) * HTB)
#define PG8_SB(b, h) ((4 + (b) * 2 + (h)) * HTB)
#define PG8_STAGE(bufoff, gbase, voff) do { _Pragma("unroll") for (int _i = 0; _i < 2; ++_i) \
        __builtin_amdgcn_global_load_lds((const unsigned*)((const char*)(gbase) + (voff)[_i]), (PG8_LAS unsigned*)(lds + (bufoff) + ldsw + _i * 8192), 16, 0, 0); } while (0)
#define PG8_LDA(dst, b, h) do { _Pragma("unroll") for (int m = 0; m < 4; ++m) _Pragma("unroll") for (int k = 0; k < 2; ++k) dst[m][k] = *(const PG8_LAS bf16x8*)(lds + PG8_SA(b, h) + aoff + m * 2048 + k * 1024); } while (0)
#define PG8_LDB(dst, b, h) do { _Pragma("unroll") for (int n = 0; n < 2; ++n) _Pragma("unroll") for (int k = 0; k < 2; ++k) dst[n][k] = *(const PG8_LAS bf16x8*)(lds + PG8_SB(b, h) + boff + n * 2048 + k * 1024); } while (0)
#define PG8_MMA(ai, bj, At, Bt) do { __builtin_amdgcn_s_setprio(1); _Pragma("unroll") for (int m = 0; m < 4; ++m) _Pragma("unroll") for (int n = 0; n < 2; ++n) _Pragma("unroll") for (int k = 0; k < 2; ++k) \
        acc[ai][bj][m][n] = __builtin_amdgcn_mfma_f32_16x16x32_bf16(Bt[n][k], At[m][k], acc[ai][bj][m][n], 0, 0, 0); __builtin_amdgcn_s_setprio(0); } while (0)
#define PG8_WAIT_V(n) asm volatile("s_waitcnt vmcnt(" #n ")" ::: "memory")
#define PG8_WAIT_L(n) asm volatile("s_waitcnt lgkmcnt(" #n ")" ::: "memory")
#define PG8_BAR __builtin_amdgcn_s_barrier()
#define PG8_SCHED __builtin_amdgcn_sched_barrier(0)
    Unit cur, nxt; int ui = 0;
    if (!S.next(0, cur)) return;
    f32x4 acc[2][2][4][2];
#pragma unroll
    for (int a = 0; a < 2; ++a)
#pragma unroll
        for (int b = 0; b < 2; ++b)
#pragma unroll
            for (int m = 0; m < 4; ++m)
#pragma unroll
                for (int n = 0; n < 2; ++n) acc[a][b][m][n] = (f32x4){0.f, 0.f, 0.f, 0.f};
    bf16x8 At[4][2], B0[2][2], B1[2][2];
    const char* cA = (const char*)g.A + (size_t)cur.pm * tstep + (size_t)cur.kt0 * kstep; const char* cB = (const char*)g.Bt + (size_t)cur.pn * tstep + (size_t)cur.kt0 * kstep;
    S.a_ready(cur);
    if constexpr (SP2) {
        PG8_STAGE(PG8_SB(0, 0), cB, voffB); PG8_STAGE(PG8_SB(0, 1), cB + hstep, voffB); PG8_STAGE(PG8_SA(0, 0), cA, voffA); PG8_STAGE(PG8_SA(0, 1), cA + hstep, voffA);
        if (wr == 1) PG8_BAR;
        PG8_WAIT_V(2); PG8_BAR;
        PG8_STAGE(PG8_SB(1, 0), cB + kstep, voffB); PG8_STAGE(PG8_SA(1, 0), cA + kstep, voffA); PG8_STAGE(PG8_SB(1, 1), cB + hstep + kstep, voffB);
        PG8_WAIT_V(6); PG8_BAR;
    } else {
        PG8_STAGE(PG8_SB(0, 0), cB, voffB); PG8_STAGE(PG8_SA(0, 0), cA, voffA); PG8_STAGE(PG8_SB(0, 1), cB + hstep, voffB); PG8_STAGE(PG8_SA(0, 1), cA + hstep, voffA);
        if (wr == 1) PG8_BAR;
        PG8_WAIT_V(4); PG8_BAR;
        PG8_STAGE(PG8_SB(1, 0), cB + kstep, voffB); PG8_STAGE(PG8_SA(1, 0), cA + kstep, voffA); PG8_STAGE(PG8_SB(1, 1), cB + hstep + kstep, voffB);
        PG8_WAIT_V(6); PG8_BAR;
    }
    for (;;) {
        const bool has_next = S.next(ui + 1, nxt);
        const char* nA = has_next ? (const char*)g.A + (size_t)nxt.pm * tstep + (size_t)nxt.kt0 * kstep : cA; const char* nB = has_next ? (const char*)g.Bt + (size_t)nxt.pn * tstep + (size_t)nxt.kt0 * kstep : cB;
        const int nt = cur.nkt;
        for (int t = 0; t < nt; t += 2) {
            const bool last = (t == nt - 2);
            const char* a1 = cA + (size_t)(t + 1) * kstep;
            const char* a2 = last ? nA : cA + (size_t)(t + 2) * kstep; const char* b2 = last ? nB : cB + (size_t)(t + 2) * kstep;
            const char* a3 = a2 + kstep; const char* b3 = b2 + kstep;
            if (last && has_next) S.a_ready(nxt);
            if constexpr (SP2) {
            PG8_LDB(B0, 0, 0); PG8_LDB(B1, 0, 1); PG8_SCHED; PG8_LDA(At, 0, 0); PG8_STAGE(PG8_SA(1, 1), a1 + hstep, voffA);
            PG8_WAIT_V(8); PG8_WAIT_L(0); PG8_BAR; PG8_MMA(0, 0, At, B0); PG8_MMA(0, 1, At, B1); PG8_BAR; PG8_SCHED;
            PG8_LDA(At, 0, 1); PG8_STAGE(PG8_SB(0, 0), b2, voffB); PG8_STAGE(PG8_SB(0, 1), b2 + hstep, voffB); PG8_STAGE(PG8_SA(0, 0), a2, voffA);
            PG8_WAIT_V(8); PG8_WAIT_L(0); PG8_BAR; PG8_MMA(1, 0, At, B0); PG8_MMA(1, 1, At, B1); PG8_BAR; PG8_SCHED;
            PG8_LDB(B0, 1, 0); PG8_LDB(B1, 1, 1); PG8_SCHED; PG8_LDA(At, 1, 0); PG8_STAGE(PG8_SA(0, 1), a2 + hstep, voffA);
            PG8_WAIT_V(8); PG8_WAIT_L(0); PG8_BAR; PG8_MMA(0, 0, At, B0); PG8_MMA(0, 1, At, B1); PG8_BAR; PG8_SCHED;
            PG8_LDA(At, 1, 1); PG8_STAGE(PG8_SB(1, 0), b3, voffB); PG8_STAGE(PG8_SB(1, 1), b3 + hstep, voffB); PG8_STAGE(PG8_SA(1, 0), a3, voffA);
            PG8_WAIT_V(8); PG8_WAIT_L(0); PG8_BAR; PG8_MMA(1, 0, At, B0); PG8_MMA(1, 1, At, B1); PG8_BAR; PG8_SCHED;
            } else {
            PG8_LDB(B0, 0, 0); PG8_SCHED; PG8_LDA(At, 0, 0); PG8_STAGE(PG8_SA(1, 1), a1 + hstep, voffA);
            PG8_WAIT_L(8); PG8_BAR; PG8_WAIT_L(0); PG8_MMA(0, 0, At, B0); PG8_BAR; PG8_SCHED;
            PG8_LDB(B1, 0, 1); PG8_STAGE(PG8_SB(0, 0), b2, voffB);
            PG8_BAR; PG8_WAIT_L(0); PG8_MMA(0, 1, At, B1); PG8_BAR;
            PG8_LDA(At, 0, 1); PG8_STAGE(PG8_SA(0, 0), a2, voffA);
            PG8_BAR; PG8_WAIT_L(0); PG8_MMA(1, 0, At, B0); PG8_BAR; PG8_SCHED;
            PG8_STAGE(PG8_SB(0, 1), b2 + hstep, voffB);
            PG8_WAIT_V(6); PG8_BAR; PG8_MMA(1, 1, At, B1); PG8_BAR;
            PG8_LDB(B0, 1, 0); PG8_SCHED; PG8_LDA(At, 1, 0); PG8_STAGE(PG8_SA(0, 1), a2 + hstep, voffA);
            PG8_WAIT_L(8); PG8_BAR; PG8_WAIT_L(0); PG8_MMA(0, 0, At, B0); PG8_BAR; PG8_SCHED;
            PG8_LDB(B1, 1, 1); PG8_STAGE(PG8_SB(1, 0), b3, voffB);
            PG8_BAR; PG8_WAIT_L(0); PG8_MMA(0, 1, At, B1); PG8_BAR;
            PG8_LDA(At, 1, 1); PG8_STAGE(PG8_SA(1, 0), a3, voffA);
            PG8_BAR; PG8_WAIT_L(0); PG8_MMA(1, 0, At, B0); PG8_BAR; PG8_SCHED;
            PG8_STAGE(PG8_SB(1, 1), b3 + hstep, voffB);
            PG8_WAIT_V(6); PG8_BAR; PG8_MMA(1, 1, At, B1); PG8_BAR;
            }
        }
        if constexpr (ALIGN_EPI) { if (wr == 0) PG8_BAR; }
        if constexpr (!Epi::AFTER_DRAIN) { E(acc, cur, wr, wc, fr, fq); S.done(cur); }
        if (!has_next) break;
#pragma unroll
        for (int a = 0; a < 2; ++a)
#pragma unroll
            for (int b = 0; b < 2; ++b)
#pragma unroll
                for (int m = 0; m < 4; ++m)
#pragma unroll
                    for (int n = 0; n < 2; ++n) acc[a][b][m][n] = (f32x4){0.f, 0.f, 0.f, 0.f};
        cur = nxt; cA = nA; cB = nB; ++ui;
        if constexpr (ALIGN_EPI) { if (wr == 1) PG8_BAR; }
    }
    PG8_WAIT_V(0);
    if constexpr (!ALIGN_EPI) { if (wr == 0) PG8_BAR; }
    PG8_BAR;
    if constexpr (Epi::AFTER_DRAIN) { E.fused(acc, cur, wr, wc, fr, fq, lds, wid, lane); S.done(cur); }
#undef PG8_SA
#undef PG8_SB
#undef PG8_STAGE
#undef PG8_LDA
#undef PG8_LDB
#undef PG8_MMA
#undef PG8_WAIT_V
#undef PG8_WAIT_L
#undef PG8_BAR
#undef PG8_SCHED
}
}
namespace att {
typedef unsigned short bf16;
constexpr int NW = 8, QBLK = 32, KVBLK = 64;
constexpr float SCALE = 0.07216878364870322f;
constexpr float THR = 8.f;
constexpr int SDEPTH = 1;
constexpr int LDQ = 1792, LDK = 1792, LDR = 64, LDO = 1024;
constexpr int SHM_V = KVBLK * 128 * 2, SHM_K = KVBLK * 192 * 2, SHM_QR = NW * 4 * 64 * 16, SHM_ATTN = 2 * SHM_V + 2 * SHM_K + NW * 64 * 4 + SHM_QR;
using bf16x8 = __attribute__((ext_vector_type(8))) short;
using s16x4  = __attribute__((ext_vector_type(4))) short;
using f32x16 = __attribute__((ext_vector_type(16))) float;
using u32x4  = __attribute__((ext_vector_type(4))) unsigned;
#define KSWZ(row, colB) ((row) * 384 + ((colB) ^ ((((row) >> 1) & 7) << 4)))
#define SBAR() __builtin_amdgcn_sched_barrier(0)
__device__ __forceinline__ int crow(int r, int hi) { return (r & 3) + 8 * (r >> 2) + 4 * hi; }
__device__ __forceinline__ unsigned cvtpk(float lo, float hi) { unsigned r; asm volatile("v_cvt_pk_bf16_f32 %0, %1, %2" : "=v"(r) : "v"(lo), "v"(hi)); return r; }
__device__ __forceinline__ bf16x8 ld8(const bf16* p) { return *reinterpret_cast<const bf16x8*>(p); }
__device__ __forceinline__ float bf2f(short b) { return __uint_as_float(((unsigned)(unsigned short)b) << 16); }

__device__ __forceinline__ void partialSM(f32x16& p0, f32x16& p1, float& m_reg, float& mn, float& alpha) {
  constexpr float C = SCALE * 1.4426950408889634f;
  float pmax = p0[0];
#pragma unroll
  for (int r = 1; r < 16; ++r) pmax = fmaxf(pmax, p0[r]);
#pragma unroll
  for (int r = 0; r < 16; ++r) pmax = fmaxf(pmax, p1[r]);
  { auto rr = __builtin_amdgcn_permlane32_swap(__float_as_uint(pmax), __float_as_uint(pmax), false, false);
    pmax = fmaxf(__uint_as_float(rr[0]), __uint_as_float(rr[1])); }
  if (__builtin_expect(__all(pmax - m_reg <= THR / SCALE), 1)) { mn = m_reg; alpha = 1.f; }
  else { mn = fmaxf(m_reg, pmax); alpha = __builtin_amdgcn_exp2f((m_reg - mn) * C); m_reg = mn; }
  float mnC = -mn * C;
#pragma unroll
  for (int r = 0; r < 16; ++r) p0[r] = fmaf(p0[r], C, mnC);
#pragma unroll
  for (int r = 0; r < 16; ++r) p1[r] = fmaf(p1[r], C, mnC);
#pragma unroll
  for (int r = 0; r < 16; ++r) p0[r] = __builtin_amdgcn_exp2f(p0[r]);
}
__device__ __forceinline__ void finishSM(f32x16& p0, f32x16& p1, float alpha, float& l_reg, bf16x8& pa0, bf16x8& pa1, bf16x8& pa2, bf16x8& pa3) {
#pragma unroll
  for (int r = 0; r < 16; ++r) p1[r] = __builtin_amdgcn_exp2f(p1[r]);
  float ps = 0;
#pragma unroll
  for (int r = 0; r < 16; ++r) ps += p0[r];
#pragma unroll
  for (int r = 0; r < 16; ++r) ps += p1[r];
  { auto rr = __builtin_amdgcn_permlane32_swap(__float_as_uint(ps), __float_as_uint(ps), false, false);
    ps = __uint_as_float(rr[0]) + __uint_as_float(rr[1]); }
  l_reg = l_reg * alpha + ps;
#define PK4(P, BASE, OUT) do { unsigned a0 = cvtpk(P[BASE + 0], P[BASE + 1]), a1 = cvtpk(P[BASE + 2], P[BASE + 3]);   \
    unsigned b0 = cvtpk(P[BASE + 4], P[BASE + 5]), b1 = cvtpk(P[BASE + 6], P[BASE + 7]);                              \
    auto r0 = __builtin_amdgcn_permlane32_swap(a0, b0, false, false); auto r1 = __builtin_amdgcn_permlane32_swap(a1, b1, false, false); \
    u32x4 w = {r0[0], r1[0], r0[1], r1[1]}; OUT = *reinterpret_cast<bf16x8*>(&w); } while (0)
  PK4(p0, 0, pa0); PK4(p0, 8, pa1); PK4(p1, 0, pa2); PK4(p1, 8, pa3);
#undef PK4
}
__device__ __forceinline__ void qkt(f32x16& p0, f32x16& p1, const bf16* Ks, const bf16x8 (&qr)[8], const bf16x8* qrl, int r32, int hi) {
  p0 = f32x16{}; p1 = f32x16{};
#pragma unroll
  for (int d0 = 0; d0 < 12; ++d0) { int cb = (d0 * 16 + hi * 8) * 2;
    bf16x8 b0 = *reinterpret_cast<const bf16x8*>((const char*)Ks + KSWZ(r32, cb));
    bf16x8 b1 = *reinterpret_cast<const bf16x8*>((const char*)Ks + KSWZ(32 + r32, cb));
    const bf16x8 qf = d0 < 8 ? qr[d0 < 8 ? d0 : 0] : qrl[(d0 - 8) * 64];
    p0 = __builtin_amdgcn_mfma_f32_32x32x16_bf16(b0, qf, p0, 0, 0, 0);
    p1 = __builtin_amdgcn_mfma_f32_32x32x16_bf16(b1, qf, p1, 0, 0, 0); }
}
__device__ __forceinline__ int v_st(int k, int c) { const int kk = (k & ~0xC) | ((k & 4) << 1) | ((k & 8) >> 1); return ((kk >> 3) * 4 + (c >> 5)) * 512 + ((kk & 7) * 32 + (c & 31)) * 2; }
__device__ __forceinline__ int v_rd_base(int lane) { return ((lane & 3) << 3) | (((lane >> 2) & 3) << 6) | (((lane >> 4) & 1) << 5) | (((lane >> 5) & 1) << 8); }
constexpr int v_rd_off(int d0, int ks, int half) { return d0 * 512 + ks * 4096 + half * 2048; }
template <int OFF> __device__ __forceinline__ s16x4 tr_read(int vb) {
  s16x4 r; asm volatile("ds_read_b64_tr_b16 %0, %1 offset:%2" : "=&v"(r) : "v"(vb), "i"(OFF) : "memory"); return r;
}
template <int D0> __device__ __forceinline__ void pv_one(f32x16& od, int vb, bf16x8 pa0, bf16x8 pa1, bf16x8 pa2, bf16x8 pa3) {
  const s16x4 l0 = tr_read<v_rd_off(D0, 0, 0)>(vb), h0 = tr_read<v_rd_off(D0, 0, 1)>(vb), l1 = tr_read<v_rd_off(D0, 1, 0)>(vb), h1 = tr_read<v_rd_off(D0, 1, 1)>(vb);
  const s16x4 l2 = tr_read<v_rd_off(D0, 2, 0)>(vb), h2 = tr_read<v_rd_off(D0, 2, 1)>(vb), l3 = tr_read<v_rd_off(D0, 3, 0)>(vb), h3 = tr_read<v_rd_off(D0, 3, 1)>(vb);
  asm volatile("s_waitcnt lgkmcnt(0)" ::: "memory"); SBAR();
#define PK(L, H) (bf16x8){L[0], L[1], L[2], L[3], H[0], H[1], H[2], H[3]}
  od = __builtin_amdgcn_mfma_f32_32x32x16_bf16(pa0, PK(l0, h0), od, 0, 0, 0);
  od = __builtin_amdgcn_mfma_f32_32x32x16_bf16(pa1, PK(l1, h1), od, 0, 0, 0);
  od = __builtin_amdgcn_mfma_f32_32x32x16_bf16(pa2, PK(l2, h2), od, 0, 0, 0);
  od = __builtin_amdgcn_mfma_f32_32x32x16_bf16(pa3, PK(l3, h3), od, 0, 0, 0);
#undef PK
}
__device__ __forceinline__ void pv_d0(f32x16 (&o)[4], int vb, bf16x8 pa0, bf16x8 pa1, bf16x8 pa2, bf16x8 pa3) {
  pv_one<0>(o[0], vb, pa0, pa1, pa2, pa3); pv_one<1>(o[1], vb, pa0, pa1, pa2, pa3); pv_one<2>(o[2], vb, pa0, pa1, pa2, pa3); pv_one<3>(o[3], vb, pa0, pa1, pa2, pa3);
}
__device__ __forceinline__ void attn_body(const bf16* __restrict__ Qb, const bf16* __restrict__ Kn, const bf16* __restrict__ Vh, const bf16* __restrict__ Kr,
                                          bf16* __restrict__ Ob, int seq, int rope, int qtok0, const float* __restrict__ tab, char* lds,
                                          unsigned* __restrict__ xs, unsigned* __restrict__ cnt, const float* __restrict__ gain, int head) {
  int tid_ = threadIdx.x; asm volatile("" : "+v"(tid_));
  const int tid = tid_, wid = tid >> 6, lane = tid & 63, r32 = lane & 31, hi = lane >> 5;
  bf16* V_lds = (bf16*)lds; bf16* K_lds = (bf16*)(lds + 2 * SHM_V);
  float* ws = (float*)(lds + 2 * SHM_V + 2 * SHM_K) + wid * 64; float* li_l = ws; float* al_l = ws + 32;
  float m_reg = -1e30f, l_reg = 0; f32x16 o[4] = {}; bf16x8 qr[8]; bf16x8 qx[4];
  bf16x8* qrl = (bf16x8*)(lds + 2 * SHM_V + 2 * SHM_K + NW * 64 * 4) + wid * 256 + lane;
  const bf16* Qw = Qb + (long)(wid * QBLK + r32) * LDQ + hi * 8;
#pragma unroll
  for (int d0 = 0; d0 < 8; ++d0) qr[d0] = ld8(Qw + d0 * 16);
#pragma unroll
  for (int d0 = 0; d0 < 4; ++d0) qx[d0] = ld8(Qw + 128 + d0 * 16);
  if (rope) {
    const int tt = qtok0 + wid * QBLK + r32; const int prow = tt >> 6, pcol = tt & 63;
    const float* tr = tab + (prow * 16 + hi * 8) * 2; const float* tc = tab + (pcol * 16 + hi * 8) * 2;
    unsigned a1[4], a2[4], c1[4], c2[4];
#pragma unroll
    for (int j = 0; j < 8; j += 2) {
      float o1[2], o2[2], p1[2], p2[2];
#pragma unroll
      for (int e = 0; e < 2; ++e) {
        const float cr = tr[(j + e) * 2], sr_ = tr[(j + e) * 2 + 1], cc = tc[(j + e) * 2], sc_ = tc[(j + e) * 2 + 1];
        const float x1 = bf2f(qx[0][j + e]), x2 = bf2f(qx[1][j + e]), y1 = bf2f(qx[2][j + e]), y2 = bf2f(qx[3][j + e]);
        o1[e] = x1 * cr - x2 * sr_; o2[e] = x2 * cr + x1 * sr_; p1[e] = y1 * cc - y2 * sc_; p2[e] = y2 * cc + y1 * sc_; }
      a1[j >> 1] = cvtpk(o1[0], o1[1]); a2[j >> 1] = cvtpk(o2[0], o2[1]); c1[j >> 1] = cvtpk(p1[0], p1[1]); c2[j >> 1] = cvtpk(p2[0], p2[1]); }
    { u32x4 w = {a1[0], a1[1], a1[2], a1[3]}; qx[0] = *reinterpret_cast<bf16x8*>(&w); }
    { u32x4 w = {a2[0], a2[1], a2[2], a2[3]}; qx[1] = *reinterpret_cast<bf16x8*>(&w); }
    { u32x4 w = {c1[0], c1[1], c1[2], c1[3]}; qx[2] = *reinterpret_cast<bf16x8*>(&w); }
    { u32x4 w = {c2[0], c2[1], c2[2], c2[3]}; qx[3] = *reinterpret_cast<bf16x8*>(&w); }
  }
#pragma unroll
  for (int d0 = 0; d0 < 4; ++d0) qrl[d0 * 64] = qx[d0];
  const int sr = tid >> 4, sc = (tid & 15) * 8, vst0 = v_st(sr, sc), vst1 = v_st(32 + sr, sc);
  const int rr = tid >> 3, rc = (tid & 7) * 8;
  const int vb0 = (int)(uintptr_t)V_lds + v_rd_base(lane);
  struct { bf16x8 vs0, vs1, ks0, ks1, kr0; } sr_[SDEPTH];
#define SLOAD(i, k0) do { sr_[i].vs0 = ld8(&Vh[(long)((k0) + sr) * LDK + sc]); sr_[i].vs1 = ld8(&Vh[(long)((k0) + 32 + sr) * LDK + sc]); \
    sr_[i].ks0 = ld8(&Kn[(long)((k0) + sr) * LDK + sc]); sr_[i].ks1 = ld8(&Kn[(long)((k0) + 32 + sr) * LDK + sc]); sr_[i].kr0 = ld8(&Kr[(long)((k0) + rr) * LDR + rc]); } while (0)
#define SWRITE(b, i) do { *(bf16x8*)((char*)V_lds + (b) * SHM_V + vst0) = sr_[i].vs0;          \
    *(bf16x8*)((char*)V_lds + (b) * SHM_V + vst1) = sr_[i].vs1; int kc = sc * 2;               \
    *(bf16x8*)((char*)K_lds + (b) * SHM_K + KSWZ(sr, kc)) = sr_[i].ks0;                       \
    *(bf16x8*)((char*)K_lds + (b) * SHM_K + KSWZ(32 + sr, kc)) = sr_[i].ks1;                  \
    *(bf16x8*)((char*)K_lds + (b) * SHM_K + KSWZ(rr, 256 + rc * 2)) = sr_[i].kr0; } while (0)
#define SWAIT() do { if constexpr (SDEPTH == 2) asm volatile("s_waitcnt vmcnt(5)" ::: "memory"); else asm volatile("s_waitcnt vmcnt(0)" ::: "memory"); } while (0)
#define RESC(a) do { if (__any((a) < 1.f)) { if (hi == 0) al_l[r32] = (a); asm volatile("s_waitcnt lgkmcnt(0)" ::: "memory"); \
    _Pragma("unroll") for (int d = 0; d < 4; ++d) _Pragma("unroll") for (int r = 0; r < 16; ++r) o[d][r] *= al_l[crow(r, hi)]; } } while (0)
  f32x16 pA0, pA1, pB0, pB1; float mnA, mnB, alA, alB; bf16x8 pa0, pa1, pa2, pa3; const int NT = seq / KVBLK;
  constexpr int SE = 0, SO = SDEPTH - 1;
  SLOAD(SE, 0); asm volatile("s_waitcnt vmcnt(0)" ::: "memory"); SWRITE(0, SE); __syncthreads();
  qkt(pA0, pA1, K_lds, qr, qrl, r32, hi); partialSM(pA0, pA1, m_reg, mnA, alA);
  SLOAD(SO, KVBLK); if constexpr (SDEPTH == 2) { if (2 < NT) SLOAD(SE, 2 * KVBLK); }
  SWAIT(); SWRITE(1, SO); __syncthreads();
  for (int j = 1; j + 1 < NT; j += 2) {
    SBAR(); qkt(pB0, pB1, (bf16*)((char*)K_lds + SHM_K), qr, qrl, r32, hi);
    finishSM(pA0, pA1, alA, l_reg, pa0, pa1, pa2, pa3); SBAR();
    SLOAD(SO, (j + SDEPTH) * KVBLK); SBAR();
    pv_d0(o, vb0, pa0, pa1, pa2, pa3); partialSM(pB0, pB1, m_reg, mnB, alB);
    __syncthreads(); SWAIT(); SWRITE(0, SE);
    RESC(alB); __syncthreads();
    SBAR(); qkt(pA0, pA1, K_lds, qr, qrl, r32, hi);
    finishSM(pB0, pB1, alB, l_reg, pa0, pa1, pa2, pa3); SBAR();
    if (SDEPTH == 1 || j + 3 < NT) SLOAD(SE, (j + 1 + SDEPTH) * KVBLK); SBAR();
    pv_d0(o, vb0 + (int)SHM_V, pa0, pa1, pa2, pa3); partialSM(pA0, pA1, m_reg, mnA, alA);
    __syncthreads(); SWAIT(); SWRITE(1, SO);
    RESC(alA); __syncthreads();
  }
  SBAR(); qkt(pB0, pB1, (bf16*)((char*)K_lds + SHM_K), qr, qrl, r32, hi);
  finishSM(pA0, pA1, alA, l_reg, pa0, pa1, pa2, pa3); SBAR();
  pv_d0(o, vb0, pa0, pa1, pa2, pa3); partialSM(pB0, pB1, m_reg, mnB, alB);
  __syncthreads(); RESC(alB);
  finishSM(pB0, pB1, alB, l_reg, pa0, pa1, pa2, pa3); SBAR();
  pv_d0(o, vb0 + (int)SHM_V, pa0, pa1, pa2, pa3);
  if (hi == 0) li_l[r32] = l_reg; asm volatile("s_waitcnt lgkmcnt(0)" ::: "memory");
  float rli[16];
#pragma unroll
  for (int r = 0; r < 16; ++r) rli[r] = __builtin_amdgcn_rcpf(li_l[crow(r, hi)]);
  float rs[16];
#pragma unroll
  for (int r = 0; r < 16; ++r) { float s = 0.f;
#pragma unroll
    for (int d0 = 0; d0 < 4; ++d0) { o[d0][r] *= rli[r]; s += o[d0][r] * o[d0][r]; }
    rs[r] = s; }
#pragma unroll
  for (int x = 1; x < 32; x <<= 1)
#pragma unroll
    for (int r = 0; r < 16; ++r) rs[r] += __shfl_xor(rs[r], x);
  asm volatile("s_waitcnt lgkmcnt(0)" ::: "memory");
  if (r32 == 0) {
#pragma unroll
    for (int r = 0; r < 16; ++r) al_l[crow(r, hi)] = rs[r]; }
  asm volatile("s_waitcnt lgkmcnt(0)" ::: "memory");
  if (lane < 32) __hip_atomic_store(xs + (size_t)(wid * QBLK + lane) * 4 + head, __float_as_uint(al_l[lane]), __ATOMIC_RELAXED, __HIP_MEMORY_SCOPE_AGENT);
  asm volatile("s_waitcnt vmcnt(0)" ::: "memory");
  if (lane == 0) __hip_atomic_fetch_add(cnt, 1u, __ATOMIC_RELAXED, __HIP_MEMORY_SCOPE_AGENT);
  if (wid == 0) { unsigned sp = 0;
    while ((unsigned)__builtin_amdgcn_readfirstlane(__hip_atomic_load(cnt, __ATOMIC_RELAXED, __HIP_MEMORY_SCOPE_AGENT)) < 32u) { __builtin_amdgcn_s_sleep(2); if (++sp > (1u << 22)) break; }
    __builtin_amdgcn_fence(__ATOMIC_ACQUIRE, "agent"); }
  asm volatile("s_waitcnt vmcnt(0) lgkmcnt(0)" ::: "memory"); __syncthreads();
  if (lane < 32) { const unsigned* sl = xs + (size_t)(wid * QBLK + lane) * 4; float t = 0.f;
#pragma unroll
    for (int q = 0; q < 4; ++q) t += __uint_as_float(__hip_atomic_load(sl + q, __ATOMIC_RELAXED, __HIP_MEMORY_SCOPE_AGENT));
    li_l[lane] = 1.0f / sqrtf(t * (1.0f / 512.0f) + 1e-6f); }
  asm volatile("s_waitcnt lgkmcnt(0)" ::: "memory");
  float g4[4];
#pragma unroll
  for (int d0 = 0; d0 < 4; ++d0) g4[d0] = gain[d0 * 32 + r32];
  bf16* Ow = Ob + (long)(wid * QBLK) * LDO;
#pragma unroll
  for (int r = 0; r < 16; ++r) { int orow = crow(r, hi); const float rn = li_l[orow];
#pragma unroll
    for (int d0 = 0; d0 < 4; ++d0) { const float v = o[d0][r] * rn * g4[d0]; Ow[(long)orow * LDO + d0 * 32 + r32] = (bf16)(cvtpk(v, v) & 0xffffu); } }
  __syncthreads();
#undef SLOAD
#undef SWRITE
#undef SWAIT
#undef RESC
}
#undef KSWZ
#undef SBAR
}

namespace ml {
using att::bf16; using att::bf16x8; using att::s16x4; using att::f32x16; using att::u32x4;
typedef float f32x4 __attribute__((ext_vector_type(4)));
using att::crow;
__device__ __forceinline__ unsigned cvtpk(float lo, float hi) { unsigned r; asm("v_cvt_pk_bf16_f32 %0, %1, %2" : "=v"(r) : "v"(lo), "v"(hi)); return r; }
 using att::ld8; using att::bf2f; using att::v_st; using att::v_rd_base; using att::v_rd_off;
constexpr int TBr = 4352, CTXr = 256, SEQr = 4096;
constexpr float LOG2E = 1.4426950408889634f;
constexpr int TSTRIDE = 32 * 17 * 256;
#define MLAS __attribute__((address_space(3)))
__device__ __forceinline__ float log_sigmoid_f(float x) { return x >= 0.f ? -log1pf(__expf(-x)) : x - log1pf(__expf(x)); }
template <int OFF> __device__ __forceinline__ s16x4 trr(int vb) { s16x4 r; asm volatile("ds_read_b64_tr_b16 %0, %1 offset:%2" : "=&v"(r) : "v"(vb), "i"(OFF) : "memory"); return r; }
#define MLPK(L, H) (bf16x8){L[0], L[1], L[2], L[3], H[0], H[1], H[2], H[3]}
__device__ __forceinline__ void unit_rows(int b, int dir, int j, int& rb, int& sg) {
    if (dir == 0) { rb = b * TBr + 256 * j; sg = 1; }
    else { rb = (j == 0) ? b * TBr + 255 : b * TBr + TBr - 1 - 256 * (j - 1); sg = -1; }
}
struct Conv8 { float w0[8], w1[8], w2[8], bb[8]; };
__device__ __forceinline__ void conv8_load(Conv8& cp, const float* __restrict__ cw, const float* __restrict__ cb, int c) {
#pragma unroll
    for (int j = 0; j < 8; ++j) { cp.w0[j] = cw[c + j]; cp.w1[j] = cw[1024 + c + j]; cp.w2[j] = cw[2048 + c + j]; cp.bb[j] = cb[c + j]; }
}
__device__ __forceinline__ void conv8x8(const bf16* __restrict__ P, int r0, int sg, int sr, int c, const Conv8& cp, float scale, bf16x8 (&out)[8]) {
    bf16x8 x0[8], xm[8], xp[8]; float fm[8], fp[8];
#pragma unroll
    for (int g = 0; g < 8; ++g) { const int r = r0 + sg * (32 * g + sr); const int t = r % TBr; const bool hp = (t != 0) && (t != CTXr), hn = (t != CTXr - 1) && (t != TBr - 1);
        const bf16* p = P + (size_t)r * 2560 + 448 + c; x0[g] = ld8(p); xm[g] = ld8(hp ? p - 2560 : p); xp[g] = ld8(hn ? p + 2560 : p); fm[g] = hp ? 1.0f : 0.0f; fp[g] = hn ? 1.0f : 0.0f; }
    asm volatile("" ::: "memory");
#pragma unroll
    for (int g = 0; g < 8; ++g) { float u[8];
#pragma unroll
        for (int j = 0; j < 8; ++j) { const float a = cp.w0[j] * fm[g] * bf2f(xm[g][j]) + cp.w1[j] * bf2f(x0[g][j]) + cp.w2[j] * fp[g] * bf2f(xp[g][j]) + cp.bb[j];
            u[j] = a * __builtin_amdgcn_rcpf(1.0f + __builtin_amdgcn_exp2f(-LOG2E * a)) * scale; }
        u32x4 o = {cvtpk(u[0], u[1]), cvtpk(u[2], u[3]), cvtpk(u[4], u[5]), cvtpk(u[6], u[7])};
        out[g] = *reinterpret_cast<bf16x8*>(&o); }
}
__device__ __forceinline__ void gate_scan_task(const float* __restrict__ G, const float* __restrict__ gate_b, float* __restrict__ T, float* __restrict__ sca, int task, int lane) {
    const int seq = task / 17, j = task - seq * 17, b = seq >> 3, h = (seq >> 1) & 3, dir = seq & 1;
    int rb, sg; unit_rows(b, dir, j, rb, sg);
    const int gi = (2 * dir) * 4 + h, gf = (2 * dir + 1) * 4 + h; const float ib = gate_b[gi], fb = gate_b[gf];
    float igv[4], fgv[4];
#pragma unroll
    for (int rnd = 0; rnd < 4; ++rnd) { const size_t r = (size_t)(rb + sg * (64 * rnd + lane)); igv[rnd] = G[r * 16 + gi] + ib; fgv[rnd] = G[r * 16 + gf] + fb; }
    float cb = 0.f, cpm = -3.0e38f; float* Tb = T + (size_t)task * 256;
#pragma unroll
    for (int rnd = 0; rnd < 4; ++rnd) { const int i = 64 * rnd + lane;
        float bc = log_sigmoid_f(fgv[rnd]);
#pragma unroll
        for (int o = 1; o < 64; o <<= 1) { const float t_ = __shfl_up(bc, o); if (lane >= o) bc += t_; }
        bc += cb;
        const float al = igv[rnd] - bc; float pm = al;
#pragma unroll
        for (int o = 1; o < 64; o <<= 1) { const float t_ = __shfl_up(pm, o); if (lane >= o) pm = fmaxf(pm, t_); }
        pm = fmaxf(pm, cpm);
        Tb[i] = bc; Tb[TSTRIDE + i] = al; Tb[2 * TSTRIDE + i] = pm;
        cb = __shfl(bc, 63); cpm = __shfl(pm, 63); }
    if (j < 16 && lane == 0) { sca[(seq * 16 + j) * 2] = cpm; sca[(seq * 16 + j) * 2 + 1] = cb; }
}
__device__ __forceinline__ void mlstm_local(const bf16* __restrict__ P, const float* __restrict__ T, const float* __restrict__ cw, const float* __restrict__ cbias,
                                            float* __restrict__ Cloc, float* __restrict__ nloc, int unit, char* lds) {
    int tid_ = threadIdx.x; asm volatile("" : "+v"(tid_));
    const int tid = tid_, wid = tid >> 6, lane = tid & 63, r32 = lane & 31, hi = lane >> 5;
    const int seq = unit >> 4, j = unit & 15, b = seq >> 3, h = (seq >> 1) & 3, dir = seq & 1;
    int rb, sg; unit_rows(b, dir, j, rb, sg);
    const float* Tal = T + TSTRIDE + (size_t)(seq * 17 + j) * 256; const float mlm = T[2 * TSTRIDE + (size_t)(seq * 17 + j) * 256 + 255];
    float* npart = (float*)(lds + 131072);
    const int sr = tid >> 4, sc = (tid & 15) * 8;
    float wv[8]; bf16x8 vreg[8];
#pragma unroll
    for (int g = 0; g < 8; ++g) { const int i = 32 * g + sr; wv[g] = Tal[i]; vreg[g] = ld8(P + (size_t)(rb + sg * i) * 2560 + 1472 + h * 128 + sc); }
    asm volatile("" ::: "memory");
    float nacc[8] = {0.f, 0.f, 0.f, 0.f, 0.f, 0.f, 0.f, 0.f};
    { Conv8 cp; conv8_load(cp, cw, cbias, 512 + h * 128 + sc);
      bf16x8 kv[8]; conv8x8(P, rb, sg, sr, 512 + h * 128 + sc, cp, 0.08838834764831845f, kv);
#pragma unroll
      for (int g = 0; g < 8; ++g) { const int i = 32 * g + sr; *(bf16x8*)(lds + (i >> 6) * 16384 + v_st(i & 63, sc)) = kv[g]; wv[g] = __expf(wv[g] - mlm);
#pragma unroll
          for (int x = 0; x < 8; ++x) nacc[x] += wv[g] * bf2f(kv[g][x]); } }
#pragma unroll
    for (int g = 0; g < 8; ++g) { const int i = 32 * g + sr; const float w = wv[g]; const bf16x8 v = vreg[g];
        u32x4 o = {cvtpk(bf2f(v[0]) * w, bf2f(v[1]) * w), cvtpk(bf2f(v[2]) * w, bf2f(v[3]) * w), cvtpk(bf2f(v[4]) * w, bf2f(v[5]) * w), cvtpk(bf2f(v[6]) * w, bf2f(v[7]) * w)};
        *(u32x4*)(lds + 65536 + (i >> 6) * 16384 + v_st(i & 63, sc)) = o; }
#pragma unroll
    for (int x = 0; x < 8; ++x) { nacc[x] += __shfl_xor(nacc[x], 16); nacc[x] += __shfl_xor(nacc[x], 32); }
    if (lane < 16) {
#pragma unroll
        for (int x = 0; x < 8; ++x) npart[wid * 128 + sc + x] = nacc[x]; }
    __syncthreads();
    const int db = wid >> 1, eb0 = 2 * (wid & 1);
    const int vbK = (int)(uintptr_t)lds + v_rd_base(lane) + db * 512, vbV = (int)(uintptr_t)lds + 65536 + v_rd_base(lane) + eb0 * 512;
    f32x16 c0 = {}, c1 = {};
#define MLA_STEP(TL, KS) do { const s16x4 al_ = trr<(TL) * 16384 + v_rd_off(0, KS, 0)>(vbK), ah_ = trr<(TL) * 16384 + v_rd_off(0, KS, 1)>(vbK); \
        const s16x4 bl0 = trr<(TL) * 16384 + v_rd_off(0, KS, 0)>(vbV), bh0 = trr<(TL) * 16384 + v_rd_off(0, KS, 1)>(vbV), bl1 = trr<(TL) * 16384 + v_rd_off(1, KS, 0)>(vbV), bh1 = trr<(TL) * 16384 + v_rd_off(1, KS, 1)>(vbV); \
        asm volatile("s_waitcnt lgkmcnt(0)" ::: "memory"); __builtin_amdgcn_sched_barrier(0); \
        c0 = __builtin_amdgcn_mfma_f32_32x32x16_bf16(MLPK(al_, ah_), MLPK(bl0, bh0), c0, 0, 0, 0); c1 = __builtin_amdgcn_mfma_f32_32x32x16_bf16(MLPK(al_, ah_), MLPK(bl1, bh1), c1, 0, 0, 0); } while (0)
#define MLA_TILE(TL) do { MLA_STEP(TL, 0); MLA_STEP(TL, 1); MLA_STEP(TL, 2); MLA_STEP(TL, 3); } while (0)
    MLA_TILE(0); MLA_TILE(1); MLA_TILE(2); MLA_TILE(3);
#undef MLA_TILE
#undef MLA_STEP
    float* Co = Cloc + (size_t)unit * 16384;
#pragma unroll
    for (int r = 0; r < 16; ++r) { const int d = db * 32 + crow(r, hi); Co[d * 128 + eb0 * 32 + r32] = c0[r]; Co[d * 128 + eb0 * 32 + 32 + r32] = c1[r]; }
    if (tid < 128) { float s = 0.f;
#pragma unroll
        for (int w = 0; w < 8; ++w) s += npart[w * 128 + tid];
        nloc[unit * 128 + tid] = s; }
    __syncthreads();
}
__device__ __forceinline__ void mlstm_scan(const float* __restrict__ Cloc, const float* __restrict__ nloc, const float* __restrict__ sca, bf16* __restrict__ CstT, float* __restrict__ nst, float* __restrict__ bm, int gtid, int gthreads) {
    for (int item = gtid; item < 32 * 2048; item += gthreads) {
        const int seq = item >> 11, rem = item & 2047, e = rem & 127, dg = rem >> 7;
        float st[8] = {0.f, 0.f, 0.f, 0.f, 0.f, 0.f, 0.f, 0.f}; float nv = 0.f, Bst = 0.f, Mst = 0.f;
        asm volatile("" : "+v"(Bst), "+v"(Mst));
        const float* Cl0 = Cloc + (size_t)(seq * 16) * 16384 + (dg * 8) * 128 + e;
        for (int half = 0; half < 2; ++half) {
            float cl[8][8], nlv[8], mlv[8], blv[8];
#pragma unroll
            for (int jj = 0; jj < 8; ++jj) { const int lu = seq * 16 + half * 8 + jj;
#pragma unroll
                for (int i = 0; i < 8; ++i) cl[jj][i] = Cl0[(size_t)(half * 8 + jj) * 16384 + i * 128];
                nlv[jj] = nloc[lu * 128 + e]; mlv[jj] = sca[lu * 2]; blv[jj] = sca[lu * 2 + 1]; }
#pragma unroll
            for (int jj = 0; jj < 8; ++jj) { const int j = half * 8 + jj; const size_t su = (size_t)seq * 17 + j;
                u32x4 o = {cvtpk(st[0], st[1]), cvtpk(st[2], st[3]), cvtpk(st[4], st[5]), cvtpk(st[6], st[7])};
                *(u32x4*)(CstT + su * 16384 + e * 128 + dg * 8) = o;
                if (dg == 0) { nst[su * 128 + e] = nv; if (e == 0) { bm[su * 2] = Bst; bm[su * 2 + 1] = Mst; } }
                const float Mend = fmaxf(Mst, mlv[jj] - Bst), fa = __expf(Mst - Mend), fbv = __expf(mlv[jj] - Bst - Mend);
#pragma unroll
                for (int i = 0; i < 8; ++i) st[i] = fa * st[i] + fbv * cl[jj][i];
                nv = fa * nv + fbv * nlv[jj];
                Bst += blv[jj]; Mst = Mend; }
        }
        { const size_t su = (size_t)seq * 17 + 16;
          u32x4 o = {cvtpk(st[0], st[1]), cvtpk(st[2], st[3]), cvtpk(st[4], st[5]), cvtpk(st[6], st[7])};
          *(u32x4*)(CstT + su * 16384 + e * 128 + dg * 8) = o;
          if (dg == 0) { nst[su * 128 + e] = nv; if (e == 0) { bm[su * 2] = Bst; bm[su * 2 + 1] = Mst; } } }
    }
}
#define KSW(row, colB) ((row) * 256 + ((colB) ^ (((row) & 15) << 4)))
template <int D0, int KS> __device__ __forceinline__ void pv_pair(f32x16& od, int vb, bf16x8 pa, bf16x8 pb) {
    const s16x4 l0 = trr<v_rd_off(D0, KS, 0)>(vb), h0 = trr<v_rd_off(D0, KS, 1)>(vb), l1 = trr<v_rd_off(D0, KS + 1, 0)>(vb), h1 = trr<v_rd_off(D0, KS + 1, 1)>(vb);
    asm volatile("s_waitcnt lgkmcnt(0)" ::: "memory"); __builtin_amdgcn_sched_barrier(0);
    od = __builtin_amdgcn_mfma_f32_32x32x16_bf16(pa, MLPK(l0, h0), od, 0, 0, 0);
    od = __builtin_amdgcn_mfma_f32_32x32x16_bf16(pb, MLPK(l1, h1), od, 0, 0, 0);
}
__device__ __forceinline__ void mlstm_out2(const bf16* __restrict__ P, const float* __restrict__ T, const float* __restrict__ cw, const float* __restrict__ cbias, const bf16* __restrict__ CstT, const float* __restrict__ nst,
                                           const float* __restrict__ bm, const float* __restrict__ mnorm, bf16* __restrict__ MIX, int b, int h, int tb, char* lds) {
    int tid_ = threadIdx.x; asm volatile("" : "+v"(tid_));
    const int tid = tid_, wid = tid >> 6, lane = tid & 63, r32 = lane & 31, hi = lane >> 5;
    const int seqf = b * 8 + h * 2, seqb = seqf + 1; const int jb = tb == 0 ? 0 : 17 - tb; const bool zs = (tb == 0);
    const size_t suf = (size_t)seqf * 17 + tb, sub = (size_t)seqb * 17 + jb;
    const int rb = b * TBr + 256 * tb;
    float* tabs = (float*)(lds + 131072);
    float* nlf = tabs + 2048; float* nlb = tabs + 2176; float* wsc = tabs + 2304 + wid * 32;
    const int sr = tid >> 4, sc = (tid & 15) * 8;
    {   Conv8 cp; conv8_load(cp, cw, cbias, 512 + h * 128 + sc);
        bf16x8 kv[8]; conv8x8(P, rb, 1, sr, 512 + h * 128 + sc, cp, 0.08838834764831845f, kv);
#pragma unroll
        for (int g = 0; g < 8; ++g) { const int i = 32 * g + sr; *(bf16x8*)(lds + KSW(i, sc * 2)) = kv[g]; } }
    {   Conv8 cp; conv8_load(cp, cw, cbias, h * 128 + sc);
        bf16x8 qv[8]; conv8x8(P, rb, 1, sr, h * 128 + sc, cp, 1.0f, qv);
#pragma unroll
        for (int g = 0; g < 8; ++g) { const int i = 32 * g + sr; *(bf16x8*)(lds + 65536 + KSW(i, sc * 2)) = qv[g]; } }
    bf16x8 vreg[8];
#pragma unroll
    for (int g = 0; g < 8; ++g) vreg[g] = ld8(P + (size_t)(rb + 32 * g + sr) * 2560 + 1472 + h * 128 + sc);
    asm volatile("" ::: "memory");
    {
        const int dir = tid >> 8, n = tid & 255; const size_t su = dir ? sub : suf; const size_t ti = su * 256 + (dir ? 255 - n : n);
        const float bl = T[ti], al = T[TSTRIDE + ti], pm = T[2 * TSTRIDE + ti]; float Bst = 0.f, Mst = 0.f; if (!zs) { Bst = bm[su * 2]; Mst = bm[su * 2 + 1]; }
        float* tb_ = tabs + dir * 1024; const float M = fmaxf(Mst, pm - Bst);
        tb_[n] = __expf(-(Bst + bl + M)); tb_[256 + n] = (al - Bst) * LOG2E; tb_[512 + n] = M * LOG2E; tb_[768 + n] = __expf(Mst - M); }
    if (wid == 2) { nlf[lane] = zs ? 0.f : nst[suf * 128 + lane]; nlf[64 + lane] = zs ? 0.f : nst[suf * 128 + 64 + lane]; }
    if (wid == 3) { nlb[lane] = zs ? 0.f : nst[sub * 128 + lane]; nlb[64 + lane] = zs ? 0.f : nst[sub * 128 + 64 + lane]; }
    __syncthreads();
    bf16x8 qr[8];
#pragma unroll
    for (int d0 = 0; d0 < 8; ++d0) qr[d0] = *reinterpret_cast<const bf16x8*>(lds + 65536 + KSW(wid * 32 + r32, (d0 * 16 + hi * 8) * 2));
    asm volatile("s_waitcnt lgkmcnt(0)" ::: "memory");
    __syncthreads();
#pragma unroll
    for (int g = 0; g < 8; ++g) { const int i = 32 * g + sr; *(bf16x8*)(lds + 65536 + (i >> 6) * 16384 + v_st(i & 63, sc)) = vreg[g]; }
    __syncthreads();
    const int qi = wid * 32 + r32;
    float qnf = 0.f, qnb = 0.f;
#pragma unroll
    for (int d0 = 0; d0 < 8; ++d0) {
#pragma unroll
        for (int jj = 0; jj < 8; ++jj) { const float qv = bf2f(qr[d0][jj]); qnf += qv * nlf[d0 * 16 + hi * 8 + jj]; qnb += qv * nlb[d0 * 16 + hi * 8 + jj]; }
        asm volatile("" : "+v"(qnf), "+v"(qnb)); }
    { auto rr = __builtin_amdgcn_permlane32_swap(__float_as_uint(qnf), __float_as_uint(qnf), false, false); qnf = __uint_as_float(rr[0]) + __uint_as_float(rr[1]); }
    { auto rr = __builtin_amdgcn_permlane32_swap(__float_as_uint(qnb), __float_as_uint(qnb), false, false); qnb = __uint_as_float(rr[0]) + __uint_as_float(rr[1]); }
    const int vb0 = (int)(uintptr_t)lds + 65536 + v_rd_base(lane);
    const int dtile = wid >> 1;
    unsigned hfp[32];
#define ML_PK4(Pv, BASE, OUT) do { unsigned a0 = cvtpk(Pv[BASE + 0], Pv[BASE + 1]), a1 = cvtpk(Pv[BASE + 2], Pv[BASE + 3]);   \
    unsigned b0_ = cvtpk(Pv[BASE + 4], Pv[BASE + 5]), b1_ = cvtpk(Pv[BASE + 6], Pv[BASE + 7]);                              \
    auto r0 = __builtin_amdgcn_permlane32_swap(a0, b0_, false, false); auto r1 = __builtin_amdgcn_permlane32_swap(a1, b1_, false, false); \
    u32x4 w = {r0[0], r1[0], r0[1], r1[1]}; OUT = *reinterpret_cast<bf16x8*>(&w); } while (0)
#pragma unroll
    for (int dir = 0; dir < 2; ++dir) {
        const float* tb_ = tabs + dir * 1024; const size_t su = dir ? sub : suf;
        f32x16 o[4];
        if (zs) { o[0] = f32x16{}; o[1] = f32x16{}; o[2] = f32x16{}; o[3] = f32x16{}; }
        else { const bf16* Cb = CstT + su * 16384 + (size_t)r32 * 128 + hi * 8;
#pragma unroll
          for (int ep = 0; ep < 2; ++ep) { bf16x8 cf[16];
#pragma unroll
              for (int x = 0; x < 16; ++x) cf[x] = ld8(Cb + (2 * ep + (x >> 3)) * 32 * 128 + (x & 7) * 16);
              f32x16 a0 = {}, a1 = {};
#pragma unroll
              for (int d0 = 0; d0 < 8; ++d0) { a0 = __builtin_amdgcn_mfma_f32_32x32x16_bf16(qr[d0], cf[d0], a0, 0, 0, 0); a1 = __builtin_amdgcn_mfma_f32_32x32x16_bf16(qr[d0], cf[8 + d0], a1, 0, 0, 0); }
              o[2 * ep] = a0; o[2 * ep + 1] = a1; }
#pragma unroll
          for (int r = 0; r < 16; ++r) { const float isc = tb_[768 + wid * 32 + crow(r, hi)];
#pragma unroll
              for (int eb = 0; eb < 4; ++eb) o[eb][r] *= isc; } }
        const float qn = dir ? qnb : qnf;
        const float m2q = tb_[512 + qi]; float dsum = 0.f;
        const int kt0 = dir ? dtile : 0, kt1 = dir ? 4 : dtile + 1;
        for (int kt = kt0; kt < kt1; ++kt) {
            const char* Ks = lds + kt * 64 * 256; const bool diag = (kt == dtile); const int vb = vb0 + kt * 16384;
#pragma unroll
            for (int hh = 0; hh < 2; ++hh) {
                f32x16 p = {}, p2 = {};
#pragma unroll
                for (int d0 = 0; d0 < 8; d0 += 2) { const int cb = (d0 * 16 + hi * 8) * 2;
                    const bf16x8 b0 = *reinterpret_cast<const bf16x8*>(Ks + KSW(32 * hh + r32, cb)), b1 = *reinterpret_cast<const bf16x8*>(Ks + KSW(32 * hh + r32, cb + 32));
                    p = __builtin_amdgcn_mfma_f32_32x32x16_bf16(b0, qr[d0], p, 0, 0, 0); p2 = __builtin_amdgcn_mfma_f32_32x32x16_bf16(b1, qr[d0 + 1], p2, 0, 0, 0); }
                p += p2;
#pragma unroll
                for (int g4 = 0; g4 < 4; ++g4) { const int sb = kt * 64 + 32 * hh + 8 * g4 + 4 * hi;
                    const f32x4 a4 = *(const f32x4*)(tb_ + 256 + sb);
#pragma unroll
                    for (int x = 0; x < 4; ++x) { const int r = 4 * g4 + x, s0 = sb + x;
                        float w0 = __builtin_amdgcn_exp2f(a4[x] - m2q);
                        if (diag) { if (dir ? (s0 < qi) : (s0 > qi)) w0 = 0.f; }
                        p[r] *= w0; dsum += p[r]; } }
                bf16x8 pa, pb;
                ML_PK4(p, 0, pa); ML_PK4(p, 8, pb);
                if (hh == 0) { pv_pair<0, 0>(o[0], vb, pa, pb); pv_pair<1, 0>(o[1], vb, pa, pb); pv_pair<2, 0>(o[2], vb, pa, pb); pv_pair<3, 0>(o[3], vb, pa, pb); }
                else         { pv_pair<0, 2>(o[0], vb, pa, pb); pv_pair<1, 2>(o[1], vb, pa, pb); pv_pair<2, 2>(o[2], vb, pa, pb); pv_pair<3, 2>(o[3], vb, pa, pb); }
            }
        }
        { auto rr = __builtin_amdgcn_permlane32_swap(__float_as_uint(dsum), __float_as_uint(dsum), false, false); dsum = __uint_as_float(rr[0]) + __uint_as_float(rr[1]); }
        const float den = dsum + tb_[768 + qi] * qn; const float rd = 1.0f / fmaxf(fabsf(den), tb_[qi]);
        if (hi == 0) wsc[r32] = rd; asm volatile("s_waitcnt lgkmcnt(0)" ::: "memory");
        if (dir == 0) {
#pragma unroll
            for (int r = 0; r < 16; r += 2) { const float ra = wsc[crow(r, hi)], rb_ = wsc[crow(r + 1, hi)];
#pragma unroll
                for (int eb = 0; eb < 4; ++eb) hfp[eb * 8 + (r >> 1)] = cvtpk(o[eb][r] * ra, o[eb][r + 1] * rb_); }
            asm volatile("s_waitcnt lgkmcnt(0)" ::: "memory");
        } else {
            float rdr[16];
#pragma unroll
            for (int r = 0; r < 16; ++r) rdr[r] = wsc[crow(r, hi)];
            bf16x8 og8[8];
            { const bf16* ogp = P + (size_t)(rb + wid * 32 + r32) * 2560 + 1984 + h * 128 + 64 * hi;
#pragma unroll
              for (int c8 = 0; c8 < 8; ++c8) og8[c8] = ld8(ogp + 8 * c8); }
            __syncthreads();
            float* W = (float*)(lds + wid * 16896);
#pragma unroll
            for (int r = 0; r < 16; ++r)
#pragma unroll
                for (int eb = 0; eb < 4; ++eb) { const unsigned pk = hfp[eb * 8 + (r >> 1)]; const float hf = (r & 1) ? __uint_as_float(pk & 0xffff0000u) : __uint_as_float(pk << 16);
                    W[crow(r, hi) * 132 + eb * 32 + r32] = hf + o[eb][r] * rdr[r]; }
            asm volatile("s_waitcnt lgkmcnt(0)" ::: "memory");
            const int tok = r32, eh = hi; const size_t row = (size_t)(rb + wid * 32 + tok);
            const float* mg = mnorm + h * 128 + 64 * eh;
            float v[64]; float s = 0.f;
#pragma unroll
            for (int c8 = 0; c8 < 8; ++c8) { const bf16x8 g8 = og8[c8]; const f32x4 w0 = *(const f32x4*)(W + tok * 132 + 64 * eh + 8 * c8), w1 = *(const f32x4*)(W + tok * 132 + 64 * eh + 8 * c8 + 4);
                const float hv[8] = {w0.x, w0.y, w0.z, w0.w, w1.x, w1.y, w1.z, w1.w};
#pragma unroll
                for (int x = 0; x < 8; ++x) { const float vv = hv[x] * __builtin_amdgcn_rcpf(1.0f + __builtin_amdgcn_exp2f(-LOG2E * bf2f(g8[x]))); v[8 * c8 + x] = vv; s += vv; } }
            { auto rr = __builtin_amdgcn_permlane32_swap(__float_as_uint(s), __float_as_uint(s), false, false); s = __uint_as_float(rr[0]) + __uint_as_float(rr[1]); }
            const float mu = s * (1.0f / 128.0f); float q = 0.f;
#pragma unroll
            for (int x = 0; x < 64; ++x) { v[x] -= mu; q += v[x] * v[x]; }
            { auto rr = __builtin_amdgcn_permlane32_swap(__float_as_uint(q), __float_as_uint(q), false, false); q = __uint_as_float(rr[0]) + __uint_as_float(rr[1]); }
            const float rstd = 1.0f / sqrtf(q * (1.0f / 128.0f) + 1e-6f);
            bf16* orow = MIX + row * 1024 + 512 + h * 128 + 64 * eh;
#pragma unroll
            for (int c8 = 0; c8 < 8; ++c8) { const f32x4 g0 = *(const f32x4*)(mg + 8 * c8), g1 = *(const f32x4*)(mg + 8 * c8 + 4);
                u32x4 ov = {cvtpk(v[8 * c8] * rstd * g0.x, v[8 * c8 + 1] * rstd * g0.y), cvtpk(v[8 * c8 + 2] * rstd * g0.z, v[8 * c8 + 3] * rstd * g0.w),
                            cvtpk(v[8 * c8 + 4] * rstd * g1.x, v[8 * c8 + 5] * rstd * g1.y), cvtpk(v[8 * c8 + 6] * rstd * g1.z, v[8 * c8 + 7] * rstd * g1.w)};
                *(u32x4*)(orow + 8 * c8) = ov; }
        }
    }
#undef ML_PK4
    __syncthreads();
}
#undef KSW
#undef MLPK
#undef MLAS
}

#define LAS __attribute__((address_space(3)))
typedef unsigned short bf16;
typedef float f32x4 __attribute__((ext_vector_type(4)));
typedef unsigned u32x4 __attribute__((ext_vector_type(4)));
typedef unsigned u32x2 __attribute__((ext_vector_type(2)));
typedef short bf16x8 __attribute__((ext_vector_type(8)));
constexpr int NWAVES = 8, NTHREADS = 512;
constexpr int DM = 1024, NB = 4, SEQ = 4096, CTXL = 256, TB = SEQ + CTXL  , R = NB * TB  ;
constexpr int DFF = 2752, DFFP = 2816, NW1 = 2 * DFFP  , DIN = 2512, DINP = 2560, KUP = 384, NUP = 1792;
constexpr int NMOD = 9;
constexpr float EPS = 1e-6f;
constexpr size_t MiB = 1u << 20;
constexpr size_t WS_CTL = 0, CTL_BYTES = 1 * MiB;
constexpr size_t WS_MOD = 1 * MiB;
constexpr size_t WS_TAB = WS_MOD + 512 * 1024;
constexpr size_t WS_W1 = 2 * MiB;
constexpr size_t WS_W2 = WS_W1 + (size_t)2 * NW1 * DM * 2;
constexpr size_t WS_WIN = WS_W2 + (size_t)2 * DM * DFFP * 2;
constexpr size_t WS_WUP = WS_WIN + (size_t)DINP * DM * 2;
constexpr size_t WS_WOUT = WS_WUP + (size_t)NUP * KUP * 2;
constexpr size_t WS_XC = WS_WOUT + (size_t)DM * DM * 2;
constexpr size_t WS_H = WS_XC + (size_t)NB * CTXL * DM * 4;
constexpr size_t WS_BIG = WS_H + (size_t)R * DM * 2;
constexpr size_t BIG_KR = (size_t)R * DINP * 2;
constexpr size_t BIG_G = BIG_KR + (size_t)R * 64 * 2;
constexpr size_t WS_Y = WS_BIG + (size_t)R * DFFP * 2;
constexpr size_t WS_Q = WS_Y + (size_t)R * DM * 2;
constexpr size_t WS_AUP = WS_Q + (size_t)R * 768 * 2;
constexpr size_t WS_HF = WS_AUP + (size_t)R * 512 * 2;
constexpr size_t WS_HB = WS_HF + (size_t)R * 512 * 2;
constexpr size_t WS_MS = WS_HB + (size_t)R * 512 * 2;
constexpr size_t MS_NLOC = 0, MS_SCA = 262144, MS_NST = 266240, MS_BM = 544768;
constexpr size_t MS_X1 = 3u << 20, MS_X2 = (3u << 20) + (512u << 10);
constexpr size_t MS_T = 1u << 20;
constexpr size_t WS_END = WS_MS + 4 * MiB;
static_assert(BIG_G + (size_t)R * 16 * 4 <= (size_t)R * DFFP * 2, "P + KR + G fit the hidden region");
static_assert(WS_W1 % 256 == 0 && WS_W2 % 256 == 0 && WS_WIN % 256 == 0 && WS_WUP % 256 == 0 && WS_WOUT % 256 == 0 && WS_XC % 256 == 0 && WS_H % 256 == 0 && WS_BIG % 256 == 0 && WS_Y % 256 == 0 && WS_Q % 256 == 0 && WS_AUP % 256 == 0 && WS_HF % 256 == 0, "alignment");
static_assert(WS_END <= 305u * MiB, "workspace budget");
constexpr int LDS_BYTES = 147456, LDS_MISC = 143360;

#define LDS_WAIT() asm volatile("s_waitcnt lgkmcnt(0)" ::: "memory")
__device__ __forceinline__ unsigned f2bf(float f) { unsigned u = __builtin_bit_cast(unsigned, f); return (u + 0x7fffu + ((u >> 16) & 1u)) >> 16; }
__device__ __forceinline__ unsigned pk2(float lo, float hi) { return f2bf(lo) | (f2bf(hi) << 16); }
__device__ __forceinline__ float bflo(unsigned w) { return __uint_as_float(w << 16); }
__device__ __forceinline__ float bfhi(unsigned w) { return __uint_as_float(w & 0xffff0000u); }
__device__ __forceinline__ float bf1(bf16 b) { return __uint_as_float(((unsigned)b) << 16); }
__device__ __forceinline__ float wave_sum(float v) {
#pragma unroll
    for (int o = 1; o < 64; o <<= 1) v += __shfl_xor(v, o);
    return v;
}
__device__ __forceinline__ float sigmoid_f(float x) { return __builtin_amdgcn_rcpf(1.0f + __builtin_amdgcn_exp2f(-1.4426950408889634f * x)); }
__device__ __forceinline__ float silu1(float x) { return x * sigmoid_f(x); }

struct Args { const float* in[22]; float* out; unsigned char* ws; int ph_lo, ph_hi; };
struct ArgsV { const Args* p; int z;
    __device__ __forceinline__ const float* in(int i) const { return p->in[i + z]; }
    __device__ __forceinline__ float* out() const { return (float*)p->in[22 + z]; }
    __device__ __forceinline__ unsigned char* ws() const { return (unsigned char*)p->in[23 + z]; } };
enum { I_X = 0, I_C, I_CTX, I_CCTX, I_WMOD, I_BMOD, I_NPRE, I_NPOST, I_WG, I_WU, I_WD, I_WIN, I_QN, I_WUQ, I_KVN, I_WUKV, I_AON, I_CW, I_CB, I_GB, I_MN, I_WOUT };

__device__ __forceinline__ const float* xin_row(const ArgsV& a, int r) { const int b = r / TB, t = r - b * TB; return t < CTXL ? a.in(I_CTX) + (size_t)(b * CTXL + t) * DM : a.in(I_X) + (size_t)(b * SEQ + t - CTXL) * DM; }
__device__ __forceinline__ float* xres_row(const ArgsV& a, int r) { const int b = r / TB, t = r - b * TB; return t < CTXL ? (float*)(a.ws() + WS_XC) + (size_t)(b * CTXL + t) * DM : a.out() + (size_t)(b * SEQ + t - CTXL) * DM; }
__device__ __forceinline__ const float* mod_vec(const ArgsV& a, int l, int r, int j) { const int b = r / TB, t = r - b * TB; const int bb = t < CTXL ? 4 : b; return (const float*)(a.ws() + WS_MOD) + (size_t)((l * 5 + bb) * NMOD + j) * DM; }

__device__ __forceinline__ void cvt_item(const float* src, int srcN, int k0, int c0, int ncv, bf16* dst, int dstK, int drow0, int dk0, LAS float* scr, int lane) {
    const int n4 = (lane & 15) * 4, kr = lane >> 4;
    f32x4 v[16];
    const bool ok = n4 < ncv;
    const float* sp = src + (size_t)(k0 + kr) * srcN + c0 + n4;
#pragma unroll
    for (int i = 0; i < 16; ++i) { v[i] = (f32x4){0.f, 0.f, 0.f, 0.f}; if (ok) v[i] = *(const f32x4*)(sp + (size_t)(4 * i) * srcN); }
#pragma unroll
    for (int i = 0; i < 16; ++i) { const int k = 4 * i + kr; *(LAS f32x4*)(scr + k * 68 + ((n4 + 8 * (k >> 3)) & 63)) = v[i]; }
    LDS_WAIT(); asm volatile("" ::: "memory");
    const int c = lane & 7;
#pragma unroll
    for (int j = 0; j < 8; ++j) { const int n = (lane >> 3) + 8 * j; const LAS float* s = scr + (8 * c) * 68 + ((n + 8 * c) & 63);
        u32x4 o; o.x = pk2(s[0 * 68], s[1 * 68]); o.y = pk2(s[2 * 68], s[3 * 68]); o.z = pk2(s[4 * 68], s[5 * 68]); o.w = pk2(s[6 * 68], s[7 * 68]);
        *(u32x4*)(dst + (size_t)(drow0 + n) * dstK + dk0 + 8 * c) = o; }
    LDS_WAIT(); asm volatile("" ::: "memory");
}
__device__ __forceinline__ void wconv_layer(const ArgsV& a, int l, LAS unsigned char* lds, int bid, int nbl, int wave, int lane, int parts) {
    LAS float* scr = (LAS float*)(lds + wave * 17408);
    const int gw = bid * NWAVES + wave, NGW = nbl * NWAVES;
    constexpr int I_1 = 88 * 16, I_2 = 16 * 44, I_IN = 40 * 16, I_UP = 28 * 6, I_OUT = 16 * 16;
    constexpr int NITEMS = 2 * I_1 + 2 * I_2 + I_IN + I_UP + I_OUT;
    bf16* W1 = (bf16*)(a.ws() + WS_W1); bf16* W2 = (bf16*)(a.ws() + WS_W2); bf16* WIN = (bf16*)(a.ws() + WS_WIN); bf16* WUP = (bf16*)(a.ws() + WS_WUP); bf16* WOUT = (bf16*)(a.ws() + WS_WOUT);
    for (int it = gw; it < NITEMS; it += NGW) {
        int r = it;
        { const int pj = it < 2 * I_1 ? it / I_1 : (it < 2 * I_1 + 2 * I_2 ? (it - 2 * I_1) / I_2 : 2); const int pbit = pj == 0 ? 1 : (pj == 1 ? 4 : 2); if (!(parts & pbit)) continue; }
        if (r < 2 * I_1) { const int j = r / I_1; r -= j * I_1; const int g = r / 16, kb = r % 16; const int row0 = 64 * g, pn = row0 >> 8, i = row0 & 255; const int hc = 128 * pn + (i & 127);
            const float* src = (i < 128 ? a.in(I_WG) : a.in(I_WU)) + (size_t)(l * 2 + j) * DM * DFF;
            cvt_item(src, DFF, 64 * kb, hc < DFF ? hc : 0, hc < DFF ? 64 : 0, W1 + (size_t)j * NW1 * DM, DM, row0, 64 * kb, scr, lane); continue; }
        r -= 2 * I_1;
        if (r < 2 * I_2) { const int j = r / I_2; r -= j * I_2; const int g = r / 44, kb = r % 44;
            const float* src = a.in(I_WD) + (size_t)(l * 2 + j) * DFF * DM;
            cvt_item(src, DM, kb < 43 ? 64 * kb : 0, 64 * g, kb < 43 ? 64 : 0, W2 + (size_t)j * DM * DFFP, DFFP, 64 * g, 64 * kb, scr, lane); continue; }
        r -= 2 * I_2;
        if (r < I_IN) { const int g = r / 16, kb = r % 16; int ncv = DIN - 64 * g; ncv = ncv < 0 ? 0 : (ncv > 64 ? 64 : ncv);
            cvt_item(a.in(I_WIN) + (size_t)l * DM * DIN, DIN, 64 * kb, ncv > 0 ? 64 * g : 0, ncv, WIN, DM, 64 * g, 64 * kb, scr, lane); continue; }
        r -= I_IN;
        if (r < I_UP) { const int g = r / 6, kb = r % 6;
            if (g < 12) cvt_item(a.in(I_WUQ) + (size_t)l * 256 * 768, 768, kb < 4 ? 64 * kb : 0, 64 * g, kb < 4 ? 64 : 0, WUP, KUP, 64 * g, 64 * kb, scr, lane);
            else cvt_item(a.in(I_WUKV) + (size_t)l * 128 * 1024, 1024, kb >= 4 ? 64 * (kb - 4) : 0, 64 * (g - 12), kb >= 4 ? 64 : 0, WUP, KUP, 64 * g, 64 * kb, scr, lane);
            continue; }
        r -= I_UP;
        { const int g = r / 16, kb = r % 16; cvt_item(a.in(I_WOUT) + (size_t)l * DM * DM, DM, 64 * kb, 64 * g, 64, WOUT, DM, 64 * g, 64 * kb, scr, lane); }
    }
}
__device__ __forceinline__ void mod_phase(const ArgsV& a, LAS unsigned char* lds, int bid, int nbl, int tid, int wave, int lane) {
    LAS float* sv = (LAS float*)(lds);
    LAS float* red = (LAS float*)(lds + 20480);
    for (int i = tid; i < 5 * DM; i += NTHREADS) { const float v = i < 4 * DM ? a.in(I_C)[i] : a.in(I_CCTX)[i - 4 * DM]; sv[i] = silu1(v); }
    __syncthreads();
    float* mod = (float*)(a.ws() + WS_MOD);
    for (int u = bid; u < 256; u += nbl) {
        const int l = u >> 7, cb = (u & 127) * 72; const bool act = lane < 18;
        const float* W = a.in(I_WMOD) + (size_t)l * DM * (NMOD * DM) + cb + 4 * (act ? lane : 0);
        f32x4 acc[5];
#pragma unroll
        for (int bb = 0; bb < 5; ++bb) acc[bb] = (f32x4){0.f, 0.f, 0.f, 0.f};
        for (int k0 = wave * 128; k0 < wave * 128 + 128; k0 += 32) { f32x4 w[32];
#pragma unroll
            for (int i = 0; i < 32; ++i) w[i] = *(const f32x4*)(W + (size_t)(k0 + i) * (NMOD * DM));
#pragma unroll
            for (int i = 0; i < 32; ++i)
#pragma unroll
                for (int bb = 0; bb < 5; ++bb) acc[bb] += w[i] * sv[bb * DM + k0 + i]; }
        if (act) {
#pragma unroll
            for (int bb = 0; bb < 5; ++bb) *(LAS f32x4*)(red + (wave * 5 + bb) * 72 + 4 * lane) = acc[bb]; }
        __syncthreads();
        for (int i = tid; i < 5 * 72; i += NTHREADS) { const int bb = i / 72, cc = i % 72; float s = 0.f;
#pragma unroll
            for (int w = 0; w < 8; ++w) s += red[(w * 5 + bb) * 72 + cc];
            mod[(size_t)(l * 5 + bb) * (NMOD * DM) + cb + cc] = s + a.in(I_BMOD)[(size_t)l * NMOD * DM + cb + cc]; }
        __syncthreads();
    }
    if (bid == nbl - 1 && tid < 64) {
        constexpr float inv[16] = {1.0f, 0.5623413251903491f, 0.31622776601683794f, 0.1778279410038923f, 0.1f, 0.05623413251903491f, 0.03162277660168379f, 0.01778279410038923f,
                                   0.01f, 0.005623413251903491f, 0.0031622776601683794f, 0.001778279410038923f, 0.001f, 0.0005623413251903491f, 0.00031622776601683794f, 0.0001778279410038923f};
        float* tab = (float*)(a.ws() + WS_TAB);
#pragma unroll
        for (int f = 0; f < 16; ++f) {
            const float ang = (float)tid * inv[f];
            const double ad = (double)ang; const double kq = __builtin_rint(ad * 0.63661977236758134308); const double rd = ad - kq * 1.57079632679489661923;
            const float x = (float)rd, x2 = x * x; const int q = ((int)kq) & 3;
            const float sp = x + x * x2 * (-1.6666654611e-1f + x2 * (8.3321608736e-3f + x2 * (-1.9515295891e-4f)));
            const float cp = 1.0f - 0.5f * x2 + x2 * x2 * (4.166664568298827e-2f + x2 * (-1.388731625493765e-3f + x2 * 2.443315711809948e-5f));
            const float sn = (q == 0) ? sp : (q == 1) ? cp : (q == 2) ? -sp : -cp;
            const float cs = (q == 0) ? cp : (q == 1) ? -sp : (q == 2) ? -cp : sp;
            tab[(tid * 16 + f) * 2] = cs; tab[(tid * 16 + f) * 2 + 1] = sn; }
    }
    __syncthreads();
}

__device__ __forceinline__ void rw_pre(const f32x4 (&x)[4], const float* g, const float* sc, const float* sh, bf16* hrow, int lane) {
    float ss = 0.f;
#pragma unroll
    for (int j = 0; j < 4; ++j) ss += (x[j].x * x[j].x + x[j].y * x[j].y) + (x[j].z * x[j].z + x[j].w * x[j].w);
    const float rstd = 1.0f / sqrtf(wave_sum(ss) * (1.0f / DM) + EPS);
#pragma unroll
    for (int j = 0; j < 4; ++j) { const int c = 256 * j + 4 * lane; const f32x4 gv = *(const f32x4*)(g + c), sv = *(const f32x4*)(sc + c), hv = *(const f32x4*)(sh + c);
        f32x4 o; o.x = x[j].x * rstd * gv.x * (1.0f + sv.x) + hv.x; o.y = x[j].y * rstd * gv.y * (1.0f + sv.y) + hv.y; o.z = x[j].z * rstd * gv.z * (1.0f + sv.z) + hv.z; o.w = x[j].w * rstd * gv.w * (1.0f + sv.w) + hv.w;
        u32x2 w; w.x = pk2(o.x, o.y); w.y = pk2(o.z, o.w); *(u32x2*)(hrow + c) = w; }
}
__device__ __forceinline__ void phase_rw_a(const ArgsV& a, int bid, int nbl, int wave, int lane) {
    const int gw = bid * NWAVES + wave, NGW = nbl * NWAVES; bf16* H = (bf16*)(a.ws() + WS_H);
    for (int ra = gw; ra < R; ra += 2 * NGW) {
        const int rb_ = ra + NGW < R ? ra + NGW : ra; const float* xa = xin_row(a, ra); const float* xb = xin_row(a, rb_); f32x4 x0[4], x1[4];
#pragma unroll
        for (int j = 0; j < 4; ++j) { x0[j] = *(const f32x4*)(xa + 256 * j + 4 * lane); x1[j] = *(const f32x4*)(xb + 256 * j + 4 * lane); }
        rw_pre(x0, a.in(I_NPRE) + 0, mod_vec(a, 0, ra, 1), mod_vec(a, 0, ra, 0), H + (size_t)ra * DM, lane);
        if (rb_ != ra) rw_pre(x1, a.in(I_NPRE) + 0, mod_vec(a, 0, rb_, 1), mod_vec(a, 0, rb_, 0), H + (size_t)rb_ * DM, lane); }
}
__device__ __forceinline__ void rwb_load_y(const ArgsV& a, int r, int nsl, int lane, f32x4 (&y)[4]) {
    const int t = r % TB;
    const float* sp = (const float*)(a.ws() + WS_AUP) + (size_t)((r / TB) * CTXL + t) * DM + 4 * lane;
    { f32x4 v[4][4];
#pragma unroll
      for (int s = 0; s < 4; ++s)
#pragma unroll
          for (int j = 0; j < 4; ++j) v[s][j] = *(const f32x4*)(sp + (size_t)s * 1024 * 1024 + 256 * j);
#pragma unroll
      for (int j = 0; j < 4; ++j) y[j] = (v[0][j] + v[1][j]) + (v[2][j] + v[3][j]); }
    if (nsl > 4) { f32x4 v[7][4];
#pragma unroll
      for (int s = 0; s < 7; ++s)
#pragma unroll
          for (int j = 0; j < 4; ++j) v[s][j] = *(const f32x4*)(sp + (size_t)(4 + s) * 1024 * 1024 + 256 * j);
#pragma unroll
      for (int j = 0; j < 4; ++j) y[j] += ((v[0][j] + v[1][j]) + (v[2][j] + v[3][j])) + ((v[4][j] + v[5][j]) + v[6][j]); }
}
__device__ __forceinline__ void phase_rw_b(const ArgsV& a, int l, int sub, int bid, int nbl, int wave, int lane, bool dry = false) {
    const int gw = bid * NWAVES + wave, NGW = nbl * NWAVES; bf16* H = (bf16*)(a.ws() + WS_H);
    const float wgt = sub == 1 ? 1.0f : 0.5f; const float* gpost = a.in(I_NPOST) + (size_t)(l * 3 + sub) * DM;
    const int nl = sub == 2 ? l + 1 : l, nsub = sub == 2 ? 0 : sub + 1;
    const bool from_input = (l == 0 && sub == 0); const int nsl = sub == 1 ? 4 : 11;
    if (l == 1 && sub >= 1) return;
    for (int i0 = gw; i0 < NB * CTXL; i0 += NGW) {
        const int r0 = (i0 / CTXL) * TB + (i0 % CTXL);
        f32x4 y0[4], x0[4];
        const float* xs0 = from_input ? xin_row(a, r0) : xres_row(a, r0);
#pragma unroll
        for (int j = 0; j < 4; ++j) x0[j] = *(const f32x4*)(xs0 + 256 * j + 4 * lane);
        rwb_load_y(a, r0, nsl, lane, y0);
        float ss0 = 0.f;
#pragma unroll
        for (int j = 0; j < 4; ++j) ss0 += (y0[j].x * y0[j].x + y0[j].y * y0[j].y) + (y0[j].z * y0[j].z + y0[j].w * y0[j].w);
        const float rs0 = 1.0f / sqrtf(wave_sum(ss0) * (1.0f / DM) + EPS);
        float* xd0 = dry ? (float*)(a.ws() + WS_BIG) + (size_t)r0 * DM : xres_row(a, r0); const float* gate0 = mod_vec(a, l, r0, 3 * sub + 2);
#pragma unroll
        for (int j = 0; j < 4; ++j) { const int c = 256 * j + 4 * lane; const f32x4 gp = *(const f32x4*)(gpost + c), g0 = *(const f32x4*)(gate0 + c);
            x0[j].x += wgt * g0.x * (y0[j].x * rs0 * gp.x); x0[j].y += wgt * g0.y * (y0[j].y * rs0 * gp.y); x0[j].z += wgt * g0.z * (y0[j].z * rs0 * gp.z); x0[j].w += wgt * g0.w * (y0[j].w * rs0 * gp.w);
            *(f32x4*)(xd0 + c) = x0[j]; }
        rw_pre(x0, a.in(I_NPRE) + (size_t)(nl * 3 + nsub) * DM, mod_vec(a, nl, r0, 3 * nsub + 1), mod_vec(a, nl, r0, 3 * nsub), H + (size_t)r0 * DM, lane);
    }
}
__device__ __forceinline__ void phase_rw_prep(const ArgsV& a, int l, int bid, int nbl, int wave, int lane) {
    const int gw = bid * NWAVES + wave, NGW = nbl * NWAVES;
    const bf16* P = (const bf16*)(a.ws() + WS_BIG); bf16* AUP = (bf16*)(a.ws() + WS_AUP); bf16* KR = (bf16*)(a.ws() + WS_BIG + BIG_KR);
    const float* tab = (const float*)(a.ws() + WS_TAB);
    const float* qn = a.in(I_QN) + l * 256; const float* kvn = a.in(I_KVN) + l * 128;
    for (int task = gw; task < 32 * 17; task += NGW)
        ml::gate_scan_task((const float*)(a.ws() + WS_BIG + BIG_G), a.in(I_GB) + l * 16, (float*)(a.ws() + WS_MS + MS_T), (float*)(a.ws() + WS_MS + MS_SCA), task, lane);
    for (int ra = gw; ra < R; ra += 2 * NGW) {
        const int rb_ = ra + NGW < R ? ra + NGW : ra; const bool two = rb_ != ra;
        const bf16* pa = P + (size_t)ra * DINP; const bf16* pb = P + (size_t)rb_ * DINP;
        const u32x2 wa = *(const u32x2*)(pa + 4 * lane), wb = *(const u32x2*)(pb + 4 * lane);
        const unsigned ka = *(const unsigned*)(pa + 256 + 2 * lane), kb = *(const unsigned*)(pb + 256 + 2 * lane);
        const float va = bf1(pa[384 + lane]), vb = bf1(pb[384 + lane]);
        const f32x4 g = *(const f32x4*)(qn + 4 * lane); const float kg0 = kvn[2 * lane], kg1 = kvn[2 * lane + 1];
        float a0 = bflo(wa.x), a1 = bfhi(wa.x), a2 = bflo(wa.y), a3 = bfhi(wa.y), b0 = bflo(wb.x), b1 = bfhi(wb.x), b2 = bflo(wb.y), b3 = bfhi(wb.y);
        float sa = (a0 * a0 + a1 * a1) + (a2 * a2 + a3 * a3), sb = (b0 * b0 + b1 * b1) + (b2 * b2 + b3 * b3);
        const float c0 = bflo(ka), c1 = bfhi(ka), d0 = bflo(kb), d1 = bfhi(kb); float ta = c0 * c0 + c1 * c1, tb = d0 * d0 + d1 * d1;
#pragma unroll
        for (int o = 1; o < 64; o <<= 1) { sa += __shfl_xor(sa, o); sb += __shfl_xor(sb, o); ta += __shfl_xor(ta, o); tb += __shfl_xor(tb, o); }
        const float voa = __shfl_xor(va, 16), vob = __shfl_xor(vb, 16);
        const float rqa = 1.0f / sqrtf(sa * (1.0f / 256.0f) + EPS), rqb = 1.0f / sqrtf(sb * (1.0f / 256.0f) + EPS), rka = 1.0f / sqrtf(ta * (1.0f / 128.0f) + EPS), rkb = 1.0f / sqrtf(tb * (1.0f / 128.0f) + EPS);
        { u32x2 o; o.x = pk2(a0 * rqa * g.x, a1 * rqa * g.y); o.y = pk2(a2 * rqa * g.z, a3 * rqa * g.w); *(u32x2*)(AUP + (size_t)ra * KUP + 4 * lane) = o;
          *(unsigned*)(AUP + (size_t)ra * KUP + 256 + 2 * lane) = pk2(c0 * rka * kg0, c1 * rka * kg1); }
        if (two) { u32x2 o; o.x = pk2(b0 * rqb * g.x, b1 * rqb * g.y); o.y = pk2(b2 * rqb * g.z, b3 * rqb * g.w); *(u32x2*)(AUP + (size_t)rb_ * KUP + 4 * lane) = o;
          *(unsigned*)(AUP + (size_t)rb_ * KUP + 256 + 2 * lane) = pk2(d0 * rkb * kg0, d1 * rkb * kg1); }
        const int ax = lane >> 5, half = (lane >> 4) & 1, f = lane & 15;
        { const int t = ra % TB; float o = va;
          if (t >= CTXL) { const int tt = t - CTXL; const int pos = ax == 0 ? (tt >> 6) : (tt & 63); const float cs = tab[(pos * 16 + f) * 2], sn = tab[(pos * 16 + f) * 2 + 1]; o = half == 0 ? va * cs - voa * sn : va * cs + voa * sn; }
          KR[(size_t)ra * 64 + lane] = (bf16)f2bf(o); }
        if (two) { const int t = rb_ % TB; float o = vb;
          if (t >= CTXL) { const int tt = t - CTXL; const int pos = ax == 0 ? (tt >> 6) : (tt & 63); const float cs = tab[(pos * 16 + f) * 2], sn = tab[(pos * 16 + f) * 2 + 1]; o = half == 0 ? vb * cs - vob * sn : vb * cs + vob * sn; }
          KR[(size_t)rb_ * 64 + lane] = (bf16)f2bf(o); }
    }
}
#define RLX_AGENT __ATOMIC_RELAXED, __HIP_MEMORY_SCOPE_AGENT
#define VM_WAIT() asm volatile("s_waitcnt vmcnt(0)" ::: "memory")
#define XB_TMO      128
#define XB_XCNT(j)  (256  + 64 * (j))
#define XB_XSUB(j)  (1280 + 64 * (j))
#define XB_XGEN(j)  (2304 + 64 * (j))
#define XB_TOP      3328
#define XB_TOPGEN   3392
#define XCD_BAR_WORDS 3456
#define XB_SPIN_CAP (1u << 18)

__device__ __forceinline__ unsigned xb_ld(unsigned* p)              { return __hip_atomic_load(p, __ATOMIC_RELAXED, __HIP_MEMORY_SCOPE_AGENT); }
__device__ __forceinline__ unsigned xb_add(unsigned* p, unsigned v) { return __hip_atomic_fetch_add(p, v, __ATOMIC_RELAXED, __HIP_MEMORY_SCOPE_AGENT); }
__device__ __forceinline__ unsigned xb_xcc_id() { return (unsigned)__builtin_amdgcn_s_getreg((3 << 11) | 20) & 0xFu; }
#define XB_SPIN(cond, bar) do { unsigned _sp = 0; while (cond) { __builtin_amdgcn_s_sleep(1); \
    if ((++_sp & 255u) == 0u) { if (xb_ld(&(bar)[XB_TMO])) break; if (_sp > XB_SPIN_CAP) { atomicAdd(&(bar)[XB_TMO], 1u); break; } } } } while (0)

struct XcdBarrier {
    unsigned* bar; unsigned x;
    volatile LAS unsigned* st;
};

__device__ __forceinline__ XcdBarrier xcd_barrier_post(unsigned* bar, volatile LAS unsigned* st) {
    XcdBarrier b; b.bar = bar; b.x = xb_xcc_id(); b.st = st;
    if (threadIdx.x == 0) (void)xb_add(&bar[XB_XCNT(b.x)], 1u);
    return b;
}
__device__ __forceinline__ void xcd_barrier_complete(unsigned* bar, unsigned x, unsigned& nloc, unsigned& nx) {
    const unsigned G = gridDim.x * gridDim.y * gridDim.z;
    unsigned sum, cnt, mine, sp = 0u;
    for (;;) {
        sum = 0u; cnt = 0u; mine = 0u;
#pragma unroll
        for (unsigned j = 0; j < 16; ++j) { const unsigned c = xb_ld(&bar[XB_XCNT(j)]); sum += c; cnt += (c > 0u) ? 1u : 0u; mine = (j == x) ? c : mine; }
        if (sum == G) break;
        __builtin_amdgcn_s_sleep(1);
        if ((++sp & 255u) == 0u) { if (xb_ld(&bar[XB_TMO])) break; if (sp > XB_SPIN_CAP) { atomicAdd(&bar[XB_TMO], 1u); break; } }
    }
    nloc = mine > 0u ? mine : 1u; nx = cnt > 0u ? cnt : 1u;
}

__device__ __forceinline__ void xcd_barrier(const XcdBarrier& b) {
    asm volatile("s_waitcnt vmcnt(0)" ::: "memory");
    __syncthreads();
    if (threadIdx.x == 0) {
        unsigned* bar = b.bar;
        __builtin_amdgcn_s_waitcnt(0);
        unsigned nloc = b.st[0], nx = b.st[1];
        if (nloc == 0u) { xcd_barrier_complete(bar, b.x, nloc, nx); b.st[0] = nloc; b.st[1] = nx; }
        const unsigned old = xb_add(&bar[XB_XSUB(b.x)], 1u);
        const unsigned gen = old / nloc;
        if (old + 1u == (gen + 1u) * nloc) {
            __builtin_amdgcn_fence(__ATOMIC_RELEASE, "agent");
            asm volatile("s_waitcnt vmcnt(0)" ::: "memory");
            const unsigned og = xb_add(&bar[XB_TOP], 1u);
            const unsigned tg = og / nx;
            if (og + 1u == (tg + 1u) * nx) xb_add(&bar[XB_TOPGEN], 1u);
            else XB_SPIN(xb_ld(&bar[XB_TOPGEN]) == tg, bar);
            __builtin_amdgcn_fence(__ATOMIC_ACQUIRE, "agent");
            xb_add(&bar[XB_XGEN(b.x)], 1u);
            asm volatile("s_waitcnt vmcnt(0)" ::: "memory");
        } else {
            XB_SPIN(xb_ld(&bar[XB_XGEN(b.x)]) == gen, bar);
            __builtin_amdgcn_fence(__ATOMIC_ACQUIRE, "agent");
            asm volatile("s_waitcnt vmcnt(0)" ::: "memory");
        }
    }
    __syncthreads();
}
constexpr int PPL = 15, N_PHASES = 1 + 2 * PPL, SKIP_PHASE = 1 + PPL;
__global__ void __launch_bounds__(NTHREADS, 2) mega_fwd(Args args) {
    extern __shared__ __attribute__((aligned(16))) unsigned char lds_raw[];
    LAS unsigned char* lds = (LAS unsigned char*)lds_raw;
    cg::grid_group grid = cg::this_grid();
    volatile LAS unsigned* MISC = (volatile LAS unsigned*)(lds + LDS_MISC);
    if (threadIdx.x < 16) MISC[threadIdx.x] = 0u;
    __syncthreads();
    XcdBarrier bar = xcd_barrier_post((unsigned*)(args.ws + WS_CTL), MISC + 8);
    bool first_sync = true;
    for (int ph = args.ph_lo; ph < args.ph_hi; ++ph) {
        if (ph == SKIP_PHASE || ph == 1 + PPL + 11 || ph == 1 + PPL + 14 || ph == 1 + 9 || ph == 1 + PPL + 9) continue;
#define TID_DECL int tid_ = threadIdx.x; asm volatile("" : "+v"(tid_)); const int tid = tid_, lane = tid & 63, wave = __builtin_amdgcn_readfirstlane(tid >> 6); (void)tid; (void)lane; (void)wave
        int bid_ = blockIdx.x, nbl_ = gridDim.x; asm volatile("" : "+s"(bid_), "+s"(nbl_)); const int bid = bid_, nbl = nbl_;
        int zo_ = 0; asm volatile("" : "+s"(zo_));
        const ArgsV A_{&args, zo_}; unsigned char* ws = A_.ws();
        XcdBarrier barl = bar; asm volatile("" : "+s"(barl.x), "+s"(barl.bar));
        if (ph == 0) { TID_DECL; mod_phase(A_, lds, bid, nbl, tid, wave, lane); wconv_layer(A_, 0, lds, bid, nbl, wave, lane, 7); }
        else {
            const int l = (ph - 1) / PPL, k = (ph - 1) % PPL;
            if (k == 0) { TID_DECL; phase_rw_a(A_, bid, nbl, wave, lane); }
            else if (k == 1 || k == 12) { const int j = k == 12;
                pg8::Gemm g{(const pg8::bf16_t*)(ws + WS_H), (const pg8::bf16_t*)(ws + WS_W1) + (size_t)j * NW1 * DM, R, NW1, DM}; pg8::TileOrder S; S.init(0, NW1, DM, nbl, bid, 1);
                pg8::EpiSwiGLU E{(pg8::bf16_t*)(ws + WS_BIG), DFFP};
                pg8::gemm_phase<pg8::EpiSwiGLU, pg8::TileOrder, true, true>(lds, g, S, E); }
            else if (k == 2 || k == 13 || k == 10) { const int j = k == 13, sub = k == 2 ? 0 : (k == 10 ? 1 : 2);
                const pg8::bf16_t* A = (const pg8::bf16_t*)(ws + (k == 10 ? WS_H : WS_BIG));
                const pg8::bf16_t* Bt = k == 10 ? (const pg8::bf16_t*)(ws + WS_WOUT) : (const pg8::bf16_t*)(ws + WS_W2) + (size_t)j * DM * DFFP;
                const int K = k == 10 ? DM : DFFP;
                pg8::Gemm g{A, Bt, R, DM, K}; pg8::TileOrder S; S.init(1, DM, K, nbl, bid, 1);
                const bool has_next = !(l == 1 && sub == 2); const int nl = sub == 2 ? l + 1 : l, nsub = sub == 2 ? 0 : sub + 1;
                const float* modb = (const float*)(ws + WS_MOD); unsigned* cntb = (unsigned*)(ws + WS_CTL + 65536) + (size_t)((l * 3 + sub) * 2) * (68 * 64);
                pg8::EpiNormRes E{(l == 0 && sub == 0) ? A_.in(I_X) : (const float*)A_.out(), A_.out(), has_next ? (pg8::bf16_t*)(ws + WS_H) : nullptr,
                                  modb + (size_t)((l * 5) * NMOD + 3 * sub + 2) * DM, A_.in(I_NPOST) + (size_t)(l * 3 + sub) * DM,
                                  A_.in(I_NPRE) + (size_t)((has_next ? nl : 0) * 3 + nsub) * DM, modb + (size_t)(((has_next ? nl : 0) * 5) * NMOD + 3 * nsub + 1) * DM, modb + (size_t)(((has_next ? nl : 0) * 5) * NMOD + 3 * nsub) * DM,
                                  sub == 1 ? 1.0f : 0.5f, pg8::PanelSS{(unsigned*)(ws + WS_MS + MS_X1), cntb}, pg8::PanelSS{(unsigned*)(ws + WS_MS + MS_X2), cntb + 68 * 64}};
                pg8::gemm_phase<pg8::EpiNormRes, pg8::TileOrder, false, true>(lds, g, S, E);
                if (l == 0 || k == 2) { __syncthreads();
                    pg8::TileOrder S2; S2.init(2, DM, K, nbl, bid, k == 10 ? 4 : 11);
                    pg8::EpiSlab E2{(float*)(ws + WS_AUP)};
                    pg8::gemm_phase<pg8::EpiSlab, pg8::TileOrder, true, true>(lds, g, S2, E2); } }
            else if (k == 6) {
                pg8::Gemm g{(const pg8::bf16_t*)(ws + WS_AUP), (const pg8::bf16_t*)(ws + WS_WUP), R, NUP, KUP}; pg8::TileOrder S; S.init(3, NUP, KUP, nbl, bid, 1);
                pg8::EpiStore E{(pg8::bf16_t*)(ws + WS_Y), NUP};
                pg8::gemm_phase<pg8::EpiStore, pg8::TileOrder, true, true>(lds, g, S, E);
                if (k == 6) {
                    __syncthreads();
                    for (int u = bid; u < 512; u += nbl)
                        ml::mlstm_local((const ml::bf16*)(ws + WS_BIG), (const float*)(ws + WS_MS + MS_T), A_.in(I_CW) + (size_t)l * 3 * 1024, A_.in(I_CB) + (size_t)l * 1024,
                                        (float*)(ws + WS_HF), (float*)(ws + WS_MS + MS_NLOC), u, (char*)lds_raw); } }
            else if (k == 3 || k == 11 || k == 14) { TID_DECL; phase_rw_b(A_, l, k == 3 ? 0 : (k == 11 ? 1 : 2), bid, nbl, wave, lane);
                if (l == 0) wconv_layer(A_, 1, lds, bid, nbl, wave, lane, k == 3 ? 1 : (k == 11 ? 2 : 4)); }
            else if (k == 4) {
                pg8::Gemm g{(const pg8::bf16_t*)(ws + WS_H), (const pg8::bf16_t*)(ws + WS_WIN), R, DINP, DM}; pg8::TileOrder S; S.init(0, DINP, DM, nbl, bid, 1);
                pg8::EpiP E{(pg8::bf16_t*)(ws + WS_BIG), DINP, (float*)(ws + WS_BIG + BIG_G)};
                pg8::gemm_phase<pg8::EpiP, pg8::TileOrder, true, true>(lds, g, S, E); }
            else if (k == 5) { TID_DECL; phase_rw_prep(A_, l, bid, nbl, wave, lane); }
            else if (k == 7 || k == 8) {
                if (k == 7) { TID_DECL; ml::mlstm_scan((const float*)(ws + WS_HF), (const float*)(ws + WS_MS + MS_NLOC), (const float*)(ws + WS_MS + MS_SCA), (ml::bf16*)(ws + WS_AUP), (float*)(ws + WS_MS + MS_NST), (float*)(ws + WS_MS + MS_BM), bid * NTHREADS + tid, nbl * NTHREADS); }
                att::bf16* QKV = (att::bf16*)(ws + WS_Y); const att::bf16* KR = (const att::bf16*)(ws + WS_BIG + BIG_KR);
                const float* tab = (const float*)(ws + WS_TAB);
                int u0, u1;
                if (k == 8) { u0 = bid; u1 = 256; } else { u0 = (l == 0 && bid >= 128) ? 256 + (bid - 128) : 272; u1 = 272; }
                for (int u = u0; u < u1; u += nbl) {
                    int b, h, seq, rope, qtok0; size_t rq;
                    if (u < 256) { b = u >> 6; h = (u >> 4) & 3; const int qb = u & 15; rq = (size_t)b * TB + CTXL + (size_t)qb * 256; seq = TB; rope = 1; qtok0 = qb * 256; }
                    else { b = (u - 256) >> 2; h = (u - 256) & 3; rq = (size_t)b * TB; seq = CTXL; rope = 0; qtok0 = 0; }
                    const size_t r0 = (size_t)b * TB;
                    const int panel = u < 256 ? (b * 16 + (u & 15)) : (64 + b);
                    att::attn_body(QKV + rq * NUP + h * 192, QKV + r0 * NUP + 768 + h * 256, QKV + r0 * NUP + 768 + h * 256 + 128, KR + r0 * 64, (att::bf16*)(ws + WS_H) + rq * DM + h * 128, seq, rope, qtok0, tab, (char*)lds_raw,
                                   (unsigned*)(ws + WS_MS + MS_X1) + rq * 4, (unsigned*)(ws + WS_CTL + 65536) + (size_t)(12 + l) * (68 * 64) + 64 * panel, A_.in(I_AON) + l * 512 + h * 128, h);
                }
                const int m0 = nbl - 1 - bid, m1 = (k == 8) ? 256 : ((l == 0) ? 16 : 0);
                for (int u = m0; u < m1; u += nbl) { const int bh = (k == 8) ? (u >> 4) : u, tbk = (k == 8) ? 1 + (u & 15) : 0;
                    ml::mlstm_out2((const ml::bf16*)(ws + WS_BIG), (const float*)(ws + WS_MS + MS_T), A_.in(I_CW) + (size_t)l * 3 * 1024, A_.in(I_CB) + (size_t)l * 1024, (const ml::bf16*)(ws + WS_AUP),
                                   (const float*)(ws + WS_MS + MS_NST), (const float*)(ws + WS_MS + MS_BM), A_.in(I_MN) + l * 512, (ml::bf16*)(ws + WS_H), bh >> 2, bh & 3, tbk, (char*)lds_raw); }
            }
        }
        if (ph + 1 < args.ph_hi) { if (first_sync) { grid.sync(); first_sync = false; } else xcd_barrier(barl); }
    }
}

#ifndef MK_ONE_LAUNCH
#define MK_ONE_LAUNCH 1
#endif
extern "C" void kernel_launch(void* const* d_in, const int* in_sizes, int n_in, void* d_out, int out_size, void* d_ws, size_t ws_size, hipStream_t stream) {
    static int grid = 0;
    if (grid == 0) {
        if (n_in != 22 || in_sizes[0] != NB * SEQ * DM || out_size != NB * SEQ * DM || ws_size < WS_END) { fprintf(stderr, "kernel_launch: shape/workspace mismatch (n_in %d, in0 %d, out %d, ws %zu need %zu)\n", n_in, n_in > 0 ? in_sizes[0] : -1, out_size, ws_size, (size_t)WS_END); grid = -1; return; }
        int dev = 0, cus = 0, per_cu = 0;
        if (hipGetDevice(&dev) != hipSuccess || hipDeviceGetAttribute(&cus, hipDeviceAttributeMultiprocessorCount, dev) != hipSuccess) { grid = -1; return; }
        if (hipFuncSetAttribute((const void*)mega_fwd, hipFuncAttributeMaxDynamicSharedMemorySize, LDS_BYTES) != hipSuccess) { fprintf(stderr, "kernel_launch: hipFuncSetAttribute failed\n"); grid = -1; return; }
        if (hipOccupancyMaxActiveBlocksPerMultiprocessor(&per_cu, (const void*)mega_fwd, NTHREADS, LDS_BYTES) != hipSuccess || per_cu < 1) { fprintf(stderr, "kernel_launch: occupancy query says %d\n", per_cu); per_cu = 1; }
        (void)hipGetLastError();
        grid = cus * (per_cu > 1 ? 1 : per_cu);
    }
    if (grid < 0) return;
    if (hipMemsetAsync((char*)d_ws + WS_CTL, 0, 65536 + 14 * 68 * 256, stream) != hipSuccess) { fprintf(stderr, "kernel_launch: memset of the barrier words failed\n"); return; }
    Args a{};
    for (int i = 0; i < 22; ++i) a.in[i] = (const float*)d_in[i];
    a.out = (float*)d_out; a.ws = (unsigned char*)d_ws;
#if MK_ONE_LAUNCH
    a.ph_lo = 0; a.ph_hi = N_PHASES;
    void* kargs[] = {&a};
    hipError_t e = hipLaunchCooperativeKernel((const void*)mega_fwd, dim3(grid), dim3(NTHREADS), kargs, LDS_BYTES, stream);
    if (e != hipSuccess) fprintf(stderr, "kernel_launch: cooperative launch failed: %s (grid %d)\n", hipGetErrorString(e), grid);
#else
    for (int ph = 0; ph < N_PHASES; ++ph) { if (ph == SKIP_PHASE) continue; a.ph_lo = ph; a.ph_hi = ph + 1;
        hipLaunchKernelGGL(mega_fwd, dim3(grid), dim3(NTHREADS), LDS_BYTES, stream, a);
        const hipError_t le = hipPeekAtLastError(); if (le != hipSuccess) { fprintf(stderr, "kernel_launch: launch of phase %d failed: %s\n", ph, hipGetErrorName(le)); break; } }
#endif
}
```

```cpp
#include <hip/hip_runtime.h>
#include <hip/hip_cooperative_groups.h>
#include <cstdio>
#include <cstdint>
namespace cg = cooperative_groups;
namespace pg8 {
#define PG8_LAS __attribute__((address_space(3)))
typedef unsigned short bf16_t;
typedef short bf16x8 __attribute__((ext_vector_type(8)));
typedef float f32x4 __attribute__((ext_vector_type(4)));
typedef unsigned u32x4 __attribute__((ext_vector_type(4)));
constexpr int BM = 256, BK = 64, HALF = 128, HTB = HALF * BK * 2  , STAGE_BYTES = 8 * HTB, NXCD = 8, WGM = 8;

__host__ __device__ __forceinline__ int lds_byte(int r, int c) { const int st = (r >> 4) * 2 + (c >> 5), rr = r & 15, cc = c & 31, ob = rr * 64 + cc * 2; return st * 1024 + (ob ^ (((ob >> 9) & 1) << 5)); }
__host__ __device__ __forceinline__ void stage_rc(int b, int& R, int& C) { const int st = b / 1024, sb = b % 1024, swz = sb ^ (((sb >> 9) & 1) << 5); R = (st >> 1) * 16 + swz / 64; C = (st & 1) * 32 + (swz % 64) / 2; }
__host__ __device__ __forceinline__ int perm32(int rho) { const int n = rho >> 4, i = rho & 15; return 8 * (i >> 2) + 4 * n + (i & 3); }

struct Unit { int pm, pn, kt0, nkt; };
struct Gemm { const bf16_t* A; const bf16_t* Bt; int M, N, K; };

struct StaticOrder {
    int nM, nN, nwg, G, c, nkt;
    __host__ __device__ void init(int M, int N, int K, int G_, int c_) { nM = M / BM; nN = N / BM; nwg = nM * nN; G = G_; c = c_; nkt = K / BK; }
    __host__ __device__ bool next(int i, Unit& u) const {
        const long L = (long)i * G + c; if (L >= nwg) return false;
        int wgid = (int)L; { const int q = nwg / NXCD, r = nwg % NXCD, xcd = wgid % NXCD, off = wgid / NXCD; wgid = (xcd < r ? xcd * (q + 1) : r * (q + 1) + (xcd - r) * q) + off; }
        const int nig = WGM * nN, gid = wgid / nig, fm = gid * WGM, gsz = (nM - fm) < WGM ? (nM - fm) : WGM;
        u.pm = fm + ((wgid % nig) % gsz); u.pn = (wgid % nig) / gsz; u.kt0 = 0; u.nkt = nkt; return true;
    }
    __device__ __forceinline__ void a_ready(const Unit&) const {}
    __device__ __forceinline__ void done(const Unit&) const {}
};

__device__ __forceinline__ unsigned cvt_pk_bf16(float lo, float hi) { unsigned r; asm volatile("v_cvt_pk_bf16_f32 %0, %1, %2" : "=v"(r) : "v"(lo), "v"(hi)); return r; }
typedef float f32x2 __attribute__((ext_vector_type(2)));
__device__ __forceinline__ f32x2 gelu_pk(f32x2 v) {
    const f32x2 av = __builtin_elementwise_abs(v), d = av * 0.2316418882f + 1.0f;
    f32x2 t; t.x = __builtin_amdgcn_rcpf(d.x); t.y = __builtin_amdgcn_rcpf(d.y);
    f32x2 q = t * 0.5307027145f + (-0.7265760135f); q = q * t + 0.7107068705f; q = q * t + (-0.142248368f); q = q * t + 0.127414796f; q = q * t;
    const f32x2 s = (v * v) * (-0.72134752044f);
    f32x2 e; e.x = __builtin_amdgcn_exp2f(s.x); e.y = __builtin_amdgcn_exp2f(s.y);
    const f32x2 m = v * (q * e), r = v - m;
    f32x2 o; o.x = v.x < 0.f ? m.x : r.x; o.y = v.y < 0.f ? m.y : r.y; return o;
}
__device__ __forceinline__ float silu_f(float x) { return x * __builtin_amdgcn_rcpf(1.0f + __builtin_amdgcn_exp2f(-1.4426950408889634f * x)); }
__device__ __forceinline__ void st8(bf16_t* p, f32x4 v0, f32x4 v1) { u32x4 w; w.x = cvt_pk_bf16(v0[0], v0[1]); w.y = cvt_pk_bf16(v0[2], v0[3]); w.z = cvt_pk_bf16(v1[0], v1[1]); w.w = cvt_pk_bf16(v1[2], v1[3]); *(u32x4*)p = w; }
struct EpiStore {
    static constexpr bool PERM = true, AFTER_DRAIN = false;
    bf16_t* O; int ldc;
    __device__ __forceinline__ void operator()(const f32x4 (&acc)[2][2][4][2], const Unit& u, int wr, int wc, int fr, int fq) const {
        const int row0 = u.pm * BM + wr * 64 + fr, col0 = u.pn * BM + wc * 32 + 8 * fq;
#pragma unroll
        for (int ai = 0; ai < 2; ++ai)
#pragma unroll
            for (int m = 0; m < 4; ++m) { bf16_t* rowp = O + (size_t)(row0 + ai * HALF + m * 16) * ldc + col0;
#pragma unroll
                for (int bj = 0; bj < 2; ++bj) st8(rowp + bj * HALF, acc[ai][bj][m][0], acc[ai][bj][m][1]); }
    }
};
struct EpiSwiGLU {
    static constexpr bool PERM = true, AFTER_DRAIN = false;
    bf16_t* O; int ldc;
    __device__ __forceinline__ void operator()(const f32x4 (&acc)[2][2][4][2], const Unit& u, int wr, int wc, int fr, int fq) const {
        const int row0 = u.pm * BM + wr * 64 + fr, col0 = u.pn * HALF + wc * 32 + 8 * fq;
#pragma unroll
        for (int ai = 0; ai < 2; ++ai)
#pragma unroll
            for (int m = 0; m < 4; ++m) { bf16_t* rowp = O + (size_t)(row0 + ai * HALF + m * 16) * ldc + col0;
                f32x4 v0, v1;
#pragma unroll
                for (int j = 0; j < 4; ++j) { v0[j] = silu_f(acc[ai][0][m][0][j]) * acc[ai][1][m][0][j]; v1[j] = silu_f(acc[ai][0][m][1][j]) * acc[ai][1][m][1][j]; }
                st8(rowp, v0, v1); }
    }
};
struct EpiP {
    static constexpr bool PERM = true, AFTER_DRAIN = false;
    bf16_t* O; int ldc; float* G;
    __device__ __forceinline__ void operator()(const f32x4 (&acc)[2][2][4][2], const Unit& u, int wr, int wc, int fr, int fq) const {
        const int row0 = u.pm * BM + wr * 64 + fr, col0 = u.pn * BM + wc * 32 + 8 * fq;
        const bool gt = (u.pn == 9) && (wc == 2) && (fq < 2);
#pragma unroll
        for (int ai = 0; ai < 2; ++ai)
#pragma unroll
            for (int m = 0; m < 4; ++m) { const int row = row0 + ai * HALF + m * 16; bf16_t* rowp = O + (size_t)row * ldc + col0;
#pragma unroll
                for (int bj = 0; bj < 2; ++bj) st8(rowp + bj * HALF, acc[ai][bj][m][0], acc[ai][bj][m][1]);
                if (gt) { *(f32x4*)(G + (size_t)row * 16 + 8 * fq) = acc[ai][1][m][0]; *(f32x4*)(G + (size_t)row * 16 + 8 * fq + 4) = acc[ai][1][m][1]; } }
    }
};
struct EpiSlab {
    static constexpr bool PERM = false, AFTER_DRAIN = false;
    float* S;
    __device__ __forceinline__ void operator()(const f32x4 (&acc)[2][2][4][2], const Unit& u, int wr, int wc, int fr, int fq) const {
        const int row0 = (u.pm / 17) * BM + wr * 64 + fr, col0 = u.pn * BM + wc * 32 + 4 * fq; const int slice = u.kt0 / u.nkt;
        float* base = S + (size_t)slice * 1024 * 1024;
#pragma unroll
        for (int ai = 0; ai < 2; ++ai)
#pragma unroll
            for (int m = 0; m < 4; ++m) { float* rowp = base + (size_t)(row0 + ai * HALF + m * 16) * 1024 + col0;
#pragma unroll
                for (int bj = 0; bj < 2; ++bj)
#pragma unroll
                    for (int n = 0; n < 2; ++n) *(f32x4*)(rowp + bj * HALF + n * 16) = acc[ai][bj][m][n]; }
    }
};
struct TileOrder {
    int mode, nM, nN, nwg, G, c, nkt, nsl;
    __device__ void init(int mode_, int N, int K, int G_, int c_, int nsl_) { mode = mode_; nN = N / BM; G = G_; c = c_; nsl = nsl_;
        if (mode == 2) { nM = 4; nwg = 4 * nN * nsl; nkt = (K / BK) / nsl; } else { nM = mode == 1 ? 64 : 68; nwg = nM * nN; nkt = K / BK; } }
    __device__ bool next(int i, Unit& u) const {
        const long L = (long)i * G + c; if (L >= nwg) return false;
        if (mode == 2) { const int sl = (int)L % nsl, t = (int)L / nsl; u.pn = t % nN; u.pm = 17 * (t / nN); u.kt0 = sl * nkt; u.nkt = nkt; return true; }
        int wgid = (int)L; { const int q = nwg / NXCD, r = nwg % NXCD, xcd = wgid % NXCD, off = wgid / NXCD; wgid = (xcd < r ? xcd * (q + 1) : r * (q + 1) + (xcd - r) * q) + off; }
        const int nig = WGM * nN, gid = wgid / nig, fm = gid * WGM, gsz = (nM - fm) < WGM ? (nM - fm) : WGM;
        int pm = fm + ((wgid % nig) % gsz); u.pn = (wgid % nig) / gsz; if (mode == 1) pm += (pm >> 4) + 1;
        u.pm = pm; u.kt0 = 0; u.nkt = nkt;
        if (mode == 3) { if (u.pn < 3) { u.kt0 = 0; u.nkt = 4; } else { u.kt0 = 4; u.nkt = 2; } }
        return true;
    }
    __device__ __forceinline__ void a_ready(const Unit&) const {}
    __device__ __forceinline__ void done(const Unit&) const {}
};

struct PanelSS {
    unsigned* xbuf;
    unsigned* cnt;
    __device__ __forceinline__ void run(const f32x4 (&v)[2][2][4][2], const Unit& u, int wr, int wc, int fr, int fq, PG8_LAS unsigned char* lds, int wid, int lane) const {
        PG8_LAS float* P = (PG8_LAS float*)lds;
        PG8_LAS float* S = (PG8_LAS float*)(lds + 8192);
#pragma unroll
        for (int ai = 0; ai < 2; ++ai)
#pragma unroll
            for (int m = 0; m < 4; ++m) { float s = 0.f;
#pragma unroll
                for (int bj = 0; bj < 2; ++bj)
#pragma unroll
                    for (int n = 0; n < 2; ++n) { const f32x4 x = v[ai][bj][m][n]; s += (x[0] * x[0] + x[1] * x[1]) + (x[2] * x[2] + x[3] * x[3]); }
                s += __shfl_xor(s, 16); s += __shfl_xor(s, 32);
                if (fq == 0) P[(ai * HALF + wr * 64 + m * 16 + fr) * 4 + wc] = s; }
        asm volatile("s_waitcnt lgkmcnt(0)" ::: "memory"); __builtin_amdgcn_s_barrier(); asm volatile("" ::: "memory");
        const int row = wid * 32 + (lane & 31);
        if (lane < 32) { const float t = (P[row * 4 + 0] + P[row * 4 + 1]) + (P[row * 4 + 2] + P[row * 4 + 3]);
            __hip_atomic_store(xbuf + (size_t)(u.pm * BM + row) * 4 + u.pn, __float_as_uint(t), __ATOMIC_RELAXED, __HIP_MEMORY_SCOPE_AGENT); }
        asm volatile("s_waitcnt vmcnt(0)" ::: "memory");
        if (lane == 0) __hip_atomic_fetch_add(cnt + 64 * u.pm, 1u, __ATOMIC_RELAXED, __HIP_MEMORY_SCOPE_AGENT);
        if (wid == 0) { unsigned sp = 0;
            while ((unsigned)__builtin_amdgcn_readfirstlane(__hip_atomic_load(cnt + 64 * u.pm, __ATOMIC_RELAXED, __HIP_MEMORY_SCOPE_AGENT)) < 32u) { __builtin_amdgcn_s_sleep(2); if (++sp > (1u << 22)) break; }
            __builtin_amdgcn_fence(__ATOMIC_ACQUIRE, "agent"); }
        asm volatile("s_waitcnt vmcnt(0) lgkmcnt(0)" ::: "memory"); __builtin_amdgcn_s_barrier(); asm volatile("" ::: "memory");
        if (lane < 32) { const unsigned* slot = xbuf + (size_t)(u.pm * BM + row) * 4; float t = 0.f;
#pragma unroll
            for (int q = 0; q < 4; ++q) t += __uint_as_float(__hip_atomic_load(slot + q, __ATOMIC_RELAXED, __HIP_MEMORY_SCOPE_AGENT));
            S[row] = t; }
        asm volatile("s_waitcnt lgkmcnt(0)" ::: "memory"); __builtin_amdgcn_s_barrier(); asm volatile("" ::: "memory");
    }
};
struct EpiNormRes {
    static constexpr bool PERM = false, AFTER_DRAIN = true;
    const float* xsrc; float* xdst;
    bf16_t* H;
    const float* gate; const float* gpost;
    const float* gpre; const float* sc; const float* sh;
    float wgt; PanelSS st1, st2;
    __device__ __forceinline__ void fused(f32x4 (&acc)[2][2][4][2], const Unit& u, int wr, int wc, int fr, int fq, PG8_LAS unsigned char* lds, int wid, int lane) const {
        const PG8_LAS float* S = (const PG8_LAS float*)(lds + 8192);
        const int b = u.pm / 17, tp = (u.pm - 17 * b - 1) * BM;
        const int col0 = u.pn * BM + wc * 32 + 4 * fq; const size_t mo = (size_t)b * 9 * 1024;
        st1.run(acc, u, wr, wc, fr, fq, lds, wid, lane);
        {   f32x4 cg[2][2];
#pragma unroll
            for (int bj = 0; bj < 2; ++bj)
#pragma unroll
                for (int n = 0; n < 2; ++n) cg[bj][n] = *(const f32x4*)(gate + mo + col0 + bj * HALF + n * 16) * *(const f32x4*)(gpost + col0 + bj * HALF + n * 16) * wgt;
#pragma unroll
            for (int ai = 0; ai < 2; ++ai)
#pragma unroll
                for (int m = 0; m < 4; ++m) { const int r = ai * HALF + wr * 64 + m * 16 + fr; const float rs = 1.0f / sqrtf(S[r] * (1.0f / 1024.0f) + 1e-6f);
                    const size_t off = ((size_t)b * 4096 + tp + r) * 1024 + col0;
#pragma unroll
                    for (int bj = 0; bj < 2; ++bj)
#pragma unroll
                        for (int n = 0; n < 2; ++n) { const f32x4 xo = *(const f32x4*)(xsrc + off + bj * HALF + n * 16); const f32x4 xn = xo + cg[bj][n] * (acc[ai][bj][m][n] * rs);
                            acc[ai][bj][m][n] = xn; *(f32x4*)(xdst + off + bj * HALF + n * 16) = xn; }
                    asm volatile("" : "+v"(acc[ai][0][m][0]), "+v"(acc[ai][0][m][1]), "+v"(acc[ai][1][m][0]), "+v"(acc[ai][1][m][1]));
                    if (m & 1) asm volatile("" ::: "memory"); } }
        if (H == nullptr) return;
        asm volatile("s_waitcnt lgkmcnt(0)" ::: "memory"); __builtin_amdgcn_s_barrier(); asm volatile("" ::: "memory");
        st2.run(acc, u, wr, wc, fr, fq, lds, wid, lane);
        {   typedef unsigned u32x2v __attribute__((ext_vector_type(2)));
            f32x4 ca[2][2], cs[2][2];
#pragma unroll
            for (int bj = 0; bj < 2; ++bj)
#pragma unroll
                for (int n = 0; n < 2; ++n) { const int c = col0 + bj * HALF + n * 16; ca[bj][n] = *(const f32x4*)(gpre + c) * (*(const f32x4*)(sc + mo + c) + 1.0f); cs[bj][n] = *(const f32x4*)(sh + mo + c); }
#pragma unroll
            for (int ai = 0; ai < 2; ++ai)
#pragma unroll
                for (int m = 0; m < 4; ++m) { const int r = ai * HALF + wr * 64 + m * 16 + fr; const float rs = 1.0f / sqrtf(S[r] * (1.0f / 1024.0f) + 1e-6f);
                    bf16_t* hp = H + (size_t)(u.pm * BM + r) * 1024 + col0;
#pragma unroll
                    for (int bj = 0; bj < 2; ++bj)
#pragma unroll
                        for (int n = 0; n < 2; ++n) { const f32x4 o = acc[ai][bj][m][n] * rs * ca[bj][n] + cs[bj][n]; u32x2v w; w.x = cvt_pk_bf16(o[0], o[1]); w.y = cvt_pk_bf16(o[2], o[3]);
                            *(u32x2v*)(hp + bj * HALF + n * 16) = w; } } }
    }
};

template <class Epi, class Sched, bool ALIGN_EPI = false, bool SP2 = false>
__device__ __forceinline__ void gemm_phase(PG8_LAS unsigned char* lds, const Gemm g, const Sched& S, const Epi& E) {
    int tid_ = threadIdx.x; asm volatile("" : "+v"(tid_));
    const int tid = tid_, wid = __builtin_amdgcn_readfirstlane(tid >> 6), lane = tid & 63, wr = wid >> 2, wc = wid & 3, fr = lane & 15, fq = lane >> 4;
    const int K = g.K;
    unsigned voffA[2], voffB[2];
#pragma unroll
    for (int i = 0; i < 2; ++i) { int R, C; stage_rc(tid * 16 + i * 8192, R, C); const int Rb = Epi::PERM ? ((R & ~31) + perm32(R & 31)) : R;
        voffA[i] = (unsigned)(R * K + C) * 2u; voffB[i] = (unsigned)(Rb * K + C) * 2u; }
    const size_t kstep = (size_t)(BK * 2);
    const size_t hstep = (size_t)HALF * K * 2;
    const size_t tstep = 2 * hstep;
    const unsigned ldsw = (unsigned)wid * 1024u;
    const int aoff = lds_byte(wr * 64 + fr, fq * 8), boff = lds_byte(wc * 32 + fr, fq * 8);
#define PG8_SA(b, h) (((b) * 2 + (h)) * HTB)
#define PG8_SB(b, h) ((4 + (b) * 2 + (h)) * HTB)
#define PG8_STAGE(bufoff, gbase, voff) do { _Pragma("unroll") for (int _i = 0; _i < 2; ++_i) \
        __builtin_amdgcn_global_load_lds((const unsigned*)((const char*)(gbase) + (voff)[_i]), (PG8_LAS unsigned*)(lds + (bufoff) + ldsw + _i * 8192), 16, 0, 0); } while (0)
#define PG8_LDA(dst, b, h) do { _Pragma("unroll") for (int m = 0; m < 4; ++m) _Pragma("unroll") for (int k = 0; k < 2; ++k) dst[m][k] = *(const PG8_LAS bf16x8*)(lds + PG8_SA(b, h) + aoff + m * 2048 + k * 1024); } while (0)
#define PG8_LDB(dst, b, h) do { _Pragma("unroll") for (int n = 0; n < 2; ++n) _Pragma("unroll") for (int k = 0; k < 2; ++k) dst[n][k] = *(const PG8_LAS bf16x8*)(lds + PG8_SB(b, h) + boff + n * 2048 + k * 1024); } while (0)
#define PG8_MMA(ai, bj, At, Bt) do { __builtin_amdgcn_s_setprio(1); _Pragma("unroll") for (int m = 0; m < 4; ++m) _Pragma("unroll") for (int n = 0; n < 2; ++n) _Pragma("unroll") for (int k = 0; k < 2; ++k) \
        acc[ai][bj][m][n] = __builtin_amdgcn_mfma_f32_16x16x32_bf16(Bt[n][k], At[m][k], acc[ai][bj][m][n], 0, 0, 0); __builtin_amdgcn_s_setprio(0); } while (0)
#define PG8_WAIT_V(n) asm volatile("s_waitcnt vmcnt(" #n ")" ::: "memory")
#define PG8_WAIT_L(n) asm volatile("s_waitcnt lgkmcnt(" #n ")" ::: "memory")
#define PG8_BAR __builtin_amdgcn_s_barrier()
#define PG8_SCHED __builtin_amdgcn_sched_barrier(0)
    Unit cur, nxt; int ui = 0;
    if (!S.next(0, cur)) return;
    f32x4 acc[2][2][4][2];
#pragma unroll
    for (int a = 0; a < 2; ++a)
#pragma unroll
        for (int b = 0; b < 2; ++b)
#pragma unroll
            for (int m = 0; m < 4; ++m)
#pragma unroll
                for (int n = 0; n < 2; ++n) acc[a][b][m][n] = (f32x4){0.f, 0.f, 0.f, 0.f};
    bf16x8 At[4][2], B0[2][2], B1[2][2];
    const char* cA = (const char*)g.A + (size_t)cur.pm * tstep + (size_t)cur.kt0 * kstep; const char* cB = (const char*)g.Bt + (size_t)cur.pn * tstep + (size_t)cur.kt0 * kstep;
    S.a_ready(cur);
    if constexpr (SP2) {
        PG8_STAGE(PG8_SB(0, 0), cB, voffB); PG8_STAGE(PG8_SB(0, 1), cB + hstep, voffB); PG8_STAGE(PG8_SA(0, 0), cA, voffA); PG8_STAGE(PG8_SA(0, 1), cA + hstep, voffA);
        if (wr == 1) PG8_BAR;
        PG8_WAIT_V(2); PG8_BAR;
        PG8_STAGE(PG8_SB(1, 0), cB + kstep, voffB); PG8_STAGE(PG8_SA(1, 0), cA + kstep, voffA); PG8_STAGE(PG8_SB(1, 1), cB + hstep + kstep, voffB);
        PG8_WAIT_V(6); PG8_BAR;
    } else {
        PG8_STAGE(PG8_SB(0, 0), cB, voffB); PG8_STAGE(PG8_SA(0, 0), cA, voffA); PG8_STAGE(PG8_SB(0, 1), cB + hstep, voffB); PG8_STAGE(PG8_SA(0, 1), cA + hstep, voffA);
        if (wr == 1) PG8_BAR;
        PG8_WAIT_V(4); PG8_BAR;
        PG8_STAGE(PG8_SB(1, 0), cB + kstep, voffB); PG8_STAGE(PG8_SA(1, 0), cA + kstep, voffA); PG8_STAGE(PG8_SB(1, 1), cB + hstep + kstep, voffB);
        PG8_WAIT_V(6); PG8_BAR;
    }
    for (;;) {
        const bool has_next = S.next(ui + 1, nxt);
        const char* nA = has_next ? (const char*)g.A + (size_t)nxt.pm * tstep + (size_t)nxt.kt0 * kstep : cA; const char* nB = has_next ? (const char*)g.Bt + (size_t)nxt.pn * tstep + (size_t)nxt.kt0 * kstep : cB;
        const int nt = cur.nkt;
        for (int t = 0; t < nt; t += 2) {
            const bool last = (t == nt - 2);
            const char* a1 = cA + (size_t)(t + 1) * kstep;
            const char* a2 = last ? nA : cA + (size_t)(t + 2) * kstep; const char* b2 = last ? nB : cB + (size_t)(t + 2) * kstep;
            const char* a3 = a2 + kstep; const char* b3 = b2 + kstep;
            if (last && has_next) S.a_ready(nxt);
            if constexpr (SP2) {
            PG8_LDB(B0, 0, 0); PG8_LDB(B1, 0, 1); PG8_SCHED; PG8_LDA(At, 0, 0); PG8_STAGE(PG8_SA(1, 1), a1 + hstep, voffA);
            PG8_WAIT_V(8); PG8_WAIT_L(0); PG8_BAR; PG8_MMA(0, 0, At, B0); PG8_MMA(0, 1, At, B1); PG8_BAR; PG8_SCHED;
            PG8_LDA(At, 0, 1); PG8_STAGE(PG8_SB(0, 0), b2, voffB); PG8_STAGE(PG8_SB(0, 1), b2 + hstep, voffB); PG8_STAGE(PG8_SA(0, 0), a2, voffA);
            PG8_WAIT_V(8); PG8_WAIT_L(0); PG8_BAR; PG8_MMA(1, 0, At, B0); PG8_MMA(1, 1, At, B1); PG8_BAR; PG8_SCHED;
            PG8_LDB(B0, 1, 0); PG8_LDB(B1, 1, 1); PG8_SCHED; PG8_LDA(At, 1, 0); PG8_STAGE(PG8_SA(0, 1), a2 + hstep, voffA);
            PG8_WAIT_V(8); PG8_WAIT_L(0); PG8_BAR; PG8_MMA(0, 0, At, B0); PG8_MMA(0, 1, At, B1); PG8_BAR; PG8_SCHED;
            PG8_LDA(At, 1, 1); PG8_STAGE(PG8_SB(1, 0), b3, voffB); PG8_STAGE(PG8_SB(1, 1), b3 + hstep, voffB); PG8_STAGE(PG8_SA(1, 0), a3, voffA);
            PG8_WAIT_V(8); PG8_WAIT_L(0); PG8_BAR; PG8_MMA(1, 0, At, B0); PG8_MMA(1, 1, At, B1); PG8_BAR; PG8_SCHED;
            } else {
            PG8_LDB(B0, 0, 0); PG8_SCHED; PG8_LDA(At, 0, 0); PG8_STAGE(PG8_SA(1, 1), a1 + hstep, voffA);
            PG8_WAIT_L(8); PG8_BAR; PG8_WAIT_L(0); PG8_MMA(0, 0, At, B0); PG8_BAR; PG8_SCHED;
            PG8_LDB(B1, 0, 1); PG8_STAGE(PG8_SB(0, 0), b2, voffB);
            PG8_BAR; PG8_WAIT_L(0); PG8_MMA(0, 1, At, B1); PG8_BAR;
            PG8_LDA(At, 0, 1); PG8_STAGE(PG8_SA(0, 0), a2, voffA);
            PG8_BAR; PG8_WAIT_L(0); PG8_MMA(1, 0, At, B0); PG8_BAR; PG8_SCHED;
            PG8_STAGE(PG8_SB(0, 1), b2 + hstep, voffB);
            PG8_WAIT_V(6); PG8_BAR; PG8_MMA(1, 1, At, B1); PG8_BAR;
            PG8_LDB(B0, 1, 0); PG8_SCHED; PG8_LDA(At, 1, 0); PG8_STAGE(PG8_SA(0, 1), a2 + hstep, voffA);
            PG8_WAIT_L(8); PG8_BAR; PG8_WAIT_L(0); PG8_MMA(0, 0, At, B0); PG8_BAR; PG8_SCHED;
            PG8_LDB(B1, 1, 1); PG8_STAGE(PG8_SB(1, 0), b3, voffB);
            PG8_BAR; PG8_WAIT_L(0); PG8_MMA(0, 1, At, B1); PG8_BAR;
            PG8_LDA(At, 1, 1); PG8_STAGE(PG8_SA(1, 0), a3, voffA);
            PG8_BAR; PG8_WAIT_L(0); PG8_MMA(1, 0, At, B0); PG8_BAR; PG8_SCHED;
            PG8_STAGE(PG8_SB(1, 1), b3 + hstep, voffB);
            PG8_WAIT_V(6); PG8_BAR; PG8_MMA(1, 1, At, B1); PG8_BAR;
            }
        }
        if constexpr (ALIGN_EPI) { if (wr == 0) PG8_BAR; }
        if constexpr (!Epi::AFTER_DRAIN) { E(acc, cur, wr, wc, fr, fq); S.done(cur); }
        if (!has_next) break;
#pragma unroll
        for (int a = 0; a < 2; ++a)
#pragma unroll
            for (int b = 0; b < 2; ++b)
#pragma unroll
                for (int m = 0; m < 4; ++m)
#pragma unroll
                    for (int n = 0; n < 2; ++n) acc[a][b][m][n] = (f32x4){0.f, 0.f, 0.f, 0.f};
        cur = nxt; cA = nA; cB = nB; ++ui;
        if constexpr (ALIGN_EPI) { if (wr == 1) PG8_BAR; }
    }
    PG8_WAIT_V(0);
    if constexpr (!ALIGN_EPI) { if (wr == 0) PG8_BAR; }
    PG8_BAR;
    if constexpr (Epi::AFTER_DRAIN) { E.fused(acc, cur, wr, wc, fr, fq, lds, wid, lane); S.done(cur); }
#undef PG8_SA
#undef PG8_SB
#undef PG8_STAGE
#undef PG8_LDA
#undef PG8_LDB
#undef PG8_MMA
#undef PG8_WAIT_V
#undef PG8_WAIT_L
#undef PG8_BAR
#undef PG8_SCHED
}
}
namespace att {
typedef unsigned short bf16;
constexpr int NW = 8, QBLK = 32, KVBLK = 64;
constexpr float SCALE = 0.07216878364870322f;
constexpr float THR = 8.f;
constexpr int SDEPTH = 1;
constexpr int LDQ = 1792, LDK = 1792, LDR = 64, LDO = 1024;
constexpr int SHM_V = KVBLK * 128 * 2, SHM_K = KVBLK * 192 * 2, SHM_QR = NW * 4 * 64 * 16, SHM_ATTN = 2 * SHM_V + 2 * SHM_K + NW * 64 * 4 + SHM_QR;
using bf16x8 = __attribute__((ext_vector_type(8))) short;
using s16x4  = __attribute__((ext_vector_type(4))) short;
using f32x16 = __attribute__((ext_vector_type(16))) float;
using u32x4  = __attribute__((ext_vector_type(4))) unsigned;
#define KSWZ(row, colB) ((row) * 384 + ((colB) ^ ((((row) >> 1) & 7) << 4)))
#define SBAR() __builtin_amdgcn_sched_barrier(0)
__device__ __forceinline__ int crow(int r, int hi) { return (r & 3) + 8 * (r >> 2) + 4 * hi; }
__device__ __forceinline__ unsigned cvtpk(float lo, float hi) { unsigned r; asm volatile("v_cvt_pk_bf16_f32 %0, %1, %2" : "=v"(r) : "v"(lo), "v"(hi)); return r; }
__device__ __forceinline__ bf16x8 ld8(const bf16* p) { return *reinterpret_cast<const bf16x8*>(p); }
__device__ __forceinline__ float bf2f(short b) { return __uint_as_float(((unsigned)(unsigned short)b) << 16); }

__device__ __forceinline__ void partialSM(f32x16& p0, f32x16& p1, float& m_reg, float& mn, float& alpha) {
  constexpr float C = SCALE * 1.4426950408889634f;
  float pmax = p0[0];
#pragma unroll
  for (int r = 1; r < 16; ++r) pmax = fmaxf(pmax, p0[r]);
#pragma unroll
  for (int r = 0; r < 16; ++r) pmax = fmaxf(pmax, p1[r]);
  { auto rr = __builtin_amdgcn_permlane32_swap(__float_as_uint(pmax), __float_as_uint(pmax), false, false);
    pmax = fmaxf(__uint_as_float(rr[0]), __uint_as_float(rr[1])); }
  if (__builtin_expect(__all(pmax - m_reg <= THR / SCALE), 1)) { mn = m_reg; alpha = 1.f; }
  else { mn = fmaxf(m_reg, pmax); alpha = __builtin_amdgcn_exp2f((m_reg - mn) * C); m_reg = mn; }
  float mnC = -mn * C;
#pragma unroll
  for (int r = 0; r < 16; ++r) p0[r] = fmaf(p0[r], C, mnC);
#pragma unroll
  for (int r = 0; r < 16; ++r) p1[r] = fmaf(p1[r], C, mnC);
#pragma unroll
  for (int r = 0; r < 16; ++r) p0[r] = __builtin_amdgcn_exp2f(p0[r]);
}
__device__ __forceinline__ void finishSM(f32x16& p0, f32x16& p1, float alpha, float& l_reg, bf16x8& pa0, bf16x8& pa1, bf16x8& pa2, bf16x8& pa3) {
#pragma unroll
  for (int r = 0; r < 16; ++r) p1[r] = __builtin_amdgcn_exp2f(p1[r]);
  float ps = 0;
#pragma unroll
  for (int r = 0; r < 16; ++r) ps += p0[r];
#pragma unroll
  for (int r = 0; r < 16; ++r) ps += p1[r];
  { auto rr = __builtin_amdgcn_permlane32_swap(__float_as_uint(ps), __float_as_uint(ps), false, false);
    ps = __uint_as_float(rr[0]) + __uint_as_float(rr[1]); }
  l_reg = l_reg * alpha + ps;
#define PK4(P, BASE, OUT) do { unsigned a0 = cvtpk(P[BASE + 0], P[BASE + 1]), a1 = cvtpk(P[BASE + 2], P[BASE + 3]);   \
    unsigned b0 = cvtpk(P[BASE + 4], P[BASE + 5]), b1 = cvtpk(P[BASE + 6], P[BASE + 7]);                              \
    auto r0 = __builtin_amdgcn_permlane32_swap(a0, b0, false, false); auto r1 = __builtin_amdgcn_permlane32_swap(a1, b1, false, false); \
    u32x4 w = {r0[0], r1[0], r0[1], r1[1]}; OUT = *reinterpret_cast<bf16x8*>(&w); } while (0)
  PK4(p0, 0, pa0); PK4(p0, 8, pa1); PK4(p1, 0, pa2); PK4(p1, 8, pa3);
#undef PK4
}
__device__ __forceinline__ void qkt(f32x16& p0, f32x16& p1, const bf16* Ks, const bf16x8 (&qr)[8], const bf16x8* qrl, int r32, int hi) {
  p0 = f32x16{}; p1 = f32x16{};
#pragma unroll
  for (int d0 = 0; d0 < 12; ++d0) { int cb = (d0 * 16 + hi * 8) * 2;
    bf16x8 b0 = *reinterpret_cast<const bf16x8*>((const char*)Ks + KSWZ(r32, cb));
    bf16x8 b1 = *reinterpret_cast<const bf16x8*>((const char*)Ks + KSWZ(32 + r32, cb));
    const bf16x8 qf = d0 < 8 ? qr[d0 < 8 ? d0 : 0] : qrl[(d0 - 8) * 64];
    p0 = __builtin_amdgcn_mfma_f32_32x32x16_bf16(b0, qf, p0, 0, 0, 0);
    p1 = __builtin_amdgcn_mfma_f32_32x32x16_bf16(b1, qf, p1, 0, 0, 0); }
}
__device__ __forceinline__ int v_st(int k, int c) { const int kk = (k & ~0xC) | ((k & 4) << 1) | ((k & 8) >> 1); return ((kk >> 3) * 4 + (c >> 5)) * 512 + ((kk & 7) * 32 + (c & 31)) * 2; }
__device__ __forceinline__ int v_rd_base(int lane) { return ((lane & 3) << 3) | (((lane >> 2) & 3) << 6) | (((lane >> 4) & 1) << 5) | (((lane >> 5) & 1) << 8); }
constexpr int v_rd_off(int d0, int ks, int half) { return d0 * 512 + ks * 4096 + half * 2048; }
template <int OFF> __device__ __forceinline__ s16x4 tr_read(int vb) {
  s16x4 r; asm volatile("ds_read_b64_tr_b16 %0, %1 offset:%2" : "=&v"(r) : "v"(vb), "i"(OFF) : "memory"); return r;
}
template <int D0> __device__ __forceinline__ void pv_one(f32x16& od, int vb, bf16x8 pa0, bf16x8 pa1, bf16x8 pa2, bf16x8 pa3) {
  const s16x4 l0 = tr_read<v_rd_off(D0, 0, 0)>(vb), h0 = tr_read<v_rd_off(D0, 0, 1)>(vb), l1 = tr_read<v_rd_off(D0, 1, 0)>(vb), h1 = tr_read<v_rd_off(D0, 1, 1)>(vb);
  const s16x4 l2 = tr_read<v_rd_off(D0, 2, 0)>(vb), h2 = tr_read<v_rd_off(D0, 2, 1)>(vb), l3 = tr_read<v_rd_off(D0, 3, 0)>(vb), h3 = tr_read<v_rd_off(D0, 3, 1)>(vb);
  asm volatile("s_waitcnt lgkmcnt(0)" ::: "memory"); SBAR();
#define PK(L, H) (bf16x8){L[0], L[1], L[2], L[3], H[0], H[1], H[2], H[3]}
  od = __builtin_amdgcn_mfma_f32_32x32x16_bf16(pa0, PK(l0, h0), od, 0, 0, 0);
  od = __builtin_amdgcn_mfma_f32_32x32x16_bf16(pa1, PK(l1, h1), od, 0, 0, 0);
  od = __builtin_amdgcn_mfma_f32_32x32x16_bf16(pa2, PK(l2, h2), od, 0, 0, 0);
  od = __builtin_amdgcn_mfma_f32_32x32x16_bf16(pa3, PK(l3, h3), od, 0, 0, 0);
#undef PK
}
__device__ __forceinline__ void pv_d0(f32x16 (&o)[4], int vb, bf16x8 pa0, bf16x8 pa1, bf16x8 pa2, bf16x8 pa3) {
  pv_one<0>(o[0], vb, pa0, pa1, pa2, pa3); pv_one<1>(o[1], vb, pa0, pa1, pa2, pa3); pv_one<2>(o[2], vb, pa0, pa1, pa2, pa3); pv_one<3>(o[3], vb, pa0, pa1, pa2, pa3);
}
__device__ __forceinline__ void attn_body(const bf16* __restrict__ Qb, const bf16* __restrict__ Kn, const bf16* __restrict__ Vh, const bf16* __restrict__ Kr,
                                          bf16* __restrict__ Ob, int seq, int rope, int qtok0, const float* __restrict__ tab, char* lds,
                                          unsigned* __restrict__ xs, unsigned* __restrict__ cnt, const float* __restrict__ gain, int head) {
  int tid_ = threadIdx.x; asm volatile("" : "+v"(tid_));
  const int tid = tid_, wid = tid >> 6, lane = tid & 63, r32 = lane & 31, hi = lane >> 5;
  bf16* V_lds = (bf16*)lds; bf16* K_lds = (bf16*)(lds + 2 * SHM_V);
  float* ws = (float*)(lds + 2 * SHM_V + 2 * SHM_K) + wid * 64; float* li_l = ws; float* al_l = ws + 32;
  float m_reg = -1e30f, l_reg = 0; f32x16 o[4] = {}; bf16x8 qr[8]; bf16x8 qx[4];
  bf16x8* qrl = (bf16x8*)(lds + 2 * SHM_V + 2 * SHM_K + NW * 64 * 4) + wid * 256 + lane;
  const bf16* Qw = Qb + (long)(wid * QBLK + r32) * LDQ + hi * 8;
#pragma unroll
  for (int d0 = 0; d0 < 8; ++d0) qr[d0] = ld8(Qw + d0 * 16);
#pragma unroll
  for (int d0 = 0; d0 < 4; ++d0) qx[d0] = ld8(Qw + 128 + d0 * 16);
  if (rope) {
    const int tt = qtok0 + wid * QBLK + r32; const int prow = tt >> 6, pcol = tt & 63;
    const float* tr = tab + (prow * 16 + hi * 8) * 2; const float* tc = tab + (pcol * 16 + hi * 8) * 2;
    unsigned a1[4], a2[4], c1[4], c2[4];
#pragma unroll
    for (int j = 0; j < 8; j += 2) {
      float o1[2], o2[2], p1[2], p2[2];
#pragma unroll
      for (int e = 0; e < 2; ++e) {
        const float cr = tr[(j + e) * 2], sr_ = tr[(j + e) * 2 + 1], cc = tc[(j + e) * 2], sc_ = tc[(j + e) * 2 + 1];
        const float x1 = bf2f(qx[0][j + e]), x2 = bf2f(qx[1][j + e]), y1 = bf2f(qx[2][j + e]), y2 = bf2f(qx[3][j + e]);
        o1[e] = x1 * cr - x2 * sr_; o2[e] = x2 * cr + x1 * sr_; p1[e] = y1 * cc - y2 * sc_; p2[e] = y2 * cc + y1 * sc_; }
      a1[j >> 1] = cvtpk(o1[0], o1[1]); a2[j >> 1] = cvtpk(o2[0], o2[1]); c1[j >> 1] = cvtpk(p1[0], p1[1]); c2[j >> 1] = cvtpk(p2[0], p2[1]); }
    { u32x4 w = {a1[0], a1[1], a1[2], a1[3]}; qx[0] = *reinterpret_cast<bf16x8*>(&w); }
    { u32x4 w = {a2[0], a2[1], a2[2], a2[3]}; qx[1] = *reinterpret_cast<bf16x8*>(&w); }
    { u32x4 w = {c1[0], c1[1], c1[2], c1[3]}; qx[2] = *reinterpret_cast<bf16x8*>(&w); }
    { u32x4 w = {c2[0], c2[1], c2[2], c2[3]}; qx[3] = *reinterpret_cast<bf16x8*>(&w); }
  }
#pragma unroll
  for (int d0 = 0; d0 < 4; ++d0) qrl[d0 * 64] = qx[d0];
  const int sr = tid >> 4, sc = (tid & 15) * 8, vst0 = v_st(sr, sc), vst1 = v_st(32 + sr, sc);
  const int rr = tid >> 3, rc = (tid & 7) * 8;
  const int vb0 = (int)(uintptr_t)V_lds + v_rd_base(lane);
  struct { bf16x8 vs0, vs1, ks0, ks1, kr0; } sr_[SDEPTH];
#define SLOAD(i, k0) do { sr_[i].vs0 = ld8(&Vh[(long)((k0) + sr) * LDK + sc]); sr_[i].vs1 = ld8(&Vh[(long)((k0) + 32 + sr) * LDK + sc]); \
    sr_[i].ks0 = ld8(&Kn[(long)((k0) + sr) * LDK + sc]); sr_[i].ks1 = ld8(&Kn[(long)((k0) + 32 + sr) * LDK + sc]); sr_[i].kr0 = ld8(&Kr[(long)((k0) + rr) * LDR + rc]); } while (0)
#define SWRITE(b, i) do { *(bf16x8*)((char*)V_lds + (b) * SHM_V + vst0) = sr_[i].vs0;          \
    *(bf16x8*)((char*)V_lds + (b) * SHM_V + vst1) = sr_[i].vs1; int kc = sc * 2;               \
    *(bf16x8*)((char*)K_lds + (b) * SHM_K + KSWZ(sr, kc)) = sr_[i].ks0;                       \
    *(bf16x8*)((char*)K_lds + (b) * SHM_K + KSWZ(32 + sr, kc)) = sr_[i].ks1;                  \
    *(bf16x8*)((char*)K_lds + (b) * SHM_K + KSWZ(rr, 256 + rc * 2)) = sr_[i].kr0; } while (0)
#define SWAIT() do { if constexpr (SDEPTH == 2) asm volatile("s_waitcnt vmcnt(5)" ::: "memory"); else asm volatile("s_waitcnt vmcnt(0)" ::: "memory"); } while (0)
#define RESC(a) do { if (__any((a) < 1.f)) { if (hi == 0) al_l[r32] = (a); asm volatile("s_waitcnt lgkmcnt(0)" ::: "memory"); \
    _Pragma("unroll") for (int d = 0; d < 4; ++d) _Pragma("unroll") for (int r = 0; r < 16; ++r) o[d][r] *= al_l[crow(r, hi)]; } } while (0)
  f32x16 pA0, pA1, pB0, pB1; float mnA, mnB, alA, alB; bf16x8 pa0, pa1, pa2, pa3; const int NT = seq / KVBLK;
  constexpr int SE = 0, SO = SDEPTH - 1;
  SLOAD(SE, 0); asm volatile("s_waitcnt vmcnt(0)" ::: "memory"); SWRITE(0, SE); __syncthreads();
  qkt(pA0, pA1, K_lds, qr, qrl, r32, hi); partialSM(pA0, pA1, m_reg, mnA, alA);
  SLOAD(SO, KVBLK); if constexpr (SDEPTH == 2) { if (2 < NT) SLOAD(SE, 2 * KVBLK); }
  SWAIT(); SWRITE(1, SO); __syncthreads();
  for (int j = 1; j + 1 < NT; j += 2) {
    SBAR(); qkt(pB0, pB1, (bf16*)((char*)K_lds + SHM_K), qr, qrl, r32, hi);
    finishSM(pA0, pA1, alA, l_reg, pa0, pa1, pa2, pa3); SBAR();
    SLOAD(SO, (j + SDEPTH) * KVBLK); SBAR();
    pv_d0(o, vb0, pa0, pa1, pa2, pa3); partialSM(pB0, pB1, m_reg, mnB, alB);
    __syncthreads(); SWAIT(); SWRITE(0, SE);
    RESC(alB); __syncthreads();
    SBAR(); qkt(pA0, pA1, K_lds, qr, qrl, r32, hi);
    finishSM(pB0, pB1, alB, l_reg, pa0, pa1, pa2, pa3); SBAR();
    if (SDEPTH == 1 || j + 3 < NT) SLOAD(SE, (j + 1 + SDEPTH) * KVBLK); SBAR();
    pv_d0(o, vb0 + (int)SHM_V, pa0, pa1, pa2, pa3); partialSM(pA0, pA1, m_reg, mnA, alA);
    __syncthreads(); SWAIT(); SWRITE(1, SO);
    RESC(alA); __syncthreads();
  }
  SBAR(); qkt(pB0, pB1, (bf16*)((char*)K_lds + SHM_K), qr, qrl, r32, hi);
  finishSM(pA0, pA1, alA, l_reg, pa0, pa1, pa2, pa3); SBAR();
  pv_d0(o, vb0, pa0, pa1, pa2, pa3); partialSM(pB0, pB1, m_reg, mnB, alB);
  __syncthreads(); RESC(alB);
  finishSM(pB0, pB1, alB, l_reg, pa0, pa1, pa2, pa3); SBAR();
  pv_d0(o, vb0 + (int)SHM_V, pa0, pa1, pa2, pa3);
  if (hi == 0) li_l[r32] = l_reg; asm volatile("s_waitcnt lgkmcnt(0)" ::: "memory");
  float rli[16];
#pragma unroll
  for (int r = 0; r < 16; ++r) rli[r] = __builtin_amdgcn_rcpf(li_l[crow(r, hi)]);
  float rs[16];
#pragma unroll
  for (int r = 0; r < 16; ++r) { float s = 0.f;
#pragma unroll
    for (int d0 = 0; d0 < 4; ++d0) { o[d0][r] *= rli[r]; s += o[d0][r] * o[d0][r]; }
    rs[r] = s; }
#pragma unroll
  for (int x = 1; x < 32; x <<= 1)
#pragma unroll
    for (int r = 0; r < 16; ++r) rs[r] += __shfl_xor(rs[r], x);
  asm volatile("s_waitcnt lgkmcnt(0)" ::: "memory");
  if (r32 == 0) {
#pragma unroll
    for (int r = 0; r < 16; ++r) al_l[crow(r, hi)] = rs[r]; }
  asm volatile("s_waitcnt lgkmcnt(0)" ::: "memory");
  if (lane < 32) __hip_atomic_store(xs + (size_t)(wid * QBLK + lane) * 4 + head, __float_as_uint(al_l[lane]), __ATOMIC_RELAXED, __HIP_MEMORY_SCOPE_AGENT);
  asm volatile("s_waitcnt vmcnt(0)" ::: "memory");
  if (lane == 0) __hip_atomic_fetch_add(cnt, 1u, __ATOMIC_RELAXED, __HIP_MEMORY_SCOPE_AGENT);
  if (wid == 0) { unsigned sp = 0;
    while ((unsigned)__builtin_amdgcn_readfirstlane(__hip_atomic_load(cnt, __ATOMIC_RELAXED, __HIP_MEMORY_SCOPE_AGENT)) < 32u) { __builtin_amdgcn_s_sleep(2); if (++sp > (1u << 22)) break; }
    __builtin_amdgcn_fence(__ATOMIC_ACQUIRE, "agent"); }
  asm volatile("s_waitcnt vmcnt(0) lgkmcnt(0)" ::: "memory"); __syncthreads();
  if (lane < 32) { const unsigned* sl = xs + (size_t)(wid * QBLK + lane) * 4; float t = 0.f;
#pragma unroll
    for (int q = 0; q < 4; ++q) t += __uint_as_float(__hip_atomic_load(sl + q, __ATOMIC_RELAXED, __HIP_MEMORY_SCOPE_AGENT));
    li_l[lane] = 1.0f / sqrtf(t * (1.0f / 512.0f) + 1e-6f); }
  asm volatile("s_waitcnt lgkmcnt(0)" ::: "memory");
  float g4[4];
#pragma unroll
  for (int d0 = 0; d0 < 4; ++d0) g4[d0] = gain[d0 * 32 + r32];
  char* Ol = lds + wid * 8704;
#pragma unroll
  for (int r = 0; r < 16; ++r) { const int orow = crow(r, hi); const float rn = li_l[orow];
#pragma unroll
    for (int d0 = 0; d0 < 4; ++d0) { const float v = o[d0][r] * rn * g4[d0]; *(bf16*)(Ol + orow * 272 + (d0 * 32 + r32) * 2) = (bf16)(cvtpk(v, v) & 0xffffu); } }
  asm volatile("s_waitcnt lgkmcnt(0)" ::: "memory");
  bf16* Ow = Ob + (long)(wid * QBLK) * LDO;
#pragma unroll
  for (int i = 0; i < 8; i += 2) { const int row = (lane >> 4) + 4 * i, c16 = lane & 15;
    const u32x4 w0 = *reinterpret_cast<const u32x4*>(Ol + row * 272 + c16 * 16), w1 = *reinterpret_cast<const u32x4*>(Ol + (row + 4) * 272 + c16 * 16);
    *reinterpret_cast<u32x4*>(Ow + (long)row * LDO + c16 * 8) = w0; *reinterpret_cast<u32x4*>(Ow + (long)(row + 4) * LDO + c16 * 8) = w1;
    asm volatile("" ::: "memory"); }
  __syncthreads();
#undef SLOAD
#undef SWRITE
#undef SWAIT
#undef RESC
}
#undef KSWZ
#undef SBAR
}

namespace ml {
using att::bf16; using att::bf16x8; using att::s16x4; using att::f32x16; using att::u32x4;
typedef float f32x4 __attribute__((ext_vector_type(4)));
using att::crow;
__device__ __forceinline__ unsigned cvtpk(float lo, float hi) { unsigned r; asm("v_cvt_pk_bf16_f32 %0, %1, %2" : "=v"(r) : "v"(lo), "v"(hi)); return r; }
 using att::ld8; using att::bf2f; using att::v_st; using att::v_rd_base; using att::v_rd_off;
constexpr int TBr = 4352, CTXr = 256, SEQr = 4096;
constexpr float LOG2E = 1.4426950408889634f;
constexpr int TSTRIDE = 32 * 17 * 256;
#define MLAS __attribute__((address_space(3)))
__device__ __forceinline__ float log_sigmoid_f(float x) {
    const float t = __expf(-fabsf(x));
    const float l1p = t < 0.03f ? t * (1.0f - t * (0.5f - t * (0.33333334f - 0.25f * t))) : __logf(1.0f + t);
    return fminf(x, 0.f) - l1p;
}
template <int OFF> __device__ __forceinline__ s16x4 trr(int vb) { s16x4 r; asm volatile("ds_read_b64_tr_b16 %0, %1 offset:%2" : "=&v"(r) : "v"(vb), "i"(OFF) : "memory"); return r; }
#define MLPK(L, H) (bf16x8){L[0], L[1], L[2], L[3], H[0], H[1], H[2], H[3]}
__device__ __forceinline__ void unit_rows(int b, int dir, int j, int& rb, int& sg) {
    if (dir == 0) { rb = b * TBr + 256 * j; sg = 1; }
    else { rb = (j == 0) ? b * TBr + 255 : b * TBr + TBr - 1 - 256 * (j - 1); sg = -1; }
}
struct Conv8 { float w0[8], w1[8], w2[8], bb[8]; };
__device__ __forceinline__ void conv8_load(Conv8& cp, const float* __restrict__ cw, const float* __restrict__ cb, int c) {
#pragma unroll
    for (int j = 0; j < 8; ++j) { cp.w0[j] = cw[c + j]; cp.w1[j] = cw[1024 + c + j]; cp.w2[j] = cw[2048 + c + j]; cp.bb[j] = cb[c + j]; }
}
__device__ __forceinline__ void conv8x8(const bf16* __restrict__ P, int r0, int sg, int sr, int c, const Conv8& cp, float scale, bf16x8 (&out)[8]) {
    bf16x8 x0[8], xm[8], xp[8]; float fm[8], fp[8];
#pragma unroll
    for (int g = 0; g < 8; ++g) { const int r = r0 + sg * (32 * g + sr); const int t = r % TBr; const bool hp = (t != 0) && (t != CTXr), hn = (t != CTXr - 1) && (t != TBr - 1);
        const bf16* p = P + (size_t)r * 2560 + 448 + c; x0[g] = ld8(p); xm[g] = ld8(hp ? p - 2560 : p); xp[g] = ld8(hn ? p + 2560 : p); fm[g] = hp ? 1.0f : 0.0f; fp[g] = hn ? 1.0f : 0.0f; }
    asm volatile("" ::: "memory");
#pragma unroll
    for (int g = 0; g < 8; ++g) { float u[8];
#pragma unroll
        for (int j = 0; j < 8; ++j) { const float a = cp.w0[j] * fm[g] * bf2f(xm[g][j]) + cp.w1[j] * bf2f(x0[g][j]) + cp.w2[j] * fp[g] * bf2f(xp[g][j]) + cp.bb[j];
            u[j] = a * __builtin_amdgcn_rcpf(1.0f + __builtin_amdgcn_exp2f(-LOG2E * a)) * scale; }
        u32x4 o = {cvtpk(u[0], u[1]), cvtpk(u[2], u[3]), cvtpk(u[4], u[5]), cvtpk(u[6], u[7])};
        out[g] = *reinterpret_cast<bf16x8*>(&o); }
}
__device__ __forceinline__ void gate_scan_task(const float* __restrict__ G, const float* __restrict__ gate_b, float* __restrict__ T, float* __restrict__ sca, int task, int lane) {
    const int seq = task / 17, j = task - seq * 17, b = seq >> 3, h = (seq >> 1) & 3, dir = seq & 1;
    int rb, sg; unit_rows(b, dir, j, rb, sg);
    const int gi = (2 * dir) * 4 + h, gf = (2 * dir + 1) * 4 + h; const float ib = gate_b[gi], fb = gate_b[gf];
    float igv[4], fgv[4];
#pragma unroll
    for (int rnd = 0; rnd < 4; ++rnd) { const size_t r = (size_t)(rb + sg * (64 * rnd + lane)); igv[rnd] = G[r * 16 + gi] + ib; fgv[rnd] = G[r * 16 + gf] + fb; }
    float cb = 0.f, cpm = -3.0e38f; float* Tb = T + (size_t)task * 256;
#pragma unroll
    for (int rnd = 0; rnd < 4; ++rnd) { const int i = 64 * rnd + lane;
        float bc = log_sigmoid_f(fgv[rnd]);
#pragma unroll
        for (int o = 1; o < 64; o <<= 1) { const float t_ = __shfl_up(bc, o); if (lane >= o) bc += t_; }
        bc += cb;
        const float al = igv[rnd] - bc; float pm = al;
#pragma unroll
        for (int o = 1; o < 64; o <<= 1) { const float t_ = __shfl_up(pm, o); if (lane >= o) pm = fmaxf(pm, t_); }
        pm = fmaxf(pm, cpm);
        Tb[i] = bc; Tb[TSTRIDE + i] = al; Tb[2 * TSTRIDE + i] = pm;
        cb = __shfl(bc, 63); cpm = __shfl(pm, 63); }
    if (j < 16 && lane == 0) { sca[(seq * 16 + j) * 2] = cpm; sca[(seq * 16 + j) * 2 + 1] = cb; }
}
__device__ __forceinline__ void mlstm_local(const bf16* __restrict__ P, const float* __restrict__ T, const float* __restrict__ cw, const float* __restrict__ cbias,
                                            float* __restrict__ Cloc, float* __restrict__ nloc, int unit, char* lds) {
    int tid_ = threadIdx.x; asm volatile("" : "+v"(tid_));
    const int tid = tid_, wid = tid >> 6, lane = tid & 63, r32 = lane & 31, hi = lane >> 5;
    const int seq = unit >> 4, j = unit & 15, b = seq >> 3, h = (seq >> 1) & 3, dir = seq & 1;
    int rb, sg; unit_rows(b, dir, j, rb, sg);
    const float* Tal = T + TSTRIDE + (size_t)(seq * 17 + j) * 256; const float mlm = T[2 * TSTRIDE + (size_t)(seq * 17 + j) * 256 + 255];
    float* npart = (float*)(lds + 131072);
    const int sr = tid >> 4, sc = (tid & 15) * 8;
    float wv[8]; bf16x8 vreg[8];
#pragma unroll
    for (int g = 0; g < 8; ++g) { const int i = 32 * g + sr; wv[g] = Tal[i]; vreg[g] = ld8(P + (size_t)(rb + sg * i) * 2560 + 1472 + h * 128 + sc); }
    asm volatile("" ::: "memory");
    float nacc[8] = {0.f, 0.f, 0.f, 0.f, 0.f, 0.f, 0.f, 0.f};
    { Conv8 cp; conv8_load(cp, cw, cbias, 512 + h * 128 + sc);
      bf16x8 kv[8]; conv8x8(P, rb, sg, sr, 512 + h * 128 + sc, cp, 0.08838834764831845f, kv);
#pragma unroll
      for (int g = 0; g < 8; ++g) { const int i = 32 * g + sr; *(bf16x8*)(lds + (i >> 6) * 16384 + v_st(i & 63, sc)) = kv[g]; wv[g] = __expf(wv[g] - mlm);
#pragma unroll
          for (int x = 0; x < 8; ++x) nacc[x] += wv[g] * bf2f(kv[g][x]); } }
#pragma unroll
    for (int g = 0; g < 8; ++g) { const int i = 32 * g + sr; const float w = wv[g]; const bf16x8 v = vreg[g];
        u32x4 o = {cvtpk(bf2f(v[0]) * w, bf2f(v[1]) * w), cvtpk(bf2f(v[2]) * w, bf2f(v[3]) * w), cvtpk(bf2f(v[4]) * w, bf2f(v[5]) * w), cvtpk(bf2f(v[6]) * w, bf2f(v[7]) * w)};
        *(u32x4*)(lds + 65536 + (i >> 6) * 16384 + v_st(i & 63, sc)) = o; }
#pragma unroll
    for (int x = 0; x < 8; ++x) { nacc[x] += __shfl_xor(nacc[x], 16); nacc[x] += __shfl_xor(nacc[x], 32); }
    if (lane < 16) {
#pragma unroll
        for (int x = 0; x < 8; ++x) npart[wid * 128 + sc + x] = nacc[x]; }
    __syncthreads();
    const int db = wid >> 1, eb0 = 2 * (wid & 1);
    const int vbK = (int)(uintptr_t)lds + v_rd_base(lane) + db * 512, vbV = (int)(uintptr_t)lds + 65536 + v_rd_base(lane) + eb0 * 512;
    f32x16 c0 = {}, c1 = {};
#define MLA_STEP(TL, KS) do { const s16x4 al_ = trr<(TL) * 16384 + v_rd_off(0, KS, 0)>(vbK), ah_ = trr<(TL) * 16384 + v_rd_off(0, KS, 1)>(vbK); \
        const s16x4 bl0 = trr<(TL) * 16384 + v_rd_off(0, KS, 0)>(vbV), bh0 = trr<(TL) * 16384 + v_rd_off(0, KS, 1)>(vbV), bl1 = trr<(TL) * 16384 + v_rd_off(1, KS, 0)>(vbV), bh1 = trr<(TL) * 16384 + v_rd_off(1, KS, 1)>(vbV); \
        asm volatile("s_waitcnt lgkmcnt(0)" ::: "memory"); __builtin_amdgcn_sched_barrier(0); \
        c0 = __builtin_amdgcn_mfma_f32_32x32x16_bf16(MLPK(al_, ah_), MLPK(bl0, bh0), c0, 0, 0, 0); c1 = __builtin_amdgcn_mfma_f32_32x32x16_bf16(MLPK(al_, ah_), MLPK(bl1, bh1), c1, 0, 0, 0); } while (0)
#define MLA_TILE(TL) do { MLA_STEP(TL, 0); MLA_STEP(TL, 1); MLA_STEP(TL, 2); MLA_STEP(TL, 3); } while (0)
    MLA_TILE(0); MLA_TILE(1); MLA_TILE(2); MLA_TILE(3);
#undef MLA_TILE
#undef MLA_STEP
    float* Co = Cloc + (size_t)unit * 16384;
#pragma unroll
    for (int r = 0; r < 16; ++r) { const int d = db * 32 + crow(r, hi); Co[d * 128 + eb0 * 32 + r32] = c0[r]; Co[d * 128 + eb0 * 32 + 32 + r32] = c1[r]; }
    if (tid < 128) { float s = 0.f;
#pragma unroll
        for (int w = 0; w < 8; ++w) s += npart[w * 128 + tid];
        nloc[unit * 128 + tid] = s; }
    __syncthreads();
}
__device__ __forceinline__ void mlstm_scan(const float* __restrict__ Cloc, const float* __restrict__ nloc, const float* __restrict__ sca, bf16* __restrict__ CstT, float* __restrict__ nst, float* __restrict__ bm, int gtid, int gthreads) {
    for (int item = gtid; item < 32 * 2048; item += gthreads) {
        const int seq = item >> 11, rem = item & 2047, e = rem & 127, dg = rem >> 7;
        float st[8] = {0.f, 0.f, 0.f, 0.f, 0.f, 0.f, 0.f, 0.f}; float nv = 0.f, Bst = 0.f, Mst = 0.f;
        asm volatile("" : "+v"(Bst), "+v"(Mst));
        const float* Cl0 = Cloc + (size_t)(seq * 16) * 16384 + (dg * 8) * 128 + e;
        for (int half = 0; half < 2; ++half) {
            float cl[8][8], nlv[8], mlv[8], blv[8];
#pragma unroll
            for (int jj = 0; jj < 8; ++jj) { const int lu = seq * 16 + half * 8 + jj;
#pragma unroll
                for (int i = 0; i < 8; ++i) cl[jj][i] = Cl0[(size_t)(half * 8 + jj) * 16384 + i * 128];
                nlv[jj] = nloc[lu * 128 + e]; mlv[jj] = sca[lu * 2]; blv[jj] = sca[lu * 2 + 1]; }
#pragma unroll
            for (int jj = 0; jj < 8; ++jj) { const int j = half * 8 + jj; const size_t su = (size_t)seq * 17 + j;
                u32x4 o = {cvtpk(st[0], st[1]), cvtpk(st[2], st[3]), cvtpk(st[4], st[5]), cvtpk(st[6], st[7])};
                *(u32x4*)(CstT + su * 16384 + e * 128 + dg * 8) = o;
                if (dg == 0) { nst[su * 128 + e] = nv; if (e == 0) { bm[su * 2] = Bst; bm[su * 2 + 1] = Mst; } }
                const float Mend = fmaxf(Mst, mlv[jj] - Bst), fa = __expf(Mst - Mend), fbv = __expf(mlv[jj] - Bst - Mend);
#pragma unroll
                for (int i = 0; i < 8; ++i) st[i] = fa * st[i] + fbv * cl[jj][i];
                nv = fa * nv + fbv * nlv[jj];
                Bst += blv[jj]; Mst = Mend; }
        }
        { const size_t su = (size_t)seq * 17 + 16;
          u32x4 o = {cvtpk(st[0], st[1]), cvtpk(st[2], st[3]), cvtpk(st[4], st[5]), cvtpk(st[6], st[7])};
          *(u32x4*)(CstT + su * 16384 + e * 128 + dg * 8) = o;
          if (dg == 0) { nst[su * 128 + e] = nv; if (e == 0) { bm[su * 2] = Bst; bm[su * 2 + 1] = Mst; } } }
    }
}
#define KSW(row, colB) ((row) * 256 + ((colB) ^ (((row) & 15) << 4)))
template <int D0, int KS> __device__ __forceinline__ void pv_pair(f32x16& od, int vb, bf16x8 pa, bf16x8 pb) {
    const s16x4 l0 = trr<v_rd_off(D0, KS, 0)>(vb), h0 = trr<v_rd_off(D0, KS, 1)>(vb), l1 = trr<v_rd_off(D0, KS + 1, 0)>(vb), h1 = trr<v_rd_off(D0, KS + 1, 1)>(vb);
    asm volatile("s_waitcnt lgkmcnt(0)" ::: "memory"); __builtin_amdgcn_sched_barrier(0);
    od = __builtin_amdgcn_mfma_f32_32x32x16_bf16(pa, MLPK(l0, h0), od, 0, 0, 0);
    od = __builtin_amdgcn_mfma_f32_32x32x16_bf16(pb, MLPK(l1, h1), od, 0, 0, 0);
}
__device__ __forceinline__ void mlstm_out2(const bf16* __restrict__ P, const float* __restrict__ T, const float* __restrict__ cw, const float* __restrict__ cbias, const bf16* __restrict__ CstT, const float* __restrict__ nst,
                                           const float* __restrict__ bm, const float* __restrict__ mnorm, bf16* __restrict__ MIX, int b, int h, int tb, char* lds) {
    int tid_ = threadIdx.x; asm volatile("" : "+v"(tid_));
    const int tid = tid_, wid = tid >> 6, lane = tid & 63, r32 = lane & 31, hi = lane >> 5;
    const int seqf = b * 8 + h * 2, seqb = seqf + 1; const int jb = tb == 0 ? 0 : 17 - tb; const bool zs = (tb == 0);
    const size_t suf = (size_t)seqf * 17 + tb, sub = (size_t)seqb * 17 + jb;
    const int rb = b * TBr + 256 * tb;
    float* tabs = (float*)(lds + 131072);
    float* nlf = tabs + 2048; float* nlb = tabs + 2176; float* wsc = tabs + 2304 + wid * 32;
    const int sr = tid >> 4, sc = (tid & 15) * 8;
    {   Conv8 cp; conv8_load(cp, cw, cbias, 512 + h * 128 + sc);
        bf16x8 kv[8]; conv8x8(P, rb, 1, sr, 512 + h * 128 + sc, cp, 0.08838834764831845f, kv);
#pragma unroll
        for (int g = 0; g < 8; ++g) { const int i = 32 * g + sr; *(bf16x8*)(lds + KSW(i, sc * 2)) = kv[g]; } }
    {   Conv8 cp; conv8_load(cp, cw, cbias, h * 128 + sc);
        bf16x8 qv[8]; conv8x8(P, rb, 1, sr, h * 128 + sc, cp, 1.0f, qv);
#pragma unroll
        for (int g = 0; g < 8; ++g) { const int i = 32 * g + sr; *(bf16x8*)(lds + 65536 + KSW(i, sc * 2)) = qv[g]; } }
    bf16x8 vreg[8];
#pragma unroll
    for (int g = 0; g < 8; ++g) vreg[g] = ld8(P + (size_t)(rb + 32 * g + sr) * 2560 + 1472 + h * 128 + sc);
    asm volatile("" ::: "memory");
    {
        const int dir = tid >> 8, n = tid & 255; const size_t su = dir ? sub : suf; const size_t ti = su * 256 + (dir ? 255 - n : n);
        const float bl = T[ti], al = T[TSTRIDE + ti], pm = T[2 * TSTRIDE + ti]; float Bst = 0.f, Mst = 0.f; if (!zs) { Bst = bm[su * 2]; Mst = bm[su * 2 + 1]; }
        float* tb_ = tabs + dir * 1024; const float M = fmaxf(Mst, pm - Bst);
        tb_[n] = __expf(-(Bst + bl + M)); tb_[256 + n] = (al - Bst) * LOG2E; tb_[512 + n] = M * LOG2E; tb_[768 + n] = __expf(Mst - M); }
    if (wid == 2) { nlf[lane] = zs ? 0.f : nst[suf * 128 + lane]; nlf[64 + lane] = zs ? 0.f : nst[suf * 128 + 64 + lane]; }
    if (wid == 3) { nlb[lane] = zs ? 0.f : nst[sub * 128 + lane]; nlb[64 + lane] = zs ? 0.f : nst[sub * 128 + 64 + lane]; }
    __syncthreads();
    bf16x8 qr[8];
#pragma unroll
    for (int d0 = 0; d0 < 8; ++d0) qr[d0] = *reinterpret_cast<const bf16x8*>(lds + 65536 + KSW(wid * 32 + r32, (d0 * 16 + hi * 8) * 2));
    asm volatile("s_waitcnt lgkmcnt(0)" ::: "memory");
    __syncthreads();
#pragma unroll
    for (int g = 0; g < 8; ++g) { const int i = 32 * g + sr; *(bf16x8*)(lds + 65536 + (i >> 6) * 16384 + v_st(i & 63, sc)) = vreg[g]; }
    __syncthreads();
    const int qi = wid * 32 + r32;
    float qnf = 0.f, qnb = 0.f;
#pragma unroll
    for (int d0 = 0; d0 < 8; ++d0) {
#pragma unroll
        for (int jj = 0; jj < 8; ++jj) { const float qv = bf2f(qr[d0][jj]); qnf += qv * nlf[d0 * 16 + hi * 8 + jj]; qnb += qv * nlb[d0 * 16 + hi * 8 + jj]; }
        asm volatile("" : "+v"(qnf), "+v"(qnb)); }
    { auto rr = __builtin_amdgcn_permlane32_swap(__float_as_uint(qnf), __float_as_uint(qnf), false, false); qnf = __uint_as_float(rr[0]) + __uint_as_float(rr[1]); }
    { auto rr = __builtin_amdgcn_permlane32_swap(__float_as_uint(qnb), __float_as_uint(qnb), false, false); qnb = __uint_as_float(rr[0]) + __uint_as_float(rr[1]); }
    const int vb0 = (int)(uintptr_t)lds + 65536 + v_rd_base(lane);
    const int dtile = wid >> 1;
    unsigned hfp[32];
#define ML_PK4(Pv, BASE, OUT) do { unsigned a0 = cvtpk(Pv[BASE + 0], Pv[BASE + 1]), a1 = cvtpk(Pv[BASE + 2], Pv[BASE + 3]);   \
    unsigned b0_ = cvtpk(Pv[BASE + 4], Pv[BASE + 5]), b1_ = cvtpk(Pv[BASE + 6], Pv[BASE + 7]);                              \
    auto r0 = __builtin_amdgcn_permlane32_swap(a0, b0_, false, false); auto r1 = __builtin_amdgcn_permlane32_swap(a1, b1_, false, false); \
    u32x4 w = {r0[0], r1[0], r0[1], r1[1]}; OUT = *reinterpret_cast<bf16x8*>(&w); } while (0)
#pragma unroll
    for (int dir = 0; dir < 2; ++dir) {
        const float* tb_ = tabs + dir * 1024; const size_t su = dir ? sub : suf;
        f32x16 o[4];
        if (zs) { o[0] = f32x16{}; o[1] = f32x16{}; o[2] = f32x16{}; o[3] = f32x16{}; }
        else { const bf16* Cb = CstT + su * 16384 + (size_t)r32 * 128 + hi * 8;
#pragma unroll
          for (int ep = 0; ep < 2; ++ep) { bf16x8 cf[16];
#pragma unroll
              for (int x = 0; x < 16; ++x) cf[x] = ld8(Cb + (2 * ep + (x >> 3)) * 32 * 128 + (x & 7) * 16);
              f32x16 a0 = {}, a1 = {};
#pragma unroll
              for (int d0 = 0; d0 < 8; ++d0) { a0 = __builtin_amdgcn_mfma_f32_32x32x16_bf16(qr[d0], cf[d0], a0, 0, 0, 0); a1 = __builtin_amdgcn_mfma_f32_32x32x16_bf16(qr[d0], cf[8 + d0], a1, 0, 0, 0); }
              o[2 * ep] = a0; o[2 * ep + 1] = a1; }
#pragma unroll
          for (int r = 0; r < 16; ++r) { const float isc = tb_[768 + wid * 32 + crow(r, hi)];
#pragma unroll
              for (int eb = 0; eb < 4; ++eb) o[eb][r] *= isc; } }
        const float qn = dir ? qnb : qnf;
        const float m2q = tb_[512 + qi]; float dsum = 0.f;
        const int kt0 = dir ? dtile : 0, kt1 = dir ? 4 : dtile + 1;
        for (int kt = kt0; kt < kt1; ++kt) {
            const char* Ks = lds + kt * 64 * 256; const bool diag = (kt == dtile); const int vb = vb0 + kt * 16384;
#pragma unroll
            for (int hh = 0; hh < 2; ++hh) {
                f32x16 p = {}, p2 = {};
#pragma unroll
                for (int d0 = 0; d0 < 8; d0 += 2) { const int cb = (d0 * 16 + hi * 8) * 2;
                    const bf16x8 b0 = *reinterpret_cast<const bf16x8*>(Ks + KSW(32 * hh + r32, cb)), b1 = *reinterpret_cast<const bf16x8*>(Ks + KSW(32 * hh + r32, cb + 32));
                    p = __builtin_amdgcn_mfma_f32_32x32x16_bf16(b0, qr[d0], p, 0, 0, 0); p2 = __builtin_amdgcn_mfma_f32_32x32x16_bf16(b1, qr[d0 + 1], p2, 0, 0, 0); }
                p += p2;
#pragma unroll
                for (int g4 = 0; g4 < 4; ++g4) { const int sb = kt * 64 + 32 * hh + 8 * g4 + 4 * hi;
                    const f32x4 a4 = *(const f32x4*)(tb_ + 256 + sb);
#pragma unroll
                    for (int x = 0; x < 4; ++x) { const int r = 4 * g4 + x, s0 = sb + x;
                        float w0 = __builtin_amdgcn_exp2f(a4[x] - m2q);
                        if (diag) { if (dir ? (s0 < qi) : (s0 > qi)) w0 = 0.f; }
                        p[r] *= w0; dsum += p[r]; } }
                bf16x8 pa, pb;
                ML_PK4(p, 0, pa); ML_PK4(p, 8, pb);
                if (hh == 0) { pv_pair<0, 0>(o[0], vb, pa, pb); pv_pair<1, 0>(o[1], vb, pa, pb); pv_pair<2, 0>(o[2], vb, pa, pb); pv_pair<3, 0>(o[3], vb, pa, pb); }
                else         { pv_pair<0, 2>(o[0], vb, pa, pb); pv_pair<1, 2>(o[1], vb, pa, pb); pv_pair<2, 2>(o[2], vb, pa, pb); pv_pair<3, 2>(o[3], vb, pa, pb); }
            }
        }
        { auto rr = __builtin_amdgcn_permlane32_swap(__float_as_uint(dsum), __float_as_uint(dsum), false, false); dsum = __uint_as_float(rr[0]) + __uint_as_float(rr[1]); }
        const float den = dsum + tb_[768 + qi] * qn; const float rd = 1.0f / fmaxf(fabsf(den), tb_[qi]);
        if (hi == 0) wsc[r32] = rd; asm volatile("s_waitcnt lgkmcnt(0)" ::: "memory");
        if (dir == 0) {
#pragma unroll
            for (int r = 0; r < 16; r += 2) { const float ra = wsc[crow(r, hi)], rb_ = wsc[crow(r + 1, hi)];
#pragma unroll
                for (int eb = 0; eb < 4; ++eb) hfp[eb * 8 + (r >> 1)] = cvtpk(o[eb][r] * ra, o[eb][r + 1] * rb_); }
            asm volatile("s_waitcnt lgkmcnt(0)" ::: "memory");
        } else {
            float rdr[16];
#pragma unroll
            for (int r = 0; r < 16; ++r) rdr[r] = wsc[crow(r, hi)];
            bf16x8 og8[8];
            { const bf16* ogp = P + (size_t)(rb + wid * 32 + r32) * 2560 + 1984 + h * 128 + 64 * hi;
#pragma unroll
              for (int c8 = 0; c8 < 8; ++c8) og8[c8] = ld8(ogp + 8 * c8); }
            __syncthreads();
            float* W = (float*)(lds + wid * 16896);
#pragma unroll
            for (int r = 0; r < 16; ++r)
#pragma unroll
                for (int eb = 0; eb < 4; ++eb) { const unsigned pk = hfp[eb * 8 + (r >> 1)]; const float hf = (r & 1) ? __uint_as_float(pk & 0xffff0000u) : __uint_as_float(pk << 16);
                    W[crow(r, hi) * 132 + eb * 32 + r32] = hf + o[eb][r] * rdr[r]; }
            asm volatile("s_waitcnt lgkmcnt(0)" ::: "memory");
            const int tok = r32, eh = hi; const size_t row = (size_t)(rb + wid * 32 + tok);
            const float* mg = mnorm + h * 128 + 64 * eh;
            float v[64]; float s = 0.f;
#pragma unroll
            for (int c8 = 0; c8 < 8; ++c8) { const bf16x8 g8 = og8[c8]; const f32x4 w0 = *(const f32x4*)(W + tok * 132 + 64 * eh + 8 * c8), w1 = *(const f32x4*)(W + tok * 132 + 64 * eh + 8 * c8 + 4);
                const float hv[8] = {w0.x, w0.y, w0.z, w0.w, w1.x, w1.y, w1.z, w1.w};
#pragma unroll
                for (int x = 0; x < 8; ++x) { const float vv = hv[x] * __builtin_amdgcn_rcpf(1.0f + __builtin_amdgcn_exp2f(-LOG2E * bf2f(g8[x]))); v[8 * c8 + x] = vv; s += vv; } }
            { auto rr = __builtin_amdgcn_permlane32_swap(__float_as_uint(s), __float_as_uint(s), false, false); s = __uint_as_float(rr[0]) + __uint_as_float(rr[1]); }
            const float mu = s * (1.0f / 128.0f); float q = 0.f;
#pragma unroll
            for (int x = 0; x < 64; ++x) { v[x] -= mu; q += v[x] * v[x]; }
            { auto rr = __builtin_amdgcn_permlane32_swap(__float_as_uint(q), __float_as_uint(q), false, false); q = __uint_as_float(rr[0]) + __uint_as_float(rr[1]); }
            const float rstd = 1.0f / sqrtf(q * (1.0f / 128.0f) + 1e-6f);
            bf16* orow = MIX + row * 1024 + 512 + h * 128 + 64 * eh;
#pragma unroll
            for (int c8 = 0; c8 < 8; ++c8) { const f32x4 g0 = *(const f32x4*)(mg + 8 * c8), g1 = *(const f32x4*)(mg + 8 * c8 + 4);
                u32x4 ov = {cvtpk(v[8 * c8] * rstd * g0.x, v[8 * c8 + 1] * rstd * g0.y), cvtpk(v[8 * c8 + 2] * rstd * g0.z, v[8 * c8 + 3] * rstd * g0.w),
                            cvtpk(v[8 * c8 + 4] * rstd * g1.x, v[8 * c8 + 5] * rstd * g1.y), cvtpk(v[8 * c8 + 6] * rstd * g1.z, v[8 * c8 + 7] * rstd * g1.w)};
                *(u32x4*)(orow + 8 * c8) = ov; }
        }
    }
#undef ML_PK4
    __syncthreads();
}
#undef KSW
#undef MLPK
#undef MLAS
}

#define LAS __attribute__((address_space(3)))
typedef unsigned short bf16;
typedef float f32x4 __attribute__((ext_vector_type(4)));
typedef unsigned u32x4 __attribute__((ext_vector_type(4)));
typedef unsigned u32x2 __attribute__((ext_vector_type(2)));
typedef short bf16x8 __attribute__((ext_vector_type(8)));
constexpr int NWAVES = 8, NTHREADS = 512;
constexpr int DM = 1024, NB = 4, SEQ = 4096, CTXL = 256, TB = SEQ + CTXL  , R = NB * TB  ;
constexpr int DFF = 2752, DFFP = 2816, NW1 = 2 * DFFP  , DIN = 2512, DINP = 2560, KUP = 384, NUP = 1792;
constexpr int NMOD = 9;
constexpr float EPS = 1e-6f;
constexpr size_t MiB = 1u << 20;
constexpr size_t WS_CTL = 0, CTL_BYTES = 1 * MiB;
constexpr size_t WS_MOD = 1 * MiB;
constexpr size_t WS_TAB = WS_MOD + 512 * 1024;
constexpr size_t WS_W1 = 2 * MiB;
constexpr size_t WS_W2 = WS_W1 + (size_t)2 * NW1 * DM * 2;
constexpr size_t WS_WIN = WS_W2 + (size_t)2 * DM * DFFP * 2;
constexpr size_t WS_WUP = WS_WIN + (size_t)DINP * DM * 2;
constexpr size_t WS_WOUT = WS_WUP + (size_t)NUP * KUP * 2;
constexpr size_t WS_XC = WS_WOUT + (size_t)DM * DM * 2;
constexpr size_t WS_H = WS_XC + (size_t)NB * CTXL * DM * 4;
constexpr size_t WS_BIG = WS_H + (size_t)R * DM * 2;
constexpr size_t BIG_KR = (size_t)R * DINP * 2;
constexpr size_t BIG_G = BIG_KR + (size_t)R * 64 * 2;
constexpr size_t WS_Y = WS_BIG + (size_t)R * DFFP * 2;
constexpr size_t WS_Q = WS_Y + (size_t)R * DM * 2;
constexpr size_t WS_AUP = WS_Q + (size_t)R * 768 * 2;
constexpr size_t WS_HF = WS_AUP + (size_t)R * 512 * 2;
constexpr size_t WS_HB = WS_HF + (size_t)R * 512 * 2;
constexpr size_t WS_MS = WS_HB + (size_t)R * 512 * 2;
constexpr size_t MS_NLOC = 0, MS_SCA = 262144, MS_NST = 266240, MS_BM = 544768;
constexpr size_t MS_X1 = 3u << 20, MS_X2 = (3u << 20) + (512u << 10);
constexpr size_t MS_T = 1u << 20;
constexpr size_t WS_END = WS_MS + 4 * MiB;
static_assert(BIG_G + (size_t)R * 16 * 4 <= (size_t)R * DFFP * 2, "P + KR + G fit the hidden region");
static_assert(WS_W1 % 256 == 0 && WS_W2 % 256 == 0 && WS_WIN % 256 == 0 && WS_WUP % 256 == 0 && WS_WOUT % 256 == 0 && WS_XC % 256 == 0 && WS_H % 256 == 0 && WS_BIG % 256 == 0 && WS_Y % 256 == 0 && WS_Q % 256 == 0 && WS_AUP % 256 == 0 && WS_HF % 256 == 0, "alignment");
static_assert(WS_END <= 305u * MiB, "workspace budget");
constexpr int LDS_BYTES = 147456, LDS_MISC = 143360;

#define LDS_WAIT() asm volatile("s_waitcnt lgkmcnt(0)" ::: "memory")
__device__ __forceinline__ unsigned f2bf(float f) { unsigned u = __builtin_bit_cast(unsigned, f); return (u + 0x7fffu + ((u >> 16) & 1u)) >> 16; }
__device__ __forceinline__ unsigned pk2(float lo, float hi) { return f2bf(lo) | (f2bf(hi) << 16); }
__device__ __forceinline__ float bflo(unsigned w) { return __uint_as_float(w << 16); }
__device__ __forceinline__ float bfhi(unsigned w) { return __uint_as_float(w & 0xffff0000u); }
__device__ __forceinline__ float bf1(bf16 b) { return __uint_as_float(((unsigned)b) << 16); }
__device__ __forceinline__ float wave_sum(float v) {
#pragma unroll
    for (int o = 1; o < 64; o <<= 1) v += __shfl_xor(v, o);
    return v;
}
__device__ __forceinline__ float sigmoid_f(float x) { return __builtin_amdgcn_rcpf(1.0f + __builtin_amdgcn_exp2f(-1.4426950408889634f * x)); }
__device__ __forceinline__ float silu1(float x) { return x * sigmoid_f(x); }

struct Args { const float* in[22]; float* out; unsigned char* ws; int ph_lo, ph_hi; };
struct ArgsV { const Args* p; int z;
    __device__ __forceinline__ const float* in(int i) const { return p->in[i + z]; }
    __device__ __forceinline__ float* out() const { return (float*)p->in[22 + z]; }
    __device__ __forceinline__ unsigned char* ws() const { return (unsigned char*)p->in[23 + z]; } };
enum { I_X = 0, I_C, I_CTX, I_CCTX, I_WMOD, I_BMOD, I_NPRE, I_NPOST, I_WG, I_WU, I_WD, I_WIN, I_QN, I_WUQ, I_KVN, I_WUKV, I_AON, I_CW, I_CB, I_GB, I_MN, I_WOUT };

__device__ __forceinline__ const float* xin_row(const ArgsV& a, int r) { const int b = r / TB, t = r - b * TB; return t < CTXL ? a.in(I_CTX) + (size_t)(b * CTXL + t) * DM : a.in(I_X) + (size_t)(b * SEQ + t - CTXL) * DM; }
__device__ __forceinline__ float* xres_row(const ArgsV& a, int r) { const int b = r / TB, t = r - b * TB; return t < CTXL ? (float*)(a.ws() + WS_XC) + (size_t)(b * CTXL + t) * DM : a.out() + (size_t)(b * SEQ + t - CTXL) * DM; }
__device__ __forceinline__ const float* mod_vec(const ArgsV& a, int l, int r, int j) { const int b = r / TB, t = r - b * TB; const int bb = t < CTXL ? 4 : b; return (const float*)(a.ws() + WS_MOD) + (size_t)((l * 5 + bb) * NMOD + j) * DM; }

__device__ __forceinline__ void cvt_item(const float* src, int srcN, int k0, int c0, int ncv, bf16* dst, int dstK, int drow0, int dk0, LAS float* scr, int lane) {
    const int n4 = (lane & 15) * 4, kr = lane >> 4;
    f32x4 v[16];
    const bool ok = n4 < ncv;
    const float* sp = src + (size_t)(k0 + kr) * srcN + c0 + n4;
#pragma unroll
    for (int i = 0; i < 16; ++i) { v[i] = (f32x4){0.f, 0.f, 0.f, 0.f}; if (ok) v[i] = *(const f32x4*)(sp + (size_t)(4 * i) * srcN); }
#pragma unroll
    for (int i = 0; i < 16; ++i) { const int k = 4 * i + kr; *(LAS f32x4*)(scr + k * 68 + ((n4 + 8 * (k >> 3)) & 63)) = v[i]; }
    LDS_WAIT(); asm volatile("" ::: "memory");
    const int c = lane & 7;
#pragma unroll
    for (int j = 0; j < 8; ++j) { const int n = (lane >> 3) + 8 * j; const LAS float* s = scr + (8 * c) * 68 + ((n + 8 * c) & 63);
        u32x4 o; o.x = pk2(s[0 * 68], s[1 * 68]); o.y = pk2(s[2 * 68], s[3 * 68]); o.z = pk2(s[4 * 68], s[5 * 68]); o.w = pk2(s[6 * 68], s[7 * 68]);
        *(u32x4*)(dst + (size_t)(drow0 + n) * dstK + dk0 + 8 * c) = o; }
    LDS_WAIT(); asm volatile("" ::: "memory");
}
__device__ __forceinline__ void wconv_layer(const ArgsV& a, int l, LAS unsigned char* lds, int bid, int nbl, int wave, int lane) {
    LAS float* scr = (LAS float*)(lds + wave * 17408);
    const int gw = bid * NWAVES + wave, NGW = nbl * NWAVES;
    constexpr int I_1 = 88 * 16, I_2 = 16 * 44, I_IN = 40 * 16, I_UP = 28 * 6, I_OUT = 16 * 16;
    constexpr int NITEMS = 2 * I_1 + 2 * I_2 + I_IN + I_UP + I_OUT;
    bf16* W1 = (bf16*)(a.ws() + WS_W1); bf16* W2 = (bf16*)(a.ws() + WS_W2); bf16* WIN = (bf16*)(a.ws() + WS_WIN); bf16* WUP = (bf16*)(a.ws() + WS_WUP); bf16* WOUT = (bf16*)(a.ws() + WS_WOUT);
    for (int it = gw; it < NITEMS; it += NGW) {
        int r = it;
        if (r < 2 * I_1) { const int j = r / I_1; r -= j * I_1; const int g = r / 16, kb = r % 16; const int row0 = 64 * g, pn = row0 >> 8, i = row0 & 255; const int hc = 128 * pn + (i & 127);
            const float* src = (i < 128 ? a.in(I_WG) : a.in(I_WU)) + (size_t)(l * 2 + j) * DM * DFF;
            cvt_item(src, DFF, 64 * kb, hc < DFF ? hc : 0, hc < DFF ? 64 : 0, W1 + (size_t)j * NW1 * DM, DM, row0, 64 * kb, scr, lane); continue; }
        r -= 2 * I_1;
        if (r < 2 * I_2) { const int j = r / I_2; r -= j * I_2; const int g = r / 44, kb = r % 44;
            const float* src = a.in(I_WD) + (size_t)(l * 2 + j) * DFF * DM;
            cvt_item(src, DM, kb < 43 ? 64 * kb : 0, 64 * g, kb < 43 ? 64 : 0, W2 + (size_t)j * DM * DFFP, DFFP, 64 * g, 64 * kb, scr, lane); continue; }
        r -= 2 * I_2;
        if (r < I_IN) { const int g = r / 16, kb = r % 16; int ncv = DIN - 64 * g; ncv = ncv < 0 ? 0 : (ncv > 64 ? 64 : ncv);
            cvt_item(a.in(I_WIN) + (size_t)l * DM * DIN, DIN, 64 * kb, ncv > 0 ? 64 * g : 0, ncv, WIN, DM, 64 * g, 64 * kb, scr, lane); continue; }
        r -= I_IN;
        if (r < I_UP) { const int g = r / 6, kb = r % 6;
            if (g < 12) cvt_item(a.in(I_WUQ) + (size_t)l * 256 * 768, 768, kb < 4 ? 64 * kb : 0, 64 * g, kb < 4 ? 64 : 0, WUP, KUP, 64 * g, 64 * kb, scr, lane);
            else cvt_item(a.in(I_WUKV) + (size_t)l * 128 * 1024, 1024, kb >= 4 ? 64 * (kb - 4) : 0, 64 * (g - 12), kb >= 4 ? 64 : 0, WUP, KUP, 64 * g, 64 * kb, scr, lane);
            continue; }
        r -= I_UP;
        { const int g = r / 16, kb = r % 16; cvt_item(a.in(I_WOUT) + (size_t)l * DM * DM, DM, 64 * kb, 64 * g, 64, WOUT, DM, 64 * g, 64 * kb, scr, lane); }
    }
}
__device__ __forceinline__ void mod_phase(const ArgsV& a, LAS unsigned char* lds, int bid, int nbl, int tid, int wave, int lane) {
    LAS float* sv = (LAS float*)(lds);
    LAS float* red = (LAS float*)(lds + 20480);
    for (int i = tid; i < 5 * DM; i += NTHREADS) { const float v = i < 4 * DM ? a.in(I_C)[i] : a.in(I_CCTX)[i - 4 * DM]; sv[i] = silu1(v); }
    __syncthreads();
    float* mod = (float*)(a.ws() + WS_MOD);
    for (int u = bid; u < 256; u += nbl) {
        const int l = u >> 7, cb = (u & 127) * 72; const bool act = lane < 18;
        const float* W = a.in(I_WMOD) + (size_t)l * DM * (NMOD * DM) + cb + 4 * (act ? lane : 0);
        f32x4 acc[5];
#pragma unroll
        for (int bb = 0; bb < 5; ++bb) acc[bb] = (f32x4){0.f, 0.f, 0.f, 0.f};
        for (int k0 = wave * 128; k0 < wave * 128 + 128; k0 += 32) { f32x4 w[32];
#pragma unroll
            for (int i = 0; i < 32; ++i) w[i] = *(const f32x4*)(W + (size_t)(k0 + i) * (NMOD * DM));
#pragma unroll
            for (int i = 0; i < 32; ++i)
#pragma unroll
                for (int bb = 0; bb < 5; ++bb) acc[bb] += w[i] * sv[bb * DM + k0 + i]; }
        if (act) {
#pragma unroll
            for (int bb = 0; bb < 5; ++bb) *(LAS f32x4*)(red + (wave * 5 + bb) * 72 + 4 * lane) = acc[bb]; }
        __syncthreads();
        for (int i = tid; i < 5 * 72; i += NTHREADS) { const int bb = i / 72, cc = i % 72; float s = 0.f;
#pragma unroll
            for (int w = 0; w < 8; ++w) s += red[(w * 5 + bb) * 72 + cc];
            mod[(size_t)(l * 5 + bb) * (NMOD * DM) + cb + cc] = s + a.in(I_BMOD)[(size_t)l * NMOD * DM + cb + cc]; }
        __syncthreads();
    }
    if (bid == nbl - 1 && tid < 64) {
        constexpr float inv[16] = {1.0f, 0.5623413251903491f, 0.31622776601683794f, 0.1778279410038923f, 0.1f, 0.05623413251903491f, 0.03162277660168379f, 0.01778279410038923f,
                                   0.01f, 0.005623413251903491f, 0.0031622776601683794f, 0.001778279410038923f, 0.001f, 0.0005623413251903491f, 0.00031622776601683794f, 0.0001778279410038923f};
        float* tab = (float*)(a.ws() + WS_TAB);
#pragma unroll
        for (int f = 0; f < 16; ++f) {
            const float ang = (float)tid * inv[f];
            const double ad = (double)ang; const double kq = __builtin_rint(ad * 0.63661977236758134308); const double rd = ad - kq * 1.57079632679489661923;
            const float x = (float)rd, x2 = x * x; const int q = ((int)kq) & 3;
            const float sp = x + x * x2 * (-1.6666654611e-1f + x2 * (8.3321608736e-3f + x2 * (-1.9515295891e-4f)));
            const float cp = 1.0f - 0.5f * x2 + x2 * x2 * (4.166664568298827e-2f + x2 * (-1.388731625493765e-3f + x2 * 2.443315711809948e-5f));
            const float sn = (q == 0) ? sp : (q == 1) ? cp : (q == 2) ? -sp : -cp;
            const float cs = (q == 0) ? cp : (q == 1) ? -sp : (q == 2) ? -cp : sp;
            tab[(tid * 16 + f) * 2] = cs; tab[(tid * 16 + f) * 2 + 1] = sn; }
    }
    __syncthreads();
}

__device__ __forceinline__ void rw_pre(const f32x4 (&x)[4], const float* g, const float* sc, const float* sh, bf16* hrow, int lane) {
    float ss = 0.f;
#pragma unroll
    for (int j = 0; j < 4; ++j) ss += (x[j].x * x[j].x + x[j].y * x[j].y) + (x[j].z * x[j].z + x[j].w * x[j].w);
    const float rstd = 1.0f / sqrtf(wave_sum(ss) * (1.0f / DM) + EPS);
#pragma unroll
    for (int j = 0; j < 4; ++j) { const int c = 256 * j + 4 * lane; const f32x4 gv = *(const f32x4*)(g + c), sv = *(const f32x4*)(sc + c), hv = *(const f32x4*)(sh + c);
        f32x4 o; o.x = x[j].x * rstd * gv.x * (1.0f + sv.x) + hv.x; o.y = x[j].y * rstd * gv.y * (1.0f + sv.y) + hv.y; o.z = x[j].z * rstd * gv.z * (1.0f + sv.z) + hv.z; o.w = x[j].w * rstd * gv.w * (1.0f + sv.w) + hv.w;
        u32x2 w; w.x = pk2(o.x, o.y); w.y = pk2(o.z, o.w); *(u32x2*)(hrow + c) = w; }
}
__device__ __forceinline__ void phase_rw_a(const ArgsV& a, int bid, int nbl, int wave, int lane) {
    const int gw = bid * NWAVES + wave, NGW = nbl * NWAVES; bf16* H = (bf16*)(a.ws() + WS_H);
    for (int ra = gw; ra < R; ra += 2 * NGW) {
        const int rb_ = ra + NGW < R ? ra + NGW : ra; const float* xa = xin_row(a, ra); const float* xb = xin_row(a, rb_); f32x4 x0[4], x1[4];
#pragma unroll
        for (int j = 0; j < 4; ++j) { x0[j] = *(const f32x4*)(xa + 256 * j + 4 * lane); x1[j] = *(const f32x4*)(xb + 256 * j + 4 * lane); }
        rw_pre(x0, a.in(I_NPRE) + 0, mod_vec(a, 0, ra, 1), mod_vec(a, 0, ra, 0), H + (size_t)ra * DM, lane);
        if (rb_ != ra) rw_pre(x1, a.in(I_NPRE) + 0, mod_vec(a, 0, rb_, 1), mod_vec(a, 0, rb_, 0), H + (size_t)rb_ * DM, lane); }
}
__device__ __forceinline__ void rwb_load_y(const ArgsV& a, int r, int nsl, int lane, f32x4 (&y)[4]) {
    const int t = r % TB;
    const float* sp = (const float*)(a.ws() + WS_AUP) + (size_t)((r / TB) * CTXL + t) * DM + 4 * lane;
    { f32x4 v[4][4];
#pragma unroll
      for (int s = 0; s < 4; ++s)
#pragma unroll
          for (int j = 0; j < 4; ++j) v[s][j] = *(const f32x4*)(sp + (size_t)s * 1024 * 1024 + 256 * j);
#pragma unroll
      for (int j = 0; j < 4; ++j) y[j] = (v[0][j] + v[1][j]) + (v[2][j] + v[3][j]); }
    if (nsl > 4) { f32x4 v[7][4];
#pragma unroll
      for (int s = 0; s < 7; ++s)
#pragma unroll
          for (int j = 0; j < 4; ++j) v[s][j] = *(const f32x4*)(sp + (size_t)(4 + s) * 1024 * 1024 + 256 * j);
#pragma unroll
      for (int j = 0; j < 4; ++j) y[j] += ((v[0][j] + v[1][j]) + (v[2][j] + v[3][j])) + ((v[4][j] + v[5][j]) + v[6][j]); }
}
__device__ __forceinline__ void phase_rw_b(const ArgsV& a, int l, int sub, int bid, int nbl, int wave, int lane, bool dry = false) {
    const int gw = bid * NWAVES + wave, NGW = nbl * NWAVES; bf16* H = (bf16*)(a.ws() + WS_H);
    const float wgt = sub == 1 ? 1.0f : 0.5f; const float* gpost = a.in(I_NPOST) + (size_t)(l * 3 + sub) * DM;
    const int nl = sub == 2 ? l + 1 : l, nsub = sub == 2 ? 0 : sub + 1;
    const bool from_input = (l == 0 && sub == 0); const int nsl = sub == 1 ? 4 : 11;
    if (l == 1 && sub >= 1) return;
    for (int i0 = gw; i0 < NB * CTXL; i0 += NGW) {
        const int r0 = (i0 / CTXL) * TB + (i0 % CTXL);
        f32x4 y0[4], x0[4];
        const float* xs0 = from_input ? xin_row(a, r0) : xres_row(a, r0);
#pragma unroll
        for (int j = 0; j < 4; ++j) x0[j] = *(const f32x4*)(xs0 + 256 * j + 4 * lane);
        rwb_load_y(a, r0, nsl, lane, y0);
        float ss0 = 0.f;
#pragma unroll
        for (int j = 0; j < 4; ++j) ss0 += (y0[j].x * y0[j].x + y0[j].y * y0[j].y) + (y0[j].z * y0[j].z + y0[j].w * y0[j].w);
        const float rs0 = 1.0f / sqrtf(wave_sum(ss0) * (1.0f / DM) + EPS);
        float* xd0 = dry ? (float*)(a.ws() + WS_BIG) + (size_t)r0 * DM : xres_row(a, r0); const float* gate0 = mod_vec(a, l, r0, 3 * sub + 2);
#pragma unroll
        for (int j = 0; j < 4; ++j) { const int c = 256 * j + 4 * lane; const f32x4 gp = *(const f32x4*)(gpost + c), g0 = *(const f32x4*)(gate0 + c);
            x0[j].x += wgt * g0.x * (y0[j].x * rs0 * gp.x); x0[j].y += wgt * g0.y * (y0[j].y * rs0 * gp.y); x0[j].z += wgt * g0.z * (y0[j].z * rs0 * gp.z); x0[j].w += wgt * g0.w * (y0[j].w * rs0 * gp.w);
            *(f32x4*)(xd0 + c) = x0[j]; }
        rw_pre(x0, a.in(I_NPRE) + (size_t)(nl * 3 + nsub) * DM, mod_vec(a, nl, r0, 3 * nsub + 1), mod_vec(a, nl, r0, 3 * nsub), H + (size_t)r0 * DM, lane);
    }
}
__device__ __forceinline__ void phase_rw_prep(const ArgsV& a, int l, int bid, int nbl, int wave, int lane) {
    const int gw = bid * NWAVES + wave, NGW = nbl * NWAVES;
    const bf16* P = (const bf16*)(a.ws() + WS_BIG); bf16* AUP = (bf16*)(a.ws() + WS_AUP); bf16* KR = (bf16*)(a.ws() + WS_BIG + BIG_KR);
    const float* tab = (const float*)(a.ws() + WS_TAB);
    const float* qn = a.in(I_QN) + l * 256; const float* kvn = a.in(I_KVN) + l * 128;
    for (int task = gw; task < 32 * 17; task += NGW)
        ml::gate_scan_task((const float*)(a.ws() + WS_BIG + BIG_G), a.in(I_GB) + l * 16, (float*)(a.ws() + WS_MS + MS_T), (float*)(a.ws() + WS_MS + MS_SCA), task, lane);
    for (int ra = gw; ra < R; ra += 2 * NGW) {
        const int rb_ = ra + NGW < R ? ra + NGW : ra; const bool two = rb_ != ra;
        const bf16* pa = P + (size_t)ra * DINP; const bf16* pb = P + (size_t)rb_ * DINP;
        const u32x2 wa = *(const u32x2*)(pa + 4 * lane), wb = *(const u32x2*)(pb + 4 * lane);
        const unsigned ka = *(const unsigned*)(pa + 256 + 2 * lane), kb = *(const unsigned*)(pb + 256 + 2 * lane);
        const float va = bf1(pa[384 + lane]), vb = bf1(pb[384 + lane]);
        const f32x4 g = *(const f32x4*)(qn + 4 * lane); const float kg0 = kvn[2 * lane], kg1 = kvn[2 * lane + 1];
        float a0 = bflo(wa.x), a1 = bfhi(wa.x), a2 = bflo(wa.y), a3 = bfhi(wa.y), b0 = bflo(wb.x), b1 = bfhi(wb.x), b2 = bflo(wb.y), b3 = bfhi(wb.y);
        float sa = (a0 * a0 + a1 * a1) + (a2 * a2 + a3 * a3), sb = (b0 * b0 + b1 * b1) + (b2 * b2 + b3 * b3);
        const float c0 = bflo(ka), c1 = bfhi(ka), d0 = bflo(kb), d1 = bfhi(kb); float ta = c0 * c0 + c1 * c1, tb = d0 * d0 + d1 * d1;
#pragma unroll
        for (int o = 1; o < 64; o <<= 1) { sa += __shfl_xor(sa, o); sb += __shfl_xor(sb, o); ta += __shfl_xor(ta, o); tb += __shfl_xor(tb, o); }
        const float voa = __shfl_xor(va, 16), vob = __shfl_xor(vb, 16);
        const float rqa = 1.0f / sqrtf(sa * (1.0f / 256.0f) + EPS), rqb = 1.0f / sqrtf(sb * (1.0f / 256.0f) + EPS), rka = 1.0f / sqrtf(ta * (1.0f / 128.0f) + EPS), rkb = 1.0f / sqrtf(tb * (1.0f / 128.0f) + EPS);
        { u32x2 o; o.x = pk2(a0 * rqa * g.x, a1 * rqa * g.y); o.y = pk2(a2 * rqa * g.z, a3 * rqa * g.w); *(u32x2*)(AUP + (size_t)ra * KUP + 4 * lane) = o;
          *(unsigned*)(AUP + (size_t)ra * KUP + 256 + 2 * lane) = pk2(c0 * rka * kg0, c1 * rka * kg1); }
        if (two) { u32x2 o; o.x = pk2(b0 * rqb * g.x, b1 * rqb * g.y); o.y = pk2(b2 * rqb * g.z, b3 * rqb * g.w); *(u32x2*)(AUP + (size_t)rb_ * KUP + 4 * lane) = o;
          *(unsigned*)(AUP + (size_t)rb_ * KUP + 256 + 2 * lane) = pk2(d0 * rkb * kg0, d1 * rkb * kg1); }
        const int ax = lane >> 5, half = (lane >> 4) & 1, f = lane & 15;
        { const int t = ra % TB; float o = va;
          if (t >= CTXL) { const int tt = t - CTXL; const int pos = ax == 0 ? (tt >> 6) : (tt & 63); const float cs = tab[(pos * 16 + f) * 2], sn = tab[(pos * 16 + f) * 2 + 1]; o = half == 0 ? va * cs - voa * sn : va * cs + voa * sn; }
          KR[(size_t)ra * 64 + lane] = (bf16)f2bf(o); }
        if (two) { const int t = rb_ % TB; float o = vb;
          if (t >= CTXL) { const int tt = t - CTXL; const int pos = ax == 0 ? (tt >> 6) : (tt & 63); const float cs = tab[(pos * 16 + f) * 2], sn = tab[(pos * 16 + f) * 2 + 1]; o = half == 0 ? vb * cs - vob * sn : vb * cs + vob * sn; }
          KR[(size_t)rb_ * 64 + lane] = (bf16)f2bf(o); }
    }
}
#define RLX_AGENT __ATOMIC_RELAXED, __HIP_MEMORY_SCOPE_AGENT
#define VM_WAIT() asm volatile("s_waitcnt vmcnt(0)" ::: "memory")
#define XB_TMO      128
#define XB_XCNT(j)  (256  + 64 * (j))
#define XB_XSUB(j)  (1280 + 64 * (j))
#define XB_XGEN(j)  (2304 + 64 * (j))
#define XB_TOP      3328
#define XB_TOPGEN   3392
#define XCD_BAR_WORDS 3456
#define XB_SPIN_CAP (1u << 18)

__device__ __forceinline__ unsigned xb_ld(unsigned* p)              { return __hip_atomic_load(p, __ATOMIC_RELAXED, __HIP_MEMORY_SCOPE_AGENT); }
__device__ __forceinline__ unsigned xb_add(unsigned* p, unsigned v) { return __hip_atomic_fetch_add(p, v, __ATOMIC_RELAXED, __HIP_MEMORY_SCOPE_AGENT); }
__device__ __forceinline__ unsigned xb_xcc_id() { return (unsigned)__builtin_amdgcn_s_getreg((3 << 11) | 20) & 0xFu; }
#define XB_SPIN(cond, bar) do { unsigned _sp = 0; while (cond) { __builtin_amdgcn_s_sleep(1); \
    if ((++_sp & 255u) == 0u) { if (xb_ld(&(bar)[XB_TMO])) break; if (_sp > XB_SPIN_CAP) { atomicAdd(&(bar)[XB_TMO], 1u); break; } } } } while (0)

struct XcdBarrier {
    unsigned* bar; unsigned x;
    volatile LAS unsigned* st;
};

__device__ __forceinline__ XcdBarrier xcd_barrier_post(unsigned* bar, volatile LAS unsigned* st) {
    XcdBarrier b; b.bar = bar; b.x = xb_xcc_id(); b.st = st;
    if (threadIdx.x == 0) (void)xb_add(&bar[XB_XCNT(b.x)], 1u);
    return b;
}
__device__ __forceinline__ void xcd_barrier_complete(unsigned* bar, unsigned x, unsigned& nloc, unsigned& nx) {
    const unsigned G = gridDim.x * gridDim.y * gridDim.z;
    unsigned sum, cnt, mine, sp = 0u;
    for (;;) {
        sum = 0u; cnt = 0u; mine = 0u;
#pragma unroll
        for (unsigned j = 0; j < 16; ++j) { const unsigned c = xb_ld(&bar[XB_XCNT(j)]); sum += c; cnt += (c > 0u) ? 1u : 0u; mine = (j == x) ? c : mine; }
        if (sum == G) break;
        __builtin_amdgcn_s_sleep(1);
        if ((++sp & 255u) == 0u) { if (xb_ld(&bar[XB_TMO])) break; if (sp > XB_SPIN_CAP) { atomicAdd(&bar[XB_TMO], 1u); break; } }
    }
    nloc = mine > 0u ? mine : 1u; nx = cnt > 0u ? cnt : 1u;
}

__device__ __forceinline__ void xcd_barrier(const XcdBarrier& b) {
    asm volatile("s_waitcnt vmcnt(0)" ::: "memory");
    __syncthreads();
    if (threadIdx.x == 0) {
        unsigned* bar = b.bar;
        __builtin_amdgcn_s_waitcnt(0);
        unsigned nloc = b.st[0], nx = b.st[1];
        if (nloc == 0u) { xcd_barrier_complete(bar, b.x, nloc, nx); b.st[0] = nloc; b.st[1] = nx; }
        const unsigned old = xb_add(&bar[XB_XSUB(b.x)], 1u);
        const unsigned gen = old / nloc;
        if (old + 1u == (gen + 1u) * nloc) {
            __builtin_amdgcn_fence(__ATOMIC_RELEASE, "agent");
            asm volatile("s_waitcnt vmcnt(0)" ::: "memory");
            const unsigned og = xb_add(&bar[XB_TOP], 1u);
            const unsigned tg = og / nx;
            if (og + 1u == (tg + 1u) * nx) xb_add(&bar[XB_TOPGEN], 1u);
            else XB_SPIN(xb_ld(&bar[XB_TOPGEN]) == tg, bar);
            __builtin_amdgcn_fence(__ATOMIC_ACQUIRE, "agent");
            xb_add(&bar[XB_XGEN(b.x)], 1u);
            asm volatile("s_waitcnt vmcnt(0)" ::: "memory");
        } else {
            XB_SPIN(xb_ld(&bar[XB_XGEN(b.x)]) == gen, bar);
            __builtin_amdgcn_fence(__ATOMIC_ACQUIRE, "agent");
            asm volatile("s_waitcnt vmcnt(0)" ::: "memory");
        }
    }
    __syncthreads();
}
constexpr int PPL = 15, N_PHASES = 1 + 2 * PPL, SKIP_PHASE = 1 + PPL;
__global__ void __launch_bounds__(NTHREADS, 2) mega_fwd(Args args) {
    extern __shared__ __attribute__((aligned(16))) unsigned char lds_raw[];
    LAS unsigned char* lds = (LAS unsigned char*)lds_raw;
    cg::grid_group grid = cg::this_grid();
    volatile LAS unsigned* MISC = (volatile LAS unsigned*)(lds + LDS_MISC);
    if (threadIdx.x < 16) MISC[threadIdx.x] = 0u;
    __syncthreads();
    XcdBarrier bar = xcd_barrier_post((unsigned*)(args.ws + WS_CTL), MISC + 8);
    bool first_sync = true;
    for (int ph = args.ph_lo; ph < args.ph_hi; ++ph) {
        if (ph == SKIP_PHASE || ph == 1 + PPL + 11 || ph == 1 + PPL + 14 || ph == 1 + 9 || ph == 1 + PPL + 9) continue;
#define TID_DECL int tid_ = threadIdx.x; asm volatile("" : "+v"(tid_)); const int tid = tid_, lane = tid & 63, wave = __builtin_amdgcn_readfirstlane(tid >> 6); (void)tid; (void)lane; (void)wave
        int bid_ = blockIdx.x, nbl_ = gridDim.x; asm volatile("" : "+s"(bid_), "+s"(nbl_)); const int bid = bid_, nbl = nbl_;
        int zo_ = 0; asm volatile("" : "+s"(zo_));
        const ArgsV A_{&args, zo_}; unsigned char* ws = A_.ws();
        XcdBarrier barl = bar; asm volatile("" : "+s"(barl.x), "+s"(barl.bar));
        if (ph == 0) { TID_DECL; mod_phase(A_, lds, bid, nbl, tid, wave, lane); wconv_layer(A_, 0, lds, bid, nbl, wave, lane); }
        else {
            const int l = (ph - 1) / PPL, k = (ph - 1) % PPL;
            if (k == 0) { TID_DECL; phase_rw_a(A_, bid, nbl, wave, lane); }
            else if (k == 1 || k == 12) { const int j = k == 12;
                pg8::Gemm g{(const pg8::bf16_t*)(ws + WS_H), (const pg8::bf16_t*)(ws + WS_W1) + (size_t)j * NW1 * DM, R, NW1, DM}; pg8::TileOrder S; S.init(0, NW1, DM, nbl, bid, 1);
                pg8::EpiSwiGLU E{(pg8::bf16_t*)(ws + WS_BIG), DFFP};
                pg8::gemm_phase<pg8::EpiSwiGLU, pg8::TileOrder, true, true>(lds, g, S, E); }
            else if (k == 2 || k == 13 || k == 10) { const int j = k == 13, sub = k == 2 ? 0 : (k == 10 ? 1 : 2);
                const pg8::bf16_t* A = (const pg8::bf16_t*)(ws + (k == 10 ? WS_H : WS_BIG));
                const pg8::bf16_t* Bt = k == 10 ? (const pg8::bf16_t*)(ws + WS_WOUT) : (const pg8::bf16_t*)(ws + WS_W2) + (size_t)j * DM * DFFP;
                const int K = k == 10 ? DM : DFFP;
                pg8::Gemm g{A, Bt, R, DM, K}; pg8::TileOrder S; S.init(1, DM, K, nbl, bid, 1);
                const bool has_next = !(l == 1 && sub == 2); const int nl = sub == 2 ? l + 1 : l, nsub = sub == 2 ? 0 : sub + 1;
                const float* modb = (const float*)(ws + WS_MOD); unsigned* cntb = (unsigned*)(ws + WS_CTL + 65536) + (size_t)((l * 3 + sub) * 2) * (68 * 64);
                pg8::EpiNormRes E{(l == 0 && sub == 0) ? A_.in(I_X) : (const float*)A_.out(), A_.out(), has_next ? (pg8::bf16_t*)(ws + WS_H) : nullptr,
                                  modb + (size_t)((l * 5) * NMOD + 3 * sub + 2) * DM, A_.in(I_NPOST) + (size_t)(l * 3 + sub) * DM,
                                  A_.in(I_NPRE) + (size_t)((has_next ? nl : 0) * 3 + nsub) * DM, modb + (size_t)(((has_next ? nl : 0) * 5) * NMOD + 3 * nsub + 1) * DM, modb + (size_t)(((has_next ? nl : 0) * 5) * NMOD + 3 * nsub) * DM,
                                  sub == 1 ? 1.0f : 0.5f, pg8::PanelSS{(unsigned*)(ws + WS_MS + MS_X1), cntb}, pg8::PanelSS{(unsigned*)(ws + WS_MS + MS_X2), cntb + 68 * 64}};
                pg8::gemm_phase<pg8::EpiNormRes, pg8::TileOrder, false, true>(lds, g, S, E);
                if (l == 0 || k == 2) { __syncthreads();
                    pg8::TileOrder S2; S2.init(2, DM, K, nbl, bid, k == 10 ? 4 : 11);
                    pg8::EpiSlab E2{(float*)(ws + WS_AUP)};
                    pg8::gemm_phase<pg8::EpiSlab, pg8::TileOrder, true, true>(lds, g, S2, E2); } }
            else if (k == 6) {
                pg8::Gemm g{(const pg8::bf16_t*)(ws + WS_AUP), (const pg8::bf16_t*)(ws + WS_WUP), R, NUP, KUP}; pg8::TileOrder S; S.init(3, NUP, KUP, nbl, bid, 1);
                pg8::EpiStore E{(pg8::bf16_t*)(ws + WS_Y), NUP};
                pg8::gemm_phase<pg8::EpiStore, pg8::TileOrder, true, true>(lds, g, S, E);
                if (k == 6) {
                    __syncthreads();
                    for (int u = bid; u < 512; u += nbl)
                        ml::mlstm_local((const ml::bf16*)(ws + WS_BIG), (const float*)(ws + WS_MS + MS_T), A_.in(I_CW) + (size_t)l * 3 * 1024, A_.in(I_CB) + (size_t)l * 1024,
                                        (float*)(ws + WS_HF), (float*)(ws + WS_MS + MS_NLOC), u, (char*)lds_raw); } }
            else if (k == 3 || k == 11 || k == 14) { TID_DECL; phase_rw_b(A_, l, k == 3 ? 0 : (k == 11 ? 1 : 2), bid, nbl, wave, lane); if (k == 14 && l == 0) wconv_layer(A_, 1, lds, bid, nbl, wave, lane); }
            else if (k == 4) {
                pg8::Gemm g{(const pg8::bf16_t*)(ws + WS_H), (const pg8::bf16_t*)(ws + WS_WIN), R, DINP, DM}; pg8::TileOrder S; S.init(0, DINP, DM, nbl, bid, 1);
                pg8::EpiP E{(pg8::bf16_t*)(ws + WS_BIG), DINP, (float*)(ws + WS_BIG + BIG_G)};
                pg8::gemm_phase<pg8::EpiP, pg8::TileOrder, true, true>(lds, g, S, E); }
            else if (k == 5) { TID_DECL; phase_rw_prep(A_, l, bid, nbl, wave, lane); }
            else if (k == 7 || k == 8) {
                if (k == 7) { TID_DECL; ml::mlstm_scan((const float*)(ws + WS_HF), (const float*)(ws + WS_MS + MS_NLOC), (const float*)(ws + WS_MS + MS_SCA), (ml::bf16*)(ws + WS_AUP), (float*)(ws + WS_MS + MS_NST), (float*)(ws + WS_MS + MS_BM), bid * NTHREADS + tid, nbl * NTHREADS); }
                att::bf16* QKV = (att::bf16*)(ws + WS_Y); const att::bf16* KR = (const att::bf16*)(ws + WS_BIG + BIG_KR);
                const float* tab = (const float*)(ws + WS_TAB);
                int u0, u1;
                if (k == 8) { u0 = bid; u1 = 256; } else { u0 = (l == 0 && bid >= 128) ? 256 + (bid - 128) : 272; u1 = 272; }
                for (int u = u0; u < u1; u += nbl) {
                    int b, h, seq, rope, qtok0; size_t rq;
                    if (u < 256) { b = u >> 6; h = (u >> 4) & 3; const int qb = u & 15; rq = (size_t)b * TB + CTXL + (size_t)qb * 256; seq = TB; rope = 1; qtok0 = qb * 256; }
                    else { b = (u - 256) >> 2; h = (u - 256) & 3; rq = (size_t)b * TB; seq = CTXL; rope = 0; qtok0 = 0; }
                    const size_t r0 = (size_t)b * TB;
                    const int panel = u < 256 ? (b * 16 + (u & 15)) : (64 + b);
                    att::attn_body(QKV + rq * NUP + h * 192, QKV + r0 * NUP + 768 + h * 256, QKV + r0 * NUP + 768 + h * 256 + 128, KR + r0 * 64, (att::bf16*)(ws + WS_H) + rq * DM + h * 128, seq, rope, qtok0, tab, (char*)lds_raw,
                                   (unsigned*)(ws + WS_MS + MS_X1) + rq * 4, (unsigned*)(ws + WS_CTL + 65536) + (size_t)(12 + l) * (68 * 64) + 64 * panel, A_.in(I_AON) + l * 512 + h * 128, h);
                }
                const int m0 = nbl - 1 - bid, m1 = (k == 8) ? 256 : ((l == 0) ? 16 : 0);
                for (int u = m0; u < m1; u += nbl) { const int bh = (k == 8) ? (u >> 4) : u, tbk = (k == 8) ? 1 + (u & 15) : 0;
                    ml::mlstm_out2((const ml::bf16*)(ws + WS_BIG), (const float*)(ws + WS_MS + MS_T), A_.in(I_CW) + (size_t)l * 3 * 1024, A_.in(I_CB) + (size_t)l * 1024, (const ml::bf16*)(ws + WS_AUP),
                                   (const float*)(ws + WS_MS + MS_NST), (const float*)(ws + WS_MS + MS_BM), A_.in(I_MN) + l * 512, (ml::bf16*)(ws + WS_H), bh >> 2, bh & 3, tbk, (char*)lds_raw); }
            }
        }
        if (ph + 1 < args.ph_hi) { if (first_sync) { grid.sync(); first_sync = false; } else xcd_barrier(barl); }
    }
}

#ifndef MK_ONE_LAUNCH
#define MK_ONE_LAUNCH 1
#endif
extern "C" void kernel_launch(void* const* d_in, const int* in_sizes, int n_in, void* d_out, int out_size, void* d_ws, size_t ws_size, hipStream_t stream) {
    static int grid = 0;
    if (grid == 0) {
        if (n_in != 22 || in_sizes[0] != NB * SEQ * DM || out_size != NB * SEQ * DM || ws_size < WS_END) { fprintf(stderr, "kernel_launch: shape/workspace mismatch (n_in %d, in0 %d, out %d, ws %zu need %zu)\n", n_in, n_in > 0 ? in_sizes[0] : -1, out_size, ws_size, (size_t)WS_END); grid = -1; return; }
        int dev = 0, cus = 0, per_cu = 0;
        if (hipGetDevice(&dev) != hipSuccess || hipDeviceGetAttribute(&cus, hipDeviceAttributeMultiprocessorCount, dev) != hipSuccess) { grid = -1; return; }
        if (hipFuncSetAttribute((const void*)mega_fwd, hipFuncAttributeMaxDynamicSharedMemorySize, LDS_BYTES) != hipSuccess) { fprintf(stderr, "kernel_launch: hipFuncSetAttribute failed\n"); grid = -1; return; }
        if (hipOccupancyMaxActiveBlocksPerMultiprocessor(&per_cu, (const void*)mega_fwd, NTHREADS, LDS_BYTES) != hipSuccess || per_cu < 1) { fprintf(stderr, "kernel_launch: occupancy query says %d\n", per_cu); per_cu = 1; }
        (void)hipGetLastError();
        grid = cus * (per_cu > 1 ? 1 : per_cu);
    }
    if (grid < 0) return;
    if (hipMemsetAsync((char*)d_ws + WS_CTL, 0, 65536 + 14 * 68 * 256, stream) != hipSuccess) { fprintf(stderr, "kernel_launch: memset of the barrier words failed\n"); return; }
    Args a{};
    for (int i = 0; i < 22; ++i) a.in[i] = (const float*)d_in[i];
    a.out = (float*)d_out; a.ws = (unsigned char*)d_ws;
#if MK_ONE_LAUNCH
    a.ph_lo = 0; a.ph_hi = N_PHASES;
    void* kargs[] = {&a};
    hipError_t e = hipLaunchCooperativeKernel((const void*)mega_fwd, dim3(grid), dim3(NTHREADS), kargs, LDS_BYTES, stream);
    if (e != hipSuccess) fprintf(stderr, "kernel_launch: cooperative launch failed: %s (grid %d)\n", hipGetErrorString(e), grid);
#else
    for (int ph = 0; ph < N_PHASES; ++ph) { if (ph == SKIP_PHASE) continue; a.ph_lo = ph; a.ph_hi = ph + 1;
        hipLaunchKernelGGL(mega_fwd, dim3(grid), dim3(NTHREADS), LDS_BYTES, stream, a);
        const hipError_t le = hipPeekAtLastError(); if (le != hipSuccess) { fprintf(stderr, "kernel_launch: launch of phase %d failed: %s\n", ph, hipGetErrorName(le)); break; } }
#endif
}
```

```cpp
#include <hip/hip_runtime.h>
#include <hip/hip_cooperative_groups.h>
#include <cstdio>
#include <cstdint>
namespace cg = cooperative_groups;
namespace pg8 {
#define PG8_LAS __attribute__((address_space(3)))
typedef unsigned short bf16_t;
typedef short bf16x8 __attribute__((ext_vector_type(8)));
typedef float f32x4 __attribute__((ext_vector_type(4)));
typedef unsigned u32x4 __attribute__((ext_vector_type(4)));
constexpr int BM = 256, BK = 64, HALF = 128, HTB = HALF * BK * 2  , STAGE_BYTES = 8 * HTB, NXCD = 8, WGM = 8;

__host__ __device__ __forceinline__ int lds_byte(int r, int c) { const int st = (r >> 4) * 2 + (c >> 5), rr = r & 15, cc = c & 31, ob = rr * 64 + cc * 2; return st * 1024 + (ob ^ (((ob >> 9) & 1) << 5)); }
__host__ __device__ __forceinline__ void stage_rc(int b, int& R, int& C) { const int st = b / 1024, sb = b % 1024, swz = sb ^ (((sb >> 9) & 1) << 5); R = (st >> 1) * 16 + swz / 64; C = (st & 1) * 32 + (swz % 64) / 2; }
__host__ __device__ __forceinline__ int perm32(int rho) { const int n = rho >> 4, i = rho & 15; return 8 * (i >> 2) + 4 * n + (i & 3); }

struct Unit { int pm, pn, kt0, nkt; };
struct Gemm { const bf16_t* A; const bf16_t* Bt; int M, N, K; };

struct StaticOrder {
    int nM, nN, nwg, G, c, nkt;
    __host__ __device__ void init(int M, int N, int K, int G_, int c_) { nM = M / BM; nN = N / BM; nwg = nM * nN; G = G_; c = c_; nkt = K / BK; }
    __host__ __device__ bool next(int i, Unit& u) const {
        const long L = (long)i * G + c; if (L >= nwg) return false;
        int wgid = (int)L; { const int q = nwg / NXCD, r = nwg % NXCD, xcd = wgid % NXCD, off = wgid / NXCD; wgid = (xcd < r ? xcd * (q + 1) : r * (q + 1) + (xcd - r) * q) + off; }
        const int nig = WGM * nN, gid = wgid / nig, fm = gid * WGM, gsz = (nM - fm) < WGM ? (nM - fm) : WGM;
        u.pm = fm + ((wgid % nig) % gsz); u.pn = (wgid % nig) / gsz; u.kt0 = 0; u.nkt = nkt; return true;
    }
    __device__ __forceinline__ void a_ready(const Unit&) const {}
    __device__ __forceinline__ void done(const Unit&) const {}
};

__device__ __forceinline__ unsigned cvt_pk_bf16(float lo, float hi) { unsigned r; asm volatile("v_cvt_pk_bf16_f32 %0, %1, %2" : "=v"(r) : "v"(lo), "v"(hi)); return r; }
typedef float f32x2 __attribute__((ext_vector_type(2)));
__device__ __forceinline__ f32x2 gelu_pk(f32x2 v) {
    const f32x2 av = __builtin_elementwise_abs(v), d = av * 0.2316418882f + 1.0f;
    f32x2 t; t.x = __builtin_amdgcn_rcpf(d.x); t.y = __builtin_amdgcn_rcpf(d.y);
    f32x2 q = t * 0.5307027145f + (-0.7265760135f); q = q * t + 0.7107068705f; q = q * t + (-0.142248368f); q = q * t + 0.127414796f; q = q * t;
    const f32x2 s = (v * v) * (-0.72134752044f);
    f32x2 e; e.x = __builtin_amdgcn_exp2f(s.x); e.y = __builtin_amdgcn_exp2f(s.y);
    const f32x2 m = v * (q * e), r = v - m;
    f32x2 o; o.x = v.x < 0.f ? m.x : r.x; o.y = v.y < 0.f ? m.y : r.y; return o;
}
__device__ __forceinline__ float silu_f(float x) { return x * __builtin_amdgcn_rcpf(1.0f + __builtin_amdgcn_exp2f(-1.4426950408889634f * x)); }
__device__ __forceinline__ void st8(bf16_t* p, f32x4 v0, f32x4 v1) { u32x4 w; w.x = cvt_pk_bf16(v0[0], v0[1]); w.y = cvt_pk_bf16(v0[2], v0[3]); w.z = cvt_pk_bf16(v1[0], v1[1]); w.w = cvt_pk_bf16(v1[2], v1[3]); *(u32x4*)p = w; }
struct EpiStore {
    static constexpr bool PERM = true, AFTER_DRAIN = false;
    bf16_t* O; int ldc;
    __device__ __forceinline__ void operator()(const f32x4 (&acc)[2][2][4][2], const Unit& u, int wr, int wc, int fr, int fq) const {
        const int row0 = u.pm * BM + wr * 64 + fr, col0 = u.pn * BM + wc * 32 + 8 * fq;
#pragma unroll
        for (int ai = 0; ai < 2; ++ai)
#pragma unroll
            for (int m = 0; m < 4; ++m) { bf16_t* rowp = O + (size_t)(row0 + ai * HALF + m * 16) * ldc + col0;
#pragma unroll
                for (int bj = 0; bj < 2; ++bj) st8(rowp + bj * HALF, acc[ai][bj][m][0], acc[ai][bj][m][1]); }
    }
};
struct EpiSwiGLU {
    static constexpr bool PERM = true, AFTER_DRAIN = false;
    bf16_t* O; int ldc;
    __device__ __forceinline__ void operator()(const f32x4 (&acc)[2][2][4][2], const Unit& u, int wr, int wc, int fr, int fq) const {
        const int row0 = u.pm * BM + wr * 64 + fr, col0 = u.pn * HALF + wc * 32 + 8 * fq;
#pragma unroll
        for (int ai = 0; ai < 2; ++ai)
#pragma unroll
            for (int m = 0; m < 4; ++m) { bf16_t* rowp = O + (size_t)(row0 + ai * HALF + m * 16) * ldc + col0;
                f32x4 v0, v1;
#pragma unroll
                for (int j = 0; j < 4; ++j) { v0[j] = silu_f(acc[ai][0][m][0][j]) * acc[ai][1][m][0][j]; v1[j] = silu_f(acc[ai][0][m][1][j]) * acc[ai][1][m][1][j]; }
                st8(rowp, v0, v1); }
    }
};
struct EpiP {
    static constexpr bool PERM = true, AFTER_DRAIN = false;
    bf16_t* O; int ldc; float* G;
    __device__ __forceinline__ void operator()(const f32x4 (&acc)[2][2][4][2], const Unit& u, int wr, int wc, int fr, int fq) const {
        const int row0 = u.pm * BM + wr * 64 + fr, col0 = u.pn * BM + wc * 32 + 8 * fq;
        const bool gt = (u.pn == 9) && (wc == 2) && (fq < 2);
#pragma unroll
        for (int ai = 0; ai < 2; ++ai)
#pragma unroll
            for (int m = 0; m < 4; ++m) { const int row = row0 + ai * HALF + m * 16; bf16_t* rowp = O + (size_t)row * ldc + col0;
#pragma unroll
                for (int bj = 0; bj < 2; ++bj) st8(rowp + bj * HALF, acc[ai][bj][m][0], acc[ai][bj][m][1]);
                if (gt) { *(f32x4*)(G + (size_t)row * 16 + 8 * fq) = acc[ai][1][m][0]; *(f32x4*)(G + (size_t)row * 16 + 8 * fq + 4) = acc[ai][1][m][1]; } }
    }
};
struct EpiSlab {
    static constexpr bool PERM = false, AFTER_DRAIN = false;
    float* S;
    __device__ __forceinline__ void operator()(const f32x4 (&acc)[2][2][4][2], const Unit& u, int wr, int wc, int fr, int fq) const {
        const int row0 = (u.pm / 17) * BM + wr * 64 + fr, col0 = u.pn * BM + wc * 32 + 4 * fq; const int slice = u.kt0 / u.nkt;
        float* base = S + (size_t)slice * 1024 * 1024;
#pragma unroll
        for (int ai = 0; ai < 2; ++ai)
#pragma unroll
            for (int m = 0; m < 4; ++m) { float* rowp = base + (size_t)(row0 + ai * HALF + m * 16) * 1024 + col0;
#pragma unroll
                for (int bj = 0; bj < 2; ++bj)
#pragma unroll
                    for (int n = 0; n < 2; ++n) *(f32x4*)(rowp + bj * HALF + n * 16) = acc[ai][bj][m][n]; }
    }
};
struct TileOrder {
    int mode, nM, nN, nwg, G, c, nkt, nsl;
    __device__ void init(int mode_, int N, int K, int G_, int c_, int nsl_) { mode = mode_; nN = N / BM; G = G_; c = c_; nsl = nsl_;
        if (mode == 2) { nM = 4; nwg = 4 * nN * nsl; nkt = (K / BK) / nsl; } else { nM = mode == 1 ? 64 : 68; nwg = nM * nN; nkt = K / BK; } }
    __device__ bool next(int i, Unit& u) const {
        const long L = (long)i * G + c; if (L >= nwg) return false;
        if (mode == 2) { const int sl = (int)L % nsl, t = (int)L / nsl; u.pn = t % nN; u.pm = 17 * (t / nN); u.kt0 = sl * nkt; u.nkt = nkt; return true; }
        int wgid = (int)L; { const int q = nwg / NXCD, r = nwg % NXCD, xcd = wgid % NXCD, off = wgid / NXCD; wgid = (xcd < r ? xcd * (q + 1) : r * (q + 1) + (xcd - r) * q) + off; }
        const int nig = WGM * nN, gid = wgid / nig, fm = gid * WGM, gsz = (nM - fm) < WGM ? (nM - fm) : WGM;
        int pm = fm + ((wgid % nig) % gsz); u.pn = (wgid % nig) / gsz; if (mode == 1) pm += (pm >> 4) + 1;
        u.pm = pm; u.kt0 = 0; u.nkt = nkt;
        if (mode == 3) { if (u.pn < 3) { u.kt0 = 0; u.nkt = 4; } else { u.kt0 = 4; u.nkt = 2; } }
        return true;
    }
    __device__ __forceinline__ void a_ready(const Unit&) const {}
    __device__ __forceinline__ void done(const Unit&) const {}
};

struct PanelSS {
    unsigned* xbuf;
    unsigned* cnt;
    __device__ __forceinline__ void run(const f32x4 (&v)[2][2][4][2], const Unit& u, int wr, int wc, int fr, int fq, PG8_LAS unsigned char* lds, int wid, int lane) const {
        PG8_LAS float* P = (PG8_LAS float*)lds;
        PG8_LAS float* S = (PG8_LAS float*)(lds + 8192);
#pragma unroll
        for (int ai = 0; ai < 2; ++ai)
#pragma unroll
            for (int m = 0; m < 4; ++m) { float s = 0.f;
#pragma unroll
                for (int bj = 0; bj < 2; ++bj)
#pragma unroll
                    for (int n = 0; n < 2; ++n) { const f32x4 x = v[ai][bj][m][n]; s += (x[0] * x[0] + x[1] * x[1]) + (x[2] * x[2] + x[3] * x[3]); }
                s += __shfl_xor(s, 16); s += __shfl_xor(s, 32);
                if (fq == 0) P[(ai * HALF + wr * 64 + m * 16 + fr) * 4 + wc] = s; }
        asm volatile("s_waitcnt lgkmcnt(0)" ::: "memory"); __builtin_amdgcn_s_barrier(); asm volatile("" ::: "memory");
        const int row = wid * 32 + (lane & 31);
        if (lane < 32) { const float t = (P[row * 4 + 0] + P[row * 4 + 1]) + (P[row * 4 + 2] + P[row * 4 + 3]);
            __hip_atomic_store(xbuf + (size_t)(u.pm * BM + row) * 4 + u.pn, __float_as_uint(t), __ATOMIC_RELAXED, __HIP_MEMORY_SCOPE_AGENT); }
        asm volatile("s_waitcnt vmcnt(0)" ::: "memory");
        if (lane == 0) __hip_atomic_fetch_add(cnt + 64 * u.pm, 1u, __ATOMIC_RELAXED, __HIP_MEMORY_SCOPE_AGENT);
        if (wid == 0) { unsigned sp = 0;
            while ((unsigned)__builtin_amdgcn_readfirstlane(__hip_atomic_load(cnt + 64 * u.pm, __ATOMIC_RELAXED, __HIP_MEMORY_SCOPE_AGENT)) < 32u) { __builtin_amdgcn_s_sleep(2); if (++sp > (1u << 22)) break; }
            __builtin_amdgcn_fence(__ATOMIC_ACQUIRE, "agent"); }
        asm volatile("s_waitcnt vmcnt(0) lgkmcnt(0)" ::: "memory"); __builtin_amdgcn_s_barrier(); asm volatile("" ::: "memory");
        if (lane < 32) { const unsigned* slot = xbuf + (size_t)(u.pm * BM + row) * 4; float t = 0.f;
#pragma unroll
            for (int q = 0; q < 4; ++q) t += __uint_as_float(__hip_atomic_load(slot + q, __ATOMIC_RELAXED, __HIP_MEMORY_SCOPE_AGENT));
            S[row] = t; }
        asm volatile("s_waitcnt lgkmcnt(0)" ::: "memory"); __builtin_amdgcn_s_barrier(); asm volatile("" ::: "memory");
    }
};
struct EpiNormRes {
    static constexpr bool PERM = false, AFTER_DRAIN = true;
    const float* xsrc; float* xdst;
    bf16_t* H;
    const float* gate; const float* gpost;
    const float* gpre; const float* sc; const float* sh;
    float wgt; PanelSS st1, st2;
    __device__ __forceinline__ void fused(f32x4 (&acc)[2][2][4][2], const Unit& u, int wr, int wc, int fr, int fq, PG8_LAS unsigned char* lds, int wid, int lane) const {
        const PG8_LAS float* S = (const PG8_LAS float*)(lds + 8192);
        const int b = u.pm / 17, tp = (u.pm - 17 * b - 1) * BM;
        const int col0 = u.pn * BM + wc * 32 + 4 * fq; const size_t mo = (size_t)b * 9 * 1024;
        st1.run(acc, u, wr, wc, fr, fq, lds, wid, lane);
        {   f32x4 cg[2][2];
#pragma unroll
            for (int bj = 0; bj < 2; ++bj)
#pragma unroll
                for (int n = 0; n < 2; ++n) cg[bj][n] = *(const f32x4*)(gate + mo + col0 + bj * HALF + n * 16) * *(const f32x4*)(gpost + col0 + bj * HALF + n * 16) * wgt;
#pragma unroll
            for (int ai = 0; ai < 2; ++ai)
#pragma unroll
                for (int m = 0; m < 4; ++m) { const int r = ai * HALF + wr * 64 + m * 16 + fr; const float rs = 1.0f / sqrtf(S[r] * (1.0f / 1024.0f) + 1e-6f);
                    const size_t off = ((size_t)b * 4096 + tp + r) * 1024 + col0;
#pragma unroll
                    for (int bj = 0; bj < 2; ++bj)
#pragma unroll
                        for (int n = 0; n < 2; ++n) { const f32x4 xo = *(const f32x4*)(xsrc + off + bj * HALF + n * 16); const f32x4 xn = xo + cg[bj][n] * (acc[ai][bj][m][n] * rs);
                            acc[ai][bj][m][n] = xn; *(f32x4*)(xdst + off + bj * HALF + n * 16) = xn; }
                    asm volatile("" : "+v"(acc[ai][0][m][0]), "+v"(acc[ai][0][m][1]), "+v"(acc[ai][1][m][0]), "+v"(acc[ai][1][m][1]));
                    if (m & 1) asm volatile("" ::: "memory"); } }
        if (H == nullptr) return;
        asm volatile("s_waitcnt lgkmcnt(0)" ::: "memory"); __builtin_amdgcn_s_barrier(); asm volatile("" ::: "memory");
        st2.run(acc, u, wr, wc, fr, fq, lds, wid, lane);
        {   typedef unsigned u32x2v __attribute__((ext_vector_type(2)));
            f32x4 ca[2][2], cs[2][2];
#pragma unroll
            for (int bj = 0; bj < 2; ++bj)
#pragma unroll
                for (int n = 0; n < 2; ++n) { const int c = col0 + bj * HALF + n * 16; ca[bj][n] = *(const f32x4*)(gpre + c) * (*(const f32x4*)(sc + mo + c) + 1.0f); cs[bj][n] = *(const f32x4*)(sh + mo + c); }
#pragma unroll
            for (int ai = 0; ai < 2; ++ai)
#pragma unroll
                for (int m = 0; m < 4; ++m) { const int r = ai * HALF + wr * 64 + m * 16 + fr; const float rs = 1.0f / sqrtf(S[r] * (1.0f / 1024.0f) + 1e-6f);
                    bf16_t* hp = H + (size_t)(u.pm * BM + r) * 1024 + col0;
#pragma unroll
                    for (int bj = 0; bj < 2; ++bj)
#pragma unroll
                        for (int n = 0; n < 2; ++n) { const f32x4 o = acc[ai][bj][m][n] * rs * ca[bj][n] + cs[bj][n]; u32x2v w; w.x = cvt_pk_bf16(o[0], o[1]); w.y = cvt_pk_bf16(o[2], o[3]);
                            *(u32x2v*)(hp + bj * HALF + n * 16) = w; } } }
    }
};

template <class Epi, class Sched, bool ALIGN_EPI = false, bool SP2 = false>
__device__ __forceinline__ void gemm_phase(PG8_LAS unsigned char* lds, const Gemm g, const Sched& S, const Epi& E) {
    int tid_ = threadIdx.x; asm volatile("" : "+v"(tid_));
    const int tid = tid_, wid = __builtin_amdgcn_readfirstlane(tid >> 6), lane = tid & 63, wr = wid >> 2, wc = wid & 3, fr = lane & 15, fq = lane >> 4;
    const int K = g.K;
    unsigned voffA[2], voffB[2];
#pragma unroll
    for (int i = 0; i < 2; ++i) { int R, C; stage_rc(tid * 16 + i * 8192, R, C); const int Rb = Epi::PERM ? ((R & ~31) + perm32(R & 31)) : R;
        voffA[i] = (unsigned)(R * K + C) * 2u; voffB[i] = (unsigned)(Rb * K + C) * 2u; }
    const size_t kstep = (size_t)(BK * 2);
    const size_t hstep = (size_t)HALF * K * 2;
    const size_t tstep = 2 * hstep;
    const unsigned ldsw = (unsigned)wid * 1024u;
    const int aoff = lds_byte(wr * 64 + fr, fq * 8), boff = lds_byte(wc * 32 + fr, fq * 8);
#define PG8_SA(b, h) (((b) * 2 + (h)) * HTB)
#define PG8_SB(b, h) ((4 + (b) * 2 + (h)) * HTB)
#define PG8_STAGE(bufoff, gbase, voff) do { _Pragma("unroll") for (int _i = 0; _i < 2; ++_i) \
        __builtin_amdgcn_global_load_lds((const unsigned*)((const char*)(gbase) + (voff)[_i]), (PG8_LAS unsigned*)(lds + (bufoff) + ldsw + _i * 8192), 16, 0, 0); } while (0)
#define PG8_LDA(dst, b, h) do { _Pragma("unroll") for (int m = 0; m < 4; ++m) _Pragma("unroll") for (int k = 0; k < 2; ++k) dst[m][k] = *(const PG8_LAS bf16x8*)(lds + PG8_SA(b, h) + aoff + m * 2048 + k * 1024); } while (0)
#define PG8_LDB(dst, b, h) do { _Pragma("unroll") for (int n = 0; n < 2; ++n) _Pragma("unroll") for (int k = 0; k < 2; ++k) dst[n][k] = *(const PG8_LAS bf16x8*)(lds + PG8_SB(b, h) + boff + n * 2048 + k * 1024); } while (0)
#define PG8_MMA(ai, bj, At, Bt) do { __builtin_amdgcn_s_setprio(1); _Pragma("unroll") for (int m = 0; m < 4; ++m) _Pragma("unroll") for (int n = 0; n < 2; ++n) _Pragma("unroll") for (int k = 0; k < 2; ++k) \
        acc[ai][bj][m][n] = __builtin_amdgcn_mfma_f32_16x16x32_bf16(Bt[n][k], At[m][k], acc[ai][bj][m][n], 0, 0, 0); __builtin_amdgcn_s_setprio(0); } while (0)
#define PG8_WAIT_V(n) asm volatile("s_waitcnt vmcnt(" #n ")" ::: "memory")
#define PG8_WAIT_L(n) asm volatile("s_waitcnt lgkmcnt(" #n ")" ::: "memory")
#define PG8_BAR __builtin_amdgcn_s_barrier()
#define PG8_SCHED __builtin_amdgcn_sched_barrier(0)
    Unit cur, nxt; int ui = 0;
    if (!S.next(0, cur)) return;
    f32x4 acc[2][2][4][2];
#pragma unroll
    for (int a = 0; a < 2; ++a)
#pragma unroll
        for (int b = 0; b < 2; ++b)
#pragma unroll
            for (int m = 0; m < 4; ++m)
#pragma unroll
                for (int n = 0; n < 2; ++n) acc[a][b][m][n] = (f32x4){0.f, 0.f, 0.f, 0.f};
    bf16x8 At[4][2], B0[2][2], B1[2][2];
    const char* cA = (const char*)g.A + (size_t)cur.pm * tstep + (size_t)cur.kt0 * kstep; const char* cB = (const char*)g.Bt + (size_t)cur.pn * tstep + (size_t)cur.kt0 * kstep;
    S.a_ready(cur);
    if constexpr (SP2) {
        PG8_STAGE(PG8_SB(0, 0), cB, voffB); PG8_STAGE(PG8_SB(0, 1), cB + hstep, voffB); PG8_STAGE(PG8_SA(0, 0), cA, voffA); PG8_STAGE(PG8_SA(0, 1), cA + hstep, voffA);
        if (wr == 1) PG8_BAR;
        PG8_WAIT_V(2); PG8_BAR;
        PG8_STAGE(PG8_SB(1, 0), cB + kstep, voffB); PG8_STAGE(PG8_SA(1, 0), cA + kstep, voffA); PG8_STAGE(PG8_SB(1, 1), cB + hstep + kstep, voffB);
        PG8_WAIT_V(6); PG8_BAR;
    } else {
        PG8_STAGE(PG8_SB(0, 0), cB, voffB); PG8_STAGE(PG8_SA(0, 0), cA, voffA); PG8_STAGE(PG8_SB(0, 1), cB + hstep, voffB); PG8_STAGE(PG8_SA(0, 1), cA + hstep, voffA);
        if (wr == 1) PG8_BAR;
        PG8_WAIT_V(4); PG8_BAR;
        PG8_STAGE(PG8_SB(1, 0), cB + kstep, voffB); PG8_STAGE(PG8_SA(1, 0), cA + kstep, voffA); PG8_STAGE(PG8_SB(1, 1), cB + hstep + kstep, voffB);
        PG8_WAIT_V(6); PG8_BAR;
    }
    for (;;) {
        const bool has_next = S.next(ui + 1, nxt);
        const char* nA = has_next ? (const char*)g.A + (size_t)nxt.pm * tstep + (size_t)nxt.kt0 * kstep : cA; const char* nB = has_next ? (const char*)g.Bt + (size_t)nxt.pn * tstep + (size_t)nxt.kt0 * kstep : cB;
        const int nt = cur.nkt;
        for (int t = 0; t < nt; t += 2) {
            const bool last = (t == nt - 2);
            const char* a1 = cA + (size_t)(t + 1) * kstep;
            const char* a2 = last ? nA : cA + (size_t)(t + 2) * kstep; const char* b2 = last ? nB : cB + (size_t)(t + 2) * kstep;
            const char* a3 = a2 + kstep; const char* b3 = b2 + kstep;
            if (last && has_next) S.a_ready(nxt);
            if constexpr (SP2) {
            PG8_LDB(B0, 0, 0); PG8_LDB(B1, 0, 1); PG8_SCHED; PG8_LDA(At, 0, 0); PG8_STAGE(PG8_SA(1, 1), a1 + hstep, voffA);
            PG8_WAIT_V(8); PG8_WAIT_L(0); PG8_BAR; PG8_MMA(0, 0, At, B0); PG8_MMA(0, 1, At, B1); PG8_BAR; PG8_SCHED;
            PG8_LDA(At, 0, 1); PG8_STAGE(PG8_SB(0, 0), b2, voffB); PG8_STAGE(PG8_SB(0, 1), b2 + hstep, voffB); PG8_STAGE(PG8_SA(0, 0), a2, voffA);
            PG8_WAIT_V(8); PG8_WAIT_L(0); PG8_BAR; PG8_MMA(1, 0, At, B0); PG8_MMA(1, 1, At, B1); PG8_BAR; PG8_SCHED;
            PG8_LDB(B0, 1, 0); PG8_LDB(B1, 1, 1); PG8_SCHED; PG8_LDA(At, 1, 0); PG8_STAGE(PG8_SA(0, 1), a2 + hstep, voffA);
            PG8_WAIT_V(8); PG8_WAIT_L(0); PG8_BAR; PG8_MMA(0, 0, At, B0); PG8_MMA(0, 1, At, B1); PG8_BAR; PG8_SCHED;
            PG8_LDA(At, 1, 1); PG8_STAGE(PG8_SB(1, 0), b3, voffB); PG8_STAGE(PG8_SB(1, 1), b3 + hstep, voffB); PG8_STAGE(PG8_SA(1, 0), a3, voffA);
            PG8_WAIT_V(8); PG8_WAIT_L(0); PG8_BAR; PG8_MMA(1, 0, At, B0); PG8_MMA(1, 1, At, B1); PG8_BAR; PG8_SCHED;
            } else {
            PG8_LDB(B0, 0, 0); PG8_SCHED; PG8_LDA(At, 0, 0); PG8_STAGE(PG8_SA(1, 1), a1 + hstep, voffA);
            PG8_WAIT_L(8); PG8_BAR; PG8_WAIT_L(0); PG8_MMA(0, 0, At, B0); PG8_BAR; PG8_SCHED;
            PG8_LDB(B1, 0, 1); PG8_STAGE(PG8_SB(0, 0), b2, voffB);
            PG8_BAR; PG8_WAIT_L(0); PG8_MMA(0, 1, At, B1); PG8_BAR;
            PG8_LDA(At, 0, 1); PG8_STAGE(PG8_SA(0, 0), a2, voffA);
            PG8_BAR; PG8_WAIT_L(0); PG8_MMA(1, 0, At, B0); PG8_BAR; PG8_SCHED;
            PG8_STAGE(PG8_SB(0, 1), b2 + hstep, voffB);
            PG8_WAIT_V(6); PG8_BAR; PG8_MMA(1, 1, At, B1); PG8_BAR;
            PG8_LDB(B0, 1, 0); PG8_SCHED; PG8_LDA(At, 1, 0); PG8_STAGE(PG8_SA(0, 1), a2 + hstep, voffA);
            PG8_WAIT_L(8); PG8_BAR; PG8_WAIT_L(0); PG8_MMA(0, 0, At, B0); PG8_BAR; PG8_SCHED;
            PG8_LDB(B1, 1, 1); PG8_STAGE(PG8_SB(1, 0), b3, voffB);
            PG8_BAR; PG8_WAIT_L(0); PG8_MMA(0, 1, At, B1); PG8_BAR;
            PG8_LDA(At, 1, 1); PG8_STAGE(PG8_SA(1, 0), a3, voffA);
            PG8_BAR; PG8_WAIT_L(0); PG8_MMA(1, 0, At, B0); PG8_BAR; PG8_SCHED;
            PG8_STAGE(PG8_SB(1, 1), b3 + hstep, voffB);
            PG8_WAIT_V(6); PG8_BAR; PG8_MMA(1, 1, At, B1); PG8_BAR;
            }
        }
        if constexpr (ALIGN_EPI) { if (wr == 0) PG8_BAR; }
        if constexpr (!Epi::AFTER_DRAIN) { E(acc, cur, wr, wc, fr, fq); S.done(cur); }
        if (!has_next) break;
#pragma unroll
        for (int a = 0; a < 2; ++a)
#pragma unroll
            for (int b = 0; b < 2; ++b)
#pragma unroll
                for (int m = 0; m < 4; ++m)
#pragma unroll
                    for (int n = 0; n < 2; ++n) acc[a][b][m][n] = (f32x4){0.f, 0.f, 0.f, 0.f};
        cur = nxt; cA = nA; cB = nB; ++ui;
        if constexpr (ALIGN_EPI) { if (wr == 1) PG8_BAR; }
    }
    PG8_WAIT_V(0);
    if constexpr (!ALIGN_EPI) { if (wr == 0) PG8_BAR; }
    PG8_BAR;
    if constexpr (Epi::AFTER_DRAIN) { E.fused(acc, cur, wr, wc, fr, fq, lds, wid, lane); S.done(cur); }
#undef PG8_SA
#undef PG8_SB
#undef PG8_STAGE
#undef PG8_LDA
#undef PG8_LDB
#undef PG8_MMA
#undef PG8_WAIT_V
#undef PG8_WAIT_L
#undef PG8_BAR
#undef PG8_SCHED
}
}
namespace att {
typedef unsigned short bf16;
constexpr int NW = 8, QBLK = 32, KVBLK = 64;
constexpr float SCALE = 0.07216878364870322f;
constexpr float THR = 8.f;
constexpr int SDEPTH = 1;
constexpr int LDQ = 1792, LDK = 1792, LDR = 64, LDO = 1024;
constexpr int SHM_V = KVBLK * 128 * 2, SHM_K = KVBLK * 192 * 2, SHM_QR = NW * 4 * 64 * 16, SHM_ATTN = 2 * SHM_V + 2 * SHM_K + NW * 64 * 4 + SHM_QR;
using bf16x8 = __attribute__((ext_vector_type(8))) short;
using s16x4  = __attribute__((ext_vector_type(4))) short;
using f32x16 = __attribute__((ext_vector_type(16))) float;
using u32x4  = __attribute__((ext_vector_type(4))) unsigned;
#define KSWZ(row, colB) ((row) * 384 + ((colB) ^ ((((row) >> 1) & 7) << 4)))
#define SBAR() __builtin_amdgcn_sched_barrier(0)
__device__ __forceinline__ int crow(int r, int hi) { return (r & 3) + 8 * (r >> 2) + 4 * hi; }
__device__ __forceinline__ unsigned cvtpk(float lo, float hi) { unsigned r; asm volatile("v_cvt_pk_bf16_f32 %0, %1, %2" : "=v"(r) : "v"(lo), "v"(hi)); return r; }
__device__ __forceinline__ bf16x8 ld8(const bf16* p) { return *reinterpret_cast<const bf16x8*>(p); }
__device__ __forceinline__ float bf2f(short b) { return __uint_as_float(((unsigned)(unsigned short)b) << 16); }

__device__ __forceinline__ void partialSM(f32x16& p0, f32x16& p1, float& m_reg, float& mn, float& alpha) {
  constexpr float C = SCALE * 1.4426950408889634f;
  float pmax = p0[0];
#pragma unroll
  for (int r = 1; r < 16; ++r) pmax = fmaxf(pmax, p0[r]);
#pragma unroll
  for (int r = 0; r < 16; ++r) pmax = fmaxf(pmax, p1[r]);
  { auto rr = __builtin_amdgcn_permlane32_swap(__float_as_uint(pmax), __float_as_uint(pmax), false, false);
    pmax = fmaxf(__uint_as_float(rr[0]), __uint_as_float(rr[1])); }
  if (__builtin_expect(__all(pmax - m_reg <= THR / SCALE), 1)) { mn = m_reg; alpha = 1.f; }
  else { mn = fmaxf(m_reg, pmax); alpha = __builtin_amdgcn_exp2f((m_reg - mn) * C); m_reg = mn; }
  float mnC = -mn * C;
#pragma unroll
  for (int r = 0; r < 16; ++r) p0[r] = fmaf(p0[r], C, mnC);
#pragma unroll
  for (int r = 0; r < 16; ++r) p1[r] = fmaf(p1[r], C, mnC);
#pragma unroll
  for (int r = 0; r < 16; ++r) p0[r] = __builtin_amdgcn_exp2f(p0[r]);
}
__device__ __forceinline__ void finishSM(f32x16& p0, f32x16& p1, float alpha, float& l_reg, bf16x8& pa0, bf16x8& pa1, bf16x8& pa2, bf16x8& pa3) {
#pragma unroll
  for (int r = 0; r < 16; ++r) p1[r] = __builtin_amdgcn_exp2f(p1[r]);
  float ps = 0;
#pragma unroll
  for (int r = 0; r < 16; ++r) ps += p0[r];
#pragma unroll
  for (int r = 0; r < 16; ++r) ps += p1[r];
  { auto rr = __builtin_amdgcn_permlane32_swap(__float_as_uint(ps), __float_as_uint(ps), false, false);
    ps = __uint_as_float(rr[0]) + __uint_as_float(rr[1]); }
  l_reg = l_reg * alpha + ps;
#define PK4(P, BASE, OUT) do { unsigned a0 = cvtpk(P[BASE + 0], P[BASE + 1]), a1 = cvtpk(P[BASE + 2], P[BASE + 3]);   \
    unsigned b0 = cvtpk(P[BASE + 4], P[BASE + 5]), b1 = cvtpk(P[BASE + 6], P[BASE + 7]);                              \
    auto r0 = __builtin_amdgcn_permlane32_swap(a0, b0, false, false); auto r1 = __builtin_amdgcn_permlane32_swap(a1, b1, false, false); \
    u32x4 w = {r0[0], r1[0], r0[1], r1[1]}; OUT = *reinterpret_cast<bf16x8*>(&w); } while (0)
  PK4(p0, 0, pa0); PK4(p0, 8, pa1); PK4(p1, 0, pa2); PK4(p1, 8, pa3);
#undef PK4
}
__device__ __forceinline__ void qkt(f32x16& p0, f32x16& p1, const bf16* Ks, const bf16x8 (&qr)[8], const bf16x8* qrl, int r32, int hi) {
  p0 = f32x16{}; p1 = f32x16{};
#pragma unroll
  for (int d0 = 0; d0 < 12; ++d0) { int cb = (d0 * 16 + hi * 8) * 2;
    bf16x8 b0 = *reinterpret_cast<const bf16x8*>((const char*)Ks + KSWZ(r32, cb));
    bf16x8 b1 = *reinterpret_cast<const bf16x8*>((const char*)Ks + KSWZ(32 + r32, cb));
    const bf16x8 qf = d0 < 8 ? qr[d0 < 8 ? d0 : 0] : qrl[(d0 - 8) * 64];
    p0 = __builtin_amdgcn_mfma_f32_32x32x16_bf16(b0, qf, p0, 0, 0, 0);
    p1 = __builtin_amdgcn_mfma_f32_32x32x16_bf16(b1, qf, p1, 0, 0, 0); }
}
__device__ __forceinline__ int v_st(int k, int c) { const int kk = (k & ~0xC) | ((k & 4) << 1) | ((k & 8) >> 1); return ((kk >> 3) * 4 + (c >> 5)) * 512 + ((kk & 7) * 32 + (c & 31)) * 2; }
__device__ __forceinline__ int v_rd_base(int lane) { return ((lane & 3) << 3) | (((lane >> 2) & 3) << 6) | (((lane >> 4) & 1) << 5) | (((lane >> 5) & 1) << 8); }
constexpr int v_rd_off(int d0, int ks, int half) { return d0 * 512 + ks * 4096 + half * 2048; }
template <int OFF> __device__ __forceinline__ s16x4 tr_read(int vb) {
  s16x4 r; asm volatile("ds_read_b64_tr_b16 %0, %1 offset:%2" : "=&v"(r) : "v"(vb), "i"(OFF) : "memory"); return r;
}
template <int D0> __device__ __forceinline__ void pv_one(f32x16& od, int vb, bf16x8 pa0, bf16x8 pa1, bf16x8 pa2, bf16x8 pa3) {
  const s16x4 l0 = tr_read<v_rd_off(D0, 0, 0)>(vb), h0 = tr_read<v_rd_off(D0, 0, 1)>(vb), l1 = tr_read<v_rd_off(D0, 1, 0)>(vb), h1 = tr_read<v_rd_off(D0, 1, 1)>(vb);
  const s16x4 l2 = tr_read<v_rd_off(D0, 2, 0)>(vb), h2 = tr_read<v_rd_off(D0, 2, 1)>(vb), l3 = tr_read<v_rd_off(D0, 3, 0)>(vb), h3 = tr_read<v_rd_off(D0, 3, 1)>(vb);
  asm volatile("s_waitcnt lgkmcnt(0)" ::: "memory"); SBAR();
#define PK(L, H) (bf16x8){L[0], L[1], L[2], L[3], H[0], H[1], H[2], H[3]}
  od = __builtin_amdgcn_mfma_f32_32x32x16_bf16(pa0, PK(l0, h0), od, 0, 0, 0);
  od = __builtin_amdgcn_mfma_f32_32x32x16_bf16(pa1, PK(l1, h1), od, 0, 0, 0);
  od = __builtin_amdgcn_mfma_f32_32x32x16_bf16(pa2, PK(l2, h2), od, 0, 0, 0);
  od = __builtin_amdgcn_mfma_f32_32x32x16_bf16(pa3, PK(l3, h3), od, 0, 0, 0);
#undef PK
}
__device__ __forceinline__ void pv_d0(f32x16 (&o)[4], int vb, bf16x8 pa0, bf16x8 pa1, bf16x8 pa2, bf16x8 pa3) {
  pv_one<0>(o[0], vb, pa0, pa1, pa2, pa3); pv_one<1>(o[1], vb, pa0, pa1, pa2, pa3); pv_one<2>(o[2], vb, pa0, pa1, pa2, pa3); pv_one<3>(o[3], vb, pa0, pa1, pa2, pa3);
}
__device__ __forceinline__ void attn_body(const bf16* __restrict__ Qb, const bf16* __restrict__ Kn, const bf16* __restrict__ Vh, const bf16* __restrict__ Kr,
                                          bf16* __restrict__ Ob, int seq, int rope, int qtok0, const float* __restrict__ tab, char* lds,
                                          unsigned* __restrict__ xs, unsigned* __restrict__ cnt, const float* __restrict__ gain, int head) {
  int tid_ = threadIdx.x; asm volatile("" : "+v"(tid_));
  const int tid = tid_, wid = tid >> 6, lane = tid & 63, r32 = lane & 31, hi = lane >> 5;
  bf16* V_lds = (bf16*)lds; bf16* K_lds = (bf16*)(lds + 2 * SHM_V);
  float* ws = (float*)(lds + 2 * SHM_V + 2 * SHM_K) + wid * 64; float* li_l = ws; float* al_l = ws + 32;
  float m_reg = -1e30f, l_reg = 0; f32x16 o[4] = {}; bf16x8 qr[8]; bf16x8 qx[4];
  bf16x8* qrl = (bf16x8*)(lds + 2 * SHM_V + 2 * SHM_K + NW * 64 * 4) + wid * 256 + lane;
  const bf16* Qw = Qb + (long)(wid * QBLK + r32) * LDQ + hi * 8;
#pragma unroll
  for (int d0 = 0; d0 < 8; ++d0) qr[d0] = ld8(Qw + d0 * 16);
#pragma unroll
  for (int d0 = 0; d0 < 4; ++d0) qx[d0] = ld8(Qw + 128 + d0 * 16);
  if (rope) {
    const int tt = qtok0 + wid * QBLK + r32; const int prow = tt >> 6, pcol = tt & 63;
    const float* tr = tab + (prow * 16 + hi * 8) * 2; const float* tc = tab + (pcol * 16 + hi * 8) * 2;
    unsigned a1[4], a2[4], c1[4], c2[4];
#pragma unroll
    for (int j = 0; j < 8; j += 2) {
      float o1[2], o2[2], p1[2], p2[2];
#pragma unroll
      for (int e = 0; e < 2; ++e) {
        const float cr = tr[(j + e) * 2], sr_ = tr[(j + e) * 2 + 1], cc = tc[(j + e) * 2], sc_ = tc[(j + e) * 2 + 1];
        const float x1 = bf2f(qx[0][j + e]), x2 = bf2f(qx[1][j + e]), y1 = bf2f(qx[2][j + e]), y2 = bf2f(qx[3][j + e]);
        o1[e] = x1 * cr - x2 * sr_; o2[e] = x2 * cr + x1 * sr_; p1[e] = y1 * cc - y2 * sc_; p2[e] = y2 * cc + y1 * sc_; }
      a1[j >> 1] = cvtpk(o1[0], o1[1]); a2[j >> 1] = cvtpk(o2[0], o2[1]); c1[j >> 1] = cvtpk(p1[0], p1[1]); c2[j >> 1] = cvtpk(p2[0], p2[1]); }
    { u32x4 w = {a1[0], a1[1], a1[2], a1[3]}; qx[0] = *reinterpret_cast<bf16x8*>(&w); }
    { u32x4 w = {a2[0], a2[1], a2[2], a2[3]}; qx[1] = *reinterpret_cast<bf16x8*>(&w); }
    { u32x4 w = {c1[0], c1[1], c1[2], c1[3]}; qx[2] = *reinterpret_cast<bf16x8*>(&w); }
    { u32x4 w = {c2[0], c2[1], c2[2], c2[3]}; qx[3] = *reinterpret_cast<bf16x8*>(&w); }
  }
#pragma unroll
  for (int d0 = 0; d0 < 4; ++d0) qrl[d0 * 64] = qx[d0];
  const int sr = tid >> 4, sc = (tid & 15) * 8, vst0 = v_st(sr, sc), vst1 = v_st(32 + sr, sc);
  const int rr = tid >> 3, rc = (tid & 7) * 8;
  const int vb0 = (int)(uintptr_t)V_lds + v_rd_base(lane);
  struct { bf16x8 vs0, vs1, ks0, ks1, kr0; } sr_[SDEPTH];
#define SLOAD(i, k0) do { sr_[i].vs0 = ld8(&Vh[(long)((k0) + sr) * LDK + sc]); sr_[i].vs1 = ld8(&Vh[(long)((k0) + 32 + sr) * LDK + sc]); \
    sr_[i].ks0 = ld8(&Kn[(long)((k0) + sr) * LDK + sc]); sr_[i].ks1 = ld8(&Kn[(long)((k0) + 32 + sr) * LDK + sc]); sr_[i].kr0 = ld8(&Kr[(long)((k0) + rr) * LDR + rc]); } while (0)
#define SWRITE(b, i) do { *(bf16x8*)((char*)V_lds + (b) * SHM_V + vst0) = sr_[i].vs0;          \
    *(bf16x8*)((char*)V_lds + (b) * SHM_V + vst1) = sr_[i].vs1; int kc = sc * 2;               \
    *(bf16x8*)((char*)K_lds + (b) * SHM_K + KSWZ(sr, kc)) = sr_[i].ks0;                       \
    *(bf16x8*)((char*)K_lds + (b) * SHM_K + KSWZ(32 + sr, kc)) = sr_[i].ks1;                  \
    *(bf16x8*)((char*)K_lds + (b) * SHM_K + KSWZ(rr, 256 + rc * 2)) = sr_[i].kr0; } while (0)
#define SWAIT() do { if constexpr (SDEPTH == 2) asm volatile("s_waitcnt vmcnt(5)" ::: "memory"); else asm volatile("s_waitcnt vmcnt(0)" ::: "memory"); } while (0)
#define RESC(a) do { if (__any((a) < 1.f)) { if (hi == 0) al_l[r32] = (a); asm volatile("s_waitcnt lgkmcnt(0)" ::: "memory"); \
    _Pragma("unroll") for (int d = 0; d < 4; ++d) _Pragma("unroll") for (int r = 0; r < 16; ++r) o[d][r] *= al_l[crow(r, hi)]; } } while (0)
  f32x16 pA0, pA1, pB0, pB1; float mnA, mnB, alA, alB; bf16x8 pa0, pa1, pa2, pa3; const int NT = seq / KVBLK;
  constexpr int SE = 0, SO = SDEPTH - 1;
  SLOAD(SE, 0); asm volatile("s_waitcnt vmcnt(0)" ::: "memory"); SWRITE(0, SE); __syncthreads();
  qkt(pA0, pA1, K_lds, qr, qrl, r32, hi); partialSM(pA0, pA1, m_reg, mnA, alA);
  SLOAD(SO, KVBLK); if constexpr (SDEPTH == 2) { if (2 < NT) SLOAD(SE, 2 * KVBLK); }
  SWAIT(); SWRITE(1, SO); __syncthreads();
  for (int j = 1; j + 1 < NT; j += 2) {
    SBAR(); qkt(pB0, pB1, (bf16*)((char*)K_lds + SHM_K), qr, qrl, r32, hi);
    finishSM(pA0, pA1, alA, l_reg, pa0, pa1, pa2, pa3); SBAR();
    SLOAD(SO, (j + SDEPTH) * KVBLK); SBAR();
    pv_d0(o, vb0, pa0, pa1, pa2, pa3); partialSM(pB0, pB1, m_reg, mnB, alB);
    __syncthreads(); SWAIT(); SWRITE(0, SE);
    RESC(alB); __syncthreads();
    SBAR(); qkt(pA0, pA1, K_lds, qr, qrl, r32, hi);
    finishSM(pB0, pB1, alB, l_reg, pa0, pa1, pa2, pa3); SBAR();
    if (SDEPTH == 1 || j + 3 < NT) SLOAD(SE, (j + 1 + SDEPTH) * KVBLK); SBAR();
    pv_d0(o, vb0 + (int)SHM_V, pa0, pa1, pa2, pa3); partialSM(pA0, pA1, m_reg, mnA, alA);
    __syncthreads(); SWAIT(); SWRITE(1, SO);
    RESC(alA); __syncthreads();
  }
  SBAR(); qkt(pB0, pB1, (bf16*)((char*)K_lds + SHM_K), qr, qrl, r32, hi);
  finishSM(pA0, pA1, alA, l_reg, pa0, pa1, pa2, pa3); SBAR();
  pv_d0(o, vb0, pa0, pa1, pa2, pa3); partialSM(pB0, pB1, m_reg, mnB, alB);
  __syncthreads(); RESC(alB);
  finishSM(pB0, pB1, alB, l_reg, pa0, pa1, pa2, pa3); SBAR();
  pv_d0(o, vb0 + (int)SHM_V, pa0, pa1, pa2, pa3);
  if (hi == 0) li_l[r32] = l_reg; asm volatile("s_waitcnt lgkmcnt(0)" ::: "memory");
  float rli[16];
#pragma unroll
  for (int r = 0; r < 16; ++r) rli[r] = __builtin_amdgcn_rcpf(li_l[crow(r, hi)]);
  float rs[16];
#pragma unroll
  for (int r = 0; r < 16; ++r) { float s = 0.f;
#pragma unroll
    for (int d0 = 0; d0 < 4; ++d0) { o[d0][r] *= rli[r]; s += o[d0][r] * o[d0][r]; }
    rs[r] = s; }
#pragma unroll
  for (int x = 1; x < 32; x <<= 1)
#pragma unroll
    for (int r = 0; r < 16; ++r) rs[r] += __shfl_xor(rs[r], x);
  asm volatile("s_waitcnt lgkmcnt(0)" ::: "memory");
  if (r32 == 0) {
#pragma unroll
    for (int r = 0; r < 16; ++r) al_l[crow(r, hi)] = rs[r]; }
  asm volatile("s_waitcnt lgkmcnt(0)" ::: "memory");
  if (lane < 32) __hip_atomic_store(xs + (size_t)(wid * QBLK + lane) * 4 + head, __float_as_uint(al_l[lane]), __ATOMIC_RELAXED, __HIP_MEMORY_SCOPE_AGENT);
  asm volatile("s_waitcnt vmcnt(0)" ::: "memory");
  if (lane == 0) __hip_atomic_fetch_add(cnt, 1u, __ATOMIC_RELAXED, __HIP_MEMORY_SCOPE_AGENT);
  if (wid == 0) { unsigned sp = 0;
    while ((unsigned)__builtin_amdgcn_readfirstlane(__hip_atomic_load(cnt, __ATOMIC_RELAXED, __HIP_MEMORY_SCOPE_AGENT)) < 32u) { __builtin_amdgcn_s_sleep(2); if (++sp > (1u << 22)) break; }
    __builtin_amdgcn_fence(__ATOMIC_ACQUIRE, "agent"); }
  asm volatile("s_waitcnt vmcnt(0) lgkmcnt(0)" ::: "memory"); __syncthreads();
  if (lane < 32) { const unsigned* sl = xs + (size_t)(wid * QBLK + lane) * 4; float t = 0.f;
#pragma unroll
    for (int q = 0; q < 4; ++q) t += __uint_as_float(__hip_atomic_load(sl + q, __ATOMIC_RELAXED, __HIP_MEMORY_SCOPE_AGENT));
    li_l[lane] = 1.0f / sqrtf(t * (1.0f / 512.0f) + 1e-6f); }
  asm volatile("s_waitcnt lgkmcnt(0)" ::: "memory");
  float g4[4];
#pragma unroll
  for (int d0 = 0; d0 < 4; ++d0) g4[d0] = gain[d0 * 32 + r32];
  char* Ol = lds + wid * 8704;
#pragma unroll
  for (int r = 0; r < 16; ++r) { const int orow = crow(r, hi); const float rn = li_l[orow];
#pragma unroll
    for (int d0 = 0; d0 < 4; ++d0) { const float v = o[d0][r] * rn * g4[d0]; *(bf16*)(Ol + orow * 272 + (d0 * 32 + r32) * 2) = (bf16)(cvtpk(v, v) & 0xffffu); } }
  asm volatile("s_waitcnt lgkmcnt(0)" ::: "memory");
  bf16* Ow = Ob + (long)(wid * QBLK) * LDO;
#pragma unroll
  for (int i = 0; i < 8; i += 2) { const int row = (lane >> 4) + 4 * i, c16 = lane & 15;
    const u32x4 w0 = *reinterpret_cast<const u32x4*>(Ol + row * 272 + c16 * 16), w1 = *reinterpret_cast<const u32x4*>(Ol + (row + 4) * 272 + c16 * 16);
    *reinterpret_cast<u32x4*>(Ow + (long)row * LDO + c16 * 8) = w0; *reinterpret_cast<u32x4*>(Ow + (long)(row + 4) * LDO + c16 * 8) = w1;
    asm volatile("" ::: "memory"); }
  __syncthreads();
#undef SLOAD
#undef SWRITE
#undef SWAIT
#undef RESC
}
#undef KSWZ
#undef SBAR
}

namespace ml {
using att::bf16; using att::bf16x8; using att::s16x4; using att::f32x16; using att::u32x4;
typedef float f32x4 __attribute__((ext_vector_type(4)));
using att::crow;
__device__ __forceinline__ unsigned cvtpk(float lo, float hi) { unsigned r; asm("v_cvt_pk_bf16_f32 %0, %1, %2" : "=v"(r) : "v"(lo), "v"(hi)); return r; }
 using att::ld8; using att::bf2f; using att::v_st; using att::v_rd_base; using att::v_rd_off;
constexpr int TBr = 4352, CTXr = 256, SEQr = 4096;
constexpr float LOG2E = 1.4426950408889634f;
constexpr int TSTRIDE = 32 * 17 * 256;
#define MLAS __attribute__((address_space(3)))
__device__ __forceinline__ float log_sigmoid_f(float x) {
    const float t = __expf(-fabsf(x));
    const float l1p = t < 0.03f ? t * (1.0f - t * (0.5f - t * (0.33333334f - 0.25f * t))) : __logf(1.0f + t);
    return fminf(x, 0.f) - l1p;
}
template <int OFF> __device__ __forceinline__ s16x4 trr(int vb) { s16x4 r; asm volatile("ds_read_b64_tr_b16 %0, %1 offset:%2" : "=&v"(r) : "v"(vb), "i"(OFF) : "memory"); return r; }
#define MLPK(L, H) (bf16x8){L[0], L[1], L[2], L[3], H[0], H[1], H[2], H[3]}
__device__ __forceinline__ void unit_rows(int b, int dir, int j, int& rb, int& sg) {
    if (dir == 0) { rb = b * TBr + 256 * j; sg = 1; }
    else { rb = (j == 0) ? b * TBr + 255 : b * TBr + TBr - 1 - 256 * (j - 1); sg = -1; }
}
struct Conv8 { float w0[8], w1[8], w2[8], bb[8]; };
__device__ __forceinline__ void conv8_load(Conv8& cp, const float* __restrict__ cw, const float* __restrict__ cb, int c) {
#pragma unroll
    for (int j = 0; j < 8; ++j) { cp.w0[j] = cw[c + j]; cp.w1[j] = cw[1024 + c + j]; cp.w2[j] = cw[2048 + c + j]; cp.bb[j] = cb[c + j]; }
}
__device__ __forceinline__ void conv8x8(const bf16* __restrict__ P, int r0, int sg, int sr, int c, const Conv8& cp, float scale, bf16x8 (&out)[8]) {
    bf16x8 x0[8], xm[8], xp[8]; float fm[8], fp[8];
#pragma unroll
    for (int g = 0; g < 8; ++g) { const int r = r0 + sg * (32 * g + sr); const int t = r % TBr; const bool hp = (t != 0) && (t != CTXr), hn = (t != CTXr - 1) && (t != TBr - 1);
        const bf16* p = P + (size_t)r * 2560 + 448 + c; x0[g] = ld8(p); xm[g] = ld8(hp ? p - 2560 : p); xp[g] = ld8(hn ? p + 2560 : p); fm[g] = hp ? 1.0f : 0.0f; fp[g] = hn ? 1.0f : 0.0f; }
    asm volatile("" ::: "memory");
#pragma unroll
    for (int g = 0; g < 8; ++g) { float u[8];
#pragma unroll
        for (int j = 0; j < 8; ++j) { const float a = cp.w0[j] * fm[g] * bf2f(xm[g][j]) + cp.w1[j] * bf2f(x0[g][j]) + cp.w2[j] * fp[g] * bf2f(xp[g][j]) + cp.bb[j];
            u[j] = a * __builtin_amdgcn_rcpf(1.0f + __builtin_amdgcn_exp2f(-LOG2E * a)) * scale; }
        u32x4 o = {cvtpk(u[0], u[1]), cvtpk(u[2], u[3]), cvtpk(u[4], u[5]), cvtpk(u[6], u[7])};
        out[g] = *reinterpret_cast<bf16x8*>(&o); }
}
__device__ __forceinline__ void gate_scan_task(const float* __restrict__ G, const float* __restrict__ gate_b, float* __restrict__ T, float* __restrict__ sca, int task, int lane) {
    const int seq = task / 17, j = task - seq * 17, b = seq >> 3, h = (seq >> 1) & 3, dir = seq & 1;
    int rb, sg; unit_rows(b, dir, j, rb, sg);
    const int gi = (2 * dir) * 4 + h, gf = (2 * dir + 1) * 4 + h; const float ib = gate_b[gi], fb = gate_b[gf];
    float igv[4], fgv[4];
#pragma unroll
    for (int rnd = 0; rnd < 4; ++rnd) { const size_t r = (size_t)(rb + sg * (64 * rnd + lane)); igv[rnd] = G[r * 16 + gi] + ib; fgv[rnd] = G[r * 16 + gf] + fb; }
    float cb = 0.f, cpm = -3.0e38f; float* Tb = T + (size_t)task * 256;
#pragma unroll
    for (int rnd = 0; rnd < 4; ++rnd) { const int i = 64 * rnd + lane;
        float bc = log_sigmoid_f(fgv[rnd]);
#pragma unroll
        for (int o = 1; o < 64; o <<= 1) { const float t_ = __shfl_up(bc, o); if (lane >= o) bc += t_; }
        bc += cb;
        const float al = igv[rnd] - bc; float pm = al;
#pragma unroll
        for (int o = 1; o < 64; o <<= 1) { const float t_ = __shfl_up(pm, o); if (lane >= o) pm = fmaxf(pm, t_); }
        pm = fmaxf(pm, cpm);
        Tb[i] = bc; Tb[TSTRIDE + i] = al; Tb[2 * TSTRIDE + i] = pm;
        cb = __shfl(bc, 63); cpm = __shfl(pm, 63); }
    if (j < 16 && lane == 0) { sca[(seq * 16 + j) * 2] = cpm; sca[(seq * 16 + j) * 2 + 1] = cb; }
}
__device__ __forceinline__ void mlstm_local(const bf16* __restrict__ P, const float* __restrict__ T, const float* __restrict__ cw, const float* __restrict__ cbias,
                                            float* __restrict__ Cloc, float* __restrict__ nloc, int unit, char* lds) {
    int tid_ = threadIdx.x; asm volatile("" : "+v"(tid_));
    const int tid = tid_, wid = tid >> 6, lane = tid & 63, r32 = lane & 31, hi = lane >> 5;
    const int seq = unit >> 4, j = unit & 15, b = seq >> 3, h = (seq >> 1) & 3, dir = seq & 1;
    int rb, sg; unit_rows(b, dir, j, rb, sg);
    const float* Tal = T + TSTRIDE + (size_t)(seq * 17 + j) * 256; const float mlm = T[2 * TSTRIDE + (size_t)(seq * 17 + j) * 256 + 255];
    float* npart = (float*)(lds + 131072);
    const int sr = tid >> 4, sc = (tid & 15) * 8;
    float wv[8]; bf16x8 vreg[8];
#pragma unroll
    for (int g = 0; g < 8; ++g) { const int i = 32 * g + sr; wv[g] = Tal[i]; vreg[g] = ld8(P + (size_t)(rb + sg * i) * 2560 + 1472 + h * 128 + sc); }
    asm volatile("" ::: "memory");
    float nacc[8] = {0.f, 0.f, 0.f, 0.f, 0.f, 0.f, 0.f, 0.f};
    { Conv8 cp; conv8_load(cp, cw, cbias, 512 + h * 128 + sc);
      bf16x8 kv[8]; conv8x8(P, rb, sg, sr, 512 + h * 128 + sc, cp, 0.08838834764831845f, kv);
#pragma unroll
      for (int g = 0; g < 8; ++g) { const int i = 32 * g + sr; *(bf16x8*)(lds + (i >> 6) * 16384 + v_st(i & 63, sc)) = kv[g]; wv[g] = __expf(wv[g] - mlm);
#pragma unroll
          for (int x = 0; x < 8; ++x) nacc[x] += wv[g] * bf2f(kv[g][x]); } }
#pragma unroll
    for (int g = 0; g < 8; ++g) { const int i = 32 * g + sr; const float w = wv[g]; const bf16x8 v = vreg[g];
        u32x4 o = {cvtpk(bf2f(v[0]) * w, bf2f(v[1]) * w), cvtpk(bf2f(v[2]) * w, bf2f(v[3]) * w), cvtpk(bf2f(v[4]) * w, bf2f(v[5]) * w), cvtpk(bf2f(v[6]) * w, bf2f(v[7]) * w)};
        *(u32x4*)(lds + 65536 + (i >> 6) * 16384 + v_st(i & 63, sc)) = o; }
#pragma unroll
    for (int x = 0; x < 8; ++x) { nacc[x] += __shfl_xor(nacc[x], 16); nacc[x] += __shfl_xor(nacc[x], 32); }
    if (lane < 16) {
#pragma unroll
        for (int x = 0; x < 8; ++x) npart[wid * 128 + sc + x] = nacc[x]; }
    __syncthreads();
    const int db = wid >> 1, eb0 = 2 * (wid & 1);
    const int vbK = (int)(uintptr_t)lds + v_rd_base(lane) + db * 512, vbV = (int)(uintptr_t)lds + 65536 + v_rd_base(lane) + eb0 * 512;
    f32x16 c0 = {}, c1 = {};
#define MLA_STEP(TL, KS) do { const s16x4 al_ = trr<(TL) * 16384 + v_rd_off(0, KS, 0)>(vbK), ah_ = trr<(TL) * 16384 + v_rd_off(0, KS, 1)>(vbK); \
        const s16x4 bl0 = trr<(TL) * 16384 + v_rd_off(0, KS, 0)>(vbV), bh0 = trr<(TL) * 16384 + v_rd_off(0, KS, 1)>(vbV), bl1 = trr<(TL) * 16384 + v_rd_off(1, KS, 0)>(vbV), bh1 = trr<(TL) * 16384 + v_rd_off(1, KS, 1)>(vbV); \
        asm volatile("s_waitcnt lgkmcnt(0)" ::: "memory"); __builtin_amdgcn_sched_barrier(0); \
        c0 = __builtin_amdgcn_mfma_f32_32x32x16_bf16(MLPK(al_, ah_), MLPK(bl0, bh0), c0, 0, 0, 0); c1 = __builtin_amdgcn_mfma_f32_32x32x16_bf16(MLPK(al_, ah_), MLPK(bl1, bh1), c1, 0, 0, 0); } while (0)
#define MLA_TILE(TL) do { MLA_STEP(TL, 0); MLA_STEP(TL, 1); MLA_STEP(TL, 2); MLA_STEP(TL, 3); } while (0)
    MLA_TILE(0); MLA_TILE(1); MLA_TILE(2); MLA_TILE(3);
#undef MLA_TILE
#undef MLA_STEP
    float* Co = Cloc + (size_t)unit * 16384;
#pragma unroll
    for (int r = 0; r < 16; ++r) { const int d = db * 32 + crow(r, hi); Co[d * 128 + eb0 * 32 + r32] = c0[r]; Co[d * 128 + eb0 * 32 + 32 + r32] = c1[r]; }
    if (tid < 128) { float s = 0.f;
#pragma unroll
        for (int w = 0; w < 8; ++w) s += npart[w * 128 + tid];
        nloc[unit * 128 + tid] = s; }
    __syncthreads();
}
__device__ __forceinline__ void mlstm_scan(const float* __restrict__ Cloc, const float* __restrict__ nloc, const float* __restrict__ sca, bf16* __restrict__ CstT, float* __restrict__ nst, float* __restrict__ bm, int gtid, int gthreads) {
    for (int item = gtid; item < 32 * 2048; item += gthreads) {
        const int seq = item >> 11, rem = item & 2047, e = rem & 127, dg = rem >> 7;
        float st[8] = {0.f, 0.f, 0.f, 0.f, 0.f, 0.f, 0.f, 0.f}; float nv = 0.f, Bst = 0.f, Mst = 0.f;
        asm volatile("" : "+v"(Bst), "+v"(Mst));
        const float* Cl0 = Cloc + (size_t)(seq * 16) * 16384 + (dg * 8) * 128 + e;
        for (int half = 0; half < 2; ++half) {
            float cl[8][8], nlv[8], mlv[8], blv[8];
#pragma unroll
            for (int jj = 0; jj < 8; ++jj) { const int lu = seq * 16 + half * 8 + jj;
#pragma unroll
                for (int i = 0; i < 8; ++i) cl[jj][i] = Cl0[(size_t)(half * 8 + jj) * 16384 + i * 128];
                nlv[jj] = nloc[lu * 128 + e]; mlv[jj] = sca[lu * 2]; blv[jj] = sca[lu * 2 + 1]; }
#pragma unroll
            for (int jj = 0; jj < 8; ++jj) { const int j = half * 8 + jj; const size_t su = (size_t)seq * 17 + j;
                u32x4 o = {cvtpk(st[0], st[1]), cvtpk(st[2], st[3]), cvtpk(st[4], st[5]), cvtpk(st[6], st[7])};
                *(u32x4*)(CstT + su * 16384 + e * 128 + dg * 8) = o;
                if (dg == 0) { nst[su * 128 + e] = nv; if (e == 0) { bm[su * 2] = Bst; bm[su * 2 + 1] = Mst; } }
                const float Mend = fmaxf(Mst, mlv[jj] - Bst), fa = __expf(Mst - Mend), fbv = __expf(mlv[jj] - Bst - Mend);
#pragma unroll
                for (int i = 0; i < 8; ++i) st[i] = fa * st[i] + fbv * cl[jj][i];
                nv = fa * nv + fbv * nlv[jj];
                Bst += blv[jj]; Mst = Mend; }
        }
        { const size_t su = (size_t)seq * 17 + 16;
          u32x4 o = {cvtpk(st[0], st[1]), cvtpk(st[2], st[3]), cvtpk(st[4], st[5]), cvtpk(st[6], st[7])};
          *(u32x4*)(CstT + su * 16384 + e * 128 + dg * 8) = o;
          if (dg == 0) { nst[su * 128 + e] = nv; if (e == 0) { bm[su * 2] = Bst; bm[su * 2 + 1] = Mst; } } }
    }
}
#define KSW(row, colB) ((row) * 256 + ((colB) ^ (((row) & 15) << 4)))
template <int D0, int KS> __device__ __forceinline__ void pv_pair(f32x16& od, int vb, bf16x8 pa, bf16x8 pb) {
    const s16x4 l0 = trr<v_rd_off(D0, KS, 0)>(vb), h0 = trr<v_rd_off(D0, KS, 1)>(vb), l1 = trr<v_rd_off(D0, KS + 1, 0)>(vb), h1 = trr<v_rd_off(D0, KS + 1, 1)>(vb);
    asm volatile("s_waitcnt lgkmcnt(0)" ::: "memory"); __builtin_amdgcn_sched_barrier(0);
    od = __builtin_amdgcn_mfma_f32_32x32x16_bf16(pa, MLPK(l0, h0), od, 0, 0, 0);
    od = __builtin_amdgcn_mfma_f32_32x32x16_bf16(pb, MLPK(l1, h1), od, 0, 0, 0);
}
__device__ __forceinline__ void mlstm_out2(const bf16* __restrict__ P, const float* __restrict__ T, const float* __restrict__ cw, const float* __restrict__ cbias, const bf16* __restrict__ CstT, const float* __restrict__ nst,
                                           const float* __restrict__ bm, const float* __restrict__ mnorm, bf16* __restrict__ MIX, int b, int h, int tb, char* lds) {
    int tid_ = threadIdx.x; asm volatile("" : "+v"(tid_));
    const int tid = tid_, wid = tid >> 6, lane = tid & 63, r32 = lane & 31, hi = lane >> 5;
    const int seqf = b * 8 + h * 2, seqb = seqf + 1; const int jb = tb == 0 ? 0 : 17 - tb; const bool zs = (tb == 0);
    const size_t suf = (size_t)seqf * 17 + tb, sub = (size_t)seqb * 17 + jb;
    const int rb = b * TBr + 256 * tb;
    float* tabs = (float*)(lds + 131072);
    float* nlf = tabs + 2048; float* nlb = tabs + 2176; float* wsc = tabs + 2304 + wid * 32;
    const int sr = tid >> 4, sc = (tid & 15) * 8;
    {   Conv8 cp; conv8_load(cp, cw, cbias, 512 + h * 128 + sc);
        bf16x8 kv[8]; conv8x8(P, rb, 1, sr, 512 + h * 128 + sc, cp, 0.08838834764831845f, kv);
#pragma unroll
        for (int g = 0; g < 8; ++g) { const int i = 32 * g + sr; *(bf16x8*)(lds + KSW(i, sc * 2)) = kv[g]; } }
    {   Conv8 cp; conv8_load(cp, cw, cbias, h * 128 + sc);
        bf16x8 qv[8]; conv8x8(P, rb, 1, sr, h * 128 + sc, cp, 1.0f, qv);
#pragma unroll
        for (int g = 0; g < 8; ++g) { const int i = 32 * g + sr; *(bf16x8*)(lds + 65536 + KSW(i, sc * 2)) = qv[g]; } }
    bf16x8 vreg[8];
#pragma unroll
    for (int g = 0; g < 8; ++g) vreg[g] = ld8(P + (size_t)(rb + 32 * g + sr) * 2560 + 1472 + h * 128 + sc);
    asm volatile("" ::: "memory");
    {
        const int dir = tid >> 8, n = tid & 255; const size_t su = dir ? sub : suf; const size_t ti = su * 256 + (dir ? 255 - n : n);
        const float bl = T[ti], al = T[TSTRIDE + ti], pm = T[2 * TSTRIDE + ti]; float Bst = 0.f, Mst = 0.f; if (!zs) { Bst = bm[su * 2]; Mst = bm[su * 2 + 1]; }
        float* tb_ = tabs + dir * 1024; const float M = fmaxf(Mst, pm - Bst);
        tb_[n] = __expf(-(Bst + bl + M)); tb_[256 + n] = (al - Bst) * LOG2E; tb_[512 + n] = M * LOG2E; tb_[768 + n] = __expf(Mst - M); }
    if (wid == 2) { nlf[lane] = zs ? 0.f : nst[suf * 128 + lane]; nlf[64 + lane] = zs ? 0.f : nst[suf * 128 + 64 + lane]; }
    if (wid == 3) { nlb[lane] = zs ? 0.f : nst[sub * 128 + lane]; nlb[64 + lane] = zs ? 0.f : nst[sub * 128 + 64 + lane]; }
    __syncthreads();
    bf16x8 qr[8];
#pragma unroll
    for (int d0 = 0; d0 < 8; ++d0) qr[d0] = *reinterpret_cast<const bf16x8*>(lds + 65536 + KSW(wid * 32 + r32, (d0 * 16 + hi * 8) * 2));
    asm volatile("s_waitcnt lgkmcnt(0)" ::: "memory");
    __syncthreads();
#pragma unroll
    for (int g = 0; g < 8; ++g) { const int i = 32 * g + sr; *(bf16x8*)(lds + 65536 + (i >> 6) * 16384 + v_st(i & 63, sc)) = vreg[g]; }
    __syncthreads();
    const int qi = wid * 32 + r32;
    float qnf = 0.f, qnb = 0.f;
#pragma unroll
    for (int d0 = 0; d0 < 8; ++d0) {
#pragma unroll
        for (int jj = 0; jj < 8; ++jj) { const float qv = bf2f(qr[d0][jj]); qnf += qv * nlf[d0 * 16 + hi * 8 + jj]; qnb += qv * nlb[d0 * 16 + hi * 8 + jj]; }
        asm volatile("" : "+v"(qnf), "+v"(qnb)); }
    { auto rr = __builtin_amdgcn_permlane32_swap(__float_as_uint(qnf), __float_as_uint(qnf), false, false); qnf = __uint_as_float(rr[0]) + __uint_as_float(rr[1]); }
    { auto rr = __builtin_amdgcn_permlane32_swap(__float_as_uint(qnb), __float_as_uint(qnb), false, false); qnb = __uint_as_float(rr[0]) + __uint_as_float(rr[1]); }
    const int vb0 = (int)(uintptr_t)lds + 65536 + v_rd_base(lane);
    const int dtile = wid >> 1;
    unsigned hfp[32];
#define ML_PK4(Pv, BASE, OUT) do { unsigned a0 = cvtpk(Pv[BASE + 0], Pv[BASE + 1]), a1 = cvtpk(Pv[BASE + 2], Pv[BASE + 3]);   \
    unsigned b0_ = cvtpk(Pv[BASE + 4], Pv[BASE + 5]), b1_ = cvtpk(Pv[BASE + 6], Pv[BASE + 7]);                              \
    auto r0 = __builtin_amdgcn_permlane32_swap(a0, b0_, false, false); auto r1 = __builtin_amdgcn_permlane32_swap(a1, b1_, false, false); \
    u32x4 w = {r0[0], r1[0], r0[1], r1[1]}; OUT = *reinterpret_cast<bf16x8*>(&w); } while (0)
#pragma unroll
    for (int dir = 0; dir < 2; ++dir) {
        const float* tb_ = tabs + dir * 1024; const size_t su = dir ? sub : suf;
        f32x16 o[4];
        if (zs) { o[0] = f32x16{}; o[1] = f32x16{}; o[2] = f32x16{}; o[3] = f32x16{}; }
        else { const bf16* Cb = CstT + su * 16384 + (size_t)r32 * 128 + hi * 8;
#pragma unroll
          for (int ep = 0; ep < 2; ++ep) { bf16x8 cf[16];
#pragma unroll
              for (int x = 0; x < 16; ++x) cf[x] = ld8(Cb + (2 * ep + (x >> 3)) * 32 * 128 + (x & 7) * 16);
              f32x16 a0 = {}, a1 = {};
#pragma unroll
              for (int d0 = 0; d0 < 8; ++d0) { a0 = __builtin_amdgcn_mfma_f32_32x32x16_bf16(qr[d0], cf[d0], a0, 0, 0, 0); a1 = __builtin_amdgcn_mfma_f32_32x32x16_bf16(qr[d0], cf[8 + d0], a1, 0, 0, 0); }
              o[2 * ep] = a0; o[2 * ep + 1] = a1; }
#pragma unroll
          for (int r = 0; r < 16; ++r) { const float isc = tb_[768 + wid * 32 + crow(r, hi)];
#pragma unroll
              for (int eb = 0; eb < 4; ++eb) o[eb][r] *= isc; } }
        const float qn = dir ? qnb : qnf;
        const float m2q = tb_[512 + qi]; float dsum = 0.f;
        const int kt0 = dir ? dtile : 0, kt1 = dir ? 4 : dtile + 1;
        for (int kt = kt0; kt < kt1; ++kt) {
            const char* Ks = lds + kt * 64 * 256; const bool diag = (kt == dtile); const int vb = vb0 + kt * 16384;
#pragma unroll
            for (int hh = 0; hh < 2; ++hh) {
                f32x16 p = {}, p2 = {};
#pragma unroll
                for (int d0 = 0; d0 < 8; d0 += 2) { const int cb = (d0 * 16 + hi * 8) * 2;
                    const bf16x8 b0 = *reinterpret_cast<const bf16x8*>(Ks + KSW(32 * hh + r32, cb)), b1 = *reinterpret_cast<const bf16x8*>(Ks + KSW(32 * hh + r32, cb + 32));
                    p = __builtin_amdgcn_mfma_f32_32x32x16_bf16(b0, qr[d0], p, 0, 0, 0); p2 = __builtin_amdgcn_mfma_f32_32x32x16_bf16(b1, qr[d0 + 1], p2, 0, 0, 0); }
                p += p2;
#pragma unroll
                for (int g4 = 0; g4 < 4; ++g4) { const int sb = kt * 64 + 32 * hh + 8 * g4 + 4 * hi;
                    const f32x4 a4 = *(const f32x4*)(tb_ + 256 + sb);
#pragma unroll
                    for (int x = 0; x < 4; ++x) { const int r = 4 * g4 + x, s0 = sb + x;
                        float w0 = __builtin_amdgcn_exp2f(a4[x] - m2q);
                        if (diag) { if (dir ? (s0 < qi) : (s0 > qi)) w0 = 0.f; }
                        p[r] *= w0; dsum += p[r]; } }
                bf16x8 pa, pb;
                ML_PK4(p, 0, pa); ML_PK4(p, 8, pb);
                if (hh == 0) { pv_pair<0, 0>(o[0], vb, pa, pb); pv_pair<1, 0>(o[1], vb, pa, pb); pv_pair<2, 0>(o[2], vb, pa, pb); pv_pair<3, 0>(o[3], vb, pa, pb); }
                else         { pv_pair<0, 2>(o[0], vb, pa, pb); pv_pair<1, 2>(o[1], vb, pa, pb); pv_pair<2, 2>(o[2], vb, pa, pb); pv_pair<3, 2>(o[3], vb, pa, pb); }
            }
        }
        { auto rr = __builtin_amdgcn_permlane32_swap(__float_as_uint(dsum), __float_as_uint(dsum), false, false); dsum = __uint_as_float(rr[0]) + __uint_as_float(rr[1]); }
        const float den = dsum + tb_[768 + qi] * qn; const float rd = 1.0f / fmaxf(fabsf(den), tb_[qi]);
        if (hi == 0) wsc[r32] = rd; asm volatile("s_waitcnt lgkmcnt(0)" ::: "memory");
        if (dir == 0) {
#pragma unroll
            for (int r = 0; r < 16; r += 2) { const float ra = wsc[crow(r, hi)], rb_ = wsc[crow(r + 1, hi)];
#pragma unroll
                for (int eb = 0; eb < 4; ++eb) hfp[eb * 8 + (r >> 1)] = cvtpk(o[eb][r] * ra, o[eb][r + 1] * rb_); }
            asm volatile("s_waitcnt lgkmcnt(0)" ::: "memory");
        } else {
            float rdr[16];
#pragma unroll
            for (int r = 0; r < 16; ++r) rdr[r] = wsc[crow(r, hi)];
            bf16x8 og8[8];
            { const bf16* ogp = P + (size_t)(rb + wid * 32 + r32) * 2560 + 1984 + h * 128 + 64 * hi;
#pragma unroll
              for (int c8 = 0; c8 < 8; ++c8) og8[c8] = ld8(ogp + 8 * c8); }
            __syncthreads();
            float* W = (float*)(lds + wid * 16896);
#pragma unroll
            for (int r = 0; r < 16; ++r)
#pragma unroll
                for (int eb = 0; eb < 4; ++eb) { const unsigned pk = hfp[eb * 8 + (r >> 1)]; const float hf = (r & 1) ? __uint_as_float(pk & 0xffff0000u) : __uint_as_float(pk << 16);
                    W[crow(r, hi) * 132 + eb * 32 + r32] = hf + o[eb][r] * rdr[r]; }
            asm volatile("s_waitcnt lgkmcnt(0)" ::: "memory");
            const int tok = r32, eh = hi; const size_t row = (size_t)(rb + wid * 32 + tok);
            const float* mg = mnorm + h * 128 + 64 * eh;
            float v[64]; float s = 0.f;
#pragma unroll
            for (int c8 = 0; c8 < 8; ++c8) { const bf16x8 g8 = og8[c8]; const f32x4 w0 = *(const f32x4*)(W + tok * 132 + 64 * eh + 8 * c8), w1 = *(const f32x4*)(W + tok * 132 + 64 * eh + 8 * c8 + 4);
                const float hv[8] = {w0.x, w0.y, w0.z, w0.w, w1.x, w1.y, w1.z, w1.w};
#pragma unroll
                for (int x = 0; x < 8; ++x) { const float vv = hv[x] * __builtin_amdgcn_rcpf(1.0f + __builtin_amdgcn_exp2f(-LOG2E * bf2f(g8[x]))); v[8 * c8 + x] = vv; s += vv; } }
            { auto rr = __builtin_amdgcn_permlane32_swap(__float_as_uint(s), __float_as_uint(s), false, false); s = __uint_as_float(rr[0]) + __uint_as_float(rr[1]); }
            const float mu = s * (1.0f / 128.0f); float q = 0.f;
#pragma unroll
            for (int x = 0; x < 64; ++x) { v[x] -= mu; q += v[x] * v[x]; }
            { auto rr = __builtin_amdgcn_permlane32_swap(__float_as_uint(q), __float_as_uint(q), false, false); q = __uint_as_float(rr[0]) + __uint_as_float(rr[1]); }
            const float rstd = 1.0f / sqrtf(q * (1.0f / 128.0f) + 1e-6f);
            bf16* orow = MIX + row * 1024 + 512 + h * 128 + 64 * eh;
#pragma unroll
            for (int c8 = 0; c8 < 8; ++c8) { const f32x4 g0 = *(const f32x4*)(mg + 8 * c8), g1 = *(const f32x4*)(mg + 8 * c8 + 4);
                u32x4 ov = {cvtpk(v[8 * c8] * rstd * g0.x, v[8 * c8 + 1] * rstd * g0.y), cvtpk(v[8 * c8 + 2] * rstd * g0.z, v[8 * c8 + 3] * rstd * g0.w),
                            cvtpk(v[8 * c8 + 4] * rstd * g1.x, v[8 * c8 + 5] * rstd * g1.y), cvtpk(v[8 * c8 + 6] * rstd * g1.z, v[8 * c8 + 7] * rstd * g1.w)};
                *(u32x4*)(orow + 8 * c8) = ov; }
        }
    }
#undef ML_PK4
    __syncthreads();
}
#undef KSW
#undef MLPK
#undef MLAS
}

#define LAS __attribute__((address_space(3)))
typedef unsigned short bf16;
typedef float f32x4 __attribute__((ext_vector_type(4)));
typedef unsigned u32x4 __attribute__((ext_vector_type(4)));
typedef unsigned u32x2 __attribute__((ext_vector_type(2)));
typedef short bf16x8 __attribute__((ext_vector_type(8)));
constexpr int NWAVES = 8, NTHREADS = 512;
constexpr int DM = 1024, NB = 4, SEQ = 4096, CTXL = 256, TB = SEQ + CTXL  , R = NB * TB  ;
constexpr int DFF = 2752, DFFP = 2816, NW1 = 2 * DFFP  , DIN = 2512, DINP = 2560, KUP = 384, NUP = 1792;
constexpr int NMOD = 9;
constexpr float EPS = 1e-6f;
constexpr size_t MiB = 1u << 20;
constexpr size_t WS_CTL = 0, CTL_BYTES = 1 * MiB;
constexpr size_t WS_MOD = 1 * MiB;
constexpr size_t WS_TAB = WS_MOD + 512 * 1024;
constexpr size_t WS_W1 = 2 * MiB;
constexpr size_t WS_W2 = WS_W1 + (size_t)2 * NW1 * DM * 2;
constexpr size_t WS_WIN = WS_W2 + (size_t)2 * DM * DFFP * 2;
constexpr size_t WS_WUP = WS_WIN + (size_t)DINP * DM * 2;
constexpr size_t WS_WOUT = WS_WUP + (size_t)NUP * KUP * 2;
constexpr size_t WS_XC = WS_WOUT + (size_t)DM * DM * 2;
constexpr size_t WS_H = WS_XC + (size_t)NB * CTXL * DM * 4;
constexpr size_t WS_BIG = WS_H + (size_t)R * DM * 2;
constexpr size_t BIG_KR = (size_t)R * DINP * 2;
constexpr size_t BIG_G = BIG_KR + (size_t)R * 64 * 2;
constexpr size_t WS_Y = WS_BIG + (size_t)R * DFFP * 2;
constexpr size_t WS_Q = WS_Y + (size_t)R * DM * 2;
constexpr size_t WS_AUP = WS_Q + (size_t)R * 768 * 2;
constexpr size_t WS_HF = WS_AUP + (size_t)R * 512 * 2;
constexpr size_t WS_HB = WS_HF + (size_t)R * 512 * 2;
constexpr size_t WS_MS = WS_HB + (size_t)R * 512 * 2;
constexpr size_t MS_NLOC = 0, MS_SCA = 262144, MS_NST = 266240, MS_BM = 544768;
constexpr size_t MS_X1 = 3u << 20, MS_X2 = (3u << 20) + (512u << 10);
constexpr size_t MS_T = 1u << 20;
constexpr size_t WS_END = WS_MS + 4 * MiB;
static_assert(BIG_G + (size_t)R * 16 * 4 <= (size_t)R * DFFP * 2, "P + KR + G fit the hidden region");
static_assert(WS_W1 % 256 == 0 && WS_W2 % 256 == 0 && WS_WIN % 256 == 0 && WS_WUP % 256 == 0 && WS_WOUT % 256 == 0 && WS_XC % 256 == 0 && WS_H % 256 == 0 && WS_BIG % 256 == 0 && WS_Y % 256 == 0 && WS_Q % 256 == 0 && WS_AUP % 256 == 0 && WS_HF % 256 == 0, "alignment");
static_assert(WS_END <= 305u * MiB, "workspace budget");
constexpr int LDS_BYTES = 147456, LDS_MISC = 143360;

#define LDS_WAIT() asm volatile("s_waitcnt lgkmcnt(0)" ::: "memory")
__device__ __forceinline__ unsigned f2bf(float f) { unsigned u = __builtin_bit_cast(unsigned, f); return (u + 0x7fffu + ((u >> 16) & 1u)) >> 16; }
__device__ __forceinline__ unsigned pk2(float lo, float hi) { return f2bf(lo) | (f2bf(hi) << 16); }
__device__ __forceinline__ float bflo(unsigned w) { return __uint_as_float(w << 16); }
__device__ __forceinline__ float bfhi(unsigned w) { return __uint_as_float(w & 0xffff0000u); }
__device__ __forceinline__ float bf1(bf16 b) { return __uint_as_float(((unsigned)b) << 16); }
__device__ __forceinline__ float wave_sum(float v) {
#pragma unroll
    for (int o = 1; o < 64; o <<= 1) v += __shfl_xor(v, o);
    return v;
}
__device__ __forceinline__ float sigmoid_f(float x) { return __builtin_amdgcn_rcpf(1.0f + __builtin_amdgcn_exp2f(-1.4426950408889634f * x)); }
__device__ __forceinline__ float silu1(float x) { return x * sigmoid_f(x); }

struct Args { const float* in[22]; float* out; unsigned char* ws; int ph_lo, ph_hi; };
struct ArgsV { const Args* p; int z;
    __device__ __forceinline__ const float* in(int i) const { return p->in[i + z]; }
    __device__ __forceinline__ float* out() const { return (float*)p->in[22 + z]; }
    __device__ __forceinline__ unsigned char* ws() const { return (unsigned char*)p->in[23 + z]; } };
enum { I_X = 0, I_C, I_CTX, I_CCTX, I_WMOD, I_BMOD, I_NPRE, I_NPOST, I_WG, I_WU, I_WD, I_WIN, I_QN, I_WUQ, I_KVN, I_WUKV, I_AON, I_CW, I_CB, I_GB, I_MN, I_WOUT };

__device__ __forceinline__ const float* xin_row(const ArgsV& a, int r) { const int b = r / TB, t = r - b * TB; return t < CTXL ? a.in(I_CTX) + (size_t)(b * CTXL + t) * DM : a.in(I_X) + (size_t)(b * SEQ + t - CTXL) * DM; }
__device__ __forceinline__ float* xres_row(const ArgsV& a, int r) { const int b = r / TB, t = r - b * TB; return t < CTXL ? (float*)(a.ws() + WS_XC) + (size_t)(b * CTXL + t) * DM : a.out() + (size_t)(b * SEQ + t - CTXL) * DM; }
__device__ __forceinline__ const float* mod_vec(const ArgsV& a, int l, int r, int j) { const int b = r / TB, t = r - b * TB; const int bb = t < CTXL ? 4 : b; return (const float*)(a.ws() + WS_MOD) + (size_t)((l * 5 + bb) * NMOD + j) * DM; }

__device__ __forceinline__ void cvt_item(const float* src, int srcN, int k0, int c0, int ncv, bf16* dst, int dstK, int drow0, int dk0, LAS float* scr, int lane) {
    const int n4 = (lane & 15) * 4, kr = lane >> 4;
    f32x4 v[16];
    const bool ok = n4 < ncv;
    const float* sp = src + (size_t)(k0 + kr) * srcN + c0 + n4;
#pragma unroll
    for (int i = 0; i < 16; ++i) { v[i] = (f32x4){0.f, 0.f, 0.f, 0.f}; if (ok) v[i] = *(const f32x4*)(sp + (size_t)(4 * i) * srcN); }
#pragma unroll
    for (int i = 0; i < 16; ++i) { const int k = 4 * i + kr; *(LAS f32x4*)(scr + k * 68 + ((n4 + 8 * (k >> 3)) & 63)) = v[i]; }
    LDS_WAIT(); asm volatile("" ::: "memory");
    const int c = lane & 7;
#pragma unroll
    for (int j = 0; j < 8; ++j) { const int n = (lane >> 3) + 8 * j; const LAS float* s = scr + (8 * c) * 68 + ((n + 8 * c) & 63);
        u32x4 o; o.x = pk2(s[0 * 68], s[1 * 68]); o.y = pk2(s[2 * 68], s[3 * 68]); o.z = pk2(s[4 * 68], s[5 * 68]); o.w = pk2(s[6 * 68], s[7 * 68]);
        *(u32x4*)(dst + (size_t)(drow0 + n) * dstK + dk0 + 8 * c) = o; }
    LDS_WAIT(); asm volatile("" ::: "memory");
}
__device__ __forceinline__ void wconv_layer(const ArgsV& a, int l, LAS unsigned char* lds, int bid, int nbl, int wave, int lane) {
    LAS float* scr = (LAS float*)(lds + wave * 17408);
    const int gw = bid * NWAVES + wave, NGW = nbl * NWAVES;
    constexpr int I_1 = 88 * 16, I_2 = 16 * 44, I_IN = 40 * 16, I_UP = 28 * 6, I_OUT = 16 * 16;
    constexpr int NITEMS = 2 * I_1 + 2 * I_2 + I_IN + I_UP + I_OUT;
    bf16* W1 = (bf16*)(a.ws() + WS_W1); bf16* W2 = (bf16*)(a.ws() + WS_W2); bf16* WIN = (bf16*)(a.ws() + WS_WIN); bf16* WUP = (bf16*)(a.ws() + WS_WUP); bf16* WOUT = (bf16*)(a.ws() + WS_WOUT);
    for (int it = gw; it < NITEMS; it += NGW) {
        int r = it;
        if (r < 2 * I_1) { const int j = r / I_1; r -= j * I_1; const int g = r / 16, kb = r % 16; const int row0 = 64 * g, pn = row0 >> 8, i = row0 & 255; const int hc = 128 * pn + (i & 127);
            const float* src = (i < 128 ? a.in(I_WG) : a.in(I_WU)) + (size_t)(l * 2 + j) * DM * DFF;
            cvt_item(src, DFF, 64 * kb, hc < DFF ? hc : 0, hc < DFF ? 64 : 0, W1 + (size_t)j * NW1 * DM, DM, row0, 64 * kb, scr, lane); continue; }
        r -= 2 * I_1;
        if (r < 2 * I_2) { const int j = r / I_2; r -= j * I_2; const int g = r / 44, kb = r % 44;
            const float* src = a.in(I_WD) + (size_t)(l * 2 + j) * DFF * DM;
            cvt_item(src, DM, kb < 43 ? 64 * kb : 0, 64 * g, kb < 43 ? 64 : 0, W2 + (size_t)j * DM * DFFP, DFFP, 64 * g, 64 * kb, scr, lane); continue; }
        r -= 2 * I_2;
        if (r < I_IN) { const int g = r / 16, kb = r % 16; int ncv = DIN - 64 * g; ncv = ncv < 0 ? 0 : (ncv > 64 ? 64 : ncv);
            cvt_item(a.in(I_WIN) + (size_t)l * DM * DIN, DIN, 64 * kb, ncv > 0 ? 64 * g : 0, ncv, WIN, DM, 64 * g, 64 * kb, scr, lane); continue; }
        r -= I_IN;
        if (r < I_UP) { const int g = r / 6, kb = r % 6;
            if (g < 12) cvt_item(a.in(I_WUQ) + (size_t)l * 256 * 768, 768, kb < 4 ? 64 * kb : 0, 64 * g, kb < 4 ? 64 : 0, WUP, KUP, 64 * g, 64 * kb, scr, lane);
            else cvt_item(a.in(I_WUKV) + (size_t)l * 128 * 1024, 1024, kb >= 4 ? 64 * (kb - 4) : 0, 64 * (g - 12), kb >= 4 ? 64 : 0, WUP, KUP, 64 * g, 64 * kb, scr, lane);
            continue; }
        r -= I_UP;
        { const int g = r / 16, kb = r % 16; cvt_item(a.in(I_WOUT) + (size_t)l * DM * DM, DM, 64 * kb, 64 * g, 64, WOUT, DM, 64 * g, 64 * kb, scr, lane); }
    }
}
__device__ __forceinline__ void mod_phase(const ArgsV& a, LAS unsigned char* lds, int bid, int nbl, int tid, int wave, int lane) {
    LAS float* sv = (LAS float*)(lds);
    LAS float* red = (LAS float*)(lds + 20480);
    for (int i = tid; i < 5 * DM; i += NTHREADS) { const float v = i < 4 * DM ? a.in(I_C)[i] : a.in(I_CCTX)[i - 4 * DM]; sv[i] = silu1(v); }
    __syncthreads();
    float* mod = (float*)(a.ws() + WS_MOD);
    for (int u = bid; u < 256; u += nbl) {
        const int l = u >> 7, cb = (u & 127) * 72; const bool act = lane < 18;
        const float* W = a.in(I_WMOD) + (size_t)l * DM * (NMOD * DM) + cb + 4 * (act ? lane : 0);
        f32x4 acc[5];
#pragma unroll
        for (int bb = 0; bb < 5; ++bb) acc[bb] = (f32x4){0.f, 0.f, 0.f, 0.f};
        for (int k0 = wave * 128; k0 < wave * 128 + 128; k0 += 32) { f32x4 w[32];
#pragma unroll
            for (int i = 0; i < 32; ++i) w[i] = *(const f32x4*)(W + (size_t)(k0 + i) * (NMOD * DM));
#pragma unroll
            for (int i = 0; i < 32; ++i)
#pragma unroll
                for (int bb = 0; bb < 5; ++bb) acc[bb] += w[i] * sv[bb * DM + k0 + i]; }
        if (act) {
#pragma unroll
            for (int bb = 0; bb < 5; ++bb) *(LAS f32x4*)(red + (wave * 5 + bb) * 72 + 4 * lane) = acc[bb]; }
        __syncthreads();
        for (int i = tid; i < 5 * 72; i += NTHREADS) { const int bb = i / 72, cc = i % 72; float s = 0.f;
#pragma unroll
            for (int w = 0; w < 8; ++w) s += red[(w * 5 + bb) * 72 + cc];
            mod[(size_t)(l * 5 + bb) * (NMOD * DM) + cb + cc] = s + a.in(I_BMOD)[(size_t)l * NMOD * DM + cb + cc]; }
        __syncthreads();
    }
    if (bid == nbl - 1 && tid < 64) {
        constexpr float inv[16] = {1.0f, 0.5623413251903491f, 0.31622776601683794f, 0.1778279410038923f, 0.1f, 0.05623413251903491f, 0.03162277660168379f, 0.01778279410038923f,
                                   0.01f, 0.005623413251903491f, 0.0031622776601683794f, 0.001778279410038923f, 0.001f, 0.0005623413251903491f, 0.00031622776601683794f, 0.0001778279410038923f};
        float* tab = (float*)(a.ws() + WS_TAB);
#pragma unroll
        for (int f = 0; f < 16; ++f) {
            const float ang = (float)tid * inv[f];
            const double ad = (double)ang; const double kq = __builtin_rint(ad * 0.63661977236758134308); const double rd = ad - kq * 1.57079632679489661923;
            const float x = (float)rd, x2 = x * x; const int q = ((int)kq) & 3;
            const float sp = x + x * x2 * (-1.6666654611e-1f + x2 * (8.3321608736e-3f + x2 * (-1.9515295891e-4f)));
            const float cp = 1.0f - 0.5f * x2 + x2 * x2 * (4.166664568298827e-2f + x2 * (-1.388731625493765e-3f + x2 * 2.443315711809948e-5f));
            const float sn = (q == 0) ? sp : (q == 1) ? cp : (q == 2) ? -sp : -cp;
            const float cs = (q == 0) ? cp : (q == 1) ? -sp : (q == 2) ? -cp : sp;
            tab[(tid * 16 + f) * 2] = cs; tab[(tid * 16 + f) * 2 + 1] = sn; }
    }
    __syncthreads();
}

__device__ __forceinline__ void rw_pre(const f32x4 (&x)[4], const float* g, const float* sc, const float* sh, bf16* hrow, int lane) {
    float ss = 0.f;
#pragma unroll
    for (int j = 0; j < 4; ++j) ss += (x[j].x * x[j].x + x[j].y * x[j].y) + (x[j].z * x[j].z + x[j].w * x[j].w);
    const float rstd = 1.0f / sqrtf(wave_sum(ss) * (1.0f / DM) + EPS);
#pragma unroll
    for (int j = 0; j < 4; ++j) { const int c = 256 * j + 4 * lane; const f32x4 gv = *(const f32x4*)(g + c), sv = *(const f32x4*)(sc + c), hv = *(const f32x4*)(sh + c);
        f32x4 o; o.x = x[j].x * rstd * gv.x * (1.0f + sv.x) + hv.x; o.y = x[j].y * rstd * gv.y * (1.0f + sv.y) + hv.y; o.z = x[j].z * rstd * gv.z * (1.0f + sv.z) + hv.z; o.w = x[j].w * rstd * gv.w * (1.0f + sv.w) + hv.w;
        u32x2 w; w.x = pk2(o.x, o.y); w.y = pk2(o.z, o.w); *(u32x2*)(hrow + c) = w; }
}
__device__ __forceinline__ void phase_rw_a(const ArgsV& a, int bid, int nbl, int wave, int lane) {
    const int gw = bid * NWAVES + wave, NGW = nbl * NWAVES; bf16* H = (bf16*)(a.ws() + WS_H);
    for (int ra = gw; ra < R; ra += 2 * NGW) {
        const int rb_ = ra + NGW < R ? ra + NGW : ra; const float* xa = xin_row(a, ra); const float* xb = xin_row(a, rb_); f32x4 x0[4], x1[4];
#pragma unroll
        for (int j = 0; j < 4; ++j) { x0[j] = *(const f32x4*)(xa + 256 * j + 4 * lane); x1[j] = *(const f32x4*)(xb + 256 * j + 4 * lane); }
        rw_pre(x0, a.in(I_NPRE) + 0, mod_vec(a, 0, ra, 1), mod_vec(a, 0, ra, 0), H + (size_t)ra * DM, lane);
        if (rb_ != ra) rw_pre(x1, a.in(I_NPRE) + 0, mod_vec(a, 0, rb_, 1), mod_vec(a, 0, rb_, 0), H + (size_t)rb_ * DM, lane); }
}
__device__ __forceinline__ void phase_rw_b(const ArgsV& a, int l, int sub, int bid, int nbl, int wave, int lane, bool dry = false) {
    const int gw = bid * NWAVES + wave, NGW = nbl * NWAVES; bf16* H = (bf16*)(a.ws() + WS_H);
    const float wgt = sub == 1 ? 1.0f : 0.5f; const float* gpost = a.in(I_NPOST) + (size_t)(l * 3 + sub) * DM;
    const int nl = sub == 2 ? l + 1 : l, nsub = sub == 2 ? 0 : sub + 1;
    const bool from_input = (l == 0 && sub == 0); const int nsl = sub == 1 ? 4 : 11;
    if (l == 1 && sub >= 1) return;
    const float* gpre = a.in(I_NPRE) + (size_t)(nl * 3 + nsub) * DM;
    for (int i0 = gw; i0 < NB * CTXL; i0 += NGW) {
        const int r0 = (i0 / CTXL) * TB + (i0 % CTXL);
        const float* xs0 = from_input ? xin_row(a, r0) : xres_row(a, r0);
        const float* gate0 = mod_vec(a, l, r0, 3 * sub + 2); const float* sc0 = mod_vec(a, nl, r0, 3 * nsub + 1); const float* sh0 = mod_vec(a, nl, r0, 3 * nsub);
        const float* sp = (const float*)(a.ws() + WS_AUP) + (size_t)((r0 / TB) * CTXL + (r0 % TB)) * DM + 4 * lane;
        f32x4 x0[4], y0[4], gp[4], gt[4], gn[4], sv[4], hv[4];
        {   f32x4 v[4][4];
#pragma unroll
            for (int j = 0; j < 4; ++j) { const int c = 256 * j + 4 * lane; x0[j] = *(const f32x4*)(xs0 + c); gp[j] = *(const f32x4*)(gpost + c); gt[j] = *(const f32x4*)(gate0 + c);
#pragma unroll
                for (int s = 0; s < 4; ++s) v[s][j] = *(const f32x4*)(sp + (size_t)s * 1024 * 1024 + 256 * j); }
            asm volatile("" ::: "memory");
#pragma unroll
            for (int j = 0; j < 4; ++j) y0[j] = (v[0][j] + v[1][j]) + (v[2][j] + v[3][j]); }
        if (nsl > 4) {
            {   f32x4 w[4][4];
#pragma unroll
                for (int j = 0; j < 4; ++j) { const int c = 256 * j + 4 * lane; gn[j] = *(const f32x4*)(gpre + c); sv[j] = *(const f32x4*)(sc0 + c); hv[j] = *(const f32x4*)(sh0 + c);
#pragma unroll
                    for (int s = 0; s < 4; ++s) w[s][j] = *(const f32x4*)(sp + (size_t)(4 + s) * 1024 * 1024 + 256 * j); }
                asm volatile("" ::: "memory");
#pragma unroll
                for (int j = 0; j < 4; ++j) y0[j] += (w[0][j] + w[1][j]) + (w[2][j] + w[3][j]); }
            {   f32x4 w[3][4];
#pragma unroll
                for (int s = 0; s < 3; ++s)
#pragma unroll
                    for (int j = 0; j < 4; ++j) w[s][j] = *(const f32x4*)(sp + (size_t)(8 + s) * 1024 * 1024 + 256 * j);
#pragma unroll
                for (int j = 0; j < 4; ++j) y0[j] += (w[0][j] + w[1][j]) + w[2][j]; }
        } else {
#pragma unroll
            for (int j = 0; j < 4; ++j) { const int c = 256 * j + 4 * lane; gn[j] = *(const f32x4*)(gpre + c); sv[j] = *(const f32x4*)(sc0 + c); hv[j] = *(const f32x4*)(sh0 + c); }
        }
        float ss0 = 0.f;
#pragma unroll
        for (int j = 0; j < 4; ++j) ss0 += (y0[j].x * y0[j].x + y0[j].y * y0[j].y) + (y0[j].z * y0[j].z + y0[j].w * y0[j].w);
        const float rs0 = 1.0f / sqrtf(wave_sum(ss0) * (1.0f / DM) + EPS);
        float* xd0 = dry ? (float*)(a.ws() + WS_BIG) + (size_t)r0 * DM : xres_row(a, r0);
        float s2 = 0.f;
#pragma unroll
        for (int j = 0; j < 4; ++j) { const int c = 256 * j + 4 * lane;
            x0[j].x += wgt * gt[j].x * (y0[j].x * rs0 * gp[j].x); x0[j].y += wgt * gt[j].y * (y0[j].y * rs0 * gp[j].y); x0[j].z += wgt * gt[j].z * (y0[j].z * rs0 * gp[j].z); x0[j].w += wgt * gt[j].w * (y0[j].w * rs0 * gp[j].w);
            *(f32x4*)(xd0 + c) = x0[j]; s2 += (x0[j].x * x0[j].x + x0[j].y * x0[j].y) + (x0[j].z * x0[j].z + x0[j].w * x0[j].w); }
        const float rstd = 1.0f / sqrtf(wave_sum(s2) * (1.0f / DM) + EPS); bf16* hrow = H + (size_t)r0 * DM;
#pragma unroll
        for (int j = 0; j < 4; ++j) { const int c = 256 * j + 4 * lane; f32x4 o;
            o.x = x0[j].x * rstd * gn[j].x * (1.0f + sv[j].x) + hv[j].x; o.y = x0[j].y * rstd * gn[j].y * (1.0f + sv[j].y) + hv[j].y; o.z = x0[j].z * rstd * gn[j].z * (1.0f + sv[j].z) + hv[j].z; o.w = x0[j].w * rstd * gn[j].w * (1.0f + sv[j].w) + hv[j].w;
            u32x2 w; w.x = pk2(o.x, o.y); w.y = pk2(o.z, o.w); *(u32x2*)(hrow + c) = w; }
    }
}
__device__ __forceinline__ void phase_rw_prep(const ArgsV& a, int l, int bid, int nbl, int wave, int lane) {
    const int gw = bid * NWAVES + wave, NGW = nbl * NWAVES;
    const bf16* P = (const bf16*)(a.ws() + WS_BIG); bf16* AUP = (bf16*)(a.ws() + WS_AUP); bf16* KR = (bf16*)(a.ws() + WS_BIG + BIG_KR);
    const float* tab = (const float*)(a.ws() + WS_TAB);
    const float* qn = a.in(I_QN) + l * 256; const float* kvn = a.in(I_KVN) + l * 128;
    for (int task = gw; task < 32 * 17; task += NGW)
        ml::gate_scan_task((const float*)(a.ws() + WS_BIG + BIG_G), a.in(I_GB) + l * 16, (float*)(a.ws() + WS_MS + MS_T), (float*)(a.ws() + WS_MS + MS_SCA), task, lane);
    for (int ra = gw; ra < R; ra += 2 * NGW) {
        const int rb_ = ra + NGW < R ? ra + NGW : ra; const bool two = rb_ != ra;
        const bf16* pa = P + (size_t)ra * DINP; const bf16* pb = P + (size_t)rb_ * DINP;
        const u32x2 wa = *(const u32x2*)(pa + 4 * lane), wb = *(const u32x2*)(pb + 4 * lane);
        const unsigned ka = *(const unsigned*)(pa + 256 + 2 * lane), kb = *(const unsigned*)(pb + 256 + 2 * lane);
        const float va = bf1(pa[384 + lane]), vb = bf1(pb[384 + lane]);
        const f32x4 g = *(const f32x4*)(qn + 4 * lane); const float kg0 = kvn[2 * lane], kg1 = kvn[2 * lane + 1];
        float a0 = bflo(wa.x), a1 = bfhi(wa.x), a2 = bflo(wa.y), a3 = bfhi(wa.y), b0 = bflo(wb.x), b1 = bfhi(wb.x), b2 = bflo(wb.y), b3 = bfhi(wb.y);
        float sa = (a0 * a0 + a1 * a1) + (a2 * a2 + a3 * a3), sb = (b0 * b0 + b1 * b1) + (b2 * b2 + b3 * b3);
        const float c0 = bflo(ka), c1 = bfhi(ka), d0 = bflo(kb), d1 = bfhi(kb); float ta = c0 * c0 + c1 * c1, tb = d0 * d0 + d1 * d1;
#pragma unroll
        for (int o = 1; o < 64; o <<= 1) { sa += __shfl_xor(sa, o); sb += __shfl_xor(sb, o); ta += __shfl_xor(ta, o); tb += __shfl_xor(tb, o); }
        const float voa = __shfl_xor(va, 16), vob = __shfl_xor(vb, 16);
        const float rqa = 1.0f / sqrtf(sa * (1.0f / 256.0f) + EPS), rqb = 1.0f / sqrtf(sb * (1.0f / 256.0f) + EPS), rka = 1.0f / sqrtf(ta * (1.0f / 128.0f) + EPS), rkb = 1.0f / sqrtf(tb * (1.0f / 128.0f) + EPS);
        { u32x2 o; o.x = pk2(a0 * rqa * g.x, a1 * rqa * g.y); o.y = pk2(a2 * rqa * g.z, a3 * rqa * g.w); *(u32x2*)(AUP + (size_t)ra * KUP + 4 * lane) = o;
          *(unsigned*)(AUP + (size_t)ra * KUP + 256 + 2 * lane) = pk2(c0 * rka * kg0, c1 * rka * kg1); }
        if (two) { u32x2 o; o.x = pk2(b0 * rqb * g.x, b1 * rqb * g.y); o.y = pk2(b2 * rqb * g.z, b3 * rqb * g.w); *(u32x2*)(AUP + (size_t)rb_ * KUP + 4 * lane) = o;
          *(unsigned*)(AUP + (size_t)rb_ * KUP + 256 + 2 * lane) = pk2(d0 * rkb * kg0, d1 * rkb * kg1); }
        const int ax = lane >> 5, half = (lane >> 4) & 1, f = lane & 15;
        { const int t = ra % TB; float o = va;
          if (t >= CTXL) { const int tt = t - CTXL; const int pos = ax == 0 ? (tt >> 6) : (tt & 63); const float cs = tab[(pos * 16 + f) * 2], sn = tab[(pos * 16 + f) * 2 + 1]; o = half == 0 ? va * cs - voa * sn : va * cs + voa * sn; }
          KR[(size_t)ra * 64 + lane] = (bf16)f2bf(o); }
        if (two) { const int t = rb_ % TB; float o = vb;
          if (t >= CTXL) { const int tt = t - CTXL; const int pos = ax == 0 ? (tt >> 6) : (tt & 63); const float cs = tab[(pos * 16 + f) * 2], sn = tab[(pos * 16 + f) * 2 + 1]; o = half == 0 ? vb * cs - vob * sn : vb * cs + vob * sn; }
          KR[(size_t)rb_ * 64 + lane] = (bf16)f2bf(o); }
    }
}
#define RLX_AGENT __ATOMIC_RELAXED, __HIP_MEMORY_SCOPE_AGENT
#define VM_WAIT() asm volatile("s_waitcnt vmcnt(0)" ::: "memory")
#define XB_TMO      128
#define XB_XCNT(j)  (256  + 64 * (j))
#define XB_XSUB(j)  (1280 + 64 * (j))
#define XB_XGEN(j)  (2304 + 64 * (j))
#define XB_TOP      3328
#define XB_TOPGEN   3392
#define XCD_BAR_WORDS 3456
#define XB_SPIN_CAP (1u << 18)

__device__ __forceinline__ unsigned xb_ld(unsigned* p)              { return __hip_atomic_load(p, __ATOMIC_RELAXED, __HIP_MEMORY_SCOPE_AGENT); }
__device__ __forceinline__ unsigned xb_add(unsigned* p, unsigned v) { return __hip_atomic_fetch_add(p, v, __ATOMIC_RELAXED, __HIP_MEMORY_SCOPE_AGENT); }
__device__ __forceinline__ unsigned xb_xcc_id() { return (unsigned)__builtin_amdgcn_s_getreg((3 << 11) | 20) & 0xFu; }
#define XB_SPIN(cond, bar) do { unsigned _sp = 0; while (cond) { __builtin_amdgcn_s_sleep(1); \
    if ((++_sp & 255u) == 0u) { if (xb_ld(&(bar)[XB_TMO])) break; if (_sp > XB_SPIN_CAP) { atomicAdd(&(bar)[XB_TMO], 1u); break; } } } } while (0)

struct XcdBarrier {
    unsigned* bar; unsigned x;
    volatile LAS unsigned* st;
};

__device__ __forceinline__ XcdBarrier xcd_barrier_post(unsigned* bar, volatile LAS unsigned* st) {
    XcdBarrier b; b.bar = bar; b.x = xb_xcc_id(); b.st = st;
    if (threadIdx.x == 0) (void)xb_add(&bar[XB_XCNT(b.x)], 1u);
    return b;
}
__device__ __forceinline__ void xcd_barrier_complete(unsigned* bar, unsigned x, unsigned& nloc, unsigned& nx) {
    const unsigned G = gridDim.x * gridDim.y * gridDim.z;
    unsigned sum, cnt, mine, sp = 0u;
    for (;;) {
        sum = 0u; cnt = 0u; mine = 0u;
#pragma unroll
        for (unsigned j = 0; j < 16; ++j) { const unsigned c = xb_ld(&bar[XB_XCNT(j)]); sum += c; cnt += (c > 0u) ? 1u : 0u; mine = (j == x) ? c : mine; }
        if (sum == G) break;
        __builtin_amdgcn_s_sleep(1);
        if ((++sp & 255u) == 0u) { if (xb_ld(&bar[XB_TMO])) break; if (sp > XB_SPIN_CAP) { atomicAdd(&bar[XB_TMO], 1u); break; } }
    }
    nloc = mine > 0u ? mine : 1u; nx = cnt > 0u ? cnt : 1u;
}

__device__ __forceinline__ void xcd_barrier(const XcdBarrier& b) {
    asm volatile("s_waitcnt vmcnt(0)" ::: "memory");
    __syncthreads();
    if (threadIdx.x == 0) {
        unsigned* bar = b.bar;
        __builtin_amdgcn_s_waitcnt(0);
        unsigned nloc = b.st[0], nx = b.st[1];
        if (nloc == 0u) { xcd_barrier_complete(bar, b.x, nloc, nx); b.st[0] = nloc; b.st[1] = nx; }
        const unsigned old = xb_add(&bar[XB_XSUB(b.x)], 1u);
        const unsigned gen = old / nloc;
        if (old + 1u == (gen + 1u) * nloc) {
            __builtin_amdgcn_fence(__ATOMIC_RELEASE, "agent");
            asm volatile("s_waitcnt vmcnt(0)" ::: "memory");
            const unsigned og = xb_add(&bar[XB_TOP], 1u);
            const unsigned tg = og / nx;
            if (og + 1u == (tg + 1u) * nx) xb_add(&bar[XB_TOPGEN], 1u);
            else XB_SPIN(xb_ld(&bar[XB_TOPGEN]) == tg, bar);
            __builtin_amdgcn_fence(__ATOMIC_ACQUIRE, "agent");
            xb_add(&bar[XB_XGEN(b.x)], 1u);
            asm volatile("s_waitcnt vmcnt(0)" ::: "memory");
        } else {
            XB_SPIN(xb_ld(&bar[XB_XGEN(b.x)]) == gen, bar);
            __builtin_amdgcn_fence(__ATOMIC_ACQUIRE, "agent");
            asm volatile("s_waitcnt vmcnt(0)" ::: "memory");
        }
    }
    __syncthreads();
}
constexpr int PPL = 15, N_PHASES = 1 + 2 * PPL, SKIP_PHASE = 1 + PPL;
__global__ void __launch_bounds__(NTHREADS, 2) mega_fwd(Args args) {
    extern __shared__ __attribute__((aligned(16))) unsigned char lds_raw[];
    LAS unsigned char* lds = (LAS unsigned char*)lds_raw;
    cg::grid_group grid = cg::this_grid();
    volatile LAS unsigned* MISC = (volatile LAS unsigned*)(lds + LDS_MISC);
    if (threadIdx.x < 16) MISC[threadIdx.x] = 0u;
    __syncthreads();
    XcdBarrier bar = xcd_barrier_post((unsigned*)(args.ws + WS_CTL), MISC + 8);
    for (int ph = args.ph_lo; ph < args.ph_hi; ++ph) {
        if (ph == SKIP_PHASE || ph == 1 + PPL + 11 || ph == 1 + PPL + 14 || ph == 1 + 9 || ph == 1 + PPL + 9) continue;
#define TID_DECL int tid_ = threadIdx.x; asm volatile("" : "+v"(tid_)); const int tid = tid_, lane = tid & 63, wave = __builtin_amdgcn_readfirstlane(tid >> 6); (void)tid; (void)lane; (void)wave
        int bid_ = blockIdx.x, nbl_ = gridDim.x; asm volatile("" : "+s"(bid_), "+s"(nbl_)); const int bid = bid_, nbl = nbl_;
        int zo_ = 0; asm volatile("" : "+s"(zo_));
        const ArgsV A_{&args, zo_}; unsigned char* ws = A_.ws();
        XcdBarrier barl = bar; asm volatile("" : "+s"(barl.x), "+s"(barl.bar));
        if (ph == 0) { TID_DECL; mod_phase(A_, lds, bid, nbl, tid, wave, lane); wconv_layer(A_, 0, lds, bid, nbl, wave, lane); }
        else {
            const int l = (ph - 1) / PPL, k = (ph - 1) % PPL;
            if (k == 0) { TID_DECL; phase_rw_a(A_, bid, nbl, wave, lane); }
            else if (k == 1 || k == 12) { const int j = k == 12;
                pg8::Gemm g{(const pg8::bf16_t*)(ws + WS_H), (const pg8::bf16_t*)(ws + WS_W1) + (size_t)j * NW1 * DM, R, NW1, DM}; pg8::TileOrder S; S.init(0, NW1, DM, nbl, bid, 1);
                pg8::EpiSwiGLU E{(pg8::bf16_t*)(ws + WS_BIG), DFFP};
                pg8::gemm_phase<pg8::EpiSwiGLU, pg8::TileOrder, true, true>(lds, g, S, E); }
            else if (k == 2 || k == 13 || k == 10) { const int j = k == 13, sub = k == 2 ? 0 : (k == 10 ? 1 : 2);
                const pg8::bf16_t* A = (const pg8::bf16_t*)(ws + (k == 10 ? WS_H : WS_BIG));
                const pg8::bf16_t* Bt = k == 10 ? (const pg8::bf16_t*)(ws + WS_WOUT) : (const pg8::bf16_t*)(ws + WS_W2) + (size_t)j * DM * DFFP;
                const int K = k == 10 ? DM : DFFP;
                pg8::Gemm g{A, Bt, R, DM, K}; pg8::TileOrder S; S.init(1, DM, K, nbl, bid, 1);
                const bool has_next = !(l == 1 && sub == 2); const int nl = sub == 2 ? l + 1 : l, nsub = sub == 2 ? 0 : sub + 1;
                const float* modb = (const float*)(ws + WS_MOD); unsigned* cntb = (unsigned*)(ws + WS_CTL + 65536) + (size_t)((l * 3 + sub) * 2) * (68 * 64);
                pg8::EpiNormRes E{(l == 0 && sub == 0) ? A_.in(I_X) : (const float*)A_.out(), A_.out(), has_next ? (pg8::bf16_t*)(ws + WS_H) : nullptr,
                                  modb + (size_t)((l * 5) * NMOD + 3 * sub + 2) * DM, A_.in(I_NPOST) + (size_t)(l * 3 + sub) * DM,
                                  A_.in(I_NPRE) + (size_t)((has_next ? nl : 0) * 3 + nsub) * DM, modb + (size_t)(((has_next ? nl : 0) * 5) * NMOD + 3 * nsub + 1) * DM, modb + (size_t)(((has_next ? nl : 0) * 5) * NMOD + 3 * nsub) * DM,
                                  sub == 1 ? 1.0f : 0.5f, pg8::PanelSS{(unsigned*)(ws + WS_MS + MS_X1), cntb}, pg8::PanelSS{(unsigned*)(ws + WS_MS + MS_X2), cntb + 68 * 64}};
                pg8::gemm_phase<pg8::EpiNormRes, pg8::TileOrder, false, true>(lds, g, S, E);
                if (l == 0 || k == 2) { __syncthreads();
                    pg8::TileOrder S2; S2.init(2, DM, K, nbl, bid, k == 10 ? 4 : 11);
                    pg8::EpiSlab E2{(float*)(ws + WS_AUP)};
                    pg8::gemm_phase<pg8::EpiSlab, pg8::TileOrder, true, true>(lds, g, S2, E2); } }
            else if (k == 6) {
                pg8::Gemm g{(const pg8::bf16_t*)(ws + WS_AUP), (const pg8::bf16_t*)(ws + WS_WUP), R, NUP, KUP}; pg8::TileOrder S; S.init(3, NUP, KUP, nbl, bid, 1);
                pg8::EpiStore E{(pg8::bf16_t*)(ws + WS_Y), NUP};
                pg8::gemm_phase<pg8::EpiStore, pg8::TileOrder, true, true>(lds, g, S, E);
                if (k == 6) {
                    __syncthreads();
                    for (int u = bid; u < 512; u += nbl)
                        ml::mlstm_local((const ml::bf16*)(ws + WS_BIG), (const float*)(ws + WS_MS + MS_T), A_.in(I_CW) + (size_t)l * 3 * 1024, A_.in(I_CB) + (size_t)l * 1024,
                                        (float*)(ws + WS_HF), (float*)(ws + WS_MS + MS_NLOC), u, (char*)lds_raw); } }
            else if (k == 3 || k == 11 || k == 14) { TID_DECL; phase_rw_b(A_, l, k == 3 ? 0 : (k == 11 ? 1 : 2), bid, nbl, wave, lane); if (k == 14 && l == 0) wconv_layer(A_, 1, lds, bid, nbl, wave, lane); }
            else if (k == 4) {
                pg8::Gemm g{(const pg8::bf16_t*)(ws + WS_H), (const pg8::bf16_t*)(ws + WS_WIN), R, DINP, DM}; pg8::TileOrder S; S.init(0, DINP, DM, nbl, bid, 1);
                pg8::EpiP E{(pg8::bf16_t*)(ws + WS_BIG), DINP, (float*)(ws + WS_BIG + BIG_G)};
                pg8::gemm_phase<pg8::EpiP, pg8::TileOrder, true, true>(lds, g, S, E); }
            else if (k == 5) { TID_DECL; phase_rw_prep(A_, l, bid, nbl, wave, lane); }
            else if (k == 7 || k == 8) {
                if (k == 7) { TID_DECL; ml::mlstm_scan((const float*)(ws + WS_HF), (const float*)(ws + WS_MS + MS_NLOC), (const float*)(ws + WS_MS + MS_SCA), (ml::bf16*)(ws + WS_AUP), (float*)(ws + WS_MS + MS_NST), (float*)(ws + WS_MS + MS_BM), bid * NTHREADS + tid, nbl * NTHREADS); }
                att::bf16* QKV = (att::bf16*)(ws + WS_Y); const att::bf16* KR = (const att::bf16*)(ws + WS_BIG + BIG_KR);
                const float* tab = (const float*)(ws + WS_TAB);
                int u0, u1;
                if (k == 8) { u0 = bid; u1 = 256; } else { u0 = (l == 0 && bid >= 128) ? 256 + (bid - 128) : 272; u1 = 272; }
                for (int u = u0; u < u1; u += nbl) {
                    int b, h, seq, rope, qtok0; size_t rq;
                    if (u < 256) { b = u >> 6; h = (u >> 4) & 3; const int qb = u & 15; rq = (size_t)b * TB + CTXL + (size_t)qb * 256; seq = TB; rope = 1; qtok0 = qb * 256; }
                    else { b = (u - 256) >> 2; h = (u - 256) & 3; rq = (size_t)b * TB; seq = CTXL; rope = 0; qtok0 = 0; }
                    const size_t r0 = (size_t)b * TB;
                    const int panel = u < 256 ? (b * 16 + (u & 15)) : (64 + b);
                    att::attn_body(QKV + rq * NUP + h * 192, QKV + r0 * NUP + 768 + h * 256, QKV + r0 * NUP + 768 + h * 256 + 128, KR + r0 * 64, (att::bf16*)(ws + WS_H) + rq * DM + h * 128, seq, rope, qtok0, tab, (char*)lds_raw,
                                   (unsigned*)(ws + WS_MS + MS_X1) + rq * 4, (unsigned*)(ws + WS_CTL + 65536) + (size_t)(12 + l) * (68 * 64) + 64 * panel, A_.in(I_AON) + l * 512 + h * 128, h);
                }
                const int m0 = nbl - 1 - bid, m1 = (k == 8) ? 256 : ((l == 0) ? 16 : 0);
                for (int u = m0; u < m1; u += nbl) { const int bh = (k == 8) ? (u >> 4) : u, tbk = (k == 8) ? 1 + (u & 15) : 0;
                    ml::mlstm_out2((const ml::bf16*)(ws + WS_BIG), (const float*)(ws + WS_MS + MS_T), A_.in(I_CW) + (size_t)l * 3 * 1024, A_.in(I_CB) + (size_t)l * 1024, (const ml::bf16*)(ws + WS_AUP),
                                   (const float*)(ws + WS_MS + MS_NST), (const float*)(ws + WS_MS + MS_BM), A_.in(I_MN) + l * 512, (ml::bf16*)(ws + WS_H), bh >> 2, bh & 3, tbk, (char*)lds_raw); }
            }
        }
        if (ph + 1 < args.ph_hi) { if (args.ph_hi < 0) grid.sync(); else xcd_barrier(barl); }
    }
}

#ifndef MK_ONE_LAUNCH
#define MK_ONE_LAUNCH 1
#endif
extern "C" void kernel_launch(void* const* d_in, const int* in_sizes, int n_in, void* d_out, int out_size, void* d_ws, size_t ws_size, hipStream_t stream) {
    static int grid = 0;
    if (grid == 0) {
        if (n_in != 22 || in_sizes[0] != NB * SEQ * DM || out_size != NB * SEQ * DM || ws_size < WS_END) { fprintf(stderr, "kernel_launch: shape/workspace mismatch (n_in %d, in0 %d, out %d, ws %zu need %zu)\n", n_in, n_in > 0 ? in_sizes[0] : -1, out_size, ws_size, (size_t)WS_END); grid = -1; return; }
        int dev = 0, cus = 0, per_cu = 0;
        if (hipGetDevice(&dev) != hipSuccess || hipDeviceGetAttribute(&cus, hipDeviceAttributeMultiprocessorCount, dev) != hipSuccess) { grid = -1; return; }
        if (hipFuncSetAttribute((const void*)mega_fwd, hipFuncAttributeMaxDynamicSharedMemorySize, LDS_BYTES) != hipSuccess) { fprintf(stderr, "kernel_launch: hipFuncSetAttribute failed\n"); grid = -1; return; }
        if (hipOccupancyMaxActiveBlocksPerMultiprocessor(&per_cu, (const void*)mega_fwd, NTHREADS, LDS_BYTES) != hipSuccess || per_cu < 1) { fprintf(stderr, "kernel_launch: occupancy query says %d\n", per_cu); per_cu = 1; }
        (void)hipGetLastError();
        grid = cus * (per_cu > 1 ? 1 : per_cu);
    }
    if (grid < 0) return;
    if (hipMemsetAsync((char*)d_ws + WS_CTL, 0, 65536 + 14 * 68 * 256, stream) != hipSuccess) { fprintf(stderr, "kernel_launch: memset of the barrier words failed\n"); return; }
    Args a{};
    for (int i = 0; i < 22; ++i) a.in[i] = (const float*)d_in[i];
    a.out = (float*)d_out; a.ws = (unsigned char*)d_ws;
#if MK_ONE_LAUNCH
    a.ph_lo = 0; a.ph_hi = N_PHASES;
    void* kargs[] = {&a};
    hipError_t e = hipLaunchCooperativeKernel((const void*)mega_fwd, dim3(grid), dim3(NTHREADS), kargs, LDS_BYTES, stream);
    if (e != hipSuccess) fprintf(stderr, "kernel_launch: cooperative launch failed: %s (grid %d)\n", hipGetErrorString(e), grid);
#else
    for (int ph = 0; ph < N_PHASES; ++ph) { if (ph == SKIP_PHASE) continue; a.ph_lo = ph; a.ph_hi = ph + 1;
        hipLaunchKernelGGL(mega_fwd, dim3(grid), dim3(NTHREADS), LDS_BYTES, stream, a);
        const hipError_t le = hipPeekAtLastError(); if (le != hipSuccess) { fprintf(stderr, "kernel_launch: launch of phase %d failed: %s\n", ph, hipGetErrorName(le)); break; } }
#endif
}
```

```cpp
#include <hip/hip_runtime.h>
#include <hip/hip_cooperative_groups.h>
#include <cstdio>
#include <cstdint>
namespace cg = cooperative_groups;
namespace pg8 {
#define PG8_LAS __attribute__((address_space(3)))
typedef unsigned short bf16_t;
typedef short bf16x8 __attribute__((ext_vector_type(8)));
typedef float f32x4 __attribute__((ext_vector_type(4)));
typedef unsigned u32x4 __attribute__((ext_vector_type(4)));
constexpr int BM = 256, BK = 64, HALF = 128, HTB = HALF * BK * 2  , STAGE_BYTES = 8 * HTB, NXCD = 8, WGM = 8;

__host__ __device__ __forceinline__ int lds_byte(int r, int c) { const int st = (r >> 4) * 2 + (c >> 5), rr = r & 15, cc = c & 31, ob = rr * 64 + cc * 2; return st * 1024 + (ob ^ (((ob >> 9) & 1) << 5)); }
__host__ __device__ __forceinline__ void stage_rc(int b, int& R, int& C) { const int st = b / 1024, sb = b % 1024, swz = sb ^ (((sb >> 9) & 1) << 5); R = (st >> 1) * 16 + swz / 64; C = (st & 1) * 32 + (swz % 64) / 2; }
__host__ __device__ __forceinline__ int perm32(int rho) { const int n = rho >> 4, i = rho & 15; return 8 * (i >> 2) + 4 * n + (i & 3); }

struct Unit { int pm, pn, kt0, nkt; };
struct Gemm { const bf16_t* A; const bf16_t* Bt; int M, N, K; };

struct StaticOrder {
    int nM, nN, nwg, G, c, nkt;
    __host__ __device__ void init(int M, int N, int K, int G_, int c_) { nM = M / BM; nN = N / BM; nwg = nM * nN; G = G_; c = c_; nkt = K / BK; }
    __host__ __device__ bool next(int i, Unit& u) const {
        const long L = (long)i * G + c; if (L >= nwg) return false;
        int wgid = (int)L; { const int q = nwg / NXCD, r = nwg % NXCD, xcd = wgid % NXCD, off = wgid / NXCD; wgid = (xcd < r ? xcd * (q + 1) : r * (q + 1) + (xcd - r) * q) + off; }
        const int nig = WGM * nN, gid = wgid / nig, fm = gid * WGM, gsz = (nM - fm) < WGM ? (nM - fm) : WGM;
        u.pm = fm + ((wgid % nig) % gsz); u.pn = (wgid % nig) / gsz; u.kt0 = 0; u.nkt = nkt; return true;
    }
    __device__ __forceinline__ void a_ready(const Unit&) const {}
    __device__ __forceinline__ void done(const Unit&) const {}
};

__device__ __forceinline__ unsigned cvt_pk_bf16(float lo, float hi) { unsigned r; asm volatile("v_cvt_pk_bf16_f32 %0, %1, %2" : "=v"(r) : "v"(lo), "v"(hi)); return r; }
typedef float f32x2 __attribute__((ext_vector_type(2)));
__device__ __forceinline__ f32x2 gelu_pk(f32x2 v) {
    const f32x2 av = __builtin_elementwise_abs(v), d = av * 0.2316418882f + 1.0f;
    f32x2 t; t.x = __builtin_amdgcn_rcpf(d.x); t.y = __builtin_amdgcn_rcpf(d.y);
    f32x2 q = t * 0.5307027145f + (-0.7265760135f); q = q * t + 0.7107068705f; q = q * t + (-0.142248368f); q = q * t + 0.127414796f; q = q * t;
    const f32x2 s = (v * v) * (-0.72134752044f);
    f32x2 e; e.x = __builtin_amdgcn_exp2f(s.x); e.y = __builtin_amdgcn_exp2f(s.y);
    const f32x2 m = v * (q * e), r = v - m;
    f32x2 o; o.x = v.x < 0.f ? m.x : r.x; o.y = v.y < 0.f ? m.y : r.y; return o;
}
__device__ __forceinline__ float silu_f(float x) { return x * __builtin_amdgcn_rcpf(1.0f + __builtin_amdgcn_exp2f(-1.4426950408889634f * x)); }
__device__ __forceinline__ void st8(bf16_t* p, f32x4 v0, f32x4 v1) { u32x4 w; w.x = cvt_pk_bf16(v0[0], v0[1]); w.y = cvt_pk_bf16(v0[2], v0[3]); w.z = cvt_pk_bf16(v1[0], v1[1]); w.w = cvt_pk_bf16(v1[2], v1[3]); *(u32x4*)p = w; }
struct EpiStore {
    static constexpr bool PERM = true, AFTER_DRAIN = false;
    bf16_t* O; int ldc;
    __device__ __forceinline__ void operator()(const f32x4 (&acc)[2][2][4][2], const Unit& u, int wr, int wc, int fr, int fq) const {
        const int row0 = u.pm * BM + wr * 64 + fr, col0 = u.pn * BM + wc * 32 + 8 * fq;
#pragma unroll
        for (int ai = 0; ai < 2; ++ai)
#pragma unroll
            for (int m = 0; m < 4; ++m) { bf16_t* rowp = O + (size_t)(row0 + ai * HALF + m * 16) * ldc + col0;
#pragma unroll
                for (int bj = 0; bj < 2; ++bj) st8(rowp + bj * HALF, acc[ai][bj][m][0], acc[ai][bj][m][1]); }
    }
};
struct EpiSwiGLU {
    static constexpr bool PERM = true, AFTER_DRAIN = false;
    bf16_t* O; int ldc;
    __device__ __forceinline__ void operator()(const f32x4 (&acc)[2][2][4][2], const Unit& u, int wr, int wc, int fr, int fq) const {
        const int row0 = u.pm * BM + wr * 64 + fr, col0 = u.pn * HALF + wc * 32 + 8 * fq;
#pragma unroll
        for (int ai = 0; ai < 2; ++ai)
#pragma unroll
            for (int m = 0; m < 4; ++m) { bf16_t* rowp = O + (size_t)(row0 + ai * HALF + m * 16) * ldc + col0;
                f32x4 v0, v1;
#pragma unroll
                for (int j = 0; j < 4; ++j) { v0[j] = silu_f(acc[ai][0][m][0][j]) * acc[ai][1][m][0][j]; v1[j] = silu_f(acc[ai][0][m][1][j]) * acc[ai][1][m][1][j]; }
                st8(rowp, v0, v1); }
    }
};
struct EpiP {
    static constexpr bool PERM = true, AFTER_DRAIN = false;
    bf16_t* O; int ldc; float* G;
    __device__ __forceinline__ void operator()(const f32x4 (&acc)[2][2][4][2], const Unit& u, int wr, int wc, int fr, int fq) const {
        const int row0 = u.pm * BM + wr * 64 + fr, col0 = u.pn * BM + wc * 32 + 8 * fq;
        const bool gt = (u.pn == 9) && (wc == 2) && (fq < 2);
#pragma unroll
        for (int ai = 0; ai < 2; ++ai)
#pragma unroll
            for (int m = 0; m < 4; ++m) { const int row = row0 + ai * HALF + m * 16; bf16_t* rowp = O + (size_t)row * ldc + col0;
#pragma unroll
                for (int bj = 0; bj < 2; ++bj) st8(rowp + bj * HALF, acc[ai][bj][m][0], acc[ai][bj][m][1]);
                if (gt) { *(f32x4*)(G + (size_t)row * 16 + 8 * fq) = acc[ai][1][m][0]; *(f32x4*)(G + (size_t)row * 16 + 8 * fq + 4) = acc[ai][1][m][1]; } }
    }
};
struct EpiSlab {
    static constexpr bool PERM = false, AFTER_DRAIN = false;
    float* S;
    __device__ __forceinline__ void operator()(const f32x4 (&acc)[2][2][4][2], const Unit& u, int wr, int wc, int fr, int fq) const {
        const int row0 = (u.pm / 17) * BM + wr * 64 + fr, col0 = u.pn * BM + wc * 32 + 4 * fq; const int slice = u.kt0 / u.nkt;
        float* base = S + (size_t)slice * 1024 * 1024;
#pragma unroll
        for (int ai = 0; ai < 2; ++ai)
#pragma unroll
            for (int m = 0; m < 4; ++m) { float* rowp = base + (size_t)(row0 + ai * HALF + m * 16) * 1024 + col0;
#pragma unroll
                for (int bj = 0; bj < 2; ++bj)
#pragma unroll
                    for (int n = 0; n < 2; ++n) *(f32x4*)(rowp + bj * HALF + n * 16) = acc[ai][bj][m][n]; }
    }
};
struct TileOrder {
    int mode, nM, nN, nwg, G, c, nkt, nsl;
    __device__ void init(int mode_, int N, int K, int G_, int c_, int nsl_) { mode = mode_; nN = N / BM; G = G_; c = c_; nsl = nsl_;
        if (mode == 2) { nM = 4; nwg = 4 * nN * nsl; nkt = (K / BK) / nsl; } else { nM = mode == 1 ? 64 : 68; nwg = nM * nN; nkt = K / BK; } }
    __device__ bool next(int i, Unit& u) const {
        const long L = (long)i * G + c; if (L >= nwg) return false;
        if (mode == 2) { const int sl = (int)L % nsl, t = (int)L / nsl; u.pn = t % nN; u.pm = 17 * (t / nN); u.kt0 = sl * nkt; u.nkt = nkt; return true; }
        int wgid = (int)L; { const int q = nwg / NXCD, r = nwg % NXCD, xcd = wgid % NXCD, off = wgid / NXCD; wgid = (xcd < r ? xcd * (q + 1) : r * (q + 1) + (xcd - r) * q) + off; }
        const int nig = WGM * nN, gid = wgid / nig, fm = gid * WGM, gsz = (nM - fm) < WGM ? (nM - fm) : WGM;
        int pm = fm + ((wgid % nig) % gsz); u.pn = (wgid % nig) / gsz; if (mode == 1) pm += (pm >> 4) + 1;
        u.pm = pm; u.kt0 = 0; u.nkt = nkt;
        if (mode == 3) { if (u.pn < 3) { u.kt0 = 0; u.nkt = 4; } else { u.kt0 = 4; u.nkt = 2; } }
        return true;
    }
    __device__ __forceinline__ void a_ready(const Unit&) const {}
    __device__ __forceinline__ void done(const Unit&) const {}
};

struct PanelSS {
    unsigned* xbuf;
    unsigned* cnt;
    __device__ __forceinline__ void run(const f32x4 (&v)[2][2][4][2], const Unit& u, int wr, int wc, int fr, int fq, PG8_LAS unsigned char* lds, int wid, int lane) const {
        PG8_LAS float* P = (PG8_LAS float*)lds;
        PG8_LAS float* S = (PG8_LAS float*)(lds + 8192);
#pragma unroll
        for (int ai = 0; ai < 2; ++ai)
#pragma unroll
            for (int m = 0; m < 4; ++m) { float s = 0.f;
#pragma unroll
                for (int bj = 0; bj < 2; ++bj)
#pragma unroll
                    for (int n = 0; n < 2; ++n) { const f32x4 x = v[ai][bj][m][n]; s += (x[0] * x[0] + x[1] * x[1]) + (x[2] * x[2] + x[3] * x[3]); }
                s += __shfl_xor(s, 16); s += __shfl_xor(s, 32);
                if (fq == 0) P[(ai * HALF + wr * 64 + m * 16 + fr) * 4 + wc] = s; }
        asm volatile("s_waitcnt lgkmcnt(0)" ::: "memory"); __builtin_amdgcn_s_barrier(); asm volatile("" ::: "memory");
        const int row = wid * 32 + (lane & 31);
        if (lane < 32) { const float t = (P[row * 4 + 0] + P[row * 4 + 1]) + (P[row * 4 + 2] + P[row * 4 + 3]);
            __hip_atomic_store(xbuf + (size_t)(u.pm * BM + row) * 4 + u.pn, __float_as_uint(t), __ATOMIC_RELAXED, __HIP_MEMORY_SCOPE_AGENT); }
        asm volatile("s_waitcnt vmcnt(0)" ::: "memory");
        if (lane == 0) __hip_atomic_fetch_add(cnt + 64 * u.pm, 1u, __ATOMIC_RELAXED, __HIP_MEMORY_SCOPE_AGENT);
        if (wid == 0) { unsigned sp = 0;
            while ((unsigned)__builtin_amdgcn_readfirstlane(__hip_atomic_load(cnt + 64 * u.pm, __ATOMIC_RELAXED, __HIP_MEMORY_SCOPE_AGENT)) < 32u) { __builtin_amdgcn_s_sleep(2); if (++sp > (1u << 22)) break; }
            __builtin_amdgcn_fence(__ATOMIC_ACQUIRE, "agent"); }
        asm volatile("s_waitcnt vmcnt(0) lgkmcnt(0)" ::: "memory"); __builtin_amdgcn_s_barrier(); asm volatile("" ::: "memory");
        if (lane < 32) { const unsigned* slot = xbuf + (size_t)(u.pm * BM + row) * 4; float t = 0.f;
#pragma unroll
            for (int q = 0; q < 4; ++q) t += __uint_as_float(__hip_atomic_load(slot + q, __ATOMIC_RELAXED, __HIP_MEMORY_SCOPE_AGENT));
            S[row] = t; }
        asm volatile("s_waitcnt lgkmcnt(0)" ::: "memory"); __builtin_amdgcn_s_barrier(); asm volatile("" ::: "memory");
    }
};
struct EpiNormRes {
    static constexpr bool PERM = false, AFTER_DRAIN = true;
    const float* xsrc; float* xdst;
    bf16_t* H;
    const float* gate; const float* gpost;
    const float* gpre; const float* sc; const float* sh;
    float wgt; PanelSS st1, st2;
    __device__ __forceinline__ void fused(f32x4 (&acc)[2][2][4][2], const Unit& u, int wr, int wc, int fr, int fq, PG8_LAS unsigned char* lds, int wid, int lane) const {
        const PG8_LAS float* S = (const PG8_LAS float*)(lds + 8192);
        const int b = u.pm / 17, tp = (u.pm - 17 * b - 1) * BM;
        const int col0 = u.pn * BM + wc * 32 + 4 * fq; const size_t mo = (size_t)b * 9 * 1024;
        st1.run(acc, u, wr, wc, fr, fq, lds, wid, lane);
        {   f32x4 cg[2][2];
#pragma unroll
            for (int bj = 0; bj < 2; ++bj)
#pragma unroll
                for (int n = 0; n < 2; ++n) cg[bj][n] = *(const f32x4*)(gate + mo + col0 + bj * HALF + n * 16) * *(const f32x4*)(gpost + col0 + bj * HALF + n * 16) * wgt;
#pragma unroll
            for (int ai = 0; ai < 2; ++ai)
#pragma unroll
                for (int m = 0; m < 4; ++m) { const int r = ai * HALF + wr * 64 + m * 16 + fr; const float rs = 1.0f / sqrtf(S[r] * (1.0f / 1024.0f) + 1e-6f);
                    const size_t off = ((size_t)b * 4096 + tp + r) * 1024 + col0;
#pragma unroll
                    for (int bj = 0; bj < 2; ++bj)
#pragma unroll
                        for (int n = 0; n < 2; ++n) { const f32x4 xo = *(const f32x4*)(xsrc + off + bj * HALF + n * 16); const f32x4 xn = xo + cg[bj][n] * (acc[ai][bj][m][n] * rs);
                            acc[ai][bj][m][n] = xn; *(f32x4*)(xdst + off + bj * HALF + n * 16) = xn; }
                    asm volatile("" : "+v"(acc[ai][0][m][0]), "+v"(acc[ai][0][m][1]), "+v"(acc[ai][1][m][0]), "+v"(acc[ai][1][m][1]));
                    if (m & 1) asm volatile("" ::: "memory"); } }
        if (H == nullptr) return;
        asm volatile("s_waitcnt lgkmcnt(0)" ::: "memory"); __builtin_amdgcn_s_barrier(); asm volatile("" ::: "memory");
        st2.run(acc, u, wr, wc, fr, fq, lds, wid, lane);
        {   typedef unsigned u32x2v __attribute__((ext_vector_type(2)));
            f32x4 ca[2][2], cs[2][2];
#pragma unroll
            for (int bj = 0; bj < 2; ++bj)
#pragma unroll
                for (int n = 0; n < 2; ++n) { const int c = col0 + bj * HALF + n * 16; ca[bj][n] = *(const f32x4*)(gpre + c) * (*(const f32x4*)(sc + mo + c) + 1.0f); cs[bj][n] = *(const f32x4*)(sh + mo + c); }
#pragma unroll
            for (int ai = 0; ai < 2; ++ai)
#pragma unroll
                for (int m = 0; m < 4; ++m) { const int r = ai * HALF + wr * 64 + m * 16 + fr; const float rs = 1.0f / sqrtf(S[r] * (1.0f / 1024.0f) + 1e-6f);
                    bf16_t* hp = H + (size_t)(u.pm * BM + r) * 1024 + col0;
#pragma unroll
                    for (int bj = 0; bj < 2; ++bj)
#pragma unroll
                        for (int n = 0; n < 2; ++n) { const f32x4 o = acc[ai][bj][m][n] * rs * ca[bj][n] + cs[bj][n]; u32x2v w; w.x = cvt_pk_bf16(o[0], o[1]); w.y = cvt_pk_bf16(o[2], o[3]);
                            *(u32x2v*)(hp + bj * HALF + n * 16) = w; } } }
    }
};

template <class Epi, class Sched, bool ALIGN_EPI = false, bool SP2 = false>
__device__ __forceinline__ void gemm_phase(PG8_LAS unsigned char* lds, const Gemm g, const Sched& S, const Epi& E) {
    int tid_ = threadIdx.x; asm volatile("" : "+v"(tid_));
    const int tid = tid_, wid = __builtin_amdgcn_readfirstlane(tid >> 6), lane = tid & 63, wr = wid >> 2, wc = wid & 3, fr = lane & 15, fq = lane >> 4;
    const int K = g.K;
    unsigned voffA[2], voffB[2];
#pragma unroll
    for (int i = 0; i < 2; ++i) { int R, C; stage_rc(tid * 16 + i * 8192, R, C); const int Rb = Epi::PERM ? ((R & ~31) + perm32(R & 31)) : R;
        voffA[i] = (unsigned)(R * K + C) * 2u; voffB[i] = (unsigned)(Rb * K + C) * 2u; }
    const size_t kstep = (size_t)(BK * 2);
    const size_t hstep = (size_t)HALF * K * 2;
    const size_t tstep = 2 * hstep;
    const unsigned ldsw = (unsigned)wid * 1024u;
    const int aoff = lds_byte(wr * 64 + fr, fq * 8), boff = lds_byte(wc * 32 + fr, fq * 8);
#define PG8_SA(b, h) (((b) * 2 + (h)) * HTB)
#define PG8_SB(b, h) ((4 + (b) * 2 + (h)) * HTB)
#define PG8_STAGE(bufoff, gbase, voff) do { _Pragma("unroll") for (int _i = 0; _i < 2; ++_i) \
        __builtin_amdgcn_global_load_lds((const unsigned*)((const char*)(gbase) + (voff)[_i]), (PG8_LAS unsigned*)(lds + (bufoff) + ldsw + _i * 8192), 16, 0, 0); } while (0)
#define PG8_LDA(dst, b, h) do { _Pragma("unroll") for (int m = 0; m < 4; ++m) _Pragma("unroll") for (int k = 0; k < 2; ++k) dst[m][k] = *(const PG8_LAS bf16x8*)(lds + PG8_SA(b, h) + aoff + m * 2048 + k * 1024); } while (0)
#define PG8_LDB(dst, b, h) do { _Pragma("unroll") for (int n = 0; n < 2; ++n) _Pragma("unroll") for (int k = 0; k < 2; ++k) dst[n][k] = *(const PG8_LAS bf16x8*)(lds + PG8_SB(b, h) + boff + n * 2048 + k * 1024); } while (0)
#define PG8_MMA(ai, bj, At, Bt) do { __builtin_amdgcn_s_setprio(1); _Pragma("unroll") for (int m = 0; m < 4; ++m) _Pragma("unroll") for (int n = 0; n < 2; ++n) _Pragma("unroll") for (int k = 0; k < 2; ++k) \
        acc[ai][bj][m][n] = __builtin_amdgcn_mfma_f32_16x16x32_bf16(Bt[n][k], At[m][k], acc[ai][bj][m][n], 0, 0, 0); __builtin_amdgcn_s_setprio(0); } while (0)
#define PG8_WAIT_V(n) asm volatile("s_waitcnt vmcnt(" #n ")" ::: "memory")
#define PG8_WAIT_L(n) asm volatile("s_waitcnt lgkmcnt(" #n ")" ::: "memory")
#define PG8_BAR __builtin_amdgcn_s_barrier()
#define PG8_SCHED __builtin_amdgcn_sched_barrier(0)
    Unit cur, nxt; int ui = 0;
    if (!S.next(0, cur)) return;
    f32x4 acc[2][2][4][2];
#pragma unroll
    for (int a = 0; a < 2; ++a)
#pragma unroll
        for (int b = 0; b < 2; ++b)
#pragma unroll
            for (int m = 0; m < 4; ++m)
#pragma unroll
                for (int n = 0; n < 2; ++n) acc[a][b][m][n] = (f32x4){0.f, 0.f, 0.f, 0.f};
    bf16x8 At[4][2], B0[2][2], B1[2][2];
    const char* cA = (const char*)g.A + (size_t)cur.pm * tstep + (size_t)cur.kt0 * kstep; const char* cB = (const char*)g.Bt + (size_t)cur.pn * tstep + (size_t)cur.kt0 * kstep;
    S.a_ready(cur);
    if constexpr (SP2) {
        PG8_STAGE(PG8_SB(0, 0), cB, voffB); PG8_STAGE(PG8_SB(0, 1), cB + hstep, voffB); PG8_STAGE(PG8_SA(0, 0), cA, voffA); PG8_STAGE(PG8_SA(0, 1), cA + hstep, voffA);
        if (wr == 1) PG8_BAR;
        PG8_WAIT_V(2); PG8_BAR;
        PG8_STAGE(PG8_SB(1, 0), cB + kstep, voffB); PG8_STAGE(PG8_SA(1, 0), cA + kstep, voffA); PG8_STAGE(PG8_SB(1, 1), cB + hstep + kstep, voffB);
        PG8_WAIT_V(6); PG8_BAR;
    } else {
        PG8_STAGE(PG8_SB(0, 0), cB, voffB); PG8_STAGE(PG8_SA(0, 0), cA, voffA); PG8_STAGE(PG8_SB(0, 1), cB + hstep, voffB); PG8_STAGE(PG8_SA(0, 1), cA + hstep, voffA);
        if (wr == 1) PG8_BAR;
        PG8_WAIT_V(4); PG8_BAR;
        PG8_STAGE(PG8_SB(1, 0), cB + kstep, voffB); PG8_STAGE(PG8_SA(1, 0), cA + kstep, voffA); PG8_STAGE(PG8_SB(1, 1), cB + hstep + kstep, voffB);
        PG8_WAIT_V(6); PG8_BAR;
    }
    for (;;) {
        const bool has_next = S.next(ui + 1, nxt);
        const char* nA = has_next ? (const char*)g.A + (size_t)nxt.pm * tstep + (size_t)nxt.kt0 * kstep : cA; const char* nB = has_next ? (const char*)g.Bt + (size_t)nxt.pn * tstep + (size_t)nxt.kt0 * kstep : cB;
        const int nt = cur.nkt;
        for (int t = 0; t < nt; t += 2) {
            const bool last = (t == nt - 2);
            const char* a1 = cA + (size_t)(t + 1) * kstep;
            const char* a2 = last ? nA : cA + (size_t)(t + 2) * kstep; const char* b2 = last ? nB : cB + (size_t)(t + 2) * kstep;
            const char* a3 = a2 + kstep; const char* b3 = b2 + kstep;
            if (last && has_next) S.a_ready(nxt);
            if constexpr (SP2) {
            PG8_LDB(B0, 0, 0); PG8_LDB(B1, 0, 1); PG8_SCHED; PG8_LDA(At, 0, 0); PG8_STAGE(PG8_SA(1, 1), a1 + hstep, voffA);
            PG8_WAIT_V(8); PG8_WAIT_L(0); PG8_BAR; PG8_MMA(0, 0, At, B0); PG8_MMA(0, 1, At, B1); PG8_BAR; PG8_SCHED;
            PG8_LDA(At, 0, 1); PG8_STAGE(PG8_SB(0, 0), b2, voffB); PG8_STAGE(PG8_SB(0, 1), b2 + hstep, voffB); PG8_STAGE(PG8_SA(0, 0), a2, voffA);
            PG8_WAIT_V(8); PG8_WAIT_L(0); PG8_BAR; PG8_MMA(1, 0, At, B0); PG8_MMA(1, 1, At, B1); PG8_BAR; PG8_SCHED;
            PG8_LDB(B0, 1, 0); PG8_LDB(B1, 1, 1); PG8_SCHED; PG8_LDA(At, 1, 0); PG8_STAGE(PG8_SA(0, 1), a2 + hstep, voffA);
            PG8_WAIT_V(8); PG8_WAIT_L(0); PG8_BAR; PG8_MMA(0, 0, At, B0); PG8_MMA(0, 1, At, B1); PG8_BAR; PG8_SCHED;
            PG8_LDA(At, 1, 1); PG8_STAGE(PG8_SB(1, 0), b3, voffB); PG8_STAGE(PG8_SB(1, 1), b3 + hstep, voffB); PG8_STAGE(PG8_SA(1, 0), a3, voffA);
            PG8_WAIT_V(8); PG8_WAIT_L(0); PG8_BAR; PG8_MMA(1, 0, At, B0); PG8_MMA(1, 1, At, B1); PG8_BAR; PG8_SCHED;
            } else {
            PG8_LDB(B0, 0, 0); PG8_SCHED; PG8_LDA(At, 0, 0); PG8_STAGE(PG8_SA(1, 1), a1 + hstep, voffA);
            PG8_WAIT_L(8); PG8_BAR; PG8_WAIT_L(0); PG8_MMA(0, 0, At, B0); PG8_BAR; PG8_SCHED;
            PG8_LDB(B1, 0, 1); PG8_STAGE(PG8_SB(0, 0), b2, voffB);
            PG8_BAR; PG8_WAIT_L(0); PG8_MMA(0, 1, At, B1); PG8_BAR;
            PG8_LDA(At, 0, 1); PG8_STAGE(PG8_SA(0, 0), a2, voffA);
            PG8_BAR; PG8_WAIT_L(0); PG8_MMA(1, 0, At, B0); PG8_BAR; PG8_SCHED;
            PG8_STAGE(PG8_SB(0, 1), b2 + hstep, voffB);
            PG8_WAIT_V(6); PG8_BAR; PG8_MMA(1, 1, At, B1); PG8_BAR;
            PG8_LDB(B0, 1, 0); PG8_SCHED; PG8_LDA(At, 1, 0); PG8_STAGE(PG8_SA(0, 1), a2 + hstep, voffA);
            PG8_WAIT_L(8); PG8_BAR; PG8_WAIT_L(0); PG8_MMA(0, 0, At, B0); PG8_BAR; PG8_SCHED;
            PG8_LDB(B1, 1, 1); PG8_STAGE(PG8_SB(1, 0), b3, voffB);
            PG8_BAR; PG8_WAIT_L(0); PG8_MMA(0, 1, At, B1); PG8_BAR;
            PG8_LDA(At, 1, 1); PG8_STAGE(PG8_SA(1, 0), a3, voffA);
            PG8_BAR; PG8_WAIT_L(0); PG8_MMA(1, 0, At, B0); PG8_BAR; PG8_SCHED;
            PG8_STAGE(PG8_SB(1, 1), b3 + hstep, voffB);
            PG8_WAIT_V(6); PG8_BAR; PG8_MMA(1, 1, At, B1); PG8_BAR;
            }
        }
        if constexpr (ALIGN_EPI) { if (wr == 0) PG8_BAR; }
        if constexpr (!Epi::AFTER_DRAIN) { E(acc, cur, wr, wc, fr, fq); S.done(cur); }
        if (!has_next) break;
#pragma unroll
        for (int a = 0; a < 2; ++a)
#pragma unroll
            for (int b = 0; b < 2; ++b)
#pragma unroll
                for (int m = 0; m < 4; ++m)
#pragma unroll
                    for (int n = 0; n < 2; ++n) acc[a][b][m][n] = (f32x4){0.f, 0.f, 0.f, 0.f};
        cur = nxt; cA = nA; cB = nB; ++ui;
        if constexpr (ALIGN_EPI) { if (wr == 1) PG8_BAR; }
    }
    PG8_WAIT_V(0);
    if constexpr (!ALIGN_EPI) { if (wr == 0) PG8_BAR; }
    PG8_BAR;
    if constexpr (Epi::AFTER_DRAIN) { E.fused(acc, cur, wr, wc, fr, fq, lds, wid, lane); S.done(cur); }
#undef PG8_SA
#undef PG8_SB
#undef PG8_STAGE
#undef PG8_LDA
#undef PG8_LDB
#undef PG8_MMA
#undef PG8_WAIT_V
#undef PG8_WAIT_L
#undef PG8_BAR
#undef PG8_SCHED
}
}
namespace att {
typedef unsigned short bf16;
constexpr int NW = 8, QBLK = 32, KVBLK = 64;
constexpr float SCALE = 0.07216878364870322f;
constexpr float THR = 8.f;
constexpr int SDEPTH = 1;
constexpr int LDQ = 1792, LDK = 1792, LDR = 64, LDO = 1024;
constexpr int SHM_V = KVBLK * 128 * 2, SHM_K = KVBLK * 192 * 2, SHM_QR = NW * 4 * 64 * 16, SHM_ATTN = 2 * SHM_V + 2 * SHM_K + NW * 64 * 4 + SHM_QR;
using bf16x8 = __attribute__((ext_vector_type(8))) short;
using s16x4  = __attribute__((ext_vector_type(4))) short;
using f32x16 = __attribute__((ext_vector_type(16))) float;
using u32x4  = __attribute__((ext_vector_type(4))) unsigned;
#define KSWZ(row, colB) ((row) * 384 + ((colB) ^ ((((row) >> 1) & 7) << 4)))
#define SBAR() __builtin_amdgcn_sched_barrier(0)
__device__ __forceinline__ int crow(int r, int hi) { return (r & 3) + 8 * (r >> 2) + 4 * hi; }
__device__ __forceinline__ unsigned cvtpk(float lo, float hi) { unsigned r; asm volatile("v_cvt_pk_bf16_f32 %0, %1, %2" : "=v"(r) : "v"(lo), "v"(hi)); return r; }
__device__ __forceinline__ bf16x8 ld8(const bf16* p) { return *reinterpret_cast<const bf16x8*>(p); }
__device__ __forceinline__ float bf2f(short b) { return __uint_as_float(((unsigned)(unsigned short)b) << 16); }

__device__ __forceinline__ void partialSM(f32x16& p0, f32x16& p1, float& m_reg, float& mn, float& alpha) {
  constexpr float C = SCALE * 1.4426950408889634f;
  float pmax = p0[0];
#pragma unroll
  for (int r = 1; r < 16; ++r) pmax = fmaxf(pmax, p0[r]);
#pragma unroll
  for (int r = 0; r < 16; ++r) pmax = fmaxf(pmax, p1[r]);
  { auto rr = __builtin_amdgcn_permlane32_swap(__float_as_uint(pmax), __float_as_uint(pmax), false, false);
    pmax = fmaxf(__uint_as_float(rr[0]), __uint_as_float(rr[1])); }
  if (__builtin_expect(__all(pmax - m_reg <= THR / SCALE), 1)) { mn = m_reg; alpha = 1.f; }
  else { mn = fmaxf(m_reg, pmax); alpha = __builtin_amdgcn_exp2f((m_reg - mn) * C); m_reg = mn; }
  float mnC = -mn * C;
#pragma unroll
  for (int r = 0; r < 16; ++r) p0[r] = fmaf(p0[r], C, mnC);
#pragma unroll
  for (int r = 0; r < 16; ++r) p1[r] = fmaf(p1[r], C, mnC);
#pragma unroll
  for (int r = 0; r < 16; ++r) p0[r] = __builtin_amdgcn_exp2f(p0[r]);
}
__device__ __forceinline__ void finishSM(f32x16& p0, f32x16& p1, float alpha, float& l_reg, bf16x8& pa0, bf16x8& pa1, bf16x8& pa2, bf16x8& pa3) {
#pragma unroll
  for (int r = 0; r < 16; ++r) p1[r] = __builtin_amdgcn_exp2f(p1[r]);
  float ps = 0;
#pragma unroll
  for (int r = 0; r < 16; ++r) ps += p0[r];
#pragma unroll
  for (int r = 0; r < 16; ++r) ps += p1[r];
  { auto rr = __builtin_amdgcn_permlane32_swap(__float_as_uint(ps), __float_as_uint(ps), false, false);
    ps = __uint_as_float(rr[0]) + __uint_as_float(rr[1]); }
  l_reg = l_reg * alpha + ps;
#define PK4(P, BASE, OUT) do { unsigned a0 = cvtpk(P[BASE + 0], P[BASE + 1]), a1 = cvtpk(P[BASE + 2], P[BASE + 3]);   \
    unsigned b0 = cvtpk(P[BASE + 4], P[BASE + 5]), b1 = cvtpk(P[BASE + 6], P[BASE + 7]);                              \
    auto r0 = __builtin_amdgcn_permlane32_swap(a0, b0, false, false); auto r1 = __builtin_amdgcn_permlane32_swap(a1, b1, false, false); \
    u32x4 w = {r0[0], r1[0], r0[1], r1[1]}; OUT = *reinterpret_cast<bf16x8*>(&w); } while (0)
  PK4(p0, 0, pa0); PK4(p0, 8, pa1); PK4(p1, 0, pa2); PK4(p1, 8, pa3);
#undef PK4
}
__device__ __forceinline__ void qkt(f32x16& p0, f32x16& p1, const bf16* Ks, const bf16x8 (&qr)[8], const bf16x8* qrl, int r32, int hi) {
  p0 = f32x16{}; p1 = f32x16{};
#pragma unroll
  for (int d0 = 0; d0 < 12; ++d0) { int cb = (d0 * 16 + hi * 8) * 2;
    bf16x8 b0 = *reinterpret_cast<const bf16x8*>((const char*)Ks + KSWZ(r32, cb));
    bf16x8 b1 = *reinterpret_cast<const bf16x8*>((const char*)Ks + KSWZ(32 + r32, cb));
    const bf16x8 qf = d0 < 8 ? qr[d0 < 8 ? d0 : 0] : qrl[(d0 - 8) * 64];
    p0 = __builtin_amdgcn_mfma_f32_32x32x16_bf16(b0, qf, p0, 0, 0, 0);
    p1 = __builtin_amdgcn_mfma_f32_32x32x16_bf16(b1, qf, p1, 0, 0, 0); }
}
__device__ __forceinline__ int v_st(int k, int c) { const int kk = (k & ~0xC) | ((k & 4) << 1) | ((k & 8) >> 1); return ((kk >> 3) * 4 + (c >> 5)) * 512 + ((kk & 7) * 32 + (c & 31)) * 2; }
__device__ __forceinline__ int v_rd_base(int lane) { return ((lane & 3) << 3) | (((lane >> 2) & 3) << 6) | (((lane >> 4) & 1) << 5) | (((lane >> 5) & 1) << 8); }
constexpr int v_rd_off(int d0, int ks, int half) { return d0 * 512 + ks * 4096 + half * 2048; }
template <int OFF> __device__ __forceinline__ s16x4 tr_read(int vb) {
  s16x4 r; asm volatile("ds_read_b64_tr_b16 %0, %1 offset:%2" : "=&v"(r) : "v"(vb), "i"(OFF) : "memory"); return r;
}
template <int D0> __device__ __forceinline__ void pv_one(f32x16& od, int vb, bf16x8 pa0, bf16x8 pa1, bf16x8 pa2, bf16x8 pa3) {
  const s16x4 l0 = tr_read<v_rd_off(D0, 0, 0)>(vb), h0 = tr_read<v_rd_off(D0, 0, 1)>(vb), l1 = tr_read<v_rd_off(D0, 1, 0)>(vb), h1 = tr_read<v_rd_off(D0, 1, 1)>(vb);
  const s16x4 l2 = tr_read<v_rd_off(D0, 2, 0)>(vb), h2 = tr_read<v_rd_off(D0, 2, 1)>(vb), l3 = tr_read<v_rd_off(D0, 3, 0)>(vb), h3 = tr_read<v_rd_off(D0, 3, 1)>(vb);
  asm volatile("s_waitcnt lgkmcnt(0)" ::: "memory"); SBAR();
#define PK(L, H) (bf16x8){L[0], L[1], L[2], L[3], H[0], H[1], H[2], H[3]}
  od = __builtin_amdgcn_mfma_f32_32x32x16_bf16(pa0, PK(l0, h0), od, 0, 0, 0);
  od = __builtin_amdgcn_mfma_f32_32x32x16_bf16(pa1, PK(l1, h1), od, 0, 0, 0);
  od = __builtin_amdgcn_mfma_f32_32x32x16_bf16(pa2, PK(l2, h2), od, 0, 0, 0);
  od = __builtin_amdgcn_mfma_f32_32x32x16_bf16(pa3, PK(l3, h3), od, 0, 0, 0);
#undef PK
}
__device__ __forceinline__ void pv_d0(f32x16 (&o)[4], int vb, bf16x8 pa0, bf16x8 pa1, bf16x8 pa2, bf16x8 pa3) {
  pv_one<0>(o[0], vb, pa0, pa1, pa2, pa3); pv_one<1>(o[1], vb, pa0, pa1, pa2, pa3); pv_one<2>(o[2], vb, pa0, pa1, pa2, pa3); pv_one<3>(o[3], vb, pa0, pa1, pa2, pa3);
}
__device__ __forceinline__ void attn_body(const bf16* __restrict__ Qb, const bf16* __restrict__ Kn, const bf16* __restrict__ Vh, const bf16* __restrict__ Kr,
                                          bf16* __restrict__ Ob, int seq, int rope, int qtok0, const float* __restrict__ tab, char* lds,
                                          unsigned* __restrict__ xs, unsigned* __restrict__ cnt, const float* __restrict__ gain, int head) {
  int tid_ = threadIdx.x; asm volatile("" : "+v"(tid_));
  const int tid = tid_, wid = tid >> 6, lane = tid & 63, r32 = lane & 31, hi = lane >> 5;
  bf16* V_lds = (bf16*)lds; bf16* K_lds = (bf16*)(lds + 2 * SHM_V);
  float* ws = (float*)(lds + 2 * SHM_V + 2 * SHM_K) + wid * 64; float* li_l = ws; float* al_l = ws + 32;
  float m_reg = -1e30f, l_reg = 0; f32x16 o[4] = {}; bf16x8 qr[8]; bf16x8 qx[4];
  bf16x8* qrl = (bf16x8*)(lds + 2 * SHM_V + 2 * SHM_K + NW * 64 * 4) + wid * 256 + lane;
  const bf16* Qw = Qb + (long)(wid * QBLK + r32) * LDQ + hi * 8;
#pragma unroll
  for (int d0 = 0; d0 < 8; ++d0) qr[d0] = ld8(Qw + d0 * 16);
#pragma unroll
  for (int d0 = 0; d0 < 4; ++d0) qx[d0] = ld8(Qw + 128 + d0 * 16);
  if (rope) {
    const int tt = qtok0 + wid * QBLK + r32; const int prow = tt >> 6, pcol = tt & 63;
    const float* tr = tab + (prow * 16 + hi * 8) * 2; const float* tc = tab + (pcol * 16 + hi * 8) * 2;
    unsigned a1[4], a2[4], c1[4], c2[4];
#pragma unroll
    for (int j = 0; j < 8; j += 2) {
      float o1[2], o2[2], p1[2], p2[2];
#pragma unroll
      for (int e = 0; e < 2; ++e) {
        const float cr = tr[(j + e) * 2], sr_ = tr[(j + e) * 2 + 1], cc = tc[(j + e) * 2], sc_ = tc[(j + e) * 2 + 1];
        const float x1 = bf2f(qx[0][j + e]), x2 = bf2f(qx[1][j + e]), y1 = bf2f(qx[2][j + e]), y2 = bf2f(qx[3][j + e]);
        o1[e] = x1 * cr - x2 * sr_; o2[e] = x2 * cr + x1 * sr_; p1[e] = y1 * cc - y2 * sc_; p2[e] = y2 * cc + y1 * sc_; }
      a1[j >> 1] = cvtpk(o1[0], o1[1]); a2[j >> 1] = cvtpk(o2[0], o2[1]); c1[j >> 1] = cvtpk(p1[0], p1[1]); c2[j >> 1] = cvtpk(p2[0], p2[1]); }
    { u32x4 w = {a1[0], a1[1], a1[2], a1[3]}; qx[0] = *reinterpret_cast<bf16x8*>(&w); }
    { u32x4 w = {a2[0], a2[1], a2[2], a2[3]}; qx[1] = *reinterpret_cast<bf16x8*>(&w); }
    { u32x4 w = {c1[0], c1[1], c1[2], c1[3]}; qx[2] = *reinterpret_cast<bf16x8*>(&w); }
    { u32x4 w = {c2[0], c2[1], c2[2], c2[3]}; qx[3] = *reinterpret_cast<bf16x8*>(&w); }
  }
#pragma unroll
  for (int d0 = 0; d0 < 4; ++d0) qrl[d0 * 64] = qx[d0];
  const int sr = tid >> 4, sc = (tid & 15) * 8, vst0 = v_st(sr, sc), vst1 = v_st(32 + sr, sc);
  const int rr = tid >> 3, rc = (tid & 7) * 8;
  const int vb0 = (int)(uintptr_t)V_lds + v_rd_base(lane);
  struct { bf16x8 vs0, vs1, ks0, ks1, kr0; } sr_[SDEPTH];
#define SLOAD(i, k0) do { sr_[i].vs0 = ld8(&Vh[(long)((k0) + sr) * LDK + sc]); sr_[i].vs1 = ld8(&Vh[(long)((k0) + 32 + sr) * LDK + sc]); \
    sr_[i].ks0 = ld8(&Kn[(long)((k0) + sr) * LDK + sc]); sr_[i].ks1 = ld8(&Kn[(long)((k0) + 32 + sr) * LDK + sc]); sr_[i].kr0 = ld8(&Kr[(long)((k0) + rr) * LDR + rc]); } while (0)
#define SWRITE(b, i) do { *(bf16x8*)((char*)V_lds + (b) * SHM_V + vst0) = sr_[i].vs0;          \
    *(bf16x8*)((char*)V_lds + (b) * SHM_V + vst1) = sr_[i].vs1; int kc = sc * 2;               \
    *(bf16x8*)((char*)K_lds + (b) * SHM_K + KSWZ(sr, kc)) = sr_[i].ks0;                       \
    *(bf16x8*)((char*)K_lds + (b) * SHM_K + KSWZ(32 + sr, kc)) = sr_[i].ks1;                  \
    *(bf16x8*)((char*)K_lds + (b) * SHM_K + KSWZ(rr, 256 + rc * 2)) = sr_[i].kr0; } while (0)
#define SWAIT() do { if constexpr (SDEPTH == 2) asm volatile("s_waitcnt vmcnt(5)" ::: "memory"); else asm volatile("s_waitcnt vmcnt(0)" ::: "memory"); } while (0)
#define RESC(a) do { if (__any((a) < 1.f)) { if (hi == 0) al_l[r32] = (a); asm volatile("s_waitcnt lgkmcnt(0)" ::: "memory"); \
    _Pragma("unroll") for (int d = 0; d < 4; ++d) _Pragma("unroll") for (int r = 0; r < 16; ++r) o[d][r] *= al_l[crow(r, hi)]; } } while (0)
  f32x16 pA0, pA1, pB0, pB1; float mnA, mnB, alA, alB; bf16x8 pa0, pa1, pa2, pa3; const int NT = seq / KVBLK;
  constexpr int SE = 0, SO = SDEPTH - 1;
  SLOAD(SE, 0); asm volatile("s_waitcnt vmcnt(0)" ::: "memory"); SWRITE(0, SE); __syncthreads();
  qkt(pA0, pA1, K_lds, qr, qrl, r32, hi); partialSM(pA0, pA1, m_reg, mnA, alA);
  SLOAD(SO, KVBLK); if constexpr (SDEPTH == 2) { if (2 < NT) SLOAD(SE, 2 * KVBLK); }
  SWAIT(); SWRITE(1, SO); __syncthreads();
  for (int j = 1; j + 1 < NT; j += 2) {
    SBAR(); qkt(pB0, pB1, (bf16*)((char*)K_lds + SHM_K), qr, qrl, r32, hi);
    finishSM(pA0, pA1, alA, l_reg, pa0, pa1, pa2, pa3); SBAR();
    SLOAD(SO, (j + SDEPTH) * KVBLK); SBAR();
    pv_d0(o, vb0, pa0, pa1, pa2, pa3); partialSM(pB0, pB1, m_reg, mnB, alB);
    __syncthreads(); SWAIT(); SWRITE(0, SE);
    RESC(alB); __syncthreads();
    SBAR(); qkt(pA0, pA1, K_lds, qr, qrl, r32, hi);
    finishSM(pB0, pB1, alB, l_reg, pa0, pa1, pa2, pa3); SBAR();
    if (SDEPTH == 1 || j + 3 < NT) SLOAD(SE, (j + 1 + SDEPTH) * KVBLK); SBAR();
    pv_d0(o, vb0 + (int)SHM_V, pa0, pa1, pa2, pa3); partialSM(pA0, pA1, m_reg, mnA, alA);
    __syncthreads(); SWAIT(); SWRITE(1, SO);
    RESC(alA); __syncthreads();
  }
  SBAR(); qkt(pB0, pB1, (bf16*)((char*)K_lds + SHM_K), qr, qrl, r32, hi);
  finishSM(pA0, pA1, alA, l_reg, pa0, pa1, pa2, pa3); SBAR();
  pv_d0(o, vb0, pa0, pa1, pa2, pa3); partialSM(pB0, pB1, m_reg, mnB, alB);
  __syncthreads(); RESC(alB);
  finishSM(pB0, pB1, alB, l_reg, pa0, pa1, pa2, pa3); SBAR();
  pv_d0(o, vb0 + (int)SHM_V, pa0, pa1, pa2, pa3);
  if (hi == 0) li_l[r32] = l_reg; asm volatile("s_waitcnt lgkmcnt(0)" ::: "memory");
  float rli[16];
#pragma unroll
  for (int r = 0; r < 16; ++r) rli[r] = __builtin_amdgcn_rcpf(li_l[crow(r, hi)]);
  float rs[16];
#pragma unroll
  for (int r = 0; r < 16; ++r) { float s = 0.f;
#pragma unroll
    for (int d0 = 0; d0 < 4; ++d0) { o[d0][r] *= rli[r]; s += o[d0][r] * o[d0][r]; }
    rs[r] = s; }
#pragma unroll
  for (int x = 1; x < 32; x <<= 1)
#pragma unroll
    for (int r = 0; r < 16; ++r) rs[r] += __shfl_xor(rs[r], x);
  asm volatile("s_waitcnt lgkmcnt(0)" ::: "memory");
  if (r32 == 0) {
#pragma unroll
    for (int r = 0; r < 16; ++r) al_l[crow(r, hi)] = rs[r]; }
  asm volatile("s_waitcnt lgkmcnt(0)" ::: "memory");
  if (lane < 32) __hip_atomic_store(xs + (size_t)(wid * QBLK + lane) * 4 + head, __float_as_uint(al_l[lane]), __ATOMIC_RELAXED, __HIP_MEMORY_SCOPE_AGENT);
  asm volatile("s_waitcnt vmcnt(0)" ::: "memory");
  if (lane == 0) __hip_atomic_fetch_add(cnt, 1u, __ATOMIC_RELAXED, __HIP_MEMORY_SCOPE_AGENT);
  if (wid == 0) { unsigned sp = 0;
    while ((unsigned)__builtin_amdgcn_readfirstlane(__hip_atomic_load(cnt, __ATOMIC_RELAXED, __HIP_MEMORY_SCOPE_AGENT)) < 32u) { __builtin_amdgcn_s_sleep(2); if (++sp > (1u << 22)) break; }
    __builtin_amdgcn_fence(__ATOMIC_ACQUIRE, "agent"); }
  asm volatile("s_waitcnt vmcnt(0) lgkmcnt(0)" ::: "memory"); __syncthreads();
  if (lane < 32) { const unsigned* sl = xs + (size_t)(wid * QBLK + lane) * 4; float t = 0.f;
#pragma unroll
    for (int q = 0; q < 4; ++q) t += __uint_as_float(__hip_atomic_load(sl + q, __ATOMIC_RELAXED, __HIP_MEMORY_SCOPE_AGENT));
    li_l[lane] = 1.0f / sqrtf(t * (1.0f / 512.0f) + 1e-6f); }
  asm volatile("s_waitcnt lgkmcnt(0)" ::: "memory");
  float g4[4];
#pragma unroll
  for (int d0 = 0; d0 < 4; ++d0) g4[d0] = gain[d0 * 32 + r32];
  char* Ol = lds + wid * 8704;
#pragma unroll
  for (int r = 0; r < 16; ++r) { const int orow = crow(r, hi); const float rn = li_l[orow];
#pragma unroll
    for (int d0 = 0; d0 < 4; ++d0) { const float v = o[d0][r] * rn * g4[d0]; *(bf16*)(Ol + orow * 272 + (d0 * 32 + r32) * 2) = (bf16)(cvtpk(v, v) & 0xffffu); } }
  asm volatile("s_waitcnt lgkmcnt(0)" ::: "memory");
  bf16* Ow = Ob + (long)(wid * QBLK) * LDO;
#pragma unroll
  for (int i = 0; i < 8; i += 2) { const int row = (lane >> 4) + 4 * i, c16 = lane & 15;
    const u32x4 w0 = *reinterpret_cast<const u32x4*>(Ol + row * 272 + c16 * 16), w1 = *reinterpret_cast<const u32x4*>(Ol + (row + 4) * 272 + c16 * 16);
    *reinterpret_cast<u32x4*>(Ow + (long)row * LDO + c16 * 8) = w0; *reinterpret_cast<u32x4*>(Ow + (long)(row + 4) * LDO + c16 * 8) = w1;
    asm volatile("" ::: "memory"); }
  __syncthreads();
#undef SLOAD
#undef SWRITE
#undef SWAIT
#undef RESC
}
#undef KSWZ
#undef SBAR
}

namespace ml {
using att::bf16; using att::bf16x8; using att::s16x4; using att::f32x16; using att::u32x4;
typedef float f32x4 __attribute__((ext_vector_type(4)));
using att::crow;
__device__ __forceinline__ unsigned cvtpk(float lo, float hi) { unsigned r; asm("v_cvt_pk_bf16_f32 %0, %1, %2" : "=v"(r) : "v"(lo), "v"(hi)); return r; }
 using att::ld8; using att::bf2f; using att::v_st; using att::v_rd_base; using att::v_rd_off;
constexpr int TBr = 4352, CTXr = 256, SEQr = 4096;
constexpr float LOG2E = 1.4426950408889634f;
constexpr int TSTRIDE = 32 * 17 * 256;
#define MLAS __attribute__((address_space(3)))
__device__ __forceinline__ float log_sigmoid_f(float x) {
    const float t = __expf(-fabsf(x));
    const float l1p = t < 0.03f ? t * (1.0f - t * (0.5f - t * (0.33333334f - 0.25f * t))) : __logf(1.0f + t);
    return fminf(x, 0.f) - l1p;
}
template <int OFF> __device__ __forceinline__ s16x4 trr(int vb) { s16x4 r; asm volatile("ds_read_b64_tr_b16 %0, %1 offset:%2" : "=&v"(r) : "v"(vb), "i"(OFF) : "memory"); return r; }
#define MLPK(L, H) (bf16x8){L[0], L[1], L[2], L[3], H[0], H[1], H[2], H[3]}
__device__ __forceinline__ void unit_rows(int b, int dir, int j, int& rb, int& sg) {
    if (dir == 0) { rb = b * TBr + 256 * j; sg = 1; }
    else { rb = (j == 0) ? b * TBr + 255 : b * TBr + TBr - 1 - 256 * (j - 1); sg = -1; }
}
struct Conv8 { float w0[8], w1[8], w2[8], bb[8]; };
__device__ __forceinline__ void conv8_load(Conv8& cp, const float* __restrict__ cw, const float* __restrict__ cb, int c) {
#pragma unroll
    for (int j = 0; j < 8; ++j) { cp.w0[j] = cw[c + j]; cp.w1[j] = cw[1024 + c + j]; cp.w2[j] = cw[2048 + c + j]; cp.bb[j] = cb[c + j]; }
}
__device__ __forceinline__ void conv8x8(const bf16* __restrict__ P, int r0, int sg, int sr, int c, const Conv8& cp, float scale, bf16x8 (&out)[8]) {
    bf16x8 x0[8], xm[8], xp[8]; float fm[8], fp[8];
#pragma unroll
    for (int g = 0; g < 8; ++g) { const int r = r0 + sg * (32 * g + sr); const int t = r % TBr; const bool hp = (t != 0) && (t != CTXr), hn = (t != CTXr - 1) && (t != TBr - 1);
        const bf16* p = P + (size_t)r * 2560 + 448 + c; x0[g] = ld8(p); xm[g] = ld8(hp ? p - 2560 : p); xp[g] = ld8(hn ? p + 2560 : p); fm[g] = hp ? 1.0f : 0.0f; fp[g] = hn ? 1.0f : 0.0f; }
    asm volatile("" ::: "memory");
#pragma unroll
    for (int g = 0; g < 8; ++g) { float u[8];
#pragma unroll
        for (int j = 0; j < 8; ++j) { const float a = cp.w0[j] * fm[g] * bf2f(xm[g][j]) + cp.w1[j] * bf2f(x0[g][j]) + cp.w2[j] * fp[g] * bf2f(xp[g][j]) + cp.bb[j];
            u[j] = a * __builtin_amdgcn_rcpf(1.0f + __builtin_amdgcn_exp2f(-LOG2E * a)) * scale; }
        u32x4 o = {cvtpk(u[0], u[1]), cvtpk(u[2], u[3]), cvtpk(u[4], u[5]), cvtpk(u[6], u[7])};
        out[g] = *reinterpret_cast<bf16x8*>(&o); }
}
__device__ __forceinline__ void conv_rows_load(const bf16* __restrict__ P, int R0, int c, bf16x8 (&x)[10]) {
    const int t0 = R0 % TBr; const bool hp0 = (t0 != 0) && (t0 != CTXr); const int t7 = t0 + 7; const bool hn7 = (t7 != CTXr - 1) && (t7 != TBr - 1);
    const bf16* p = P + (size_t)R0 * 2560 + 448 + c;
    x[0] = ld8(hp0 ? p - 2560 : p);
#pragma unroll
    for (int g = 0; g < 8; ++g) x[1 + g] = ld8(p + (size_t)g * 2560);
    x[9] = ld8(hn7 ? p + (size_t)8 * 2560 : p + (size_t)7 * 2560);
}
__device__ __forceinline__ void conv_rows_compute(const bf16x8 (&x)[10], int R0, const Conv8& cp, float scale, bf16x8 (&out)[8]) {
    const int t0 = R0 % TBr;
#pragma unroll
    for (int g = 0; g < 8; ++g) { const int t = t0 + g; const float fm = ((t != 0) && (t != CTXr)) ? 1.0f : 0.0f, fp = ((t != CTXr - 1) && (t != TBr - 1)) ? 1.0f : 0.0f; float u[8];
#pragma unroll
        for (int j = 0; j < 8; ++j) { const float a = cp.w0[j] * fm * bf2f(x[g][j]) + cp.w1[j] * bf2f(x[g + 1][j]) + cp.w2[j] * fp * bf2f(x[g + 2][j]) + cp.bb[j];
            u[j] = a * __builtin_amdgcn_rcpf(1.0f + __builtin_amdgcn_exp2f(-LOG2E * a)) * scale; }
        u32x4 o = {cvtpk(u[0], u[1]), cvtpk(u[2], u[3]), cvtpk(u[4], u[5]), cvtpk(u[6], u[7])};
        out[g] = *reinterpret_cast<bf16x8*>(&o); }
}
__device__ __forceinline__ void gate_scan_task(const float* __restrict__ G, const float* __restrict__ gate_b, float* __restrict__ T, float* __restrict__ sca, int task, int lane) {
    const int seq = task / 17, j = task - seq * 17, b = seq >> 3, h = (seq >> 1) & 3, dir = seq & 1;
    int rb, sg; unit_rows(b, dir, j, rb, sg);
    const int gi = (2 * dir) * 4 + h, gf = (2 * dir + 1) * 4 + h; const float ib = gate_b[gi], fb = gate_b[gf];
    float igv[4], fgv[4];
#pragma unroll
    for (int rnd = 0; rnd < 4; ++rnd) { const size_t r = (size_t)(rb + sg * (64 * rnd + lane)); igv[rnd] = G[r * 16 + gi] + ib; fgv[rnd] = G[r * 16 + gf] + fb; }
    float cb = 0.f, cpm = -3.0e38f; float* Tb = T + (size_t)task * 256;
#pragma unroll
    for (int rnd = 0; rnd < 4; ++rnd) { const int i = 64 * rnd + lane;
        float bc = log_sigmoid_f(fgv[rnd]);
#pragma unroll
        for (int o = 1; o < 64; o <<= 1) { const float t_ = __shfl_up(bc, o); if (lane >= o) bc += t_; }
        bc += cb;
        const float al = igv[rnd] - bc; float pm = al;
#pragma unroll
        for (int o = 1; o < 64; o <<= 1) { const float t_ = __shfl_up(pm, o); if (lane >= o) pm = fmaxf(pm, t_); }
        pm = fmaxf(pm, cpm);
        Tb[i] = bc; Tb[TSTRIDE + i] = al; Tb[2 * TSTRIDE + i] = pm;
        cb = __shfl(bc, 63); cpm = __shfl(pm, 63); }
    if (j < 16 && lane == 0) { sca[(seq * 16 + j) * 2] = cpm; sca[(seq * 16 + j) * 2 + 1] = cb; }
}
__device__ __forceinline__ void mlstm_local(const bf16* __restrict__ P, const float* __restrict__ T, const float* __restrict__ cw, const float* __restrict__ cbias,
                                            float* __restrict__ Cloc, float* __restrict__ nloc, int unit, char* lds) {
    int tid_ = threadIdx.x; asm volatile("" : "+v"(tid_));
    const int tid = tid_, wid = tid >> 6, lane = tid & 63, r32 = lane & 31, hi = lane >> 5;
    const int seq = unit >> 4, j = unit & 15, b = seq >> 3, h = (seq >> 1) & 3, dir = seq & 1;
    int rb, sg; unit_rows(b, dir, j, rb, sg);
    const float* Tal = T + TSTRIDE + (size_t)(seq * 17 + j) * 256; const float mlm = T[2 * TSTRIDE + (size_t)(seq * 17 + j) * 256 + 255];
    float* npart = (float*)(lds + 131072);
    const int sr = tid >> 4, sc = (tid & 15) * 8;
    float wv[8]; bf16x8 vreg[8];
#pragma unroll
    for (int g = 0; g < 8; ++g) { const int i = 32 * g + sr; wv[g] = Tal[i]; vreg[g] = ld8(P + (size_t)(rb + sg * i) * 2560 + 1472 + h * 128 + sc); }
    asm volatile("" ::: "memory");
    float nacc[8] = {0.f, 0.f, 0.f, 0.f, 0.f, 0.f, 0.f, 0.f};
    {
        const int R0 = sg > 0 ? rb + 8 * sr : rb - 8 * sr - 7;
        bf16x8 xk[10]; conv_rows_load(P, R0, 512 + h * 128 + sc, xk); float wk[8];
#pragma unroll
        for (int g = 0; g < 8; ++g) wk[g] = Tal[8 * sr + g];
        asm volatile("" ::: "memory");
        Conv8 cp; conv8_load(cp, cw, cbias, 512 + h * 128 + sc); bf16x8 kv[8]; conv_rows_compute(xk, R0, cp, 0.08838834764831845f, kv);
#pragma unroll
        for (int g = 0; g < 8; ++g) { const int i = 8 * sr + g; const bf16x8 kr = sg > 0 ? kv[g] : kv[7 - g];
            *(bf16x8*)(lds + (i >> 6) * 16384 + v_st(i & 63, sc)) = kr; const float w = __expf(wk[g] - mlm);
#pragma unroll
            for (int x = 0; x < 8; ++x) nacc[x] += w * bf2f(kr[x]); } }
#pragma unroll
    for (int g = 0; g < 8; ++g) wv[g] = __expf(wv[g] - mlm);
#pragma unroll
    for (int g = 0; g < 8; ++g) { const int i = 32 * g + sr; const float w = wv[g]; const bf16x8 v = vreg[g];
        u32x4 o = {cvtpk(bf2f(v[0]) * w, bf2f(v[1]) * w), cvtpk(bf2f(v[2]) * w, bf2f(v[3]) * w), cvtpk(bf2f(v[4]) * w, bf2f(v[5]) * w), cvtpk(bf2f(v[6]) * w, bf2f(v[7]) * w)};
        *(u32x4*)(lds + 65536 + (i >> 6) * 16384 + v_st(i & 63, sc)) = o; }
#pragma unroll
    for (int x = 0; x < 8; ++x) { nacc[x] += __shfl_xor(nacc[x], 16); nacc[x] += __shfl_xor(nacc[x], 32); }
    if (lane < 16) {
#pragma unroll
        for (int x = 0; x < 8; ++x) npart[wid * 128 + sc + x] = nacc[x]; }
    __syncthreads();
    const int db = wid >> 1, eb0 = 2 * (wid & 1);
    const int vbK = (int)(uintptr_t)lds + v_rd_base(lane) + db * 512, vbV = (int)(uintptr_t)lds + 65536 + v_rd_base(lane) + eb0 * 512;
    f32x16 c0 = {}, c1 = {};
#define MLA_STEP(TL, KS) do { const s16x4 al_ = trr<(TL) * 16384 + v_rd_off(0, KS, 0)>(vbK), ah_ = trr<(TL) * 16384 + v_rd_off(0, KS, 1)>(vbK); \
        const s16x4 bl0 = trr<(TL) * 16384 + v_rd_off(0, KS, 0)>(vbV), bh0 = trr<(TL) * 16384 + v_rd_off(0, KS, 1)>(vbV), bl1 = trr<(TL) * 16384 + v_rd_off(1, KS, 0)>(vbV), bh1 = trr<(TL) * 16384 + v_rd_off(1, KS, 1)>(vbV); \
        asm volatile("s_waitcnt lgkmcnt(0)" ::: "memory"); __builtin_amdgcn_sched_barrier(0); \
        c0 = __builtin_amdgcn_mfma_f32_32x32x16_bf16(MLPK(al_, ah_), MLPK(bl0, bh0), c0, 0, 0, 0); c1 = __builtin_amdgcn_mfma_f32_32x32x16_bf16(MLPK(al_, ah_), MLPK(bl1, bh1), c1, 0, 0, 0); } while (0)
#define MLA_TILE(TL) do { MLA_STEP(TL, 0); MLA_STEP(TL, 1); MLA_STEP(TL, 2); MLA_STEP(TL, 3); } while (0)
    MLA_TILE(0); MLA_TILE(1); MLA_TILE(2); MLA_TILE(3);
#undef MLA_TILE
#undef MLA_STEP
    float* Co = Cloc + (size_t)unit * 16384;
#pragma unroll
    for (int r = 0; r < 16; ++r) { const int d = db * 32 + crow(r, hi); Co[d * 128 + eb0 * 32 + r32] = c0[r]; Co[d * 128 + eb0 * 32 + 32 + r32] = c1[r]; }
    if (tid < 128) { float s = 0.f;
#pragma unroll
        for (int w = 0; w < 8; ++w) s += npart[w * 128 + tid];
        nloc[unit * 128 + tid] = s; }
    __syncthreads();
}
__device__ __forceinline__ void mlstm_scan(const float* __restrict__ Cloc, const float* __restrict__ nloc, const float* __restrict__ sca, bf16* __restrict__ CstT, float* __restrict__ nst, float* __restrict__ bm, int gtid, int gthreads) {
    for (int item = gtid; item < 32 * 2048; item += gthreads) {
        const int seq = item >> 11, rem = item & 2047, e = rem & 127, dg = rem >> 7;
        float st[8] = {0.f, 0.f, 0.f, 0.f, 0.f, 0.f, 0.f, 0.f}; float nv = 0.f, Bst = 0.f, Mst = 0.f;
        asm volatile("" : "+v"(Bst), "+v"(Mst));
        const float* Cl0 = Cloc + (size_t)(seq * 16) * 16384 + (dg * 8) * 128 + e;
        for (int half = 0; half < 2; ++half) {
            float cl[8][8], nlv[8], mlv[8], blv[8];
#pragma unroll
            for (int jj = 0; jj < 8; ++jj) { const int lu = seq * 16 + half * 8 + jj;
#pragma unroll
                for (int i = 0; i < 8; ++i) cl[jj][i] = Cl0[(size_t)(half * 8 + jj) * 16384 + i * 128];
                nlv[jj] = nloc[lu * 128 + e]; mlv[jj] = sca[lu * 2]; blv[jj] = sca[lu * 2 + 1]; }
#pragma unroll
            for (int jj = 0; jj < 8; ++jj) { const int j = half * 8 + jj; const size_t su = (size_t)seq * 17 + j;
                u32x4 o = {cvtpk(st[0], st[1]), cvtpk(st[2], st[3]), cvtpk(st[4], st[5]), cvtpk(st[6], st[7])};
                *(u32x4*)(CstT + su * 16384 + e * 128 + dg * 8) = o;
                if (dg == 0) { nst[su * 128 + e] = nv; if (e == 0) { bm[su * 2] = Bst; bm[su * 2 + 1] = Mst; } }
                const float Mend = fmaxf(Mst, mlv[jj] - Bst), fa = __expf(Mst - Mend), fbv = __expf(mlv[jj] - Bst - Mend);
#pragma unroll
                for (int i = 0; i < 8; ++i) st[i] = fa * st[i] + fbv * cl[jj][i];
                nv = fa * nv + fbv * nlv[jj];
                Bst += blv[jj]; Mst = Mend; }
        }
        { const size_t su = (size_t)seq * 17 + 16;
          u32x4 o = {cvtpk(st[0], st[1]), cvtpk(st[2], st[3]), cvtpk(st[4], st[5]), cvtpk(st[6], st[7])};
          *(u32x4*)(CstT + su * 16384 + e * 128 + dg * 8) = o;
          if (dg == 0) { nst[su * 128 + e] = nv; if (e == 0) { bm[su * 2] = Bst; bm[su * 2 + 1] = Mst; } } }
    }
}
#define KSW(row, colB) ((row) * 256 + ((colB) ^ (((row) & 15) << 4)))
template <int D0, int KS> __device__ __forceinline__ void pv_pair(f32x16& od, int vb, bf16x8 pa, bf16x8 pb) {
    const s16x4 l0 = trr<v_rd_off(D0, KS, 0)>(vb), h0 = trr<v_rd_off(D0, KS, 1)>(vb), l1 = trr<v_rd_off(D0, KS + 1, 0)>(vb), h1 = trr<v_rd_off(D0, KS + 1, 1)>(vb);
    asm volatile("s_waitcnt lgkmcnt(0)" ::: "memory"); __builtin_amdgcn_sched_barrier(0);
    od = __builtin_amdgcn_mfma_f32_32x32x16_bf16(pa, MLPK(l0, h0), od, 0, 0, 0);
    od = __builtin_amdgcn_mfma_f32_32x32x16_bf16(pb, MLPK(l1, h1), od, 0, 0, 0);
}
__device__ __forceinline__ void mlstm_out2(const bf16* __restrict__ P, const float* __restrict__ T, const float* __restrict__ cw, const float* __restrict__ cbias, const bf16* __restrict__ CstT, const float* __restrict__ nst,
                                           const float* __restrict__ bm, const float* __restrict__ mnorm, bf16* __restrict__ MIX, int b, int h, int tb, char* lds) {
    int tid_ = threadIdx.x; asm volatile("" : "+v"(tid_));
    const int tid = tid_, wid = tid >> 6, lane = tid & 63, r32 = lane & 31, hi = lane >> 5;
    const int seqf = b * 8 + h * 2, seqb = seqf + 1; const int jb = tb == 0 ? 0 : 17 - tb; const bool zs = (tb == 0);
    const size_t suf = (size_t)seqf * 17 + tb, sub = (size_t)seqb * 17 + jb;
    const int rb = b * TBr + 256 * tb;
    float* tabs = (float*)(lds + 131072);
    float* nlf = tabs + 2048; float* nlb = tabs + 2176; float* wsc = tabs + 2304 + wid * 32;
    const int sr = tid >> 4, sc = (tid & 15) * 8;
    {
        bf16x8 xk[10], xq[10]; conv_rows_load(P, rb + 8 * sr, 512 + h * 128 + sc, xk); conv_rows_load(P, rb + 8 * sr, h * 128 + sc, xq);
        asm volatile("" ::: "memory");
        { Conv8 cp; conv8_load(cp, cw, cbias, 512 + h * 128 + sc); bf16x8 kv[8]; conv_rows_compute(xk, rb + 8 * sr, cp, 0.08838834764831845f, kv);
#pragma unroll
          for (int g = 0; g < 8; ++g) { const int i = 8 * sr + g; *(bf16x8*)(lds + KSW(i, sc * 2)) = kv[g]; } }
        { Conv8 cp; conv8_load(cp, cw, cbias, h * 128 + sc); bf16x8 qv[8]; conv_rows_compute(xq, rb + 8 * sr, cp, 1.0f, qv);
#pragma unroll
          for (int g = 0; g < 8; ++g) { const int i = 8 * sr + g; *(bf16x8*)(lds + 65536 + KSW(i, sc * 2)) = qv[g]; } } }
    bf16x8 vreg[8];
#pragma unroll
    for (int g = 0; g < 8; ++g) vreg[g] = ld8(P + (size_t)(rb + 32 * g + sr) * 2560 + 1472 + h * 128 + sc);
    asm volatile("" ::: "memory");
    {
        const int dir = tid >> 8, n = tid & 255; const size_t su = dir ? sub : suf; const size_t ti = su * 256 + (dir ? 255 - n : n);
        const float bl = T[ti], al = T[TSTRIDE + ti], pm = T[2 * TSTRIDE + ti]; float Bst = 0.f, Mst = 0.f; if (!zs) { Bst = bm[su * 2]; Mst = bm[su * 2 + 1]; }
        float* tb_ = tabs + dir * 1024; const float M = fmaxf(Mst, pm - Bst);
        tb_[n] = __expf(-(Bst + bl + M)); tb_[256 + n] = (al - Bst) * LOG2E; tb_[512 + n] = M * LOG2E; tb_[768 + n] = __expf(Mst - M); }
    if (wid == 2) { nlf[lane] = zs ? 0.f : nst[suf * 128 + lane]; nlf[64 + lane] = zs ? 0.f : nst[suf * 128 + 64 + lane]; }
    if (wid == 3) { nlb[lane] = zs ? 0.f : nst[sub * 128 + lane]; nlb[64 + lane] = zs ? 0.f : nst[sub * 128 + 64 + lane]; }
    __syncthreads();
    bf16x8 qr[8];
#pragma unroll
    for (int d0 = 0; d0 < 8; ++d0) qr[d0] = *reinterpret_cast<const bf16x8*>(lds + 65536 + KSW(wid * 32 + r32, (d0 * 16 + hi * 8) * 2));
    asm volatile("s_waitcnt lgkmcnt(0)" ::: "memory");
    __syncthreads();
#pragma unroll
    for (int g = 0; g < 8; ++g) { const int i = 32 * g + sr; *(bf16x8*)(lds + 65536 + (i >> 6) * 16384 + v_st(i & 63, sc)) = vreg[g]; }
    __syncthreads();
    const int qi = wid * 32 + r32;
    float qnf = 0.f, qnb = 0.f;
#pragma unroll
    for (int d0 = 0; d0 < 8; ++d0) {
#pragma unroll
        for (int jj = 0; jj < 8; ++jj) { const float qv = bf2f(qr[d0][jj]); qnf += qv * nlf[d0 * 16 + hi * 8 + jj]; qnb += qv * nlb[d0 * 16 + hi * 8 + jj]; }
        asm volatile("" : "+v"(qnf), "+v"(qnb)); }
    { auto rr = __builtin_amdgcn_permlane32_swap(__float_as_uint(qnf), __float_as_uint(qnf), false, false); qnf = __uint_as_float(rr[0]) + __uint_as_float(rr[1]); }
    { auto rr = __builtin_amdgcn_permlane32_swap(__float_as_uint(qnb), __float_as_uint(qnb), false, false); qnb = __uint_as_float(rr[0]) + __uint_as_float(rr[1]); }
    const int vb0 = (int)(uintptr_t)lds + 65536 + v_rd_base(lane);
    const int dtile = wid >> 1;
    unsigned hfp[32];
#define ML_PK4(Pv, BASE, OUT) do { unsigned a0 = cvtpk(Pv[BASE + 0], Pv[BASE + 1]), a1 = cvtpk(Pv[BASE + 2], Pv[BASE + 3]);   \
    unsigned b0_ = cvtpk(Pv[BASE + 4], Pv[BASE + 5]), b1_ = cvtpk(Pv[BASE + 6], Pv[BASE + 7]);                              \
    auto r0 = __builtin_amdgcn_permlane32_swap(a0, b0_, false, false); auto r1 = __builtin_amdgcn_permlane32_swap(a1, b1_, false, false); \
    u32x4 w = {r0[0], r1[0], r0[1], r1[1]}; OUT = *reinterpret_cast<bf16x8*>(&w); } while (0)
#pragma unroll
    for (int dir = 0; dir < 2; ++dir) {
        const float* tb_ = tabs + dir * 1024; const size_t su = dir ? sub : suf;
        f32x16 o[4];
        if (zs) { o[0] = f32x16{}; o[1] = f32x16{}; o[2] = f32x16{}; o[3] = f32x16{}; }
        else { const bf16* Cb = CstT + su * 16384 + (size_t)r32 * 128 + hi * 8;
#pragma unroll
          for (int ep = 0; ep < 2; ++ep) { bf16x8 cf[16];
#pragma unroll
              for (int x = 0; x < 16; ++x) cf[x] = ld8(Cb + (2 * ep + (x >> 3)) * 32 * 128 + (x & 7) * 16);
              f32x16 a0 = {}, a1 = {};
#pragma unroll
              for (int d0 = 0; d0 < 8; ++d0) { a0 = __builtin_amdgcn_mfma_f32_32x32x16_bf16(qr[d0], cf[d0], a0, 0, 0, 0); a1 = __builtin_amdgcn_mfma_f32_32x32x16_bf16(qr[d0], cf[8 + d0], a1, 0, 0, 0); }
              o[2 * ep] = a0; o[2 * ep + 1] = a1; }
#pragma unroll
          for (int r = 0; r < 16; ++r) { const float isc = tb_[768 + wid * 32 + crow(r, hi)];
#pragma unroll
              for (int eb = 0; eb < 4; ++eb) o[eb][r] *= isc; } }
        const float qn = dir ? qnb : qnf;
        const float m2q = tb_[512 + qi]; float dsum = 0.f;
        const int kt0 = dir ? dtile : 0, kt1 = dir ? 4 : dtile + 1;
        for (int kt = kt0; kt < kt1; ++kt) {
            const char* Ks = lds + kt * 64 * 256; const bool diag = (kt == dtile); const int vb = vb0 + kt * 16384;
#pragma unroll
            for (int hh = 0; hh < 2; ++hh) {
                f32x16 p = {}, p2 = {};
#pragma unroll
                for (int d0 = 0; d0 < 8; d0 += 2) { const int cb = (d0 * 16 + hi * 8) * 2;
                    const bf16x8 b0 = *reinterpret_cast<const bf16x8*>(Ks + KSW(32 * hh + r32, cb)), b1 = *reinterpret_cast<const bf16x8*>(Ks + KSW(32 * hh + r32, cb + 32));
                    p = __builtin_amdgcn_mfma_f32_32x32x16_bf16(b0, qr[d0], p, 0, 0, 0); p2 = __builtin_amdgcn_mfma_f32_32x32x16_bf16(b1, qr[d0 + 1], p2, 0, 0, 0); }
                p += p2;
#pragma unroll
                for (int g4 = 0; g4 < 4; ++g4) { const int sb = kt * 64 + 32 * hh + 8 * g4 + 4 * hi;
                    const f32x4 a4 = *(const f32x4*)(tb_ + 256 + sb);
#pragma unroll
                    for (int x = 0; x < 4; ++x) { const int r = 4 * g4 + x, s0 = sb + x;
                        float w0 = __builtin_amdgcn_exp2f(a4[x] - m2q);
                        if (diag) { if (dir ? (s0 < qi) : (s0 > qi)) w0 = 0.f; }
                        p[r] *= w0; dsum += p[r]; } }
                bf16x8 pa, pb;
                ML_PK4(p, 0, pa); ML_PK4(p, 8, pb);
                if (hh == 0) { pv_pair<0, 0>(o[0], vb, pa, pb); pv_pair<1, 0>(o[1], vb, pa, pb); pv_pair<2, 0>(o[2], vb, pa, pb); pv_pair<3, 0>(o[3], vb, pa, pb); }
                else         { pv_pair<0, 2>(o[0], vb, pa, pb); pv_pair<1, 2>(o[1], vb, pa, pb); pv_pair<2, 2>(o[2], vb, pa, pb); pv_pair<3, 2>(o[3], vb, pa, pb); }
            }
        }
        { auto rr = __builtin_amdgcn_permlane32_swap(__float_as_uint(dsum), __float_as_uint(dsum), false, false); dsum = __uint_as_float(rr[0]) + __uint_as_float(rr[1]); }
        const float den = dsum + tb_[768 + qi] * qn; const float rd = 1.0f / fmaxf(fabsf(den), tb_[qi]);
        if (hi == 0) wsc[r32] = rd; asm volatile("s_waitcnt lgkmcnt(0)" ::: "memory");
        if (dir == 0) {
#pragma unroll
            for (int r = 0; r < 16; r += 2) { const float ra = wsc[crow(r, hi)], rb_ = wsc[crow(r + 1, hi)];
#pragma unroll
                for (int eb = 0; eb < 4; ++eb) hfp[eb * 8 + (r >> 1)] = cvtpk(o[eb][r] * ra, o[eb][r + 1] * rb_); }
            asm volatile("s_waitcnt lgkmcnt(0)" ::: "memory");
        } else {
            float rdr[16];
#pragma unroll
            for (int r = 0; r < 16; ++r) rdr[r] = wsc[crow(r, hi)];
            bf16x8 og8[8];
            { const bf16* ogp = P + (size_t)(rb + wid * 32 + r32) * 2560 + 1984 + h * 128 + 64 * hi;
#pragma unroll
              for (int c8 = 0; c8 < 8; ++c8) og8[c8] = ld8(ogp + 8 * c8); }
            __syncthreads();
            float* W = (float*)(lds + wid * 16896);
#pragma unroll
            for (int r = 0; r < 16; ++r)
#pragma unroll
                for (int eb = 0; eb < 4; ++eb) { const unsigned pk = hfp[eb * 8 + (r >> 1)]; const float hf = (r & 1) ? __uint_as_float(pk & 0xffff0000u) : __uint_as_float(pk << 16);
                    W[crow(r, hi) * 132 + eb * 32 + r32] = hf + o[eb][r] * rdr[r]; }
            asm volatile("s_waitcnt lgkmcnt(0)" ::: "memory");
            const int tok = r32, eh = hi; const size_t row = (size_t)(rb + wid * 32 + tok);
            const float* mg = mnorm + h * 128 + 64 * eh;
            float v[64]; float s = 0.f;
#pragma unroll
            for (int c8 = 0; c8 < 8; ++c8) { const bf16x8 g8 = og8[c8]; const f32x4 w0 = *(const f32x4*)(W + tok * 132 + 64 * eh + 8 * c8), w1 = *(const f32x4*)(W + tok * 132 + 64 * eh + 8 * c8 + 4);
                const float hv[8] = {w0.x, w0.y, w0.z, w0.w, w1.x, w1.y, w1.z, w1.w};
#pragma unroll
                for (int x = 0; x < 8; ++x) { const float vv = hv[x] * __builtin_amdgcn_rcpf(1.0f + __builtin_amdgcn_exp2f(-LOG2E * bf2f(g8[x]))); v[8 * c8 + x] = vv; s += vv; } }
            { auto rr = __builtin_amdgcn_permlane32_swap(__float_as_uint(s), __float_as_uint(s), false, false); s = __uint_as_float(rr[0]) + __uint_as_float(rr[1]); }
            const float mu = s * (1.0f / 128.0f); float q = 0.f;
#pragma unroll
            for (int x = 0; x < 64; ++x) { v[x] -= mu; q += v[x] * v[x]; }
            { auto rr = __builtin_amdgcn_permlane32_swap(__float_as_uint(q), __float_as_uint(q), false, false); q = __uint_as_float(rr[0]) + __uint_as_float(rr[1]); }
            const float rstd = 1.0f / sqrtf(q * (1.0f / 128.0f) + 1e-6f);
            bf16* orow = MIX + row * 1024 + 512 + h * 128 + 64 * eh;
#pragma unroll
            for (int c8 = 0; c8 < 8; ++c8) { const f32x4 g0 = *(const f32x4*)(mg + 8 * c8), g1 = *(const f32x4*)(mg + 8 * c8 + 4);
                u32x4 ov = {cvtpk(v[8 * c8] * rstd * g0.x, v[8 * c8 + 1] * rstd * g0.y), cvtpk(v[8 * c8 + 2] * rstd * g0.z, v[8 * c8 + 3] * rstd * g0.w),
                            cvtpk(v[8 * c8 + 4] * rstd * g1.x, v[8 * c8 + 5] * rstd * g1.y), cvtpk(v[8 * c8 + 6] * rstd * g1.z, v[8 * c8 + 7] * rstd * g1.w)};
                *(u32x4*)(orow + 8 * c8) = ov; }
        }
    }
#undef ML_PK4
    __syncthreads();
}
#undef KSW
#undef MLPK
#undef MLAS
}

#define LAS __attribute__((address_space(3)))
typedef unsigned short bf16;
typedef float f32x4 __attribute__((ext_vector_type(4)));
typedef unsigned u32x4 __attribute__((ext_vector_type(4)));
typedef unsigned u32x2 __attribute__((ext_vector_type(2)));
typedef short bf16x8 __attribute__((ext_vector_type(8)));
constexpr int NWAVES = 8, NTHREADS = 512;
constexpr int DM = 1024, NB = 4, SEQ = 4096, CTXL = 256, TB = SEQ + CTXL  , R = NB * TB  ;
constexpr int DFF = 2752, DFFP = 2816, NW1 = 2 * DFFP  , DIN = 2512, DINP = 2560, KUP = 384, NUP = 1792;
constexpr int NMOD = 9;
constexpr float EPS = 1e-6f;
constexpr size_t MiB = 1u << 20;
constexpr size_t WS_CTL = 0, CTL_BYTES = 1 * MiB;
constexpr size_t WS_MOD = 1 * MiB;
constexpr size_t WS_TAB = WS_MOD + 512 * 1024;
constexpr size_t WS_W1 = 2 * MiB;
constexpr size_t WS_W2 = WS_W1 + (size_t)2 * NW1 * DM * 2;
constexpr size_t WS_WIN = WS_W2 + (size_t)2 * DM * DFFP * 2;
constexpr size_t WS_WUP = WS_WIN + (size_t)DINP * DM * 2;
constexpr size_t WS_WOUT = WS_WUP + (size_t)NUP * KUP * 2;
constexpr size_t WS_XC = WS_WOUT + (size_t)DM * DM * 2;
constexpr size_t WS_H = WS_XC + (size_t)NB * CTXL * DM * 4;
constexpr size_t WS_BIG = WS_H + (size_t)R * DM * 2;
constexpr size_t BIG_KR = (size_t)R * DINP * 2;
constexpr size_t BIG_G = BIG_KR + (size_t)R * 64 * 2;
constexpr size_t WS_Y = WS_BIG + (size_t)R * DFFP * 2;
constexpr size_t WS_Q = WS_Y + (size_t)R * DM * 2;
constexpr size_t WS_AUP = WS_Q + (size_t)R * 768 * 2;
constexpr size_t WS_HF = WS_AUP + (size_t)R * 512 * 2;
constexpr size_t WS_HB = WS_HF + (size_t)R * 512 * 2;
constexpr size_t WS_MS = WS_HB + (size_t)R * 512 * 2;
constexpr size_t MS_NLOC = 0, MS_SCA = 262144, MS_NST = 266240, MS_BM = 544768;
constexpr size_t MS_X1 = 3u << 20, MS_X2 = (3u << 20) + (512u << 10);
constexpr size_t MS_T = 1u << 20;
constexpr size_t WS_END = WS_MS + 4 * MiB;
static_assert(BIG_G + (size_t)R * 16 * 4 <= (size_t)R * DFFP * 2, "P + KR + G fit the hidden region");
static_assert(WS_W1 % 256 == 0 && WS_W2 % 256 == 0 && WS_WIN % 256 == 0 && WS_WUP % 256 == 0 && WS_WOUT % 256 == 0 && WS_XC % 256 == 0 && WS_H % 256 == 0 && WS_BIG % 256 == 0 && WS_Y % 256 == 0 && WS_Q % 256 == 0 && WS_AUP % 256 == 0 && WS_HF % 256 == 0, "alignment");
static_assert(WS_END <= 305u * MiB, "workspace budget");
constexpr int LDS_BYTES = 147456, LDS_MISC = 143360;

#define LDS_WAIT() asm volatile("s_waitcnt lgkmcnt(0)" ::: "memory")
__device__ __forceinline__ unsigned f2bf(float f) { unsigned u = __builtin_bit_cast(unsigned, f); return (u + 0x7fffu + ((u >> 16) & 1u)) >> 16; }
__device__ __forceinline__ unsigned pk2(float lo, float hi) { return f2bf(lo) | (f2bf(hi) << 16); }
__device__ __forceinline__ float bflo(unsigned w) { return __uint_as_float(w << 16); }
__device__ __forceinline__ float bfhi(unsigned w) { return __uint_as_float(w & 0xffff0000u); }
__device__ __forceinline__ float bf1(bf16 b) { return __uint_as_float(((unsigned)b) << 16); }
__device__ __forceinline__ float wave_sum(float v) {
#pragma unroll
    for (int o = 1; o < 64; o <<= 1) v += __shfl_xor(v, o);
    return v;
}
__device__ __forceinline__ float sigmoid_f(float x) { return __builtin_amdgcn_rcpf(1.0f + __builtin_amdgcn_exp2f(-1.4426950408889634f * x)); }
__device__ __forceinline__ float silu1(float x) { return x * sigmoid_f(x); }

struct Args { const float* in[22]; float* out; unsigned char* ws; int ph_lo, ph_hi; };
struct ArgsV { const Args* p; int z;
    __device__ __forceinline__ const float* in(int i) const { return p->in[i + z]; }
    __device__ __forceinline__ float* out() const { return (float*)p->in[22 + z]; }
    __device__ __forceinline__ unsigned char* ws() const { return (unsigned char*)p->in[23 + z]; } };
enum { I_X = 0, I_C, I_CTX, I_CCTX, I_WMOD, I_BMOD, I_NPRE, I_NPOST, I_WG, I_WU, I_WD, I_WIN, I_QN, I_WUQ, I_KVN, I_WUKV, I_AON, I_CW, I_CB, I_GB, I_MN, I_WOUT };

__device__ __forceinline__ const float* xin_row(const ArgsV& a, int r) { const int b = r / TB, t = r - b * TB; return t < CTXL ? a.in(I_CTX) + (size_t)(b * CTXL + t) * DM : a.in(I_X) + (size_t)(b * SEQ + t - CTXL) * DM; }
__device__ __forceinline__ float* xres_row(const ArgsV& a, int r) { const int b = r / TB, t = r - b * TB; return t < CTXL ? (float*)(a.ws() + WS_XC) + (size_t)(b * CTXL + t) * DM : a.out() + (size_t)(b * SEQ + t - CTXL) * DM; }
__device__ __forceinline__ const float* mod_vec(const ArgsV& a, int l, int r, int j) { const int b = r / TB, t = r - b * TB; const int bb = t < CTXL ? 4 : b; return (const float*)(a.ws() + WS_MOD) + (size_t)((l * 5 + bb) * NMOD + j) * DM; }

__device__ __forceinline__ void cvt_item(const float* src, int srcN, int k0, int c0, int ncv, bf16* dst, int dstK, int drow0, int dk0, LAS float* scr, int lane) {
    const int n4 = (lane & 15) * 4, kr = lane >> 4;
    f32x4 v[16];
    const bool ok = n4 < ncv;
    const float* sp = src + (size_t)(k0 + kr) * srcN + c0 + n4;
#pragma unroll
    for (int i = 0; i < 16; ++i) { v[i] = (f32x4){0.f, 0.f, 0.f, 0.f}; if (ok) v[i] = *(const f32x4*)(sp + (size_t)(4 * i) * srcN); }
#pragma unroll
    for (int i = 0; i < 16; ++i) { const int k = 4 * i + kr; *(LAS f32x4*)(scr + k * 68 + ((n4 + 8 * (k >> 3)) & 63)) = v[i]; }
    LDS_WAIT(); asm volatile("" ::: "memory");
    const int c = lane & 7;
#pragma unroll
    for (int j = 0; j < 8; ++j) { const int n = (lane >> 3) + 8 * j; const LAS float* s = scr + (8 * c) * 68 + ((n + 8 * c) & 63);
        u32x4 o; o.x = pk2(s[0 * 68], s[1 * 68]); o.y = pk2(s[2 * 68], s[3 * 68]); o.z = pk2(s[4 * 68], s[5 * 68]); o.w = pk2(s[6 * 68], s[7 * 68]);
        *(u32x4*)(dst + (size_t)(drow0 + n) * dstK + dk0 + 8 * c) = o; }
    LDS_WAIT(); asm volatile("" ::: "memory");
}
__device__ __forceinline__ void wconv_layer(const ArgsV& a, int l, LAS unsigned char* lds, int bid, int nbl, int wave, int lane) {
    LAS float* scr = (LAS float*)(lds + wave * 17408);
    const int gw = bid * NWAVES + wave, NGW = nbl * NWAVES;
    constexpr int I_1 = 88 * 16, I_2 = 16 * 44, I_IN = 40 * 16, I_UP = 28 * 6, I_OUT = 16 * 16;
    constexpr int NITEMS = 2 * I_1 + 2 * I_2 + I_IN + I_UP + I_OUT;
    bf16* W1 = (bf16*)(a.ws() + WS_W1); bf16* W2 = (bf16*)(a.ws() + WS_W2); bf16* WIN = (bf16*)(a.ws() + WS_WIN); bf16* WUP = (bf16*)(a.ws() + WS_WUP); bf16* WOUT = (bf16*)(a.ws() + WS_WOUT);
    for (int it = gw; it < NITEMS; it += NGW) {
        int r = it;
        if (r < 2 * I_1) { const int j = r / I_1; r -= j * I_1; const int g = r / 16, kb = r % 16; const int row0 = 64 * g, pn = row0 >> 8, i = row0 & 255; const int hc = 128 * pn + (i & 127);
            const float* src = (i < 128 ? a.in(I_WG) : a.in(I_WU)) + (size_t)(l * 2 + j) * DM * DFF;
            cvt_item(src, DFF, 64 * kb, hc < DFF ? hc : 0, hc < DFF ? 64 : 0, W1 + (size_t)j * NW1 * DM, DM, row0, 64 * kb, scr, lane); continue; }
        r -= 2 * I_1;
        if (r < 2 * I_2) { const int j = r / I_2; r -= j * I_2; const int g = r / 44, kb = r % 44;
            const float* src = a.in(I_WD) + (size_t)(l * 2 + j) * DFF * DM;
            cvt_item(src, DM, kb < 43 ? 64 * kb : 0, 64 * g, kb < 43 ? 64 : 0, W2 + (size_t)j * DM * DFFP, DFFP, 64 * g, 64 * kb, scr, lane); continue; }
        r -= 2 * I_2;
        if (r < I_IN) { const int g = r / 16, kb = r % 16; int ncv = DIN - 64 * g; ncv = ncv < 0 ? 0 : (ncv > 64 ? 64 : ncv);
            cvt_item(a.in(I_WIN) + (size_t)l * DM * DIN, DIN, 64 * kb, ncv > 0 ? 64 * g : 0, ncv, WIN, DM, 64 * g, 64 * kb, scr, lane); continue; }
        r -= I_IN;
        if (r < I_UP) { const int g = r / 6, kb = r % 6;
            if (g < 12) cvt_item(a.in(I_WUQ) + (size_t)l * 256 * 768, 768, kb < 4 ? 64 * kb : 0, 64 * g, kb < 4 ? 64 : 0, WUP, KUP, 64 * g, 64 * kb, scr, lane);
            else cvt_item(a.in(I_WUKV) + (size_t)l * 128 * 1024, 1024, kb >= 4 ? 64 * (kb - 4) : 0, 64 * (g - 12), kb >= 4 ? 64 : 0, WUP, KUP, 64 * g, 64 * kb, scr, lane);
            continue; }
        r -= I_UP;
        { const int g = r / 16, kb = r % 16; cvt_item(a.in(I_WOUT) + (size_t)l * DM * DM, DM, 64 * kb, 64 * g, 64, WOUT, DM, 64 * g, 64 * kb, scr, lane); }
    }
}
__device__ __forceinline__ void mod_phase(const ArgsV& a, LAS unsigned char* lds, int bid, int nbl, int tid, int wave, int lane) {
    LAS float* sv = (LAS float*)(lds);
    LAS float* red = (LAS float*)(lds + 20480);
    for (int i = tid; i < 5 * DM; i += NTHREADS) { const float v = i < 4 * DM ? a.in(I_C)[i] : a.in(I_CCTX)[i - 4 * DM]; sv[i] = silu1(v); }
    __syncthreads();
    float* mod = (float*)(a.ws() + WS_MOD);
    for (int u = bid; u < 256; u += nbl) {
        const int l = u >> 7, cb = (u & 127) * 72; const bool act = lane < 18;
        const float* W = a.in(I_WMOD) + (size_t)l * DM * (NMOD * DM) + cb + 4 * (act ? lane : 0);
        f32x4 acc[5];
#pragma unroll
        for (int bb = 0; bb < 5; ++bb) acc[bb] = (f32x4){0.f, 0.f, 0.f, 0.f};
        for (int k0 = wave * 128; k0 < wave * 128 + 128; k0 += 32) { f32x4 w[32];
#pragma unroll
            for (int i = 0; i < 32; ++i) w[i] = *(const f32x4*)(W + (size_t)(k0 + i) * (NMOD * DM));
#pragma unroll
            for (int i = 0; i < 32; ++i)
#pragma unroll
                for (int bb = 0; bb < 5; ++bb) acc[bb] += w[i] * sv[bb * DM + k0 + i]; }
        if (act) {
#pragma unroll
            for (int bb = 0; bb < 5; ++bb) *(LAS f32x4*)(red + (wave * 5 + bb) * 72 + 4 * lane) = acc[bb]; }
        __syncthreads();
        for (int i = tid; i < 5 * 72; i += NTHREADS) { const int bb = i / 72, cc = i % 72; float s = 0.f;
#pragma unroll
            for (int w = 0; w < 8; ++w) s += red[(w * 5 + bb) * 72 + cc];
            mod[(size_t)(l * 5 + bb) * (NMOD * DM) + cb + cc] = s + a.in(I_BMOD)[(size_t)l * NMOD * DM + cb + cc]; }
        __syncthreads();
    }
    if (bid == nbl - 1 && tid < 64) {
        constexpr float inv[16] = {1.0f, 0.5623413251903491f, 0.31622776601683794f, 0.1778279410038923f, 0.1f, 0.05623413251903491f, 0.03162277660168379f, 0.01778279410038923f,
                                   0.01f, 0.005623413251903491f, 0.0031622776601683794f, 0.001778279410038923f, 0.001f, 0.0005623413251903491f, 0.00031622776601683794f, 0.0001778279410038923f};
        float* tab = (float*)(a.ws() + WS_TAB);
#pragma unroll
        for (int f = 0; f < 16; ++f) {
            const float ang = (float)tid * inv[f];
            const double ad = (double)ang; const double kq = __builtin_rint(ad * 0.63661977236758134308); const double rd = ad - kq * 1.57079632679489661923;
            const float x = (float)rd, x2 = x * x; const int q = ((int)kq) & 3;
            const float sp = x + x * x2 * (-1.6666654611e-1f + x2 * (8.3321608736e-3f + x2 * (-1.9515295891e-4f)));
            const float cp = 1.0f - 0.5f * x2 + x2 * x2 * (4.166664568298827e-2f + x2 * (-1.388731625493765e-3f + x2 * 2.443315711809948e-5f));
            const float sn = (q == 0) ? sp : (q == 1) ? cp : (q == 2) ? -sp : -cp;
            const float cs = (q == 0) ? cp : (q == 1) ? -sp : (q == 2) ? -cp : sp;
            tab[(tid * 16 + f) * 2] = cs; tab[(tid * 16 + f) * 2 + 1] = sn; }
    }
    __syncthreads();
}

__device__ __forceinline__ void rw_pre(const f32x4 (&x)[4], const float* g, const float* sc, const float* sh, bf16* hrow, int lane) {
    float ss = 0.f;
#pragma unroll
    for (int j = 0; j < 4; ++j) ss += (x[j].x * x[j].x + x[j].y * x[j].y) + (x[j].z * x[j].z + x[j].w * x[j].w);
    const float rstd = 1.0f / sqrtf(wave_sum(ss) * (1.0f / DM) + EPS);
#pragma unroll
    for (int j = 0; j < 4; ++j) { const int c = 256 * j + 4 * lane; const f32x4 gv = *(const f32x4*)(g + c), sv = *(const f32x4*)(sc + c), hv = *(const f32x4*)(sh + c);
        f32x4 o; o.x = x[j].x * rstd * gv.x * (1.0f + sv.x) + hv.x; o.y = x[j].y * rstd * gv.y * (1.0f + sv.y) + hv.y; o.z = x[j].z * rstd * gv.z * (1.0f + sv.z) + hv.z; o.w = x[j].w * rstd * gv.w * (1.0f + sv.w) + hv.w;
        u32x2 w; w.x = pk2(o.x, o.y); w.y = pk2(o.z, o.w); *(u32x2*)(hrow + c) = w; }
}
__device__ __forceinline__ void phase_rw_a(const ArgsV& a, int bid, int nbl, int wave, int lane) {
    const int gw = bid * NWAVES + wave, NGW = nbl * NWAVES; bf16* H = (bf16*)(a.ws() + WS_H);
    for (int ra = gw; ra < R; ra += 2 * NGW) {
        const int rb_ = ra + NGW < R ? ra + NGW : ra; const float* xa = xin_row(a, ra); const float* xb = xin_row(a, rb_); f32x4 x0[4], x1[4];
#pragma unroll
        for (int j = 0; j < 4; ++j) { x0[j] = *(const f32x4*)(xa + 256 * j + 4 * lane); x1[j] = *(const f32x4*)(xb + 256 * j + 4 * lane); }
        rw_pre(x0, a.in(I_NPRE) + 0, mod_vec(a, 0, ra, 1), mod_vec(a, 0, ra, 0), H + (size_t)ra * DM, lane);
        if (rb_ != ra) rw_pre(x1, a.in(I_NPRE) + 0, mod_vec(a, 0, rb_, 1), mod_vec(a, 0, rb_, 0), H + (size_t)rb_ * DM, lane); }
}
__device__ __forceinline__ void phase_rw_b(const ArgsV& a, int l, int sub, int bid, int nbl, int wave, int lane, bool dry = false) {
    const int gw = bid * NWAVES + wave, NGW = nbl * NWAVES; bf16* H = (bf16*)(a.ws() + WS_H);
    const float wgt = sub == 1 ? 1.0f : 0.5f; const float* gpost = a.in(I_NPOST) + (size_t)(l * 3 + sub) * DM;
    const int nl = sub == 2 ? l + 1 : l, nsub = sub == 2 ? 0 : sub + 1;
    const bool from_input = (l == 0 && sub == 0); const int nsl = sub == 1 ? 4 : 11;
    if (l == 1 && sub >= 1) return;
    const float* gpre = a.in(I_NPRE) + (size_t)(nl * 3 + nsub) * DM;
    for (int i0 = gw; i0 < NB * CTXL; i0 += NGW) {
        const int r0 = (i0 / CTXL) * TB + (i0 % CTXL);
        const float* xs0 = from_input ? xin_row(a, r0) : xres_row(a, r0);
        const float* gate0 = mod_vec(a, l, r0, 3 * sub + 2); const float* sc0 = mod_vec(a, nl, r0, 3 * nsub + 1); const float* sh0 = mod_vec(a, nl, r0, 3 * nsub);
        const float* sp = (const float*)(a.ws() + WS_AUP) + (size_t)((r0 / TB) * CTXL + (r0 % TB)) * DM + 4 * lane;
        f32x4 x0[4], y0[4], gp[4], gt[4], gn[4], sv[4], hv[4];
        {   f32x4 v[4][4];
#pragma unroll
            for (int j = 0; j < 4; ++j) { const int c = 256 * j + 4 * lane; x0[j] = *(const f32x4*)(xs0 + c); gp[j] = *(const f32x4*)(gpost + c); gt[j] = *(const f32x4*)(gate0 + c);
#pragma unroll
                for (int s = 0; s < 4; ++s) v[s][j] = *(const f32x4*)(sp + (size_t)s * 1024 * 1024 + 256 * j); }
            asm volatile("" ::: "memory");
#pragma unroll
            for (int j = 0; j < 4; ++j) y0[j] = (v[0][j] + v[1][j]) + (v[2][j] + v[3][j]); }
        if (nsl > 4) {
            {   f32x4 w[4][4];
#pragma unroll
                for (int j = 0; j < 4; ++j) { const int c = 256 * j + 4 * lane; gn[j] = *(const f32x4*)(gpre + c); sv[j] = *(const f32x4*)(sc0 + c); hv[j] = *(const f32x4*)(sh0 + c);
#pragma unroll
                    for (int s = 0; s < 4; ++s) w[s][j] = *(const f32x4*)(sp + (size_t)(4 + s) * 1024 * 1024 + 256 * j); }
                asm volatile("" ::: "memory");
#pragma unroll
                for (int j = 0; j < 4; ++j) y0[j] += (w[0][j] + w[1][j]) + (w[2][j] + w[3][j]); }
            {   f32x4 w[3][4];
#pragma unroll
                for (int s = 0; s < 3; ++s)
#pragma unroll
                    for (int j = 0; j < 4; ++j) w[s][j] = *(const f32x4*)(sp + (size_t)(8 + s) * 1024 * 1024 + 256 * j);
#pragma unroll
                for (int j = 0; j < 4; ++j) y0[j] += (w[0][j] + w[1][j]) + w[2][j]; }
        } else {
#pragma unroll
            for (int j = 0; j < 4; ++j) { const int c = 256 * j + 4 * lane; gn[j] = *(const f32x4*)(gpre + c); sv[j] = *(const f32x4*)(sc0 + c); hv[j] = *(const f32x4*)(sh0 + c); }
        }
        float ss0 = 0.f;
#pragma unroll
        for (int j = 0; j < 4; ++j) ss0 += (y0[j].x * y0[j].x + y0[j].y * y0[j].y) + (y0[j].z * y0[j].z + y0[j].w * y0[j].w);
        const float rs0 = 1.0f / sqrtf(wave_sum(ss0) * (1.0f / DM) + EPS);
        float* xd0 = dry ? (float*)(a.ws() + WS_BIG) + (size_t)r0 * DM : xres_row(a, r0);
        float s2 = 0.f;
#pragma unroll
        for (int j = 0; j < 4; ++j) { const int c = 256 * j + 4 * lane;
            x0[j].x += wgt * gt[j].x * (y0[j].x * rs0 * gp[j].x); x0[j].y += wgt * gt[j].y * (y0[j].y * rs0 * gp[j].y); x0[j].z += wgt * gt[j].z * (y0[j].z * rs0 * gp[j].z); x0[j].w += wgt * gt[j].w * (y0[j].w * rs0 * gp[j].w);
            *(f32x4*)(xd0 + c) = x0[j]; s2 += (x0[j].x * x0[j].x + x0[j].y * x0[j].y) + (x0[j].z * x0[j].z + x0[j].w * x0[j].w); }
        const float rstd = 1.0f / sqrtf(wave_sum(s2) * (1.0f / DM) + EPS); bf16* hrow = H + (size_t)r0 * DM;
#pragma unroll
        for (int j = 0; j < 4; ++j) { const int c = 256 * j + 4 * lane; f32x4 o;
            o.x = x0[j].x * rstd * gn[j].x * (1.0f + sv[j].x) + hv[j].x; o.y = x0[j].y * rstd * gn[j].y * (1.0f + sv[j].y) + hv[j].y; o.z = x0[j].z * rstd * gn[j].z * (1.0f + sv[j].z) + hv[j].z; o.w = x0[j].w * rstd * gn[j].w * (1.0f + sv[j].w) + hv[j].w;
            u32x2 w; w.x = pk2(o.x, o.y); w.y = pk2(o.z, o.w); *(u32x2*)(hrow + c) = w; }
    }
}
__device__ __forceinline__ void phase_rw_prep(const ArgsV& a, int l, int bid, int nbl, int wave, int lane) {
    const int gw = bid * NWAVES + wave, NGW = nbl * NWAVES;
    const bf16* P = (const bf16*)(a.ws() + WS_BIG); bf16* AUP = (bf16*)(a.ws() + WS_AUP); bf16* KR = (bf16*)(a.ws() + WS_BIG + BIG_KR);
    const float* tab = (const float*)(a.ws() + WS_TAB);
    const float* qn = a.in(I_QN) + l * 256; const float* kvn = a.in(I_KVN) + l * 128;
    for (int task = gw; task < 32 * 17; task += NGW)
        ml::gate_scan_task((const float*)(a.ws() + WS_BIG + BIG_G), a.in(I_GB) + l * 16, (float*)(a.ws() + WS_MS + MS_T), (float*)(a.ws() + WS_MS + MS_SCA), task, lane);
    for (int ra = gw; ra < R; ra += 2 * NGW) {
        const int rb_ = ra + NGW < R ? ra + NGW : ra; const bool two = rb_ != ra;
        const bf16* pa = P + (size_t)ra * DINP; const bf16* pb = P + (size_t)rb_ * DINP;
        const u32x2 wa = *(const u32x2*)(pa + 4 * lane), wb = *(const u32x2*)(pb + 4 * lane);
        const unsigned ka = *(const unsigned*)(pa + 256 + 2 * lane), kb = *(const unsigned*)(pb + 256 + 2 * lane);
        const float va = bf1(pa[384 + lane]), vb = bf1(pb[384 + lane]);
        const f32x4 g = *(const f32x4*)(qn + 4 * lane); const float kg0 = kvn[2 * lane], kg1 = kvn[2 * lane + 1];
        float a0 = bflo(wa.x), a1 = bfhi(wa.x), a2 = bflo(wa.y), a3 = bfhi(wa.y), b0 = bflo(wb.x), b1 = bfhi(wb.x), b2 = bflo(wb.y), b3 = bfhi(wb.y);
        float sa = (a0 * a0 + a1 * a1) + (a2 * a2 + a3 * a3), sb = (b0 * b0 + b1 * b1) + (b2 * b2 + b3 * b3);
        const float c0 = bflo(ka), c1 = bfhi(ka), d0 = bflo(kb), d1 = bfhi(kb); float ta = c0 * c0 + c1 * c1, tb = d0 * d0 + d1 * d1;
#pragma unroll
        for (int o = 1; o < 64; o <<= 1) { sa += __shfl_xor(sa, o); sb += __shfl_xor(sb, o); ta += __shfl_xor(ta, o); tb += __shfl_xor(tb, o); }
        const float voa = __shfl_xor(va, 16), vob = __shfl_xor(vb, 16);
        const float rqa = 1.0f / sqrtf(sa * (1.0f / 256.0f) + EPS), rqb = 1.0f / sqrtf(sb * (1.0f / 256.0f) + EPS), rka = 1.0f / sqrtf(ta * (1.0f / 128.0f) + EPS), rkb = 1.0f / sqrtf(tb * (1.0f / 128.0f) + EPS);
        { u32x2 o; o.x = pk2(a0 * rqa * g.x, a1 * rqa * g.y); o.y = pk2(a2 * rqa * g.z, a3 * rqa * g.w); *(u32x2*)(AUP + (size_t)ra * KUP + 4 * lane) = o;
          *(unsigned*)(AUP + (size_t)ra * KUP + 256 + 2 * lane) = pk2(c0 * rka * kg0, c1 * rka * kg1); }
        if (two) { u32x2 o; o.x = pk2(b0 * rqb * g.x, b1 * rqb * g.y); o.y = pk2(b2 * rqb * g.z, b3 * rqb * g.w); *(u32x2*)(AUP + (size_t)rb_ * KUP + 4 * lane) = o;
          *(unsigned*)(AUP + (size_t)rb_ * KUP + 256 + 2 * lane) = pk2(d0 * rkb * kg0, d1 * rkb * kg1); }
        const int ax = lane >> 5, half = (lane >> 4) & 1, f = lane & 15;
        { const int t = ra % TB; float o = va;
          if (t >= CTXL) { const int tt = t - CTXL; const int pos = ax == 0 ? (tt >> 6) : (tt & 63); const float cs = tab[(pos * 16 + f) * 2], sn = tab[(pos * 16 + f) * 2 + 1]; o = half == 0 ? va * cs - voa * sn : va * cs + voa * sn; }
          KR[(size_t)ra * 64 + lane] = (bf16)f2bf(o); }
        if (two) { const int t = rb_ % TB; float o = vb;
          if (t >= CTXL) { const int tt = t - CTXL; const int pos = ax == 0 ? (tt >> 6) : (tt & 63); const float cs = tab[(pos * 16 + f) * 2], sn = tab[(pos * 16 + f) * 2 + 1]; o = half == 0 ? vb * cs - vob * sn : vb * cs + vob * sn; }
          KR[(size_t)rb_ * 64 + lane] = (bf16)f2bf(o); }
    }
}
#define RLX_AGENT __ATOMIC_RELAXED, __HIP_MEMORY_SCOPE_AGENT
#define VM_WAIT() asm volatile("s_waitcnt vmcnt(0)" ::: "memory")
#define XB_TMO      128
#define XB_XCNT(j)  (256  + 64 * (j))
#define XB_XSUB(j)  (1280 + 64 * (j))
#define XB_XGEN(j)  (2304 + 64 * (j))
#define XB_TOP      3328
#define XB_TOPGEN   3392
#define XCD_BAR_WORDS 3456
#define XB_SPIN_CAP (1u << 18)

__device__ __forceinline__ unsigned xb_ld(unsigned* p)              { return __hip_atomic_load(p, __ATOMIC_RELAXED, __HIP_MEMORY_SCOPE_AGENT); }
__device__ __forceinline__ unsigned xb_add(unsigned* p, unsigned v) { return __hip_atomic_fetch_add(p, v, __ATOMIC_RELAXED, __HIP_MEMORY_SCOPE_AGENT); }
__device__ __forceinline__ unsigned xb_xcc_id() { return (unsigned)__builtin_amdgcn_s_getreg((3 << 11) | 20) & 0xFu; }
#define XB_SPIN(cond, bar) do { unsigned _sp = 0; while (cond) { __builtin_amdgcn_s_sleep(1); \
    if ((++_sp & 255u) == 0u) { if (xb_ld(&(bar)[XB_TMO])) break; if (_sp > XB_SPIN_CAP) { atomicAdd(&(bar)[XB_TMO], 1u); break; } } } } while (0)

struct XcdBarrier {
    unsigned* bar; unsigned x;
    volatile LAS unsigned* st;
};

__device__ __forceinline__ XcdBarrier xcd_barrier_post(unsigned* bar, volatile LAS unsigned* st) {
    XcdBarrier b; b.bar = bar; b.x = xb_xcc_id(); b.st = st;
    if (threadIdx.x == 0) (void)xb_add(&bar[XB_XCNT(b.x)], 1u);
    return b;
}
__device__ __forceinline__ void xcd_barrier_complete(unsigned* bar, unsigned x, unsigned& nloc, unsigned& nx) {
    const unsigned G = gridDim.x * gridDim.y * gridDim.z;
    unsigned sum, cnt, mine, sp = 0u;
    for (;;) {
        sum = 0u; cnt = 0u; mine = 0u;
#pragma unroll
        for (unsigned j = 0; j < 16; ++j) { const unsigned c = xb_ld(&bar[XB_XCNT(j)]); sum += c; cnt += (c > 0u) ? 1u : 0u; mine = (j == x) ? c : mine; }
        if (sum == G) break;
        __builtin_amdgcn_s_sleep(1);
        if ((++sp & 255u) == 0u) { if (xb_ld(&bar[XB_TMO])) break; if (sp > XB_SPIN_CAP) { atomicAdd(&bar[XB_TMO], 1u); break; } }
    }
    nloc = mine > 0u ? mine : 1u; nx = cnt > 0u ? cnt : 1u;
}

__device__ __forceinline__ void xcd_barrier(const XcdBarrier& b) {
    asm volatile("s_waitcnt vmcnt(0)" ::: "memory");
    __syncthreads();
    if (threadIdx.x == 0) {
        unsigned* bar = b.bar;
        __builtin_amdgcn_s_waitcnt(0);
        unsigned nloc = b.st[0], nx = b.st[1];
        if (nloc == 0u) { xcd_barrier_complete(bar, b.x, nloc, nx); b.st[0] = nloc; b.st[1] = nx; }
        const unsigned old = xb_add(&bar[XB_XSUB(b.x)], 1u);
        const unsigned gen = old / nloc;
        if (old + 1u == (gen + 1u) * nloc) {
            __builtin_amdgcn_fence(__ATOMIC_RELEASE, "agent");
            asm volatile("s_waitcnt vmcnt(0)" ::: "memory");
            const unsigned og = xb_add(&bar[XB_TOP], 1u);
            const unsigned tg = og / nx;
            if (og + 1u == (tg + 1u) * nx) xb_add(&bar[XB_TOPGEN], 1u);
            else XB_SPIN(xb_ld(&bar[XB_TOPGEN]) == tg, bar);
            __builtin_amdgcn_fence(__ATOMIC_ACQUIRE, "agent");
            xb_add(&bar[XB_XGEN(b.x)], 1u);
            asm volatile("s_waitcnt vmcnt(0)" ::: "memory");
        } else {
            XB_SPIN(xb_ld(&bar[XB_XGEN(b.x)]) == gen, bar);
            __builtin_amdgcn_fence(__ATOMIC_ACQUIRE, "agent");
            asm volatile("s_waitcnt vmcnt(0)" ::: "memory");
        }
    }
    __syncthreads();
}
constexpr int PPL = 15, N_PHASES = 1 + 2 * PPL, SKIP_PHASE = 1 + PPL;
__global__ void __launch_bounds__(NTHREADS, 2) mega_fwd(Args args) {
    extern __shared__ __attribute__((aligned(16))) unsigned char lds_raw[];
    LAS unsigned char* lds = (LAS unsigned char*)lds_raw;
    cg::grid_group grid = cg::this_grid();
    volatile LAS unsigned* MISC = (volatile LAS unsigned*)(lds + LDS_MISC);
    if (threadIdx.x < 16) MISC[threadIdx.x] = 0u;
    __syncthreads();
    XcdBarrier bar = xcd_barrier_post((unsigned*)(args.ws + WS_CTL), MISC + 8);
    for (int ph = args.ph_lo; ph < args.ph_hi; ++ph) {
        if (ph == SKIP_PHASE || ph == 1 + PPL + 11 || ph == 1 + PPL + 14 || ph == 1 + 9 || ph == 1 + PPL + 9) continue;
#define TID_DECL int tid_ = threadIdx.x; asm volatile("" : "+v"(tid_)); const int tid = tid_, lane = tid & 63, wave = __builtin_amdgcn_readfirstlane(tid >> 6); (void)tid; (void)lane; (void)wave
        int bid_ = blockIdx.x, nbl_ = gridDim.x; asm volatile("" : "+s"(bid_), "+s"(nbl_)); const int bid = bid_, nbl = nbl_;
        int zo_ = 0; asm volatile("" : "+s"(zo_));
        const ArgsV A_{&args, zo_}; unsigned char* ws = A_.ws();
        XcdBarrier barl = bar; asm volatile("" : "+s"(barl.x), "+s"(barl.bar));
        if (ph == 0) { TID_DECL; mod_phase(A_, lds, bid, nbl, tid, wave, lane); wconv_layer(A_, 0, lds, bid, nbl, wave, lane); }
        else {
            const int l = (ph - 1) / PPL, k = (ph - 1) % PPL;
            if (k == 0) { TID_DECL; phase_rw_a(A_, bid, nbl, wave, lane); }
            else if (k == 1 || k == 12) { const int j = k == 12;
                pg8::Gemm g{(const pg8::bf16_t*)(ws + WS_H), (const pg8::bf16_t*)(ws + WS_W1) + (size_t)j * NW1 * DM, R, NW1, DM}; pg8::TileOrder S; S.init(0, NW1, DM, nbl, bid, 1);
                pg8::EpiSwiGLU E{(pg8::bf16_t*)(ws + WS_BIG), DFFP};
                pg8::gemm_phase<pg8::EpiSwiGLU, pg8::TileOrder, true, true>(lds, g, S, E); }
            else if (k == 2 || k == 13 || k == 10) { const int j = k == 13, sub = k == 2 ? 0 : (k == 10 ? 1 : 2);
                const pg8::bf16_t* A = (const pg8::bf16_t*)(ws + (k == 10 ? WS_H : WS_BIG));
                const pg8::bf16_t* Bt = k == 10 ? (const pg8::bf16_t*)(ws + WS_WOUT) : (const pg8::bf16_t*)(ws + WS_W2) + (size_t)j * DM * DFFP;
                const int K = k == 10 ? DM : DFFP;
                pg8::Gemm g{A, Bt, R, DM, K}; pg8::TileOrder S; S.init(1, DM, K, nbl, bid, 1);
                const bool has_next = !(l == 1 && sub == 2); const int nl = sub == 2 ? l + 1 : l, nsub = sub == 2 ? 0 : sub + 1;
                const float* modb = (const float*)(ws + WS_MOD); unsigned* cntb = (unsigned*)(ws + WS_CTL + 65536) + (size_t)((l * 3 + sub) * 2) * (68 * 64);
                pg8::EpiNormRes E{(l == 0 && sub == 0) ? A_.in(I_X) : (const float*)A_.out(), A_.out(), has_next ? (pg8::bf16_t*)(ws + WS_H) : nullptr,
                                  modb + (size_t)((l * 5) * NMOD + 3 * sub + 2) * DM, A_.in(I_NPOST) + (size_t)(l * 3 + sub) * DM,
                                  A_.in(I_NPRE) + (size_t)((has_next ? nl : 0) * 3 + nsub) * DM, modb + (size_t)(((has_next ? nl : 0) * 5) * NMOD + 3 * nsub + 1) * DM, modb + (size_t)(((has_next ? nl : 0) * 5) * NMOD + 3 * nsub) * DM,
                                  sub == 1 ? 1.0f : 0.5f, pg8::PanelSS{(unsigned*)(ws + WS_MS + MS_X1), cntb}, pg8::PanelSS{(unsigned*)(ws + WS_MS + MS_X2), cntb + 68 * 64}};
                pg8::gemm_phase<pg8::EpiNormRes, pg8::TileOrder, false, true>(lds, g, S, E);
                if (l == 0 || k == 2) { __syncthreads();
                    pg8::TileOrder S2; S2.init(2, DM, K, nbl, bid, k == 10 ? 4 : 11);
                    pg8::EpiSlab E2{(float*)(ws + WS_AUP)};
                    pg8::gemm_phase<pg8::EpiSlab, pg8::TileOrder, true, true>(lds, g, S2, E2); } }
            else if (k == 6) {
                pg8::Gemm g{(const pg8::bf16_t*)(ws + WS_AUP), (const pg8::bf16_t*)(ws + WS_WUP), R, NUP, KUP}; pg8::TileOrder S; S.init(3, NUP, KUP, nbl, bid, 1);
                pg8::EpiStore E{(pg8::bf16_t*)(ws + WS_Y), NUP};
                pg8::gemm_phase<pg8::EpiStore, pg8::TileOrder, true, true>(lds, g, S, E);
                if (k == 6) {
                    __syncthreads();
                    for (int u = bid; u < 512; u += nbl)
                        ml::mlstm_local((const ml::bf16*)(ws + WS_BIG), (const float*)(ws + WS_MS + MS_T), A_.in(I_CW) + (size_t)l * 3 * 1024, A_.in(I_CB) + (size_t)l * 1024,
                                        (float*)(ws + WS_HF), (float*)(ws + WS_MS + MS_NLOC), u, (char*)lds_raw); } }
            else if (k == 3 || k == 11 || k == 14) { TID_DECL; phase_rw_b(A_, l, k == 3 ? 0 : (k == 11 ? 1 : 2), bid, nbl, wave, lane); if (k == 14 && l == 0) wconv_layer(A_, 1, lds, bid, nbl, wave, lane); }
            else if (k == 4) {
                pg8::Gemm g{(const pg8::bf16_t*)(ws + WS_H), (const pg8::bf16_t*)(ws + WS_WIN), R, DINP, DM}; pg8::TileOrder S; S.init(0, DINP, DM, nbl, bid, 1);
                pg8::EpiP E{(pg8::bf16_t*)(ws + WS_BIG), DINP, (float*)(ws + WS_BIG + BIG_G)};
                pg8::gemm_phase<pg8::EpiP, pg8::TileOrder, true, true>(lds, g, S, E); }
            else if (k == 5) { TID_DECL; phase_rw_prep(A_, l, bid, nbl, wave, lane); }
            else if (k == 7 || k == 8) {
                if (k == 7) { TID_DECL; ml::mlstm_scan((const float*)(ws + WS_HF), (const float*)(ws + WS_MS + MS_NLOC), (const float*)(ws + WS_MS + MS_SCA), (ml::bf16*)(ws + WS_AUP), (float*)(ws + WS_MS + MS_NST), (float*)(ws + WS_MS + MS_BM), bid * NTHREADS + tid, nbl * NTHREADS); }
                att::bf16* QKV = (att::bf16*)(ws + WS_Y); const att::bf16* KR = (const att::bf16*)(ws + WS_BIG + BIG_KR);
                const float* tab = (const float*)(ws + WS_TAB);
                int u0, u1;
                if (k == 8) { u0 = bid; u1 = 256; } else { u0 = (l == 0 && bid >= 128) ? 256 + (bid - 128) : 272; u1 = 272; }
                for (int u = u0; u < u1; u += nbl) {
                    int b, h, seq, rope, qtok0; size_t rq;
                    if (u < 256) { b = u >> 6; h = (u >> 4) & 3; const int qb = u & 15; rq = (size_t)b * TB + CTXL + (size_t)qb * 256; seq = TB; rope = 1; qtok0 = qb * 256; }
                    else { b = (u - 256) >> 2; h = (u - 256) & 3; rq = (size_t)b * TB; seq = CTXL; rope = 0; qtok0 = 0; }
                    const size_t r0 = (size_t)b * TB;
                    const int panel = u < 256 ? (b * 16 + (u & 15)) : (64 + b);
                    att::attn_body(QKV + rq * NUP + h * 192, QKV + r0 * NUP + 768 + h * 256, QKV + r0 * NUP + 768 + h * 256 + 128, KR + r0 * 64, (att::bf16*)(ws + WS_H) + rq * DM + h * 128, seq, rope, qtok0, tab, (char*)lds_raw,
                                   (unsigned*)(ws + WS_MS + MS_X1) + rq * 4, (unsigned*)(ws + WS_CTL + 65536) + (size_t)(12 + l) * (68 * 64) + 64 * panel, A_.in(I_AON) + l * 512 + h * 128, h);
                }
                const int m0 = nbl - 1 - bid, m1 = (k == 8) ? 256 : ((l == 0) ? 16 : 0);
                for (int u = m0; u < m1; u += nbl) { const int bh = (k == 8) ? (u >> 4) : u, tbk = (k == 8) ? 1 + (u & 15) : 0;
                    ml::mlstm_out2((const ml::bf16*)(ws + WS_BIG), (const float*)(ws + WS_MS + MS_T), A_.in(I_CW) + (size_t)l * 3 * 1024, A_.in(I_CB) + (size_t)l * 1024, (const ml::bf16*)(ws + WS_AUP),
                                   (const float*)(ws + WS_MS + MS_NST), (const float*)(ws + WS_MS + MS_BM), A_.in(I_MN) + l * 512, (ml::bf16*)(ws + WS_H), bh >> 2, bh & 3, tbk, (char*)lds_raw); }
            }
        }
        if (ph + 1 < args.ph_hi) { if (args.ph_hi < 0) grid.sync(); else xcd_barrier(barl); }
    }
}

#ifndef MK_ONE_LAUNCH
#define MK_ONE_LAUNCH 1
#endif
extern "C" void kernel_launch(void* const* d_in, const int* in_sizes, int n_in, void* d_out, int out_size, void* d_ws, size_t ws_size, hipStream_t stream) {
    static int grid = 0;
    if (grid == 0) {
        if (n_in != 22 || in_sizes[0] != NB * SEQ * DM || out_size != NB * SEQ * DM || ws_size < WS_END) { fprintf(stderr, "kernel_launch: shape/workspace mismatch (n_in %d, in0 %d, out %d, ws %zu need %zu)\n", n_in, n_in > 0 ? in_sizes[0] : -1, out_size, ws_size, (size_t)WS_END); grid = -1; return; }
        int dev = 0, cus = 0, per_cu = 0;
        if (hipGetDevice(&dev) != hipSuccess || hipDeviceGetAttribute(&cus, hipDeviceAttributeMultiprocessorCount, dev) != hipSuccess) { grid = -1; return; }
        if (hipFuncSetAttribute((const void*)mega_fwd, hipFuncAttributeMaxDynamicSharedMemorySize, LDS_BYTES) != hipSuccess) { fprintf(stderr, "kernel_launch: hipFuncSetAttribute failed\n"); grid = -1; return; }
        if (hipOccupancyMaxActiveBlocksPerMultiprocessor(&per_cu, (const void*)mega_fwd, NTHREADS, LDS_BYTES) != hipSuccess || per_cu < 1) { fprintf(stderr, "kernel_launch: occupancy query says %d\n", per_cu); per_cu = 1; }
        (void)hipGetLastError();
        grid = cus * (per_cu > 1 ? 1 : per_cu);
    }
    if (grid < 0) return;
    if (hipMemsetAsync((char*)d_ws + WS_CTL, 0, 65536 + 14 * 68 * 256, stream) != hipSuccess) { fprintf(stderr, "kernel_launch: memset of the barrier words failed\n"); return; }
    Args a{};
    for (int i = 0; i < 22; ++i) a.in[i] = (const float*)d_in[i];
    a.out = (float*)d_out; a.ws = (unsigned char*)d_ws;
#if MK_ONE_LAUNCH
    a.ph_lo = 0; a.ph_hi = N_PHASES;
    void* kargs[] = {&a};
    hipError_t e = hipLaunchCooperativeKernel((const void*)mega_fwd, dim3(grid), dim3(NTHREADS), kargs, LDS_BYTES, stream);
    if (e != hipSuccess) fprintf(stderr, "kernel_launch: cooperative launch failed: %s (grid %d)\n", hipGetErrorString(e), grid);
#else
    for (int ph = 0; ph < N_PHASES; ++ph) { if (ph == SKIP_PHASE) continue; a.ph_lo = ph; a.ph_hi = ph + 1;
        hipLaunchKernelGGL(mega_fwd, dim3(grid), dim3(NTHREADS), LDS_BYTES, stream, a);
        const hipError_t le = hipPeekAtLastError(); if (le != hipSuccess) { fprintf(stderr, "kernel_launch: launch of phase %d failed: %s\n", ph, hipGetErrorName(le)); break; } }
#endif
}
```

```cpp
#include <hip/hip_runtime.h>
#include <hip/hip_cooperative_groups.h>
#include <cstdio>
#include <cstdint>
namespace cg = cooperative_groups;
namespace pg8 {
#define PG8_LAS __attribute__((address_space(3)))
typedef unsigned short bf16_t;
typedef short bf16x8 __attribute__((ext_vector_type(8)));
typedef float f32x4 __attribute__((ext_vector_type(4)));
typedef unsigned u32x4 __attribute__((ext_vector_type(4)));
constexpr int BM = 256, BK = 64, HALF = 128, HTB = HALF * BK * 2  , STAGE_BYTES = 8 * HTB, NXCD = 8, WGM = 8;

__host__ __device__ __forceinline__ int lds_byte(int r, int c) { const int st = (r >> 4) * 2 + (c >> 5), rr = r & 15, cc = c & 31, ob = rr * 64 + cc * 2; return st * 1024 + (ob ^ (((ob >> 9) & 1) << 5)); }
__host__ __device__ __forceinline__ void stage_rc(int b, int& R, int& C) { const int st = b / 1024, sb = b % 1024, swz = sb ^ (((sb >> 9) & 1) << 5); R = (st >> 1) * 16 + swz / 64; C = (st & 1) * 32 + (swz % 64) / 2; }
__host__ __device__ __forceinline__ int perm32(int rho) { const int n = rho >> 4, i = rho & 15; return 8 * (i >> 2) + 4 * n + (i & 3); }

struct Unit { int pm, pn, kt0, nkt; };
struct Gemm { const bf16_t* A; const bf16_t* Bt; int M, N, K; };

struct StaticOrder {
    int nM, nN, nwg, G, c, nkt;
    __host__ __device__ void init(int M, int N, int K, int G_, int c_) { nM = M / BM; nN = N / BM; nwg = nM * nN; G = G_; c = c_; nkt = K / BK; }
    __host__ __device__ bool next(int i, Unit& u) const {
        const long L = (long)i * G + c; if (L >= nwg) return false;
        int wgid = (int)L; { const int q = nwg / NXCD, r = nwg % NXCD, xcd = wgid % NXCD, off = wgid / NXCD; wgid = (xcd < r ? xcd * (q + 1) : r * (q + 1) + (xcd - r) * q) + off; }
        const int nig = WGM * nN, gid = wgid / nig, fm = gid * WGM, gsz = (nM - fm) < WGM ? (nM - fm) : WGM;
        u.pm = fm + ((wgid % nig) % gsz); u.pn = (wgid % nig) / gsz; u.kt0 = 0; u.nkt = nkt; return true;
    }
    __device__ __forceinline__ void a_ready(const Unit&) const {}
    __device__ __forceinline__ void done(const Unit&) const {}
};

__device__ __forceinline__ unsigned cvt_pk_bf16(float lo, float hi) { unsigned r; asm volatile("v_cvt_pk_bf16_f32 %0, %1, %2" : "=v"(r) : "v"(lo), "v"(hi)); return r; }
typedef float f32x2 __attribute__((ext_vector_type(2)));
__device__ __forceinline__ f32x2 gelu_pk(f32x2 v) {
    const f32x2 av = __builtin_elementwise_abs(v), d = av * 0.2316418882f + 1.0f;
    f32x2 t; t.x = __builtin_amdgcn_rcpf(d.x); t.y = __builtin_amdgcn_rcpf(d.y);
    f32x2 q = t * 0.5307027145f + (-0.7265760135f); q = q * t + 0.7107068705f; q = q * t + (-0.142248368f); q = q * t + 0.127414796f; q = q * t;
    const f32x2 s = (v * v) * (-0.72134752044f);
    f32x2 e; e.x = __builtin_amdgcn_exp2f(s.x); e.y = __builtin_amdgcn_exp2f(s.y);
    const f32x2 m = v * (q * e), r = v - m;
    f32x2 o; o.x = v.x < 0.f ? m.x : r.x; o.y = v.y < 0.f ? m.y : r.y; return o;
}
__device__ __forceinline__ float silu_f(float x) { return x * __builtin_amdgcn_rcpf(1.0f + __builtin_amdgcn_exp2f(-1.4426950408889634f * x)); }
__device__ __forceinline__ void st8(bf16_t* p, f32x4 v0, f32x4 v1) { u32x4 w; w.x = cvt_pk_bf16(v0[0], v0[1]); w.y = cvt_pk_bf16(v0[2], v0[3]); w.z = cvt_pk_bf16(v1[0], v1[1]); w.w = cvt_pk_bf16(v1[2], v1[3]); *(u32x4*)p = w; }
struct EpiStore {
    static constexpr bool PERM = true, AFTER_DRAIN = false;
    bf16_t* O; int ldc;
    __device__ __forceinline__ void operator()(const f32x4 (&acc)[2][2][4][2], const Unit& u, int wr, int wc, int fr, int fq) const {
        const int row0 = u.pm * BM + wr * 64 + fr, col0 = u.pn * BM + wc * 32 + 8 * fq;
#pragma unroll
        for (int ai = 0; ai < 2; ++ai)
#pragma unroll
            for (int m = 0; m < 4; ++m) { bf16_t* rowp = O + (size_t)(row0 + ai * HALF + m * 16) * ldc + col0;
#pragma unroll
                for (int bj = 0; bj < 2; ++bj) st8(rowp + bj * HALF, acc[ai][bj][m][0], acc[ai][bj][m][1]); }
    }
};
struct EpiSwiGLU {
    static constexpr bool PERM = true, AFTER_DRAIN = false;
    bf16_t* O; int ldc;
    __device__ __forceinline__ void operator()(const f32x4 (&acc)[2][2][4][2], const Unit& u, int wr, int wc, int fr, int fq) const {
        const int row0 = u.pm * BM + wr * 64 + fr, col0 = u.pn * HALF + wc * 32 + 8 * fq;
#pragma unroll
        for (int ai = 0; ai < 2; ++ai)
#pragma unroll
            for (int m = 0; m < 4; ++m) { bf16_t* rowp = O + (size_t)(row0 + ai * HALF + m * 16) * ldc + col0;
                f32x4 v0, v1;
#pragma unroll
                for (int j = 0; j < 4; ++j) { v0[j] = silu_f(acc[ai][0][m][0][j]) * acc[ai][1][m][0][j]; v1[j] = silu_f(acc[ai][0][m][1][j]) * acc[ai][1][m][1][j]; }
                st8(rowp, v0, v1); }
    }
};
struct EpiP {
    static constexpr bool PERM = true, AFTER_DRAIN = false;
    bf16_t* O; int ldc; float* G;
    __device__ __forceinline__ void operator()(const f32x4 (&acc)[2][2][4][2], const Unit& u, int wr, int wc, int fr, int fq) const {
        const int row0 = u.pm * BM + wr * 64 + fr, col0 = u.pn * BM + wc * 32 + 8 * fq;
        const bool gt = (u.pn == 9) && (wc == 2) && (fq < 2);
#pragma unroll
        for (int ai = 0; ai < 2; ++ai)
#pragma unroll
            for (int m = 0; m < 4; ++m) { const int row = row0 + ai * HALF + m * 16; bf16_t* rowp = O + (size_t)row * ldc + col0;
#pragma unroll
                for (int bj = 0; bj < 2; ++bj) st8(rowp + bj * HALF, acc[ai][bj][m][0], acc[ai][bj][m][1]);
                if (gt) { *(f32x4*)(G + (size_t)row * 16 + 8 * fq) = acc[ai][1][m][0]; *(f32x4*)(G + (size_t)row * 16 + 8 * fq + 4) = acc[ai][1][m][1]; } }
    }
};
struct EpiSlab {
    static constexpr bool PERM = false, AFTER_DRAIN = false;
    float* S;
    __device__ __forceinline__ void operator()(const f32x4 (&acc)[2][2][4][2], const Unit& u, int wr, int wc, int fr, int fq) const {
        const int row0 = (u.pm / 17) * BM + wr * 64 + fr, col0 = u.pn * BM + wc * 32 + 4 * fq; const int slice = u.kt0 / u.nkt;
        float* base = S + (size_t)slice * 1024 * 1024;
#pragma unroll
        for (int ai = 0; ai < 2; ++ai)
#pragma unroll
            for (int m = 0; m < 4; ++m) { float* rowp = base + (size_t)(row0 + ai * HALF + m * 16) * 1024 + col0;
#pragma unroll
                for (int bj = 0; bj < 2; ++bj)
#pragma unroll
                    for (int n = 0; n < 2; ++n) *(f32x4*)(rowp + bj * HALF + n * 16) = acc[ai][bj][m][n]; }
    }
};
struct TileOrder {
    int mode, nM, nN, nwg, G, c, nkt, nsl;
    __device__ void init(int mode_, int N, int K, int G_, int c_, int nsl_) { mode = mode_; nN = N / BM; G = G_; c = c_; nsl = nsl_;
        if (mode == 2) { nM = 4; nwg = 4 * nN * nsl; nkt = (K / BK) / nsl; } else { nM = mode == 1 ? 64 : 68; nwg = nM * nN; nkt = K / BK; } }
    __device__ bool next(int i, Unit& u) const {
        const long L = (long)i * G + c; if (L >= nwg) return false;
        if (mode == 2) { const int sl = (int)L % nsl, t = (int)L / nsl; u.pn = t % nN; u.pm = 17 * (t / nN); u.kt0 = sl * nkt; u.nkt = nkt; return true; }
        int wgid = (int)L; { const int q = nwg / NXCD, r = nwg % NXCD, xcd = wgid % NXCD, off = wgid / NXCD; wgid = (xcd < r ? xcd * (q + 1) : r * (q + 1) + (xcd - r) * q) + off; }
        const int nig = WGM * nN, gid = wgid / nig, fm = gid * WGM, gsz = (nM - fm) < WGM ? (nM - fm) : WGM;
        int pm = fm + ((wgid % nig) % gsz); u.pn = (wgid % nig) / gsz; if (mode == 1) pm += (pm >> 4) + 1;
        u.pm = pm; u.kt0 = 0; u.nkt = nkt;
        if (mode == 3) { if (u.pn < 3) { u.kt0 = 0; u.nkt = 4; } else { u.kt0 = 4; u.nkt = 2; } }
        return true;
    }
    __device__ __forceinline__ void a_ready(const Unit&) const {}
    __device__ __forceinline__ void done(const Unit&) const {}
};

struct PanelSS {
    unsigned* xbuf;
    unsigned* cnt;
    __device__ __forceinline__ void run(const f32x4 (&v)[2][2][4][2], const Unit& u, int wr, int wc, int fr, int fq, PG8_LAS unsigned char* lds, int wid, int lane) const {
        PG8_LAS float* P = (PG8_LAS float*)lds;
        PG8_LAS float* S = (PG8_LAS float*)(lds + 8192);
#pragma unroll
        for (int ai = 0; ai < 2; ++ai)
#pragma unroll
            for (int m = 0; m < 4; ++m) { float s = 0.f;
#pragma unroll
                for (int bj = 0; bj < 2; ++bj)
#pragma unroll
                    for (int n = 0; n < 2; ++n) { const f32x4 x = v[ai][bj][m][n]; s += (x[0] * x[0] + x[1] * x[1]) + (x[2] * x[2] + x[3] * x[3]); }
                s += __shfl_xor(s, 16); s += __shfl_xor(s, 32);
                if (fq == 0) P[(ai * HALF + wr * 64 + m * 16 + fr) * 4 + wc] = s; }
        asm volatile("s_waitcnt lgkmcnt(0)" ::: "memory"); __builtin_amdgcn_s_barrier(); asm volatile("" ::: "memory");
        const int row = wid * 32 + (lane & 31);
        if (lane < 32) { const float t = (P[row * 4 + 0] + P[row * 4 + 1]) + (P[row * 4 + 2] + P[row * 4 + 3]);
            __hip_atomic_store(xbuf + (size_t)(u.pm * BM + row) * 4 + u.pn, __float_as_uint(t), __ATOMIC_RELAXED, __HIP_MEMORY_SCOPE_AGENT); }
        asm volatile("s_waitcnt vmcnt(0)" ::: "memory");
        if (lane == 0) __hip_atomic_fetch_add(cnt + 64 * u.pm, 1u, __ATOMIC_RELAXED, __HIP_MEMORY_SCOPE_AGENT);
        if (wid == 0) { unsigned sp = 0;
            while ((unsigned)__builtin_amdgcn_readfirstlane(__hip_atomic_load(cnt + 64 * u.pm, __ATOMIC_RELAXED, __HIP_MEMORY_SCOPE_AGENT)) < 32u) { __builtin_amdgcn_s_sleep(2); if (++sp > (1u << 22)) break; }
            __builtin_amdgcn_fence(__ATOMIC_ACQUIRE, "agent"); }
        asm volatile("s_waitcnt vmcnt(0) lgkmcnt(0)" ::: "memory"); __builtin_amdgcn_s_barrier(); asm volatile("" ::: "memory");
        if (lane < 32) { const unsigned* slot = xbuf + (size_t)(u.pm * BM + row) * 4; float t = 0.f;
#pragma unroll
            for (int q = 0; q < 4; ++q) t += __uint_as_float(__hip_atomic_load(slot + q, __ATOMIC_RELAXED, __HIP_MEMORY_SCOPE_AGENT));
            S[row] = t; }
        asm volatile("s_waitcnt lgkmcnt(0)" ::: "memory"); __builtin_amdgcn_s_barrier(); asm volatile("" ::: "memory");
    }
};
struct EpiNormRes {
    static constexpr bool PERM = false, AFTER_DRAIN = true;
    const float* xsrc; float* xdst;
    bf16_t* H;
    const float* gate; const float* gpost;
    const float* gpre; const float* sc; const float* sh;
    float wgt; PanelSS st1, st2;
    __device__ __forceinline__ void fused(f32x4 (&acc)[2][2][4][2], const Unit& u, int wr, int wc, int fr, int fq, PG8_LAS unsigned char* lds, int wid, int lane) const {
        const PG8_LAS float* S = (const PG8_LAS float*)(lds + 8192);
        const int b = u.pm / 17, tp = (u.pm - 17 * b - 1) * BM;
        const int col0 = u.pn * BM + wc * 32 + 4 * fq; const size_t mo = (size_t)b * 9 * 1024;
        st1.run(acc, u, wr, wc, fr, fq, lds, wid, lane);
        {   f32x4 cg[2][2];
#pragma unroll
            for (int bj = 0; bj < 2; ++bj)
#pragma unroll
                for (int n = 0; n < 2; ++n) cg[bj][n] = *(const f32x4*)(gate + mo + col0 + bj * HALF + n * 16) * *(const f32x4*)(gpost + col0 + bj * HALF + n * 16) * wgt;
#pragma unroll
            for (int ai = 0; ai < 2; ++ai)
#pragma unroll
                for (int m = 0; m < 4; ++m) { const int r = ai * HALF + wr * 64 + m * 16 + fr; const float rs = 1.0f / sqrtf(S[r] * (1.0f / 1024.0f) + 1e-6f);
                    const size_t off = ((size_t)b * 4096 + tp + r) * 1024 + col0;
#pragma unroll
                    for (int bj = 0; bj < 2; ++bj)
#pragma unroll
                        for (int n = 0; n < 2; ++n) { const f32x4 xo = *(const f32x4*)(xsrc + off + bj * HALF + n * 16); const f32x4 xn = xo + cg[bj][n] * (acc[ai][bj][m][n] * rs);
                            acc[ai][bj][m][n] = xn; *(f32x4*)(xdst + off + bj * HALF + n * 16) = xn; }
                    asm volatile("" : "+v"(acc[ai][0][m][0]), "+v"(acc[ai][0][m][1]), "+v"(acc[ai][1][m][0]), "+v"(acc[ai][1][m][1]));
                    if (m & 1) asm volatile("" ::: "memory"); } }
        if (H == nullptr) return;
        asm volatile("s_waitcnt lgkmcnt(0)" ::: "memory"); __builtin_amdgcn_s_barrier(); asm volatile("" ::: "memory");
        st2.run(acc, u, wr, wc, fr, fq, lds, wid, lane);
        {   typedef unsigned u32x2v __attribute__((ext_vector_type(2)));
            f32x4 ca[2][2], cs[2][2];
#pragma unroll
            for (int bj = 0; bj < 2; ++bj)
#pragma unroll
                for (int n = 0; n < 2; ++n) { const int c = col0 + bj * HALF + n * 16; ca[bj][n] = *(const f32x4*)(gpre + c) * (*(const f32x4*)(sc + mo + c) + 1.0f); cs[bj][n] = *(const f32x4*)(sh + mo + c); }
#pragma unroll
            for (int ai = 0; ai < 2; ++ai)
#pragma unroll
                for (int m = 0; m < 4; ++m) { const int r = ai * HALF + wr * 64 + m * 16 + fr; const float rs = 1.0f / sqrtf(S[r] * (1.0f / 1024.0f) + 1e-6f);
                    bf16_t* hp = H + (size_t)(u.pm * BM + r) * 1024 + col0;
#pragma unroll
                    for (int bj = 0; bj < 2; ++bj)
#pragma unroll
                        for (int n = 0; n < 2; ++n) { const f32x4 o = acc[ai][bj][m][n] * rs * ca[bj][n] + cs[bj][n]; u32x2v w; w.x = cvt_pk_bf16(o[0], o[1]); w.y = cvt_pk_bf16(o[2], o[3]);
                            *(u32x2v*)(hp + bj * HALF + n * 16) = w; } } }
    }
};

template <class Epi, class Sched, bool ALIGN_EPI = false, bool SP2 = false>
__device__ __forceinline__ void gemm_phase(PG8_LAS unsigned char* lds, const Gemm g, const Sched& S, const Epi& E) {
    int tid_ = threadIdx.x; asm volatile("" : "+v"(tid_));
    const int tid = tid_, wid = __builtin_amdgcn_readfirstlane(tid >> 6), lane = tid & 63, wr = wid >> 2, wc = wid & 3, fr = lane & 15, fq = lane >> 4;
    const int K = g.K;
    unsigned voffA[2], voffB[2];
#pragma unroll
    for (int i = 0; i < 2; ++i) { int R, C; stage_rc(tid * 16 + i * 8192, R, C); const int Rb = Epi::PERM ? ((R & ~31) + perm32(R & 31)) : R;
        voffA[i] = (unsigned)(R * K + C) * 2u; voffB[i] = (unsigned)(Rb * K + C) * 2u; }
    const size_t kstep = (size_t)(BK * 2);
    const size_t hstep = (size_t)HALF * K * 2;
    const size_t tstep = 2 * hstep;
    const unsigned ldsw = (unsigned)wid * 1024u;
    const int aoff = lds_byte(wr * 64 + fr, fq * 8), boff = lds_byte(wc * 32 + fr, fq * 8);
#define PG8_SA(b, h) (((b) * 2 + (h)) * HTB)
#define PG8_SB(b, h) ((4 + (b) * 2 + (h)) * HTB)
#define PG8_STAGE(bufoff, gbase, voff) do { _Pragma("unroll") for (int _i = 0; _i < 2; ++_i) \
        __builtin_amdgcn_global_load_lds((const unsigned*)((const char*)(gbase) + (voff)[_i]), (PG8_LAS unsigned*)(lds + (bufoff) + ldsw + _i * 8192), 16, 0, 0); } while (0)
#define PG8_LDA(dst, b, h) do { _Pragma("unroll") for (int m = 0; m < 4; ++m) _Pragma("unroll") for (int k = 0; k < 2; ++k) dst[m][k] = *(const PG8_LAS bf16x8*)(lds + PG8_SA(b, h) + aoff + m * 2048 + k * 1024); } while (0)
#define PG8_LDB(dst, b, h) do { _Pragma("unroll") for (int n = 0; n < 2; ++n) _Pragma("unroll") for (int k = 0; k < 2; ++k) dst[n][k] = *(const PG8_LAS bf16x8*)(lds + PG8_SB(b, h) + boff + n * 2048 + k * 1024); } while (0)
#define PG8_MMA(ai, bj, At, Bt) do { __builtin_amdgcn_s_setprio(1); _Pragma("unroll") for (int m = 0; m < 4; ++m) _Pragma("unroll") for (int n = 0; n < 2; ++n) _Pragma("unroll") for (int k = 0; k < 2; ++k) \
        acc[ai][bj][m][n] = __builtin_amdgcn_mfma_f32_16x16x32_bf16(Bt[n][k], At[m][k], acc[ai][bj][m][n], 0, 0, 0); __builtin_amdgcn_s_setprio(0); } while (0)
#define PG8_WAIT_V(n) asm volatile("s_waitcnt vmcnt(" #n ")" ::: "memory")
#define PG8_WAIT_L(n) asm volatile("s_waitcnt lgkmcnt(" #n ")" ::: "memory")
#define PG8_BAR __builtin_amdgcn_s_barrier()
#define PG8_SCHED __builtin_amdgcn_sched_barrier(0)
    Unit cur, nxt; int ui = 0;
    if (!S.next(0, cur)) return;
    f32x4 acc[2][2][4][2];
#pragma unroll
    for (int a = 0; a < 2; ++a)
#pragma unroll
        for (int b = 0; b < 2; ++b)
#pragma unroll
            for (int m = 0; m < 4; ++m)
#pragma unroll
                for (int n = 0; n < 2; ++n) acc[a][b][m][n] = (f32x4){0.f, 0.f, 0.f, 0.f};
    bf16x8 At[4][2], B0[2][2], B1[2][2];
    const char* cA = (const char*)g.A + (size_t)cur.pm * tstep + (size_t)cur.kt0 * kstep; const char* cB = (const char*)g.Bt + (size_t)cur.pn * tstep + (size_t)cur.kt0 * kstep;
    S.a_ready(cur);
    if constexpr (SP2) {
        PG8_STAGE(PG8_SB(0, 0), cB, voffB); PG8_STAGE(PG8_SB(0, 1), cB + hstep, voffB); PG8_STAGE(PG8_SA(0, 0), cA, voffA); PG8_STAGE(PG8_SA(0, 1), cA + hstep, voffA);
        if (wr == 1) PG8_BAR;
        PG8_WAIT_V(2); PG8_BAR;
        PG8_STAGE(PG8_SB(1, 0), cB + kstep, voffB); PG8_STAGE(PG8_SA(1, 0), cA + kstep, voffA); PG8_STAGE(PG8_SB(1, 1), cB + hstep + kstep, voffB);
        PG8_WAIT_V(6); PG8_BAR;
    } else {
        PG8_STAGE(PG8_SB(0, 0), cB, voffB); PG8_STAGE(PG8_SA(0, 0), cA, voffA); PG8_STAGE(PG8_SB(0, 1), cB + hstep, voffB); PG8_STAGE(PG8_SA(0, 1), cA + hstep, voffA);
        if (wr == 1) PG8_BAR;
        PG8_WAIT_V(4); PG8_BAR;
        PG8_STAGE(PG8_SB(1, 0), cB + kstep, voffB); PG8_STAGE(PG8_SA(1, 0), cA + kstep, voffA); PG8_STAGE(PG8_SB(1, 1), cB + hstep + kstep, voffB);
        PG8_WAIT_V(6); PG8_BAR;
    }
    for (;;) {
        const bool has_next = S.next(ui + 1, nxt);
        const char* nA = has_next ? (const char*)g.A + (size_t)nxt.pm * tstep + (size_t)nxt.kt0 * kstep : cA; const char* nB = has_next ? (const char*)g.Bt + (size_t)nxt.pn * tstep + (size_t)nxt.kt0 * kstep : cB;
        const int nt = cur.nkt;
        for (int t = 0; t < nt; t += 2) {
            const bool last = (t == nt - 2);
            const char* a1 = cA + (size_t)(t + 1) * kstep;
            const char* a2 = last ? nA : cA + (size_t)(t + 2) * kstep; const char* b2 = last ? nB : cB + (size_t)(t + 2) * kstep;
            const char* a3 = a2 + kstep; const char* b3 = b2 + kstep;
            if (last && has_next) S.a_ready(nxt);
            if constexpr (SP2) {
            PG8_LDB(B0, 0, 0); PG8_LDB(B1, 0, 1); PG8_SCHED; PG8_LDA(At, 0, 0); PG8_STAGE(PG8_SA(1, 1), a1 + hstep, voffA);
            PG8_WAIT_V(8); PG8_WAIT_L(0); PG8_BAR; PG8_MMA(0, 0, At, B0); PG8_MMA(0, 1, At, B1); PG8_BAR; PG8_SCHED;
            PG8_LDA(At, 0, 1); PG8_STAGE(PG8_SB(0, 0), b2, voffB); PG8_STAGE(PG8_SB(0, 1), b2 + hstep, voffB); PG8_STAGE(PG8_SA(0, 0), a2, voffA);
            PG8_WAIT_V(8); PG8_WAIT_L(0); PG8_BAR; PG8_MMA(1, 0, At, B0); PG8_MMA(1, 1, At, B1); PG8_BAR; PG8_SCHED;
            PG8_LDB(B0, 1, 0); PG8_LDB(B1, 1, 1); PG8_SCHED; PG8_LDA(At, 1, 0); PG8_STAGE(PG8_SA(0, 1), a2 + hstep, voffA);
            PG8_WAIT_V(8); PG8_WAIT_L(0); PG8_BAR; PG8_MMA(0, 0, At, B0); PG8_MMA(0, 1, At, B1); PG8_BAR; PG8_SCHED;
            PG8_LDA(At, 1, 1); PG8_STAGE(PG8_SB(1, 0), b3, voffB); PG8_STAGE(PG8_SB(1, 1), b3 + hstep, voffB); PG8_STAGE(PG8_SA(1, 0), a3, voffA);
            PG8_WAIT_V(8); PG8_WAIT_L(0); PG8_BAR; PG8_MMA(1, 0, At, B0); PG8_MMA(1, 1, At, B1); PG8_BAR; PG8_SCHED;
            } else {
            PG8_LDB(B0, 0, 0); PG8_SCHED; PG8_LDA(At, 0, 0); PG8_STAGE(PG8_SA(1, 1), a1 + hstep, voffA);
            PG8_WAIT_L(8); PG8_BAR; PG8_WAIT_L(0); PG8_MMA(0, 0, At, B0); PG8_BAR; PG8_SCHED;
            PG8_LDB(B1, 0, 1); PG8_STAGE(PG8_SB(0, 0), b2, voffB);
            PG8_BAR; PG8_WAIT_L(0); PG8_MMA(0, 1, At, B1); PG8_BAR;
            PG8_LDA(At, 0, 1); PG8_STAGE(PG8_SA(0, 0), a2, voffA);
            PG8_BAR; PG8_WAIT_L(0); PG8_MMA(1, 0, At, B0); PG8_BAR; PG8_SCHED;
            PG8_STAGE(PG8_SB(0, 1), b2 + hstep, voffB);
            PG8_WAIT_V(6); PG8_BAR; PG8_MMA(1, 1, At, B1); PG8_BAR;
            PG8_LDB(B0, 1, 0); PG8_SCHED; PG8_LDA(At, 1, 0); PG8_STAGE(PG8_SA(0, 1), a2 + hstep, voffA);
            PG8_WAIT_L(8); PG8_BAR; PG8_WAIT_L(0); PG8_MMA(0, 0, At, B0); PG8_BAR; PG8_SCHED;
            PG8_LDB(B1, 1, 1); PG8_STAGE(PG8_SB(1, 0), b3, voffB);
            PG8_BAR; PG8_WAIT_L(0); PG8_MMA(0, 1, At, B1); PG8_BAR;
            PG8_LDA(At, 1, 1); PG8_STAGE(PG8_SA(1, 0), a3, voffA);
            PG8_BAR; PG8_WAIT_L(0); PG8_MMA(1, 0, At, B0); PG8_BAR; PG8_SCHED;
            PG8_STAGE(PG8_SB(1, 1), b3 + hstep, voffB);
            PG8_WAIT_V(6); PG8_BAR; PG8_MMA(1, 1, At, B1); PG8_BAR;
            }
        }
        if constexpr (ALIGN_EPI) { if (wr == 0) PG8_BAR; }
        if constexpr (!Epi::AFTER_DRAIN) { E(acc, cur, wr, wc, fr, fq); S.done(cur); }
        if (!has_next) break;
#pragma unroll
        for (int a = 0; a < 2; ++a)
#pragma unroll
            for (int b = 0; b < 2; ++b)
#pragma unroll
                for (int m = 0; m < 4; ++m)
#pragma unroll
                    for (int n = 0; n < 2; ++n) acc[a][b][m][n] = (f32x4){0.f, 0.f, 0.f, 0.f};
        cur = nxt; cA = nA; cB = nB; ++ui;
        if constexpr (ALIGN_EPI) { if (wr == 1) PG8_BAR; }
    }
    PG8_WAIT_V(0);
    if constexpr (!ALIGN_EPI) { if (wr == 0) PG8_BAR; }
    PG8_BAR;
    if constexpr (Epi::AFTER_DRAIN) { E.fused(acc, cur, wr, wc, fr, fq, lds, wid, lane); S.done(cur); }
#undef PG8_SA
#undef PG8_SB
#undef PG8_STAGE
#undef PG8_LDA
#undef PG8_LDB
#undef PG8_MMA
#undef PG8_WAIT_V
#undef PG8_WAIT_L
#undef PG8_BAR
#undef PG8_SCHED
}
}
namespace att {
typedef unsigned short bf16;
constexpr int NW = 8, QBLK = 32, KVBLK = 64;
constexpr float SCALE = 0.07216878364870322f;
constexpr float THR = 8.f;
constexpr int SDEPTH = 1;
constexpr int LDQ = 1792, LDK = 1792, LDR = 64, LDO = 1024;
constexpr int SHM_V = KVBLK * 128 * 2, SHM_K = KVBLK * 192 * 2, SHM_QR = NW * 4 * 64 * 16, SHM_ATTN = 2 * SHM_V + 2 * SHM_K + NW * 64 * 4 + SHM_QR;
using bf16x8 = __attribute__((ext_vector_type(8))) short;
using s16x4  = __attribute__((ext_vector_type(4))) short;
using f32x16 = __attribute__((ext_vector_type(16))) float;
using u32x4  = __attribute__((ext_vector_type(4))) unsigned;
#define KSWZ(row, colB) ((row) * 384 + ((colB) ^ ((((row) >> 1) & 7) << 4)))
#define SBAR() __builtin_amdgcn_sched_barrier(0)
__device__ __forceinline__ int crow(int r, int hi) { return (r & 3) + 8 * (r >> 2) + 4 * hi; }
__device__ __forceinline__ unsigned cvtpk(float lo, float hi) { unsigned r; asm volatile("v_cvt_pk_bf16_f32 %0, %1, %2" : "=v"(r) : "v"(lo), "v"(hi)); return r; }
__device__ __forceinline__ bf16x8 ld8(const bf16* p) { return *reinterpret_cast<const bf16x8*>(p); }
__device__ __forceinline__ float bf2f(short b) { return __uint_as_float(((unsigned)(unsigned short)b) << 16); }

__device__ __forceinline__ void partialSM(f32x16& p0, f32x16& p1, float& m_reg, float& mn, float& alpha) {
  constexpr float C = SCALE * 1.4426950408889634f;
  float pmax = p0[0];
#pragma unroll
  for (int r = 1; r < 16; ++r) pmax = fmaxf(pmax, p0[r]);
#pragma unroll
  for (int r = 0; r < 16; ++r) pmax = fmaxf(pmax, p1[r]);
  { auto rr = __builtin_amdgcn_permlane32_swap(__float_as_uint(pmax), __float_as_uint(pmax), false, false);
    pmax = fmaxf(__uint_as_float(rr[0]), __uint_as_float(rr[1])); }
  if (__builtin_expect(__all(pmax - m_reg <= THR / SCALE), 1)) { mn = m_reg; alpha = 1.f; }
  else { mn = fmaxf(m_reg, pmax); alpha = __builtin_amdgcn_exp2f((m_reg - mn) * C); m_reg = mn; }
  float mnC = -mn * C;
#pragma unroll
  for (int r = 0; r < 16; ++r) p0[r] = fmaf(p0[r], C, mnC);
#pragma unroll
  for (int r = 0; r < 16; ++r) p1[r] = fmaf(p1[r], C, mnC);
#pragma unroll
  for (int r = 0; r < 16; ++r) p0[r] = __builtin_amdgcn_exp2f(p0[r]);
}
__device__ __forceinline__ void finishSM(f32x16& p0, f32x16& p1, float alpha, float& l_reg, bf16x8& pa0, bf16x8& pa1, bf16x8& pa2, bf16x8& pa3) {
#pragma unroll
  for (int r = 0; r < 16; ++r) p1[r] = __builtin_amdgcn_exp2f(p1[r]);
  float ps = 0;
#pragma unroll
  for (int r = 0; r < 16; ++r) ps += p0[r];
#pragma unroll
  for (int r = 0; r < 16; ++r) ps += p1[r];
  { auto rr = __builtin_amdgcn_permlane32_swap(__float_as_uint(ps), __float_as_uint(ps), false, false);
    ps = __uint_as_float(rr[0]) + __uint_as_float(rr[1]); }
  l_reg = l_reg * alpha + ps;
#define PK4(P, BASE, OUT) do { unsigned a0 = cvtpk(P[BASE + 0], P[BASE + 1]), a1 = cvtpk(P[BASE + 2], P[BASE + 3]);   \
    unsigned b0 = cvtpk(P[BASE + 4], P[BASE + 5]), b1 = cvtpk(P[BASE + 6], P[BASE + 7]);                              \
    auto r0 = __builtin_amdgcn_permlane32_swap(a0, b0, false, false); auto r1 = __builtin_amdgcn_permlane32_swap(a1, b1, false, false); \
    u32x4 w = {r0[0], r1[0], r0[1], r1[1]}; OUT = *reinterpret_cast<bf16x8*>(&w); } while (0)
  PK4(p0, 0, pa0); PK4(p0, 8, pa1); PK4(p1, 0, pa2); PK4(p1, 8, pa3);
#undef PK4
}
__device__ __forceinline__ void qkt(f32x16& p0, f32x16& p1, const bf16* Ks, const bf16x8 (&qr)[8], const bf16x8* qrl, int r32, int hi) {
  p0 = f32x16{}; p1 = f32x16{};
#pragma unroll
  for (int d0 = 0; d0 < 12; ++d0) { int cb = (d0 * 16 + hi * 8) * 2;
    bf16x8 b0 = *reinterpret_cast<const bf16x8*>((const char*)Ks + KSWZ(r32, cb));
    bf16x8 b1 = *reinterpret_cast<const bf16x8*>((const char*)Ks + KSWZ(32 + r32, cb));
    const bf16x8 qf = d0 < 8 ? qr[d0 < 8 ? d0 : 0] : qrl[(d0 - 8) * 64];
    p0 = __builtin_amdgcn_mfma_f32_32x32x16_bf16(b0, qf, p0, 0, 0, 0);
    p1 = __builtin_amdgcn_mfma_f32_32x32x16_bf16(b1, qf, p1, 0, 0, 0); }
}
__device__ __forceinline__ int v_st(int k, int c) { const int kk = (k & ~0xC) | ((k & 4) << 1) | ((k & 8) >> 1); return ((kk >> 3) * 4 + (c >> 5)) * 512 + ((kk & 7) * 32 + (c & 31)) * 2; }
__device__ __forceinline__ int v_rd_base(int lane) { return ((lane & 3) << 3) | (((lane >> 2) & 3) << 6) | (((lane >> 4) & 1) << 5) | (((lane >> 5) & 1) << 8); }
constexpr int v_rd_off(int d0, int ks, int half) { return d0 * 512 + ks * 4096 + half * 2048; }
template <int OFF> __device__ __forceinline__ s16x4 tr_read(int vb) {
  s16x4 r; asm volatile("ds_read_b64_tr_b16 %0, %1 offset:%2" : "=&v"(r) : "v"(vb), "i"(OFF) : "memory"); return r;
}
template <int D0> __device__ __forceinline__ void pv_one(f32x16& od, int vb, bf16x8 pa0, bf16x8 pa1, bf16x8 pa2, bf16x8 pa3) {
  const s16x4 l0 = tr_read<v_rd_off(D0, 0, 0)>(vb), h0 = tr_read<v_rd_off(D0, 0, 1)>(vb), l1 = tr_read<v_rd_off(D0, 1, 0)>(vb), h1 = tr_read<v_rd_off(D0, 1, 1)>(vb);
  const s16x4 l2 = tr_read<v_rd_off(D0, 2, 0)>(vb), h2 = tr_read<v_rd_off(D0, 2, 1)>(vb), l3 = tr_read<v_rd_off(D0, 3, 0)>(vb), h3 = tr_read<v_rd_off(D0, 3, 1)>(vb);
  asm volatile("s_waitcnt lgkmcnt(0)" ::: "memory"); SBAR();
#define PK(L, H) (bf16x8){L[0], L[1], L[2], L[3], H[0], H[1], H[2], H[3]}
  od = __builtin_amdgcn_mfma_f32_32x32x16_bf16(pa0, PK(l0, h0), od, 0, 0, 0);
  od = __builtin_amdgcn_mfma_f32_32x32x16_bf16(pa1, PK(l1, h1), od, 0, 0, 0);
  od = __builtin_amdgcn_mfma_f32_32x32x16_bf16(pa2, PK(l2, h2), od, 0, 0, 0);
  od = __builtin_amdgcn_mfma_f32_32x32x16_bf16(pa3, PK(l3, h3), od, 0, 0, 0);
#undef PK
}
__device__ __forceinline__ void pv_d0(f32x16 (&o)[4], int vb, bf16x8 pa0, bf16x8 pa1, bf16x8 pa2, bf16x8 pa3) {
  pv_one<0>(o[0], vb, pa0, pa1, pa2, pa3); pv_one<1>(o[1], vb, pa0, pa1, pa2, pa3); pv_one<2>(o[2], vb, pa0, pa1, pa2, pa3); pv_one<3>(o[3], vb, pa0, pa1, pa2, pa3);
}
__device__ __forceinline__ void attn_body(const bf16* __restrict__ Qb, const bf16* __restrict__ Kn, const bf16* __restrict__ Vh, const bf16* __restrict__ Kr,
                                          bf16* __restrict__ Ob, int seq, int rope, int qtok0, const float* __restrict__ tab, char* lds,
                                          unsigned* __restrict__ xs, unsigned* __restrict__ cnt, const float* __restrict__ gain, int head) {
  int tid_ = threadIdx.x; asm volatile("" : "+v"(tid_));
  const int tid = tid_, wid = tid >> 6, lane = tid & 63, r32 = lane & 31, hi = lane >> 5;
  bf16* V_lds = (bf16*)lds; bf16* K_lds = (bf16*)(lds + 2 * SHM_V);
  float* ws = (float*)(lds + 2 * SHM_V + 2 * SHM_K) + wid * 64; float* li_l = ws; float* al_l = ws + 32;
  float m_reg = -1e30f, l_reg = 0; f32x16 o[4] = {}; bf16x8 qr[8]; bf16x8 qx[4];
  bf16x8* qrl = (bf16x8*)(lds + 2 * SHM_V + 2 * SHM_K + NW * 64 * 4) + wid * 256 + lane;
  const bf16* Qw = Qb + (long)(wid * QBLK + r32) * LDQ + hi * 8;
#pragma unroll
  for (int d0 = 0; d0 < 8; ++d0) qr[d0] = ld8(Qw + d0 * 16);
#pragma unroll
  for (int d0 = 0; d0 < 4; ++d0) qx[d0] = ld8(Qw + 128 + d0 * 16);
  if (rope) {
    const int tt = qtok0 + wid * QBLK + r32; const int prow = tt >> 6, pcol = tt & 63;
    const float* tr = tab + (prow * 16 + hi * 8) * 2; const float* tc = tab + (pcol * 16 + hi * 8) * 2;
    unsigned a1[4], a2[4], c1[4], c2[4];
#pragma unroll
    for (int j = 0; j < 8; j += 2) {
      float o1[2], o2[2], p1[2], p2[2];
#pragma unroll
      for (int e = 0; e < 2; ++e) {
        const float cr = tr[(j + e) * 2], sr_ = tr[(j + e) * 2 + 1], cc = tc[(j + e) * 2], sc_ = tc[(j + e) * 2 + 1];
        const float x1 = bf2f(qx[0][j + e]), x2 = bf2f(qx[1][j + e]), y1 = bf2f(qx[2][j + e]), y2 = bf2f(qx[3][j + e]);
        o1[e] = x1 * cr - x2 * sr_; o2[e] = x2 * cr + x1 * sr_; p1[e] = y1 * cc - y2 * sc_; p2[e] = y2 * cc + y1 * sc_; }
      a1[j >> 1] = cvtpk(o1[0], o1[1]); a2[j >> 1] = cvtpk(o2[0], o2[1]); c1[j >> 1] = cvtpk(p1[0], p1[1]); c2[j >> 1] = cvtpk(p2[0], p2[1]); }
    { u32x4 w = {a1[0], a1[1], a1[2], a1[3]}; qx[0] = *reinterpret_cast<bf16x8*>(&w); }
    { u32x4 w = {a2[0], a2[1], a2[2], a2[3]}; qx[1] = *reinterpret_cast<bf16x8*>(&w); }
    { u32x4 w = {c1[0], c1[1], c1[2], c1[3]}; qx[2] = *reinterpret_cast<bf16x8*>(&w); }
    { u32x4 w = {c2[0], c2[1], c2[2], c2[3]}; qx[3] = *reinterpret_cast<bf16x8*>(&w); }
  }
#pragma unroll
  for (int d0 = 0; d0 < 4; ++d0) qrl[d0 * 64] = qx[d0];
  const int sr = tid >> 4, sc = (tid & 15) * 8, vst0 = v_st(sr, sc), vst1 = v_st(32 + sr, sc);
  const int rr = tid >> 3, rc = (tid & 7) * 8;
  const int vb0 = (int)(uintptr_t)V_lds + v_rd_base(lane);
  struct { bf16x8 vs0, vs1, ks0, ks1, kr0; } sr_[SDEPTH];
#define SLOAD(i, k0) do { sr_[i].vs0 = ld8(&Vh[(long)((k0) + sr) * LDK + sc]); sr_[i].vs1 = ld8(&Vh[(long)((k0) + 32 + sr) * LDK + sc]); \
    sr_[i].ks0 = ld8(&Kn[(long)((k0) + sr) * LDK + sc]); sr_[i].ks1 = ld8(&Kn[(long)((k0) + 32 + sr) * LDK + sc]); sr_[i].kr0 = ld8(&Kr[(long)((k0) + rr) * LDR + rc]); } while (0)
#define SWRITE(b, i) do { *(bf16x8*)((char*)V_lds + (b) * SHM_V + vst0) = sr_[i].vs0;          \
    *(bf16x8*)((char*)V_lds + (b) * SHM_V + vst1) = sr_[i].vs1; int kc = sc * 2;               \
    *(bf16x8*)((char*)K_lds + (b) * SHM_K + KSWZ(sr, kc)) = sr_[i].ks0;                       \
    *(bf16x8*)((char*)K_lds + (b) * SHM_K + KSWZ(32 + sr, kc)) = sr_[i].ks1;                  \
    *(bf16x8*)((char*)K_lds + (b) * SHM_K + KSWZ(rr, 256 + rc * 2)) = sr_[i].kr0; } while (0)
#define SWAIT() do { if constexpr (SDEPTH == 2) asm volatile("s_waitcnt vmcnt(5)" ::: "memory"); else asm volatile("s_waitcnt vmcnt(0)" ::: "memory"); } while (0)
#define RESC(a) do { if (__any((a) < 1.f)) { if (hi == 0) al_l[r32] = (a); asm volatile("s_waitcnt lgkmcnt(0)" ::: "memory"); \
    _Pragma("unroll") for (int d = 0; d < 4; ++d) _Pragma("unroll") for (int r = 0; r < 16; ++r) o[d][r] *= al_l[crow(r, hi)]; } } while (0)
  f32x16 pA0, pA1, pB0, pB1; float mnA, mnB, alA, alB; bf16x8 pa0, pa1, pa2, pa3; const int NT = seq / KVBLK;
  constexpr int SE = 0, SO = SDEPTH - 1;
  SLOAD(SE, 0); asm volatile("s_waitcnt vmcnt(0)" ::: "memory"); SWRITE(0, SE); __syncthreads();
  qkt(pA0, pA1, K_lds, qr, qrl, r32, hi); partialSM(pA0, pA1, m_reg, mnA, alA);
  SLOAD(SO, KVBLK); if constexpr (SDEPTH == 2) { if (2 < NT) SLOAD(SE, 2 * KVBLK); }
  SWAIT(); SWRITE(1, SO); __syncthreads();
  for (int j = 1; j + 1 < NT; j += 2) {
    SBAR(); qkt(pB0, pB1, (bf16*)((char*)K_lds + SHM_K), qr, qrl, r32, hi);
    finishSM(pA0, pA1, alA, l_reg, pa0, pa1, pa2, pa3); SBAR();
    SLOAD(SO, (j + SDEPTH) * KVBLK); SBAR();
    pv_d0(o, vb0, pa0, pa1, pa2, pa3); partialSM(pB0, pB1, m_reg, mnB, alB);
    __syncthreads(); SWAIT(); SWRITE(0, SE);
    RESC(alB); __syncthreads();
    SBAR(); qkt(pA0, pA1, K_lds, qr, qrl, r32, hi);
    finishSM(pB0, pB1, alB, l_reg, pa0, pa1, pa2, pa3); SBAR();
    if (SDEPTH == 1 || j + 3 < NT) SLOAD(SE, (j + 1 + SDEPTH) * KVBLK); SBAR();
    pv_d0(o, vb0 + (int)SHM_V, pa0, pa1, pa2, pa3); partialSM(pA0, pA1, m_reg, mnA, alA);
    __syncthreads(); SWAIT(); SWRITE(1, SO);
    RESC(alA); __syncthreads();
  }
  SBAR(); qkt(pB0, pB1, (bf16*)((char*)K_lds + SHM_K), qr, qrl, r32, hi);
  finishSM(pA0, pA1, alA, l_reg, pa0, pa1, pa2, pa3); SBAR();
  pv_d0(o, vb0, pa0, pa1, pa2, pa3); partialSM(pB0, pB1, m_reg, mnB, alB);
  __syncthreads(); RESC(alB);
  finishSM(pB0, pB1, alB, l_reg, pa0, pa1, pa2, pa3); SBAR();
  pv_d0(o, vb0 + (int)SHM_V, pa0, pa1, pa2, pa3);
  if (hi == 0) li_l[r32] = l_reg; asm volatile("s_waitcnt lgkmcnt(0)" ::: "memory");
  float rli[16];
#pragma unroll
  for (int r = 0; r < 16; ++r) rli[r] = __builtin_amdgcn_rcpf(li_l[crow(r, hi)]);
  float rs[16];
#pragma unroll
  for (int r = 0; r < 16; ++r) { float s = 0.f;
#pragma unroll
    for (int d0 = 0; d0 < 4; ++d0) { o[d0][r] *= rli[r]; s += o[d0][r] * o[d0][r]; }
    rs[r] = s; }
#pragma unroll
  for (int x = 1; x < 32; x <<= 1)
#pragma unroll
    for (int r = 0; r < 16; ++r) rs[r] += __shfl_xor(rs[r], x);
  asm volatile("s_waitcnt lgkmcnt(0)" ::: "memory");
  if (r32 == 0) {
#pragma unroll
    for (int r = 0; r < 16; ++r) al_l[crow(r, hi)] = rs[r]; }
  asm volatile("s_waitcnt lgkmcnt(0)" ::: "memory");
  if (lane < 32) __hip_atomic_store(xs + (size_t)(wid * QBLK + lane) * 4 + head, __float_as_uint(al_l[lane]), __ATOMIC_RELAXED, __HIP_MEMORY_SCOPE_AGENT);
  asm volatile("s_waitcnt vmcnt(0)" ::: "memory");
  if (lane == 0) __hip_atomic_fetch_add(cnt, 1u, __ATOMIC_RELAXED, __HIP_MEMORY_SCOPE_AGENT);
  if (wid == 0) { unsigned sp = 0;
    while ((unsigned)__builtin_amdgcn_readfirstlane(__hip_atomic_load(cnt, __ATOMIC_RELAXED, __HIP_MEMORY_SCOPE_AGENT)) < 32u) { __builtin_amdgcn_s_sleep(2); if (++sp > (1u << 22)) break; }
    __builtin_amdgcn_fence(__ATOMIC_ACQUIRE, "agent"); }
  asm volatile("s_waitcnt vmcnt(0) lgkmcnt(0)" ::: "memory"); __syncthreads();
  if (lane < 32) { const unsigned* sl = xs + (size_t)(wid * QBLK + lane) * 4; float t = 0.f;
#pragma unroll
    for (int q = 0; q < 4; ++q) t += __uint_as_float(__hip_atomic_load(sl + q, __ATOMIC_RELAXED, __HIP_MEMORY_SCOPE_AGENT));
    li_l[lane] = 1.0f / sqrtf(t * (1.0f / 512.0f) + 1e-6f); }
  asm volatile("s_waitcnt lgkmcnt(0)" ::: "memory");
  float g4[4];
#pragma unroll
  for (int d0 = 0; d0 < 4; ++d0) g4[d0] = gain[d0 * 32 + r32];
  char* Ol = lds + wid * 8704;
#pragma unroll
  for (int r = 0; r < 16; ++r) { const int orow = crow(r, hi); const float rn = li_l[orow];
#pragma unroll
    for (int d0 = 0; d0 < 4; ++d0) { const float v = o[d0][r] * rn * g4[d0]; *(bf16*)(Ol + orow * 272 + (d0 * 32 + r32) * 2) = (bf16)(cvtpk(v, v) & 0xffffu); } }
  asm volatile("s_waitcnt lgkmcnt(0)" ::: "memory");
  bf16* Ow = Ob + (long)(wid * QBLK) * LDO;
#pragma unroll
  for (int i = 0; i < 8; i += 2) { const int row = (lane >> 4) + 4 * i, c16 = lane & 15;
    const u32x4 w0 = *reinterpret_cast<const u32x4*>(Ol + row * 272 + c16 * 16), w1 = *reinterpret_cast<const u32x4*>(Ol + (row + 4) * 272 + c16 * 16);
    *reinterpret_cast<u32x4*>(Ow + (long)row * LDO + c16 * 8) = w0; *reinterpret_cast<u32x4*>(Ow + (long)(row + 4) * LDO + c16 * 8) = w1;
    asm volatile("" ::: "memory"); }
  __syncthreads();
#undef SLOAD
#undef SWRITE
#undef SWAIT
#undef RESC
}
#undef KSWZ
#undef SBAR
}

namespace ml {
using att::bf16; using att::bf16x8; using att::s16x4; using att::f32x16; using att::u32x4;
typedef float f32x4 __attribute__((ext_vector_type(4)));
using att::crow;
__device__ __forceinline__ unsigned cvtpk(float lo, float hi) { unsigned r; asm("v_cvt_pk_bf16_f32 %0, %1, %2" : "=v"(r) : "v"(lo), "v"(hi)); return r; }
 using att::ld8; using att::bf2f; using att::v_st; using att::v_rd_base; using att::v_rd_off;
constexpr int TBr = 4352, CTXr = 256, SEQr = 4096;
constexpr float LOG2E = 1.4426950408889634f;
constexpr int TSTRIDE = 32 * 17 * 256;
#define MLAS __attribute__((address_space(3)))
__device__ __forceinline__ float log_sigmoid_f(float x) {
    const float t = __expf(-fabsf(x));
    const float l1p = t < 0.03f ? t * (1.0f - t * (0.5f - t * (0.33333334f - 0.25f * t))) : __logf(1.0f + t);
    return fminf(x, 0.f) - l1p;
}
template <int OFF> __device__ __forceinline__ s16x4 trr(int vb) { s16x4 r; asm volatile("ds_read_b64_tr_b16 %0, %1 offset:%2" : "=&v"(r) : "v"(vb), "i"(OFF) : "memory"); return r; }
#define MLPK(L, H) (bf16x8){L[0], L[1], L[2], L[3], H[0], H[1], H[2], H[3]}
__device__ __forceinline__ void unit_rows(int b, int dir, int j, int& rb, int& sg) {
    if (dir == 0) { rb = b * TBr + 256 * j; sg = 1; }
    else { rb = (j == 0) ? b * TBr + 255 : b * TBr + TBr - 1 - 256 * (j - 1); sg = -1; }
}
struct Conv8 { float w0[8], w1[8], w2[8], bb[8]; };
__device__ __forceinline__ void conv8_load(Conv8& cp, const float* __restrict__ cw, const float* __restrict__ cb, int c) {
#pragma unroll
    for (int j = 0; j < 8; ++j) { cp.w0[j] = cw[c + j]; cp.w1[j] = cw[1024 + c + j]; cp.w2[j] = cw[2048 + c + j]; cp.bb[j] = cb[c + j]; }
}
__device__ __forceinline__ void conv8x8(const bf16* __restrict__ P, int r0, int sg, int sr, int c, const Conv8& cp, float scale, bf16x8 (&out)[8]) {
    bf16x8 x0[8], xm[8], xp[8]; float fm[8], fp[8];
#pragma unroll
    for (int g = 0; g < 8; ++g) { const int r = r0 + sg * (32 * g + sr); const int t = r % TBr; const bool hp = (t != 0) && (t != CTXr), hn = (t != CTXr - 1) && (t != TBr - 1);
        const bf16* p = P + (size_t)r * 2560 + 448 + c; x0[g] = ld8(p); xm[g] = ld8(hp ? p - 2560 : p); xp[g] = ld8(hn ? p + 2560 : p); fm[g] = hp ? 1.0f : 0.0f; fp[g] = hn ? 1.0f : 0.0f; }
    asm volatile("" ::: "memory");
#pragma unroll
    for (int g = 0; g < 8; ++g) { float u[8];
#pragma unroll
        for (int j = 0; j < 8; ++j) { const float a = cp.w0[j] * fm[g] * bf2f(xm[g][j]) + cp.w1[j] * bf2f(x0[g][j]) + cp.w2[j] * fp[g] * bf2f(xp[g][j]) + cp.bb[j];
            u[j] = a * __builtin_amdgcn_rcpf(1.0f + __builtin_amdgcn_exp2f(-LOG2E * a)) * scale; }
        u32x4 o = {cvtpk(u[0], u[1]), cvtpk(u[2], u[3]), cvtpk(u[4], u[5]), cvtpk(u[6], u[7])};
        out[g] = *reinterpret_cast<bf16x8*>(&o); }
}
__device__ __forceinline__ void conv_rows_load(const bf16* __restrict__ P, int R0, int c, bf16x8 (&x)[10]) {
    const int t0 = R0 % TBr; const bool hp0 = (t0 != 0) && (t0 != CTXr); const int t7 = t0 + 7; const bool hn7 = (t7 != CTXr - 1) && (t7 != TBr - 1);
    const bf16* p = P + (size_t)R0 * 2560 + 448 + c;
    x[0] = ld8(hp0 ? p - 2560 : p);
#pragma unroll
    for (int g = 0; g < 8; ++g) x[1 + g] = ld8(p + (size_t)g * 2560);
    x[9] = ld8(hn7 ? p + (size_t)8 * 2560 : p + (size_t)7 * 2560);
}
__device__ __forceinline__ void conv_rows_compute(const bf16x8 (&x)[10], int R0, const Conv8& cp, float scale, bf16x8 (&out)[8]) {
    const int t0 = R0 % TBr;
#pragma unroll
    for (int g = 0; g < 8; ++g) { const int t = t0 + g; const float fm = ((t != 0) && (t != CTXr)) ? 1.0f : 0.0f, fp = ((t != CTXr - 1) && (t != TBr - 1)) ? 1.0f : 0.0f; float u[8];
#pragma unroll
        for (int j = 0; j < 8; ++j) { const float a = cp.w0[j] * fm * bf2f(x[g][j]) + cp.w1[j] * bf2f(x[g + 1][j]) + cp.w2[j] * fp * bf2f(x[g + 2][j]) + cp.bb[j];
            u[j] = a * __builtin_amdgcn_rcpf(1.0f + __builtin_amdgcn_exp2f(-LOG2E * a)) * scale; }
        u32x4 o = {cvtpk(u[0], u[1]), cvtpk(u[2], u[3]), cvtpk(u[4], u[5]), cvtpk(u[6], u[7])};
        out[g] = *reinterpret_cast<bf16x8*>(&o); }
}
__device__ __forceinline__ void gate_scan_task(const float* __restrict__ G, const float* __restrict__ gate_b, float* __restrict__ T, float* __restrict__ sca, int task, int lane) {
    const int seq = task / 17, j = task - seq * 17, b = seq >> 3, h = (seq >> 1) & 3, dir = seq & 1;
    int rb, sg; unit_rows(b, dir, j, rb, sg);
    const int gi = (2 * dir) * 4 + h, gf = (2 * dir + 1) * 4 + h; const float ib = gate_b[gi], fb = gate_b[gf];
    float igv[4], fgv[4];
#pragma unroll
    for (int rnd = 0; rnd < 4; ++rnd) { const size_t r = (size_t)(rb + sg * (64 * rnd + lane)); igv[rnd] = G[r * 16 + gi] + ib; fgv[rnd] = G[r * 16 + gf] + fb; }
    float cb = 0.f, cpm = -3.0e38f; float* Tb = T + (size_t)task * 256;
#pragma unroll
    for (int rnd = 0; rnd < 4; ++rnd) { const int i = 64 * rnd + lane;
        float bc = log_sigmoid_f(fgv[rnd]);
#pragma unroll
        for (int o = 1; o < 64; o <<= 1) { const float t_ = __shfl_up(bc, o); if (lane >= o) bc += t_; }
        bc += cb;
        const float al = igv[rnd] - bc; float pm = al;
#pragma unroll
        for (int o = 1; o < 64; o <<= 1) { const float t_ = __shfl_up(pm, o); if (lane >= o) pm = fmaxf(pm, t_); }
        pm = fmaxf(pm, cpm);
        Tb[i] = bc; Tb[TSTRIDE + i] = al; Tb[2 * TSTRIDE + i] = pm;
        cb = __shfl(bc, 63); cpm = __shfl(pm, 63); }
    if (j < 16 && lane == 0) { sca[(seq * 16 + j) * 2] = cpm; sca[(seq * 16 + j) * 2 + 1] = cb; }
}
__device__ __forceinline__ void mlstm_local(const bf16* __restrict__ P, const float* __restrict__ T, const float* __restrict__ cw, const float* __restrict__ cbias,
                                            float* __restrict__ Cloc, float* __restrict__ nloc, int unit, char* lds) {
    int tid_ = threadIdx.x; asm volatile("" : "+v"(tid_));
    const int tid = tid_, wid = tid >> 6, lane = tid & 63, r32 = lane & 31, hi = lane >> 5;
    const int seq = unit >> 4, j = unit & 15, b = seq >> 3, h = (seq >> 1) & 3, dir = seq & 1;
    int rb, sg; unit_rows(b, dir, j, rb, sg);
    const float* Tal = T + TSTRIDE + (size_t)(seq * 17 + j) * 256; const float mlm = T[2 * TSTRIDE + (size_t)(seq * 17 + j) * 256 + 255];
    float* npart = (float*)(lds + 131072);
    const int sr = tid >> 4, sc = (tid & 15) * 8;
    float wv[8]; bf16x8 vreg[8];
#pragma unroll
    for (int g = 0; g < 8; ++g) { const int i = 32 * g + sr; wv[g] = Tal[i]; vreg[g] = ld8(P + (size_t)(rb + sg * i) * 2560 + 1472 + h * 128 + sc); }
    asm volatile("" ::: "memory");
    float nacc[8] = {0.f, 0.f, 0.f, 0.f, 0.f, 0.f, 0.f, 0.f};
    {
        const int R0 = sg > 0 ? rb + 8 * sr : rb - 8 * sr - 7;
        bf16x8 xk[10]; conv_rows_load(P, R0, 512 + h * 128 + sc, xk); float wk[8];
#pragma unroll
        for (int g = 0; g < 8; ++g) wk[g] = Tal[8 * sr + g];
        asm volatile("" ::: "memory");
        Conv8 cp; conv8_load(cp, cw, cbias, 512 + h * 128 + sc); bf16x8 kv[8]; conv_rows_compute(xk, R0, cp, 0.08838834764831845f, kv);
#pragma unroll
        for (int g = 0; g < 8; ++g) { const int i = 8 * sr + g; const bf16x8 kr = sg > 0 ? kv[g] : kv[7 - g];
            *(bf16x8*)(lds + (i >> 6) * 16384 + v_st(i & 63, sc)) = kr; const float w = __expf(wk[g] - mlm);
#pragma unroll
            for (int x = 0; x < 8; ++x) nacc[x] += w * bf2f(kr[x]); } }
#pragma unroll
    for (int g = 0; g < 8; ++g) wv[g] = __expf(wv[g] - mlm);
#pragma unroll
    for (int g = 0; g < 8; ++g) { const int i = 32 * g + sr; const float w = wv[g]; const bf16x8 v = vreg[g];
        u32x4 o = {cvtpk(bf2f(v[0]) * w, bf2f(v[1]) * w), cvtpk(bf2f(v[2]) * w, bf2f(v[3]) * w), cvtpk(bf2f(v[4]) * w, bf2f(v[5]) * w), cvtpk(bf2f(v[6]) * w, bf2f(v[7]) * w)};
        *(u32x4*)(lds + 65536 + (i >> 6) * 16384 + v_st(i & 63, sc)) = o; }
#pragma unroll
    for (int x = 0; x < 8; ++x) { nacc[x] += __shfl_xor(nacc[x], 16); nacc[x] += __shfl_xor(nacc[x], 32); }
    if (lane < 16) {
#pragma unroll
        for (int x = 0; x < 8; ++x) npart[wid * 128 + sc + x] = nacc[x]; }
    __syncthreads();
    const int db = wid >> 1, eb0 = 2 * (wid & 1);
    const int vbK = (int)(uintptr_t)lds + v_rd_base(lane) + db * 512, vbV = (int)(uintptr_t)lds + 65536 + v_rd_base(lane) + eb0 * 512;
    f32x16 c0 = {}, c1 = {};
#define MLA_STEP(TL, KS) do { const s16x4 al_ = trr<(TL) * 16384 + v_rd_off(0, KS, 0)>(vbK), ah_ = trr<(TL) * 16384 + v_rd_off(0, KS, 1)>(vbK); \
        const s16x4 bl0 = trr<(TL) * 16384 + v_rd_off(0, KS, 0)>(vbV), bh0 = trr<(TL) * 16384 + v_rd_off(0, KS, 1)>(vbV), bl1 = trr<(TL) * 16384 + v_rd_off(1, KS, 0)>(vbV), bh1 = trr<(TL) * 16384 + v_rd_off(1, KS, 1)>(vbV); \
        asm volatile("s_waitcnt lgkmcnt(0)" ::: "memory"); __builtin_amdgcn_sched_barrier(0); \
        c0 = __builtin_amdgcn_mfma_f32_32x32x16_bf16(MLPK(al_, ah_), MLPK(bl0, bh0), c0, 0, 0, 0); c1 = __builtin_amdgcn_mfma_f32_32x32x16_bf16(MLPK(al_, ah_), MLPK(bl1, bh1), c1, 0, 0, 0); } while (0)
#define MLA_TILE(TL) do { MLA_STEP(TL, 0); MLA_STEP(TL, 1); MLA_STEP(TL, 2); MLA_STEP(TL, 3); } while (0)
    MLA_TILE(0); MLA_TILE(1); MLA_TILE(2); MLA_TILE(3);
#undef MLA_TILE
#undef MLA_STEP
    float* Co = Cloc + (size_t)unit * 16384;
#pragma unroll
    for (int r = 0; r < 16; ++r) { const int d = db * 32 + crow(r, hi); Co[d * 128 + eb0 * 32 + r32] = c0[r]; Co[d * 128 + eb0 * 32 + 32 + r32] = c1[r]; }
    if (tid < 128) { float s = 0.f;
#pragma unroll
        for (int w = 0; w < 8; ++w) s += npart[w * 128 + tid];
        nloc[unit * 128 + tid] = s; }
    __syncthreads();
}
__device__ __forceinline__ void mlstm_scan(const float* __restrict__ Cloc, const float* __restrict__ nloc, const float* __restrict__ sca, bf16* __restrict__ CstT, float* __restrict__ nst, float* __restrict__ bm, int gtid, int gthreads) {
    for (int item = gtid; item < 32 * 2048; item += gthreads) {
        const int seq = item >> 11, rem = item & 2047, e = rem & 127, dg = rem >> 7;
        float st[8] = {0.f, 0.f, 0.f, 0.f, 0.f, 0.f, 0.f, 0.f}; float nv = 0.f, Bst = 0.f, Mst = 0.f;
        asm volatile("" : "+v"(Bst), "+v"(Mst));
        const float* Cl0 = Cloc + (size_t)(seq * 16) * 16384 + (dg * 8) * 128 + e;
        for (int half = 0; half < 2; ++half) {
            float cl[8][8], nlv[8], mlv[8], blv[8];
#pragma unroll
            for (int jj = 0; jj < 8; ++jj) { const int lu = seq * 16 + half * 8 + jj;
#pragma unroll
                for (int i = 0; i < 8; ++i) cl[jj][i] = Cl0[(size_t)(half * 8 + jj) * 16384 + i * 128];
                nlv[jj] = nloc[lu * 128 + e]; mlv[jj] = sca[lu * 2]; blv[jj] = sca[lu * 2 + 1]; }
#pragma unroll
            for (int jj = 0; jj < 8; ++jj) { const int j = half * 8 + jj; const size_t su = (size_t)seq * 17 + j;
                u32x4 o = {cvtpk(st[0], st[1]), cvtpk(st[2], st[3]), cvtpk(st[4], st[5]), cvtpk(st[6], st[7])};
                *(u32x4*)(CstT + su * 16384 + e * 128 + dg * 8) = o;
                if (dg == 0) { nst[su * 128 + e] = nv; if (e == 0) { bm[su * 2] = Bst; bm[su * 2 + 1] = Mst; } }
                const float Mend = fmaxf(Mst, mlv[jj] - Bst), fa = __expf(Mst - Mend), fbv = __expf(mlv[jj] - Bst - Mend);
#pragma unroll
                for (int i = 0; i < 8; ++i) st[i] = fa * st[i] + fbv * cl[jj][i];
                nv = fa * nv + fbv * nlv[jj];
                Bst += blv[jj]; Mst = Mend; }
        }
        { const size_t su = (size_t)seq * 17 + 16;
          u32x4 o = {cvtpk(st[0], st[1]), cvtpk(st[2], st[3]), cvtpk(st[4], st[5]), cvtpk(st[6], st[7])};
          *(u32x4*)(CstT + su * 16384 + e * 128 + dg * 8) = o;
          if (dg == 0) { nst[su * 128 + e] = nv; if (e == 0) { bm[su * 2] = Bst; bm[su * 2 + 1] = Mst; } } }
    }
}
#define KSW(row, colB) ((row) * 256 + ((colB) ^ (((row) & 15) << 4)))
template <int D0, int KS> __device__ __forceinline__ void pv_pair(f32x16& od, int vb, bf16x8 pa, bf16x8 pb) {
    const s16x4 l0 = trr<v_rd_off(D0, KS, 0)>(vb), h0 = trr<v_rd_off(D0, KS, 1)>(vb), l1 = trr<v_rd_off(D0, KS + 1, 0)>(vb), h1 = trr<v_rd_off(D0, KS + 1, 1)>(vb);
    asm volatile("s_waitcnt lgkmcnt(0)" ::: "memory"); __builtin_amdgcn_sched_barrier(0);
    od = __builtin_amdgcn_mfma_f32_32x32x16_bf16(pa, MLPK(l0, h0), od, 0, 0, 0);
    od = __builtin_amdgcn_mfma_f32_32x32x16_bf16(pb, MLPK(l1, h1), od, 0, 0, 0);
}
__device__ __forceinline__ void mlstm_out2(const bf16* __restrict__ P, const float* __restrict__ T, const float* __restrict__ cw, const float* __restrict__ cbias, const bf16* __restrict__ CstT, const float* __restrict__ nst,
                                           const float* __restrict__ bm, const float* __restrict__ mnorm, bf16* __restrict__ MIX, int b, int h, int tb, char* lds) {
    int tid_ = threadIdx.x; asm volatile("" : "+v"(tid_));
    const int tid = tid_, wid = tid >> 6, lane = tid & 63, r32 = lane & 31, hi = lane >> 5;
    const int seqf = b * 8 + h * 2, seqb = seqf + 1; const int jb = tb == 0 ? 0 : 17 - tb; const bool zs = (tb == 0);
    const size_t suf = (size_t)seqf * 17 + tb, sub = (size_t)seqb * 17 + jb;
    const int rb = b * TBr + 256 * tb;
    float* tabs = (float*)(lds + 131072);
    float* nlf = tabs + 2048; float* nlb = tabs + 2176; float* wsc = tabs + 2304 + wid * 32;
    const int sr = tid >> 4, sc = (tid & 15) * 8;
    {
        bf16x8 xk[10], xq[10]; conv_rows_load(P, rb + 8 * sr, 512 + h * 128 + sc, xk); conv_rows_load(P, rb + 8 * sr, h * 128 + sc, xq);
        asm volatile("" ::: "memory");
        { Conv8 cp; conv8_load(cp, cw, cbias, 512 + h * 128 + sc); bf16x8 kv[8]; conv_rows_compute(xk, rb + 8 * sr, cp, 0.08838834764831845f, kv);
#pragma unroll
          for (int g = 0; g < 8; ++g) { const int i = 8 * sr + g; *(bf16x8*)(lds + KSW(i, sc * 2)) = kv[g]; } }
        { Conv8 cp; conv8_load(cp, cw, cbias, h * 128 + sc); bf16x8 qv[8]; conv_rows_compute(xq, rb + 8 * sr, cp, 1.0f, qv);
#pragma unroll
          for (int g = 0; g < 8; ++g) { const int i = 8 * sr + g; *(bf16x8*)(lds + 65536 + KSW(i, sc * 2)) = qv[g]; } } }
    bf16x8 vreg[8];
#pragma unroll
    for (int g = 0; g < 8; ++g) vreg[g] = ld8(P + (size_t)(rb + 32 * g + sr) * 2560 + 1472 + h * 128 + sc);
    asm volatile("" ::: "memory");
    {
        const int dir = tid >> 8, n = tid & 255; const size_t su = dir ? sub : suf; const size_t ti = su * 256 + (dir ? 255 - n : n);
        const float bl = T[ti], al = T[TSTRIDE + ti], pm = T[2 * TSTRIDE + ti]; float Bst = 0.f, Mst = 0.f; if (!zs) { Bst = bm[su * 2]; Mst = bm[su * 2 + 1]; }
        float* tb_ = tabs + dir * 1024; const float M = fmaxf(Mst, pm - Bst);
        tb_[n] = __expf(-(Bst + bl + M)); tb_[256 + n] = (al - Bst) * LOG2E; tb_[512 + n] = M * LOG2E; tb_[768 + n] = __expf(Mst - M); }
    if (wid == 2) { nlf[lane] = zs ? 0.f : nst[suf * 128 + lane]; nlf[64 + lane] = zs ? 0.f : nst[suf * 128 + 64 + lane]; }
    if (wid == 3) { nlb[lane] = zs ? 0.f : nst[sub * 128 + lane]; nlb[64 + lane] = zs ? 0.f : nst[sub * 128 + 64 + lane]; }
    __syncthreads();
    bf16x8 qr[8];
#pragma unroll
    for (int d0 = 0; d0 < 8; ++d0) qr[d0] = *reinterpret_cast<const bf16x8*>(lds + 65536 + KSW(wid * 32 + r32, (d0 * 16 + hi * 8) * 2));
    asm volatile("s_waitcnt lgkmcnt(0)" ::: "memory");
    __syncthreads();
#pragma unroll
    for (int g = 0; g < 8; ++g) { const int i = 32 * g + sr; *(bf16x8*)(lds + 65536 + (i >> 6) * 16384 + v_st(i & 63, sc)) = vreg[g]; }
    __syncthreads();
    const int qi = wid * 32 + r32;
    float qnf = 0.f, qnb = 0.f;
#pragma unroll
    for (int d0 = 0; d0 < 8; ++d0) {
#pragma unroll
        for (int jj = 0; jj < 8; ++jj) { const float qv = bf2f(qr[d0][jj]); qnf += qv * nlf[d0 * 16 + hi * 8 + jj]; qnb += qv * nlb[d0 * 16 + hi * 8 + jj]; }
        asm volatile("" : "+v"(qnf), "+v"(qnb)); }
    { auto rr = __builtin_amdgcn_permlane32_swap(__float_as_uint(qnf), __float_as_uint(qnf), false, false); qnf = __uint_as_float(rr[0]) + __uint_as_float(rr[1]); }
    { auto rr = __builtin_amdgcn_permlane32_swap(__float_as_uint(qnb), __float_as_uint(qnb), false, false); qnb = __uint_as_float(rr[0]) + __uint_as_float(rr[1]); }
    const int vb0 = (int)(uintptr_t)lds + 65536 + v_rd_base(lane);
    const int dtile = wid >> 1;
    unsigned hfp[32];
#define ML_PK4(Pv, BASE, OUT) do { unsigned a0 = cvtpk(Pv[BASE + 0], Pv[BASE + 1]), a1 = cvtpk(Pv[BASE + 2], Pv[BASE + 3]);   \
    unsigned b0_ = cvtpk(Pv[BASE + 4], Pv[BASE + 5]), b1_ = cvtpk(Pv[BASE + 6], Pv[BASE + 7]);                              \
    auto r0 = __builtin_amdgcn_permlane32_swap(a0, b0_, false, false); auto r1 = __builtin_amdgcn_permlane32_swap(a1, b1_, false, false); \
    u32x4 w = {r0[0], r1[0], r0[1], r1[1]}; OUT = *reinterpret_cast<bf16x8*>(&w); } while (0)
#pragma unroll
    for (int dir = 0; dir < 2; ++dir) {
        const float* tb_ = tabs + dir * 1024; const size_t su = dir ? sub : suf;
        f32x16 o[4];
        if (zs) { o[0] = f32x16{}; o[1] = f32x16{}; o[2] = f32x16{}; o[3] = f32x16{}; }
        else { const bf16* Cb = CstT + su * 16384 + (size_t)r32 * 128 + hi * 8;
#pragma unroll
          for (int ep = 0; ep < 2; ++ep) { bf16x8 cf[16];
#pragma unroll
              for (int x = 0; x < 16; ++x) cf[x] = ld8(Cb + (2 * ep + (x >> 3)) * 32 * 128 + (x & 7) * 16);
              f32x16 a0 = {}, a1 = {};
#pragma unroll
              for (int d0 = 0; d0 < 8; ++d0) { a0 = __builtin_amdgcn_mfma_f32_32x32x16_bf16(qr[d0], cf[d0], a0, 0, 0, 0); a1 = __builtin_amdgcn_mfma_f32_32x32x16_bf16(qr[d0], cf[8 + d0], a1, 0, 0, 0); }
              o[2 * ep] = a0; o[2 * ep + 1] = a1; }
#pragma unroll
          for (int r = 0; r < 16; ++r) { const float isc = tb_[768 + wid * 32 + crow(r, hi)];
#pragma unroll
              for (int eb = 0; eb < 4; ++eb) o[eb][r] *= isc; } }
        const float qn = dir ? qnb : qnf;
        const float m2q = tb_[512 + qi]; float dsum = 0.f;
        const int kt0 = dir ? dtile : 0, kt1 = dir ? 4 : dtile + 1;
        for (int kt = kt0; kt < kt1; ++kt) {
            const char* Ks = lds + kt * 64 * 256; const bool diag = (kt == dtile); const int vb = vb0 + kt * 16384;
#pragma unroll
            for (int hh = 0; hh < 2; ++hh) {
                f32x16 p = {}, p2 = {};
#pragma unroll
                for (int d0 = 0; d0 < 8; d0 += 2) { const int cb = (d0 * 16 + hi * 8) * 2;
                    const bf16x8 b0 = *reinterpret_cast<const bf16x8*>(Ks + KSW(32 * hh + r32, cb)), b1 = *reinterpret_cast<const bf16x8*>(Ks + KSW(32 * hh + r32, cb + 32));
                    p = __builtin_amdgcn_mfma_f32_32x32x16_bf16(b0, qr[d0], p, 0, 0, 0); p2 = __builtin_amdgcn_mfma_f32_32x32x16_bf16(b1, qr[d0 + 1], p2, 0, 0, 0); }
                p += p2;
#pragma unroll
                for (int g4 = 0; g4 < 4; ++g4) { const int sb = kt * 64 + 32 * hh + 8 * g4 + 4 * hi;
                    const f32x4 a4 = *(const f32x4*)(tb_ + 256 + sb);
#pragma unroll
                    for (int x = 0; x < 4; ++x) { const int r = 4 * g4 + x, s0 = sb + x;
                        float w0 = __builtin_amdgcn_exp2f(a4[x] - m2q);
                        if (diag) { if (dir ? (s0 < qi) : (s0 > qi)) w0 = 0.f; }
                        p[r] *= w0; dsum += p[r]; } }
                bf16x8 pa, pb;
                ML_PK4(p, 0, pa); ML_PK4(p, 8, pb);
                if (hh == 0) { pv_pair<0, 0>(o[0], vb, pa, pb); pv_pair<1, 0>(o[1], vb, pa, pb); pv_pair<2, 0>(o[2], vb, pa, pb); pv_pair<3, 0>(o[3], vb, pa, pb); }
                else         { pv_pair<0, 2>(o[0], vb, pa, pb); pv_pair<1, 2>(o[1], vb, pa, pb); pv_pair<2, 2>(o[2], vb, pa, pb); pv_pair<3, 2>(o[3], vb, pa, pb); }
            }
        }
        { auto rr = __builtin_amdgcn_permlane32_swap(__float_as_uint(dsum), __float_as_uint(dsum), false, false); dsum = __uint_as_float(rr[0]) + __uint_as_float(rr[1]); }
        const float den = dsum + tb_[768 + qi] * qn; const float rd = 1.0f / fmaxf(fabsf(den), tb_[qi]);
        if (hi == 0) wsc[r32] = rd; asm volatile("s_waitcnt lgkmcnt(0)" ::: "memory");
        if (dir == 0) {
#pragma unroll
            for (int r = 0; r < 16; r += 2) { const float ra = wsc[crow(r, hi)], rb_ = wsc[crow(r + 1, hi)];
#pragma unroll
                for (int eb = 0; eb < 4; ++eb) hfp[eb * 8 + (r >> 1)] = cvtpk(o[eb][r] * ra, o[eb][r + 1] * rb_); }
            asm volatile("s_waitcnt lgkmcnt(0)" ::: "memory");
        } else {
            float rdr[16];
#pragma unroll
            for (int r = 0; r < 16; ++r) rdr[r] = wsc[crow(r, hi)];
            bf16x8 og8[8];
            { const bf16* ogp = P + (size_t)(rb + wid * 32 + r32) * 2560 + 1984 + h * 128 + 64 * hi;
#pragma unroll
              for (int c8 = 0; c8 < 8; ++c8) og8[c8] = ld8(ogp + 8 * c8); }
            __syncthreads();
            float* W = (float*)(lds + wid * 16896);
#pragma unroll
            for (int r = 0; r < 16; ++r)
#pragma unroll
                for (int eb = 0; eb < 4; ++eb) { const unsigned pk = hfp[eb * 8 + (r >> 1)]; const float hf = (r & 1) ? __uint_as_float(pk & 0xffff0000u) : __uint_as_float(pk << 16);
                    W[crow(r, hi) * 132 + eb * 32 + r32] = hf + o[eb][r] * rdr[r]; }
            asm volatile("s_waitcnt lgkmcnt(0)" ::: "memory");
            const int tok = r32, eh = hi; const size_t row = (size_t)(rb + wid * 32 + tok);
            const float* mg = mnorm + h * 128 + 64 * eh;
            float v[64]; float s = 0.f;
#pragma unroll
            for (int c8 = 0; c8 < 8; ++c8) { const bf16x8 g8 = og8[c8]; const f32x4 w0 = *(const f32x4*)(W + tok * 132 + 64 * eh + 8 * c8), w1 = *(const f32x4*)(W + tok * 132 + 64 * eh + 8 * c8 + 4);
                const float hv[8] = {w0.x, w0.y, w0.z, w0.w, w1.x, w1.y, w1.z, w1.w};
#pragma unroll
                for (int x = 0; x < 8; ++x) { const float vv = hv[x] * __builtin_amdgcn_rcpf(1.0f + __builtin_amdgcn_exp2f(-LOG2E * bf2f(g8[x]))); v[8 * c8 + x] = vv; s += vv; } }
            { auto rr = __builtin_amdgcn_permlane32_swap(__float_as_uint(s), __float_as_uint(s), false, false); s = __uint_as_float(rr[0]) + __uint_as_float(rr[1]); }
            const float mu = s * (1.0f / 128.0f); float q = 0.f;
#pragma unroll
            for (int x = 0; x < 64; ++x) { v[x] -= mu; q += v[x] * v[x]; }
            { auto rr = __builtin_amdgcn_permlane32_swap(__float_as_uint(q), __float_as_uint(q), false, false); q = __uint_as_float(rr[0]) + __uint_as_float(rr[1]); }
            const float rstd = 1.0f / sqrtf(q * (1.0f / 128.0f) + 1e-6f);
            bf16* orow = MIX + row * 1024 + 512 + h * 128 + 64 * eh;
#pragma unroll
            for (int c8 = 0; c8 < 8; ++c8) { const f32x4 g0 = *(const f32x4*)(mg + 8 * c8), g1 = *(const f32x4*)(mg + 8 * c8 + 4);
                u32x4 ov = {cvtpk(v[8 * c8] * rstd * g0.x, v[8 * c8 + 1] * rstd * g0.y), cvtpk(v[8 * c8 + 2] * rstd * g0.z, v[8 * c8 + 3] * rstd * g0.w),
                            cvtpk(v[8 * c8 + 4] * rstd * g1.x, v[8 * c8 + 5] * rstd * g1.y), cvtpk(v[8 * c8 + 6] * rstd * g1.z, v[8 * c8 + 7] * rstd * g1.w)};
                *(u32x4*)(orow + 8 * c8) = ov; }
        }
    }
#undef ML_PK4
    __syncthreads();
}
#undef KSW
#undef MLPK
#undef MLAS
}

#define LAS __attribute__((address_space(3)))
typedef unsigned short bf16;
typedef float f32x4 __attribute__((ext_vector_type(4)));
typedef unsigned u32x4 __attribute__((ext_vector_type(4)));
typedef unsigned u32x2 __attribute__((ext_vector_type(2)));
typedef short bf16x8 __attribute__((ext_vector_type(8)));
constexpr int NWAVES = 8, NTHREADS = 512;
constexpr int DM = 1024, NB = 4, SEQ = 4096, CTXL = 256, TB = SEQ + CTXL  , R = NB * TB  ;
constexpr int DFF = 2752, DFFP = 2816, NW1 = 2 * DFFP  , DIN = 2512, DINP = 2560, KUP = 384, NUP = 1792;
constexpr int NMOD = 9;
constexpr float EPS = 1e-6f;
constexpr size_t MiB = 1u << 20;
constexpr size_t WS_CTL = 0, CTL_BYTES = 1 * MiB;
constexpr size_t WS_MOD = 1 * MiB;
constexpr size_t WS_TAB = WS_MOD + 512 * 1024;
constexpr size_t WS_W1 = 2 * MiB;
constexpr size_t WS_W2 = WS_W1 + (size_t)2 * NW1 * DM * 2;
constexpr size_t WS_WIN = WS_W2 + (size_t)2 * DM * DFFP * 2;
constexpr size_t WS_WUP = WS_WIN + (size_t)DINP * DM * 2;
constexpr size_t WS_WOUT = WS_WUP + (size_t)NUP * KUP * 2;
constexpr size_t WS_XC = WS_WOUT + (size_t)DM * DM * 2;
constexpr size_t WS_H = WS_XC + (size_t)NB * CTXL * DM * 4;
constexpr size_t WS_BIG = WS_H + (size_t)R * DM * 2;
constexpr size_t BIG_KR = (size_t)R * DINP * 2;
constexpr size_t BIG_G = BIG_KR + (size_t)R * 64 * 2;
constexpr size_t WS_Y = WS_BIG + (size_t)R * DFFP * 2;
constexpr size_t WS_Q = WS_Y + (size_t)R * DM * 2;
constexpr size_t WS_AUP = WS_Q + (size_t)R * 768 * 2;
constexpr size_t WS_HF = WS_AUP + (size_t)R * 512 * 2;
constexpr size_t WS_HB = WS_HF + (size_t)R * 512 * 2;
constexpr size_t WS_MS = WS_HB + (size_t)R * 512 * 2;
constexpr size_t MS_NLOC = 0, MS_SCA = 262144, MS_NST = 266240, MS_BM = 544768;
constexpr size_t MS_X1 = 3u << 20, MS_X2 = (3u << 20) + (512u << 10);
constexpr size_t MS_T = 1u << 20;
constexpr size_t WS_END = WS_MS + 4 * MiB;
static_assert(BIG_G + (size_t)R * 16 * 4 <= (size_t)R * DFFP * 2, "P + KR + G fit the hidden region");
static_assert(WS_W1 % 256 == 0 && WS_W2 % 256 == 0 && WS_WIN % 256 == 0 && WS_WUP % 256 == 0 && WS_WOUT % 256 == 0 && WS_XC % 256 == 0 && WS_H % 256 == 0 && WS_BIG % 256 == 0 && WS_Y % 256 == 0 && WS_Q % 256 == 0 && WS_AUP % 256 == 0 && WS_HF % 256 == 0, "alignment");
static_assert(WS_END <= 305u * MiB, "workspace budget");
constexpr int LDS_BYTES = 147456, LDS_MISC = 143360;

#define LDS_WAIT() asm volatile("s_waitcnt lgkmcnt(0)" ::: "memory")
__device__ __forceinline__ unsigned f2bf(float f) { unsigned u = __builtin_bit_cast(unsigned, f); return (u + 0x7fffu + ((u >> 16) & 1u)) >> 16; }
__device__ __forceinline__ unsigned pk2(float lo, float hi) { return f2bf(lo) | (f2bf(hi) << 16); }
__device__ __forceinline__ float bflo(unsigned w) { return __uint_as_float(w << 16); }
__device__ __forceinline__ float bfhi(unsigned w) { return __uint_as_float(w & 0xffff0000u); }
__device__ __forceinline__ float bf1(bf16 b) { return __uint_as_float(((unsigned)b) << 16); }
__device__ __forceinline__ float wave_sum(float v) {
#pragma unroll
    for (int o = 1; o < 64; o <<= 1) v += __shfl_xor(v, o);
    return v;
}
__device__ __forceinline__ float sigmoid_f(float x) { return __builtin_amdgcn_rcpf(1.0f + __builtin_amdgcn_exp2f(-1.4426950408889634f * x)); }
__device__ __forceinline__ float silu1(float x) { return x * sigmoid_f(x); }

struct Args { const float* in[22]; float* out; unsigned char* ws; int ph_lo, ph_hi; };
struct ArgsV { const Args* p; int z;
    __device__ __forceinline__ const float* in(int i) const { return p->in[i + z]; }
    __device__ __forceinline__ float* out() const { return (float*)p->in[22 + z]; }
    __device__ __forceinline__ unsigned char* ws() const { return (unsigned char*)p->in[23 + z]; } };
enum { I_X = 0, I_C, I_CTX, I_CCTX, I_WMOD, I_BMOD, I_NPRE, I_NPOST, I_WG, I_WU, I_WD, I_WIN, I_QN, I_WUQ, I_KVN, I_WUKV, I_AON, I_CW, I_CB, I_GB, I_MN, I_WOUT };

__device__ __forceinline__ const float* xin_row(const ArgsV& a, int r) { const int b = r / TB, t = r - b * TB; return t < CTXL ? a.in(I_CTX) + (size_t)(b * CTXL + t) * DM : a.in(I_X) + (size_t)(b * SEQ + t - CTXL) * DM; }
__device__ __forceinline__ float* xres_row(const ArgsV& a, int r) { const int b = r / TB, t = r - b * TB; return t < CTXL ? (float*)(a.ws() + WS_XC) + (size_t)(b * CTXL + t) * DM : a.out() + (size_t)(b * SEQ + t - CTXL) * DM; }
__device__ __forceinline__ const float* mod_vec(const ArgsV& a, int l, int r, int j) { const int b = r / TB, t = r - b * TB; const int bb = t < CTXL ? 4 : b; return (const float*)(a.ws() + WS_MOD) + (size_t)((l * 5 + bb) * NMOD + j) * DM; }

__device__ __forceinline__ void cvt_item(const float* src, int srcN, int k0, int c0, int ncv, bf16* dst, int dstK, int drow0, int dk0, LAS float* scr, int lane) {
    const int n4 = (lane & 15) * 4, kr = lane >> 4;
    f32x4 v[16];
    const bool ok = n4 < ncv;
    const float* sp = src + (size_t)(k0 + kr) * srcN + c0 + n4;
#pragma unroll
    for (int i = 0; i < 16; ++i) { v[i] = (f32x4){0.f, 0.f, 0.f, 0.f}; if (ok) v[i] = *(const f32x4*)(sp + (size_t)(4 * i) * srcN); }
#pragma unroll
    for (int i = 0; i < 16; ++i) { const int k = 4 * i + kr; *(LAS f32x4*)(scr + k * 68 + ((n4 + 8 * (k >> 3)) & 63)) = v[i]; }
    LDS_WAIT(); asm volatile("" ::: "memory");
    const int c = lane & 7;
#pragma unroll
    for (int j = 0; j < 8; ++j) { const int n = (lane >> 3) + 8 * j; const LAS float* s = scr + (8 * c) * 68 + ((n + 8 * c) & 63);
        u32x4 o; o.x = pk2(s[0 * 68], s[1 * 68]); o.y = pk2(s[2 * 68], s[3 * 68]); o.z = pk2(s[4 * 68], s[5 * 68]); o.w = pk2(s[6 * 68], s[7 * 68]);
        *(u32x4*)(dst + (size_t)(drow0 + n) * dstK + dk0 + 8 * c) = o; }
    LDS_WAIT(); asm volatile("" ::: "memory");
}
__device__ __forceinline__ void wconv_layer(const ArgsV& a, int l, LAS unsigned char* lds, int bid, int nbl, int wave, int lane, int parts) {
    LAS float* scr = (LAS float*)(lds + wave * 17408);
    const int gw = bid * NWAVES + wave, NGW = nbl * NWAVES;
    constexpr int I_1 = 88 * 16, I_2 = 16 * 44, I_IN = 40 * 16, I_UP = 28 * 6, I_OUT = 16 * 16;
    constexpr int NITEMS = 2 * I_1 + 2 * I_2 + I_IN + I_UP + I_OUT;
    bf16* W1 = (bf16*)(a.ws() + WS_W1); bf16* W2 = (bf16*)(a.ws() + WS_W2); bf16* WIN = (bf16*)(a.ws() + WS_WIN); bf16* WUP = (bf16*)(a.ws() + WS_WUP); bf16* WOUT = (bf16*)(a.ws() + WS_WOUT);
    for (int it = gw; it < NITEMS; it += NGW) {
        int r = it;
        { int pbit; if (it < 2 * I_1) pbit = (it / I_1 == 0) ? 1 : 2; else if (it < 2 * I_1 + 2 * I_2) pbit = ((it - 2 * I_1) / I_2 == 0) ? 1 : 2; else if (it < 2 * I_1 + 2 * I_2 + I_IN + I_UP) pbit = 1; else pbit = 2;
          if (!(parts & pbit)) continue; }
        if (r < 2 * I_1) { const int j = r / I_1; r -= j * I_1; const int g = r / 16, kb = r % 16; const int row0 = 64 * g, pn = row0 >> 8, i = row0 & 255; const int hc = 128 * pn + (i & 127);
            const float* src = (i < 128 ? a.in(I_WG) : a.in(I_WU)) + (size_t)(l * 2 + j) * DM * DFF;
            cvt_item(src, DFF, 64 * kb, hc < DFF ? hc : 0, hc < DFF ? 64 : 0, W1 + (size_t)j * NW1 * DM, DM, row0, 64 * kb, scr, lane); continue; }
        r -= 2 * I_1;
        if (r < 2 * I_2) { const int j = r / I_2; r -= j * I_2; const int g = r / 44, kb = r % 44;
            const float* src = a.in(I_WD) + (size_t)(l * 2 + j) * DFF * DM;
            cvt_item(src, DM, kb < 43 ? 64 * kb : 0, 64 * g, kb < 43 ? 64 : 0, W2 + (size_t)j * DM * DFFP, DFFP, 64 * g, 64 * kb, scr, lane); continue; }
        r -= 2 * I_2;
        if (r < I_IN) { const int g = r / 16, kb = r % 16; int ncv = DIN - 64 * g; ncv = ncv < 0 ? 0 : (ncv > 64 ? 64 : ncv);
            cvt_item(a.in(I_WIN) + (size_t)l * DM * DIN, DIN, 64 * kb, ncv > 0 ? 64 * g : 0, ncv, WIN, DM, 64 * g, 64 * kb, scr, lane); continue; }
        r -= I_IN;
        if (r < I_UP) { const int g = r / 6, kb = r % 6;
            if (g < 12) cvt_item(a.in(I_WUQ) + (size_t)l * 256 * 768, 768, kb < 4 ? 64 * kb : 0, 64 * g, kb < 4 ? 64 : 0, WUP, KUP, 64 * g, 64 * kb, scr, lane);
            else cvt_item(a.in(I_WUKV) + (size_t)l * 128 * 1024, 1024, kb >= 4 ? 64 * (kb - 4) : 0, 64 * (g - 12), kb >= 4 ? 64 : 0, WUP, KUP, 64 * g, 64 * kb, scr, lane);
            continue; }
        r -= I_UP;
        { const int g = r / 16, kb = r % 16; cvt_item(a.in(I_WOUT) + (size_t)l * DM * DM, DM, 64 * kb, 64 * g, 64, WOUT, DM, 64 * g, 64 * kb, scr, lane); }
    }
}
__device__ __forceinline__ void mod_phase(const ArgsV& a, LAS unsigned char* lds, int bid, int nbl, int tid, int wave, int lane) {
    LAS float* sv = (LAS float*)(lds);
    LAS float* red = (LAS float*)(lds + 20480);
    for (int i = tid; i < 5 * DM; i += NTHREADS) { const float v = i < 4 * DM ? a.in(I_C)[i] : a.in(I_CCTX)[i - 4 * DM]; sv[i] = silu1(v); }
    __syncthreads();
    float* mod = (float*)(a.ws() + WS_MOD);
    for (int u = bid; u < 256; u += nbl) {
        const int l = u >> 7, cb = (u & 127) * 72; const bool act = lane < 18;
        const float* W = a.in(I_WMOD) + (size_t)l * DM * (NMOD * DM) + cb + 4 * (act ? lane : 0);
        f32x4 acc[5];
#pragma unroll
        for (int bb = 0; bb < 5; ++bb) acc[bb] = (f32x4){0.f, 0.f, 0.f, 0.f};
        for (int k0 = wave * 128; k0 < wave * 128 + 128; k0 += 32) { f32x4 w[32];
#pragma unroll
            for (int i = 0; i < 32; ++i) w[i] = *(const f32x4*)(W + (size_t)(k0 + i) * (NMOD * DM));
#pragma unroll
            for (int i = 0; i < 32; ++i)
#pragma unroll
                for (int bb = 0; bb < 5; ++bb) acc[bb] += w[i] * sv[bb * DM + k0 + i]; }
        if (act) {
#pragma unroll
            for (int bb = 0; bb < 5; ++bb) *(LAS f32x4*)(red + (wave * 5 + bb) * 72 + 4 * lane) = acc[bb]; }
        __syncthreads();
        for (int i = tid; i < 5 * 72; i += NTHREADS) { const int bb = i / 72, cc = i % 72; float s = 0.f;
#pragma unroll
            for (int w = 0; w < 8; ++w) s += red[(w * 5 + bb) * 72 + cc];
            mod[(size_t)(l * 5 + bb) * (NMOD * DM) + cb + cc] = s + a.in(I_BMOD)[(size_t)l * NMOD * DM + cb + cc]; }
        __syncthreads();
    }
    if (bid == nbl - 1 && tid < 64) {
        constexpr float inv[16] = {1.0f, 0.5623413251903491f, 0.31622776601683794f, 0.1778279410038923f, 0.1f, 0.05623413251903491f, 0.03162277660168379f, 0.01778279410038923f,
                                   0.01f, 0.005623413251903491f, 0.0031622776601683794f, 0.001778279410038923f, 0.001f, 0.0005623413251903491f, 0.00031622776601683794f, 0.0001778279410038923f};
        float* tab = (float*)(a.ws() + WS_TAB);
#pragma unroll
        for (int f = 0; f < 16; ++f) {
            const float ang = (float)tid * inv[f];
            const double ad = (double)ang; const double kq = __builtin_rint(ad * 0.63661977236758134308); const double rd = ad - kq * 1.57079632679489661923;
            const float x = (float)rd, x2 = x * x; const int q = ((int)kq) & 3;
            const float sp = x + x * x2 * (-1.6666654611e-1f + x2 * (8.3321608736e-3f + x2 * (-1.9515295891e-4f)));
            const float cp = 1.0f - 0.5f * x2 + x2 * x2 * (4.166664568298827e-2f + x2 * (-1.388731625493765e-3f + x2 * 2.443315711809948e-5f));
            const float sn = (q == 0) ? sp : (q == 1) ? cp : (q == 2) ? -sp : -cp;
            const float cs = (q == 0) ? cp : (q == 1) ? -sp : (q == 2) ? -cp : sp;
            tab[(tid * 16 + f) * 2] = cs; tab[(tid * 16 + f) * 2 + 1] = sn; }
    }
    __syncthreads();
}

__device__ __forceinline__ void rw_pre(const f32x4 (&x)[4], const float* g, const float* sc, const float* sh, bf16* hrow, int lane) {
    float ss = 0.f;
#pragma unroll
    for (int j = 0; j < 4; ++j) ss += (x[j].x * x[j].x + x[j].y * x[j].y) + (x[j].z * x[j].z + x[j].w * x[j].w);
    const float rstd = 1.0f / sqrtf(wave_sum(ss) * (1.0f / DM) + EPS);
#pragma unroll
    for (int j = 0; j < 4; ++j) { const int c = 256 * j + 4 * lane; const f32x4 gv = *(const f32x4*)(g + c), sv = *(const f32x4*)(sc + c), hv = *(const f32x4*)(sh + c);
        f32x4 o; o.x = x[j].x * rstd * gv.x * (1.0f + sv.x) + hv.x; o.y = x[j].y * rstd * gv.y * (1.0f + sv.y) + hv.y; o.z = x[j].z * rstd * gv.z * (1.0f + sv.z) + hv.z; o.w = x[j].w * rstd * gv.w * (1.0f + sv.w) + hv.w;
        u32x2 w; w.x = pk2(o.x, o.y); w.y = pk2(o.z, o.w); *(u32x2*)(hrow + c) = w; }
}
__device__ __forceinline__ void phase_rw_a(const ArgsV& a, int bid, int nbl, int wave, int lane) {
    const int gw = bid * NWAVES + wave, NGW = nbl * NWAVES; bf16* H = (bf16*)(a.ws() + WS_H);
    for (int ra = gw; ra < R; ra += 2 * NGW) {
        const int rb_ = ra + NGW < R ? ra + NGW : ra; const float* xa = xin_row(a, ra); const float* xb = xin_row(a, rb_); f32x4 x0[4], x1[4];
#pragma unroll
        for (int j = 0; j < 4; ++j) { x0[j] = *(const f32x4*)(xa + 256 * j + 4 * lane); x1[j] = *(const f32x4*)(xb + 256 * j + 4 * lane); }
        rw_pre(x0, a.in(I_NPRE) + 0, mod_vec(a, 0, ra, 1), mod_vec(a, 0, ra, 0), H + (size_t)ra * DM, lane);
        if (rb_ != ra) rw_pre(x1, a.in(I_NPRE) + 0, mod_vec(a, 0, rb_, 1), mod_vec(a, 0, rb_, 0), H + (size_t)rb_ * DM, lane); }
}
__device__ __forceinline__ void phase_rw_b(const ArgsV& a, int l, int sub, int bid, int nbl, int wave, int lane, bool dry = false) {
    const int gw = bid * NWAVES + wave, NGW = nbl * NWAVES; bf16* H = (bf16*)(a.ws() + WS_H);
    const float wgt = sub == 1 ? 1.0f : 0.5f; const float* gpost = a.in(I_NPOST) + (size_t)(l * 3 + sub) * DM;
    const int nl = sub == 2 ? l + 1 : l, nsub = sub == 2 ? 0 : sub + 1;
    const bool from_input = (l == 0 && sub == 0); const int nsl = sub == 1 ? 4 : 11;
    if (l == 1 && sub >= 1) return;
    const float* gpre = a.in(I_NPRE) + (size_t)(nl * 3 + nsub) * DM;
    for (int i0 = gw; i0 < NB * CTXL; i0 += NGW) {
        const int r0 = (i0 / CTXL) * TB + (i0 % CTXL);
        const float* xs0 = from_input ? xin_row(a, r0) : xres_row(a, r0);
        const float* gate0 = mod_vec(a, l, r0, 3 * sub + 2); const float* sc0 = mod_vec(a, nl, r0, 3 * nsub + 1); const float* sh0 = mod_vec(a, nl, r0, 3 * nsub);
        const float* sp = (const float*)(a.ws() + WS_AUP) + (size_t)((r0 / TB) * CTXL + (r0 % TB)) * DM + 4 * lane;
        f32x4 x0[4], y0[4], gp[4], gt[4], gn[4], sv[4], hv[4];
        {   f32x4 v[4][4];
#pragma unroll
            for (int j = 0; j < 4; ++j) { const int c = 256 * j + 4 * lane; x0[j] = *(const f32x4*)(xs0 + c); gp[j] = *(const f32x4*)(gpost + c); gt[j] = *(const f32x4*)(gate0 + c);
#pragma unroll
                for (int s = 0; s < 4; ++s) v[s][j] = *(const f32x4*)(sp + (size_t)s * 1024 * 1024 + 256 * j); }
            asm volatile("" ::: "memory");
#pragma unroll
            for (int j = 0; j < 4; ++j) y0[j] = (v[0][j] + v[1][j]) + (v[2][j] + v[3][j]); }
        if (nsl > 4) {
            {   f32x4 w[4][4];
#pragma unroll
                for (int j = 0; j < 4; ++j) { const int c = 256 * j + 4 * lane; gn[j] = *(const f32x4*)(gpre + c); sv[j] = *(const f32x4*)(sc0 + c); hv[j] = *(const f32x4*)(sh0 + c);
#pragma unroll
                    for (int s = 0; s < 4; ++s) w[s][j] = *(const f32x4*)(sp + (size_t)(4 + s) * 1024 * 1024 + 256 * j); }
                asm volatile("" ::: "memory");
#pragma unroll
                for (int j = 0; j < 4; ++j) y0[j] += (w[0][j] + w[1][j]) + (w[2][j] + w[3][j]); }
            {   f32x4 w[3][4];
#pragma unroll
                for (int s = 0; s < 3; ++s)
#pragma unroll
                    for (int j = 0; j < 4; ++j) w[s][j] = *(const f32x4*)(sp + (size_t)(8 + s) * 1024 * 1024 + 256 * j);
#pragma unroll
                for (int j = 0; j < 4; ++j) y0[j] += (w[0][j] + w[1][j]) + w[2][j]; }
        } else {
#pragma unroll
            for (int j = 0; j < 4; ++j) { const int c = 256 * j + 4 * lane; gn[j] = *(const f32x4*)(gpre + c); sv[j] = *(const f32x4*)(sc0 + c); hv[j] = *(const f32x4*)(sh0 + c); }
        }
        float ss0 = 0.f;
#pragma unroll
        for (int j = 0; j < 4; ++j) ss0 += (y0[j].x * y0[j].x + y0[j].y * y0[j].y) + (y0[j].z * y0[j].z + y0[j].w * y0[j].w);
        const float rs0 = 1.0f / sqrtf(wave_sum(ss0) * (1.0f / DM) + EPS);
        float* xd0 = dry ? (float*)(a.ws() + WS_BIG) + (size_t)r0 * DM : xres_row(a, r0);
        float s2 = 0.f;
#pragma unroll
        for (int j = 0; j < 4; ++j) { const int c = 256 * j + 4 * lane;
            x0[j].x += wgt * gt[j].x * (y0[j].x * rs0 * gp[j].x); x0[j].y += wgt * gt[j].y * (y0[j].y * rs0 * gp[j].y); x0[j].z += wgt * gt[j].z * (y0[j].z * rs0 * gp[j].z); x0[j].w += wgt * gt[j].w * (y0[j].w * rs0 * gp[j].w);
            *(f32x4*)(xd0 + c) = x0[j]; s2 += (x0[j].x * x0[j].x + x0[j].y * x0[j].y) + (x0[j].z * x0[j].z + x0[j].w * x0[j].w); }
        const float rstd = 1.0f / sqrtf(wave_sum(s2) * (1.0f / DM) + EPS); bf16* hrow = H + (size_t)r0 * DM;
#pragma unroll
        for (int j = 0; j < 4; ++j) { const int c = 256 * j + 4 * lane; f32x4 o;
            o.x = x0[j].x * rstd * gn[j].x * (1.0f + sv[j].x) + hv[j].x; o.y = x0[j].y * rstd * gn[j].y * (1.0f + sv[j].y) + hv[j].y; o.z = x0[j].z * rstd * gn[j].z * (1.0f + sv[j].z) + hv[j].z; o.w = x0[j].w * rstd * gn[j].w * (1.0f + sv[j].w) + hv[j].w;
            u32x2 w; w.x = pk2(o.x, o.y); w.y = pk2(o.z, o.w); *(u32x2*)(hrow + c) = w; }
    }
}
__device__ __forceinline__ void phase_rw_prep(const ArgsV& a, int l, int bid, int nbl, int wave, int lane) {
    const int gw = bid * NWAVES + wave, NGW = nbl * NWAVES;
    const bf16* P = (const bf16*)(a.ws() + WS_BIG); bf16* AUP = (bf16*)(a.ws() + WS_AUP); bf16* KR = (bf16*)(a.ws() + WS_BIG + BIG_KR);
    const float* tab = (const float*)(a.ws() + WS_TAB);
    const float* qn = a.in(I_QN) + l * 256; const float* kvn = a.in(I_KVN) + l * 128;
    for (int task = gw; task < 32 * 17; task += NGW)
        ml::gate_scan_task((const float*)(a.ws() + WS_BIG + BIG_G), a.in(I_GB) + l * 16, (float*)(a.ws() + WS_MS + MS_T), (float*)(a.ws() + WS_MS + MS_SCA), task, lane);
    for (int ra = gw; ra < R; ra += 2 * NGW) {
        const int rb_ = ra + NGW < R ? ra + NGW : ra; const bool two = rb_ != ra;
        const bf16* pa = P + (size_t)ra * DINP; const bf16* pb = P + (size_t)rb_ * DINP;
        const u32x2 wa = *(const u32x2*)(pa + 4 * lane), wb = *(const u32x2*)(pb + 4 * lane);
        const unsigned ka = *(const unsigned*)(pa + 256 + 2 * lane), kb = *(const unsigned*)(pb + 256 + 2 * lane);
        const float va = bf1(pa[384 + lane]), vb = bf1(pb[384 + lane]);
        const f32x4 g = *(const f32x4*)(qn + 4 * lane); const float kg0 = kvn[2 * lane], kg1 = kvn[2 * lane + 1];
        float a0 = bflo(wa.x), a1 = bfhi(wa.x), a2 = bflo(wa.y), a3 = bfhi(wa.y), b0 = bflo(wb.x), b1 = bfhi(wb.x), b2 = bflo(wb.y), b3 = bfhi(wb.y);
        float sa = (a0 * a0 + a1 * a1) + (a2 * a2 + a3 * a3), sb = (b0 * b0 + b1 * b1) + (b2 * b2 + b3 * b3);
        const float c0 = bflo(ka), c1 = bfhi(ka), d0 = bflo(kb), d1 = bfhi(kb); float ta = c0 * c0 + c1 * c1, tb = d0 * d0 + d1 * d1;
#pragma unroll
        for (int o = 1; o < 64; o <<= 1) { sa += __shfl_xor(sa, o); sb += __shfl_xor(sb, o); ta += __shfl_xor(ta, o); tb += __shfl_xor(tb, o); }
        const float voa = __shfl_xor(va, 16), vob = __shfl_xor(vb, 16);
        const float rqa = 1.0f / sqrtf(sa * (1.0f / 256.0f) + EPS), rqb = 1.0f / sqrtf(sb * (1.0f / 256.0f) + EPS), rka = 1.0f / sqrtf(ta * (1.0f / 128.0f) + EPS), rkb = 1.0f / sqrtf(tb * (1.0f / 128.0f) + EPS);
        { u32x2 o; o.x = pk2(a0 * rqa * g.x, a1 * rqa * g.y); o.y = pk2(a2 * rqa * g.z, a3 * rqa * g.w); *(u32x2*)(AUP + (size_t)ra * KUP + 4 * lane) = o;
          *(unsigned*)(AUP + (size_t)ra * KUP + 256 + 2 * lane) = pk2(c0 * rka * kg0, c1 * rka * kg1); }
        if (two) { u32x2 o; o.x = pk2(b0 * rqb * g.x, b1 * rqb * g.y); o.y = pk2(b2 * rqb * g.z, b3 * rqb * g.w); *(u32x2*)(AUP + (size_t)rb_ * KUP + 4 * lane) = o;
          *(unsigned*)(AUP + (size_t)rb_ * KUP + 256 + 2 * lane) = pk2(d0 * rkb * kg0, d1 * rkb * kg1); }
        const int ax = lane >> 5, half = (lane >> 4) & 1, f = lane & 15;
        { const int t = ra % TB; float o = va;
          if (t >= CTXL) { const int tt = t - CTXL; const int pos = ax == 0 ? (tt >> 6) : (tt & 63); const float cs = tab[(pos * 16 + f) * 2], sn = tab[(pos * 16 + f) * 2 + 1]; o = half == 0 ? va * cs - voa * sn : va * cs + voa * sn; }
          KR[(size_t)ra * 64 + lane] = (bf16)f2bf(o); }
        if (two) { const int t = rb_ % TB; float o = vb;
          if (t >= CTXL) { const int tt = t - CTXL; const int pos = ax == 0 ? (tt >> 6) : (tt & 63); const float cs = tab[(pos * 16 + f) * 2], sn = tab[(pos * 16 + f) * 2 + 1]; o = half == 0 ? vb * cs - vob * sn : vb * cs + vob * sn; }
          KR[(size_t)rb_ * 64 + lane] = (bf16)f2bf(o); }
    }
}
#define RLX_AGENT __ATOMIC_RELAXED, __HIP_MEMORY_SCOPE_AGENT
#define VM_WAIT() asm volatile("s_waitcnt vmcnt(0)" ::: "memory")
#define XB_TMO      128
#define XB_XCNT(j)  (256  + 64 * (j))
#define XB_XSUB(j)  (1280 + 64 * (j))
#define XB_XGEN(j)  (2304 + 64 * (j))
#define XB_TOP      3328
#define XB_TOPGEN   3392
#define XCD_BAR_WORDS 3456
#define XB_SPIN_CAP (1u << 18)

__device__ __forceinline__ unsigned xb_ld(unsigned* p)              { return __hip_atomic_load(p, __ATOMIC_RELAXED, __HIP_MEMORY_SCOPE_AGENT); }
__device__ __forceinline__ unsigned xb_add(unsigned* p, unsigned v) { return __hip_atomic_fetch_add(p, v, __ATOMIC_RELAXED, __HIP_MEMORY_SCOPE_AGENT); }
__device__ __forceinline__ unsigned xb_xcc_id() { return (unsigned)__builtin_amdgcn_s_getreg((3 << 11) | 20) & 0xFu; }
#define XB_SPIN(cond, bar) do { unsigned _sp = 0; while (cond) { __builtin_amdgcn_s_sleep(1); \
    if ((++_sp & 255u) == 0u) { if (xb_ld(&(bar)[XB_TMO])) break; if (_sp > XB_SPIN_CAP) { atomicAdd(&(bar)[XB_TMO], 1u); break; } } } } while (0)

struct XcdBarrier {
    unsigned* bar; unsigned x;
    volatile LAS unsigned* st;
};

__device__ __forceinline__ XcdBarrier xcd_barrier_post(unsigned* bar, volatile LAS unsigned* st) {
    XcdBarrier b; b.bar = bar; b.x = xb_xcc_id(); b.st = st;
    if (threadIdx.x == 0) (void)xb_add(&bar[XB_XCNT(b.x)], 1u);
    return b;
}
__device__ __forceinline__ void xcd_barrier_complete(unsigned* bar, unsigned x, unsigned& nloc, unsigned& nx) {
    const unsigned G = gridDim.x * gridDim.y * gridDim.z;
    unsigned sum, cnt, mine, sp = 0u;
    for (;;) {
        sum = 0u; cnt = 0u; mine = 0u;
#pragma unroll
        for (unsigned j = 0; j < 16; ++j) { const unsigned c = xb_ld(&bar[XB_XCNT(j)]); sum += c; cnt += (c > 0u) ? 1u : 0u; mine = (j == x) ? c : mine; }
        if (sum == G) break;
        __builtin_amdgcn_s_sleep(1);
        if ((++sp & 255u) == 0u) { if (xb_ld(&bar[XB_TMO])) break; if (sp > XB_SPIN_CAP) { atomicAdd(&bar[XB_TMO], 1u); break; } }
    }
    nloc = mine > 0u ? mine : 1u; nx = cnt > 0u ? cnt : 1u;
}

__device__ __forceinline__ void xcd_barrier(const XcdBarrier& b) {
    asm volatile("s_waitcnt vmcnt(0)" ::: "memory");
    __syncthreads();
    if (threadIdx.x == 0) {
        unsigned* bar = b.bar;
        __builtin_amdgcn_s_waitcnt(0);
        unsigned nloc = b.st[0], nx = b.st[1];
        if (nloc == 0u) { xcd_barrier_complete(bar, b.x, nloc, nx); b.st[0] = nloc; b.st[1] = nx; }
        const unsigned old = xb_add(&bar[XB_XSUB(b.x)], 1u);
        const unsigned gen = old / nloc;
        if (old + 1u == (gen + 1u) * nloc) {
            __builtin_amdgcn_fence(__ATOMIC_RELEASE, "agent");
            asm volatile("s_waitcnt vmcnt(0)" ::: "memory");
            const unsigned og = xb_add(&bar[XB_TOP], 1u);
            const unsigned tg = og / nx;
            if (og + 1u == (tg + 1u) * nx) xb_add(&bar[XB_TOPGEN], 1u);
            else XB_SPIN(xb_ld(&bar[XB_TOPGEN]) == tg, bar);
            __builtin_amdgcn_fence(__ATOMIC_ACQUIRE, "agent");
            xb_add(&bar[XB_XGEN(b.x)], 1u);
            asm volatile("s_waitcnt vmcnt(0)" ::: "memory");
        } else {
            XB_SPIN(xb_ld(&bar[XB_XGEN(b.x)]) == gen, bar);
            __builtin_amdgcn_fence(__ATOMIC_ACQUIRE, "agent");
            asm volatile("s_waitcnt vmcnt(0)" ::: "memory");
        }
    }
    __syncthreads();
}
constexpr int PPL = 15, N_PHASES = 1 + 2 * PPL, SKIP_PHASE = 1 + PPL;
__global__ void __launch_bounds__(NTHREADS, 2) mega_fwd(Args args) {
    extern __shared__ __attribute__((aligned(16))) unsigned char lds_raw[];
    LAS unsigned char* lds = (LAS unsigned char*)lds_raw;
    cg::grid_group grid = cg::this_grid();
    volatile LAS unsigned* MISC = (volatile LAS unsigned*)(lds + LDS_MISC);
    if (threadIdx.x < 16) MISC[threadIdx.x] = 0u;
    __syncthreads();
    XcdBarrier bar = xcd_barrier_post((unsigned*)(args.ws + WS_CTL), MISC + 8);
    for (int ph = args.ph_lo; ph < args.ph_hi; ++ph) {
        if (ph == SKIP_PHASE || ph == 1 + PPL + 11 || ph == 1 + PPL + 14 || ph == 1 + 9 || ph == 1 + PPL + 9) continue;
#define TID_DECL int tid_ = threadIdx.x; asm volatile("" : "+v"(tid_)); const int tid = tid_, lane = tid & 63, wave = __builtin_amdgcn_readfirstlane(tid >> 6); (void)tid; (void)lane; (void)wave
        int bid_ = blockIdx.x, nbl_ = gridDim.x; asm volatile("" : "+s"(bid_), "+s"(nbl_)); const int bid = bid_, nbl = nbl_;
        int zo_ = 0; asm volatile("" : "+s"(zo_));
        const ArgsV A_{&args, zo_}; unsigned char* ws = A_.ws();
        XcdBarrier barl = bar; asm volatile("" : "+s"(barl.x), "+s"(barl.bar));
        if (ph == 0) { TID_DECL; mod_phase(A_, lds, bid, nbl, tid, wave, lane); }
        else {
            const int l = (ph - 1) / PPL, k = (ph - 1) % PPL;
            if (k == 0) { TID_DECL; phase_rw_a(A_, bid, nbl, wave, lane); }
            else if (k == 1 || k == 12) { const int j = k == 12;
                pg8::Gemm g{(const pg8::bf16_t*)(ws + WS_H), (const pg8::bf16_t*)(ws + WS_W1) + (size_t)j * NW1 * DM, R, NW1, DM}; pg8::TileOrder S; S.init(0, NW1, DM, nbl, bid, 1);
                pg8::EpiSwiGLU E{(pg8::bf16_t*)(ws + WS_BIG), DFFP};
                pg8::gemm_phase<pg8::EpiSwiGLU, pg8::TileOrder, true, true>(lds, g, S, E); }
            else if (k == 2 || k == 13 || k == 10) { const int j = k == 13, sub = k == 2 ? 0 : (k == 10 ? 1 : 2);
                const pg8::bf16_t* A = (const pg8::bf16_t*)(ws + (k == 10 ? WS_H : WS_BIG));
                const pg8::bf16_t* Bt = k == 10 ? (const pg8::bf16_t*)(ws + WS_WOUT) : (const pg8::bf16_t*)(ws + WS_W2) + (size_t)j * DM * DFFP;
                const int K = k == 10 ? DM : DFFP;
                pg8::Gemm g{A, Bt, R, DM, K}; pg8::TileOrder S; S.init(1, DM, K, nbl, bid, 1);
                const bool has_next = !(l == 1 && sub == 2); const int nl = sub == 2 ? l + 1 : l, nsub = sub == 2 ? 0 : sub + 1;
                const float* modb = (const float*)(ws + WS_MOD); unsigned* cntb = (unsigned*)(ws + WS_CTL + 65536) + (size_t)((l * 3 + sub) * 2) * (68 * 64);
                pg8::EpiNormRes E{(l == 0 && sub == 0) ? A_.in(I_X) : (const float*)A_.out(), A_.out(), has_next ? (pg8::bf16_t*)(ws + WS_H) : nullptr,
                                  modb + (size_t)((l * 5) * NMOD + 3 * sub + 2) * DM, A_.in(I_NPOST) + (size_t)(l * 3 + sub) * DM,
                                  A_.in(I_NPRE) + (size_t)((has_next ? nl : 0) * 3 + nsub) * DM, modb + (size_t)(((has_next ? nl : 0) * 5) * NMOD + 3 * nsub + 1) * DM, modb + (size_t)(((has_next ? nl : 0) * 5) * NMOD + 3 * nsub) * DM,
                                  sub == 1 ? 1.0f : 0.5f, pg8::PanelSS{(unsigned*)(ws + WS_MS + MS_X1), cntb}, pg8::PanelSS{(unsigned*)(ws + WS_MS + MS_X2), cntb + 68 * 64}};
                pg8::gemm_phase<pg8::EpiNormRes, pg8::TileOrder, false, true>(lds, g, S, E);
                if (l == 0 || k == 2) { __syncthreads();
                    pg8::TileOrder S2; S2.init(2, DM, K, nbl, bid, k == 10 ? 4 : 11);
                    pg8::EpiSlab E2{(float*)(ws + WS_AUP)};
                    pg8::gemm_phase<pg8::EpiSlab, pg8::TileOrder, true, true>(lds, g, S2, E2); } }
            else if (k == 6) {
                pg8::Gemm g{(const pg8::bf16_t*)(ws + WS_AUP), (const pg8::bf16_t*)(ws + WS_WUP), R, NUP, KUP}; pg8::TileOrder S; S.init(3, NUP, KUP, nbl, bid, 1);
                pg8::EpiStore E{(pg8::bf16_t*)(ws + WS_Y), NUP};
                pg8::gemm_phase<pg8::EpiStore, pg8::TileOrder, true, true>(lds, g, S, E);
                if (k == 6) {
                    __syncthreads();
                    for (int u = bid; u < 512; u += nbl)
                        ml::mlstm_local((const ml::bf16*)(ws + WS_BIG), (const float*)(ws + WS_MS + MS_T), A_.in(I_CW) + (size_t)l * 3 * 1024, A_.in(I_CB) + (size_t)l * 1024,
                                        (float*)(ws + WS_HF), (float*)(ws + WS_MS + MS_NLOC), u, (char*)lds_raw); } }
            else if (k == 3 || k == 11 || k == 14) { TID_DECL; phase_rw_b(A_, l, k == 3 ? 0 : (k == 11 ? 1 : 2), bid, nbl, wave, lane); }
            else if (k == 4) {
                pg8::Gemm g{(const pg8::bf16_t*)(ws + WS_H), (const pg8::bf16_t*)(ws + WS_WIN), R, DINP, DM}; pg8::TileOrder S; S.init(0, DINP, DM, nbl, bid, 1);
                pg8::EpiP E{(pg8::bf16_t*)(ws + WS_BIG), DINP, (float*)(ws + WS_BIG + BIG_G)};
                pg8::gemm_phase<pg8::EpiP, pg8::TileOrder, true, true>(lds, g, S, E); }
            else if (k == 5) { TID_DECL; phase_rw_prep(A_, l, bid, nbl, wave, lane); }
            else if (k == 7 || k == 8) {
                if (k == 7) { TID_DECL; ml::mlstm_scan((const float*)(ws + WS_HF), (const float*)(ws + WS_MS + MS_NLOC), (const float*)(ws + WS_MS + MS_SCA), (ml::bf16*)(ws + WS_AUP), (float*)(ws + WS_MS + MS_NST), (float*)(ws + WS_MS + MS_BM), bid * NTHREADS + tid, nbl * NTHREADS); }
                att::bf16* QKV = (att::bf16*)(ws + WS_Y); const att::bf16* KR = (const att::bf16*)(ws + WS_BIG + BIG_KR);
                const float* tab = (const float*)(ws + WS_TAB);
                int u0, u1;
                if (k == 8) { u0 = bid; u1 = 256; } else { u0 = (l == 0 && bid >= 128) ? 256 + (bid - 128) : 272; u1 = 272; }
                for (int u = u0; u < u1; u += nbl) {
                    int b, h, seq, rope, qtok0; size_t rq;
                    if (u < 256) { b = u >> 6; h = (u >> 4) & 3; const int qb = u & 15; rq = (size_t)b * TB + CTXL + (size_t)qb * 256; seq = TB; rope = 1; qtok0 = qb * 256; }
                    else { b = (u - 256) >> 2; h = (u - 256) & 3; rq = (size_t)b * TB; seq = CTXL; rope = 0; qtok0 = 0; }
                    const size_t r0 = (size_t)b * TB;
                    const int panel = u < 256 ? (b * 16 + (u & 15)) : (64 + b);
                    att::attn_body(QKV + rq * NUP + h * 192, QKV + r0 * NUP + 768 + h * 256, QKV + r0 * NUP + 768 + h * 256 + 128, KR + r0 * 64, (att::bf16*)(ws + WS_H) + rq * DM + h * 128, seq, rope, qtok0, tab, (char*)lds_raw,
                                   (unsigned*)(ws + WS_MS + MS_X1) + rq * 4, (unsigned*)(ws + WS_CTL + 65536) + (size_t)(12 + l) * (68 * 64) + 64 * panel, A_.in(I_AON) + l * 512 + h * 128, h);
                }
                const int m0 = nbl - 1 - bid, m1 = (k == 8) ? 256 : ((l == 0) ? 16 : 0);
                for (int u = m0; u < m1; u += nbl) { const int bh = (k == 8) ? (u >> 4) : u, tbk = (k == 8) ? 1 + (u & 15) : 0;
                    ml::mlstm_out2((const ml::bf16*)(ws + WS_BIG), (const float*)(ws + WS_MS + MS_T), A_.in(I_CW) + (size_t)l * 3 * 1024, A_.in(I_CB) + (size_t)l * 1024, (const ml::bf16*)(ws + WS_AUP),
                                   (const float*)(ws + WS_MS + MS_NST), (const float*)(ws + WS_MS + MS_BM), A_.in(I_MN) + l * 512, (ml::bf16*)(ws + WS_H), bh >> 2, bh & 3, tbk, (char*)lds_raw); }
            }
        }
        {
            int wl = -1, wparts = 0, wg0 = 0, wn = nbl;
            if (ph == 0) { wl = 0; wparts = 3; } else if (ph == 1 + 7) { wl = 1; wparts = 1; wg0 = 144; wn = 96; } else if (ph == 1 + 14) { wl = 1; wparts = 2; }
            if (wl >= 0 && bid >= wg0 && bid < wg0 + wn) { TID_DECL; __syncthreads(); wconv_layer(A_, wl, lds, bid - wg0, wn, wave, lane, wparts); } }
        if (ph + 1 < args.ph_hi) { if (args.ph_hi < 0) grid.sync(); else xcd_barrier(barl); }
    }
}

#ifndef MK_ONE_LAUNCH
#define MK_ONE_LAUNCH 1
#endif
extern "C" void kernel_launch(void* const* d_in, const int* in_sizes, int n_in, void* d_out, int out_size, void* d_ws, size_t ws_size, hipStream_t stream) {
    static int grid = 0;
    if (grid == 0) {
        if (n_in != 22 || in_sizes[0] != NB * SEQ * DM || out_size != NB * SEQ * DM || ws_size < WS_END) { fprintf(stderr, "kernel_launch: shape/workspace mismatch (n_in %d, in0 %d, out %d, ws %zu need %zu)\n", n_in, n_in > 0 ? in_sizes[0] : -1, out_size, ws_size, (size_t)WS_END); grid = -1; return; }
        int dev = 0, cus = 0, per_cu = 0;
        if (hipGetDevice(&dev) != hipSuccess || hipDeviceGetAttribute(&cus, hipDeviceAttributeMultiprocessorCount, dev) != hipSuccess) { grid = -1; return; }
        if (hipFuncSetAttribute((const void*)mega_fwd, hipFuncAttributeMaxDynamicSharedMemorySize, LDS_BYTES) != hipSuccess) { fprintf(stderr, "kernel_launch: hipFuncSetAttribute failed\n"); grid = -1; return; }
        if (hipOccupancyMaxActiveBlocksPerMultiprocessor(&per_cu, (const void*)mega_fwd, NTHREADS, LDS_BYTES) != hipSuccess || per_cu < 1) { fprintf(stderr, "kernel_launch: occupancy query says %d\n", per_cu); per_cu = 1; }
        (void)hipGetLastError();
        grid = cus * (per_cu > 1 ? 1 : per_cu);
    }
    if (grid < 0) return;
    if (hipMemsetAsync((char*)d_ws + WS_CTL, 0, 65536 + 14 * 68 * 256, stream) != hipSuccess) { fprintf(stderr, "kernel_launch: memset of the barrier words failed\n"); return; }
    Args a{};
    for (int i = 0; i < 22; ++i) a.in[i] = (const float*)d_in[i];
    a.out = (float*)d_out; a.ws = (unsigned char*)d_ws;
#if MK_ONE_LAUNCH
    a.ph_lo = 0; a.ph_hi = N_PHASES;
    void* kargs[] = {&a};
    hipError_t e = hipLaunchCooperativeKernel((const void*)mega_fwd, dim3(grid), dim3(NTHREADS), kargs, LDS_BYTES, stream);
    if (e != hipSuccess) fprintf(stderr, "kernel_launch: cooperative launch failed: %s (grid %d)\n", hipGetErrorString(e), grid);
#else
    for (int ph = 0; ph < N_PHASES; ++ph) { if (ph == SKIP_PHASE) continue; a.ph_lo = ph; a.ph_hi = ph + 1;
        hipLaunchKernelGGL(mega_fwd, dim3(grid), dim3(NTHREADS), LDS_BYTES, stream, a);
        const hipError_t le = hipPeekAtLastError(); if (le != hipSuccess) { fprintf(stderr, "kernel_launch: launch of phase %d failed: %s\n", ph, hipGetErrorName(le)); break; } }
#endif
}
```

```cpp
#include <hip/hip_runtime.h>
#include <hip/hip_cooperative_groups.h>
#include <cstdio>
#include <cstdint>
namespace cg = cooperative_groups;
namespace pg8 {
#define PG8_LAS __attribute__((address_space(3)))
typedef unsigned short bf16_t;
typedef short bf16x8 __attribute__((ext_vector_type(8)));
typedef float f32x4 __attribute__((ext_vector_type(4)));
typedef unsigned u32x4 __attribute__((ext_vector_type(4)));
constexpr int BM = 256, BK = 64, HALF = 128, HTB = HALF * BK * 2  , STAGE_BYTES = 8 * HTB, NXCD = 8, WGM = 8;

__host__ __device__ __forceinline__ int lds_byte(int r, int c) { const int st = (r >> 4) * 2 + (c >> 5), rr = r & 15, cc = c & 31, ob = rr * 64 + cc * 2; return st * 1024 + (ob ^ (((ob >> 9) & 1) << 5)); }
__host__ __device__ __forceinline__ void stage_rc(int b, int& R, int& C) { const int st = b / 1024, sb = b % 1024, swz = sb ^ (((sb >> 9) & 1) << 5); R = (st >> 1) * 16 + swz / 64; C = (st & 1) * 32 + (swz % 64) / 2; }
__host__ __device__ __forceinline__ int perm32(int rho) { const int n = rho >> 4, i = rho & 15; return 8 * (i >> 2) + 4 * n + (i & 3); }

struct Unit { int pm, pn, kt0, nkt; };
struct Gemm { const bf16_t* A; const bf16_t* Bt; int M, N, K; };

struct StaticOrder {
    int nM, nN, nwg, G, c, nkt;
    __host__ __device__ void init(int M, int N, int K, int G_, int c_) { nM = M / BM; nN = N / BM; nwg = nM * nN; G = G_; c = c_; nkt = K / BK; }
    __host__ __device__ bool next(int i, Unit& u) const {
        const long L = (long)i * G + c; if (L >= nwg) return false;
        int wgid = (int)L; { const int q = nwg / NXCD, r = nwg % NXCD, xcd = wgid % NXCD, off = wgid / NXCD; wgid = (xcd < r ? xcd * (q + 1) : r * (q + 1) + (xcd - r) * q) + off; }
        const int nig = WGM * nN, gid = wgid / nig, fm = gid * WGM, gsz = (nM - fm) < WGM ? (nM - fm) : WGM;
        u.pm = fm + ((wgid % nig) % gsz); u.pn = (wgid % nig) / gsz; u.kt0 = 0; u.nkt = nkt; return true;
    }
    __device__ __forceinline__ void a_ready(const Unit&) const {}
    __device__ __forceinline__ void done(const Unit&) const {}
};

__device__ __forceinline__ unsigned cvt_pk_bf16(float lo, float hi) { unsigned r; asm volatile("v_cvt_pk_bf16_f32 %0, %1, %2" : "=v"(r) : "v"(lo), "v"(hi)); return r; }
typedef float f32x2 __attribute__((ext_vector_type(2)));
__device__ __forceinline__ f32x2 gelu_pk(f32x2 v) {
    const f32x2 av = __builtin_elementwise_abs(v), d = av * 0.2316418882f + 1.0f;
    f32x2 t; t.x = __builtin_amdgcn_rcpf(d.x); t.y = __builtin_amdgcn_rcpf(d.y);
    f32x2 q = t * 0.5307027145f + (-0.7265760135f); q = q * t + 0.7107068705f; q = q * t + (-0.142248368f); q = q * t + 0.127414796f; q = q * t;
    const f32x2 s = (v * v) * (-0.72134752044f);
    f32x2 e; e.x = __builtin_amdgcn_exp2f(s.x); e.y = __builtin_amdgcn_exp2f(s.y);
    const f32x2 m = v * (q * e), r = v - m;
    f32x2 o; o.x = v.x < 0.f ? m.x : r.x; o.y = v.y < 0.f ? m.y : r.y; return o;
}
__device__ __forceinline__ float silu_f(float x) { return x * __builtin_amdgcn_rcpf(1.0f + __builtin_amdgcn_exp2f(-1.4426950408889634f * x)); }
__device__ __forceinline__ void st8(bf16_t* p, f32x4 v0, f32x4 v1) { u32x4 w; w.x = cvt_pk_bf16(v0[0], v0[1]); w.y = cvt_pk_bf16(v0[2], v0[3]); w.z = cvt_pk_bf16(v1[0], v1[1]); w.w = cvt_pk_bf16(v1[2], v1[3]); *(u32x4*)p = w; }
struct EpiStore {
    static constexpr bool PERM = true, AFTER_DRAIN = false;
    bf16_t* O; int ldc;
    __device__ __forceinline__ void operator()(const f32x4 (&acc)[2][2][4][2], const Unit& u, int wr, int wc, int fr, int fq) const {
        const int row0 = u.pm * BM + wr * 64 + fr, col0 = u.pn * BM + wc * 32 + 8 * fq;
#pragma unroll
        for (int ai = 0; ai < 2; ++ai)
#pragma unroll
            for (int m = 0; m < 4; ++m) { bf16_t* rowp = O + (size_t)(row0 + ai * HALF + m * 16) * ldc + col0;
#pragma unroll
                for (int bj = 0; bj < 2; ++bj) st8(rowp + bj * HALF, acc[ai][bj][m][0], acc[ai][bj][m][1]); }
    }
};
struct EpiSwiGLU {
    static constexpr bool PERM = true, AFTER_DRAIN = false;
    bf16_t* O; int ldc;
    __device__ __forceinline__ void operator()(const f32x4 (&acc)[2][2][4][2], const Unit& u, int wr, int wc, int fr, int fq) const {
        const int row0 = u.pm * BM + wr * 64 + fr, col0 = u.pn * HALF + wc * 32 + 8 * fq;
#pragma unroll
        for (int ai = 0; ai < 2; ++ai)
#pragma unroll
            for (int m = 0; m < 4; ++m) { bf16_t* rowp = O + (size_t)(row0 + ai * HALF + m * 16) * ldc + col0;
                f32x4 v0, v1;
#pragma unroll
                for (int j = 0; j < 4; ++j) { v0[j] = silu_f(acc[ai][0][m][0][j]) * acc[ai][1][m][0][j]; v1[j] = silu_f(acc[ai][0][m][1][j]) * acc[ai][1][m][1][j]; }
                st8(rowp, v0, v1); }
    }
};
struct EpiP {
    static constexpr bool PERM = true, AFTER_DRAIN = false;
    bf16_t* O; int ldc; float* G;
    __device__ __forceinline__ void operator()(const f32x4 (&acc)[2][2][4][2], const Unit& u, int wr, int wc, int fr, int fq) const {
        const int row0 = u.pm * BM + wr * 64 + fr, col0 = u.pn * BM + wc * 32 + 8 * fq;
        const bool gt = (u.pn == 9) && (wc == 2) && (fq < 2);
#pragma unroll
        for (int ai = 0; ai < 2; ++ai)
#pragma unroll
            for (int m = 0; m < 4; ++m) { const int row = row0 + ai * HALF + m * 16; bf16_t* rowp = O + (size_t)row * ldc + col0;
#pragma unroll
                for (int bj = 0; bj < 2; ++bj) st8(rowp + bj * HALF, acc[ai][bj][m][0], acc[ai][bj][m][1]);
                if (gt) { *(f32x4*)(G + (size_t)row * 16 + 8 * fq) = acc[ai][1][m][0]; *(f32x4*)(G + (size_t)row * 16 + 8 * fq + 4) = acc[ai][1][m][1]; } }
    }
};
struct EpiSlab {
    static constexpr bool PERM = false, AFTER_DRAIN = false;
    float* S;
    __device__ __forceinline__ void operator()(const f32x4 (&acc)[2][2][4][2], const Unit& u, int wr, int wc, int fr, int fq) const {
        const int row0 = (u.pm / 17) * BM + wr * 64 + fr, col0 = u.pn * BM + wc * 32 + 4 * fq; const int slice = u.kt0 / u.nkt;
        float* base = S + (size_t)slice * 1024 * 1024;
#pragma unroll
        for (int ai = 0; ai < 2; ++ai)
#pragma unroll
            for (int m = 0; m < 4; ++m) { float* rowp = base + (size_t)(row0 + ai * HALF + m * 16) * 1024 + col0;
#pragma unroll
                for (int bj = 0; bj < 2; ++bj)
#pragma unroll
                    for (int n = 0; n < 2; ++n) *(f32x4*)(rowp + bj * HALF + n * 16) = acc[ai][bj][m][n]; }
    }
};
struct TileOrder {
    int mode, nM, nN, nwg, G, c, nkt, nsl;
    __device__ void init(int mode_, int N, int K, int G_, int c_, int nsl_) { mode = mode_; nN = N / BM; G = G_; c = c_; nsl = nsl_;
        if (mode == 2) { nM = 4; nwg = 4 * nN * nsl; nkt = (K / BK) / nsl; } else { nM = mode == 1 ? 64 : 68; nwg = nM * nN; nkt = K / BK; } }
    __device__ bool next(int i, Unit& u) const {
        const long L = (long)i * G + c; if (L >= nwg) return false;
        if (mode == 2) { const int sl = (int)L % nsl, t = (int)L / nsl; u.pn = t % nN; u.pm = 17 * (t / nN); u.kt0 = sl * nkt; u.nkt = nkt; return true; }
        int wgid = (int)L; { const int q = nwg / NXCD, r = nwg % NXCD, xcd = wgid % NXCD, off = wgid / NXCD; wgid = (xcd < r ? xcd * (q + 1) : r * (q + 1) + (xcd - r) * q) + off; }
        const int nig = WGM * nN, gid = wgid / nig, fm = gid * WGM, gsz = (nM - fm) < WGM ? (nM - fm) : WGM;
        int pm = fm + ((wgid % nig) % gsz); u.pn = (wgid % nig) / gsz; if (mode == 1) pm += (pm >> 4) + 1;
        u.pm = pm; u.kt0 = 0; u.nkt = nkt;
        if (mode == 3) { if (u.pn < 3) { u.kt0 = 0; u.nkt = 4; } else { u.kt0 = 4; u.nkt = 2; } }
        return true;
    }
    __device__ __forceinline__ void a_ready(const Unit&) const {}
    __device__ __forceinline__ void done(const Unit&) const {}
};

struct PanelSS {
    unsigned* xbuf;
    unsigned* cnt;
    __device__ __forceinline__ void run(const f32x4 (&v)[2][2][4][2], const Unit& u, int wr, int wc, int fr, int fq, PG8_LAS unsigned char* lds, int wid, int lane) const {
        PG8_LAS float* P = (PG8_LAS float*)lds;
        PG8_LAS float* S = (PG8_LAS float*)(lds + 8192);
#pragma unroll
        for (int ai = 0; ai < 2; ++ai)
#pragma unroll
            for (int m = 0; m < 4; ++m) { float s = 0.f;
#pragma unroll
                for (int bj = 0; bj < 2; ++bj)
#pragma unroll
                    for (int n = 0; n < 2; ++n) { const f32x4 x = v[ai][bj][m][n]; s += (x[0] * x[0] + x[1] * x[1]) + (x[2] * x[2] + x[3] * x[3]); }
                s += __shfl_xor(s, 16); s += __shfl_xor(s, 32);
                if (fq == 0) P[(ai * HALF + wr * 64 + m * 16 + fr) * 4 + wc] = s; }
        asm volatile("s_waitcnt lgkmcnt(0)" ::: "memory"); __builtin_amdgcn_s_barrier(); asm volatile("" ::: "memory");
        const int row = wid * 32 + (lane & 31);
        if (lane < 32) { const float t = (P[row * 4 + 0] + P[row * 4 + 1]) + (P[row * 4 + 2] + P[row * 4 + 3]);
            __hip_atomic_store(xbuf + (size_t)(u.pm * BM + row) * 4 + u.pn, __float_as_uint(t), __ATOMIC_RELAXED, __HIP_MEMORY_SCOPE_AGENT); }
        asm volatile("s_waitcnt vmcnt(0)" ::: "memory");
        if (lane == 0) __hip_atomic_fetch_add(cnt + 64 * u.pm, 1u, __ATOMIC_RELAXED, __HIP_MEMORY_SCOPE_AGENT);
        if (wid == 0) { unsigned sp = 0;
            while ((unsigned)__builtin_amdgcn_readfirstlane(__hip_atomic_load(cnt + 64 * u.pm, __ATOMIC_RELAXED, __HIP_MEMORY_SCOPE_AGENT)) < 32u) { __builtin_amdgcn_s_sleep(2); if (++sp > (1u << 22)) break; }
            __builtin_amdgcn_fence(__ATOMIC_ACQUIRE, "agent"); }
        asm volatile("s_waitcnt vmcnt(0) lgkmcnt(0)" ::: "memory"); __builtin_amdgcn_s_barrier(); asm volatile("" ::: "memory");
        if (lane < 32) { const unsigned* slot = xbuf + (size_t)(u.pm * BM + row) * 4; float t = 0.f;
#pragma unroll
            for (int q = 0; q < 4; ++q) t += __uint_as_float(__hip_atomic_load(slot + q, __ATOMIC_RELAXED, __HIP_MEMORY_SCOPE_AGENT));
            S[row] = t; }
        asm volatile("s_waitcnt lgkmcnt(0)" ::: "memory"); __builtin_amdgcn_s_barrier(); asm volatile("" ::: "memory");
    }
};
struct EpiNormRes {
    static constexpr bool PERM = false, AFTER_DRAIN = true;
    bf16_t* xb; float* xout;
    bf16_t* H;
    const float* gate; const float* gpost;
    const float* gpre; const float* sc; const float* sh;
    float wgt; PanelSS st1, st2;
    __device__ __forceinline__ void fused(f32x4 (&acc)[2][2][4][2], const Unit& u, int wr, int wc, int fr, int fq, PG8_LAS unsigned char* lds, int wid, int lane) const {
        const PG8_LAS float* S = (const PG8_LAS float*)(lds + 8192);
        const int b = u.pm / 17, tp = (u.pm - 17 * b - 1) * BM;
        const int col0 = u.pn * BM + wc * 32 + 4 * fq; const size_t mo = (size_t)b * 9 * 1024;
        st1.run(acc, u, wr, wc, fr, fq, lds, wid, lane);
        {   f32x4 cg[2][2];
#pragma unroll
            for (int bj = 0; bj < 2; ++bj)
#pragma unroll
                for (int n = 0; n < 2; ++n) cg[bj][n] = *(const f32x4*)(gate + mo + col0 + bj * HALF + n * 16) * *(const f32x4*)(gpost + col0 + bj * HALF + n * 16) * wgt;
            typedef unsigned u32x2r __attribute__((ext_vector_type(2)));
            if (H == nullptr) {
#pragma unroll
            for (int ai = 0; ai < 2; ++ai)
#pragma unroll
                for (int m = 0; m < 4; ++m) { const int r = ai * HALF + wr * 64 + m * 16 + fr; const float rs = 1.0f / sqrtf(S[r] * (1.0f / 1024.0f) + 1e-6f);
                    const size_t off = ((size_t)b * 4096 + tp + r) * 1024 + col0;
#pragma unroll
                    for (int bj = 0; bj < 2; ++bj)
#pragma unroll
                        for (int n = 0; n < 2; ++n) { const u32x2r w = *(const u32x2r*)(xb + off + bj * HALF + n * 16); f32x4 xo; xo[0] = __uint_as_float(w.x << 16); xo[1] = __uint_as_float(w.x & 0xffff0000u); xo[2] = __uint_as_float(w.y << 16); xo[3] = __uint_as_float(w.y & 0xffff0000u);
                            *(f32x4*)(xout + off + bj * HALF + n * 16) = xo + cg[bj][n] * (acc[ai][bj][m][n] * rs); }
                    if (m & 1) asm volatile("" ::: "memory"); }
                return; }
#pragma unroll
            for (int ai = 0; ai < 2; ++ai)
#pragma unroll
                for (int m = 0; m < 4; ++m) { const int r = ai * HALF + wr * 64 + m * 16 + fr; const float rs = 1.0f / sqrtf(S[r] * (1.0f / 1024.0f) + 1e-6f);
                    const size_t off = ((size_t)b * 4096 + tp + r) * 1024 + col0;
#pragma unroll
                    for (int bj = 0; bj < 2; ++bj)
#pragma unroll
                        for (int n = 0; n < 2; ++n) { const u32x2r w = *(const u32x2r*)(xb + off + bj * HALF + n * 16); f32x4 xo; xo[0] = __uint_as_float(w.x << 16); xo[1] = __uint_as_float(w.x & 0xffff0000u); xo[2] = __uint_as_float(w.y << 16); xo[3] = __uint_as_float(w.y & 0xffff0000u);
                            const f32x4 xn = xo + cg[bj][n] * (acc[ai][bj][m][n] * rs);
                            acc[ai][bj][m][n] = xn; u32x2r o; o.x = cvt_pk_bf16(xn[0], xn[1]); o.y = cvt_pk_bf16(xn[2], xn[3]); *(u32x2r*)(xb + off + bj * HALF + n * 16) = o; }
                    asm volatile("" : "+v"(acc[ai][0][m][0]), "+v"(acc[ai][0][m][1]), "+v"(acc[ai][1][m][0]), "+v"(acc[ai][1][m][1]));
                    if (m & 1) asm volatile("" ::: "memory"); } }
        asm volatile("s_waitcnt lgkmcnt(0)" ::: "memory"); __builtin_amdgcn_s_barrier(); asm volatile("" ::: "memory");
        st2.run(acc, u, wr, wc, fr, fq, lds, wid, lane);
        {   typedef unsigned u32x2v __attribute__((ext_vector_type(2)));
            f32x4 ca[2][2], cs[2][2];
#pragma unroll
            for (int bj = 0; bj < 2; ++bj)
#pragma unroll
                for (int n = 0; n < 2; ++n) { const int c = col0 + bj * HALF + n * 16; ca[bj][n] = *(const f32x4*)(gpre + c) * (*(const f32x4*)(sc + mo + c) + 1.0f); cs[bj][n] = *(const f32x4*)(sh + mo + c); }
#pragma unroll
            for (int ai = 0; ai < 2; ++ai)
#pragma unroll
                for (int m = 0; m < 4; ++m) { const int r = ai * HALF + wr * 64 + m * 16 + fr; const float rs = 1.0f / sqrtf(S[r] * (1.0f / 1024.0f) + 1e-6f);
                    bf16_t* hp = H + (size_t)(u.pm * BM + r) * 1024 + col0;
#pragma unroll
                    for (int bj = 0; bj < 2; ++bj)
#pragma unroll
                        for (int n = 0; n < 2; ++n) { const f32x4 o = acc[ai][bj][m][n] * rs * ca[bj][n] + cs[bj][n]; u32x2v w; w.x = cvt_pk_bf16(o[0], o[1]); w.y = cvt_pk_bf16(o[2], o[3]);
                            *(u32x2v*)(hp + bj * HALF + n * 16) = w; } } }
    }
};

template <class Epi, class Sched, bool ALIGN_EPI = false, bool SP2 = false>
__device__ __forceinline__ void gemm_phase(PG8_LAS unsigned char* lds, const Gemm g, const Sched& S, const Epi& E) {
    int tid_ = threadIdx.x; asm volatile("" : "+v"(tid_));
    const int tid = tid_, wid = __builtin_amdgcn_readfirstlane(tid >> 6), lane = tid & 63, wr = wid >> 2, wc = wid & 3, fr = lane & 15, fq = lane >> 4;
    const int K = g.K;
    unsigned voffA[2], voffB[2];
#pragma unroll
    for (int i = 0; i < 2; ++i) { int R, C; stage_rc(tid * 16 + i * 8192, R, C); const int Rb = Epi::PERM ? ((R & ~31) + perm32(R & 31)) : R;
        voffA[i] = (unsigned)(R * K + C) * 2u; voffB[i] = (unsigned)(Rb * K + C) * 2u; }
    const size_t kstep = (size_t)(BK * 2);
    const size_t hstep = (size_t)HALF * K * 2;
    const size_t tstep = 2 * hstep;
    const unsigned ldsw = (unsigned)wid * 1024u;
    const int aoff = lds_byte(wr * 64 + fr, fq * 8), boff = lds_byte(wc * 32 + fr, fq * 8);
#define PG8_SA(b, h) (((b) * 2 + (h)) * HTB)
#define PG8_SB(b, h) ((4 + (b) * 2 + (h)) * HTB)
#define PG8_STAGE(bufoff, gbase, voff) do { _Pragma("unroll") for (int _i = 0; _i < 2; ++_i) \
        __builtin_amdgcn_global_load_lds((const unsigned*)((const char*)(gbase) + (voff)[_i]), (PG8_LAS unsigned*)(lds + (bufoff) + ldsw + _i * 8192), 16, 0, 0); } while (0)
#define PG8_LDA(dst, b, h) do { _Pragma("unroll") for (int m = 0; m < 4; ++m) _Pragma("unroll") for (int k = 0; k < 2; ++k) dst[m][k] = *(const PG8_LAS bf16x8*)(lds + PG8_SA(b, h) + aoff + m * 2048 + k * 1024); } while (0)
#define PG8_LDB(dst, b, h) do { _Pragma("unroll") for (int n = 0; n < 2; ++n) _Pragma("unroll") for (int k = 0; k < 2; ++k) dst[n][k] = *(const PG8_LAS bf16x8*)(lds + PG8_SB(b, h) + boff + n * 2048 + k * 1024); } while (0)
#define PG8_MMA(ai, bj, At, Bt) do { __builtin_amdgcn_s_setprio(1); _Pragma("unroll") for (int m = 0; m < 4; ++m) _Pragma("unroll") for (int n = 0; n < 2; ++n) _Pragma("unroll") for (int k = 0; k < 2; ++k) \
        acc[ai][bj][m][n] = __builtin_amdgcn_mfma_f32_16x16x32_bf16(Bt[n][k], At[m][k], acc[ai][bj][m][n], 0, 0, 0); __builtin_amdgcn_s_setprio(0); } while (0)
#define PG8_WAIT_V(n) asm volatile("s_waitcnt vmcnt(" #n ")" ::: "memory")
#define PG8_WAIT_L(n) asm volatile("s_waitcnt lgkmcnt(" #n ")" ::: "memory")
#define PG8_BAR __builtin_amdgcn_s_barrier()
#define PG8_SCHED __builtin_amdgcn_sched_barrier(0)
    Unit cur, nxt; int ui = 0;
    if (!S.next(0, cur)) return;
    f32x4 acc[2][2][4][2];
#pragma unroll
    for (int a = 0; a < 2; ++a)
#pragma unroll
        for (int b = 0; b < 2; ++b)
#pragma unroll
            for (int m = 0; m < 4; ++m)
#pragma unroll
                for (int n = 0; n < 2; ++n) acc[a][b][m][n] = (f32x4){0.f, 0.f, 0.f, 0.f};
    bf16x8 At[4][2], B0[2][2], B1[2][2];
    const char* cA = (const char*)g.A + (size_t)cur.pm * tstep + (size_t)cur.kt0 * kstep; const char* cB = (const char*)g.Bt + (size_t)cur.pn * tstep + (size_t)cur.kt0 * kstep;
    S.a_ready(cur);
    if constexpr (SP2) {
        PG8_STAGE(PG8_SB(0, 0), cB, voffB); PG8_STAGE(PG8_SB(0, 1), cB + hstep, voffB); PG8_STAGE(PG8_SA(0, 0), cA, voffA); PG8_STAGE(PG8_SA(0, 1), cA + hstep, voffA);
        if (wr == 1) PG8_BAR;
        PG8_WAIT_V(2); PG8_BAR;
        PG8_STAGE(PG8_SB(1, 0), cB + kstep, voffB); PG8_STAGE(PG8_SA(1, 0), cA + kstep, voffA); PG8_STAGE(PG8_SB(1, 1), cB + hstep + kstep, voffB);
        PG8_WAIT_V(6); PG8_BAR;
    } else {
        PG8_STAGE(PG8_SB(0, 0), cB, voffB); PG8_STAGE(PG8_SA(0, 0), cA, voffA); PG8_STAGE(PG8_SB(0, 1), cB + hstep, voffB); PG8_STAGE(PG8_SA(0, 1), cA + hstep, voffA);
        if (wr == 1) PG8_BAR;
        PG8_WAIT_V(4); PG8_BAR;
        PG8_STAGE(PG8_SB(1, 0), cB + kstep, voffB); PG8_STAGE(PG8_SA(1, 0), cA + kstep, voffA); PG8_STAGE(PG8_SB(1, 1), cB + hstep + kstep, voffB);
        PG8_WAIT_V(6); PG8_BAR;
    }
    for (;;) {
        const bool has_next = S.next(ui + 1, nxt);
        const char* nA = has_next ? (const char*)g.A + (size_t)nxt.pm * tstep + (size_t)nxt.kt0 * kstep : cA; const char* nB = has_next ? (const char*)g.Bt + (size_t)nxt.pn * tstep + (size_t)nxt.kt0 * kstep : cB;
        const int nt = cur.nkt;
        for (int t = 0; t < nt; t += 2) {
            const bool last = (t == nt - 2);
            const char* a1 = cA + (size_t)(t + 1) * kstep;
            const char* a2 = last ? nA : cA + (size_t)(t + 2) * kstep; const char* b2 = last ? nB : cB + (size_t)(t + 2) * kstep;
            const char* a3 = a2 + kstep; const char* b3 = b2 + kstep;
            if (last && has_next) S.a_ready(nxt);
            if constexpr (SP2) {
            PG8_LDB(B0, 0, 0); PG8_LDB(B1, 0, 1); PG8_SCHED; PG8_LDA(At, 0, 0); PG8_STAGE(PG8_SA(1, 1), a1 + hstep, voffA);
            PG8_WAIT_V(8); PG8_WAIT_L(0); PG8_BAR; PG8_MMA(0, 0, At, B0); PG8_MMA(0, 1, At, B1); PG8_BAR; PG8_SCHED;
            PG8_LDA(At, 0, 1); PG8_STAGE(PG8_SB(0, 0), b2, voffB); PG8_STAGE(PG8_SB(0, 1), b2 + hstep, voffB); PG8_STAGE(PG8_SA(0, 0), a2, voffA);
            PG8_WAIT_V(8); PG8_WAIT_L(0); PG8_BAR; PG8_MMA(1, 0, At, B0); PG8_MMA(1, 1, At, B1); PG8_BAR; PG8_SCHED;
            PG8_LDB(B0, 1, 0); PG8_LDB(B1, 1, 1); PG8_SCHED; PG8_LDA(At, 1, 0); PG8_STAGE(PG8_SA(0, 1), a2 + hstep, voffA);
            PG8_WAIT_V(8); PG8_WAIT_L(0); PG8_BAR; PG8_MMA(0, 0, At, B0); PG8_MMA(0, 1, At, B1); PG8_BAR; PG8_SCHED;
            PG8_LDA(At, 1, 1); PG8_STAGE(PG8_SB(1, 0), b3, voffB); PG8_STAGE(PG8_SB(1, 1), b3 + hstep, voffB); PG8_STAGE(PG8_SA(1, 0), a3, voffA);
            PG8_WAIT_V(8); PG8_WAIT_L(0); PG8_BAR; PG8_MMA(1, 0, At, B0); PG8_MMA(1, 1, At, B1); PG8_BAR; PG8_SCHED;
            } else {
            PG8_LDB(B0, 0, 0); PG8_SCHED; PG8_LDA(At, 0, 0); PG8_STAGE(PG8_SA(1, 1), a1 + hstep, voffA);
            PG8_WAIT_L(8); PG8_BAR; PG8_WAIT_L(0); PG8_MMA(0, 0, At, B0); PG8_BAR; PG8_SCHED;
            PG8_LDB(B1, 0, 1); PG8_STAGE(PG8_SB(0, 0), b2, voffB);
            PG8_BAR; PG8_WAIT_L(0); PG8_MMA(0, 1, At, B1); PG8_BAR;
            PG8_LDA(At, 0, 1); PG8_STAGE(PG8_SA(0, 0), a2, voffA);
            PG8_BAR; PG8_WAIT_L(0); PG8_MMA(1, 0, At, B0); PG8_BAR; PG8_SCHED;
            PG8_STAGE(PG8_SB(0, 1), b2 + hstep, voffB);
            PG8_WAIT_V(6); PG8_BAR; PG8_MMA(1, 1, At, B1); PG8_BAR;
            PG8_LDB(B0, 1, 0); PG8_SCHED; PG8_LDA(At, 1, 0); PG8_STAGE(PG8_SA(0, 1), a2 + hstep, voffA);
            PG8_WAIT_L(8); PG8_BAR; PG8_WAIT_L(0); PG8_MMA(0, 0, At, B0); PG8_BAR; PG8_SCHED;
            PG8_LDB(B1, 1, 1); PG8_STAGE(PG8_SB(1, 0), b3, voffB);
            PG8_BAR; PG8_WAIT_L(0); PG8_MMA(0, 1, At, B1); PG8_BAR;
            PG8_LDA(At, 1, 1); PG8_STAGE(PG8_SA(1, 0), a3, voffA);
            PG8_BAR; PG8_WAIT_L(0); PG8_MMA(1, 0, At, B0); PG8_BAR; PG8_SCHED;
            PG8_STAGE(PG8_SB(1, 1), b3 + hstep, voffB);
            PG8_WAIT_V(6); PG8_BAR; PG8_MMA(1, 1, At, B1); PG8_BAR;
            }
        }
        if constexpr (ALIGN_EPI) { if (wr == 0) PG8_BAR; }
        if constexpr (!Epi::AFTER_DRAIN) { E(acc, cur, wr, wc, fr, fq); S.done(cur); }
        if (!has_next) break;
#pragma unroll
        for (int a = 0; a < 2; ++a)
#pragma unroll
            for (int b = 0; b < 2; ++b)
#pragma unroll
                for (int m = 0; m < 4; ++m)
#pragma unroll
                    for (int n = 0; n < 2; ++n) acc[a][b][m][n] = (f32x4){0.f, 0.f, 0.f, 0.f};
        cur = nxt; cA = nA; cB = nB; ++ui;
        if constexpr (ALIGN_EPI) { if (wr == 1) PG8_BAR; }
    }
    PG8_WAIT_V(0);
    if constexpr (!ALIGN_EPI) { if (wr == 0) PG8_BAR; }
    PG8_BAR;
    if constexpr (Epi::AFTER_DRAIN) { E.fused(acc, cur, wr, wc, fr, fq, lds, wid, lane); S.done(cur); }
#undef PG8_SA
#undef PG8_SB
#undef PG8_STAGE
#undef PG8_LDA
#undef PG8_LDB
#undef PG8_MMA
#undef PG8_WAIT_V
#undef PG8_WAIT_L
#undef PG8_BAR
#undef PG8_SCHED
}
}
namespace att {
typedef unsigned short bf16;
constexpr int NW = 8, QBLK = 32, KVBLK = 64;
constexpr float SCALE = 0.07216878364870322f;
constexpr float THR = 8.f;
constexpr int SDEPTH = 1;
constexpr int LDQ = 1792, LDK = 1792, LDR = 64, LDO = 1024;
constexpr int SHM_V = KVBLK * 128 * 2, SHM_K = KVBLK * 192 * 2, SHM_QR = NW * 4 * 64 * 16, SHM_ATTN = 2 * SHM_V + 2 * SHM_K + NW * 64 * 4 + SHM_QR;
using bf16x8 = __attribute__((ext_vector_type(8))) short;
using s16x4  = __attribute__((ext_vector_type(4))) short;
using f32x16 = __attribute__((ext_vector_type(16))) float;
using u32x4  = __attribute__((ext_vector_type(4))) unsigned;
#define KSWZ(row, colB) ((row) * 384 + ((colB) ^ ((((row) >> 1) & 7) << 4)))
#define SBAR() __builtin_amdgcn_sched_barrier(0)
__device__ __forceinline__ int crow(int r, int hi) { return (r & 3) + 8 * (r >> 2) + 4 * hi; }
__device__ __forceinline__ unsigned cvtpk(float lo, float hi) { unsigned r; asm volatile("v_cvt_pk_bf16_f32 %0, %1, %2" : "=v"(r) : "v"(lo), "v"(hi)); return r; }
__device__ __forceinline__ bf16x8 ld8(const bf16* p) { return *reinterpret_cast<const bf16x8*>(p); }
__device__ __forceinline__ float bf2f(short b) { return __uint_as_float(((unsigned)(unsigned short)b) << 16); }

__device__ __forceinline__ void partialSM(f32x16& p0, f32x16& p1, float& m_reg, float& mn, float& alpha) {
  constexpr float C = SCALE * 1.4426950408889634f;
  float pmax = p0[0];
#pragma unroll
  for (int r = 1; r < 16; ++r) pmax = fmaxf(pmax, p0[r]);
#pragma unroll
  for (int r = 0; r < 16; ++r) pmax = fmaxf(pmax, p1[r]);
  { auto rr = __builtin_amdgcn_permlane32_swap(__float_as_uint(pmax), __float_as_uint(pmax), false, false);
    pmax = fmaxf(__uint_as_float(rr[0]), __uint_as_float(rr[1])); }
  if (__builtin_expect(__all(pmax - m_reg <= THR / SCALE), 1)) { mn = m_reg; alpha = 1.f; }
  else { mn = fmaxf(m_reg, pmax); alpha = __builtin_amdgcn_exp2f((m_reg - mn) * C); m_reg = mn; }
  float mnC = -mn * C;
#pragma unroll
  for (int r = 0; r < 16; ++r) p0[r] = fmaf(p0[r], C, mnC);
#pragma unroll
  for (int r = 0; r < 16; ++r) p1[r] = fmaf(p1[r], C, mnC);
#pragma unroll
  for (int r = 0; r < 16; ++r) p0[r] = __builtin_amdgcn_exp2f(p0[r]);
}
__device__ __forceinline__ void finishSM(f32x16& p0, f32x16& p1, float alpha, float& l_reg, bf16x8& pa0, bf16x8& pa1, bf16x8& pa2, bf16x8& pa3) {
#pragma unroll
  for (int r = 0; r < 16; ++r) p1[r] = __builtin_amdgcn_exp2f(p1[r]);
  float ps = 0;
#pragma unroll
  for (int r = 0; r < 16; ++r) ps += p0[r];
#pragma unroll
  for (int r = 0; r < 16; ++r) ps += p1[r];
  { auto rr = __builtin_amdgcn_permlane32_swap(__float_as_uint(ps), __float_as_uint(ps), false, false);
    ps = __uint_as_float(rr[0]) + __uint_as_float(rr[1]); }
  l_reg = l_reg * alpha + ps;
#define PK4(P, BASE, OUT) do { unsigned a0 = cvtpk(P[BASE + 0], P[BASE + 1]), a1 = cvtpk(P[BASE + 2], P[BASE + 3]);   \
    unsigned b0 = cvtpk(P[BASE + 4], P[BASE + 5]), b1 = cvtpk(P[BASE + 6], P[BASE + 7]);                              \
    auto r0 = __builtin_amdgcn_permlane32_swap(a0, b0, false, false); auto r1 = __builtin_amdgcn_permlane32_swap(a1, b1, false, false); \
    u32x4 w = {r0[0], r1[0], r0[1], r1[1]}; OUT = *reinterpret_cast<bf16x8*>(&w); } while (0)
  PK4(p0, 0, pa0); PK4(p0, 8, pa1); PK4(p1, 0, pa2); PK4(p1, 8, pa3);
#undef PK4
}
__device__ __forceinline__ void qkt(f32x16& p0, f32x16& p1, const bf16* Ks, const bf16x8 (&qr)[8], const bf16x8* qrl, int r32, int hi) {
  p0 = f32x16{}; p1 = f32x16{};
#pragma unroll
  for (int d0 = 0; d0 < 12; ++d0) { int cb = (d0 * 16 + hi * 8) * 2;
    bf16x8 b0 = *reinterpret_cast<const bf16x8*>((const char*)Ks + KSWZ(r32, cb));
    bf16x8 b1 = *reinterpret_cast<const bf16x8*>((const char*)Ks + KSWZ(32 + r32, cb));
    const bf16x8 qf = d0 < 8 ? qr[d0 < 8 ? d0 : 0] : qrl[(d0 - 8) * 64];
    p0 = __builtin_amdgcn_mfma_f32_32x32x16_bf16(b0, qf, p0, 0, 0, 0);
    p1 = __builtin_amdgcn_mfma_f32_32x32x16_bf16(b1, qf, p1, 0, 0, 0); }
}
__device__ __forceinline__ int v_st(int k, int c) { const int kk = (k & ~0xC) | ((k & 4) << 1) | ((k & 8) >> 1); return ((kk >> 3) * 4 + (c >> 5)) * 512 + ((kk & 7) * 32 + (c & 31)) * 2; }
__device__ __forceinline__ int v_rd_base(int lane) { return ((lane & 3) << 3) | (((lane >> 2) & 3) << 6) | (((lane >> 4) & 1) << 5) | (((lane >> 5) & 1) << 8); }
constexpr int v_rd_off(int d0, int ks, int half) { return d0 * 512 + ks * 4096 + half * 2048; }
template <int OFF> __device__ __forceinline__ s16x4 tr_read(int vb) {
  s16x4 r; asm volatile("ds_read_b64_tr_b16 %0, %1 offset:%2" : "=&v"(r) : "v"(vb), "i"(OFF) : "memory"); return r;
}
template <int D0> __device__ __forceinline__ void pv_one(f32x16& od, int vb, bf16x8 pa0, bf16x8 pa1, bf16x8 pa2, bf16x8 pa3) {
  const s16x4 l0 = tr_read<v_rd_off(D0, 0, 0)>(vb), h0 = tr_read<v_rd_off(D0, 0, 1)>(vb), l1 = tr_read<v_rd_off(D0, 1, 0)>(vb), h1 = tr_read<v_rd_off(D0, 1, 1)>(vb);
  const s16x4 l2 = tr_read<v_rd_off(D0, 2, 0)>(vb), h2 = tr_read<v_rd_off(D0, 2, 1)>(vb), l3 = tr_read<v_rd_off(D0, 3, 0)>(vb), h3 = tr_read<v_rd_off(D0, 3, 1)>(vb);
  asm volatile("s_waitcnt lgkmcnt(0)" ::: "memory"); SBAR();
#define PK(L, H) (bf16x8){L[0], L[1], L[2], L[3], H[0], H[1], H[2], H[3]}
  od = __builtin_amdgcn_mfma_f32_32x32x16_bf16(pa0, PK(l0, h0), od, 0, 0, 0);
  od = __builtin_amdgcn_mfma_f32_32x32x16_bf16(pa1, PK(l1, h1), od, 0, 0, 0);
  od = __builtin_amdgcn_mfma_f32_32x32x16_bf16(pa2, PK(l2, h2), od, 0, 0, 0);
  od = __builtin_amdgcn_mfma_f32_32x32x16_bf16(pa3, PK(l3, h3), od, 0, 0, 0);
#undef PK
}
__device__ __forceinline__ void pv_d0(f32x16 (&o)[4], int vb, bf16x8 pa0, bf16x8 pa1, bf16x8 pa2, bf16x8 pa3) {
  pv_one<0>(o[0], vb, pa0, pa1, pa2, pa3); pv_one<1>(o[1], vb, pa0, pa1, pa2, pa3); pv_one<2>(o[2], vb, pa0, pa1, pa2, pa3); pv_one<3>(o[3], vb, pa0, pa1, pa2, pa3);
}
__device__ __forceinline__ void attn_body(const bf16* __restrict__ Qb, const bf16* __restrict__ Kn, const bf16* __restrict__ Vh, const bf16* __restrict__ Kr,
                                          bf16* __restrict__ Ob, int seq, int rope, int qtok0, const float* __restrict__ tab, char* lds,
                                          unsigned* __restrict__ xs, unsigned* __restrict__ cnt, const float* __restrict__ gain, int head) {
  int tid_ = threadIdx.x; asm volatile("" : "+v"(tid_));
  const int tid = tid_, wid = tid >> 6, lane = tid & 63, r32 = lane & 31, hi = lane >> 5;
  bf16* V_lds = (bf16*)lds; bf16* K_lds = (bf16*)(lds + 2 * SHM_V);
  float* ws = (float*)(lds + 2 * SHM_V + 2 * SHM_K) + wid * 64; float* li_l = ws; float* al_l = ws + 32;
  float m_reg = -1e30f, l_reg = 0; f32x16 o[4] = {}; bf16x8 qr[8]; bf16x8 qx[4];
  bf16x8* qrl = (bf16x8*)(lds + 2 * SHM_V + 2 * SHM_K + NW * 64 * 4) + wid * 256 + lane;
  const bf16* Qw = Qb + (long)(wid * QBLK + r32) * LDQ + hi * 8;
#pragma unroll
  for (int d0 = 0; d0 < 8; ++d0) qr[d0] = ld8(Qw + d0 * 16);
#pragma unroll
  for (int d0 = 0; d0 < 4; ++d0) qx[d0] = ld8(Qw + 128 + d0 * 16);
  if (rope) {
    const int tt = qtok0 + wid * QBLK + r32; const int prow = tt >> 6, pcol = tt & 63;
    const float* tr = tab + (prow * 16 + hi * 8) * 2; const float* tc = tab + (pcol * 16 + hi * 8) * 2;
    unsigned a1[4], a2[4], c1[4], c2[4];
#pragma unroll
    for (int j = 0; j < 8; j += 2) {
      float o1[2], o2[2], p1[2], p2[2];
#pragma unroll
      for (int e = 0; e < 2; ++e) {
        const float cr = tr[(j + e) * 2], sr_ = tr[(j + e) * 2 + 1], cc = tc[(j + e) * 2], sc_ = tc[(j + e) * 2 + 1];
        const float x1 = bf2f(qx[0][j + e]), x2 = bf2f(qx[1][j + e]), y1 = bf2f(qx[2][j + e]), y2 = bf2f(qx[3][j + e]);
        o1[e] = x1 * cr - x2 * sr_; o2[e] = x2 * cr + x1 * sr_; p1[e] = y1 * cc - y2 * sc_; p2[e] = y2 * cc + y1 * sc_; }
      a1[j >> 1] = cvtpk(o1[0], o1[1]); a2[j >> 1] = cvtpk(o2[0], o2[1]); c1[j >> 1] = cvtpk(p1[0], p1[1]); c2[j >> 1] = cvtpk(p2[0], p2[1]); }
    { u32x4 w = {a1[0], a1[1], a1[2], a1[3]}; qx[0] = *reinterpret_cast<bf16x8*>(&w); }
    { u32x4 w = {a2[0], a2[1], a2[2], a2[3]}; qx[1] = *reinterpret_cast<bf16x8*>(&w); }
    { u32x4 w = {c1[0], c1[1], c1[2], c1[3]}; qx[2] = *reinterpret_cast<bf16x8*>(&w); }
    { u32x4 w = {c2[0], c2[1], c2[2], c2[3]}; qx[3] = *reinterpret_cast<bf16x8*>(&w); }
  }
#pragma unroll
  for (int d0 = 0; d0 < 4; ++d0) qrl[d0 * 64] = qx[d0];
  const int sr = tid >> 4, sc = (tid & 15) * 8, vst0 = v_st(sr, sc), vst1 = v_st(32 + sr, sc);
  const int rr = tid >> 3, rc = (tid & 7) * 8;
  const int vb0 = (int)(uintptr_t)V_lds + v_rd_base(lane);
  struct { bf16x8 vs0, vs1, ks0, ks1, kr0; } sr_[SDEPTH];
#define SLOAD(i, k0) do { sr_[i].vs0 = ld8(&Vh[(long)((k0) + sr) * LDK + sc]); sr_[i].vs1 = ld8(&Vh[(long)((k0) + 32 + sr) * LDK + sc]); \
    sr_[i].ks0 = ld8(&Kn[(long)((k0) + sr) * LDK + sc]); sr_[i].ks1 = ld8(&Kn[(long)((k0) + 32 + sr) * LDK + sc]); sr_[i].kr0 = ld8(&Kr[(long)((k0) + rr) * LDR + rc]); } while (0)
#define SWRITE(b, i) do { *(bf16x8*)((char*)V_lds + (b) * SHM_V + vst0) = sr_[i].vs0;          \
    *(bf16x8*)((char*)V_lds + (b) * SHM_V + vst1) = sr_[i].vs1; int kc = sc * 2;               \
    *(bf16x8*)((char*)K_lds + (b) * SHM_K + KSWZ(sr, kc)) = sr_[i].ks0;                       \
    *(bf16x8*)((char*)K_lds + (b) * SHM_K + KSWZ(32 + sr, kc)) = sr_[i].ks1;                  \
    *(bf16x8*)((char*)K_lds + (b) * SHM_K + KSWZ(rr, 256 + rc * 2)) = sr_[i].kr0; } while (0)
#define SWAIT() do { if constexpr (SDEPTH == 2) asm volatile("s_waitcnt vmcnt(5)" ::: "memory"); else asm volatile("s_waitcnt vmcnt(0)" ::: "memory"); } while (0)
#define RESC(a) do { if (__any((a) < 1.f)) { if (hi == 0) al_l[r32] = (a); asm volatile("s_waitcnt lgkmcnt(0)" ::: "memory"); \
    _Pragma("unroll") for (int d = 0; d < 4; ++d) _Pragma("unroll") for (int r = 0; r < 16; ++r) o[d][r] *= al_l[crow(r, hi)]; } } while (0)
  f32x16 pA0, pA1, pB0, pB1; float mnA, mnB, alA, alB; bf16x8 pa0, pa1, pa2, pa3; const int NT = seq / KVBLK;
  constexpr int SE = 0, SO = SDEPTH - 1;
  SLOAD(SE, 0); asm volatile("s_waitcnt vmcnt(0)" ::: "memory"); SWRITE(0, SE); __syncthreads();
  qkt(pA0, pA1, K_lds, qr, qrl, r32, hi); partialSM(pA0, pA1, m_reg, mnA, alA);
  SLOAD(SO, KVBLK); if constexpr (SDEPTH == 2) { if (2 < NT) SLOAD(SE, 2 * KVBLK); }
  SWAIT(); SWRITE(1, SO); __syncthreads();
  for (int j = 1; j + 1 < NT; j += 2) {
    SBAR(); qkt(pB0, pB1, (bf16*)((char*)K_lds + SHM_K), qr, qrl, r32, hi);
    finishSM(pA0, pA1, alA, l_reg, pa0, pa1, pa2, pa3); SBAR();
    SLOAD(SO, (j + SDEPTH) * KVBLK); SBAR();
    pv_d0(o, vb0, pa0, pa1, pa2, pa3); partialSM(pB0, pB1, m_reg, mnB, alB);
    __syncthreads(); SWAIT(); SWRITE(0, SE);
    RESC(alB); __syncthreads();
    SBAR(); qkt(pA0, pA1, K_lds, qr, qrl, r32, hi);
    finishSM(pB0, pB1, alB, l_reg, pa0, pa1, pa2, pa3); SBAR();
    if (SDEPTH == 1 || j + 3 < NT) SLOAD(SE, (j + 1 + SDEPTH) * KVBLK); SBAR();
    pv_d0(o, vb0 + (int)SHM_V, pa0, pa1, pa2, pa3); partialSM(pA0, pA1, m_reg, mnA, alA);
    __syncthreads(); SWAIT(); SWRITE(1, SO);
    RESC(alA); __syncthreads();
  }
  SBAR(); qkt(pB0, pB1, (bf16*)((char*)K_lds + SHM_K), qr, qrl, r32, hi);
  finishSM(pA0, pA1, alA, l_reg, pa0, pa1, pa2, pa3); SBAR();
  pv_d0(o, vb0, pa0, pa1, pa2, pa3); partialSM(pB0, pB1, m_reg, mnB, alB);
  __syncthreads(); RESC(alB);
  finishSM(pB0, pB1, alB, l_reg, pa0, pa1, pa2, pa3); SBAR();
  pv_d0(o, vb0 + (int)SHM_V, pa0, pa1, pa2, pa3);
  if (hi == 0) li_l[r32] = l_reg; asm volatile("s_waitcnt lgkmcnt(0)" ::: "memory");
  float rli[16];
#pragma unroll
  for (int r = 0; r < 16; ++r) rli[r] = __builtin_amdgcn_rcpf(li_l[crow(r, hi)]);
  float rs[16];
#pragma unroll
  for (int r = 0; r < 16; ++r) { float s = 0.f;
#pragma unroll
    for (int d0 = 0; d0 < 4; ++d0) { o[d0][r] *= rli[r]; s += o[d0][r] * o[d0][r]; }
    rs[r] = s; }
#pragma unroll
  for (int x = 1; x < 32; x <<= 1)
#pragma unroll
    for (int r = 0; r < 16; ++r) rs[r] += __shfl_xor(rs[r], x);
  asm volatile("s_waitcnt lgkmcnt(0)" ::: "memory");
  if (r32 == 0) {
#pragma unroll
    for (int r = 0; r < 16; ++r) al_l[crow(r, hi)] = rs[r]; }
  asm volatile("s_waitcnt lgkmcnt(0)" ::: "memory");
  if (lane < 32) __hip_atomic_store(xs + (size_t)(wid * QBLK + lane) * 4 + head, __float_as_uint(al_l[lane]), __ATOMIC_RELAXED, __HIP_MEMORY_SCOPE_AGENT);
  asm volatile("s_waitcnt vmcnt(0)" ::: "memory");
  if (lane == 0) __hip_atomic_fetch_add(cnt, 1u, __ATOMIC_RELAXED, __HIP_MEMORY_SCOPE_AGENT);
  if (wid == 0) { unsigned sp = 0;
    while ((unsigned)__builtin_amdgcn_readfirstlane(__hip_atomic_load(cnt, __ATOMIC_RELAXED, __HIP_MEMORY_SCOPE_AGENT)) < 32u) { __builtin_amdgcn_s_sleep(2); if (++sp > (1u << 22)) break; }
    __builtin_amdgcn_fence(__ATOMIC_ACQUIRE, "agent"); }
  asm volatile("s_waitcnt vmcnt(0) lgkmcnt(0)" ::: "memory"); __syncthreads();
  if (lane < 32) { const unsigned* sl = xs + (size_t)(wid * QBLK + lane) * 4; float t = 0.f;
#pragma unroll
    for (int q = 0; q < 4; ++q) t += __uint_as_float(__hip_atomic_load(sl + q, __ATOMIC_RELAXED, __HIP_MEMORY_SCOPE_AGENT));
    li_l[lane] = 1.0f / sqrtf(t * (1.0f / 512.0f) + 1e-6f); }
  asm volatile("s_waitcnt lgkmcnt(0)" ::: "memory");
  float g4[4];
#pragma unroll
  for (int d0 = 0; d0 < 4; ++d0) g4[d0] = gain[d0 * 32 + r32];
  char* Ol = lds + wid * 8704;
#pragma unroll
  for (int r = 0; r < 16; ++r) { const int orow = crow(r, hi); const float rn = li_l[orow];
#pragma unroll
    for (int d0 = 0; d0 < 4; ++d0) { const float v = o[d0][r] * rn * g4[d0]; *(bf16*)(Ol + orow * 272 + (d0 * 32 + r32) * 2) = (bf16)(cvtpk(v, v) & 0xffffu); } }
  asm volatile("s_waitcnt lgkmcnt(0)" ::: "memory");
  bf16* Ow = Ob + (long)(wid * QBLK) * LDO;
#pragma unroll
  for (int i = 0; i < 8; i += 2) { const int row = (lane >> 4) + 4 * i, c16 = lane & 15;
    const u32x4 w0 = *reinterpret_cast<const u32x4*>(Ol + row * 272 + c16 * 16), w1 = *reinterpret_cast<const u32x4*>(Ol + (row + 4) * 272 + c16 * 16);
    *reinterpret_cast<u32x4*>(Ow + (long)row * LDO + c16 * 8) = w0; *reinterpret_cast<u32x4*>(Ow + (long)(row + 4) * LDO + c16 * 8) = w1;
    asm volatile("" ::: "memory"); }
  __syncthreads();
#undef SLOAD
#undef SWRITE
#undef SWAIT
#undef RESC
}
#undef KSWZ
#undef SBAR
}

namespace ml {
using att::bf16; using att::bf16x8; using att::s16x4; using att::f32x16; using att::u32x4;
typedef float f32x4 __attribute__((ext_vector_type(4)));
using att::crow;
__device__ __forceinline__ unsigned cvtpk(float lo, float hi) { unsigned r; asm("v_cvt_pk_bf16_f32 %0, %1, %2" : "=v"(r) : "v"(lo), "v"(hi)); return r; }
 using att::ld8; using att::bf2f; using att::v_st; using att::v_rd_base; using att::v_rd_off;
constexpr int TBr = 4352, CTXr = 256, SEQr = 4096;
constexpr float LOG2E = 1.4426950408889634f;
constexpr int TSTRIDE = 32 * 17 * 256;
#define MLAS __attribute__((address_space(3)))
__device__ __forceinline__ float log_sigmoid_f(float x) {
    const float t = __expf(-fabsf(x));
    const float l1p = t < 0.03f ? t * (1.0f - t * (0.5f - t * (0.33333334f - 0.25f * t))) : __logf(1.0f + t);
    return fminf(x, 0.f) - l1p;
}
template <int OFF> __device__ __forceinline__ s16x4 trr(int vb) { s16x4 r; asm volatile("ds_read_b64_tr_b16 %0, %1 offset:%2" : "=&v"(r) : "v"(vb), "i"(OFF) : "memory"); return r; }
#define MLPK(L, H) (bf16x8){L[0], L[1], L[2], L[3], H[0], H[1], H[2], H[3]}
__device__ __forceinline__ void unit_rows(int b, int dir, int j, int& rb, int& sg) {
    if (dir == 0) { rb = b * TBr + 256 * j; sg = 1; }
    else { rb = (j == 0) ? b * TBr + 255 : b * TBr + TBr - 1 - 256 * (j - 1); sg = -1; }
}
struct Conv8 { float w0[8], w1[8], w2[8], bb[8]; };
__device__ __forceinline__ void conv8_load(Conv8& cp, const float* __restrict__ cw, const float* __restrict__ cb, int c) {
#pragma unroll
    for (int j = 0; j < 8; ++j) { cp.w0[j] = cw[c + j]; cp.w1[j] = cw[1024 + c + j]; cp.w2[j] = cw[2048 + c + j]; cp.bb[j] = cb[c + j]; }
}
__device__ __forceinline__ void conv8x8(const bf16* __restrict__ P, int r0, int sg, int sr, int c, const Conv8& cp, float scale, bf16x8 (&out)[8]) {
    bf16x8 x0[8], xm[8], xp[8]; float fm[8], fp[8];
#pragma unroll
    for (int g = 0; g < 8; ++g) { const int r = r0 + sg * (32 * g + sr); const int t = r % TBr; const bool hp = (t != 0) && (t != CTXr), hn = (t != CTXr - 1) && (t != TBr - 1);
        const bf16* p = P + (size_t)r * 2560 + 448 + c; x0[g] = ld8(p); xm[g] = ld8(hp ? p - 2560 : p); xp[g] = ld8(hn ? p + 2560 : p); fm[g] = hp ? 1.0f : 0.0f; fp[g] = hn ? 1.0f : 0.0f; }
    asm volatile("" ::: "memory");
#pragma unroll
    for (int g = 0; g < 8; ++g) { float u[8];
#pragma unroll
        for (int j = 0; j < 8; ++j) { const float a = cp.w0[j] * fm[g] * bf2f(xm[g][j]) + cp.w1[j] * bf2f(x0[g][j]) + cp.w2[j] * fp[g] * bf2f(xp[g][j]) + cp.bb[j];
            u[j] = a * __builtin_amdgcn_rcpf(1.0f + __builtin_amdgcn_exp2f(-LOG2E * a)) * scale; }
        u32x4 o = {cvtpk(u[0], u[1]), cvtpk(u[2], u[3]), cvtpk(u[4], u[5]), cvtpk(u[6], u[7])};
        out[g] = *reinterpret_cast<bf16x8*>(&o); }
}
__device__ __forceinline__ void conv_rows_load(const bf16* __restrict__ P, int R0, int c, bf16x8 (&x)[10]) {
    const int t0 = R0 % TBr; const bool hp0 = (t0 != 0) && (t0 != CTXr); const int t7 = t0 + 7; const bool hn7 = (t7 != CTXr - 1) && (t7 != TBr - 1);
    const bf16* p = P + (size_t)R0 * 2560 + 448 + c;
    x[0] = ld8(hp0 ? p - 2560 : p);
#pragma unroll
    for (int g = 0; g < 8; ++g) x[1 + g] = ld8(p + (size_t)g * 2560);
    x[9] = ld8(hn7 ? p + (size_t)8 * 2560 : p + (size_t)7 * 2560);
}
__device__ __forceinline__ void conv_rows_compute(const bf16x8 (&x)[10], int R0, const Conv8& cp, float scale, bf16x8 (&out)[8]) {
    const int t0 = R0 % TBr;
#pragma unroll
    for (int g = 0; g < 8; ++g) { const int t = t0 + g; const float fm = ((t != 0) && (t != CTXr)) ? 1.0f : 0.0f, fp = ((t != CTXr - 1) && (t != TBr - 1)) ? 1.0f : 0.0f; float u[8];
#pragma unroll
        for (int j = 0; j < 8; ++j) { const float a = cp.w0[j] * fm * bf2f(x[g][j]) + cp.w1[j] * bf2f(x[g + 1][j]) + cp.w2[j] * fp * bf2f(x[g + 2][j]) + cp.bb[j];
            u[j] = a * __builtin_amdgcn_rcpf(1.0f + __builtin_amdgcn_exp2f(-LOG2E * a)) * scale; }
        u32x4 o = {cvtpk(u[0], u[1]), cvtpk(u[2], u[3]), cvtpk(u[4], u[5]), cvtpk(u[6], u[7])};
        out[g] = *reinterpret_cast<bf16x8*>(&o); }
}
__device__ __forceinline__ void gate_scan_task(const float* __restrict__ G, const float* __restrict__ gate_b, float* __restrict__ T, float* __restrict__ sca, int task, int lane) {
    const int seq = task / 17, j = task - seq * 17, b = seq >> 3, h = (seq >> 1) & 3, dir = seq & 1;
    int rb, sg; unit_rows(b, dir, j, rb, sg);
    const int gi = (2 * dir) * 4 + h, gf = (2 * dir + 1) * 4 + h; const float ib = gate_b[gi], fb = gate_b[gf];
    float igv[4], fgv[4];
#pragma unroll
    for (int rnd = 0; rnd < 4; ++rnd) { const size_t r = (size_t)(rb + sg * (64 * rnd + lane)); igv[rnd] = G[r * 16 + gi] + ib; fgv[rnd] = G[r * 16 + gf] + fb; }
    float cb = 0.f, cpm = -3.0e38f; float* Tb = T + (size_t)task * 256;
#pragma unroll
    for (int rnd = 0; rnd < 4; ++rnd) { const int i = 64 * rnd + lane;
        float bc = log_sigmoid_f(fgv[rnd]);
#pragma unroll
        for (int o = 1; o < 64; o <<= 1) { const float t_ = __shfl_up(bc, o); if (lane >= o) bc += t_; }
        bc += cb;
        const float al = igv[rnd] - bc; float pm = al;
#pragma unroll
        for (int o = 1; o < 64; o <<= 1) { const float t_ = __shfl_up(pm, o); if (lane >= o) pm = fmaxf(pm, t_); }
        pm = fmaxf(pm, cpm);
        Tb[i] = bc; Tb[TSTRIDE + i] = al; Tb[2 * TSTRIDE + i] = pm;
        cb = __shfl(bc, 63); cpm = __shfl(pm, 63); }
    if (j < 16 && lane == 0) { sca[(seq * 16 + j) * 2] = cpm; sca[(seq * 16 + j) * 2 + 1] = cb; }
}
__device__ __forceinline__ void mlstm_local(const bf16* __restrict__ P, const float* __restrict__ T, const float* __restrict__ cw, const float* __restrict__ cbias,
                                            float* __restrict__ Cloc, float* __restrict__ nloc, int unit, char* lds) {
    int tid_ = threadIdx.x; asm volatile("" : "+v"(tid_));
    const int tid = tid_, wid = tid >> 6, lane = tid & 63, r32 = lane & 31, hi = lane >> 5;
    const int seq = unit >> 4, j = unit & 15, b = seq >> 3, h = (seq >> 1) & 3, dir = seq & 1;
    int rb, sg; unit_rows(b, dir, j, rb, sg);
    const float* Tal = T + TSTRIDE + (size_t)(seq * 17 + j) * 256; const float mlm = T[2 * TSTRIDE + (size_t)(seq * 17 + j) * 256 + 255];
    float* npart = (float*)(lds + 131072);
    const int sr = tid >> 4, sc = (tid & 15) * 8;
    float wv[8]; bf16x8 vreg[8];
#pragma unroll
    for (int g = 0; g < 8; ++g) { const int i = 32 * g + sr; wv[g] = Tal[i]; vreg[g] = ld8(P + (size_t)(rb + sg * i) * 2560 + 1472 + h * 128 + sc); }
    asm volatile("" ::: "memory");
    float nacc[8] = {0.f, 0.f, 0.f, 0.f, 0.f, 0.f, 0.f, 0.f};
    {
        const int R0 = sg > 0 ? rb + 8 * sr : rb - 8 * sr - 7;
        bf16x8 xk[10]; conv_rows_load(P, R0, 512 + h * 128 + sc, xk); float wk[8];
#pragma unroll
        for (int g = 0; g < 8; ++g) wk[g] = Tal[8 * sr + g];
        asm volatile("" ::: "memory");
        Conv8 cp; conv8_load(cp, cw, cbias, 512 + h * 128 + sc); bf16x8 kv[8]; conv_rows_compute(xk, R0, cp, 0.08838834764831845f, kv);
#pragma unroll
        for (int g = 0; g < 8; ++g) { const int i = 8 * sr + g; const bf16x8 kr = sg > 0 ? kv[g] : kv[7 - g];
            *(bf16x8*)(lds + (i >> 6) * 16384 + v_st(i & 63, sc)) = kr; const float w = __expf(wk[g] - mlm);
#pragma unroll
            for (int x = 0; x < 8; ++x) nacc[x] += w * bf2f(kr[x]); } }
#pragma unroll
    for (int g = 0; g < 8; ++g) wv[g] = __expf(wv[g] - mlm);
#pragma unroll
    for (int g = 0; g < 8; ++g) { const int i = 32 * g + sr; const float w = wv[g]; const bf16x8 v = vreg[g];
        u32x4 o = {cvtpk(bf2f(v[0]) * w, bf2f(v[1]) * w), cvtpk(bf2f(v[2]) * w, bf2f(v[3]) * w), cvtpk(bf2f(v[4]) * w, bf2f(v[5]) * w), cvtpk(bf2f(v[6]) * w, bf2f(v[7]) * w)};
        *(u32x4*)(lds + 65536 + (i >> 6) * 16384 + v_st(i & 63, sc)) = o; }
#pragma unroll
    for (int x = 0; x < 8; ++x) { nacc[x] += __shfl_xor(nacc[x], 16); nacc[x] += __shfl_xor(nacc[x], 32); }
    if (lane < 16) {
#pragma unroll
        for (int x = 0; x < 8; ++x) npart[wid * 128 + sc + x] = nacc[x]; }
    __syncthreads();
    const int db = wid >> 1, eb0 = 2 * (wid & 1);
    const int vbK = (int)(uintptr_t)lds + v_rd_base(lane) + db * 512, vbV = (int)(uintptr_t)lds + 65536 + v_rd_base(lane) + eb0 * 512;
    f32x16 c0 = {}, c1 = {};
#define MLA_STEP(TL, KS) do { const s16x4 al_ = trr<(TL) * 16384 + v_rd_off(0, KS, 0)>(vbK), ah_ = trr<(TL) * 16384 + v_rd_off(0, KS, 1)>(vbK); \
        const s16x4 bl0 = trr<(TL) * 16384 + v_rd_off(0, KS, 0)>(vbV), bh0 = trr<(TL) * 16384 + v_rd_off(0, KS, 1)>(vbV), bl1 = trr<(TL) * 16384 + v_rd_off(1, KS, 0)>(vbV), bh1 = trr<(TL) * 16384 + v_rd_off(1, KS, 1)>(vbV); \
        asm volatile("s_waitcnt lgkmcnt(0)" ::: "memory"); __builtin_amdgcn_sched_barrier(0); \
        c0 = __builtin_amdgcn_mfma_f32_32x32x16_bf16(MLPK(al_, ah_), MLPK(bl0, bh0), c0, 0, 0, 0); c1 = __builtin_amdgcn_mfma_f32_32x32x16_bf16(MLPK(al_, ah_), MLPK(bl1, bh1), c1, 0, 0, 0); } while (0)
#define MLA_TILE(TL) do { MLA_STEP(TL, 0); MLA_STEP(TL, 1); MLA_STEP(TL, 2); MLA_STEP(TL, 3); } while (0)
    MLA_TILE(0); MLA_TILE(1); MLA_TILE(2); MLA_TILE(3);
#undef MLA_TILE
#undef MLA_STEP
    float* Co = Cloc + (size_t)unit * 16384;
#pragma unroll
    for (int r = 0; r < 16; ++r) { const int d = db * 32 + crow(r, hi); Co[d * 128 + eb0 * 32 + r32] = c0[r]; Co[d * 128 + eb0 * 32 + 32 + r32] = c1[r]; }
    if (tid < 128) { float s = 0.f;
#pragma unroll
        for (int w = 0; w < 8; ++w) s += npart[w * 128 + tid];
        nloc[unit * 128 + tid] = s; }
    __syncthreads();
}
__device__ __forceinline__ void mlstm_scan(const float* __restrict__ Cloc, const float* __restrict__ nloc, const float* __restrict__ sca, bf16* __restrict__ CstT, float* __restrict__ nst, float* __restrict__ bm, int gtid, int gthreads) {
    for (int item = gtid; item < 32 * 2048; item += gthreads) {
        const int seq = item >> 11, rem = item & 2047, e = rem & 127, dg = rem >> 7;
        float st[8] = {0.f, 0.f, 0.f, 0.f, 0.f, 0.f, 0.f, 0.f}; float nv = 0.f, Bst = 0.f, Mst = 0.f;
        asm volatile("" : "+v"(Bst), "+v"(Mst));
        const float* Cl0 = Cloc + (size_t)(seq * 16) * 16384 + (dg * 8) * 128 + e;
        for (int half = 0; half < 2; ++half) {
            float cl[8][8], nlv[8], mlv[8], blv[8];
#pragma unroll
            for (int jj = 0; jj < 8; ++jj) { const int lu = seq * 16 + half * 8 + jj;
#pragma unroll
                for (int i = 0; i < 8; ++i) cl[jj][i] = Cl0[(size_t)(half * 8 + jj) * 16384 + i * 128];
                nlv[jj] = nloc[lu * 128 + e]; mlv[jj] = sca[lu * 2]; blv[jj] = sca[lu * 2 + 1]; }
#pragma unroll
            for (int jj = 0; jj < 8; ++jj) { const int j = half * 8 + jj; const size_t su = (size_t)seq * 17 + j;
                u32x4 o = {cvtpk(st[0], st[1]), cvtpk(st[2], st[3]), cvtpk(st[4], st[5]), cvtpk(st[6], st[7])};
                *(u32x4*)(CstT + su * 16384 + e * 128 + dg * 8) = o;
                if (dg == 0) { nst[su * 128 + e] = nv; if (e == 0) { bm[su * 2] = Bst; bm[su * 2 + 1] = Mst; } }
                const float Mend = fmaxf(Mst, mlv[jj] - Bst), fa = __expf(Mst - Mend), fbv = __expf(mlv[jj] - Bst - Mend);
#pragma unroll
                for (int i = 0; i < 8; ++i) st[i] = fa * st[i] + fbv * cl[jj][i];
                nv = fa * nv + fbv * nlv[jj];
                Bst += blv[jj]; Mst = Mend; }
        }
        { const size_t su = (size_t)seq * 17 + 16;
          u32x4 o = {cvtpk(st[0], st[1]), cvtpk(st[2], st[3]), cvtpk(st[4], st[5]), cvtpk(st[6], st[7])};
          *(u32x4*)(CstT + su * 16384 + e * 128 + dg * 8) = o;
          if (dg == 0) { nst[su * 128 + e] = nv; if (e == 0) { bm[su * 2] = Bst; bm[su * 2 + 1] = Mst; } } }
    }
}
#define KSW(row, colB) ((row) * 256 + ((colB) ^ (((row) & 15) << 4)))
template <int D0, int KS> __device__ __forceinline__ void pv_pair(f32x16& od, int vb, bf16x8 pa, bf16x8 pb) {
    const s16x4 l0 = trr<v_rd_off(D0, KS, 0)>(vb), h0 = trr<v_rd_off(D0, KS, 1)>(vb), l1 = trr<v_rd_off(D0, KS + 1, 0)>(vb), h1 = trr<v_rd_off(D0, KS + 1, 1)>(vb);
    asm volatile("s_waitcnt lgkmcnt(0)" ::: "memory"); __builtin_amdgcn_sched_barrier(0);
    od = __builtin_amdgcn_mfma_f32_32x32x16_bf16(pa, MLPK(l0, h0), od, 0, 0, 0);
    od = __builtin_amdgcn_mfma_f32_32x32x16_bf16(pb, MLPK(l1, h1), od, 0, 0, 0);
}
__device__ __forceinline__ void mlstm_out2(const bf16* __restrict__ P, const float* __restrict__ T, const float* __restrict__ cw, const float* __restrict__ cbias, const bf16* __restrict__ CstT, const float* __restrict__ nst,
                                           const float* __restrict__ bm, const float* __restrict__ mnorm, bf16* __restrict__ MIX, int b, int h, int tb, char* lds) {
    int tid_ = threadIdx.x; asm volatile("" : "+v"(tid_));
    const int tid = tid_, wid = tid >> 6, lane = tid & 63, r32 = lane & 31, hi = lane >> 5;
    const int seqf = b * 8 + h * 2, seqb = seqf + 1; const int jb = tb == 0 ? 0 : 17 - tb; const bool zs = (tb == 0);
    const size_t suf = (size_t)seqf * 17 + tb, sub = (size_t)seqb * 17 + jb;
    const int rb = b * TBr + 256 * tb;
    float* tabs = (float*)(lds + 131072);
    float* nlf = tabs + 2048; float* nlb = tabs + 2176; float* wsc = tabs + 2304 + wid * 32;
    const int sr = tid >> 4, sc = (tid & 15) * 8;
    {
        bf16x8 xk[10], xq[10]; conv_rows_load(P, rb + 8 * sr, 512 + h * 128 + sc, xk); conv_rows_load(P, rb + 8 * sr, h * 128 + sc, xq);
        asm volatile("" ::: "memory");
        { Conv8 cp; conv8_load(cp, cw, cbias, 512 + h * 128 + sc); bf16x8 kv[8]; conv_rows_compute(xk, rb + 8 * sr, cp, 0.08838834764831845f, kv);
#pragma unroll
          for (int g = 0; g < 8; ++g) { const int i = 8 * sr + g; *(bf16x8*)(lds + KSW(i, sc * 2)) = kv[g]; } }
        { Conv8 cp; conv8_load(cp, cw, cbias, h * 128 + sc); bf16x8 qv[8]; conv_rows_compute(xq, rb + 8 * sr, cp, 1.0f, qv);
#pragma unroll
          for (int g = 0; g < 8; ++g) { const int i = 8 * sr + g; *(bf16x8*)(lds + 65536 + KSW(i, sc * 2)) = qv[g]; } } }
    bf16x8 vreg[8];
#pragma unroll
    for (int g = 0; g < 8; ++g) vreg[g] = ld8(P + (size_t)(rb + 32 * g + sr) * 2560 + 1472 + h * 128 + sc);
    asm volatile("" ::: "memory");
    {
        const int dir = tid >> 8, n = tid & 255; const size_t su = dir ? sub : suf; const size_t ti = su * 256 + (dir ? 255 - n : n);
        const float bl = T[ti], al = T[TSTRIDE + ti], pm = T[2 * TSTRIDE + ti]; float Bst = 0.f, Mst = 0.f; if (!zs) { Bst = bm[su * 2]; Mst = bm[su * 2 + 1]; }
        float* tb_ = tabs + dir * 1024; const float M = fmaxf(Mst, pm - Bst);
        tb_[n] = __expf(-(Bst + bl + M)); tb_[256 + n] = (al - Bst) * LOG2E; tb_[512 + n] = M * LOG2E; tb_[768 + n] = __expf(Mst - M); }
    if (wid == 2) { nlf[lane] = zs ? 0.f : nst[suf * 128 + lane]; nlf[64 + lane] = zs ? 0.f : nst[suf * 128 + 64 + lane]; }
    if (wid == 3) { nlb[lane] = zs ? 0.f : nst[sub * 128 + lane]; nlb[64 + lane] = zs ? 0.f : nst[sub * 128 + 64 + lane]; }
    __syncthreads();
    bf16x8 qr[8];
#pragma unroll
    for (int d0 = 0; d0 < 8; ++d0) qr[d0] = *reinterpret_cast<const bf16x8*>(lds + 65536 + KSW(wid * 32 + r32, (d0 * 16 + hi * 8) * 2));
    asm volatile("s_waitcnt lgkmcnt(0)" ::: "memory");
    __syncthreads();
#pragma unroll
    for (int g = 0; g < 8; ++g) { const int i = 32 * g + sr; *(bf16x8*)(lds + 65536 + (i >> 6) * 16384 + v_st(i & 63, sc)) = vreg[g]; }
    __syncthreads();
    const int qi = wid * 32 + r32;
    float qnf = 0.f, qnb = 0.f;
#pragma unroll
    for (int d0 = 0; d0 < 8; ++d0) {
#pragma unroll
        for (int jj = 0; jj < 8; ++jj) { const float qv = bf2f(qr[d0][jj]); qnf += qv * nlf[d0 * 16 + hi * 8 + jj]; qnb += qv * nlb[d0 * 16 + hi * 8 + jj]; }
        asm volatile("" : "+v"(qnf), "+v"(qnb)); }
    { auto rr = __builtin_amdgcn_permlane32_swap(__float_as_uint(qnf), __float_as_uint(qnf), false, false); qnf = __uint_as_float(rr[0]) + __uint_as_float(rr[1]); }
    { auto rr = __builtin_amdgcn_permlane32_swap(__float_as_uint(qnb), __float_as_uint(qnb), false, false); qnb = __uint_as_float(rr[0]) + __uint_as_float(rr[1]); }
    const int vb0 = (int)(uintptr_t)lds + 65536 + v_rd_base(lane);
    const int dtile = wid >> 1;
    unsigned hfp[32];
#define ML_PK4(Pv, BASE, OUT) do { unsigned a0 = cvtpk(Pv[BASE + 0], Pv[BASE + 1]), a1 = cvtpk(Pv[BASE + 2], Pv[BASE + 3]);   \
    unsigned b0_ = cvtpk(Pv[BASE + 4], Pv[BASE + 5]), b1_ = cvtpk(Pv[BASE + 6], Pv[BASE + 7]);                              \
    auto r0 = __builtin_amdgcn_permlane32_swap(a0, b0_, false, false); auto r1 = __builtin_amdgcn_permlane32_swap(a1, b1_, false, false); \
    u32x4 w = {r0[0], r1[0], r0[1], r1[1]}; OUT = *reinterpret_cast<bf16x8*>(&w); } while (0)
#pragma unroll
    for (int dir = 0; dir < 2; ++dir) {
        const float* tb_ = tabs + dir * 1024; const size_t su = dir ? sub : suf;
        f32x16 o[4];
        if (zs) { o[0] = f32x16{}; o[1] = f32x16{}; o[2] = f32x16{}; o[3] = f32x16{}; }
        else { const bf16* Cb = CstT + su * 16384 + (size_t)r32 * 128 + hi * 8;
#pragma unroll
          for (int ep = 0; ep < 2; ++ep) { bf16x8 cf[16];
#pragma unroll
              for (int x = 0; x < 16; ++x) cf[x] = ld8(Cb + (2 * ep + (x >> 3)) * 32 * 128 + (x & 7) * 16);
              f32x16 a0 = {}, a1 = {};
#pragma unroll
              for (int d0 = 0; d0 < 8; ++d0) { a0 = __builtin_amdgcn_mfma_f32_32x32x16_bf16(qr[d0], cf[d0], a0, 0, 0, 0); a1 = __builtin_amdgcn_mfma_f32_32x32x16_bf16(qr[d0], cf[8 + d0], a1, 0, 0, 0); }
              o[2 * ep] = a0; o[2 * ep + 1] = a1; }
#pragma unroll
          for (int r = 0; r < 16; ++r) { const float isc = tb_[768 + wid * 32 + crow(r, hi)];
#pragma unroll
              for (int eb = 0; eb < 4; ++eb) o[eb][r] *= isc; } }
        const float qn = dir ? qnb : qnf;
        const float m2q = tb_[512 + qi]; float dsum = 0.f;
        const int kt0 = dir ? dtile : 0, kt1 = dir ? 4 : dtile + 1;
        for (int kt = kt0; kt < kt1; ++kt) {
            const char* Ks = lds + kt * 64 * 256; const bool diag = (kt == dtile); const int vb = vb0 + kt * 16384;
#pragma unroll
            for (int hh = 0; hh < 2; ++hh) {
                f32x16 p = {}, p2 = {};
#pragma unroll
                for (int d0 = 0; d0 < 8; d0 += 2) { const int cb = (d0 * 16 + hi * 8) * 2;
                    const bf16x8 b0 = *reinterpret_cast<const bf16x8*>(Ks + KSW(32 * hh + r32, cb)), b1 = *reinterpret_cast<const bf16x8*>(Ks + KSW(32 * hh + r32, cb + 32));
                    p = __builtin_amdgcn_mfma_f32_32x32x16_bf16(b0, qr[d0], p, 0, 0, 0); p2 = __builtin_amdgcn_mfma_f32_32x32x16_bf16(b1, qr[d0 + 1], p2, 0, 0, 0); }
                p += p2;
#pragma unroll
                for (int g4 = 0; g4 < 4; ++g4) { const int sb = kt * 64 + 32 * hh + 8 * g4 + 4 * hi;
                    const f32x4 a4 = *(const f32x4*)(tb_ + 256 + sb);
#pragma unroll
                    for (int x = 0; x < 4; ++x) { const int r = 4 * g4 + x, s0 = sb + x;
                        float w0 = __builtin_amdgcn_exp2f(a4[x] - m2q);
                        if (diag) { if (dir ? (s0 < qi) : (s0 > qi)) w0 = 0.f; }
                        p[r] *= w0; dsum += p[r]; } }
                bf16x8 pa, pb;
                ML_PK4(p, 0, pa); ML_PK4(p, 8, pb);
                if (hh == 0) { pv_pair<0, 0>(o[0], vb, pa, pb); pv_pair<1, 0>(o[1], vb, pa, pb); pv_pair<2, 0>(o[2], vb, pa, pb); pv_pair<3, 0>(o[3], vb, pa, pb); }
                else         { pv_pair<0, 2>(o[0], vb, pa, pb); pv_pair<1, 2>(o[1], vb, pa, pb); pv_pair<2, 2>(o[2], vb, pa, pb); pv_pair<3, 2>(o[3], vb, pa, pb); }
            }
        }
        { auto rr = __builtin_amdgcn_permlane32_swap(__float_as_uint(dsum), __float_as_uint(dsum), false, false); dsum = __uint_as_float(rr[0]) + __uint_as_float(rr[1]); }
        const float den = dsum + tb_[768 + qi] * qn; const float rd = 1.0f / fmaxf(fabsf(den), tb_[qi]);
        if (hi == 0) wsc[r32] = rd; asm volatile("s_waitcnt lgkmcnt(0)" ::: "memory");
        if (dir == 0) {
#pragma unroll
            for (int r = 0; r < 16; r += 2) { const float ra = wsc[crow(r, hi)], rb_ = wsc[crow(r + 1, hi)];
#pragma unroll
                for (int eb = 0; eb < 4; ++eb) hfp[eb * 8 + (r >> 1)] = cvtpk(o[eb][r] * ra, o[eb][r + 1] * rb_); }
            asm volatile("s_waitcnt lgkmcnt(0)" ::: "memory");
        } else {
            float rdr[16];
#pragma unroll
            for (int r = 0; r < 16; ++r) rdr[r] = wsc[crow(r, hi)];
            bf16x8 og8[8];
            { const bf16* ogp = P + (size_t)(rb + wid * 32 + r32) * 2560 + 1984 + h * 128 + 64 * hi;
#pragma unroll
              for (int c8 = 0; c8 < 8; ++c8) og8[c8] = ld8(ogp + 8 * c8); }
            __syncthreads();
            float* W = (float*)(lds + wid * 16896);
#pragma unroll
            for (int r = 0; r < 16; ++r)
#pragma unroll
                for (int eb = 0; eb < 4; ++eb) { const unsigned pk = hfp[eb * 8 + (r >> 1)]; const float hf = (r & 1) ? __uint_as_float(pk & 0xffff0000u) : __uint_as_float(pk << 16);
                    W[crow(r, hi) * 132 + eb * 32 + r32] = hf + o[eb][r] * rdr[r]; }
            asm volatile("s_waitcnt lgkmcnt(0)" ::: "memory");
            const int tok = r32, eh = hi; const size_t row = (size_t)(rb + wid * 32 + tok);
            const float* mg = mnorm + h * 128 + 64 * eh;
            float v[64]; float s = 0.f;
#pragma unroll
            for (int c8 = 0; c8 < 8; ++c8) { const bf16x8 g8 = og8[c8]; const f32x4 w0 = *(const f32x4*)(W + tok * 132 + 64 * eh + 8 * c8), w1 = *(const f32x4*)(W + tok * 132 + 64 * eh + 8 * c8 + 4);
                const float hv[8] = {w0.x, w0.y, w0.z, w0.w, w1.x, w1.y, w1.z, w1.w};
#pragma unroll
                for (int x = 0; x < 8; ++x) { const float vv = hv[x] * __builtin_amdgcn_rcpf(1.0f + __builtin_amdgcn_exp2f(-LOG2E * bf2f(g8[x]))); v[8 * c8 + x] = vv; s += vv; } }
            { auto rr = __builtin_amdgcn_permlane32_swap(__float_as_uint(s), __float_as_uint(s), false, false); s = __uint_as_float(rr[0]) + __uint_as_float(rr[1]); }
            const float mu = s * (1.0f / 128.0f); float q = 0.f;
#pragma unroll
            for (int x = 0; x < 64; ++x) { v[x] -= mu; q += v[x] * v[x]; }
            { auto rr = __builtin_amdgcn_permlane32_swap(__float_as_uint(q), __float_as_uint(q), false, false); q = __uint_as_float(rr[0]) + __uint_as_float(rr[1]); }
            const float rstd = 1.0f / sqrtf(q * (1.0f / 128.0f) + 1e-6f);
            bf16* orow = MIX + row * 1024 + 512 + h * 128 + 64 * eh;
#pragma unroll
            for (int c8 = 0; c8 < 8; ++c8) { const f32x4 g0 = *(const f32x4*)(mg + 8 * c8), g1 = *(const f32x4*)(mg + 8 * c8 + 4);
                u32x4 ov = {cvtpk(v[8 * c8] * rstd * g0.x, v[8 * c8 + 1] * rstd * g0.y), cvtpk(v[8 * c8 + 2] * rstd * g0.z, v[8 * c8 + 3] * rstd * g0.w),
                            cvtpk(v[8 * c8 + 4] * rstd * g1.x, v[8 * c8 + 5] * rstd * g1.y), cvtpk(v[8 * c8 + 6] * rstd * g1.z, v[8 * c8 + 7] * rstd * g1.w)};
                *(u32x4*)(orow + 8 * c8) = ov; }
        }
    }
#undef ML_PK4
    __syncthreads();
}
#undef KSW
#undef MLPK
#undef MLAS
}

#define LAS __attribute__((address_space(3)))
typedef unsigned short bf16;
typedef float f32x4 __attribute__((ext_vector_type(4)));
typedef unsigned u32x4 __attribute__((ext_vector_type(4)));
typedef unsigned u32x2 __attribute__((ext_vector_type(2)));
typedef short bf16x8 __attribute__((ext_vector_type(8)));
constexpr int NWAVES = 8, NTHREADS = 512;
constexpr int DM = 1024, NB = 4, SEQ = 4096, CTXL = 256, TB = SEQ + CTXL  , R = NB * TB  ;
constexpr int DFF = 2752, DFFP = 2816, NW1 = 2 * DFFP  , DIN = 2512, DINP = 2560, KUP = 384, NUP = 1792;
constexpr int NMOD = 9;
constexpr float EPS = 1e-6f;
constexpr size_t MiB = 1u << 20;
constexpr size_t WS_CTL = 0, CTL_BYTES = 1 * MiB;
constexpr size_t WS_MOD = 1 * MiB;
constexpr size_t WS_TAB = WS_MOD + 512 * 1024;
constexpr size_t WS_W1 = 2 * MiB;
constexpr size_t WS_W2 = WS_W1 + (size_t)2 * NW1 * DM * 2;
constexpr size_t WS_WIN = WS_W2 + (size_t)2 * DM * DFFP * 2;
constexpr size_t WS_WUP = WS_WIN + (size_t)DINP * DM * 2;
constexpr size_t WS_WOUT = WS_WUP + (size_t)NUP * KUP * 2;
constexpr size_t WS_XC = WS_WOUT + (size_t)DM * DM * 2;
constexpr size_t WS_H = WS_XC + (size_t)NB * CTXL * DM * 4;
constexpr size_t WS_BIG = WS_H + (size_t)R * DM * 2;
constexpr size_t BIG_KR = (size_t)R * DINP * 2;
constexpr size_t BIG_G = BIG_KR + (size_t)R * 64 * 2;
constexpr size_t WS_Y = WS_BIG + (size_t)R * DFFP * 2;
constexpr size_t WS_Q = WS_Y + (size_t)R * DM * 2;
constexpr size_t WS_AUP = WS_Q + (size_t)R * 768 * 2;
constexpr size_t WS_HF = WS_AUP + (size_t)R * 512 * 2;
constexpr size_t WS_HB = WS_HF + (size_t)R * 512 * 2;
constexpr size_t WS_MS = WS_HB + (size_t)R * 512 * 2;
constexpr size_t MS_NLOC = 0, MS_SCA = 262144, MS_NST = 266240, MS_BM = 544768;
constexpr size_t MS_X1 = 3u << 20, MS_X2 = (3u << 20) + (512u << 10);
constexpr size_t MS_T = 1u << 20;
constexpr size_t WS_END = WS_MS + 4 * MiB;
static_assert(BIG_G + (size_t)R * 16 * 4 <= (size_t)R * DFFP * 2, "P + KR + G fit the hidden region");
static_assert(WS_W1 % 256 == 0 && WS_W2 % 256 == 0 && WS_WIN % 256 == 0 && WS_WUP % 256 == 0 && WS_WOUT % 256 == 0 && WS_XC % 256 == 0 && WS_H % 256 == 0 && WS_BIG % 256 == 0 && WS_Y % 256 == 0 && WS_Q % 256 == 0 && WS_AUP % 256 == 0 && WS_HF % 256 == 0, "alignment");
static_assert(WS_END <= 305u * MiB, "workspace budget");
constexpr int LDS_BYTES = 147456, LDS_MISC = 143360;

#define LDS_WAIT() asm volatile("s_waitcnt lgkmcnt(0)" ::: "memory")
__device__ __forceinline__ unsigned f2bf(float f) { unsigned u = __builtin_bit_cast(unsigned, f); return (u + 0x7fffu + ((u >> 16) & 1u)) >> 16; }
__device__ __forceinline__ unsigned pk2(float lo, float hi) { return f2bf(lo) | (f2bf(hi) << 16); }
__device__ __forceinline__ float bflo(unsigned w) { return __uint_as_float(w << 16); }
__device__ __forceinline__ float bfhi(unsigned w) { return __uint_as_float(w & 0xffff0000u); }
__device__ __forceinline__ float bf1(bf16 b) { return __uint_as_float(((unsigned)b) << 16); }
__device__ __forceinline__ float wave_sum(float v) {
#pragma unroll
    for (int o = 1; o < 64; o <<= 1) v += __shfl_xor(v, o);
    return v;
}
__device__ __forceinline__ float sigmoid_f(float x) { return __builtin_amdgcn_rcpf(1.0f + __builtin_amdgcn_exp2f(-1.4426950408889634f * x)); }
__device__ __forceinline__ float silu1(float x) { return x * sigmoid_f(x); }

struct Args { const float* in[22]; float* out; unsigned char* ws; int ph_lo, ph_hi; };
struct ArgsV { const Args* p; int z;
    __device__ __forceinline__ const float* in(int i) const { return p->in[i + z]; }
    __device__ __forceinline__ float* out() const { return (float*)p->in[22 + z]; }
    __device__ __forceinline__ unsigned char* ws() const { return (unsigned char*)p->in[23 + z]; } };
enum { I_X = 0, I_C, I_CTX, I_CCTX, I_WMOD, I_BMOD, I_NPRE, I_NPOST, I_WG, I_WU, I_WD, I_WIN, I_QN, I_WUQ, I_KVN, I_WUKV, I_AON, I_CW, I_CB, I_GB, I_MN, I_WOUT };

__device__ __forceinline__ const float* xin_row(const ArgsV& a, int r) { const int b = r / TB, t = r - b * TB; return t < CTXL ? a.in(I_CTX) + (size_t)(b * CTXL + t) * DM : a.in(I_X) + (size_t)(b * SEQ + t - CTXL) * DM; }
__device__ __forceinline__ float* xres_row(const ArgsV& a, int r) { const int b = r / TB, t = r - b * TB; return t < CTXL ? (float*)(a.ws() + WS_XC) + (size_t)(b * CTXL + t) * DM : a.out() + (size_t)(b * SEQ + t - CTXL) * DM; }
__device__ __forceinline__ const float* mod_vec(const ArgsV& a, int l, int r, int j) { const int b = r / TB, t = r - b * TB; const int bb = t < CTXL ? 4 : b; return (const float*)(a.ws() + WS_MOD) + (size_t)((l * 5 + bb) * NMOD + j) * DM; }

__device__ __forceinline__ void cvt_item(const float* src, int srcN, int k0, int c0, int ncv, bf16* dst, int dstK, int drow0, int dk0, LAS float* scr, int lane) {
    const int n4 = (lane & 15) * 4, kr = lane >> 4;
    f32x4 v[16];
    const bool ok = n4 < ncv;
    const float* sp = src + (size_t)(k0 + kr) * srcN + c0 + n4;
#pragma unroll
    for (int i = 0; i < 16; ++i) { v[i] = (f32x4){0.f, 0.f, 0.f, 0.f}; if (ok) v[i] = *(const f32x4*)(sp + (size_t)(4 * i) * srcN); }
#pragma unroll
    for (int i = 0; i < 16; ++i) { const int k = 4 * i + kr; *(LAS f32x4*)(scr + k * 68 + ((n4 + 8 * (k >> 3)) & 63)) = v[i]; }
    LDS_WAIT(); asm volatile("" ::: "memory");
    const int c = lane & 7;
#pragma unroll
    for (int j = 0; j < 8; ++j) { const int n = (lane >> 3) + 8 * j; const LAS float* s = scr + (8 * c) * 68 + ((n + 8 * c) & 63);
        u32x4 o; o.x = pk2(s[0 * 68], s[1 * 68]); o.y = pk2(s[2 * 68], s[3 * 68]); o.z = pk2(s[4 * 68], s[5 * 68]); o.w = pk2(s[6 * 68], s[7 * 68]);
        *(u32x4*)(dst + (size_t)(drow0 + n) * dstK + dk0 + 8 * c) = o; }
    LDS_WAIT(); asm volatile("" ::: "memory");
}
__device__ __forceinline__ void wconv_layer(const ArgsV& a, int l, LAS unsigned char* lds, int bid, int nbl, int wave, int lane) {
    LAS float* scr = (LAS float*)(lds + wave * 17408);
    const int gw = bid * NWAVES + wave, NGW = nbl * NWAVES;
    constexpr int I_1 = 88 * 16, I_2 = 16 * 44, I_IN = 40 * 16, I_UP = 28 * 6, I_OUT = 16 * 16;
    constexpr int NITEMS = 2 * I_1 + 2 * I_2 + I_IN + I_UP + I_OUT;
    bf16* W1 = (bf16*)(a.ws() + WS_W1); bf16* W2 = (bf16*)(a.ws() + WS_W2); bf16* WIN = (bf16*)(a.ws() + WS_WIN); bf16* WUP = (bf16*)(a.ws() + WS_WUP); bf16* WOUT = (bf16*)(a.ws() + WS_WOUT);
    for (int it = gw; it < NITEMS; it += NGW) {
        int r = it;
        if (r < 2 * I_1) { const int j = r / I_1; r -= j * I_1; const int g = r / 16, kb = r % 16; const int row0 = 64 * g, pn = row0 >> 8, i = row0 & 255; const int hc = 128 * pn + (i & 127);
            const float* src = (i < 128 ? a.in(I_WG) : a.in(I_WU)) + (size_t)(l * 2 + j) * DM * DFF;
            cvt_item(src, DFF, 64 * kb, hc < DFF ? hc : 0, hc < DFF ? 64 : 0, W1 + (size_t)j * NW1 * DM, DM, row0, 64 * kb, scr, lane); continue; }
        r -= 2 * I_1;
        if (r < 2 * I_2) { const int j = r / I_2; r -= j * I_2; const int g = r / 44, kb = r % 44;
            const float* src = a.in(I_WD) + (size_t)(l * 2 + j) * DFF * DM;
            cvt_item(src, DM, kb < 43 ? 64 * kb : 0, 64 * g, kb < 43 ? 64 : 0, W2 + (size_t)j * DM * DFFP, DFFP, 64 * g, 64 * kb, scr, lane); continue; }
        r -= 2 * I_2;
        if (r < I_IN) { const int g = r / 16, kb = r % 16; int ncv = DIN - 64 * g; ncv = ncv < 0 ? 0 : (ncv > 64 ? 64 : ncv);
            cvt_item(a.in(I_WIN) + (size_t)l * DM * DIN, DIN, 64 * kb, ncv > 0 ? 64 * g : 0, ncv, WIN, DM, 64 * g, 64 * kb, scr, lane); continue; }
        r -= I_IN;
        if (r < I_UP) { const int g = r / 6, kb = r % 6;
            if (g < 12) cvt_item(a.in(I_WUQ) + (size_t)l * 256 * 768, 768, kb < 4 ? 64 * kb : 0, 64 * g, kb < 4 ? 64 : 0, WUP, KUP, 64 * g, 64 * kb, scr, lane);
            else cvt_item(a.in(I_WUKV) + (size_t)l * 128 * 1024, 1024, kb >= 4 ? 64 * (kb - 4) : 0, 64 * (g - 12), kb >= 4 ? 64 : 0, WUP, KUP, 64 * g, 64 * kb, scr, lane);
            continue; }
        r -= I_UP;
        { const int g = r / 16, kb = r % 16; cvt_item(a.in(I_WOUT) + (size_t)l * DM * DM, DM, 64 * kb, 64 * g, 64, WOUT, DM, 64 * g, 64 * kb, scr, lane); }
    }
}
__device__ __forceinline__ void mod_phase(const ArgsV& a, LAS unsigned char* lds, int bid, int nbl, int tid, int wave, int lane) {
    LAS float* sv = (LAS float*)(lds);
    LAS float* red = (LAS float*)(lds + 20480);
    for (int i = tid; i < 5 * DM; i += NTHREADS) { const float v = i < 4 * DM ? a.in(I_C)[i] : a.in(I_CCTX)[i - 4 * DM]; sv[i] = silu1(v); }
    __syncthreads();
    float* mod = (float*)(a.ws() + WS_MOD);
    for (int u = bid; u < 256; u += nbl) {
        const int l = u >> 7, cb = (u & 127) * 72; const bool act = lane < 18;
        const float* W = a.in(I_WMOD) + (size_t)l * DM * (NMOD * DM) + cb + 4 * (act ? lane : 0);
        f32x4 acc[5];
#pragma unroll
        for (int bb = 0; bb < 5; ++bb) acc[bb] = (f32x4){0.f, 0.f, 0.f, 0.f};
        for (int k0 = wave * 128; k0 < wave * 128 + 128; k0 += 32) { f32x4 w[32];
#pragma unroll
            for (int i = 0; i < 32; ++i) w[i] = *(const f32x4*)(W + (size_t)(k0 + i) * (NMOD * DM));
#pragma unroll
            for (int i = 0; i < 32; ++i)
#pragma unroll
                for (int bb = 0; bb < 5; ++bb) acc[bb] += w[i] * sv[bb * DM + k0 + i]; }
        if (act) {
#pragma unroll
            for (int bb = 0; bb < 5; ++bb) *(LAS f32x4*)(red + (wave * 5 + bb) * 72 + 4 * lane) = acc[bb]; }
        __syncthreads();
        for (int i = tid; i < 5 * 72; i += NTHREADS) { const int bb = i / 72, cc = i % 72; float s = 0.f;
#pragma unroll
            for (int w = 0; w < 8; ++w) s += red[(w * 5 + bb) * 72 + cc];
            mod[(size_t)(l * 5 + bb) * (NMOD * DM) + cb + cc] = s + a.in(I_BMOD)[(size_t)l * NMOD * DM + cb + cc]; }
        __syncthreads();
    }
    if (bid == nbl - 1 && tid < 64) {
        constexpr float inv[16] = {1.0f, 0.5623413251903491f, 0.31622776601683794f, 0.1778279410038923f, 0.1f, 0.05623413251903491f, 0.03162277660168379f, 0.01778279410038923f,
                                   0.01f, 0.005623413251903491f, 0.0031622776601683794f, 0.001778279410038923f, 0.001f, 0.0005623413251903491f, 0.00031622776601683794f, 0.0001778279410038923f};
        float* tab = (float*)(a.ws() + WS_TAB);
#pragma unroll
        for (int f = 0; f < 16; ++f) {
            const float ang = (float)tid * inv[f];
            const double ad = (double)ang; const double kq = __builtin_rint(ad * 0.63661977236758134308); const double rd = ad - kq * 1.57079632679489661923;
            const float x = (float)rd, x2 = x * x; const int q = ((int)kq) & 3;
            const float sp = x + x * x2 * (-1.6666654611e-1f + x2 * (8.3321608736e-3f + x2 * (-1.9515295891e-4f)));
            const float cp = 1.0f - 0.5f * x2 + x2 * x2 * (4.166664568298827e-2f + x2 * (-1.388731625493765e-3f + x2 * 2.443315711809948e-5f));
            const float sn = (q == 0) ? sp : (q == 1) ? cp : (q == 2) ? -sp : -cp;
            const float cs = (q == 0) ? cp : (q == 1) ? -sp : (q == 2) ? -cp : sp;
            tab[(tid * 16 + f) * 2] = cs; tab[(tid * 16 + f) * 2 + 1] = sn; }
    }
    __syncthreads();
}

__device__ __forceinline__ void rw_pre(const f32x4 (&x)[4], const float* g, const float* sc, const float* sh, bf16* hrow, int lane) {
    float ss = 0.f;
#pragma unroll
    for (int j = 0; j < 4; ++j) ss += (x[j].x * x[j].x + x[j].y * x[j].y) + (x[j].z * x[j].z + x[j].w * x[j].w);
    const float rstd = 1.0f / sqrtf(wave_sum(ss) * (1.0f / DM) + EPS);
#pragma unroll
    for (int j = 0; j < 4; ++j) { const int c = 256 * j + 4 * lane; const f32x4 gv = *(const f32x4*)(g + c), sv = *(const f32x4*)(sc + c), hv = *(const f32x4*)(sh + c);
        f32x4 o; o.x = x[j].x * rstd * gv.x * (1.0f + sv.x) + hv.x; o.y = x[j].y * rstd * gv.y * (1.0f + sv.y) + hv.y; o.z = x[j].z * rstd * gv.z * (1.0f + sv.z) + hv.z; o.w = x[j].w * rstd * gv.w * (1.0f + sv.w) + hv.w;
        u32x2 w; w.x = pk2(o.x, o.y); w.y = pk2(o.z, o.w); *(u32x2*)(hrow + c) = w; }
}
__device__ __forceinline__ void xb_store(const ArgsV& a, int r, const f32x4 (&x)[4], int lane) {
    const int b = r / TB, t = r - b * TB; if (t < CTXL) return;
    bf16* xr = (bf16*)(a.ws() + WS_Y) + (size_t)(b * SEQ + t - CTXL) * DM;
#pragma unroll
    for (int j = 0; j < 4; ++j) { u32x2 w; w.x = pk2(x[j].x, x[j].y); w.y = pk2(x[j].z, x[j].w); *(u32x2*)(xr + 256 * j + 4 * lane) = w; }
}
__device__ __forceinline__ void phase_rw_a(const ArgsV& a, int bid, int nbl, int wave, int lane) {
    const int gw = bid * NWAVES + wave, NGW = nbl * NWAVES; bf16* H = (bf16*)(a.ws() + WS_H);
    for (int ra = gw; ra < R; ra += 2 * NGW) {
        const int rb_ = ra + NGW < R ? ra + NGW : ra; const float* xa = xin_row(a, ra); const float* xb = xin_row(a, rb_); f32x4 x0[4], x1[4];
#pragma unroll
        for (int j = 0; j < 4; ++j) { x0[j] = *(const f32x4*)(xa + 256 * j + 4 * lane); x1[j] = *(const f32x4*)(xb + 256 * j + 4 * lane); }
        xb_store(a, ra, x0, lane); if (rb_ != ra) xb_store(a, rb_, x1, lane);
        rw_pre(x0, a.in(I_NPRE) + 0, mod_vec(a, 0, ra, 1), mod_vec(a, 0, ra, 0), H + (size_t)ra * DM, lane);
        if (rb_ != ra) rw_pre(x1, a.in(I_NPRE) + 0, mod_vec(a, 0, rb_, 1), mod_vec(a, 0, rb_, 0), H + (size_t)rb_ * DM, lane); }
}
__device__ __forceinline__ void phase_rw_b(const ArgsV& a, int l, int sub, int bid, int nbl, int wave, int lane, bool dry = false) {
    const int gw = bid * NWAVES + wave, NGW = nbl * NWAVES; bf16* H = (bf16*)(a.ws() + WS_H);
    const float wgt = sub == 1 ? 1.0f : 0.5f; const float* gpost = a.in(I_NPOST) + (size_t)(l * 3 + sub) * DM;
    const int nl = sub == 2 ? l + 1 : l, nsub = sub == 2 ? 0 : sub + 1;
    const bool from_input = (l == 0 && sub == 0); const int nsl = sub == 1 ? 4 : 11;
    if (l == 1 && sub >= 1) return;
    const float* gpre = a.in(I_NPRE) + (size_t)(nl * 3 + nsub) * DM;
    for (int i0 = gw; i0 < NB * CTXL; i0 += NGW) {
        const int r0 = (i0 / CTXL) * TB + (i0 % CTXL);
        const float* xs0 = from_input ? xin_row(a, r0) : xres_row(a, r0);
        const float* gate0 = mod_vec(a, l, r0, 3 * sub + 2); const float* sc0 = mod_vec(a, nl, r0, 3 * nsub + 1); const float* sh0 = mod_vec(a, nl, r0, 3 * nsub);
        const float* sp = (const float*)(a.ws() + WS_AUP) + (size_t)((r0 / TB) * CTXL + (r0 % TB)) * DM + 4 * lane;
        f32x4 x0[4], y0[4], gp[4], gt[4], gn[4], sv[4], hv[4];
        {   f32x4 v[4][4];
#pragma unroll
            for (int j = 0; j < 4; ++j) { const int c = 256 * j + 4 * lane; x0[j] = *(const f32x4*)(xs0 + c); gp[j] = *(const f32x4*)(gpost + c); gt[j] = *(const f32x4*)(gate0 + c);
#pragma unroll
                for (int s = 0; s < 4; ++s) v[s][j] = *(const f32x4*)(sp + (size_t)s * 1024 * 1024 + 256 * j); }
            asm volatile("" ::: "memory");
#pragma unroll
            for (int j = 0; j < 4; ++j) y0[j] = (v[0][j] + v[1][j]) + (v[2][j] + v[3][j]); }
        if (nsl > 4) {
            {   f32x4 w[4][4];
#pragma unroll
                for (int j = 0; j < 4; ++j) { const int c = 256 * j + 4 * lane; gn[j] = *(const f32x4*)(gpre + c); sv[j] = *(const f32x4*)(sc0 + c); hv[j] = *(const f32x4*)(sh0 + c);
#pragma unroll
                    for (int s = 0; s < 4; ++s) w[s][j] = *(const f32x4*)(sp + (size_t)(4 + s) * 1024 * 1024 + 256 * j); }
                asm volatile("" ::: "memory");
#pragma unroll
                for (int j = 0; j < 4; ++j) y0[j] += (w[0][j] + w[1][j]) + (w[2][j] + w[3][j]); }
            {   f32x4 w[3][4];
#pragma unroll
                for (int s = 0; s < 3; ++s)
#pragma unroll
                    for (int j = 0; j < 4; ++j) w[s][j] = *(const f32x4*)(sp + (size_t)(8 + s) * 1024 * 1024 + 256 * j);
#pragma unroll
                for (int j = 0; j < 4; ++j) y0[j] += (w[0][j] + w[1][j]) + w[2][j]; }
        } else {
#pragma unroll
            for (int j = 0; j < 4; ++j) { const int c = 256 * j + 4 * lane; gn[j] = *(const f32x4*)(gpre + c); sv[j] = *(const f32x4*)(sc0 + c); hv[j] = *(const f32x4*)(sh0 + c); }
        }
        float ss0 = 0.f;
#pragma unroll
        for (int j = 0; j < 4; ++j) ss0 += (y0[j].x * y0[j].x + y0[j].y * y0[j].y) + (y0[j].z * y0[j].z + y0[j].w * y0[j].w);
        const float rs0 = 1.0f / sqrtf(wave_sum(ss0) * (1.0f / DM) + EPS);
        float* xd0 = dry ? (float*)(a.ws() + WS_BIG) + (size_t)r0 * DM : xres_row(a, r0);
        float s2 = 0.f;
#pragma unroll
        for (int j = 0; j < 4; ++j) { const int c = 256 * j + 4 * lane;
            x0[j].x += wgt * gt[j].x * (y0[j].x * rs0 * gp[j].x); x0[j].y += wgt * gt[j].y * (y0[j].y * rs0 * gp[j].y); x0[j].z += wgt * gt[j].z * (y0[j].z * rs0 * gp[j].z); x0[j].w += wgt * gt[j].w * (y0[j].w * rs0 * gp[j].w);
            *(f32x4*)(xd0 + c) = x0[j]; s2 += (x0[j].x * x0[j].x + x0[j].y * x0[j].y) + (x0[j].z * x0[j].z + x0[j].w * x0[j].w); }
        const float rstd = 1.0f / sqrtf(wave_sum(s2) * (1.0f / DM) + EPS); bf16* hrow = H + (size_t)r0 * DM;
#pragma unroll
        for (int j = 0; j < 4; ++j) { const int c = 256 * j + 4 * lane; f32x4 o;
            o.x = x0[j].x * rstd * gn[j].x * (1.0f + sv[j].x) + hv[j].x; o.y = x0[j].y * rstd * gn[j].y * (1.0f + sv[j].y) + hv[j].y; o.z = x0[j].z * rstd * gn[j].z * (1.0f + sv[j].z) + hv[j].z; o.w = x0[j].w * rstd * gn[j].w * (1.0f + sv[j].w) + hv[j].w;
            u32x2 w; w.x = pk2(o.x, o.y); w.y = pk2(o.z, o.w); *(u32x2*)(hrow + c) = w; }
    }
}
__device__ __forceinline__ void phase_rw_prep(const ArgsV& a, int l, int bid, int nbl, int wave, int lane) {
    const int gw = bid * NWAVES + wave, NGW = nbl * NWAVES;
    const bf16* P = (const bf16*)(a.ws() + WS_BIG); bf16* AUP = (bf16*)(a.ws() + WS_AUP); bf16* KR = (bf16*)(a.ws() + WS_BIG + BIG_KR);
    const float* tab = (const float*)(a.ws() + WS_TAB);
    const float* qn = a.in(I_QN) + l * 256; const float* kvn = a.in(I_KVN) + l * 128;
    for (int task = gw; task < 32 * 17; task += NGW)
        ml::gate_scan_task((const float*)(a.ws() + WS_BIG + BIG_G), a.in(I_GB) + l * 16, (float*)(a.ws() + WS_MS + MS_T), (float*)(a.ws() + WS_MS + MS_SCA), task, lane);
    for (int ra = gw; ra < R; ra += 2 * NGW) {
        const int rb_ = ra + NGW < R ? ra + NGW : ra; const bool two = rb_ != ra;
        const bf16* pa = P + (size_t)ra * DINP; const bf16* pb = P + (size_t)rb_ * DINP;
        const u32x2 wa = *(const u32x2*)(pa + 4 * lane), wb = *(const u32x2*)(pb + 4 * lane);
        const unsigned ka = *(const unsigned*)(pa + 256 + 2 * lane), kb = *(const unsigned*)(pb + 256 + 2 * lane);
        const float va = bf1(pa[384 + lane]), vb = bf1(pb[384 + lane]);
        const f32x4 g = *(const f32x4*)(qn + 4 * lane); const float kg0 = kvn[2 * lane], kg1 = kvn[2 * lane + 1];
        float a0 = bflo(wa.x), a1 = bfhi(wa.x), a2 = bflo(wa.y), a3 = bfhi(wa.y), b0 = bflo(wb.x), b1 = bfhi(wb.x), b2 = bflo(wb.y), b3 = bfhi(wb.y);
        float sa = (a0 * a0 + a1 * a1) + (a2 * a2 + a3 * a3), sb = (b0 * b0 + b1 * b1) + (b2 * b2 + b3 * b3);
        const float c0 = bflo(ka), c1 = bfhi(ka), d0 = bflo(kb), d1 = bfhi(kb); float ta = c0 * c0 + c1 * c1, tb = d0 * d0 + d1 * d1;
#pragma unroll
        for (int o = 1; o < 64; o <<= 1) { sa += __shfl_xor(sa, o); sb += __shfl_xor(sb, o); ta += __shfl_xor(ta, o); tb += __shfl_xor(tb, o); }
        const float voa = __shfl_xor(va, 16), vob = __shfl_xor(vb, 16);
        const float rqa = 1.0f / sqrtf(sa * (1.0f / 256.0f) + EPS), rqb = 1.0f / sqrtf(sb * (1.0f / 256.0f) + EPS), rka = 1.0f / sqrtf(ta * (1.0f / 128.0f) + EPS), rkb = 1.0f / sqrtf(tb * (1.0f / 128.0f) + EPS);
        { u32x2 o; o.x = pk2(a0 * rqa * g.x, a1 * rqa * g.y); o.y = pk2(a2 * rqa * g.z, a3 * rqa * g.w); *(u32x2*)(AUP + (size_t)ra * KUP + 4 * lane) = o;
          *(unsigned*)(AUP + (size_t)ra * KUP + 256 + 2 * lane) = pk2(c0 * rka * kg0, c1 * rka * kg1); }
        if (two) { u32x2 o; o.x = pk2(b0 * rqb * g.x, b1 * rqb * g.y); o.y = pk2(b2 * rqb * g.z, b3 * rqb * g.w); *(u32x2*)(AUP + (size_t)rb_ * KUP + 4 * lane) = o;
          *(unsigned*)(AUP + (size_t)rb_ * KUP + 256 + 2 * lane) = pk2(d0 * rkb * kg0, d1 * rkb * kg1); }
        const int ax = lane >> 5, half = (lane >> 4) & 1, f = lane & 15;
        { const int t = ra % TB; float o = va;
          if (t >= CTXL) { const int tt = t - CTXL; const int pos = ax == 0 ? (tt >> 6) : (tt & 63); const float cs = tab[(pos * 16 + f) * 2], sn = tab[(pos * 16 + f) * 2 + 1]; o = half == 0 ? va * cs - voa * sn : va * cs + voa * sn; }
          KR[(size_t)ra * 64 + lane] = (bf16)f2bf(o); }
        if (two) { const int t = rb_ % TB; float o = vb;
          if (t >= CTXL) { const int tt = t - CTXL; const int pos = ax == 0 ? (tt >> 6) : (tt & 63); const float cs = tab[(pos * 16 + f) * 2], sn = tab[(pos * 16 + f) * 2 + 1]; o = half == 0 ? vb * cs - vob * sn : vb * cs + vob * sn; }
          KR[(size_t)rb_ * 64 + lane] = (bf16)f2bf(o); }
    }
}
#define RLX_AGENT __ATOMIC_RELAXED, __HIP_MEMORY_SCOPE_AGENT
#define VM_WAIT() asm volatile("s_waitcnt vmcnt(0)" ::: "memory")
#define XB_TMO      128
#define XB_XCNT(j)  (256  + 64 * (j))
#define XB_XSUB(j)  (1280 + 64 * (j))
#define XB_XGEN(j)  (2304 + 64 * (j))
#define XB_TOP      3328
#define XB_TOPGEN   3392
#define XCD_BAR_WORDS 3456
#define XB_SPIN_CAP (1u << 18)

__device__ __forceinline__ unsigned xb_ld(unsigned* p)              { return __hip_atomic_load(p, __ATOMIC_RELAXED, __HIP_MEMORY_SCOPE_AGENT); }
__device__ __forceinline__ unsigned xb_add(unsigned* p, unsigned v) { return __hip_atomic_fetch_add(p, v, __ATOMIC_RELAXED, __HIP_MEMORY_SCOPE_AGENT); }
__device__ __forceinline__ unsigned xb_xcc_id() { return (unsigned)__builtin_amdgcn_s_getreg((3 << 11) | 20) & 0xFu; }
#define XB_SPIN(cond, bar) do { unsigned _sp = 0; while (cond) { __builtin_amdgcn_s_sleep(1); \
    if ((++_sp & 255u) == 0u) { if (xb_ld(&(bar)[XB_TMO])) break; if (_sp > XB_SPIN_CAP) { atomicAdd(&(bar)[XB_TMO], 1u); break; } } } } while (0)

struct XcdBarrier {
    unsigned* bar; unsigned x;
    volatile LAS unsigned* st;
};

__device__ __forceinline__ XcdBarrier xcd_barrier_post(unsigned* bar, volatile LAS unsigned* st) {
    XcdBarrier b; b.bar = bar; b.x = xb_xcc_id(); b.st = st;
    if (threadIdx.x == 0) (void)xb_add(&bar[XB_XCNT(b.x)], 1u);
    return b;
}
__device__ __forceinline__ void xcd_barrier_complete(unsigned* bar, unsigned x, unsigned& nloc, unsigned& nx) {
    const unsigned G = gridDim.x * gridDim.y * gridDim.z;
    unsigned sum, cnt, mine, sp = 0u;
    for (;;) {
        sum = 0u; cnt = 0u; mine = 0u;
#pragma unroll
        for (unsigned j = 0; j < 16; ++j) { const unsigned c = xb_ld(&bar[XB_XCNT(j)]); sum += c; cnt += (c > 0u) ? 1u : 0u; mine = (j == x) ? c : mine; }
        if (sum == G) break;
        __builtin_amdgcn_s_sleep(1);
        if ((++sp & 255u) == 0u) { if (xb_ld(&bar[XB_TMO])) break; if (sp > XB_SPIN_CAP) { atomicAdd(&bar[XB_TMO], 1u); break; } }
    }
    nloc = mine > 0u ? mine : 1u; nx = cnt > 0u ? cnt : 1u;
}

__device__ __forceinline__ void xcd_barrier(const XcdBarrier& b) {
    asm volatile("s_waitcnt vmcnt(0)" ::: "memory");
    __syncthreads();
    if (threadIdx.x == 0) {
        unsigned* bar = b.bar;
        __builtin_amdgcn_s_waitcnt(0);
        unsigned nloc = b.st[0], nx = b.st[1];
        if (nloc == 0u) { xcd_barrier_complete(bar, b.x, nloc, nx); b.st[0] = nloc; b.st[1] = nx; }
        const unsigned old = xb_add(&bar[XB_XSUB(b.x)], 1u);
        const unsigned gen = old / nloc;
        if (old + 1u == (gen + 1u) * nloc) {
            __builtin_amdgcn_fence(__ATOMIC_RELEASE, "agent");
            asm volatile("s_waitcnt vmcnt(0)" ::: "memory");
            const unsigned og = xb_add(&bar[XB_TOP], 1u);
            const unsigned tg = og / nx;
            if (og + 1u == (tg + 1u) * nx) xb_add(&bar[XB_TOPGEN], 1u);
            else XB_SPIN(xb_ld(&bar[XB_TOPGEN]) == tg, bar);
            __builtin_amdgcn_fence(__ATOMIC_ACQUIRE, "agent");
            xb_add(&bar[XB_XGEN(b.x)], 1u);
            asm volatile("s_waitcnt vmcnt(0)" ::: "memory");
        } else {
            XB_SPIN(xb_ld(&bar[XB_XGEN(b.x)]) == gen, bar);
            __builtin_amdgcn_fence(__ATOMIC_ACQUIRE, "agent");
            asm volatile("s_waitcnt vmcnt(0)" ::: "memory");
        }
    }
    __syncthreads();
}
constexpr int PPL = 15, N_PHASES = 1 + 2 * PPL, SKIP_PHASE = 1 + PPL;
__global__ void __launch_bounds__(NTHREADS, 2) mega_fwd(Args args) {
    extern __shared__ __attribute__((aligned(16))) unsigned char lds_raw[];
    LAS unsigned char* lds = (LAS unsigned char*)lds_raw;
    cg::grid_group grid = cg::this_grid();
    volatile LAS unsigned* MISC = (volatile LAS unsigned*)(lds + LDS_MISC);
    if (threadIdx.x < 16) MISC[threadIdx.x] = 0u;
    __syncthreads();
    XcdBarrier bar = xcd_barrier_post((unsigned*)(args.ws + WS_CTL), MISC + 8);
    for (int ph = args.ph_lo; ph < args.ph_hi; ++ph) {
        if (ph == SKIP_PHASE || ph == 1 + PPL + 11 || ph == 1 + PPL + 14 || ph == 1 + 9 || ph == 1 + PPL + 9) continue;
#define TID_DECL int tid_ = threadIdx.x; asm volatile("" : "+v"(tid_)); const int tid = tid_, lane = tid & 63, wave = __builtin_amdgcn_readfirstlane(tid >> 6); (void)tid; (void)lane; (void)wave
        int bid_ = blockIdx.x, nbl_ = gridDim.x; asm volatile("" : "+s"(bid_), "+s"(nbl_)); const int bid = bid_, nbl = nbl_;
        int zo_ = 0; asm volatile("" : "+s"(zo_));
        const ArgsV A_{&args, zo_}; unsigned char* ws = A_.ws();
        XcdBarrier barl = bar; asm volatile("" : "+s"(barl.x), "+s"(barl.bar));
        if (ph == 0) { TID_DECL; mod_phase(A_, lds, bid, nbl, tid, wave, lane); wconv_layer(A_, 0, lds, bid, nbl, wave, lane); }
        else {
            const int l = (ph - 1) / PPL, k = (ph - 1) % PPL;
            if (k == 0) { TID_DECL; phase_rw_a(A_, bid, nbl, wave, lane); }
            else if (k == 1 || k == 12) { const int j = k == 12;
                pg8::Gemm g{(const pg8::bf16_t*)(ws + WS_H), (const pg8::bf16_t*)(ws + WS_W1) + (size_t)j * NW1 * DM, R, NW1, DM}; pg8::TileOrder S; S.init(0, NW1, DM, nbl, bid, 1);
                pg8::EpiSwiGLU E{(pg8::bf16_t*)(ws + WS_BIG), DFFP};
                pg8::gemm_phase<pg8::EpiSwiGLU, pg8::TileOrder, true, true>(lds, g, S, E); }
            else if (k == 2 || k == 13 || k == 10) { const int j = k == 13, sub = k == 2 ? 0 : (k == 10 ? 1 : 2);
                const pg8::bf16_t* A = (const pg8::bf16_t*)(ws + (k == 10 ? WS_H : WS_BIG));
                const pg8::bf16_t* Bt = k == 10 ? (const pg8::bf16_t*)(ws + WS_WOUT) : (const pg8::bf16_t*)(ws + WS_W2) + (size_t)j * DM * DFFP;
                const int K = k == 10 ? DM : DFFP;
                pg8::Gemm g{A, Bt, R, DM, K}; pg8::TileOrder S; S.init(1, DM, K, nbl, bid, 1);
                const bool has_next = !(l == 1 && sub == 2); const int nl = sub == 2 ? l + 1 : l, nsub = sub == 2 ? 0 : sub + 1;
                const float* modb = (const float*)(ws + WS_MOD); unsigned* cntb = (unsigned*)(ws + WS_CTL + 65536) + (size_t)((l * 3 + sub) * 2) * (68 * 64);
                pg8::EpiNormRes E{(pg8::bf16_t*)(ws + WS_Y), A_.out(), has_next ? (pg8::bf16_t*)(ws + WS_H) : nullptr,
                                  modb + (size_t)((l * 5) * NMOD + 3 * sub + 2) * DM, A_.in(I_NPOST) + (size_t)(l * 3 + sub) * DM,
                                  A_.in(I_NPRE) + (size_t)((has_next ? nl : 0) * 3 + nsub) * DM, modb + (size_t)(((has_next ? nl : 0) * 5) * NMOD + 3 * nsub + 1) * DM, modb + (size_t)(((has_next ? nl : 0) * 5) * NMOD + 3 * nsub) * DM,
                                  sub == 1 ? 1.0f : 0.5f, pg8::PanelSS{(unsigned*)(ws + WS_MS + MS_X1), cntb}, pg8::PanelSS{(unsigned*)(ws + WS_MS + MS_X2), cntb + 68 * 64}};
                pg8::gemm_phase<pg8::EpiNormRes, pg8::TileOrder, false, true>(lds, g, S, E);
                if (l == 0 || k == 2) { __syncthreads();
                    pg8::TileOrder S2; S2.init(2, DM, K, nbl, bid, k == 10 ? 4 : 11);
                    pg8::EpiSlab E2{(float*)(ws + WS_AUP)};
                    pg8::gemm_phase<pg8::EpiSlab, pg8::TileOrder, true, true>(lds, g, S2, E2); } }
            else if (k == 6) {
                pg8::Gemm g{(const pg8::bf16_t*)(ws + WS_AUP), (const pg8::bf16_t*)(ws + WS_WUP), R, NUP, KUP}; pg8::TileOrder S; S.init(3, NUP, KUP, nbl, bid, 1);
                pg8::EpiStore E{(pg8::bf16_t*)A_.out(), NUP};
                pg8::gemm_phase<pg8::EpiStore, pg8::TileOrder, true, true>(lds, g, S, E);
                if (k == 6) {
                    __syncthreads();
                    for (int u = bid; u < 512; u += nbl)
                        ml::mlstm_local((const ml::bf16*)(ws + WS_BIG), (const float*)(ws + WS_MS + MS_T), A_.in(I_CW) + (size_t)l * 3 * 1024, A_.in(I_CB) + (size_t)l * 1024,
                                        (float*)(ws + WS_HF), (float*)(ws + WS_MS + MS_NLOC), u, (char*)lds_raw); } }
            else if (k == 3 || k == 11 || k == 14) { TID_DECL; phase_rw_b(A_, l, k == 3 ? 0 : (k == 11 ? 1 : 2), bid, nbl, wave, lane); if (k == 14 && l == 0) wconv_layer(A_, 1, lds, bid, nbl, wave, lane); }
            else if (k == 4) {
                pg8::Gemm g{(const pg8::bf16_t*)(ws + WS_H), (const pg8::bf16_t*)(ws + WS_WIN), R, DINP, DM}; pg8::TileOrder S; S.init(0, DINP, DM, nbl, bid, 1);
                pg8::EpiP E{(pg8::bf16_t*)(ws + WS_BIG), DINP, (float*)(ws + WS_BIG + BIG_G)};
                pg8::gemm_phase<pg8::EpiP, pg8::TileOrder, true, true>(lds, g, S, E); }
            else if (k == 5) { TID_DECL; phase_rw_prep(A_, l, bid, nbl, wave, lane); }
            else if (k == 7 || k == 8) {
                if (k == 7) { TID_DECL; ml::mlstm_scan((const float*)(ws + WS_HF), (const float*)(ws + WS_MS + MS_NLOC), (const float*)(ws + WS_MS + MS_SCA), (ml::bf16*)(ws + WS_AUP), (float*)(ws + WS_MS + MS_NST), (float*)(ws + WS_MS + MS_BM), bid * NTHREADS + tid, nbl * NTHREADS); }
                att::bf16* QKV = (att::bf16*)A_.out(); const att::bf16* KR = (const att::bf16*)(ws + WS_BIG + BIG_KR);
                const float* tab = (const float*)(ws + WS_TAB);
                int u0, u1;
                if (k == 8) { u0 = bid; u1 = 256; } else { u0 = (l == 0 && bid >= 128) ? 256 + (bid - 128) : 272; u1 = 272; }
                for (int u = u0; u < u1; u += nbl) {
                    int b, h, seq, rope, qtok0; size_t rq;
                    if (u < 256) { b = u >> 6; h = (u >> 4) & 3; const int qb = u & 15; rq = (size_t)b * TB + CTXL + (size_t)qb * 256; seq = TB; rope = 1; qtok0 = qb * 256; }
                    else { b = (u - 256) >> 2; h = (u - 256) & 3; rq = (size_t)b * TB; seq = CTXL; rope = 0; qtok0 = 0; }
                    const size_t r0 = (size_t)b * TB;
                    const int panel = u < 256 ? (b * 16 + (u & 15)) : (64 + b);
                    att::attn_body(QKV + rq * NUP + h * 192, QKV + r0 * NUP + 768 + h * 256, QKV + r0 * NUP + 768 + h * 256 + 128, KR + r0 * 64, (att::bf16*)(ws + WS_H) + rq * DM + h * 128, seq, rope, qtok0, tab, (char*)lds_raw,
                                   (unsigned*)(ws + WS_MS + MS_X1) + rq * 4, (unsigned*)(ws + WS_CTL + 65536) + (size_t)(12 + l) * (68 * 64) + 64 * panel, A_.in(I_AON) + l * 512 + h * 128, h);
                }
                const int m0 = nbl - 1 - bid, m1 = (k == 8) ? 256 : ((l == 0) ? 16 : 0);
                for (int u = m0; u < m1; u += nbl) { const int bh = (k == 8) ? (u >> 4) : u, tbk = (k == 8) ? 1 + (u & 15) : 0;
                    ml::mlstm_out2((const ml::bf16*)(ws + WS_BIG), (const float*)(ws + WS_MS + MS_T), A_.in(I_CW) + (size_t)l * 3 * 1024, A_.in(I_CB) + (size_t)l * 1024, (const ml::bf16*)(ws + WS_AUP),
                                   (const float*)(ws + WS_MS + MS_NST), (const float*)(ws + WS_MS + MS_BM), A_.in(I_MN) + l * 512, (ml::bf16*)(ws + WS_H), bh >> 2, bh & 3, tbk, (char*)lds_raw); }
            }
        }
        if (ph + 1 < args.ph_hi) { if (args.ph_hi < 0) grid.sync(); else xcd_barrier(barl); }
    }
}

#ifndef MK_ONE_LAUNCH
#define MK_ONE_LAUNCH 1
#endif
extern "C" void kernel_launch(void* const* d_in, const int* in_sizes, int n_in, void* d_out, int out_size, void* d_ws, size_t ws_size, hipStream_t stream) {
    static int grid = 0;
    if (grid == 0) {
        if (n_in != 22 || in_sizes[0] != NB * SEQ * DM || out_size != NB * SEQ * DM || ws_size < WS_END) { fprintf(stderr, "kernel_launch: shape/workspace mismatch (n_in %d, in0 %d, out %d, ws %zu need %zu)\n", n_in, n_in > 0 ? in_sizes[0] : -1, out_size, ws_size, (size_t)WS_END); grid = -1; return; }
        int dev = 0, cus = 0, per_cu = 0;
        if (hipGetDevice(&dev) != hipSuccess || hipDeviceGetAttribute(&cus, hipDeviceAttributeMultiprocessorCount, dev) != hipSuccess) { grid = -1; return; }
        if (hipFuncSetAttribute((const void*)mega_fwd, hipFuncAttributeMaxDynamicSharedMemorySize, LDS_BYTES) != hipSuccess) { fprintf(stderr, "kernel_launch: hipFuncSetAttribute failed\n"); grid = -1; return; }
        if (hipOccupancyMaxActiveBlocksPerMultiprocessor(&per_cu, (const void*)mega_fwd, NTHREADS, LDS_BYTES) != hipSuccess || per_cu < 1) { fprintf(stderr, "kernel_launch: occupancy query says %d\n", per_cu); per_cu = 1; }
        (void)hipGetLastError();
        grid = cus * (per_cu > 1 ? 1 : per_cu);
    }
    if (grid < 0) return;
    if (hipMemsetAsync((char*)d_ws + WS_CTL, 0, 65536 + 14 * 68 * 256, stream) != hipSuccess) { fprintf(stderr, "kernel_launch: memset of the barrier words failed\n"); return; }
    Args a{};
    for (int i = 0; i < 22; ++i) a.in[i] = (const float*)d_in[i];
    a.out = (float*)d_out; a.ws = (unsigned char*)d_ws;
#if MK_ONE_LAUNCH
    a.ph_lo = 0; a.ph_hi = N_PHASES;
    void* kargs[] = {&a};
    hipError_t e = hipLaunchCooperativeKernel((const void*)mega_fwd, dim3(grid), dim3(NTHREADS), kargs, LDS_BYTES, stream);
    if (e != hipSuccess) fprintf(stderr, "kernel_launch: cooperative launch failed: %s (grid %d)\n", hipGetErrorString(e), grid);
#else
    for (int ph = 0; ph < N_PHASES; ++ph) { if (ph == SKIP_PHASE) continue; a.ph_lo = ph; a.ph_hi = ph + 1;
        hipLaunchKernelGGL(mega_fwd, dim3(grid), dim3(NTHREADS), LDS_BYTES, stream, a);
        const hipError_t le = hipPeekAtLastError(); if (le != hipSuccess) { fprintf(stderr, "kernel_launch: launch of phase %d failed: %s\n", ph, hipGetErrorName(le)); break; } }
#endif
}
```

```cpp
#include <hip/hip_runtime.h>
#include <hip/hip_cooperative_groups.h>
#include <cstdio>
#include <cstdint>
namespace cg = cooperative_groups;
namespace pg8 {
#define PG8_LAS __attribute__((address_space(3)))
typedef unsigned short bf16_t;
typedef short bf16x8 __attribute__((ext_vector_type(8)));
typedef float f32x4 __attribute__((ext_vector_type(4)));
typedef unsigned u32x4 __attribute__((ext_vector_type(4)));
constexpr int BM = 256, BK = 64, HALF = 128, HTB = HALF * BK * 2  , STAGE_BYTES = 8 * HTB, NXCD = 8, WGM = 8;

__host__ __device__ __forceinline__ int lds_byte(int r, int c) { const int st = (r >> 4) * 2 + (c >> 5), rr = r & 15, cc = c & 31, ob = rr * 64 + cc * 2; return st * 1024 + (ob ^ (((ob >> 9) & 1) << 5)); }
__host__ __device__ __forceinline__ void stage_rc(int b, int& R, int& C) { const int st = b / 1024, sb = b % 1024, swz = sb ^ (((sb >> 9) & 1) << 5); R = (st >> 1) * 16 + swz / 64; C = (st & 1) * 32 + (swz % 64) / 2; }
__host__ __device__ __forceinline__ int perm32(int rho) { const int n = rho >> 4, i = rho & 15; return 8 * (i >> 2) + 4 * n + (i & 3); }

struct Unit { int pm, pn, kt0, nkt; };
struct Gemm { const bf16_t* A; const bf16_t* Bt; int M, N, K; };

struct StaticOrder {
    int nM, nN, nwg, G, c, nkt;
    __host__ __device__ void init(int M, int N, int K, int G_, int c_) { nM = M / BM; nN = N / BM; nwg = nM * nN; G = G_; c = c_; nkt = K / BK; }
    __host__ __device__ bool next(int i, Unit& u) const {
        const long L = (long)i * G + c; if (L >= nwg) return false;
        int wgid = (int)L; { const int q = nwg / NXCD, r = nwg % NXCD, xcd = wgid % NXCD, off = wgid / NXCD; wgid = (xcd < r ? xcd * (q + 1) : r * (q + 1) + (xcd - r) * q) + off; }
        const int nig = WGM * nN, gid = wgid / nig, fm = gid * WGM, gsz = (nM - fm) < WGM ? (nM - fm) : WGM;
        u.pm = fm + ((wgid % nig) % gsz); u.pn = (wgid % nig) / gsz; u.kt0 = 0; u.nkt = nkt; return true;
    }
    __device__ __forceinline__ void a_ready(const Unit&) const {}
    __device__ __forceinline__ void done(const Unit&) const {}
};

__device__ __forceinline__ unsigned cvt_pk_bf16(float lo, float hi) { unsigned r; asm volatile("v_cvt_pk_bf16_f32 %0, %1, %2" : "=v"(r) : "v"(lo), "v"(hi)); return r; }
typedef float f32x2 __attribute__((ext_vector_type(2)));
__device__ __forceinline__ f32x2 gelu_pk(f32x2 v) {
    const f32x2 av = __builtin_elementwise_abs(v), d = av * 0.2316418882f + 1.0f;
    f32x2 t; t.x = __builtin_amdgcn_rcpf(d.x); t.y = __builtin_amdgcn_rcpf(d.y);
    f32x2 q = t * 0.5307027145f + (-0.7265760135f); q = q * t + 0.7107068705f; q = q * t + (-0.142248368f); q = q * t + 0.127414796f; q = q * t;
    const f32x2 s = (v * v) * (-0.72134752044f);
    f32x2 e; e.x = __builtin_amdgcn_exp2f(s.x); e.y = __builtin_amdgcn_exp2f(s.y);
    const f32x2 m = v * (q * e), r = v - m;
    f32x2 o; o.x = v.x < 0.f ? m.x : r.x; o.y = v.y < 0.f ? m.y : r.y; return o;
}
__device__ __forceinline__ float silu_f(float x) { return x * __builtin_amdgcn_rcpf(1.0f + __builtin_amdgcn_exp2f(-1.4426950408889634f * x)); }
__device__ __forceinline__ void st8(bf16_t* p, f32x4 v0, f32x4 v1) { u32x4 w; w.x = cvt_pk_bf16(v0[0], v0[1]); w.y = cvt_pk_bf16(v0[2], v0[3]); w.z = cvt_pk_bf16(v1[0], v1[1]); w.w = cvt_pk_bf16(v1[2], v1[3]); *(u32x4*)p = w; }
struct EpiStore {
    static constexpr bool PERM = true, AFTER_DRAIN = false;
    bf16_t* O; int ldc;
    __device__ __forceinline__ void operator()(const f32x4 (&acc)[2][2][4][2], const Unit& u, int wr, int wc, int fr, int fq) const {
        const int row0 = u.pm * BM + wr * 64 + fr, col0 = u.pn * BM + wc * 32 + 8 * fq;
#pragma unroll
        for (int ai = 0; ai < 2; ++ai)
#pragma unroll
            for (int m = 0; m < 4; ++m) { bf16_t* rowp = O + (size_t)(row0 + ai * HALF + m * 16) * ldc + col0;
#pragma unroll
                for (int bj = 0; bj < 2; ++bj) st8(rowp + bj * HALF, acc[ai][bj][m][0], acc[ai][bj][m][1]); }
    }
};
struct EpiSwiGLU {
    static constexpr bool PERM = true, AFTER_DRAIN = false;
    bf16_t* O; int ldc;
    __device__ __forceinline__ void operator()(const f32x4 (&acc)[2][2][4][2], const Unit& u, int wr, int wc, int fr, int fq) const {
        const int row0 = u.pm * BM + wr * 64 + fr, col0 = u.pn * HALF + wc * 32 + 8 * fq;
#pragma unroll
        for (int ai = 0; ai < 2; ++ai)
#pragma unroll
            for (int m = 0; m < 4; ++m) { bf16_t* rowp = O + (size_t)(row0 + ai * HALF + m * 16) * ldc + col0;
                f32x4 v0, v1;
#pragma unroll
                for (int j = 0; j < 4; ++j) { v0[j] = silu_f(acc[ai][0][m][0][j]) * acc[ai][1][m][0][j]; v1[j] = silu_f(acc[ai][0][m][1][j]) * acc[ai][1][m][1][j]; }
                st8(rowp, v0, v1); }
    }
};
struct EpiP {
    static constexpr bool PERM = true, AFTER_DRAIN = false;
    bf16_t* O; int ldc; float* G;
    __device__ __forceinline__ void operator()(const f32x4 (&acc)[2][2][4][2], const Unit& u, int wr, int wc, int fr, int fq) const {
        const int row0 = u.pm * BM + wr * 64 + fr, col0 = u.pn * BM + wc * 32 + 8 * fq;
        const bool gt = (u.pn == 9) && (wc == 2) && (fq < 2);
#pragma unroll
        for (int ai = 0; ai < 2; ++ai)
#pragma unroll
            for (int m = 0; m < 4; ++m) { const int row = row0 + ai * HALF + m * 16; bf16_t* rowp = O + (size_t)row * ldc + col0;
#pragma unroll
                for (int bj = 0; bj < 2; ++bj) st8(rowp + bj * HALF, acc[ai][bj][m][0], acc[ai][bj][m][1]);
                if (gt) { *(f32x4*)(G + (size_t)row * 16 + 8 * fq) = acc[ai][1][m][0]; *(f32x4*)(G + (size_t)row * 16 + 8 * fq + 4) = acc[ai][1][m][1]; } }
    }
};
struct EpiSlab {
    static constexpr bool PERM = false, AFTER_DRAIN = false;
    float* S;
    __device__ __forceinline__ void operator()(const f32x4 (&acc)[2][2][4][2], const Unit& u, int wr, int wc, int fr, int fq) const {
        const int row0 = (u.pm / 17) * BM + wr * 64 + fr, col0 = u.pn * BM + wc * 32 + 4 * fq; const int slice = u.kt0 / u.nkt;
        float* base = S + (size_t)slice * 1024 * 1024;
#pragma unroll
        for (int ai = 0; ai < 2; ++ai)
#pragma unroll
            for (int m = 0; m < 4; ++m) { float* rowp = base + (size_t)(row0 + ai * HALF + m * 16) * 1024 + col0;
#pragma unroll
                for (int bj = 0; bj < 2; ++bj)
#pragma unroll
                    for (int n = 0; n < 2; ++n) *(f32x4*)(rowp + bj * HALF + n * 16) = acc[ai][bj][m][n]; }
    }
};
struct TileOrder {
    int mode, nM, nN, nwg, G, c, nkt, nsl;
    __device__ void init(int mode_, int N, int K, int G_, int c_, int nsl_) { mode = mode_; nN = N / BM; G = G_; c = c_; nsl = nsl_;
        if (mode == 2) { nM = 4; nwg = 4 * nN * nsl; nkt = (K / BK) / nsl; } else { nM = mode == 1 ? 64 : 68; nwg = nM * nN; nkt = K / BK; } }
    __device__ bool next(int i, Unit& u) const {
        const long L = (long)i * G + c; if (L >= nwg) return false;
        if (mode == 2) { const int sl = (int)L % nsl, t = (int)L / nsl; u.pn = t % nN; u.pm = 17 * (t / nN); u.kt0 = sl * nkt; u.nkt = nkt; return true; }
        int wgid = (int)L; { const int q = nwg / NXCD, r = nwg % NXCD, xcd = wgid % NXCD, off = wgid / NXCD; wgid = (xcd < r ? xcd * (q + 1) : r * (q + 1) + (xcd - r) * q) + off; }
        const int nig = WGM * nN, gid = wgid / nig, fm = gid * WGM, gsz = (nM - fm) < WGM ? (nM - fm) : WGM;
        int pm = fm + ((wgid % nig) % gsz); u.pn = (wgid % nig) / gsz; if (mode == 1) pm += (pm >> 4) + 1;
        u.pm = pm; u.kt0 = 0; u.nkt = nkt;
        if (mode == 3) { if (u.pn < 3) { u.kt0 = 0; u.nkt = 4; } else { u.kt0 = 4; u.nkt = 2; } }
        return true;
    }
    __device__ __forceinline__ void a_ready(const Unit&) const {}
    __device__ __forceinline__ void done(const Unit&) const {}
};

struct PanelSS {
    unsigned* xbuf;
    unsigned* cnt;
    __device__ __forceinline__ void run(const f32x4 (&v)[2][2][4][2], const Unit& u, int wr, int wc, int fr, int fq, PG8_LAS unsigned char* lds, int wid, int lane) const {
        PG8_LAS float* P = (PG8_LAS float*)lds;
        PG8_LAS float* S = (PG8_LAS float*)(lds + 8192);
#pragma unroll
        for (int ai = 0; ai < 2; ++ai)
#pragma unroll
            for (int m = 0; m < 4; ++m) { float s = 0.f;
#pragma unroll
                for (int bj = 0; bj < 2; ++bj)
#pragma unroll
                    for (int n = 0; n < 2; ++n) { const f32x4 x = v[ai][bj][m][n]; s += (x[0] * x[0] + x[1] * x[1]) + (x[2] * x[2] + x[3] * x[3]); }
                s += __shfl_xor(s, 16); s += __shfl_xor(s, 32);
                if (fq == 0) P[(ai * HALF + wr * 64 + m * 16 + fr) * 4 + wc] = s; }
        asm volatile("s_waitcnt lgkmcnt(0)" ::: "memory"); __builtin_amdgcn_s_barrier(); asm volatile("" ::: "memory");
        const int row = wid * 32 + (lane & 31);
        if (lane < 32) { const float t = (P[row * 4 + 0] + P[row * 4 + 1]) + (P[row * 4 + 2] + P[row * 4 + 3]);
            __hip_atomic_store(xbuf + (size_t)(u.pm * BM + row) * 4 + u.pn, __float_as_uint(t), __ATOMIC_RELAXED, __HIP_MEMORY_SCOPE_AGENT); }
        asm volatile("s_waitcnt vmcnt(0)" ::: "memory");
        if (lane == 0) __hip_atomic_fetch_add(cnt + 64 * u.pm, 1u, __ATOMIC_RELAXED, __HIP_MEMORY_SCOPE_AGENT);
        if (wid == 0) { unsigned sp = 0;
            while ((unsigned)__builtin_amdgcn_readfirstlane(__hip_atomic_load(cnt + 64 * u.pm, __ATOMIC_RELAXED, __HIP_MEMORY_SCOPE_AGENT)) < 32u) { __builtin_amdgcn_s_sleep(2); if (++sp > (1u << 22)) break; }
            __builtin_amdgcn_fence(__ATOMIC_ACQUIRE, "agent"); }
        asm volatile("s_waitcnt vmcnt(0) lgkmcnt(0)" ::: "memory"); __builtin_amdgcn_s_barrier(); asm volatile("" ::: "memory");
        if (lane < 32) { const unsigned* slot = xbuf + (size_t)(u.pm * BM + row) * 4; float t = 0.f;
#pragma unroll
            for (int q = 0; q < 4; ++q) t += __uint_as_float(__hip_atomic_load(slot + q, __ATOMIC_RELAXED, __HIP_MEMORY_SCOPE_AGENT));
            S[row] = t; }
        asm volatile("s_waitcnt lgkmcnt(0)" ::: "memory"); __builtin_amdgcn_s_barrier(); asm volatile("" ::: "memory");
    }
};
struct EpiNormRes {
    static constexpr bool PERM = false, AFTER_DRAIN = true;
    bf16_t* xb; float* xout;
    bf16_t* H;
    const float* gate; const float* gpost;
    const float* gpre; const float* sc; const float* sh;
    float wgt; PanelSS st1, st2;
    __device__ __forceinline__ void fused(f32x4 (&acc)[2][2][4][2], const Unit& u, int wr, int wc, int fr, int fq, PG8_LAS unsigned char* lds, int wid, int lane) const {
        const PG8_LAS float* S = (const PG8_LAS float*)(lds + 8192);
        const int b = u.pm / 17, tp = (u.pm - 17 * b - 1) * BM;
        const int col0 = u.pn * BM + wc * 32 + 4 * fq; const size_t mo = (size_t)b * 9 * 1024;
        st1.run(acc, u, wr, wc, fr, fq, lds, wid, lane);
        {   f32x4 cg[2][2];
#pragma unroll
            for (int bj = 0; bj < 2; ++bj)
#pragma unroll
                for (int n = 0; n < 2; ++n) cg[bj][n] = *(const f32x4*)(gate + mo + col0 + bj * HALF + n * 16) * *(const f32x4*)(gpost + col0 + bj * HALF + n * 16) * wgt;
            typedef unsigned u32x2r __attribute__((ext_vector_type(2)));
            if (H == nullptr) {
#pragma unroll
            for (int ai = 0; ai < 2; ++ai)
#pragma unroll
                for (int m = 0; m < 4; ++m) { const int r = ai * HALF + wr * 64 + m * 16 + fr; const float rs = 1.0f / sqrtf(S[r] * (1.0f / 1024.0f) + 1e-6f);
                    const size_t off = ((size_t)b * 4096 + tp + r) * 1024 + col0;
#pragma unroll
                    for (int bj = 0; bj < 2; ++bj)
#pragma unroll
                        for (int n = 0; n < 2; ++n) { const u32x2r w = *(const u32x2r*)(xb + off + bj * HALF + n * 16); f32x4 xo; xo[0] = __uint_as_float(w.x << 16); xo[1] = __uint_as_float(w.x & 0xffff0000u); xo[2] = __uint_as_float(w.y << 16); xo[3] = __uint_as_float(w.y & 0xffff0000u);
                            *(f32x4*)(xout + off + bj * HALF + n * 16) = xo + cg[bj][n] * (acc[ai][bj][m][n] * rs); }
                    if (m & 1) asm volatile("" ::: "memory"); }
                return; }
#pragma unroll
            for (int ai = 0; ai < 2; ++ai)
#pragma unroll
                for (int m = 0; m < 4; ++m) { const int r = ai * HALF + wr * 64 + m * 16 + fr; const float rs = 1.0f / sqrtf(S[r] * (1.0f / 1024.0f) + 1e-6f);
                    const size_t off = ((size_t)b * 4096 + tp + r) * 1024 + col0;
#pragma unroll
                    for (int bj = 0; bj < 2; ++bj)
#pragma unroll
                        for (int n = 0; n < 2; ++n) { const u32x2r w = *(const u32x2r*)(xb + off + bj * HALF + n * 16); f32x4 xo; xo[0] = __uint_as_float(w.x << 16); xo[1] = __uint_as_float(w.x & 0xffff0000u); xo[2] = __uint_as_float(w.y << 16); xo[3] = __uint_as_float(w.y & 0xffff0000u);
                            const f32x4 xn = xo + cg[bj][n] * (acc[ai][bj][m][n] * rs);
                            acc[ai][bj][m][n] = xn; u32x2r o; o.x = cvt_pk_bf16(xn[0], xn[1]); o.y = cvt_pk_bf16(xn[2], xn[3]); *(u32x2r*)(xb + off + bj * HALF + n * 16) = o; }
                    asm volatile("" : "+v"(acc[ai][0][m][0]), "+v"(acc[ai][0][m][1]), "+v"(acc[ai][1][m][0]), "+v"(acc[ai][1][m][1]));
                    if (m & 1) asm volatile("" ::: "memory"); } }
        asm volatile("s_waitcnt lgkmcnt(0)" ::: "memory"); __builtin_amdgcn_s_barrier(); asm volatile("" ::: "memory");
        st2.run(acc, u, wr, wc, fr, fq, lds, wid, lane);
        {   typedef unsigned u32x2v __attribute__((ext_vector_type(2)));
            f32x4 ca[2][2], cs[2][2];
#pragma unroll
            for (int bj = 0; bj < 2; ++bj)
#pragma unroll
                for (int n = 0; n < 2; ++n) { const int c = col0 + bj * HALF + n * 16; ca[bj][n] = *(const f32x4*)(gpre + c) * (*(const f32x4*)(sc + mo + c) + 1.0f); cs[bj][n] = *(const f32x4*)(sh + mo + c); }
#pragma unroll
            for (int ai = 0; ai < 2; ++ai)
#pragma unroll
                for (int m = 0; m < 4; ++m) { const int r = ai * HALF + wr * 64 + m * 16 + fr; const float rs = 1.0f / sqrtf(S[r] * (1.0f / 1024.0f) + 1e-6f);
                    bf16_t* hp = H + (size_t)(u.pm * BM + r) * 1024 + col0;
#pragma unroll
                    for (int bj = 0; bj < 2; ++bj)
#pragma unroll
                        for (int n = 0; n < 2; ++n) { const f32x4 o = acc[ai][bj][m][n] * rs * ca[bj][n] + cs[bj][n]; u32x2v w; w.x = cvt_pk_bf16(o[0], o[1]); w.y = cvt_pk_bf16(o[2], o[3]);
                            *(u32x2v*)(hp + bj * HALF + n * 16) = w; } } }
    }
};

template <class Epi, class Sched, bool ALIGN_EPI = false, bool SP2 = false>
__device__ __forceinline__ void gemm_phase(PG8_LAS unsigned char* lds, const Gemm g, const Sched& S, const Epi& E) {
    int tid_ = threadIdx.x; asm volatile("" : "+v"(tid_));
    const int tid = tid_, wid = __builtin_amdgcn_readfirstlane(tid >> 6), lane = tid & 63, wr = wid >> 2, wc = wid & 3, fr = lane & 15, fq = lane >> 4;
    const int K = g.K;
    unsigned voffA[2], voffB[2];
#pragma unroll
    for (int i = 0; i < 2; ++i) { int R, C; stage_rc(tid * 16 + i * 8192, R, C); const int Rb = Epi::PERM ? ((R & ~31) + perm32(R & 31)) : R;
        voffA[i] = (unsigned)(R * K + C) * 2u; voffB[i] = (unsigned)(Rb * K + C) * 2u; }
    const size_t kstep = (size_t)(BK * 2);
    const size_t hstep = (size_t)HALF * K * 2;
    const size_t tstep = 2 * hstep;
    const unsigned ldsw = (unsigned)wid * 1024u;
    const int aoff = lds_byte(wr * 64 + fr, fq * 8), boff = lds_byte(wc * 32 + fr, fq * 8);
#define PG8_SA(b, h) (((b) * 2 + (h)) * HTB)
#define PG8_SB(b, h) ((4 + (b) * 2 + (h)) * HTB)
#define PG8_STAGE(bufoff, gbase, voff) do { _Pragma("unroll") for (int _i = 0; _i < 2; ++_i) \
        __builtin_amdgcn_global_load_lds((const unsigned*)((const char*)(gbase) + (voff)[_i]), (PG8_LAS unsigned*)(lds + (bufoff) + ldsw + _i * 8192), 16, 0, 0); } while (0)
#define PG8_LDA(dst, b, h) do { _Pragma("unroll") for (int m = 0; m < 4; ++m) _Pragma("unroll") for (int k = 0; k < 2; ++k) dst[m][k] = *(const PG8_LAS bf16x8*)(lds + PG8_SA(b, h) + aoff + m * 2048 + k * 1024); } while (0)
#define PG8_LDB(dst, b, h) do { _Pragma("unroll") for (int n = 0; n < 2; ++n) _Pragma("unroll") for (int k = 0; k < 2; ++k) dst[n][k] = *(const PG8_LAS bf16x8*)(lds + PG8_SB(b, h) + boff + n * 2048 + k * 1024); } while (0)
#define PG8_MMA(ai, bj, At, Bt) do { __builtin_amdgcn_s_setprio(1); _Pragma("unroll") for (int m = 0; m < 4; ++m) _Pragma("unroll") for (int n = 0; n < 2; ++n) _Pragma("unroll") for (int k = 0; k < 2; ++k) \
        acc[ai][bj][m][n] = __builtin_amdgcn_mfma_f32_16x16x32_bf16(Bt[n][k], At[m][k], acc[ai][bj][m][n], 0, 0, 0); __builtin_amdgcn_s_setprio(0); } while (0)
#define PG8_WAIT_V(n) asm volatile("s_waitcnt vmcnt(" #n ")" ::: "memory")
#define PG8_WAIT_L(n) asm volatile("s_waitcnt lgkmcnt(" #n ")" ::: "memory")
#define PG8_BAR __builtin_amdgcn_s_barrier()
#define PG8_SCHED __builtin_amdgcn_sched_barrier(0)
    Unit cur, nxt; int ui = 0;
    if (!S.next(0, cur)) return;
    f32x4 acc[2][2][4][2];
#pragma unroll
    for (int a = 0; a < 2; ++a)
#pragma unroll
        for (int b = 0; b < 2; ++b)
#pragma unroll
            for (int m = 0; m < 4; ++m)
#pragma unroll
                for (int n = 0; n < 2; ++n) acc[a][b][m][n] = (f32x4){0.f, 0.f, 0.f, 0.f};
    bf16x8 At[4][2], B0[2][2], B1[2][2];
    const char* cA = (const char*)g.A + (size_t)cur.pm * tstep + (size_t)cur.kt0 * kstep; const char* cB = (const char*)g.Bt + (size_t)cur.pn * tstep + (size_t)cur.kt0 * kstep;
    S.a_ready(cur);
    if constexpr (SP2) {
        PG8_STAGE(PG8_SB(0, 0), cB, voffB); PG8_STAGE(PG8_SB(0, 1), cB + hstep, voffB); PG8_STAGE(PG8_SA(0, 0), cA, voffA); PG8_STAGE(PG8_SA(0, 1), cA + hstep, voffA);
        if (wr == 1) PG8_BAR;
        PG8_WAIT_V(2); PG8_BAR;
        PG8_STAGE(PG8_SB(1, 0), cB + kstep, voffB); PG8_STAGE(PG8_SA(1, 0), cA + kstep, voffA); PG8_STAGE(PG8_SB(1, 1), cB + hstep + kstep, voffB);
        PG8_WAIT_V(6); PG8_BAR;
    } else {
        PG8_STAGE(PG8_SB(0, 0), cB, voffB); PG8_STAGE(PG8_SA(0, 0), cA, voffA); PG8_STAGE(PG8_SB(0, 1), cB + hstep, voffB); PG8_STAGE(PG8_SA(0, 1), cA + hstep, voffA);
        if (wr == 1) PG8_BAR;
        PG8_WAIT_V(4); PG8_BAR;
        PG8_STAGE(PG8_SB(1, 0), cB + kstep, voffB); PG8_STAGE(PG8_SA(1, 0), cA + kstep, voffA); PG8_STAGE(PG8_SB(1, 1), cB + hstep + kstep, voffB);
        PG8_WAIT_V(6); PG8_BAR;
    }
    for (;;) {
        const bool has_next = S.next(ui + 1, nxt);
        const char* nA = has_next ? (const char*)g.A + (size_t)nxt.pm * tstep + (size_t)nxt.kt0 * kstep : cA; const char* nB = has_next ? (const char*)g.Bt + (size_t)nxt.pn * tstep + (size_t)nxt.kt0 * kstep : cB;
        const int nt = cur.nkt;
        for (int t = 0; t < nt; t += 2) {
            const bool last = (t == nt - 2);
            const char* a1 = cA + (size_t)(t + 1) * kstep;
            const char* a2 = last ? nA : cA + (size_t)(t + 2) * kstep; const char* b2 = last ? nB : cB + (size_t)(t + 2) * kstep;
            const char* a3 = a2 + kstep; const char* b3 = b2 + kstep;
            if (last && has_next) S.a_ready(nxt);
            if constexpr (SP2) {
            PG8_LDB(B0, 0, 0); PG8_LDB(B1, 0, 1); PG8_SCHED; PG8_LDA(At, 0, 0); PG8_STAGE(PG8_SA(1, 1), a1 + hstep, voffA);
            PG8_WAIT_V(8); PG8_WAIT_L(0); PG8_BAR; PG8_MMA(0, 0, At, B0); PG8_MMA(0, 1, At, B1); PG8_BAR; PG8_SCHED;
            PG8_LDA(At, 0, 1); PG8_STAGE(PG8_SB(0, 0), b2, voffB); PG8_STAGE(PG8_SB(0, 1), b2 + hstep, voffB); PG8_STAGE(PG8_SA(0, 0), a2, voffA);
            PG8_WAIT_V(8); PG8_WAIT_L(0); PG8_BAR; PG8_MMA(1, 0, At, B0); PG8_MMA(1, 1, At, B1); PG8_BAR; PG8_SCHED;
            PG8_LDB(B0, 1, 0); PG8_LDB(B1, 1, 1); PG8_SCHED; PG8_LDA(At, 1, 0); PG8_STAGE(PG8_SA(0, 1), a2 + hstep, voffA);
            PG8_WAIT_V(8); PG8_WAIT_L(0); PG8_BAR; PG8_MMA(0, 0, At, B0); PG8_MMA(0, 1, At, B1); PG8_BAR; PG8_SCHED;
            PG8_LDA(At, 1, 1); PG8_STAGE(PG8_SB(1, 0), b3, voffB); PG8_STAGE(PG8_SB(1, 1), b3 + hstep, voffB); PG8_STAGE(PG8_SA(1, 0), a3, voffA);
            PG8_WAIT_V(8); PG8_WAIT_L(0); PG8_BAR; PG8_MMA(1, 0, At, B0); PG8_MMA(1, 1, At, B1); PG8_BAR; PG8_SCHED;
            } else {
            PG8_LDB(B0, 0, 0); PG8_SCHED; PG8_LDA(At, 0, 0); PG8_STAGE(PG8_SA(1, 1), a1 + hstep, voffA);
            PG8_WAIT_L(8); PG8_BAR; PG8_WAIT_L(0); PG8_MMA(0, 0, At, B0); PG8_BAR; PG8_SCHED;
            PG8_LDB(B1, 0, 1); PG8_STAGE(PG8_SB(0, 0), b2, voffB);
            PG8_BAR; PG8_WAIT_L(0); PG8_MMA(0, 1, At, B1); PG8_BAR;
            PG8_LDA(At, 0, 1); PG8_STAGE(PG8_SA(0, 0), a2, voffA);
            PG8_BAR; PG8_WAIT_L(0); PG8_MMA(1, 0, At, B0); PG8_BAR; PG8_SCHED;
            PG8_STAGE(PG8_SB(0, 1), b2 + hstep, voffB);
            PG8_WAIT_V(6); PG8_BAR; PG8_MMA(1, 1, At, B1); PG8_BAR;
            PG8_LDB(B0, 1, 0); PG8_SCHED; PG8_LDA(At, 1, 0); PG8_STAGE(PG8_SA(0, 1), a2 + hstep, voffA);
            PG8_WAIT_L(8); PG8_BAR; PG8_WAIT_L(0); PG8_MMA(0, 0, At, B0); PG8_BAR; PG8_SCHED;
            PG8_LDB(B1, 1, 1); PG8_STAGE(PG8_SB(1, 0), b3, voffB);
            PG8_BAR; PG8_WAIT_L(0); PG8_MMA(0, 1, At, B1); PG8_BAR;
            PG8_LDA(At, 1, 1); PG8_STAGE(PG8_SA(1, 0), a3, voffA);
            PG8_BAR; PG8_WAIT_L(0); PG8_MMA(1, 0, At, B0); PG8_BAR; PG8_SCHED;
            PG8_STAGE(PG8_SB(1, 1), b3 + hstep, voffB);
            PG8_WAIT_V(6); PG8_BAR; PG8_MMA(1, 1, At, B1); PG8_BAR;
            }
        }
        if constexpr (ALIGN_EPI) { if (wr == 0) PG8_BAR; }
        if constexpr (!Epi::AFTER_DRAIN) { E(acc, cur, wr, wc, fr, fq); S.done(cur); }
        if (!has_next) break;
#pragma unroll
        for (int a = 0; a < 2; ++a)
#pragma unroll
            for (int b = 0; b < 2; ++b)
#pragma unroll
                for (int m = 0; m < 4; ++m)
#pragma unroll
                    for (int n = 0; n < 2; ++n) acc[a][b][m][n] = (f32x4){0.f, 0.f, 0.f, 0.f};
        cur = nxt; cA = nA; cB = nB; ++ui;
        if constexpr (ALIGN_EPI) { if (wr == 1) PG8_BAR; }
    }
    PG8_WAIT_V(0);
    if constexpr (!ALIGN_EPI) { if (wr == 0) PG8_BAR; }
    PG8_BAR;
    if constexpr (Epi::AFTER_DRAIN) { E.fused(acc, cur, wr, wc, fr, fq, lds, wid, lane); S.done(cur); }
#undef PG8_SA
#undef PG8_SB
#undef PG8_STAGE
#undef PG8_LDA
#undef PG8_LDB
#undef PG8_MMA
#undef PG8_WAIT_V
#undef PG8_WAIT_L
#undef PG8_BAR
#undef PG8_SCHED
}
}
namespace att {
typedef unsigned short bf16;
constexpr int NW = 8, QBLK = 32, KVBLK = 64;
constexpr float SCALE = 0.07216878364870322f;
constexpr float THR = 8.f;
constexpr int SDEPTH = 1;
constexpr int LDQ = 1792, LDK = 1792, LDR = 64, LDO = 1024;
constexpr int SHM_V = KVBLK * 128 * 2, SHM_K = KVBLK * 192 * 2, SHM_QR = NW * 4 * 64 * 16, SHM_ATTN = 2 * SHM_V + 2 * SHM_K + NW * 64 * 4 + SHM_QR;
using bf16x8 = __attribute__((ext_vector_type(8))) short;
using s16x4  = __attribute__((ext_vector_type(4))) short;
using f32x16 = __attribute__((ext_vector_type(16))) float;
using u32x4  = __attribute__((ext_vector_type(4))) unsigned;
#define KSWZ(row, colB) ((row) * 384 + ((colB) ^ ((((row) >> 1) & 7) << 4)))
#define SBAR() __builtin_amdgcn_sched_barrier(0)
__device__ __forceinline__ int crow(int r, int hi) { return (r & 3) + 8 * (r >> 2) + 4 * hi; }
__device__ __forceinline__ unsigned cvtpk(float lo, float hi) { unsigned r; asm volatile("v_cvt_pk_bf16_f32 %0, %1, %2" : "=v"(r) : "v"(lo), "v"(hi)); return r; }
__device__ __forceinline__ bf16x8 ld8(const bf16* p) { return *reinterpret_cast<const bf16x8*>(p); }
__device__ __forceinline__ float bf2f(short b) { return __uint_as_float(((unsigned)(unsigned short)b) << 16); }

__device__ __forceinline__ void partialSM(f32x16& p0, f32x16& p1, float& m_reg, float& mn, float& alpha) {
  constexpr float C = SCALE * 1.4426950408889634f;
  float pmax = p0[0];
#pragma unroll
  for (int r = 1; r < 16; ++r) pmax = fmaxf(pmax, p0[r]);
#pragma unroll
  for (int r = 0; r < 16; ++r) pmax = fmaxf(pmax, p1[r]);
  { auto rr = __builtin_amdgcn_permlane32_swap(__float_as_uint(pmax), __float_as_uint(pmax), false, false);
    pmax = fmaxf(__uint_as_float(rr[0]), __uint_as_float(rr[1])); }
  if (__builtin_expect(__all(pmax - m_reg <= THR / SCALE), 1)) { mn = m_reg; alpha = 1.f; }
  else { mn = fmaxf(m_reg, pmax); alpha = __builtin_amdgcn_exp2f((m_reg - mn) * C); m_reg = mn; }
  float mnC = -mn * C;
#pragma unroll
  for (int r = 0; r < 16; ++r) p0[r] = fmaf(p0[r], C, mnC);
#pragma unroll
  for (int r = 0; r < 16; ++r) p1[r] = fmaf(p1[r], C, mnC);
#pragma unroll
  for (int r = 0; r < 16; ++r) p0[r] = __builtin_amdgcn_exp2f(p0[r]);
}
__device__ __forceinline__ void finishSM(f32x16& p0, f32x16& p1, float alpha, float& l_reg, bf16x8& pa0, bf16x8& pa1, bf16x8& pa2, bf16x8& pa3) {
#pragma unroll
  for (int r = 0; r < 16; ++r) p1[r] = __builtin_amdgcn_exp2f(p1[r]);
  float ps = 0;
#pragma unroll
  for (int r = 0; r < 16; ++r) ps += p0[r];
#pragma unroll
  for (int r = 0; r < 16; ++r) ps += p1[r];
  { auto rr = __builtin_amdgcn_permlane32_swap(__float_as_uint(ps), __float_as_uint(ps), false, false);
    ps = __uint_as_float(rr[0]) + __uint_as_float(rr[1]); }
  l_reg = l_reg * alpha + ps;
#define PK4(P, BASE, OUT) do { unsigned a0 = cvtpk(P[BASE + 0], P[BASE + 1]), a1 = cvtpk(P[BASE + 2], P[BASE + 3]);   \
    unsigned b0 = cvtpk(P[BASE + 4], P[BASE + 5]), b1 = cvtpk(P[BASE + 6], P[BASE + 7]);                              \
    auto r0 = __builtin_amdgcn_permlane32_swap(a0, b0, false, false); auto r1 = __builtin_amdgcn_permlane32_swap(a1, b1, false, false); \
    u32x4 w = {r0[0], r1[0], r0[1], r1[1]}; OUT = *reinterpret_cast<bf16x8*>(&w); } while (0)
  PK4(p0, 0, pa0); PK4(p0, 8, pa1); PK4(p1, 0, pa2); PK4(p1, 8, pa3);
#undef PK4
}
__device__ __forceinline__ void qkt(f32x16& p0, f32x16& p1, const bf16* Ks, const bf16x8 (&qr)[8], const bf16x8* qrl, int r32, int hi) {
  p0 = f32x16{}; p1 = f32x16{};
#pragma unroll
  for (int d0 = 0; d0 < 12; ++d0) { int cb = (d0 * 16 + hi * 8) * 2;
    bf16x8 b0 = *reinterpret_cast<const bf16x8*>((const char*)Ks + KSWZ(r32, cb));
    bf16x8 b1 = *reinterpret_cast<const bf16x8*>((const char*)Ks + KSWZ(32 + r32, cb));
    const bf16x8 qf = d0 < 8 ? qr[d0 < 8 ? d0 : 0] : qrl[(d0 - 8) * 64];
    p0 = __builtin_amdgcn_mfma_f32_32x32x16_bf16(b0, qf, p0, 0, 0, 0);
    p1 = __builtin_amdgcn_mfma_f32_32x32x16_bf16(b1, qf, p1, 0, 0, 0); }
}
__device__ __forceinline__ int v_st(int k, int c) { const int kk = (k & ~0xC) | ((k & 4) << 1) | ((k & 8) >> 1); return ((kk >> 3) * 4 + (c >> 5)) * 512 + ((kk & 7) * 32 + (c & 31)) * 2; }
__device__ __forceinline__ int v_rd_base(int lane) { return ((lane & 3) << 3) | (((lane >> 2) & 3) << 6) | (((lane >> 4) & 1) << 5) | (((lane >> 5) & 1) << 8); }
constexpr int v_rd_off(int d0, int ks, int half) { return d0 * 512 + ks * 4096 + half * 2048; }
template <int OFF> __device__ __forceinline__ s16x4 tr_read(int vb) {
  s16x4 r; asm volatile("ds_read_b64_tr_b16 %0, %1 offset:%2" : "=&v"(r) : "v"(vb), "i"(OFF) : "memory"); return r;
}
template <int D0> __device__ __forceinline__ void pv_one(f32x16& od, int vb, bf16x8 pa0, bf16x8 pa1, bf16x8 pa2, bf16x8 pa3) {
  const s16x4 l0 = tr_read<v_rd_off(D0, 0, 0)>(vb), h0 = tr_read<v_rd_off(D0, 0, 1)>(vb), l1 = tr_read<v_rd_off(D0, 1, 0)>(vb), h1 = tr_read<v_rd_off(D0, 1, 1)>(vb);
  const s16x4 l2 = tr_read<v_rd_off(D0, 2, 0)>(vb), h2 = tr_read<v_rd_off(D0, 2, 1)>(vb), l3 = tr_read<v_rd_off(D0, 3, 0)>(vb), h3 = tr_read<v_rd_off(D0, 3, 1)>(vb);
  asm volatile("s_waitcnt lgkmcnt(0)" ::: "memory"); SBAR();
#define PK(L, H) (bf16x8){L[0], L[1], L[2], L[3], H[0], H[1], H[2], H[3]}
  od = __builtin_amdgcn_mfma_f32_32x32x16_bf16(pa0, PK(l0, h0), od, 0, 0, 0);
  od = __builtin_amdgcn_mfma_f32_32x32x16_bf16(pa1, PK(l1, h1), od, 0, 0, 0);
  od = __builtin_amdgcn_mfma_f32_32x32x16_bf16(pa2, PK(l2, h2), od, 0, 0, 0);
  od = __builtin_amdgcn_mfma_f32_32x32x16_bf16(pa3, PK(l3, h3), od, 0, 0, 0);
#undef PK
}
__device__ __forceinline__ void pv_d0(f32x16 (&o)[4], int vb, bf16x8 pa0, bf16x8 pa1, bf16x8 pa2, bf16x8 pa3) {
  pv_one<0>(o[0], vb, pa0, pa1, pa2, pa3); pv_one<1>(o[1], vb, pa0, pa1, pa2, pa3); pv_one<2>(o[2], vb, pa0, pa1, pa2, pa3); pv_one<3>(o[3], vb, pa0, pa1, pa2, pa3);
}
__device__ __forceinline__ void attn_body(const bf16* __restrict__ Qb, const bf16* __restrict__ Kn, const bf16* __restrict__ Vh, const bf16* __restrict__ Kr,
                                          bf16* __restrict__ Ob, int seq, int rope, int qtok0, const float* __restrict__ tab, char* lds,
                                          unsigned* __restrict__ xs, unsigned* __restrict__ cnt, const float* __restrict__ gain, int head) {
  int tid_ = threadIdx.x; asm volatile("" : "+v"(tid_));
  const int tid = tid_, wid = tid >> 6, lane = tid & 63, r32 = lane & 31, hi = lane >> 5;
  bf16* V_lds = (bf16*)lds; bf16* K_lds = (bf16*)(lds + 2 * SHM_V);
  float* ws = (float*)(lds + 2 * SHM_V + 2 * SHM_K) + wid * 64; float* li_l = ws; float* al_l = ws + 32;
  float m_reg = -1e30f, l_reg = 0; f32x16 o[4] = {}; bf16x8 qr[8]; bf16x8 qx[4];
  bf16x8* qrl = (bf16x8*)(lds + 2 * SHM_V + 2 * SHM_K + NW * 64 * 4) + wid * 256 + lane;
  const bf16* Qw = Qb + (long)(wid * QBLK + r32) * LDQ + hi * 8;
#pragma unroll
  for (int d0 = 0; d0 < 8; ++d0) qr[d0] = ld8(Qw + d0 * 16);
#pragma unroll
  for (int d0 = 0; d0 < 4; ++d0) qx[d0] = ld8(Qw + 128 + d0 * 16);
  if (rope) {
    const int tt = qtok0 + wid * QBLK + r32; const int prow = tt >> 6, pcol = tt & 63;
    const float* tr = tab + (prow * 16 + hi * 8) * 2; const float* tc = tab + (pcol * 16 + hi * 8) * 2;
    unsigned a1[4], a2[4], c1[4], c2[4];
#pragma unroll
    for (int j = 0; j < 8; j += 2) {
      float o1[2], o2[2], p1[2], p2[2];
#pragma unroll
      for (int e = 0; e < 2; ++e) {
        const float cr = tr[(j + e) * 2], sr_ = tr[(j + e) * 2 + 1], cc = tc[(j + e) * 2], sc_ = tc[(j + e) * 2 + 1];
        const float x1 = bf2f(qx[0][j + e]), x2 = bf2f(qx[1][j + e]), y1 = bf2f(qx[2][j + e]), y2 = bf2f(qx[3][j + e]);
        o1[e] = x1 * cr - x2 * sr_; o2[e] = x2 * cr + x1 * sr_; p1[e] = y1 * cc - y2 * sc_; p2[e] = y2 * cc + y1 * sc_; }
      a1[j >> 1] = cvtpk(o1[0], o1[1]); a2[j >> 1] = cvtpk(o2[0], o2[1]); c1[j >> 1] = cvtpk(p1[0], p1[1]); c2[j >> 1] = cvtpk(p2[0], p2[1]); }
    { u32x4 w = {a1[0], a1[1], a1[2], a1[3]}; qx[0] = *reinterpret_cast<bf16x8*>(&w); }
    { u32x4 w = {a2[0], a2[1], a2[2], a2[3]}; qx[1] = *reinterpret_cast<bf16x8*>(&w); }
    { u32x4 w = {c1[0], c1[1], c1[2], c1[3]}; qx[2] = *reinterpret_cast<bf16x8*>(&w); }
    { u32x4 w = {c2[0], c2[1], c2[2], c2[3]}; qx[3] = *reinterpret_cast<bf16x8*>(&w); }
  }
#pragma unroll
  for (int d0 = 0; d0 < 4; ++d0) qrl[d0 * 64] = qx[d0];
  const int sr = tid >> 4, sc = (tid & 15) * 8, vst0 = v_st(sr, sc), vst1 = v_st(32 + sr, sc);
  const int rr = tid >> 3, rc = (tid & 7) * 8;
  const int vb0 = (int)(uintptr_t)V_lds + v_rd_base(lane);
  struct { bf16x8 vs0, vs1, ks0, ks1, kr0; } sr_[SDEPTH];
#define SLOAD(i, k0) do { sr_[i].vs0 = ld8(&Vh[(long)((k0) + sr) * LDK + sc]); sr_[i].vs1 = ld8(&Vh[(long)((k0) + 32 + sr) * LDK + sc]); \
    sr_[i].ks0 = ld8(&Kn[(long)((k0) + sr) * LDK + sc]); sr_[i].ks1 = ld8(&Kn[(long)((k0) + 32 + sr) * LDK + sc]); sr_[i].kr0 = ld8(&Kr[(long)((k0) + rr) * LDR + rc]); } while (0)
#define SWRITE(b, i) do { *(bf16x8*)((char*)V_lds + (b) * SHM_V + vst0) = sr_[i].vs0;          \
    *(bf16x8*)((char*)V_lds + (b) * SHM_V + vst1) = sr_[i].vs1; int kc = sc * 2;               \
    *(bf16x8*)((char*)K_lds + (b) * SHM_K + KSWZ(sr, kc)) = sr_[i].ks0;                       \
    *(bf16x8*)((char*)K_lds + (b) * SHM_K + KSWZ(32 + sr, kc)) = sr_[i].ks1;                  \
    *(bf16x8*)((char*)K_lds + (b) * SHM_K + KSWZ(rr, 256 + rc * 2)) = sr_[i].kr0; } while (0)
#define SWAIT() do { if constexpr (SDEPTH == 2) asm volatile("s_waitcnt vmcnt(5)" ::: "memory"); else asm volatile("s_waitcnt vmcnt(0)" ::: "memory"); } while (0)
#define RESC(a) do { if (__any((a) < 1.f)) { if (hi == 0) al_l[r32] = (a); asm volatile("s_waitcnt lgkmcnt(0)" ::: "memory"); \
    _Pragma("unroll") for (int d = 0; d < 4; ++d) _Pragma("unroll") for (int r = 0; r < 16; ++r) o[d][r] *= al_l[crow(r, hi)]; } } while (0)
  f32x16 pA0, pA1, pB0, pB1; float mnA, mnB, alA, alB; bf16x8 pa0, pa1, pa2, pa3; const int NT = seq / KVBLK;
  constexpr int SE = 0, SO = SDEPTH - 1;
  SLOAD(SE, 0); asm volatile("s_waitcnt vmcnt(0)" ::: "memory"); SWRITE(0, SE); __syncthreads();
  qkt(pA0, pA1, K_lds, qr, qrl, r32, hi); partialSM(pA0, pA1, m_reg, mnA, alA);
  SLOAD(SO, KVBLK); if constexpr (SDEPTH == 2) { if (2 < NT) SLOAD(SE, 2 * KVBLK); }
  SWAIT(); SWRITE(1, SO); __syncthreads();
  for (int j = 1; j + 1 < NT; j += 2) {
    SBAR(); qkt(pB0, pB1, (bf16*)((char*)K_lds + SHM_K), qr, qrl, r32, hi);
    finishSM(pA0, pA1, alA, l_reg, pa0, pa1, pa2, pa3); SBAR();
    SLOAD(SO, (j + SDEPTH) * KVBLK); SBAR();
    pv_d0(o, vb0, pa0, pa1, pa2, pa3); partialSM(pB0, pB1, m_reg, mnB, alB);
    __syncthreads(); SWAIT(); SWRITE(0, SE);
    RESC(alB); __syncthreads();
    SBAR(); qkt(pA0, pA1, K_lds, qr, qrl, r32, hi);
    finishSM(pB0, pB1, alB, l_reg, pa0, pa1, pa2, pa3); SBAR();
    if (SDEPTH == 1 || j + 3 < NT) SLOAD(SE, (j + 1 + SDEPTH) * KVBLK); SBAR();
    pv_d0(o, vb0 + (int)SHM_V, pa0, pa1, pa2, pa3); partialSM(pA0, pA1, m_reg, mnA, alA);
    __syncthreads(); SWAIT(); SWRITE(1, SO);
    RESC(alA); __syncthreads();
  }
  SBAR(); qkt(pB0, pB1, (bf16*)((char*)K_lds + SHM_K), qr, qrl, r32, hi);
  finishSM(pA0, pA1, alA, l_reg, pa0, pa1, pa2, pa3); SBAR();
  pv_d0(o, vb0, pa0, pa1, pa2, pa3); partialSM(pB0, pB1, m_reg, mnB, alB);
  __syncthreads(); RESC(alB);
  finishSM(pB0, pB1, alB, l_reg, pa0, pa1, pa2, pa3); SBAR();
  pv_d0(o, vb0 + (int)SHM_V, pa0, pa1, pa2, pa3);
  if (hi == 0) li_l[r32] = l_reg; asm volatile("s_waitcnt lgkmcnt(0)" ::: "memory");
  float rli[16];
#pragma unroll
  for (int r = 0; r < 16; ++r) rli[r] = __builtin_amdgcn_rcpf(li_l[crow(r, hi)]);
  float rs[16];
#pragma unroll
  for (int r = 0; r < 16; ++r) { float s = 0.f;
#pragma unroll
    for (int d0 = 0; d0 < 4; ++d0) { o[d0][r] *= rli[r]; s += o[d0][r] * o[d0][r]; }
    rs[r] = s; }
#pragma unroll
  for (int x = 1; x < 32; x <<= 1)
#pragma unroll
    for (int r = 0; r < 16; ++r) rs[r] += __shfl_xor(rs[r], x);
  asm volatile("s_waitcnt lgkmcnt(0)" ::: "memory");
  if (r32 == 0) {
#pragma unroll
    for (int r = 0; r < 16; ++r) al_l[crow(r, hi)] = rs[r]; }
  asm volatile("s_waitcnt lgkmcnt(0)" ::: "memory");
  if (lane < 32) __hip_atomic_store(xs + (size_t)(wid * QBLK + lane) * 4 + head, __float_as_uint(al_l[lane]), __ATOMIC_RELAXED, __HIP_MEMORY_SCOPE_AGENT);
  asm volatile("s_waitcnt vmcnt(0)" ::: "memory");
  if (lane == 0) __hip_atomic_fetch_add(cnt, 1u, __ATOMIC_RELAXED, __HIP_MEMORY_SCOPE_AGENT);
  if (wid == 0) { unsigned sp = 0;
    while ((unsigned)__builtin_amdgcn_readfirstlane(__hip_atomic_load(cnt, __ATOMIC_RELAXED, __HIP_MEMORY_SCOPE_AGENT)) < 32u) { __builtin_amdgcn_s_sleep(2); if (++sp > (1u << 22)) break; }
    __builtin_amdgcn_fence(__ATOMIC_ACQUIRE, "agent"); }
  asm volatile("s_waitcnt vmcnt(0) lgkmcnt(0)" ::: "memory"); __syncthreads();
  if (lane < 32) { const unsigned* sl = xs + (size_t)(wid * QBLK + lane) * 4; float t = 0.f;
#pragma unroll
    for (int q = 0; q < 4; ++q) t += __uint_as_float(__hip_atomic_load(sl + q, __ATOMIC_RELAXED, __HIP_MEMORY_SCOPE_AGENT));
    li_l[lane] = 1.0f / sqrtf(t * (1.0f / 512.0f) + 1e-6f); }
  asm volatile("s_waitcnt lgkmcnt(0)" ::: "memory");
  float g4[4];
#pragma unroll
  for (int d0 = 0; d0 < 4; ++d0) g4[d0] = gain[d0 * 32 + r32];
  char* Ol = lds + wid * 8704;
#pragma unroll
  for (int r = 0; r < 16; ++r) { const int orow = crow(r, hi); const float rn = li_l[orow];
#pragma unroll
    for (int d0 = 0; d0 < 4; ++d0) { const float v = o[d0][r] * rn * g4[d0]; *(bf16*)(Ol + orow * 272 + (d0 * 32 + r32) * 2) = (bf16)(cvtpk(v, v) & 0xffffu); } }
  asm volatile("s_waitcnt lgkmcnt(0)" ::: "memory");
  bf16* Ow = Ob + (long)(wid * QBLK) * LDO;
#pragma unroll
  for (int i = 0; i < 8; i += 2) { const int row = (lane >> 4) + 4 * i, c16 = lane & 15;
    const u32x4 w0 = *reinterpret_cast<const u32x4*>(Ol + row * 272 + c16 * 16), w1 = *reinterpret_cast<const u32x4*>(Ol + (row + 4) * 272 + c16 * 16);
    *reinterpret_cast<u32x4*>(Ow + (long)row * LDO + c16 * 8) = w0; *reinterpret_cast<u32x4*>(Ow + (long)(row + 4) * LDO + c16 * 8) = w1;
    asm volatile("" ::: "memory"); }
  __syncthreads();
#undef SLOAD
#undef SWRITE
#undef SWAIT
#undef RESC
}
#undef KSWZ
#undef SBAR
}

namespace ml {
using att::bf16; using att::bf16x8; using att::s16x4; using att::f32x16; using att::u32x4;
typedef float f32x4 __attribute__((ext_vector_type(4)));
using att::crow;
__device__ __forceinline__ unsigned cvtpk(float lo, float hi) { unsigned r; asm("v_cvt_pk_bf16_f32 %0, %1, %2" : "=v"(r) : "v"(lo), "v"(hi)); return r; }
 using att::ld8; using att::bf2f; using att::v_st; using att::v_rd_base; using att::v_rd_off;
constexpr int TBr = 4352, CTXr = 256, SEQr = 4096;
constexpr float LOG2E = 1.4426950408889634f;
constexpr int TSTRIDE = 32 * 17 * 256;
#define MLAS __attribute__((address_space(3)))
__device__ __forceinline__ float log_sigmoid_f(float x) {
    const float t = __expf(-fabsf(x));
    const float l1p = t < 0.03f ? t * (1.0f - t * (0.5f - t * (0.33333334f - 0.25f * t))) : __logf(1.0f + t);
    return fminf(x, 0.f) - l1p;
}
template <int OFF> __device__ __forceinline__ s16x4 trr(int vb) { s16x4 r; asm volatile("ds_read_b64_tr_b16 %0, %1 offset:%2" : "=&v"(r) : "v"(vb), "i"(OFF) : "memory"); return r; }
#define MLPK(L, H) (bf16x8){L[0], L[1], L[2], L[3], H[0], H[1], H[2], H[3]}
__device__ __forceinline__ void unit_rows(int b, int dir, int j, int& rb, int& sg) {
    if (dir == 0) { rb = b * TBr + 256 * j; sg = 1; }
    else { rb = (j == 0) ? b * TBr + 255 : b * TBr + TBr - 1 - 256 * (j - 1); sg = -1; }
}
struct Conv8 { float w0[8], w1[8], w2[8], bb[8]; };
__device__ __forceinline__ void conv8_load(Conv8& cp, const float* __restrict__ cw, const float* __restrict__ cb, int c) {
#pragma unroll
    for (int j = 0; j < 8; ++j) { cp.w0[j] = cw[c + j]; cp.w1[j] = cw[1024 + c + j]; cp.w2[j] = cw[2048 + c + j]; cp.bb[j] = cb[c + j]; }
}
__device__ __forceinline__ void conv8x8(const bf16* __restrict__ P, int r0, int sg, int sr, int c, const Conv8& cp, float scale, bf16x8 (&out)[8]) {
    bf16x8 x0[8], xm[8], xp[8]; float fm[8], fp[8];
#pragma unroll
    for (int g = 0; g < 8; ++g) { const int r = r0 + sg * (32 * g + sr); const int t = r % TBr; const bool hp = (t != 0) && (t != CTXr), hn = (t != CTXr - 1) && (t != TBr - 1);
        const bf16* p = P + (size_t)r * 2560 + 448 + c; x0[g] = ld8(p); xm[g] = ld8(hp ? p - 2560 : p); xp[g] = ld8(hn ? p + 2560 : p); fm[g] = hp ? 1.0f : 0.0f; fp[g] = hn ? 1.0f : 0.0f; }
    asm volatile("" ::: "memory");
#pragma unroll
    for (int g = 0; g < 8; ++g) { float u[8];
#pragma unroll
        for (int j = 0; j < 8; ++j) { const float a = cp.w0[j] * fm[g] * bf2f(xm[g][j]) + cp.w1[j] * bf2f(x0[g][j]) + cp.w2[j] * fp[g] * bf2f(xp[g][j]) + cp.bb[j];
            u[j] = a * __builtin_amdgcn_rcpf(1.0f + __builtin_amdgcn_exp2f(-LOG2E * a)) * scale; }
        u32x4 o = {cvtpk(u[0], u[1]), cvtpk(u[2], u[3]), cvtpk(u[4], u[5]), cvtpk(u[6], u[7])};
        out[g] = *reinterpret_cast<bf16x8*>(&o); }
}
__device__ __forceinline__ void conv_rows_load(const bf16* __restrict__ P, int R0, int c, bf16x8 (&x)[10]) {
    const int t0 = R0 % TBr; const bool hp0 = (t0 != 0) && (t0 != CTXr); const int t7 = t0 + 7; const bool hn7 = (t7 != CTXr - 1) && (t7 != TBr - 1);
    const bf16* p = P + (size_t)R0 * 2560 + 448 + c;
    x[0] = ld8(hp0 ? p - 2560 : p);
#pragma unroll
    for (int g = 0; g < 8; ++g) x[1 + g] = ld8(p + (size_t)g * 2560);
    x[9] = ld8(hn7 ? p + (size_t)8 * 2560 : p + (size_t)7 * 2560);
}
__device__ __forceinline__ void conv_rows_compute(const bf16x8 (&x)[10], int R0, const Conv8& cp, float scale, bf16x8 (&out)[8]) {
    const int t0 = R0 % TBr;
#pragma unroll
    for (int g = 0; g < 8; ++g) { const int t = t0 + g; const float fm = ((t != 0) && (t != CTXr)) ? 1.0f : 0.0f, fp = ((t != CTXr - 1) && (t != TBr - 1)) ? 1.0f : 0.0f; float u[8];
#pragma unroll
        for (int j = 0; j < 8; ++j) { const float a = cp.w0[j] * fm * bf2f(x[g][j]) + cp.w1[j] * bf2f(x[g + 1][j]) + cp.w2[j] * fp * bf2f(x[g + 2][j]) + cp.bb[j];
            u[j] = a * __builtin_amdgcn_rcpf(1.0f + __builtin_amdgcn_exp2f(-LOG2E * a)) * scale; }
        u32x4 o = {cvtpk(u[0], u[1]), cvtpk(u[2], u[3]), cvtpk(u[4], u[5]), cvtpk(u[6], u[7])};
        out[g] = *reinterpret_cast<bf16x8*>(&o); }
}
__device__ __forceinline__ void gate_scan_task(const float* __restrict__ G, const float* __restrict__ gate_b, float* __restrict__ T, float* __restrict__ sca, int task, int lane) {
    const int seq = task / 17, j = task - seq * 17, b = seq >> 3, h = (seq >> 1) & 3, dir = seq & 1;
    int rb, sg; unit_rows(b, dir, j, rb, sg);
    const int gi = (2 * dir) * 4 + h, gf = (2 * dir + 1) * 4 + h; const float ib = gate_b[gi], fb = gate_b[gf];
    float igv[4], fgv[4];
#pragma unroll
    for (int rnd = 0; rnd < 4; ++rnd) { const size_t r = (size_t)(rb + sg * (64 * rnd + lane)); igv[rnd] = G[r * 16 + gi] + ib; fgv[rnd] = G[r * 16 + gf] + fb; }
    float cb = 0.f, cpm = -3.0e38f; float* Tb = T + (size_t)task * 256;
#pragma unroll
    for (int rnd = 0; rnd < 4; ++rnd) { const int i = 64 * rnd + lane;
        float bc = log_sigmoid_f(fgv[rnd]);
#pragma unroll
        for (int o = 1; o < 64; o <<= 1) { const float t_ = __shfl_up(bc, o); if (lane >= o) bc += t_; }
        bc += cb;
        const float al = igv[rnd] - bc; float pm = al;
#pragma unroll
        for (int o = 1; o < 64; o <<= 1) { const float t_ = __shfl_up(pm, o); if (lane >= o) pm = fmaxf(pm, t_); }
        pm = fmaxf(pm, cpm);
        Tb[i] = bc; Tb[TSTRIDE + i] = al; Tb[2 * TSTRIDE + i] = pm;
        cb = __shfl(bc, 63); cpm = __shfl(pm, 63); }
    if (j < 16 && lane == 0) { sca[(seq * 16 + j) * 2] = cpm; sca[(seq * 16 + j) * 2 + 1] = cb; }
}
__device__ __forceinline__ void mlstm_local(const bf16* __restrict__ P, const float* __restrict__ T, const float* __restrict__ cw, const float* __restrict__ cbias,
                                            float* __restrict__ Cloc, float* __restrict__ nloc, int unit, char* lds) {
    int tid_ = threadIdx.x; asm volatile("" : "+v"(tid_));
    const int tid = tid_, wid = tid >> 6, lane = tid & 63, r32 = lane & 31, hi = lane >> 5;
    const int seq = unit >> 4, j = unit & 15, b = seq >> 3, h = (seq >> 1) & 3, dir = seq & 1;
    int rb, sg; unit_rows(b, dir, j, rb, sg);
    const float* Tal = T + TSTRIDE + (size_t)(seq * 17 + j) * 256; const float mlm = T[2 * TSTRIDE + (size_t)(seq * 17 + j) * 256 + 255];
    float* npart = (float*)(lds + 131072);
    const int sr = tid >> 4, sc = (tid & 15) * 8;
    float wv[8]; bf16x8 vreg[8];
#pragma unroll
    for (int g = 0; g < 8; ++g) { const int i = 32 * g + sr; wv[g] = Tal[i]; vreg[g] = ld8(P + (size_t)(rb + sg * i) * 2560 + 1472 + h * 128 + sc); }
    asm volatile("" ::: "memory");
    float nacc[8] = {0.f, 0.f, 0.f, 0.f, 0.f, 0.f, 0.f, 0.f};
    {
        const int R0 = sg > 0 ? rb + 8 * sr : rb - 8 * sr - 7;
        bf16x8 xk[10]; conv_rows_load(P, R0, 512 + h * 128 + sc, xk); float wk[8];
#pragma unroll
        for (int g = 0; g < 8; ++g) wk[g] = Tal[8 * sr + g];
        asm volatile("" ::: "memory");
        Conv8 cp; conv8_load(cp, cw, cbias, 512 + h * 128 + sc); bf16x8 kv[8]; conv_rows_compute(xk, R0, cp, 0.08838834764831845f, kv);
#pragma unroll
        for (int g = 0; g < 8; ++g) { const int i = 8 * sr + g; const bf16x8 kr = sg > 0 ? kv[g] : kv[7 - g];
            *(bf16x8*)(lds + (i >> 6) * 16384 + v_st(i & 63, sc)) = kr; const float w = __expf(wk[g] - mlm);
#pragma unroll
            for (int x = 0; x < 8; ++x) nacc[x] += w * bf2f(kr[x]); } }
#pragma unroll
    for (int g = 0; g < 8; ++g) wv[g] = __expf(wv[g] - mlm);
#pragma unroll
    for (int g = 0; g < 8; ++g) { const int i = 32 * g + sr; const float w = wv[g]; const bf16x8 v = vreg[g];
        u32x4 o = {cvtpk(bf2f(v[0]) * w, bf2f(v[1]) * w), cvtpk(bf2f(v[2]) * w, bf2f(v[3]) * w), cvtpk(bf2f(v[4]) * w, bf2f(v[5]) * w), cvtpk(bf2f(v[6]) * w, bf2f(v[7]) * w)};
        *(u32x4*)(lds + 65536 + (i >> 6) * 16384 + v_st(i & 63, sc)) = o; }
#pragma unroll
    for (int x = 0; x < 8; ++x) { nacc[x] += __shfl_xor(nacc[x], 16); nacc[x] += __shfl_xor(nacc[x], 32); }
    if (lane < 16) {
#pragma unroll
        for (int x = 0; x < 8; ++x) npart[wid * 128 + sc + x] = nacc[x]; }
    __syncthreads();
    const int db = wid >> 1, eb0 = 2 * (wid & 1);
    const int vbK = (int)(uintptr_t)lds + v_rd_base(lane) + db * 512, vbV = (int)(uintptr_t)lds + 65536 + v_rd_base(lane) + eb0 * 512;
    f32x16 c0 = {}, c1 = {};
#define MLA_STEP(TL, KS) do { const s16x4 al_ = trr<(TL) * 16384 + v_rd_off(0, KS, 0)>(vbK), ah_ = trr<(TL) * 16384 + v_rd_off(0, KS, 1)>(vbK); \
        const s16x4 bl0 = trr<(TL) * 16384 + v_rd_off(0, KS, 0)>(vbV), bh0 = trr<(TL) * 16384 + v_rd_off(0, KS, 1)>(vbV), bl1 = trr<(TL) * 16384 + v_rd_off(1, KS, 0)>(vbV), bh1 = trr<(TL) * 16384 + v_rd_off(1, KS, 1)>(vbV); \
        asm volatile("s_waitcnt lgkmcnt(0)" ::: "memory"); __builtin_amdgcn_sched_barrier(0); \
        c0 = __builtin_amdgcn_mfma_f32_32x32x16_bf16(MLPK(al_, ah_), MLPK(bl0, bh0), c0, 0, 0, 0); c1 = __builtin_amdgcn_mfma_f32_32x32x16_bf16(MLPK(al_, ah_), MLPK(bl1, bh1), c1, 0, 0, 0); } while (0)
#define MLA_TILE(TL) do { MLA_STEP(TL, 0); MLA_STEP(TL, 1); MLA_STEP(TL, 2); MLA_STEP(TL, 3); } while (0)
    MLA_TILE(0); MLA_TILE(1); MLA_TILE(2); MLA_TILE(3);
#undef MLA_TILE
#undef MLA_STEP
    float* Co = Cloc + (size_t)unit * 16384;
#pragma unroll
    for (int r = 0; r < 16; ++r) { const int d = db * 32 + crow(r, hi); Co[d * 128 + eb0 * 32 + r32] = c0[r]; Co[d * 128 + eb0 * 32 + 32 + r32] = c1[r]; }
    if (tid < 128) { float s = 0.f;
#pragma unroll
        for (int w = 0; w < 8; ++w) s += npart[w * 128 + tid];
        nloc[unit * 128 + tid] = s; }
    __syncthreads();
}
__device__ __forceinline__ void mlstm_scan(const float* __restrict__ Cloc, const float* __restrict__ nloc, const float* __restrict__ sca, bf16* __restrict__ CstT, float* __restrict__ nst, float* __restrict__ bm, int gtid, int gthreads) {
    for (int item = gtid; item < 32 * 2048; item += gthreads) {
        const int seq = item >> 11, rem = item & 2047, e = rem & 127, dg = rem >> 7;
        float st[8] = {0.f, 0.f, 0.f, 0.f, 0.f, 0.f, 0.f, 0.f}; float nv = 0.f, Bst = 0.f, Mst = 0.f;
        asm volatile("" : "+v"(Bst), "+v"(Mst));
        const float* Cl0 = Cloc + (size_t)(seq * 16) * 16384 + (dg * 8) * 128 + e;
        for (int half = 0; half < 2; ++half) {
            float cl[8][8], nlv[8], mlv[8], blv[8];
#pragma unroll
            for (int jj = 0; jj < 8; ++jj) { const int lu = seq * 16 + half * 8 + jj;
#pragma unroll
                for (int i = 0; i < 8; ++i) cl[jj][i] = Cl0[(size_t)(half * 8 + jj) * 16384 + i * 128];
                nlv[jj] = nloc[lu * 128 + e]; mlv[jj] = sca[lu * 2]; blv[jj] = sca[lu * 2 + 1]; }
#pragma unroll
            for (int jj = 0; jj < 8; ++jj) { const int j = half * 8 + jj; const size_t su = (size_t)seq * 17 + j;
                u32x4 o = {cvtpk(st[0], st[1]), cvtpk(st[2], st[3]), cvtpk(st[4], st[5]), cvtpk(st[6], st[7])};
                *(u32x4*)(CstT + su * 16384 + e * 128 + dg * 8) = o;
                if (dg == 0) { nst[su * 128 + e] = nv; if (e == 0) { bm[su * 2] = Bst; bm[su * 2 + 1] = Mst; } }
                const float Mend = fmaxf(Mst, mlv[jj] - Bst), fa = __expf(Mst - Mend), fbv = __expf(mlv[jj] - Bst - Mend);
#pragma unroll
                for (int i = 0; i < 8; ++i) st[i] = fa * st[i] + fbv * cl[jj][i];
                nv = fa * nv + fbv * nlv[jj];
                Bst += blv[jj]; Mst = Mend; }
        }
        { const size_t su = (size_t)seq * 17 + 16;
          u32x4 o = {cvtpk(st[0], st[1]), cvtpk(st[2], st[3]), cvtpk(st[4], st[5]), cvtpk(st[6], st[7])};
          *(u32x4*)(CstT + su * 16384 + e * 128 + dg * 8) = o;
          if (dg == 0) { nst[su * 128 + e] = nv; if (e == 0) { bm[su * 2] = Bst; bm[su * 2 + 1] = Mst; } } }
    }
}
#define KSW(row, colB) ((row) * 256 + ((colB) ^ (((row) & 15) << 4)))
template <int D0, int KS> __device__ __forceinline__ void pv_pair(f32x16& od, int vb, bf16x8 pa, bf16x8 pb) {
    const s16x4 l0 = trr<v_rd_off(D0, KS, 0)>(vb), h0 = trr<v_rd_off(D0, KS, 1)>(vb), l1 = trr<v_rd_off(D0, KS + 1, 0)>(vb), h1 = trr<v_rd_off(D0, KS + 1, 1)>(vb);
    asm volatile("s_waitcnt lgkmcnt(0)" ::: "memory"); __builtin_amdgcn_sched_barrier(0);
    od = __builtin_amdgcn_mfma_f32_32x32x16_bf16(pa, MLPK(l0, h0), od, 0, 0, 0);
    od = __builtin_amdgcn_mfma_f32_32x32x16_bf16(pb, MLPK(l1, h1), od, 0, 0, 0);
}
__device__ __forceinline__ void mlstm_out2(const bf16* __restrict__ P, const float* __restrict__ T, const float* __restrict__ cw, const float* __restrict__ cbias, const bf16* __restrict__ CstT, const float* __restrict__ nst,
                                           const float* __restrict__ bm, const float* __restrict__ mnorm, bf16* __restrict__ MIX, int b, int h, int tb, char* lds) {
    int tid_ = threadIdx.x; asm volatile("" : "+v"(tid_));
    const int tid = tid_, wid = tid >> 6, lane = tid & 63, r32 = lane & 31, hi = lane >> 5;
    const int seqf = b * 8 + h * 2, seqb = seqf + 1; const int jb = tb == 0 ? 0 : 17 - tb; const bool zs = (tb == 0);
    const size_t suf = (size_t)seqf * 17 + tb, sub = (size_t)seqb * 17 + jb;
    const int rb = b * TBr + 256 * tb;
    float* tabs = (float*)(lds + 131072);
    float* nlf = tabs + 2048; float* nlb = tabs + 2176; float* wsc = tabs + 2304 + wid * 32;
    const int sr = tid >> 4, sc = (tid & 15) * 8;
    {
        bf16x8 xk[10], xq[10]; conv_rows_load(P, rb + 8 * sr, 512 + h * 128 + sc, xk); conv_rows_load(P, rb + 8 * sr, h * 128 + sc, xq);
        asm volatile("" ::: "memory");
        { Conv8 cp; conv8_load(cp, cw, cbias, 512 + h * 128 + sc); bf16x8 kv[8]; conv_rows_compute(xk, rb + 8 * sr, cp, 0.08838834764831845f, kv);
#pragma unroll
          for (int g = 0; g < 8; ++g) { const int i = 8 * sr + g; *(bf16x8*)(lds + KSW(i, sc * 2)) = kv[g]; } }
        { Conv8 cp; conv8_load(cp, cw, cbias, h * 128 + sc); bf16x8 qv[8]; conv_rows_compute(xq, rb + 8 * sr, cp, 1.0f, qv);
#pragma unroll
          for (int g = 0; g < 8; ++g) { const int i = 8 * sr + g; *(bf16x8*)(lds + 65536 + KSW(i, sc * 2)) = qv[g]; } } }
    bf16x8 vreg[8];
#pragma unroll
    for (int g = 0; g < 8; ++g) vreg[g] = ld8(P + (size_t)(rb + 32 * g + sr) * 2560 + 1472 + h * 128 + sc);
    asm volatile("" ::: "memory");
    {
        const int dir = tid >> 8, n = tid & 255; const size_t su = dir ? sub : suf; const size_t ti = su * 256 + (dir ? 255 - n : n);
        const float bl = T[ti], al = T[TSTRIDE + ti], pm = T[2 * TSTRIDE + ti]; float Bst = 0.f, Mst = 0.f; if (!zs) { Bst = bm[su * 2]; Mst = bm[su * 2 + 1]; }
        float* tb_ = tabs + dir * 1024; const float M = fmaxf(Mst, pm - Bst);
        tb_[n] = __expf(-(Bst + bl + M)); tb_[256 + n] = (al - Bst) * LOG2E; tb_[512 + n] = M * LOG2E; tb_[768 + n] = __expf(Mst - M); }
    if (wid == 2) { nlf[lane] = zs ? 0.f : nst[suf * 128 + lane]; nlf[64 + lane] = zs ? 0.f : nst[suf * 128 + 64 + lane]; }
    if (wid == 3) { nlb[lane] = zs ? 0.f : nst[sub * 128 + lane]; nlb[64 + lane] = zs ? 0.f : nst[sub * 128 + 64 + lane]; }
    __syncthreads();
    bf16x8 qr[8];
#pragma unroll
    for (int d0 = 0; d0 < 8; ++d0) qr[d0] = *reinterpret_cast<const bf16x8*>(lds + 65536 + KSW(wid * 32 + r32, (d0 * 16 + hi * 8) * 2));
    asm volatile("s_waitcnt lgkmcnt(0)" ::: "memory");
    __syncthreads();
#pragma unroll
    for (int g = 0; g < 8; ++g) { const int i = 32 * g + sr; *(bf16x8*)(lds + 65536 + (i >> 6) * 16384 + v_st(i & 63, sc)) = vreg[g]; }
    __syncthreads();
    const int qi = wid * 32 + r32;
    float qnf = 0.f, qnb = 0.f;
#pragma unroll
    for (int d0 = 0; d0 < 8; ++d0) {
#pragma unroll
        for (int jj = 0; jj < 8; ++jj) { const float qv = bf2f(qr[d0][jj]); qnf += qv * nlf[d0 * 16 + hi * 8 + jj]; qnb += qv * nlb[d0 * 16 + hi * 8 + jj]; }
        asm volatile("" : "+v"(qnf), "+v"(qnb)); }
    { auto rr = __builtin_amdgcn_permlane32_swap(__float_as_uint(qnf), __float_as_uint(qnf), false, false); qnf = __uint_as_float(rr[0]) + __uint_as_float(rr[1]); }
    { auto rr = __builtin_amdgcn_permlane32_swap(__float_as_uint(qnb), __float_as_uint(qnb), false, false); qnb = __uint_as_float(rr[0]) + __uint_as_float(rr[1]); }
    const int vb0 = (int)(uintptr_t)lds + 65536 + v_rd_base(lane);
    const int dtile = wid >> 1;
    unsigned hfp[32];
#define ML_PK4(Pv, BASE, OUT) do { unsigned a0 = cvtpk(Pv[BASE + 0], Pv[BASE + 1]), a1 = cvtpk(Pv[BASE + 2], Pv[BASE + 3]);   \
    unsigned b0_ = cvtpk(Pv[BASE + 4], Pv[BASE + 5]), b1_ = cvtpk(Pv[BASE + 6], Pv[BASE + 7]);                              \
    auto r0 = __builtin_amdgcn_permlane32_swap(a0, b0_, false, false); auto r1 = __builtin_amdgcn_permlane32_swap(a1, b1_, false, false); \
    u32x4 w = {r0[0], r1[0], r0[1], r1[1]}; OUT = *reinterpret_cast<bf16x8*>(&w); } while (0)
#pragma unroll
    for (int dir = 0; dir < 2; ++dir) {
        const float* tb_ = tabs + dir * 1024; const size_t su = dir ? sub : suf;
        f32x16 o[4];
        if (zs) { o[0] = f32x16{}; o[1] = f32x16{}; o[2] = f32x16{}; o[3] = f32x16{}; }
        else { const bf16* Cb = CstT + su * 16384 + (size_t)r32 * 128 + hi * 8;
#pragma unroll
          for (int ep = 0; ep < 2; ++ep) { bf16x8 cf[16];
#pragma unroll
              for (int x = 0; x < 16; ++x) cf[x] = ld8(Cb + (2 * ep + (x >> 3)) * 32 * 128 + (x & 7) * 16);
              f32x16 a0 = {}, a1 = {};
#pragma unroll
              for (int d0 = 0; d0 < 8; ++d0) { a0 = __builtin_amdgcn_mfma_f32_32x32x16_bf16(qr[d0], cf[d0], a0, 0, 0, 0); a1 = __builtin_amdgcn_mfma_f32_32x32x16_bf16(qr[d0], cf[8 + d0], a1, 0, 0, 0); }
              o[2 * ep] = a0; o[2 * ep + 1] = a1; }
#pragma unroll
          for (int r = 0; r < 16; ++r) { const float isc = tb_[768 + wid * 32 + crow(r, hi)];
#pragma unroll
              for (int eb = 0; eb < 4; ++eb) o[eb][r] *= isc; } }
        const float qn = dir ? qnb : qnf;
        const float m2q = tb_[512 + qi]; float dsum = 0.f;
        const int kt0 = dir ? dtile : 0, kt1 = dir ? 4 : dtile + 1;
        for (int kt = kt0; kt < kt1; ++kt) {
            const char* Ks = lds + kt * 64 * 256; const bool diag = (kt == dtile); const int vb = vb0 + kt * 16384;
#pragma unroll
            for (int hh = 0; hh < 2; ++hh) {
                f32x16 p = {}, p2 = {};
#pragma unroll
                for (int d0 = 0; d0 < 8; d0 += 2) { const int cb = (d0 * 16 + hi * 8) * 2;
                    const bf16x8 b0 = *reinterpret_cast<const bf16x8*>(Ks + KSW(32 * hh + r32, cb)), b1 = *reinterpret_cast<const bf16x8*>(Ks + KSW(32 * hh + r32, cb + 32));
                    p = __builtin_amdgcn_mfma_f32_32x32x16_bf16(b0, qr[d0], p, 0, 0, 0); p2 = __builtin_amdgcn_mfma_f32_32x32x16_bf16(b1, qr[d0 + 1], p2, 0, 0, 0); }
                p += p2;
#pragma unroll
                for (int g4 = 0; g4 < 4; ++g4) { const int sb = kt * 64 + 32 * hh + 8 * g4 + 4 * hi;
                    const f32x4 a4 = *(const f32x4*)(tb_ + 256 + sb);
#pragma unroll
                    for (int x = 0; x < 4; ++x) { const int r = 4 * g4 + x, s0 = sb + x;
                        float w0 = __builtin_amdgcn_exp2f(a4[x] - m2q);
                        if (diag) { if (dir ? (s0 < qi) : (s0 > qi)) w0 = 0.f; }
                        p[r] *= w0; dsum += p[r]; } }
                bf16x8 pa, pb;
                ML_PK4(p, 0, pa); ML_PK4(p, 8, pb);
                if (hh == 0) { pv_pair<0, 0>(o[0], vb, pa, pb); pv_pair<1, 0>(o[1], vb, pa, pb); pv_pair<2, 0>(o[2], vb, pa, pb); pv_pair<3, 0>(o[3], vb, pa, pb); }
                else         { pv_pair<0, 2>(o[0], vb, pa, pb); pv_pair<1, 2>(o[1], vb, pa, pb); pv_pair<2, 2>(o[2], vb, pa, pb); pv_pair<3, 2>(o[3], vb, pa, pb); }
            }
        }
        { auto rr = __builtin_amdgcn_permlane32_swap(__float_as_uint(dsum), __float_as_uint(dsum), false, false); dsum = __uint_as_float(rr[0]) + __uint_as_float(rr[1]); }
        const float den = dsum + tb_[768 + qi] * qn; const float rd = 1.0f / fmaxf(fabsf(den), tb_[qi]);
        if (hi == 0) wsc[r32] = rd; asm volatile("s_waitcnt lgkmcnt(0)" ::: "memory");
        if (dir == 0) {
#pragma unroll
            for (int r = 0; r < 16; r += 2) { const float ra = wsc[crow(r, hi)], rb_ = wsc[crow(r + 1, hi)];
#pragma unroll
                for (int eb = 0; eb < 4; ++eb) hfp[eb * 8 + (r >> 1)] = cvtpk(o[eb][r] * ra, o[eb][r + 1] * rb_); }
            asm volatile("s_waitcnt lgkmcnt(0)" ::: "memory");
        } else {
            float rdr[16];
#pragma unroll
            for (int r = 0; r < 16; ++r) rdr[r] = wsc[crow(r, hi)];
            bf16x8 og8[8];
            { const bf16* ogp = P + (size_t)(rb + wid * 32 + r32) * 2560 + 1984 + h * 128 + 64 * hi;
#pragma unroll
              for (int c8 = 0; c8 < 8; ++c8) og8[c8] = ld8(ogp + 8 * c8); }
            __syncthreads();
            float* W = (float*)(lds + wid * 16896);
#pragma unroll
            for (int r = 0; r < 16; ++r)
#pragma unroll
                for (int eb = 0; eb < 4; ++eb) { const unsigned pk = hfp[eb * 8 + (r >> 1)]; const float hf = (r & 1) ? __uint_as_float(pk & 0xffff0000u) : __uint_as_float(pk << 16);
                    W[crow(r, hi) * 132 + eb * 32 + r32] = hf + o[eb][r] * rdr[r]; }
            asm volatile("s_waitcnt lgkmcnt(0)" ::: "memory");
            const int tok = r32, eh = hi; const size_t row = (size_t)(rb + wid * 32 + tok);
            const float* mg = mnorm + h * 128 + 64 * eh;
            float v[64]; float s = 0.f;
#pragma unroll
            for (int c8 = 0; c8 < 8; ++c8) { const bf16x8 g8 = og8[c8]; const f32x4 w0 = *(const f32x4*)(W + tok * 132 + 64 * eh + 8 * c8), w1 = *(const f32x4*)(W + tok * 132 + 64 * eh + 8 * c8 + 4);
                const float hv[8] = {w0.x, w0.y, w0.z, w0.w, w1.x, w1.y, w1.z, w1.w};
#pragma unroll
                for (int x = 0; x < 8; ++x) { const float vv = hv[x] * __builtin_amdgcn_rcpf(1.0f + __builtin_amdgcn_exp2f(-LOG2E * bf2f(g8[x]))); v[8 * c8 + x] = vv; s += vv; } }
            { auto rr = __builtin_amdgcn_permlane32_swap(__float_as_uint(s), __float_as_uint(s), false, false); s = __uint_as_float(rr[0]) + __uint_as_float(rr[1]); }
            const float mu = s * (1.0f / 128.0f); float q = 0.f;
#pragma unroll
            for (int x = 0; x < 64; ++x) { v[x] -= mu; q += v[x] * v[x]; }
            { auto rr = __builtin_amdgcn_permlane32_swap(__float_as_uint(q), __float_as_uint(q), false, false); q = __uint_as_float(rr[0]) + __uint_as_float(rr[1]); }
            const float rstd = 1.0f / sqrtf(q * (1.0f / 128.0f) + 1e-6f);
            bf16* orow = MIX + row * 1024 + 512 + h * 128 + 64 * eh;
#pragma unroll
            for (int c8 = 0; c8 < 8; ++c8) { const f32x4 g0 = *(const f32x4*)(mg + 8 * c8), g1 = *(const f32x4*)(mg + 8 * c8 + 4);
                u32x4 ov = {cvtpk(v[8 * c8] * rstd * g0.x, v[8 * c8 + 1] * rstd * g0.y), cvtpk(v[8 * c8 + 2] * rstd * g0.z, v[8 * c8 + 3] * rstd * g0.w),
                            cvtpk(v[8 * c8 + 4] * rstd * g1.x, v[8 * c8 + 5] * rstd * g1.y), cvtpk(v[8 * c8 + 6] * rstd * g1.z, v[8 * c8 + 7] * rstd * g1.w)};
                *(u32x4*)(orow + 8 * c8) = ov; }
        }
    }
#undef ML_PK4
    __syncthreads();
}
#undef KSW
#undef MLPK
#undef MLAS
}

#define LAS __attribute__((address_space(3)))
typedef unsigned short bf16;
typedef float f32x4 __attribute__((ext_vector_type(4)));
typedef unsigned u32x4 __attribute__((ext_vector_type(4)));
typedef unsigned u32x2 __attribute__((ext_vector_type(2)));
typedef short bf16x8 __attribute__((ext_vector_type(8)));
constexpr int NWAVES = 8, NTHREADS = 512;
constexpr int DM = 1024, NB = 4, SEQ = 4096, CTXL = 256, TB = SEQ + CTXL  , R = NB * TB  ;
constexpr int DFF = 2752, DFFP = 2816, NW1 = 2 * DFFP  , DIN = 2512, DINP = 2560, KUP = 384, NUP = 1792;
constexpr int NMOD = 9;
constexpr float EPS = 1e-6f;
constexpr size_t MiB = 1u << 20;
constexpr size_t WS_CTL = 0, CTL_BYTES = 1 * MiB;
constexpr size_t WS_MOD = 1 * MiB;
constexpr size_t WS_TAB = WS_MOD + 512 * 1024;
constexpr size_t WS_W1 = 2 * MiB;
constexpr size_t WS_W2 = WS_W1 + (size_t)2 * NW1 * DM * 2;
constexpr size_t WS_WIN = WS_W2 + (size_t)2 * DM * DFFP * 2;
constexpr size_t WS_WUP = WS_WIN + (size_t)DINP * DM * 2;
constexpr size_t WS_WOUT = WS_WUP + (size_t)NUP * KUP * 2;
constexpr size_t WS_XC = WS_WOUT + (size_t)DM * DM * 2;
constexpr size_t WS_H = WS_XC + (size_t)NB * CTXL * DM * 4;
constexpr size_t WS_BIG = WS_H + (size_t)R * DM * 2;
constexpr size_t BIG_KR = (size_t)R * DINP * 2;
constexpr size_t BIG_G = BIG_KR + (size_t)R * 64 * 2;
constexpr size_t WS_Y = WS_BIG + (size_t)R * DFFP * 2;
constexpr size_t WS_Q = WS_Y + (size_t)R * DM * 2;
constexpr size_t WS_AUP = WS_Q + (size_t)R * 768 * 2;
constexpr size_t WS_HF = WS_AUP + (size_t)R * 512 * 2;
constexpr size_t WS_HB = WS_HF + (size_t)R * 512 * 2;
constexpr size_t WS_MS = WS_HB + (size_t)R * 512 * 2;
constexpr size_t MS_NLOC = 0, MS_SCA = 262144, MS_NST = 266240, MS_BM = 544768;
constexpr size_t MS_X1 = 3u << 20, MS_X2 = (3u << 20) + (512u << 10);
constexpr size_t MS_T = 1u << 20;
constexpr size_t WS_END = WS_MS + 4 * MiB;
static_assert(BIG_G + (size_t)R * 16 * 4 <= (size_t)R * DFFP * 2, "P + KR + G fit the hidden region");
static_assert(WS_W1 % 256 == 0 && WS_W2 % 256 == 0 && WS_WIN % 256 == 0 && WS_WUP % 256 == 0 && WS_WOUT % 256 == 0 && WS_XC % 256 == 0 && WS_H % 256 == 0 && WS_BIG % 256 == 0 && WS_Y % 256 == 0 && WS_Q % 256 == 0 && WS_AUP % 256 == 0 && WS_HF % 256 == 0, "alignment");
static_assert(WS_END <= 305u * MiB, "workspace budget");
constexpr int LDS_BYTES = 147456, LDS_MISC = 143360;

#define LDS_WAIT() asm volatile("s_waitcnt lgkmcnt(0)" ::: "memory")
__device__ __forceinline__ unsigned f2bf(float f) { unsigned u = __builtin_bit_cast(unsigned, f); return (u + 0x7fffu + ((u >> 16) & 1u)) >> 16; }
__device__ __forceinline__ unsigned pk2(float lo, float hi) { return f2bf(lo) | (f2bf(hi) << 16); }
__device__ __forceinline__ float bflo(unsigned w) { return __uint_as_float(w << 16); }
__device__ __forceinline__ float bfhi(unsigned w) { return __uint_as_float(w & 0xffff0000u); }
__device__ __forceinline__ float bf1(bf16 b) { return __uint_as_float(((unsigned)b) << 16); }
__device__ __forceinline__ float wave_sum(float v) {
#pragma unroll
    for (int o = 1; o < 64; o <<= 1) v += __shfl_xor(v, o);
    return v;
}
__device__ __forceinline__ float sigmoid_f(float x) { return __builtin_amdgcn_rcpf(1.0f + __builtin_amdgcn_exp2f(-1.4426950408889634f * x)); }
__device__ __forceinline__ float silu1(float x) { return x * sigmoid_f(x); }

struct Args { const float* in[22]; float* out; unsigned char* ws; int ph_lo, ph_hi; };
struct ArgsV { const Args* p; int z;
    __device__ __forceinline__ const float* in(int i) const { return p->in[i + z]; }
    __device__ __forceinline__ float* out() const { return (float*)p->in[22 + z]; }
    __device__ __forceinline__ unsigned char* ws() const { return (unsigned char*)p->in[23 + z]; } };
enum { I_X = 0, I_C, I_CTX, I_CCTX, I_WMOD, I_BMOD, I_NPRE, I_NPOST, I_WG, I_WU, I_WD, I_WIN, I_QN, I_WUQ, I_KVN, I_WUKV, I_AON, I_CW, I_CB, I_GB, I_MN, I_WOUT };

__device__ __forceinline__ const float* xin_row(const ArgsV& a, int r) { const int b = r / TB, t = r - b * TB; return t < CTXL ? a.in(I_CTX) + (size_t)(b * CTXL + t) * DM : a.in(I_X) + (size_t)(b * SEQ + t - CTXL) * DM; }
__device__ __forceinline__ float* xres_row(const ArgsV& a, int r) { const int b = r / TB, t = r - b * TB; return t < CTXL ? (float*)(a.ws() + WS_XC) + (size_t)(b * CTXL + t) * DM : a.out() + (size_t)(b * SEQ + t - CTXL) * DM; }
__device__ __forceinline__ const float* mod_vec(const ArgsV& a, int l, int r, int j) { const int b = r / TB, t = r - b * TB; const int bb = t < CTXL ? 4 : b; return (const float*)(a.ws() + WS_MOD) + (size_t)((l * 5 + bb) * NMOD + j) * DM; }

__device__ __forceinline__ void cvt_item(const float* src, int srcN, int k0, int c0, int ncv, bf16* dst, int dstK, int drow0, int dk0, LAS float* scr, int lane) {
    const int n4 = (lane & 15) * 4, kr = lane >> 4;
    f32x4 v[16];
    const bool ok = n4 < ncv;
    const float* sp = src + (size_t)(k0 + kr) * srcN + c0 + n4;
#pragma unroll
    for (int i = 0; i < 16; ++i) { v[i] = (f32x4){0.f, 0.f, 0.f, 0.f}; if (ok) v[i] = *(const f32x4*)(sp + (size_t)(4 * i) * srcN); }
#pragma unroll
    for (int i = 0; i < 16; ++i) { const int k = 4 * i + kr; *(LAS f32x4*)(scr + k * 68 + ((n4 + 8 * (k >> 3)) & 63)) = v[i]; }
    LDS_WAIT(); asm volatile("" ::: "memory");
    const int c = lane & 7;
#pragma unroll
    for (int j = 0; j < 8; ++j) { const int n = (lane >> 3) + 8 * j; const LAS float* s = scr + (8 * c) * 68 + ((n + 8 * c) & 63);
        u32x4 o; o.x = pk2(s[0 * 68], s[1 * 68]); o.y = pk2(s[2 * 68], s[3 * 68]); o.z = pk2(s[4 * 68], s[5 * 68]); o.w = pk2(s[6 * 68], s[7 * 68]);
        *(u32x4*)(dst + (size_t)(drow0 + n) * dstK + dk0 + 8 * c) = o; }
    LDS_WAIT(); asm volatile("" ::: "memory");
}
__device__ __forceinline__ void wconv_layer(const ArgsV& a, int l, LAS unsigned char* lds, int bid, int nbl, int wave, int lane, int parts) {
    LAS float* scr = (LAS float*)(lds + wave * 17408);
    const int gw = bid * NWAVES + wave, NGW = nbl * NWAVES;
    constexpr int I_1 = 88 * 16, I_2 = 16 * 44, I_IN = 40 * 16, I_UP = 28 * 6, I_OUT = 16 * 16;
    constexpr int NITEMS = 2 * I_1 + 2 * I_2 + I_IN + I_UP + I_OUT;
    bf16* W1 = (bf16*)(a.ws() + WS_W1); bf16* W2 = (bf16*)(a.ws() + WS_W2); bf16* WIN = (bf16*)(a.ws() + WS_WIN); bf16* WUP = (bf16*)(a.ws() + WS_WUP); bf16* WOUT = (bf16*)(a.ws() + WS_WOUT);
    for (int it = gw; it < NITEMS; it += NGW) {
        int r = it;
        {
            int g; if (it < 2 * I_1) g = it / I_1; else if (it < 2 * I_1 + 2 * I_2) g = 2 + (it - 2 * I_1) / I_2; else if (it < 2 * I_1 + 2 * I_2 + I_IN) g = 4; else if (it < 2 * I_1 + 2 * I_2 + I_IN + I_UP) g = 5; else g = 6;
            if (!((parts >> g) & 1)) continue; }
        if (r < 2 * I_1) { const int j = r / I_1; r -= j * I_1; const int g = r / 16, kb = r % 16; const int row0 = 64 * g, pn = row0 >> 8, i = row0 & 255; const int hc = 128 * pn + (i & 127);
            const float* src = (i < 128 ? a.in(I_WG) : a.in(I_WU)) + (size_t)(l * 2 + j) * DM * DFF;
            cvt_item(src, DFF, 64 * kb, hc < DFF ? hc : 0, hc < DFF ? 64 : 0, W1 + (size_t)j * NW1 * DM, DM, row0, 64 * kb, scr, lane); continue; }
        r -= 2 * I_1;
        if (r < 2 * I_2) { const int j = r / I_2; r -= j * I_2; const int g = r / 44, kb = r % 44;
            const float* src = a.in(I_WD) + (size_t)(l * 2 + j) * DFF * DM;
            cvt_item(src, DM, kb < 43 ? 64 * kb : 0, 64 * g, kb < 43 ? 64 : 0, W2 + (size_t)j * DM * DFFP, DFFP, 64 * g, 64 * kb, scr, lane); continue; }
        r -= 2 * I_2;
        if (r < I_IN) { const int g = r / 16, kb = r % 16; int ncv = DIN - 64 * g; ncv = ncv < 0 ? 0 : (ncv > 64 ? 64 : ncv);
            cvt_item(a.in(I_WIN) + (size_t)l * DM * DIN, DIN, 64 * kb, ncv > 0 ? 64 * g : 0, ncv, WIN, DM, 64 * g, 64 * kb, scr, lane); continue; }
        r -= I_IN;
        if (r < I_UP) { const int g = r / 6, kb = r % 6;
            if (g < 12) cvt_item(a.in(I_WUQ) + (size_t)l * 256 * 768, 768, kb < 4 ? 64 * kb : 0, 64 * g, kb < 4 ? 64 : 0, WUP, KUP, 64 * g, 64 * kb, scr, lane);
            else cvt_item(a.in(I_WUKV) + (size_t)l * 128 * 1024, 1024, kb >= 4 ? 64 * (kb - 4) : 0, 64 * (g - 12), kb >= 4 ? 64 : 0, WUP, KUP, 64 * g, 64 * kb, scr, lane);
            continue; }
        r -= I_UP;
        { const int g = r / 16, kb = r % 16; cvt_item(a.in(I_WOUT) + (size_t)l * DM * DM, DM, 64 * kb, 64 * g, 64, WOUT, DM, 64 * g, 64 * kb, scr, lane); }
    }
}
__device__ __forceinline__ void mod_phase(const ArgsV& a, LAS unsigned char* lds, int bid, int nbl, int tid, int wave, int lane) {
    LAS float* sv = (LAS float*)(lds);
    LAS float* red = (LAS float*)(lds + 20480);
    for (int i = tid; i < 5 * DM; i += NTHREADS) { const float v = i < 4 * DM ? a.in(I_C)[i] : a.in(I_CCTX)[i - 4 * DM]; sv[i] = silu1(v); }
    __syncthreads();
    float* mod = (float*)(a.ws() + WS_MOD);
    for (int u = bid; u < 256; u += nbl) {
        const int l = u >> 7, cb = (u & 127) * 72; const bool act = lane < 18;
        const float* W = a.in(I_WMOD) + (size_t)l * DM * (NMOD * DM) + cb + 4 * (act ? lane : 0);
        f32x4 acc[5];
#pragma unroll
        for (int bb = 0; bb < 5; ++bb) acc[bb] = (f32x4){0.f, 0.f, 0.f, 0.f};
        for (int k0 = wave * 128; k0 < wave * 128 + 128; k0 += 32) { f32x4 w[32];
#pragma unroll
            for (int i = 0; i < 32; ++i) w[i] = *(const f32x4*)(W + (size_t)(k0 + i) * (NMOD * DM));
#pragma unroll
            for (int i = 0; i < 32; ++i)
#pragma unroll
                for (int bb = 0; bb < 5; ++bb) acc[bb] += w[i] * sv[bb * DM + k0 + i]; }
        if (act) {
#pragma unroll
            for (int bb = 0; bb < 5; ++bb) *(LAS f32x4*)(red + (wave * 5 + bb) * 72 + 4 * lane) = acc[bb]; }
        __syncthreads();
        for (int i = tid; i < 5 * 72; i += NTHREADS) { const int bb = i / 72, cc = i % 72; float s = 0.f;
#pragma unroll
            for (int w = 0; w < 8; ++w) s += red[(w * 5 + bb) * 72 + cc];
            mod[(size_t)(l * 5 + bb) * (NMOD * DM) + cb + cc] = s + a.in(I_BMOD)[(size_t)l * NMOD * DM + cb + cc]; }
        __syncthreads();
    }
    if (bid == nbl - 1 && tid < 64) {
        constexpr float inv[16] = {1.0f, 0.5623413251903491f, 0.31622776601683794f, 0.1778279410038923f, 0.1f, 0.05623413251903491f, 0.03162277660168379f, 0.01778279410038923f,
                                   0.01f, 0.005623413251903491f, 0.0031622776601683794f, 0.001778279410038923f, 0.001f, 0.0005623413251903491f, 0.00031622776601683794f, 0.0001778279410038923f};
        float* tab = (float*)(a.ws() + WS_TAB);
#pragma unroll
        for (int f = 0; f < 16; ++f) {
            const float ang = (float)tid * inv[f];
            const double ad = (double)ang; const double kq = __builtin_rint(ad * 0.63661977236758134308); const double rd = ad - kq * 1.57079632679489661923;
            const float x = (float)rd, x2 = x * x; const int q = ((int)kq) & 3;
            const float sp = x + x * x2 * (-1.6666654611e-1f + x2 * (8.3321608736e-3f + x2 * (-1.9515295891e-4f)));
            const float cp = 1.0f - 0.5f * x2 + x2 * x2 * (4.166664568298827e-2f + x2 * (-1.388731625493765e-3f + x2 * 2.443315711809948e-5f));
            const float sn = (q == 0) ? sp : (q == 1) ? cp : (q == 2) ? -sp : -cp;
            const float cs = (q == 0) ? cp : (q == 1) ? -sp : (q == 2) ? -cp : sp;
            tab[(tid * 16 + f) * 2] = cs; tab[(tid * 16 + f) * 2 + 1] = sn; }
    }
    __syncthreads();
}

__device__ __forceinline__ void rw_pre(const f32x4 (&x)[4], const float* g, const float* sc, const float* sh, bf16* hrow, int lane) {
    float ss = 0.f;
#pragma unroll
    for (int j = 0; j < 4; ++j) ss += (x[j].x * x[j].x + x[j].y * x[j].y) + (x[j].z * x[j].z + x[j].w * x[j].w);
    const float rstd = 1.0f / sqrtf(wave_sum(ss) * (1.0f / DM) + EPS);
#pragma unroll
    for (int j = 0; j < 4; ++j) { const int c = 256 * j + 4 * lane; const f32x4 gv = *(const f32x4*)(g + c), sv = *(const f32x4*)(sc + c), hv = *(const f32x4*)(sh + c);
        f32x4 o; o.x = x[j].x * rstd * gv.x * (1.0f + sv.x) + hv.x; o.y = x[j].y * rstd * gv.y * (1.0f + sv.y) + hv.y; o.z = x[j].z * rstd * gv.z * (1.0f + sv.z) + hv.z; o.w = x[j].w * rstd * gv.w * (1.0f + sv.w) + hv.w;
        u32x2 w; w.x = pk2(o.x, o.y); w.y = pk2(o.z, o.w); *(u32x2*)(hrow + c) = w; }
}
__device__ __forceinline__ void xb_store(const ArgsV& a, int r, const f32x4 (&x)[4], int lane) {
    const int b = r / TB, t = r - b * TB; if (t < CTXL) return;
    bf16* xr = (bf16*)(a.ws() + WS_Y) + (size_t)(b * SEQ + t - CTXL) * DM;
#pragma unroll
    for (int j = 0; j < 4; ++j) { u32x2 w; w.x = pk2(x[j].x, x[j].y); w.y = pk2(x[j].z, x[j].w); *(u32x2*)(xr + 256 * j + 4 * lane) = w; }
}
__device__ __forceinline__ void phase_rw_a(const ArgsV& a, int bid, int nbl, int wave, int lane) {
    const int gw = bid * NWAVES + wave, NGW = nbl * NWAVES; bf16* H = (bf16*)(a.ws() + WS_H);
    for (int ra = gw; ra < R; ra += 2 * NGW) {
        const int rb_ = ra + NGW < R ? ra + NGW : ra; const float* xa = xin_row(a, ra); const float* xb = xin_row(a, rb_); f32x4 x0[4], x1[4];
#pragma unroll
        for (int j = 0; j < 4; ++j) { x0[j] = *(const f32x4*)(xa + 256 * j + 4 * lane); x1[j] = *(const f32x4*)(xb + 256 * j + 4 * lane); }
        xb_store(a, ra, x0, lane); if (rb_ != ra) xb_store(a, rb_, x1, lane);
        rw_pre(x0, a.in(I_NPRE) + 0, mod_vec(a, 0, ra, 1), mod_vec(a, 0, ra, 0), H + (size_t)ra * DM, lane);
        if (rb_ != ra) rw_pre(x1, a.in(I_NPRE) + 0, mod_vec(a, 0, rb_, 1), mod_vec(a, 0, rb_, 0), H + (size_t)rb_ * DM, lane); }
}
__device__ __forceinline__ void phase_rw_b(const ArgsV& a, int l, int sub, int bid, int nbl, int wave, int lane, bool dry = false) {
    const int gw = bid * NWAVES + wave, NGW = nbl * NWAVES; bf16* H = (bf16*)(a.ws() + WS_H);
    const float wgt = sub == 1 ? 1.0f : 0.5f; const float* gpost = a.in(I_NPOST) + (size_t)(l * 3 + sub) * DM;
    const int nl = sub == 2 ? l + 1 : l, nsub = sub == 2 ? 0 : sub + 1;
    const bool from_input = (l == 0 && sub == 0); const int nsl = sub == 1 ? 4 : 11;
    if (l == 1 && sub >= 1) return;
    const float* gpre = a.in(I_NPRE) + (size_t)(nl * 3 + nsub) * DM;
    for (int i0 = gw; i0 < NB * CTXL; i0 += NGW) {
        const int r0 = (i0 / CTXL) * TB + (i0 % CTXL);
        const float* xs0 = from_input ? xin_row(a, r0) : xres_row(a, r0);
        const float* gate0 = mod_vec(a, l, r0, 3 * sub + 2); const float* sc0 = mod_vec(a, nl, r0, 3 * nsub + 1); const float* sh0 = mod_vec(a, nl, r0, 3 * nsub);
        const float* sp = (const float*)(a.ws() + WS_AUP) + (size_t)((r0 / TB) * CTXL + (r0 % TB)) * DM + 4 * lane;
        f32x4 x0[4], y0[4], gp[4], gt[4], gn[4], sv[4], hv[4];
        {   f32x4 v[4][4];
#pragma unroll
            for (int j = 0; j < 4; ++j) { const int c = 256 * j + 4 * lane; x0[j] = *(const f32x4*)(xs0 + c); gp[j] = *(const f32x4*)(gpost + c); gt[j] = *(const f32x4*)(gate0 + c);
#pragma unroll
                for (int s = 0; s < 4; ++s) v[s][j] = *(const f32x4*)(sp + (size_t)s * 1024 * 1024 + 256 * j); }
            asm volatile("" ::: "memory");
#pragma unroll
            for (int j = 0; j < 4; ++j) y0[j] = (v[0][j] + v[1][j]) + (v[2][j] + v[3][j]); }
        if (nsl > 4) {
            {   f32x4 w[4][4];
#pragma unroll
                for (int j = 0; j < 4; ++j) { const int c = 256 * j + 4 * lane; gn[j] = *(const f32x4*)(gpre + c); sv[j] = *(const f32x4*)(sc0 + c); hv[j] = *(const f32x4*)(sh0 + c);
#pragma unroll
                    for (int s = 0; s < 4; ++s) w[s][j] = *(const f32x4*)(sp + (size_t)(4 + s) * 1024 * 1024 + 256 * j); }
                asm volatile("" ::: "memory");
#pragma unroll
                for (int j = 0; j < 4; ++j) y0[j] += (w[0][j] + w[1][j]) + (w[2][j] + w[3][j]); }
            {   f32x4 w[3][4];
#pragma unroll
                for (int s = 0; s < 3; ++s)
#pragma unroll
                    for (int j = 0; j < 4; ++j) w[s][j] = *(const f32x4*)(sp + (size_t)(8 + s) * 1024 * 1024 + 256 * j);
#pragma unroll
                for (int j = 0; j < 4; ++j) y0[j] += (w[0][j] + w[1][j]) + w[2][j]; }
        } else {
#pragma unroll
            for (int j = 0; j < 4; ++j) { const int c = 256 * j + 4 * lane; gn[j] = *(const f32x4*)(gpre + c); sv[j] = *(const f32x4*)(sc0 + c); hv[j] = *(const f32x4*)(sh0 + c); }
        }
        float ss0 = 0.f;
#pragma unroll
        for (int j = 0; j < 4; ++j) ss0 += (y0[j].x * y0[j].x + y0[j].y * y0[j].y) + (y0[j].z * y0[j].z + y0[j].w * y0[j].w);
        const float rs0 = 1.0f / sqrtf(wave_sum(ss0) * (1.0f / DM) + EPS);
        float* xd0 = dry ? (float*)(a.ws() + WS_BIG) + (size_t)r0 * DM : xres_row(a, r0);
        float s2 = 0.f;
#pragma unroll
        for (int j = 0; j < 4; ++j) { const int c = 256 * j + 4 * lane;
            x0[j].x += wgt * gt[j].x * (y0[j].x * rs0 * gp[j].x); x0[j].y += wgt * gt[j].y * (y0[j].y * rs0 * gp[j].y); x0[j].z += wgt * gt[j].z * (y0[j].z * rs0 * gp[j].z); x0[j].w += wgt * gt[j].w * (y0[j].w * rs0 * gp[j].w);
            *(f32x4*)(xd0 + c) = x0[j]; s2 += (x0[j].x * x0[j].x + x0[j].y * x0[j].y) + (x0[j].z * x0[j].z + x0[j].w * x0[j].w); }
        const float rstd = 1.0f / sqrtf(wave_sum(s2) * (1.0f / DM) + EPS); bf16* hrow = H + (size_t)r0 * DM;
#pragma unroll
        for (int j = 0; j < 4; ++j) { const int c = 256 * j + 4 * lane; f32x4 o;
            o.x = x0[j].x * rstd * gn[j].x * (1.0f + sv[j].x) + hv[j].x; o.y = x0[j].y * rstd * gn[j].y * (1.0f + sv[j].y) + hv[j].y; o.z = x0[j].z * rstd * gn[j].z * (1.0f + sv[j].z) + hv[j].z; o.w = x0[j].w * rstd * gn[j].w * (1.0f + sv[j].w) + hv[j].w;
            u32x2 w; w.x = pk2(o.x, o.y); w.y = pk2(o.z, o.w); *(u32x2*)(hrow + c) = w; }
    }
}
__device__ __forceinline__ void phase_rw_prep(const ArgsV& a, int l, int bid, int nbl, int wave, int lane) {
    const int gw = bid * NWAVES + wave, NGW = nbl * NWAVES;
    const bf16* P = (const bf16*)(a.ws() + WS_BIG); bf16* AUP = (bf16*)(a.ws() + WS_AUP); bf16* KR = (bf16*)(a.ws() + WS_BIG + BIG_KR);
    const float* tab = (const float*)(a.ws() + WS_TAB);
    const float* qn = a.in(I_QN) + l * 256; const float* kvn = a.in(I_KVN) + l * 128;
    for (int task = gw; task < 32 * 17; task += NGW)
        ml::gate_scan_task((const float*)(a.ws() + WS_BIG + BIG_G), a.in(I_GB) + l * 16, (float*)(a.ws() + WS_MS + MS_T), (float*)(a.ws() + WS_MS + MS_SCA), task, lane);
    for (int ra = gw; ra < R; ra += 2 * NGW) {
        const int rb_ = ra + NGW < R ? ra + NGW : ra; const bool two = rb_ != ra;
        const bf16* pa = P + (size_t)ra * DINP; const bf16* pb = P + (size_t)rb_ * DINP;
        const u32x2 wa = *(const u32x2*)(pa + 4 * lane), wb = *(const u32x2*)(pb + 4 * lane);
        const unsigned ka = *(const unsigned*)(pa + 256 + 2 * lane), kb = *(const unsigned*)(pb + 256 + 2 * lane);
        const float va = bf1(pa[384 + lane]), vb = bf1(pb[384 + lane]);
        const f32x4 g = *(const f32x4*)(qn + 4 * lane); const float kg0 = kvn[2 * lane], kg1 = kvn[2 * lane + 1];
        float a0 = bflo(wa.x), a1 = bfhi(wa.x), a2 = bflo(wa.y), a3 = bfhi(wa.y), b0 = bflo(wb.x), b1 = bfhi(wb.x), b2 = bflo(wb.y), b3 = bfhi(wb.y);
        float sa = (a0 * a0 + a1 * a1) + (a2 * a2 + a3 * a3), sb = (b0 * b0 + b1 * b1) + (b2 * b2 + b3 * b3);
        const float c0 = bflo(ka), c1 = bfhi(ka), d0 = bflo(kb), d1 = bfhi(kb); float ta = c0 * c0 + c1 * c1, tb = d0 * d0 + d1 * d1;
#pragma unroll
        for (int o = 1; o < 64; o <<= 1) { sa += __shfl_xor(sa, o); sb += __shfl_xor(sb, o); ta += __shfl_xor(ta, o); tb += __shfl_xor(tb, o); }
        const float voa = __shfl_xor(va, 16), vob = __shfl_xor(vb, 16);
        const float rqa = 1.0f / sqrtf(sa * (1.0f / 256.0f) + EPS), rqb = 1.0f / sqrtf(sb * (1.0f / 256.0f) + EPS), rka = 1.0f / sqrtf(ta * (1.0f / 128.0f) + EPS), rkb = 1.0f / sqrtf(tb * (1.0f / 128.0f) + EPS);
        { u32x2 o; o.x = pk2(a0 * rqa * g.x, a1 * rqa * g.y); o.y = pk2(a2 * rqa * g.z, a3 * rqa * g.w); *(u32x2*)(AUP + (size_t)ra * KUP + 4 * lane) = o;
          *(unsigned*)(AUP + (size_t)ra * KUP + 256 + 2 * lane) = pk2(c0 * rka * kg0, c1 * rka * kg1); }
        if (two) { u32x2 o; o.x = pk2(b0 * rqb * g.x, b1 * rqb * g.y); o.y = pk2(b2 * rqb * g.z, b3 * rqb * g.w); *(u32x2*)(AUP + (size_t)rb_ * KUP + 4 * lane) = o;
          *(unsigned*)(AUP + (size_t)rb_ * KUP + 256 + 2 * lane) = pk2(d0 * rkb * kg0, d1 * rkb * kg1); }
        const int ax = lane >> 5, half = (lane >> 4) & 1, f = lane & 15;
        { const int t = ra % TB; float o = va;
          if (t >= CTXL) { const int tt = t - CTXL; const int pos = ax == 0 ? (tt >> 6) : (tt & 63); const float cs = tab[(pos * 16 + f) * 2], sn = tab[(pos * 16 + f) * 2 + 1]; o = half == 0 ? va * cs - voa * sn : va * cs + voa * sn; }
          KR[(size_t)ra * 64 + lane] = (bf16)f2bf(o); }
        if (two) { const int t = rb_ % TB; float o = vb;
          if (t >= CTXL) { const int tt = t - CTXL; const int pos = ax == 0 ? (tt >> 6) : (tt & 63); const float cs = tab[(pos * 16 + f) * 2], sn = tab[(pos * 16 + f) * 2 + 1]; o = half == 0 ? vb * cs - vob * sn : vb * cs + vob * sn; }
          KR[(size_t)rb_ * 64 + lane] = (bf16)f2bf(o); }
    }
}
#define RLX_AGENT __ATOMIC_RELAXED, __HIP_MEMORY_SCOPE_AGENT
#define VM_WAIT() asm volatile("s_waitcnt vmcnt(0)" ::: "memory")
#define XB_TMO      128
#define XB_XCNT(j)  (256  + 64 * (j))
#define XB_XSUB(j)  (1280 + 64 * (j))
#define XB_XGEN(j)  (2304 + 64 * (j))
#define XB_TOP      3328
#define XB_TOPGEN   3392
#define XCD_BAR_WORDS 3456
#define XB_SPIN_CAP (1u << 18)

__device__ __forceinline__ unsigned xb_ld(unsigned* p)              { return __hip_atomic_load(p, __ATOMIC_RELAXED, __HIP_MEMORY_SCOPE_AGENT); }
__device__ __forceinline__ unsigned xb_add(unsigned* p, unsigned v) { return __hip_atomic_fetch_add(p, v, __ATOMIC_RELAXED, __HIP_MEMORY_SCOPE_AGENT); }
__device__ __forceinline__ unsigned xb_xcc_id() { return (unsigned)__builtin_amdgcn_s_getreg((3 << 11) | 20) & 0xFu; }
#define XB_SPIN(cond, bar) do { unsigned _sp = 0; while (cond) { __builtin_amdgcn_s_sleep(1); \
    if ((++_sp & 255u) == 0u) { if (xb_ld(&(bar)[XB_TMO])) break; if (_sp > XB_SPIN_CAP) { atomicAdd(&(bar)[XB_TMO], 1u); break; } } } } while (0)

struct XcdBarrier {
    unsigned* bar; unsigned x;
    volatile LAS unsigned* st;
};

__device__ __forceinline__ XcdBarrier xcd_barrier_post(unsigned* bar, volatile LAS unsigned* st) {
    XcdBarrier b; b.bar = bar; b.x = xb_xcc_id(); b.st = st;
    if (threadIdx.x == 0) (void)xb_add(&bar[XB_XCNT(b.x)], 1u);
    return b;
}
__device__ __forceinline__ void xcd_barrier_complete(unsigned* bar, unsigned x, unsigned& nloc, unsigned& nx) {
    const unsigned G = gridDim.x * gridDim.y * gridDim.z;
    unsigned sum, cnt, mine, sp = 0u;
    for (;;) {
        sum = 0u; cnt = 0u; mine = 0u;
#pragma unroll
        for (unsigned j = 0; j < 16; ++j) { const unsigned c = xb_ld(&bar[XB_XCNT(j)]); sum += c; cnt += (c > 0u) ? 1u : 0u; mine = (j == x) ? c : mine; }
        if (sum == G) break;
        __builtin_amdgcn_s_sleep(1);
        if ((++sp & 255u) == 0u) { if (xb_ld(&bar[XB_TMO])) break; if (sp > XB_SPIN_CAP) { atomicAdd(&bar[XB_TMO], 1u); break; } }
    }
    nloc = mine > 0u ? mine : 1u; nx = cnt > 0u ? cnt : 1u;
}

__device__ __forceinline__ void xcd_barrier(const XcdBarrier& b) {
    asm volatile("s_waitcnt vmcnt(0)" ::: "memory");
    __syncthreads();
    if (threadIdx.x == 0) {
        unsigned* bar = b.bar;
        __builtin_amdgcn_s_waitcnt(0);
        unsigned nloc = b.st[0], nx = b.st[1];
        if (nloc == 0u) { xcd_barrier_complete(bar, b.x, nloc, nx); b.st[0] = nloc; b.st[1] = nx; }
        const unsigned old = xb_add(&bar[XB_XSUB(b.x)], 1u);
        const unsigned gen = old / nloc;
        if (old + 1u == (gen + 1u) * nloc) {
            __builtin_amdgcn_fence(__ATOMIC_RELEASE, "agent");
            asm volatile("s_waitcnt vmcnt(0)" ::: "memory");
            const unsigned og = xb_add(&bar[XB_TOP], 1u);
            const unsigned tg = og / nx;
            if (og + 1u == (tg + 1u) * nx) xb_add(&bar[XB_TOPGEN], 1u);
            else XB_SPIN(xb_ld(&bar[XB_TOPGEN]) == tg, bar);
            __builtin_amdgcn_fence(__ATOMIC_ACQUIRE, "agent");
            xb_add(&bar[XB_XGEN(b.x)], 1u);
            asm volatile("s_waitcnt vmcnt(0)" ::: "memory");
        } else {
            XB_SPIN(xb_ld(&bar[XB_XGEN(b.x)]) == gen, bar);
            __builtin_amdgcn_fence(__ATOMIC_ACQUIRE, "agent");
            asm volatile("s_waitcnt vmcnt(0)" ::: "memory");
        }
    }
    __syncthreads();
}
constexpr int PPL = 15, N_PHASES = 1 + 2 * PPL, SKIP_PHASE = 1 + PPL;
__global__ void __launch_bounds__(NTHREADS, 2) mega_fwd(Args args) {
    extern __shared__ __attribute__((aligned(16))) unsigned char lds_raw[];
    LAS unsigned char* lds = (LAS unsigned char*)lds_raw;
    cg::grid_group grid = cg::this_grid();
    volatile LAS unsigned* MISC = (volatile LAS unsigned*)(lds + LDS_MISC);
    if (threadIdx.x < 16) MISC[threadIdx.x] = 0u;
    __syncthreads();
    XcdBarrier bar = xcd_barrier_post((unsigned*)(args.ws + WS_CTL), MISC + 8);
    for (int ph = args.ph_lo; ph < args.ph_hi; ++ph) {
        if (ph == SKIP_PHASE || ph == 1 + PPL + 11 || ph == 1 + PPL + 14 || ph == 1 + 9 || ph == 1 + PPL + 9) continue;
#define TID_DECL int tid_ = threadIdx.x; asm volatile("" : "+v"(tid_)); const int tid = tid_, lane = tid & 63, wave = __builtin_amdgcn_readfirstlane(tid >> 6); (void)tid; (void)lane; (void)wave
        int bid_ = blockIdx.x, nbl_ = gridDim.x; asm volatile("" : "+s"(bid_), "+s"(nbl_)); const int bid = bid_, nbl = nbl_;
        int zo_ = 0; asm volatile("" : "+s"(zo_));
        const ArgsV A_{&args, zo_}; unsigned char* ws = A_.ws();
        XcdBarrier barl = bar; asm volatile("" : "+s"(barl.x), "+s"(barl.bar));
        if (ph == 0) { TID_DECL; mod_phase(A_, lds, bid, nbl, tid, wave, lane); }
        else {
            const int l = (ph - 1) / PPL, k = (ph - 1) % PPL;
            if (k == 0) { TID_DECL; phase_rw_a(A_, bid, nbl, wave, lane); }
            else if (k == 1 || k == 12) { const int j = k == 12;
                pg8::Gemm g{(const pg8::bf16_t*)(ws + WS_H), (const pg8::bf16_t*)(ws + WS_W1) + (size_t)j * NW1 * DM, R, NW1, DM}; pg8::TileOrder S; S.init(0, NW1, DM, nbl, bid, 1);
                pg8::EpiSwiGLU E{(pg8::bf16_t*)(ws + WS_BIG), DFFP};
                pg8::gemm_phase<pg8::EpiSwiGLU, pg8::TileOrder, true, true>(lds, g, S, E); }
            else if (k == 2 || k == 13 || k == 10) { const int j = k == 13, sub = k == 2 ? 0 : (k == 10 ? 1 : 2);
                const pg8::bf16_t* A = (const pg8::bf16_t*)(ws + (k == 10 ? WS_H : WS_BIG));
                const pg8::bf16_t* Bt = k == 10 ? (const pg8::bf16_t*)(ws + WS_WOUT) : (const pg8::bf16_t*)(ws + WS_W2) + (size_t)j * DM * DFFP;
                const int K = k == 10 ? DM : DFFP;
                pg8::Gemm g{A, Bt, R, DM, K}; pg8::TileOrder S; S.init(1, DM, K, nbl, bid, 1);
                const bool has_next = !(l == 1 && sub == 2); const int nl = sub == 2 ? l + 1 : l, nsub = sub == 2 ? 0 : sub + 1;
                const float* modb = (const float*)(ws + WS_MOD); unsigned* cntb = (unsigned*)(ws + WS_CTL + 65536) + (size_t)((l * 3 + sub) * 2) * (68 * 64);
                pg8::EpiNormRes E{(pg8::bf16_t*)(ws + WS_Y), A_.out(), has_next ? (pg8::bf16_t*)(ws + WS_H) : nullptr,
                                  modb + (size_t)((l * 5) * NMOD + 3 * sub + 2) * DM, A_.in(I_NPOST) + (size_t)(l * 3 + sub) * DM,
                                  A_.in(I_NPRE) + (size_t)((has_next ? nl : 0) * 3 + nsub) * DM, modb + (size_t)(((has_next ? nl : 0) * 5) * NMOD + 3 * nsub + 1) * DM, modb + (size_t)(((has_next ? nl : 0) * 5) * NMOD + 3 * nsub) * DM,
                                  sub == 1 ? 1.0f : 0.5f, pg8::PanelSS{(unsigned*)(ws + WS_MS + MS_X1), cntb}, pg8::PanelSS{(unsigned*)(ws + WS_MS + MS_X2), cntb + 68 * 64}};
                pg8::gemm_phase<pg8::EpiNormRes, pg8::TileOrder, false, true>(lds, g, S, E);
                if (l == 0 || k == 2) { __syncthreads();
                    pg8::TileOrder S2; S2.init(2, DM, K, nbl, bid, k == 10 ? 4 : 11);
                    pg8::EpiSlab E2{(float*)(ws + WS_AUP)};
                    pg8::gemm_phase<pg8::EpiSlab, pg8::TileOrder, true, true>(lds, g, S2, E2); } }
            else if (k == 6) {
                pg8::Gemm g{(const pg8::bf16_t*)(ws + WS_AUP), (const pg8::bf16_t*)(ws + WS_WUP), R, NUP, KUP}; pg8::TileOrder S; S.init(3, NUP, KUP, nbl, bid, 1);
                pg8::EpiStore E{(pg8::bf16_t*)A_.out(), NUP};
                pg8::gemm_phase<pg8::EpiStore, pg8::TileOrder, true, true>(lds, g, S, E);
                if (k == 6) {
                    __syncthreads();
                    for (int u = bid; u < 512; u += nbl)
                        ml::mlstm_local((const ml::bf16*)(ws + WS_BIG), (const float*)(ws + WS_MS + MS_T), A_.in(I_CW) + (size_t)l * 3 * 1024, A_.in(I_CB) + (size_t)l * 1024,
                                        (float*)(ws + WS_HF), (float*)(ws + WS_MS + MS_NLOC), u, (char*)lds_raw); } }
            else if (k == 3 || k == 11 || k == 14) { TID_DECL; phase_rw_b(A_, l, k == 3 ? 0 : (k == 11 ? 1 : 2), bid, nbl, wave, lane); }
            else if (k == 4) {
                pg8::Gemm g{(const pg8::bf16_t*)(ws + WS_H), (const pg8::bf16_t*)(ws + WS_WIN), R, DINP, DM}; pg8::TileOrder S; S.init(0, DINP, DM, nbl, bid, 1);
                pg8::EpiP E{(pg8::bf16_t*)(ws + WS_BIG), DINP, (float*)(ws + WS_BIG + BIG_G)};
                pg8::gemm_phase<pg8::EpiP, pg8::TileOrder, true, true>(lds, g, S, E); }
            else if (k == 5) { TID_DECL; phase_rw_prep(A_, l, bid, nbl, wave, lane); }
            else if (k == 7 || k == 8) {
                if (k == 7) { TID_DECL; ml::mlstm_scan((const float*)(ws + WS_HF), (const float*)(ws + WS_MS + MS_NLOC), (const float*)(ws + WS_MS + MS_SCA), (ml::bf16*)(ws + WS_AUP), (float*)(ws + WS_MS + MS_NST), (float*)(ws + WS_MS + MS_BM), bid * NTHREADS + tid, nbl * NTHREADS); }
                att::bf16* QKV = (att::bf16*)A_.out(); const att::bf16* KR = (const att::bf16*)(ws + WS_BIG + BIG_KR);
                const float* tab = (const float*)(ws + WS_TAB);
                int u0, u1;
                if (k == 8) { u0 = bid; u1 = 256; } else { u0 = (l == 0 && bid >= 128) ? 256 + (bid - 128) : 272; u1 = 272; }
                for (int u = u0; u < u1; u += nbl) {
                    int b, h, seq, rope, qtok0; size_t rq;
                    if (u < 256) { b = u >> 6; h = (u >> 4) & 3; const int qb = u & 15; rq = (size_t)b * TB + CTXL + (size_t)qb * 256; seq = TB; rope = 1; qtok0 = qb * 256; }
                    else { b = (u - 256) >> 2; h = (u - 256) & 3; rq = (size_t)b * TB; seq = CTXL; rope = 0; qtok0 = 0; }
                    const size_t r0 = (size_t)b * TB;
                    const int panel = u < 256 ? (b * 16 + (u & 15)) : (64 + b);
                    att::attn_body(QKV + rq * NUP + h * 192, QKV + r0 * NUP + 768 + h * 256, QKV + r0 * NUP + 768 + h * 256 + 128, KR + r0 * 64, (att::bf16*)(ws + WS_H) + rq * DM + h * 128, seq, rope, qtok0, tab, (char*)lds_raw,
                                   (unsigned*)(ws + WS_MS + MS_X1) + rq * 4, (unsigned*)(ws + WS_CTL + 65536) + (size_t)(12 + l) * (68 * 64) + 64 * panel, A_.in(I_AON) + l * 512 + h * 128, h);
                }
                const int m0 = nbl - 1 - bid, m1 = (k == 8) ? 256 : ((l == 0) ? 16 : 0);
                for (int u = m0; u < m1; u += nbl) { const int bh = (k == 8) ? (u >> 4) : u, tbk = (k == 8) ? 1 + (u & 15) : 0;
                    ml::mlstm_out2((const ml::bf16*)(ws + WS_BIG), (const float*)(ws + WS_MS + MS_T), A_.in(I_CW) + (size_t)l * 3 * 1024, A_.in(I_CB) + (size_t)l * 1024, (const ml::bf16*)(ws + WS_AUP),
                                   (const float*)(ws + WS_MS + MS_NST), (const float*)(ws + WS_MS + MS_BM), A_.in(I_MN) + l * 512, (ml::bf16*)(ws + WS_H), bh >> 2, bh & 3, tbk, (char*)lds_raw); }
            }
        }
        {
            int wl = 0, wparts = 0, wg0 = 0;
            switch (ph) {
                case 0:       wl = 0; wparts = 0x01; wg0 = 0;   break;
                case 1 + 1:   wl = 0; wparts = 0x04; wg0 = 216; break;
                case 1 + 2:   wl = 0; wparts = 0x10; wg0 = 176; break;
                case 1 + 4:   wl = 0; wparts = 0x60; wg0 = 168; break;
                case 1 + 7:   wl = 0; wparts = 0x0a; wg0 = 144; break;
                case 1 + 10:  wl = 1; wparts = 0x01; wg0 = 64;  break;
                case 1 + 12:  wl = 1; wparts = 0x04; wg0 = 216; break;
                case 1 + 13:  wl = 1; wparts = 0x10; wg0 = 176; break;
                case 1 + 14:  wl = 1; wparts = 0x60; wg0 = 0;   break;
                case 16 + 4:  wl = 1; wparts = 0x02; wg0 = 168; break;
                case 16 + 7:  wl = 1; wparts = 0x08; wg0 = 128; break;
                default: break; }
            const int wg1 = (ph == 1 + 7) ? 240 : nbl;
            if (wparts != 0 && bid >= wg0 && bid < wg1) { TID_DECL; __syncthreads(); wconv_layer(A_, wl, lds, bid - wg0, wg1 - wg0, wave, lane, wparts); } }
        if (ph + 1 < args.ph_hi) { if (args.ph_hi < 0) grid.sync(); else xcd_barrier(barl); }
    }
}

#ifndef MK_ONE_LAUNCH
#define MK_ONE_LAUNCH 1
#endif
extern "C" void kernel_launch(void* const* d_in, const int* in_sizes, int n_in, void* d_out, int out_size, void* d_ws, size_t ws_size, hipStream_t stream) {
    static int grid = 0;
    if (grid == 0) {
        if (n_in != 22 || in_sizes[0] != NB * SEQ * DM || out_size != NB * SEQ * DM || ws_size < WS_END) { fprintf(stderr, "kernel_launch: shape/workspace mismatch (n_in %d, in0 %d, out %d, ws %zu need %zu)\n", n_in, n_in > 0 ? in_sizes[0] : -1, out_size, ws_size, (size_t)WS_END); grid = -1; return; }
        int dev = 0, cus = 0, per_cu = 0;
        if (hipGetDevice(&dev) != hipSuccess || hipDeviceGetAttribute(&cus, hipDeviceAttributeMultiprocessorCount, dev) != hipSuccess) { grid = -1; return; }
        if (hipFuncSetAttribute((const void*)mega_fwd, hipFuncAttributeMaxDynamicSharedMemorySize, LDS_BYTES) != hipSuccess) { fprintf(stderr, "kernel_launch: hipFuncSetAttribute failed\n"); grid = -1; return; }
        if (hipOccupancyMaxActiveBlocksPerMultiprocessor(&per_cu, (const void*)mega_fwd, NTHREADS, LDS_BYTES) != hipSuccess || per_cu < 1) { fprintf(stderr, "kernel_launch: occupancy query says %d\n", per_cu); per_cu = 1; }
        (void)hipGetLastError();
        grid = cus * (per_cu > 1 ? 1 : per_cu);
    }
    if (grid < 0) return;
    if (hipMemsetAsync((char*)d_ws + WS_CTL, 0, 65536 + 14 * 68 * 256, stream) != hipSuccess) { fprintf(stderr, "kernel_launch: memset of the barrier words failed\n"); return; }
    Args a{};
    for (int i = 0; i < 22; ++i) a.in[i] = (const float*)d_in[i];
    a.out = (float*)d_out; a.ws = (unsigned char*)d_ws;
#if MK_ONE_LAUNCH
    a.ph_lo = 0; a.ph_hi = N_PHASES;
    void* kargs[] = {&a};
    hipError_t e = hipLaunchCooperativeKernel((const void*)mega_fwd, dim3(grid), dim3(NTHREADS), kargs, LDS_BYTES, stream);
    if (e != hipSuccess) fprintf(stderr, "kernel_launch: cooperative launch failed: %s (grid %d)\n", hipGetErrorString(e), grid);
#else
    for (int ph = 0; ph < N_PHASES; ++ph) { if (ph == SKIP_PHASE) continue; a.ph_lo = ph; a.ph_hi = ph + 1;
        hipLaunchKernelGGL(mega_fwd, dim3(grid), dim3(NTHREADS), LDS_BYTES, stream, a);
        const hipError_t le = hipPeekAtLastError(); if (le != hipSuccess) { fprintf(stderr, "kernel_launch: launch of phase %d failed: %s\n", ph, hipGetErrorName(le)); break; } }
#endif
}
```

```cpp
#include <hip/hip_runtime.h>
#include <hip/hip_cooperative_groups.h>
#include <cstdio>
#include <cstdint>
namespace cg = cooperative_groups;
namespace pg8 {
#define PG8_LAS __attribute__((address_space(3)))
typedef unsigned short bf16_t;
typedef short bf16x8 __attribute__((ext_vector_type(8)));
typedef float f32x4 __attribute__((ext_vector_type(4)));
typedef unsigned u32x4 __attribute__((ext_vector_type(4)));
constexpr int BM = 256, BK = 64, HALF = 128, HTB = HALF * BK * 2  , STAGE_BYTES = 8 * HTB, NXCD = 8, WGM = 8;

__host__ __device__ __forceinline__ int lds_byte(int r, int c) { const int st = (r >> 4) * 2 + (c >> 5), rr = r & 15, cc = c & 31, ob = rr * 64 + cc * 2; return st * 1024 + (ob ^ (((ob >> 9) & 1) << 5)); }
__host__ __device__ __forceinline__ void stage_rc(int b, int& R, int& C) { const int st = b / 1024, sb = b % 1024, swz = sb ^ (((sb >> 9) & 1) << 5); R = (st >> 1) * 16 + swz / 64; C = (st & 1) * 32 + (swz % 64) / 2; }
__host__ __device__ __forceinline__ int perm32(int rho) { const int n = rho >> 4, i = rho & 15; return 8 * (i >> 2) + 4 * n + (i & 3); }

struct Unit { int pm, pn, kt0, nkt; };
struct Gemm { const bf16_t* A; const bf16_t* Bt; int M, N, K; };

struct StaticOrder {
    int nM, nN, nwg, G, c, nkt;
    __host__ __device__ void init(int M, int N, int K, int G_, int c_) { nM = M / BM; nN = N / BM; nwg = nM * nN; G = G_; c = c_; nkt = K / BK; }
    __host__ __device__ bool next(int i, Unit& u) const {
        const long L = (long)i * G + c; if (L >= nwg) return false;
        int wgid = (int)L; { const int q = nwg / NXCD, r = nwg % NXCD, xcd = wgid % NXCD, off = wgid / NXCD; wgid = (xcd < r ? xcd * (q + 1) : r * (q + 1) + (xcd - r) * q) + off; }
        const int nig = WGM * nN, gid = wgid / nig, fm = gid * WGM, gsz = (nM - fm) < WGM ? (nM - fm) : WGM;
        u.pm = fm + ((wgid % nig) % gsz); u.pn = (wgid % nig) / gsz; u.kt0 = 0; u.nkt = nkt; return true;
    }
    __device__ __forceinline__ void a_ready(const Unit&) const {}
    __device__ __forceinline__ void done(const Unit&) const {}
};

__device__ __forceinline__ unsigned cvt_pk_bf16(float lo, float hi) { unsigned r; asm volatile("v_cvt_pk_bf16_f32 %0, %1, %2" : "=v"(r) : "v"(lo), "v"(hi)); return r; }
typedef float f32x2 __attribute__((ext_vector_type(2)));
__device__ __forceinline__ f32x2 gelu_pk(f32x2 v) {
    const f32x2 av = __builtin_elementwise_abs(v), d = av * 0.2316418882f + 1.0f;
    f32x2 t; t.x = __builtin_amdgcn_rcpf(d.x); t.y = __builtin_amdgcn_rcpf(d.y);
    f32x2 q = t * 0.5307027145f + (-0.7265760135f); q = q * t + 0.7107068705f; q = q * t + (-0.142248368f); q = q * t + 0.127414796f; q = q * t;
    const f32x2 s = (v * v) * (-0.72134752044f);
    f32x2 e; e.x = __builtin_amdgcn_exp2f(s.x); e.y = __builtin_amdgcn_exp2f(s.y);
    const f32x2 m = v * (q * e), r = v - m;
    f32x2 o; o.x = v.x < 0.f ? m.x : r.x; o.y = v.y < 0.f ? m.y : r.y; return o;
}
__device__ __forceinline__ float silu_f(float x) { return x * __builtin_amdgcn_rcpf(1.0f + __builtin_amdgcn_exp2f(-1.4426950408889634f * x)); }
__device__ __forceinline__ void st8(bf16_t* p, f32x4 v0, f32x4 v1) { u32x4 w; w.x = cvt_pk_bf16(v0[0], v0[1]); w.y = cvt_pk_bf16(v0[2], v0[3]); w.z = cvt_pk_bf16(v1[0], v1[1]); w.w = cvt_pk_bf16(v1[2], v1[3]); *(u32x4*)p = w; }
struct EpiStore {
    static constexpr bool PERM = true, AFTER_DRAIN = false;
    bf16_t* O; int ldc;
    __device__ __forceinline__ void operator()(const f32x4 (&acc)[2][2][4][2], const Unit& u, int wr, int wc, int fr, int fq) const {
        const int row0 = u.pm * BM + wr * 64 + fr, col0 = u.pn * BM + wc * 32 + 8 * fq;
#pragma unroll
        for (int ai = 0; ai < 2; ++ai)
#pragma unroll
            for (int m = 0; m < 4; ++m) { bf16_t* rowp = O + (size_t)(row0 + ai * HALF + m * 16) * ldc + col0;
#pragma unroll
                for (int bj = 0; bj < 2; ++bj) st8(rowp + bj * HALF, acc[ai][bj][m][0], acc[ai][bj][m][1]); }
    }
};
struct EpiSwiGLU {
    static constexpr bool PERM = true, AFTER_DRAIN = false;
    bf16_t* O; int ldc;
    __device__ __forceinline__ void operator()(const f32x4 (&acc)[2][2][4][2], const Unit& u, int wr, int wc, int fr, int fq) const {
        const int row0 = u.pm * BM + wr * 64 + fr, col0 = u.pn * HALF + wc * 32 + 8 * fq;
#pragma unroll
        for (int ai = 0; ai < 2; ++ai)
#pragma unroll
            for (int m = 0; m < 4; ++m) { bf16_t* rowp = O + (size_t)(row0 + ai * HALF + m * 16) * ldc + col0;
                f32x4 v0, v1;
#pragma unroll
                for (int j = 0; j < 4; ++j) { v0[j] = silu_f(acc[ai][0][m][0][j]) * acc[ai][1][m][0][j]; v1[j] = silu_f(acc[ai][0][m][1][j]) * acc[ai][1][m][1][j]; }
                st8(rowp, v0, v1); }
    }
};
struct EpiP {
    static constexpr bool PERM = true, AFTER_DRAIN = false;
    bf16_t* O; int ldc; float* G;
    __device__ __forceinline__ void operator()(const f32x4 (&acc)[2][2][4][2], const Unit& u, int wr, int wc, int fr, int fq) const {
        const int row0 = u.pm * BM + wr * 64 + fr, col0 = u.pn * BM + wc * 32 + 8 * fq;
        const bool gt = (u.pn == 9) && (wc == 2) && (fq < 2);
#pragma unroll
        for (int ai = 0; ai < 2; ++ai)
#pragma unroll
            for (int m = 0; m < 4; ++m) { const int row = row0 + ai * HALF + m * 16; bf16_t* rowp = O + (size_t)row * ldc + col0;
#pragma unroll
                for (int bj = 0; bj < 2; ++bj) st8(rowp + bj * HALF, acc[ai][bj][m][0], acc[ai][bj][m][1]);
                if (gt) { *(f32x4*)(G + (size_t)row * 16 + 8 * fq) = acc[ai][1][m][0]; *(f32x4*)(G + (size_t)row * 16 + 8 * fq + 4) = acc[ai][1][m][1]; } }
    }
};
struct EpiSlab {
    static constexpr bool PERM = false, AFTER_DRAIN = false;
    float* S;
    __device__ __forceinline__ void operator()(const f32x4 (&acc)[2][2][4][2], const Unit& u, int wr, int wc, int fr, int fq) const {
        const int row0 = (u.pm / 17) * BM + wr * 64 + fr, col0 = u.pn * BM + wc * 32 + 4 * fq; const int slice = u.kt0 / u.nkt;
        float* base = S + (size_t)slice * 1024 * 1024;
#pragma unroll
        for (int ai = 0; ai < 2; ++ai)
#pragma unroll
            for (int m = 0; m < 4; ++m) { float* rowp = base + (size_t)(row0 + ai * HALF + m * 16) * 1024 + col0;
#pragma unroll
                for (int bj = 0; bj < 2; ++bj)
#pragma unroll
                    for (int n = 0; n < 2; ++n) *(f32x4*)(rowp + bj * HALF + n * 16) = acc[ai][bj][m][n]; }
    }
};
struct TileOrder {
    int mode, nM, nN, nwg, G, c, nkt, nsl;
    __device__ void init(int mode_, int N, int K, int G_, int c_, int nsl_) { mode = mode_; nN = N / BM; G = G_; c = c_; nsl = nsl_;
        if (mode == 2) { nM = 4; nwg = 4 * nN * nsl; nkt = (K / BK) / nsl; } else { nM = mode == 1 ? 64 : 68; nwg = nM * nN; nkt = K / BK; } }
    __device__ bool next(int i, Unit& u) const {
        const long L = (long)i * G + c; if (L >= nwg) return false;
        if (mode == 2) { const int sl = (int)L % nsl, t = (int)L / nsl; u.pn = t % nN; u.pm = 17 * (t / nN); u.kt0 = sl * nkt; u.nkt = nkt; return true; }
        int wgid = (int)L; { const int q = nwg / NXCD, r = nwg % NXCD, xcd = wgid % NXCD, off = wgid / NXCD; wgid = (xcd < r ? xcd * (q + 1) : r * (q + 1) + (xcd - r) * q) + off; }
        const int nig = WGM * nN, gid = wgid / nig, fm = gid * WGM, gsz = (nM - fm) < WGM ? (nM - fm) : WGM;
        int pm = fm + ((wgid % nig) % gsz); u.pn = (wgid % nig) / gsz; if (mode == 1) pm += (pm >> 4) + 1;
        u.pm = pm; u.kt0 = 0; u.nkt = nkt;
        if (mode == 3) { if (u.pn < 3) { u.kt0 = 0; u.nkt = 4; } else { u.kt0 = 4; u.nkt = 2; } }
        return true;
    }
    __device__ __forceinline__ void a_ready(const Unit&) const {}
    __device__ __forceinline__ void done(const Unit&) const {}
};

struct PanelSS {
    unsigned* xbuf;
    unsigned* cnt;
    __device__ __forceinline__ void run(const f32x4 (&v)[2][2][4][2], const Unit& u, int wr, int wc, int fr, int fq, PG8_LAS unsigned char* lds, int wid, int lane) const {
        PG8_LAS float* P = (PG8_LAS float*)lds;
        PG8_LAS float* S = (PG8_LAS float*)(lds + 8192);
#pragma unroll
        for (int ai = 0; ai < 2; ++ai)
#pragma unroll
            for (int m = 0; m < 4; ++m) { float s = 0.f;
#pragma unroll
                for (int bj = 0; bj < 2; ++bj)
#pragma unroll
                    for (int n = 0; n < 2; ++n) { const f32x4 x = v[ai][bj][m][n]; s += (x[0] * x[0] + x[1] * x[1]) + (x[2] * x[2] + x[3] * x[3]); }
                s += __shfl_xor(s, 16); s += __shfl_xor(s, 32);
                if (fq == 0) P[(ai * HALF + wr * 64 + m * 16 + fr) * 4 + wc] = s; }
        asm volatile("s_waitcnt lgkmcnt(0)" ::: "memory"); __builtin_amdgcn_s_barrier(); asm volatile("" ::: "memory");
        const int row = wid * 32 + (lane & 31);
        if (lane < 32) { const float t = (P[row * 4 + 0] + P[row * 4 + 1]) + (P[row * 4 + 2] + P[row * 4 + 3]);
            __hip_atomic_store(xbuf + (size_t)(u.pm * BM + row) * 4 + u.pn, __float_as_uint(t), __ATOMIC_RELAXED, __HIP_MEMORY_SCOPE_AGENT); }
        asm volatile("s_waitcnt vmcnt(0)" ::: "memory");
        if (lane == 0) __hip_atomic_fetch_add(cnt + 64 * u.pm, 1u, __ATOMIC_RELAXED, __HIP_MEMORY_SCOPE_AGENT);
        if (wid == 0) { unsigned sp = 0;
            while ((unsigned)__builtin_amdgcn_readfirstlane(__hip_atomic_load(cnt + 64 * u.pm, __ATOMIC_RELAXED, __HIP_MEMORY_SCOPE_AGENT)) < 32u) { __builtin_amdgcn_s_sleep(2); if (++sp > (1u << 22)) break; }
            __builtin_amdgcn_fence(__ATOMIC_ACQUIRE, "agent"); }
        asm volatile("s_waitcnt vmcnt(0) lgkmcnt(0)" ::: "memory"); __builtin_amdgcn_s_barrier(); asm volatile("" ::: "memory");
        if (lane < 32) { const unsigned* slot = xbuf + (size_t)(u.pm * BM + row) * 4; float t = 0.f;
#pragma unroll
            for (int q = 0; q < 4; ++q) t += __uint_as_float(__hip_atomic_load(slot + q, __ATOMIC_RELAXED, __HIP_MEMORY_SCOPE_AGENT));
            S[row] = t; }
        asm volatile("s_waitcnt lgkmcnt(0)" ::: "memory"); __builtin_amdgcn_s_barrier(); asm volatile("" ::: "memory");
    }
};
struct EpiNormRes {
    static constexpr bool PERM = false, AFTER_DRAIN = true;
    bf16_t* xb; float* xout;
    bf16_t* H;
    const float* gate; const float* gpost;
    const float* gpre; const float* sc; const float* sh;
    float wgt; PanelSS st1, st2;
    __device__ __forceinline__ void fused(f32x4 (&acc)[2][2][4][2], const Unit& u, int wr, int wc, int fr, int fq, PG8_LAS unsigned char* lds, int wid, int lane) const {
        const PG8_LAS float* S = (const PG8_LAS float*)(lds + 8192);
        const int b = u.pm / 17, tp = (u.pm - 17 * b - 1) * BM;
        const int col0 = u.pn * BM + wc * 32 + 4 * fq; const size_t mo = (size_t)b * 9 * 1024;
        st1.run(acc, u, wr, wc, fr, fq, lds, wid, lane);
        {   f32x4 cg[2][2];
#pragma unroll
            for (int bj = 0; bj < 2; ++bj)
#pragma unroll
                for (int n = 0; n < 2; ++n) cg[bj][n] = *(const f32x4*)(gate + mo + col0 + bj * HALF + n * 16) * *(const f32x4*)(gpost + col0 + bj * HALF + n * 16) * wgt;
            typedef unsigned u32x2r __attribute__((ext_vector_type(2)));
            if (H == nullptr) {
#pragma unroll
            for (int ai = 0; ai < 2; ++ai)
#pragma unroll
                for (int m = 0; m < 4; ++m) { const int r = ai * HALF + wr * 64 + m * 16 + fr; const float rs = 1.0f / sqrtf(S[r] * (1.0f / 1024.0f) + 1e-6f);
                    const size_t off = ((size_t)b * 4096 + tp + r) * 1024 + col0;
#pragma unroll
                    for (int bj = 0; bj < 2; ++bj)
#pragma unroll
                        for (int n = 0; n < 2; ++n) { const u32x2r w = *(const u32x2r*)(xb + off + bj * HALF + n * 16); f32x4 xo; xo[0] = __uint_as_float(w.x << 16); xo[1] = __uint_as_float(w.x & 0xffff0000u); xo[2] = __uint_as_float(w.y << 16); xo[3] = __uint_as_float(w.y & 0xffff0000u);
                            *(f32x4*)(xout + off + bj * HALF + n * 16) = xo + cg[bj][n] * (acc[ai][bj][m][n] * rs); }
                    if (m & 1) asm volatile("" ::: "memory"); }
                return; }
#pragma unroll
            for (int ai = 0; ai < 2; ++ai)
#pragma unroll
                for (int m = 0; m < 4; ++m) { const int r = ai * HALF + wr * 64 + m * 16 + fr; const float rs = 1.0f / sqrtf(S[r] * (1.0f / 1024.0f) + 1e-6f);
                    const size_t off = ((size_t)b * 4096 + tp + r) * 1024 + col0;
#pragma unroll
                    for (int bj = 0; bj < 2; ++bj)
#pragma unroll
                        for (int n = 0; n < 2; ++n) { const u32x2r w = *(const u32x2r*)(xb + off + bj * HALF + n * 16); f32x4 xo; xo[0] = __uint_as_float(w.x << 16); xo[1] = __uint_as_float(w.x & 0xffff0000u); xo[2] = __uint_as_float(w.y << 16); xo[3] = __uint_as_float(w.y & 0xffff0000u);
                            const f32x4 xn = xo + cg[bj][n] * (acc[ai][bj][m][n] * rs);
                            acc[ai][bj][m][n] = xn; u32x2r o; o.x = cvt_pk_bf16(xn[0], xn[1]); o.y = cvt_pk_bf16(xn[2], xn[3]); *(u32x2r*)(xb + off + bj * HALF + n * 16) = o; }
                    asm volatile("" : "+v"(acc[ai][0][m][0]), "+v"(acc[ai][0][m][1]), "+v"(acc[ai][1][m][0]), "+v"(acc[ai][1][m][1]));
                    if (m & 1) asm volatile("" ::: "memory"); } }
        asm volatile("s_waitcnt lgkmcnt(0)" ::: "memory"); __builtin_amdgcn_s_barrier(); asm volatile("" ::: "memory");
        st2.run(acc, u, wr, wc, fr, fq, lds, wid, lane);
        {   typedef unsigned u32x2v __attribute__((ext_vector_type(2)));
            f32x4 ca[2][2], cs[2][2];
#pragma unroll
            for (int bj = 0; bj < 2; ++bj)
#pragma unroll
                for (int n = 0; n < 2; ++n) { const int c = col0 + bj * HALF + n * 16; ca[bj][n] = *(const f32x4*)(gpre + c) * (*(const f32x4*)(sc + mo + c) + 1.0f); cs[bj][n] = *(const f32x4*)(sh + mo + c); }
#pragma unroll
            for (int ai = 0; ai < 2; ++ai)
#pragma unroll
                for (int m = 0; m < 4; ++m) { const int r = ai * HALF + wr * 64 + m * 16 + fr; const float rs = 1.0f / sqrtf(S[r] * (1.0f / 1024.0f) + 1e-6f);
                    bf16_t* hp = H + (size_t)(u.pm * BM + r) * 1024 + col0;
#pragma unroll
                    for (int bj = 0; bj < 2; ++bj)
#pragma unroll
                        for (int n = 0; n < 2; ++n) { const f32x4 o = acc[ai][bj][m][n] * rs * ca[bj][n] + cs[bj][n]; u32x2v w; w.x = cvt_pk_bf16(o[0], o[1]); w.y = cvt_pk_bf16(o[2], o[3]);
                            *(u32x2v*)(hp + bj * HALF + n * 16) = w; } } }
    }
};

template <class Epi, class Sched, bool ALIGN_EPI = false, bool SP2 = false>
__device__ __forceinline__ void gemm_phase(PG8_LAS unsigned char* lds, const Gemm g, const Sched& S, const Epi& E) {
    int tid_ = threadIdx.x; asm volatile("" : "+v"(tid_));
    const int tid = tid_, wid = __builtin_amdgcn_readfirstlane(tid >> 6), lane = tid & 63, wr = wid >> 2, wc = wid & 3, fr = lane & 15, fq = lane >> 4;
    const int K = g.K;
    unsigned voffA[2], voffB[2];
#pragma unroll
    for (int i = 0; i < 2; ++i) { int R, C; stage_rc(tid * 16 + i * 8192, R, C); const int Rb = Epi::PERM ? ((R & ~31) + perm32(R & 31)) : R;
        voffA[i] = (unsigned)(R * K + C) * 2u; voffB[i] = (unsigned)(Rb * K + C) * 2u; }
    const size_t kstep = (size_t)(BK * 2);
    const size_t hstep = (size_t)HALF * K * 2;
    const size_t tstep = 2 * hstep;
    const unsigned ldsw = (unsigned)wid * 1024u;
    const int aoff = lds_byte(wr * 64 + fr, fq * 8), boff = lds_byte(wc * 32 + fr, fq * 8);
#define PG8_SA(b, h) (((b) * 2 + (h)) * HTB)
#define PG8_SB(b, h) ((4 + (b) * 2 + (h)) * HTB)
#define PG8_STAGE(bufoff, gbase, voff) do { _Pragma("unroll") for (int _i = 0; _i < 2; ++_i) \
        __builtin_amdgcn_global_load_lds((const unsigned*)((const char*)(gbase) + (voff)[_i]), (PG8_LAS unsigned*)(lds + (bufoff) + ldsw + _i * 8192), 16, 0, 0); } while (0)
#define PG8_LDA(dst, b, h) do { _Pragma("unroll") for (int m = 0; m < 4; ++m) _Pragma("unroll") for (int k = 0; k < 2; ++k) dst[m][k] = *(const PG8_LAS bf16x8*)(lds + PG8_SA(b, h) + aoff + m * 2048 + k * 1024); } while (0)
#define PG8_LDB(dst, b, h) do { _Pragma("unroll") for (int n = 0; n < 2; ++n) _Pragma("unroll") for (int k = 0; k < 2; ++k) dst[n][k] = *(const PG8_LAS bf16x8*)(lds + PG8_SB(b, h) + boff + n * 2048 + k * 1024); } while (0)
#define PG8_MMA(ai, bj, At, Bt) do { __builtin_amdgcn_s_setprio(1); _Pragma("unroll") for (int m = 0; m < 4; ++m) _Pragma("unroll") for (int n = 0; n < 2; ++n) _Pragma("unroll") for (int k = 0; k < 2; ++k) \
        acc[ai][bj][m][n] = __builtin_amdgcn_mfma_f32_16x16x32_bf16(Bt[n][k], At[m][k], acc[ai][bj][m][n], 0, 0, 0); __builtin_amdgcn_s_setprio(0); } while (0)
#define PG8_WAIT_V(n) asm volatile("s_waitcnt vmcnt(" #n ")" ::: "memory")
#define PG8_WAIT_L(n) asm volatile("s_waitcnt lgkmcnt(" #n ")" ::: "memory")
#define PG8_BAR __builtin_amdgcn_s_barrier()
#define PG8_SCHED __builtin_amdgcn_sched_barrier(0)
    Unit cur, nxt; int ui = 0;
    if (!S.next(0, cur)) return;
    f32x4 acc[2][2][4][2];
#pragma unroll
    for (int a = 0; a < 2; ++a)
#pragma unroll
        for (int b = 0; b < 2; ++b)
#pragma unroll
            for (int m = 0; m < 4; ++m)
#pragma unroll
                for (int n = 0; n < 2; ++n) acc[a][b][m][n] = (f32x4){0.f, 0.f, 0.f, 0.f};
    bf16x8 At[4][2], B0[2][2], B1[2][2];
    const char* cA = (const char*)g.A + (size_t)cur.pm * tstep + (size_t)cur.kt0 * kstep; const char* cB = (const char*)g.Bt + (size_t)cur.pn * tstep + (size_t)cur.kt0 * kstep;
    S.a_ready(cur);
    if constexpr (SP2) {
        PG8_STAGE(PG8_SB(0, 0), cB, voffB); PG8_STAGE(PG8_SB(0, 1), cB + hstep, voffB); PG8_STAGE(PG8_SA(0, 0), cA, voffA); PG8_STAGE(PG8_SA(0, 1), cA + hstep, voffA);
        if (wr == 1) PG8_BAR;
        PG8_WAIT_V(2); PG8_BAR;
        PG8_STAGE(PG8_SB(1, 0), cB + kstep, voffB); PG8_STAGE(PG8_SA(1, 0), cA + kstep, voffA); PG8_STAGE(PG8_SB(1, 1), cB + hstep + kstep, voffB);
        PG8_WAIT_V(6); PG8_BAR;
    } else {
        PG8_STAGE(PG8_SB(0, 0), cB, voffB); PG8_STAGE(PG8_SA(0, 0), cA, voffA); PG8_STAGE(PG8_SB(0, 1), cB + hstep, voffB); PG8_STAGE(PG8_SA(0, 1), cA + hstep, voffA);
        if (wr == 1) PG8_BAR;
        PG8_WAIT_V(4); PG8_BAR;
        PG8_STAGE(PG8_SB(1, 0), cB + kstep, voffB); PG8_STAGE(PG8_SA(1, 0), cA + kstep, voffA); PG8_STAGE(PG8_SB(1, 1), cB + hstep + kstep, voffB);
        PG8_WAIT_V(6); PG8_BAR;
    }
    for (;;) {
        const bool has_next = S.next(ui + 1, nxt);
        const char* nA = has_next ? (const char*)g.A + (size_t)nxt.pm * tstep + (size_t)nxt.kt0 * kstep : cA; const char* nB = has_next ? (const char*)g.Bt + (size_t)nxt.pn * tstep + (size_t)nxt.kt0 * kstep : cB;
        const int nt = cur.nkt;
        for (int t = 0; t < nt; t += 2) {
            const bool last = (t == nt - 2);
            const char* a1 = cA + (size_t)(t + 1) * kstep;
            const char* a2 = last ? nA : cA + (size_t)(t + 2) * kstep; const char* b2 = last ? nB : cB + (size_t)(t + 2) * kstep;
            const char* a3 = a2 + kstep; const char* b3 = b2 + kstep;
            if (last && has_next) S.a_ready(nxt);
            if constexpr (SP2) {
            PG8_LDB(B0, 0, 0); PG8_LDB(B1, 0, 1); PG8_SCHED; PG8_LDA(At, 0, 0); PG8_STAGE(PG8_SA(1, 1), a1 + hstep, voffA);
            PG8_WAIT_V(8); PG8_WAIT_L(0); PG8_BAR; PG8_MMA(0, 0, At, B0); PG8_MMA(0, 1, At, B1); PG8_BAR; PG8_SCHED;
            PG8_LDA(At, 0, 1); PG8_STAGE(PG8_SB(0, 0), b2, voffB); PG8_STAGE(PG8_SB(0, 1), b2 + hstep, voffB); PG8_STAGE(PG8_SA(0, 0), a2, voffA);
            PG8_WAIT_V(8); PG8_WAIT_L(0); PG8_BAR; PG8_MMA(1, 0, At, B0); PG8_MMA(1, 1, At, B1); PG8_BAR; PG8_SCHED;
            PG8_LDB(B0, 1, 0); PG8_LDB(B1, 1, 1); PG8_SCHED; PG8_LDA(At, 1, 0); PG8_STAGE(PG8_SA(0, 1), a2 + hstep, voffA);
            PG8_WAIT_V(8); PG8_WAIT_L(0); PG8_BAR; PG8_MMA(0, 0, At, B0); PG8_MMA(0, 1, At, B1); PG8_BAR; PG8_SCHED;
            PG8_LDA(At, 1, 1); PG8_STAGE(PG8_SB(1, 0), b3, voffB); PG8_STAGE(PG8_SB(1, 1), b3 + hstep, voffB); PG8_STAGE(PG8_SA(1, 0), a3, voffA);
            PG8_WAIT_V(8); PG8_WAIT_L(0); PG8_BAR; PG8_MMA(1, 0, At, B0); PG8_MMA(1, 1, At, B1); PG8_BAR; PG8_SCHED;
            } else {
            PG8_LDB(B0, 0, 0); PG8_SCHED; PG8_LDA(At, 0, 0); PG8_STAGE(PG8_SA(1, 1), a1 + hstep, voffA);
            PG8_WAIT_L(8); PG8_BAR; PG8_WAIT_L(0); PG8_MMA(0, 0, At, B0); PG8_BAR; PG8_SCHED;
            PG8_LDB(B1, 0, 1); PG8_STAGE(PG8_SB(0, 0), b2, voffB);
            PG8_BAR; PG8_WAIT_L(0); PG8_MMA(0, 1, At, B1); PG8_BAR;
            PG8_LDA(At, 0, 1); PG8_STAGE(PG8_SA(0, 0), a2, voffA);
            PG8_BAR; PG8_WAIT_L(0); PG8_MMA(1, 0, At, B0); PG8_BAR; PG8_SCHED;
            PG8_STAGE(PG8_SB(0, 1), b2 + hstep, voffB);
            PG8_WAIT_V(6); PG8_BAR; PG8_MMA(1, 1, At, B1); PG8_BAR;
            PG8_LDB(B0, 1, 0); PG8_SCHED; PG8_LDA(At, 1, 0); PG8_STAGE(PG8_SA(0, 1), a2 + hstep, voffA);
            PG8_WAIT_L(8); PG8_BAR; PG8_WAIT_L(0); PG8_MMA(0, 0, At, B0); PG8_BAR; PG8_SCHED;
            PG8_LDB(B1, 1, 1); PG8_STAGE(PG8_SB(1, 0), b3, voffB);
            PG8_BAR; PG8_WAIT_L(0); PG8_MMA(0, 1, At, B1); PG8_BAR;
            PG8_LDA(At, 1, 1); PG8_STAGE(PG8_SA(1, 0), a3, voffA);
            PG8_BAR; PG8_WAIT_L(0); PG8_MMA(1, 0, At, B0); PG8_BAR; PG8_SCHED;
            PG8_STAGE(PG8_SB(1, 1), b3 + hstep, voffB);
            PG8_WAIT_V(6); PG8_BAR; PG8_MMA(1, 1, At, B1); PG8_BAR;
            }
        }
        if constexpr (ALIGN_EPI) { if (wr == 0) PG8_BAR; }
        if constexpr (!Epi::AFTER_DRAIN) { E(acc, cur, wr, wc, fr, fq); S.done(cur); }
        if (!has_next) break;
#pragma unroll
        for (int a = 0; a < 2; ++a)
#pragma unroll
            for (int b = 0; b < 2; ++b)
#pragma unroll
                for (int m = 0; m < 4; ++m)
#pragma unroll
                    for (int n = 0; n < 2; ++n) acc[a][b][m][n] = (f32x4){0.f, 0.f, 0.f, 0.f};
        cur = nxt; cA = nA; cB = nB; ++ui;
        if constexpr (ALIGN_EPI) { if (wr == 1) PG8_BAR; }
    }
    PG8_WAIT_V(0);
    if constexpr (!ALIGN_EPI) { if (wr == 0) PG8_BAR; }
    PG8_BAR;
    if constexpr (Epi::AFTER_DRAIN) { E.fused(acc, cur, wr, wc, fr, fq, lds, wid, lane); S.done(cur); }
#undef PG8_SA
#undef PG8_SB
#undef PG8_STAGE
#undef PG8_LDA
#undef PG8_LDB
#undef PG8_MMA
#undef PG8_WAIT_V
#undef PG8_WAIT_L
#undef PG8_BAR
#undef PG8_SCHED
}
}
namespace att {
typedef unsigned short bf16;
constexpr int NW = 8, QBLK = 32, KVBLK = 64;
constexpr float SCALE = 0.07216878364870322f;
constexpr float THR = 8.f;
constexpr int SDEPTH = 1;
constexpr int LDQ = 1792, LDK = 1792, LDR = 64, LDO = 1024;
constexpr int SHM_V = KVBLK * 128 * 2, SHM_K = KVBLK * 192 * 2, SHM_QR = NW * 4 * 64 * 16, SHM_ATTN = 2 * SHM_V + 2 * SHM_K + NW * 64 * 4 + SHM_QR;
using bf16x8 = __attribute__((ext_vector_type(8))) short;
using s16x4  = __attribute__((ext_vector_type(4))) short;
using f32x16 = __attribute__((ext_vector_type(16))) float;
using u32x4  = __attribute__((ext_vector_type(4))) unsigned;
#define KSWZ(row, colB) ((row) * 384 + ((colB) ^ ((((row) >> 1) & 7) << 4)))
#define SBAR() __builtin_amdgcn_sched_barrier(0)
__device__ __forceinline__ int crow(int r, int hi) { return (r & 3) + 8 * (r >> 2) + 4 * hi; }
__device__ __forceinline__ unsigned cvtpk(float lo, float hi) { unsigned r; asm volatile("v_cvt_pk_bf16_f32 %0, %1, %2" : "=v"(r) : "v"(lo), "v"(hi)); return r; }
__device__ __forceinline__ bf16x8 ld8(const bf16* p) { return *reinterpret_cast<const bf16x8*>(p); }
__device__ __forceinline__ float bf2f(short b) { return __uint_as_float(((unsigned)(unsigned short)b) << 16); }

__device__ __forceinline__ void partialSM(f32x16& p0, f32x16& p1, float& m_reg, float& mn, float& alpha) {
  constexpr float C = SCALE * 1.4426950408889634f;
  float pmax = p0[0];
#pragma unroll
  for (int r = 1; r < 16; ++r) pmax = fmaxf(pmax, p0[r]);
#pragma unroll
  for (int r = 0; r < 16; ++r) pmax = fmaxf(pmax, p1[r]);
  { auto rr = __builtin_amdgcn_permlane32_swap(__float_as_uint(pmax), __float_as_uint(pmax), false, false);
    pmax = fmaxf(__uint_as_float(rr[0]), __uint_as_float(rr[1])); }
  if (__builtin_expect(__all(pmax - m_reg <= THR / SCALE), 1)) { mn = m_reg; alpha = 1.f; }
  else { mn = fmaxf(m_reg, pmax); alpha = __builtin_amdgcn_exp2f((m_reg - mn) * C); m_reg = mn; }
  float mnC = -mn * C;
#pragma unroll
  for (int r = 0; r < 16; ++r) p0[r] = fmaf(p0[r], C, mnC);
#pragma unroll
  for (int r = 0; r < 16; ++r) p1[r] = fmaf(p1[r], C, mnC);
#pragma unroll
  for (int r = 0; r < 16; ++r) p0[r] = __builtin_amdgcn_exp2f(p0[r]);
}
__device__ __forceinline__ void finishSM(f32x16& p0, f32x16& p1, float alpha, float& l_reg, bf16x8& pa0, bf16x8& pa1, bf16x8& pa2, bf16x8& pa3) {
#pragma unroll
  for (int r = 0; r < 16; ++r) p1[r] = __builtin_amdgcn_exp2f(p1[r]);
  float ps = 0;
#pragma unroll
  for (int r = 0; r < 16; ++r) ps += p0[r];
#pragma unroll
  for (int r = 0; r < 16; ++r) ps += p1[r];
  { auto rr = __builtin_amdgcn_permlane32_swap(__float_as_uint(ps), __float_as_uint(ps), false, false);
    ps = __uint_as_float(rr[0]) + __uint_as_float(rr[1]); }
  l_reg = l_reg * alpha + ps;
#define PK4(P, BASE, OUT) do { unsigned a0 = cvtpk(P[BASE + 0], P[BASE + 1]), a1 = cvtpk(P[BASE + 2], P[BASE + 3]);   \
    unsigned b0 = cvtpk(P[BASE + 4], P[BASE + 5]), b1 = cvtpk(P[BASE + 6], P[BASE + 7]);                              \
    auto r0 = __builtin_amdgcn_permlane32_swap(a0, b0, false, false); auto r1 = __builtin_amdgcn_permlane32_swap(a1, b1, false, false); \
    u32x4 w = {r0[0], r1[0], r0[1], r1[1]}; OUT = *reinterpret_cast<bf16x8*>(&w); } while (0)
  PK4(p0, 0, pa0); PK4(p0, 8, pa1); PK4(p1, 0, pa2); PK4(p1, 8, pa3);
#undef PK4
}
__device__ __forceinline__ void qkt(f32x16& p0, f32x16& p1, const bf16* Ks, const bf16x8 (&qr)[8], const bf16x8* qrl, int r32, int hi) {
  p0 = f32x16{}; p1 = f32x16{};
#pragma unroll
  for (int d0 = 0; d0 < 12; ++d0) { int cb = (d0 * 16 + hi * 8) * 2;
    bf16x8 b0 = *reinterpret_cast<const bf16x8*>((const char*)Ks + KSWZ(r32, cb));
    bf16x8 b1 = *reinterpret_cast<const bf16x8*>((const char*)Ks + KSWZ(32 + r32, cb));
    const bf16x8 qf = d0 < 8 ? qr[d0 < 8 ? d0 : 0] : qrl[(d0 - 8) * 64];
    p0 = __builtin_amdgcn_mfma_f32_32x32x16_bf16(b0, qf, p0, 0, 0, 0);
    p1 = __builtin_amdgcn_mfma_f32_32x32x16_bf16(b1, qf, p1, 0, 0, 0); }
}
__device__ __forceinline__ int v_st(int k, int c) { const int kk = (k & ~0xC) | ((k & 4) << 1) | ((k & 8) >> 1); return ((kk >> 3) * 4 + (c >> 5)) * 512 + ((kk & 7) * 32 + (c & 31)) * 2; }
__device__ __forceinline__ int v_rd_base(int lane) { return ((lane & 3) << 3) | (((lane >> 2) & 3) << 6) | (((lane >> 4) & 1) << 5) | (((lane >> 5) & 1) << 8); }
constexpr int v_rd_off(int d0, int ks, int half) { return d0 * 512 + ks * 4096 + half * 2048; }
template <int OFF> __device__ __forceinline__ s16x4 tr_read(int vb) {
  s16x4 r; asm volatile("ds_read_b64_tr_b16 %0, %1 offset:%2" : "=&v"(r) : "v"(vb), "i"(OFF) : "memory"); return r;
}
template <int D0> __device__ __forceinline__ void pv_one(f32x16& od, int vb, bf16x8 pa0, bf16x8 pa1, bf16x8 pa2, bf16x8 pa3) {
  const s16x4 l0 = tr_read<v_rd_off(D0, 0, 0)>(vb), h0 = tr_read<v_rd_off(D0, 0, 1)>(vb), l1 = tr_read<v_rd_off(D0, 1, 0)>(vb), h1 = tr_read<v_rd_off(D0, 1, 1)>(vb);
  const s16x4 l2 = tr_read<v_rd_off(D0, 2, 0)>(vb), h2 = tr_read<v_rd_off(D0, 2, 1)>(vb), l3 = tr_read<v_rd_off(D0, 3, 0)>(vb), h3 = tr_read<v_rd_off(D0, 3, 1)>(vb);
  asm volatile("s_waitcnt lgkmcnt(0)" ::: "memory"); SBAR();
#define PK(L, H) (bf16x8){L[0], L[1], L[2], L[3], H[0], H[1], H[2], H[3]}
  od = __builtin_amdgcn_mfma_f32_32x32x16_bf16(pa0, PK(l0, h0), od, 0, 0, 0);
  od = __builtin_amdgcn_mfma_f32_32x32x16_bf16(pa1, PK(l1, h1), od, 0, 0, 0);
  od = __builtin_amdgcn_mfma_f32_32x32x16_bf16(pa2, PK(l2, h2), od, 0, 0, 0);
  od = __builtin_amdgcn_mfma_f32_32x32x16_bf16(pa3, PK(l3, h3), od, 0, 0, 0);
#undef PK
}
__device__ __forceinline__ void pv_d0(f32x16 (&o)[4], int vb, bf16x8 pa0, bf16x8 pa1, bf16x8 pa2, bf16x8 pa3) {
  pv_one<0>(o[0], vb, pa0, pa1, pa2, pa3); pv_one<1>(o[1], vb, pa0, pa1, pa2, pa3); pv_one<2>(o[2], vb, pa0, pa1, pa2, pa3); pv_one<3>(o[3], vb, pa0, pa1, pa2, pa3);
}
__device__ __forceinline__ void attn_body(const bf16* __restrict__ Qb, const bf16* __restrict__ Kn, const bf16* __restrict__ Vh, const bf16* __restrict__ Kr,
                                          bf16* __restrict__ Ob, int seq, int rope, int qtok0, const float* __restrict__ tab, char* lds,
                                          unsigned* __restrict__ xs, unsigned* __restrict__ cnt, const float* __restrict__ gain, int head) {
  int tid_ = threadIdx.x; asm volatile("" : "+v"(tid_));
  const int tid = tid_, wid = tid >> 6, lane = tid & 63, r32 = lane & 31, hi = lane >> 5;
  bf16* V_lds = (bf16*)lds; bf16* K_lds = (bf16*)(lds + 2 * SHM_V);
  float* ws = (float*)(lds + 2 * SHM_V + 2 * SHM_K) + wid * 64; float* li_l = ws; float* al_l = ws + 32;
  float m_reg = -1e30f, l_reg = 0; f32x16 o[4] = {}; bf16x8 qr[8]; bf16x8 qx[4];
  bf16x8* qrl = (bf16x8*)(lds + 2 * SHM_V + 2 * SHM_K + NW * 64 * 4) + wid * 256 + lane;
  const bf16* Qw = Qb + (long)(wid * QBLK + r32) * LDQ + hi * 8;
#pragma unroll
  for (int d0 = 0; d0 < 8; ++d0) qr[d0] = ld8(Qw + d0 * 16);
#pragma unroll
  for (int d0 = 0; d0 < 4; ++d0) qx[d0] = ld8(Qw + 128 + d0 * 16);
  if (rope) {
    const int tt = qtok0 + wid * QBLK + r32; const int prow = tt >> 6, pcol = tt & 63;
    const float* tr = tab + (prow * 16 + hi * 8) * 2; const float* tc = tab + (pcol * 16 + hi * 8) * 2;
    unsigned a1[4], a2[4], c1[4], c2[4];
#pragma unroll
    for (int j = 0; j < 8; j += 2) {
      float o1[2], o2[2], p1[2], p2[2];
#pragma unroll
      for (int e = 0; e < 2; ++e) {
        const float cr = tr[(j + e) * 2], sr_ = tr[(j + e) * 2 + 1], cc = tc[(j + e) * 2], sc_ = tc[(j + e) * 2 + 1];
        const float x1 = bf2f(qx[0][j + e]), x2 = bf2f(qx[1][j + e]), y1 = bf2f(qx[2][j + e]), y2 = bf2f(qx[3][j + e]);
        o1[e] = x1 * cr - x2 * sr_; o2[e] = x2 * cr + x1 * sr_; p1[e] = y1 * cc - y2 * sc_; p2[e] = y2 * cc + y1 * sc_; }
      a1[j >> 1] = cvtpk(o1[0], o1[1]); a2[j >> 1] = cvtpk(o2[0], o2[1]); c1[j >> 1] = cvtpk(p1[0], p1[1]); c2[j >> 1] = cvtpk(p2[0], p2[1]); }
    { u32x4 w = {a1[0], a1[1], a1[2], a1[3]}; qx[0] = *reinterpret_cast<bf16x8*>(&w); }
    { u32x4 w = {a2[0], a2[1], a2[2], a2[3]}; qx[1] = *reinterpret_cast<bf16x8*>(&w); }
    { u32x4 w = {c1[0], c1[1], c1[2], c1[3]}; qx[2] = *reinterpret_cast<bf16x8*>(&w); }
    { u32x4 w = {c2[0], c2[1], c2[2], c2[3]}; qx[3] = *reinterpret_cast<bf16x8*>(&w); }
  }
#pragma unroll
  for (int d0 = 0; d0 < 4; ++d0) qrl[d0 * 64] = qx[d0];
  const int sr = tid >> 4, sc = (tid & 15) * 8, vst0 = v_st(sr, sc), vst1 = v_st(32 + sr, sc);
  const int rr = tid >> 3, rc = (tid & 7) * 8;
  const int vb0 = (int)(uintptr_t)V_lds + v_rd_base(lane);
  struct { bf16x8 vs0, vs1, ks0, ks1, kr0; } sr_[SDEPTH];
#define SLOAD(i, k0) do { sr_[i].vs0 = ld8(&Vh[(long)((k0) + sr) * LDK + sc]); sr_[i].vs1 = ld8(&Vh[(long)((k0) + 32 + sr) * LDK + sc]); \
    sr_[i].ks0 = ld8(&Kn[(long)((k0) + sr) * LDK + sc]); sr_[i].ks1 = ld8(&Kn[(long)((k0) + 32 + sr) * LDK + sc]); sr_[i].kr0 = ld8(&Kr[(long)((k0) + rr) * LDR + rc]); } while (0)
#define SWRITE(b, i) do { *(bf16x8*)((char*)V_lds + (b) * SHM_V + vst0) = sr_[i].vs0;          \
    *(bf16x8*)((char*)V_lds + (b) * SHM_V + vst1) = sr_[i].vs1; int kc = sc * 2;               \
    *(bf16x8*)((char*)K_lds + (b) * SHM_K + KSWZ(sr, kc)) = sr_[i].ks0;                       \
    *(bf16x8*)((char*)K_lds + (b) * SHM_K + KSWZ(32 + sr, kc)) = sr_[i].ks1;                  \
    *(bf16x8*)((char*)K_lds + (b) * SHM_K + KSWZ(rr, 256 + rc * 2)) = sr_[i].kr0; } while (0)
#define SWAIT() do { if constexpr (SDEPTH == 2) asm volatile("s_waitcnt vmcnt(5)" ::: "memory"); else asm volatile("s_waitcnt vmcnt(0)" ::: "memory"); } while (0)
#define RESC(a) do { if (__any((a) < 1.f)) { if (hi == 0) al_l[r32] = (a); asm volatile("s_waitcnt lgkmcnt(0)" ::: "memory"); \
    _Pragma("unroll") for (int d = 0; d < 4; ++d) _Pragma("unroll") for (int r = 0; r < 16; ++r) o[d][r] *= al_l[crow(r, hi)]; } } while (0)
  f32x16 pA0, pA1, pB0, pB1; float mnA, mnB, alA, alB; bf16x8 pa0, pa1, pa2, pa3; const int NT = seq / KVBLK;
  constexpr int SE = 0, SO = SDEPTH - 1;
  SLOAD(SE, 0); asm volatile("s_waitcnt vmcnt(0)" ::: "memory"); SWRITE(0, SE); __syncthreads();
  qkt(pA0, pA1, K_lds, qr, qrl, r32, hi); partialSM(pA0, pA1, m_reg, mnA, alA);
  SLOAD(SO, KVBLK); if constexpr (SDEPTH == 2) { if (2 < NT) SLOAD(SE, 2 * KVBLK); }
  SWAIT(); SWRITE(1, SO); __syncthreads();
  for (int j = 1; j + 1 < NT; j += 2) {
    SBAR(); qkt(pB0, pB1, (bf16*)((char*)K_lds + SHM_K), qr, qrl, r32, hi);
    finishSM(pA0, pA1, alA, l_reg, pa0, pa1, pa2, pa3); SBAR();
    SLOAD(SO, (j + SDEPTH) * KVBLK); SBAR();
    pv_d0(o, vb0, pa0, pa1, pa2, pa3); partialSM(pB0, pB1, m_reg, mnB, alB);
    __syncthreads(); SWAIT(); SWRITE(0, SE);
    RESC(alB); __syncthreads();
    SBAR(); qkt(pA0, pA1, K_lds, qr, qrl, r32, hi);
    finishSM(pB0, pB1, alB, l_reg, pa0, pa1, pa2, pa3); SBAR();
    if (SDEPTH == 1 || j + 3 < NT) SLOAD(SE, (j + 1 + SDEPTH) * KVBLK); SBAR();
    pv_d0(o, vb0 + (int)SHM_V, pa0, pa1, pa2, pa3); partialSM(pA0, pA1, m_reg, mnA, alA);
    __syncthreads(); SWAIT(); SWRITE(1, SO);
    RESC(alA); __syncthreads();
  }
  SBAR(); qkt(pB0, pB1, (bf16*)((char*)K_lds + SHM_K), qr, qrl, r32, hi);
  finishSM(pA0, pA1, alA, l_reg, pa0, pa1, pa2, pa3); SBAR();
  pv_d0(o, vb0, pa0, pa1, pa2, pa3); partialSM(pB0, pB1, m_reg, mnB, alB);
  __syncthreads(); RESC(alB);
  finishSM(pB0, pB1, alB, l_reg, pa0, pa1, pa2, pa3); SBAR();
  pv_d0(o, vb0 + (int)SHM_V, pa0, pa1, pa2, pa3);
  if (hi == 0) li_l[r32] = l_reg; asm volatile("s_waitcnt lgkmcnt(0)" ::: "memory");
  float rli[16];
#pragma unroll
  for (int r = 0; r < 16; ++r) rli[r] = __builtin_amdgcn_rcpf(li_l[crow(r, hi)]);
  float rs[16];
#pragma unroll
  for (int r = 0; r < 16; ++r) { float s = 0.f;
#pragma unroll
    for (int d0 = 0; d0 < 4; ++d0) { o[d0][r] *= rli[r]; s += o[d0][r] * o[d0][r]; }
    rs[r] = s; }
#pragma unroll
  for (int x = 1; x < 32; x <<= 1)
#pragma unroll
    for (int r = 0; r < 16; ++r) rs[r] += __shfl_xor(rs[r], x);
  asm volatile("s_waitcnt lgkmcnt(0)" ::: "memory");
  if (r32 == 0) {
#pragma unroll
    for (int r = 0; r < 16; ++r) al_l[crow(r, hi)] = rs[r]; }
  asm volatile("s_waitcnt lgkmcnt(0)" ::: "memory");
  if (lane < 32) __hip_atomic_store(xs + (size_t)(wid * QBLK + lane) * 4 + head, __float_as_uint(al_l[lane]), __ATOMIC_RELAXED, __HIP_MEMORY_SCOPE_AGENT);
  asm volatile("s_waitcnt vmcnt(0)" ::: "memory");
  if (lane == 0) __hip_atomic_fetch_add(cnt, 1u, __ATOMIC_RELAXED, __HIP_MEMORY_SCOPE_AGENT);
  if (wid == 0) { unsigned sp = 0;
    while ((unsigned)__builtin_amdgcn_readfirstlane(__hip_atomic_load(cnt, __ATOMIC_RELAXED, __HIP_MEMORY_SCOPE_AGENT)) < 32u) { __builtin_amdgcn_s_sleep(2); if (++sp > (1u << 22)) break; }
    __builtin_amdgcn_fence(__ATOMIC_ACQUIRE, "agent"); }
  asm volatile("s_waitcnt vmcnt(0) lgkmcnt(0)" ::: "memory"); __syncthreads();
  if (lane < 32) { const unsigned* sl = xs + (size_t)(wid * QBLK + lane) * 4; float t = 0.f;
#pragma unroll
    for (int q = 0; q < 4; ++q) t += __uint_as_float(__hip_atomic_load(sl + q, __ATOMIC_RELAXED, __HIP_MEMORY_SCOPE_AGENT));
    li_l[lane] = 1.0f / sqrtf(t * (1.0f / 512.0f) + 1e-6f); }
  asm volatile("s_waitcnt lgkmcnt(0)" ::: "memory");
  float g4[4];
#pragma unroll
  for (int d0 = 0; d0 < 4; ++d0) g4[d0] = gain[d0 * 32 + r32];
  char* Ol = lds + wid * 8704;
#pragma unroll
  for (int r = 0; r < 16; ++r) { const int orow = crow(r, hi); const float rn = li_l[orow];
#pragma unroll
    for (int d0 = 0; d0 < 4; ++d0) { const float v = o[d0][r] * rn * g4[d0]; *(bf16*)(Ol + orow * 272 + (d0 * 32 + r32) * 2) = (bf16)(cvtpk(v, v) & 0xffffu); } }
  asm volatile("s_waitcnt lgkmcnt(0)" ::: "memory");
  bf16* Ow = Ob + (long)(wid * QBLK) * LDO;
#pragma unroll
  for (int i = 0; i < 8; i += 2) { const int row = (lane >> 4) + 4 * i, c16 = lane & 15;
    const u32x4 w0 = *reinterpret_cast<const u32x4*>(Ol + row * 272 + c16 * 16), w1 = *reinterpret_cast<const u32x4*>(Ol + (row + 4) * 272 + c16 * 16);
    *reinterpret_cast<u32x4*>(Ow + (long)row * LDO + c16 * 8) = w0; *reinterpret_cast<u32x4*>(Ow + (long)(row + 4) * LDO + c16 * 8) = w1;
    asm volatile("" ::: "memory"); }
  __syncthreads();
#undef SLOAD
#undef SWRITE
#undef SWAIT
#undef RESC
}
#undef KSWZ
#undef SBAR
}

namespace ml {
using att::bf16; using att::bf16x8; using att::s16x4; using att::f32x16; using att::u32x4;
typedef float f32x4 __attribute__((ext_vector_type(4)));
using att::crow;
__device__ __forceinline__ unsigned cvtpk(float lo, float hi) { unsigned r; asm("v_cvt_pk_bf16_f32 %0, %1, %2" : "=v"(r) : "v"(lo), "v"(hi)); return r; }
 using att::ld8; using att::bf2f; using att::v_st; using att::v_rd_base; using att::v_rd_off;
constexpr int TBr = 4352, CTXr = 256, SEQr = 4096;
constexpr float LOG2E = 1.4426950408889634f;
constexpr int TSTRIDE = 32 * 17 * 256;
#define MLAS __attribute__((address_space(3)))
__device__ __forceinline__ float log_sigmoid_f(float x) {
    const float t = __expf(-fabsf(x));
    const float l1p = t < 0.03f ? t * (1.0f - t * (0.5f - t * (0.33333334f - 0.25f * t))) : __logf(1.0f + t);
    return fminf(x, 0.f) - l1p;
}
template <int OFF> __device__ __forceinline__ s16x4 trr(int vb) { s16x4 r; asm volatile("ds_read_b64_tr_b16 %0, %1 offset:%2" : "=&v"(r) : "v"(vb), "i"(OFF) : "memory"); return r; }
#define MLPK(L, H) (bf16x8){L[0], L[1], L[2], L[3], H[0], H[1], H[2], H[3]}
__device__ __forceinline__ void unit_rows(int b, int dir, int j, int& rb, int& sg) {
    if (dir == 0) { rb = b * TBr + 256 * j; sg = 1; }
    else { rb = (j == 0) ? b * TBr + 255 : b * TBr + TBr - 1 - 256 * (j - 1); sg = -1; }
}
struct Conv8 { float w0[8], w1[8], w2[8], bb[8]; };
__device__ __forceinline__ void conv8_load(Conv8& cp, const float* __restrict__ cw, const float* __restrict__ cb, int c) {
#pragma unroll
    for (int j = 0; j < 8; ++j) { cp.w0[j] = cw[c + j]; cp.w1[j] = cw[1024 + c + j]; cp.w2[j] = cw[2048 + c + j]; cp.bb[j] = cb[c + j]; }
}
__device__ __forceinline__ void conv8x8(const bf16* __restrict__ P, int r0, int sg, int sr, int c, const Conv8& cp, float scale, bf16x8 (&out)[8]) {
    bf16x8 x0[8], xm[8], xp[8]; float fm[8], fp[8];
#pragma unroll
    for (int g = 0; g < 8; ++g) { const int r = r0 + sg * (32 * g + sr); const int t = r % TBr; const bool hp = (t != 0) && (t != CTXr), hn = (t != CTXr - 1) && (t != TBr - 1);
        const bf16* p = P + (size_t)r * 2560 + 448 + c; x0[g] = ld8(p); xm[g] = ld8(hp ? p - 2560 : p); xp[g] = ld8(hn ? p + 2560 : p); fm[g] = hp ? 1.0f : 0.0f; fp[g] = hn ? 1.0f : 0.0f; }
    asm volatile("" ::: "memory");
#pragma unroll
    for (int g = 0; g < 8; ++g) { float u[8];
#pragma unroll
        for (int j = 0; j < 8; ++j) { const float a = cp.w0[j] * fm[g] * bf2f(xm[g][j]) + cp.w1[j] * bf2f(x0[g][j]) + cp.w2[j] * fp[g] * bf2f(xp[g][j]) + cp.bb[j];
            u[j] = a * __builtin_amdgcn_rcpf(1.0f + __builtin_amdgcn_exp2f(-LOG2E * a)) * scale; }
        u32x4 o = {cvtpk(u[0], u[1]), cvtpk(u[2], u[3]), cvtpk(u[4], u[5]), cvtpk(u[6], u[7])};
        out[g] = *reinterpret_cast<bf16x8*>(&o); }
}
__device__ __forceinline__ void conv_rows_load(const bf16* __restrict__ P, int R0, int c, bf16x8 (&x)[10]) {
    const int t0 = R0 % TBr; const bool hp0 = (t0 != 0) && (t0 != CTXr); const int t7 = t0 + 7; const bool hn7 = (t7 != CTXr - 1) && (t7 != TBr - 1);
    const bf16* p = P + (size_t)R0 * 2560 + 448 + c;
    x[0] = ld8(hp0 ? p - 2560 : p);
#pragma unroll
    for (int g = 0; g < 8; ++g) x[1 + g] = ld8(p + (size_t)g * 2560);
    x[9] = ld8(hn7 ? p + (size_t)8 * 2560 : p + (size_t)7 * 2560);
}
__device__ __forceinline__ void conv_rows_compute(const bf16x8 (&x)[10], int R0, const Conv8& cp, float scale, bf16x8 (&out)[8]) {
    const int t0 = R0 % TBr;
#pragma unroll
    for (int g = 0; g < 8; ++g) { const int t = t0 + g; const float fm = ((t != 0) && (t != CTXr)) ? 1.0f : 0.0f, fp = ((t != CTXr - 1) && (t != TBr - 1)) ? 1.0f : 0.0f; float u[8];
#pragma unroll
        for (int j = 0; j < 8; ++j) { const float a = cp.w0[j] * fm * bf2f(x[g][j]) + cp.w1[j] * bf2f(x[g + 1][j]) + cp.w2[j] * fp * bf2f(x[g + 2][j]) + cp.bb[j];
            u[j] = a * __builtin_amdgcn_rcpf(1.0f + __builtin_amdgcn_exp2f(-LOG2E * a)) * scale; }
        u32x4 o = {cvtpk(u[0], u[1]), cvtpk(u[2], u[3]), cvtpk(u[4], u[5]), cvtpk(u[6], u[7])};
        out[g] = *reinterpret_cast<bf16x8*>(&o); }
}
__device__ __forceinline__ void gate_scan_task(const float* __restrict__ G, const float* __restrict__ gate_b, float* __restrict__ T, float* __restrict__ sca, int task, int lane) {
    const int seq = task / 17, j = task - seq * 17, b = seq >> 3, h = (seq >> 1) & 3, dir = seq & 1;
    int rb, sg; unit_rows(b, dir, j, rb, sg);
    const int gi = (2 * dir) * 4 + h, gf = (2 * dir + 1) * 4 + h; const float ib = gate_b[gi], fb = gate_b[gf];
    float igv[4], fgv[4];
#pragma unroll
    for (int rnd = 0; rnd < 4; ++rnd) { const size_t r = (size_t)(rb + sg * (64 * rnd + lane)); igv[rnd] = G[r * 16 + gi] + ib; fgv[rnd] = G[r * 16 + gf] + fb; }
    float cb = 0.f, cpm = -3.0e38f; float* Tb = T + (size_t)task * 256;
#pragma unroll
    for (int rnd = 0; rnd < 4; ++rnd) { const int i = 64 * rnd + lane;
        float bc = log_sigmoid_f(fgv[rnd]);
#pragma unroll
        for (int o = 1; o < 64; o <<= 1) { const float t_ = __shfl_up(bc, o); if (lane >= o) bc += t_; }
        bc += cb;
        const float al = igv[rnd] - bc; float pm = al;
#pragma unroll
        for (int o = 1; o < 64; o <<= 1) { const float t_ = __shfl_up(pm, o); if (lane >= o) pm = fmaxf(pm, t_); }
        pm = fmaxf(pm, cpm);
        Tb[i] = bc; Tb[TSTRIDE + i] = al; Tb[2 * TSTRIDE + i] = pm;
        cb = __shfl(bc, 63); cpm = __shfl(pm, 63); }
    if (j < 16 && lane == 0) { sca[(seq * 16 + j) * 2] = cpm; sca[(seq * 16 + j) * 2 + 1] = cb; }
}
__device__ __forceinline__ void mlstm_local(const bf16* __restrict__ P, const float* __restrict__ T, const float* __restrict__ cw, const float* __restrict__ cbias,
                                            float* __restrict__ Cloc, float* __restrict__ nloc, int unit, char* lds) {
    int tid_ = threadIdx.x; asm volatile("" : "+v"(tid_));
    const int tid = tid_, wid = tid >> 6, lane = tid & 63, r32 = lane & 31, hi = lane >> 5;
    const int seq = unit >> 4, j = unit & 15, b = seq >> 3, h = (seq >> 1) & 3, dir = seq & 1;
    int rb, sg; unit_rows(b, dir, j, rb, sg);
    const float* Tal = T + TSTRIDE + (size_t)(seq * 17 + j) * 256; const float mlm = T[2 * TSTRIDE + (size_t)(seq * 17 + j) * 256 + 255];
    float* npart = (float*)(lds + 131072);
    const int sr = tid >> 4, sc = (tid & 15) * 8;
    float wv[8]; bf16x8 vreg[8];
#pragma unroll
    for (int g = 0; g < 8; ++g) { const int i = 32 * g + sr; wv[g] = Tal[i]; vreg[g] = ld8(P + (size_t)(rb + sg * i) * 2560 + 1472 + h * 128 + sc); }
    asm volatile("" ::: "memory");
    float nacc[8] = {0.f, 0.f, 0.f, 0.f, 0.f, 0.f, 0.f, 0.f};
    {
        const int R0 = sg > 0 ? rb + 8 * sr : rb - 8 * sr - 7;
        bf16x8 xk[10]; conv_rows_load(P, R0, 512 + h * 128 + sc, xk); float wk[8];
#pragma unroll
        for (int g = 0; g < 8; ++g) wk[g] = Tal[8 * sr + g];
        asm volatile("" ::: "memory");
        Conv8 cp; conv8_load(cp, cw, cbias, 512 + h * 128 + sc); bf16x8 kv[8]; conv_rows_compute(xk, R0, cp, 0.08838834764831845f, kv);
#pragma unroll
        for (int g = 0; g < 8; ++g) { const int i = 8 * sr + g; const bf16x8 kr = sg > 0 ? kv[g] : kv[7 - g];
            *(bf16x8*)(lds + (i >> 6) * 16384 + v_st(i & 63, sc)) = kr; const float w = __expf(wk[g] - mlm);
#pragma unroll
            for (int x = 0; x < 8; ++x) nacc[x] += w * bf2f(kr[x]); } }
#pragma unroll
    for (int g = 0; g < 8; ++g) wv[g] = __expf(wv[g] - mlm);
#pragma unroll
    for (int g = 0; g < 8; ++g) { const int i = 32 * g + sr; const float w = wv[g]; const bf16x8 v = vreg[g];
        u32x4 o = {cvtpk(bf2f(v[0]) * w, bf2f(v[1]) * w), cvtpk(bf2f(v[2]) * w, bf2f(v[3]) * w), cvtpk(bf2f(v[4]) * w, bf2f(v[5]) * w), cvtpk(bf2f(v[6]) * w, bf2f(v[7]) * w)};
        *(u32x4*)(lds + 65536 + (i >> 6) * 16384 + v_st(i & 63, sc)) = o; }
#pragma unroll
    for (int x = 0; x < 8; ++x) { nacc[x] += __shfl_xor(nacc[x], 16); nacc[x] += __shfl_xor(nacc[x], 32); }
    if (lane < 16) {
#pragma unroll
        for (int x = 0; x < 8; ++x) npart[wid * 128 + sc + x] = nacc[x]; }
    __syncthreads();
    const int db = wid >> 1, eb0 = 2 * (wid & 1);
    const int vbK = (int)(uintptr_t)lds + v_rd_base(lane) + db * 512, vbV = (int)(uintptr_t)lds + 65536 + v_rd_base(lane) + eb0 * 512;
    f32x16 c0 = {}, c1 = {};
#define MLA_STEP(TL, KS) do { const s16x4 al_ = trr<(TL) * 16384 + v_rd_off(0, KS, 0)>(vbK), ah_ = trr<(TL) * 16384 + v_rd_off(0, KS, 1)>(vbK); \
        const s16x4 bl0 = trr<(TL) * 16384 + v_rd_off(0, KS, 0)>(vbV), bh0 = trr<(TL) * 16384 + v_rd_off(0, KS, 1)>(vbV), bl1 = trr<(TL) * 16384 + v_rd_off(1, KS, 0)>(vbV), bh1 = trr<(TL) * 16384 + v_rd_off(1, KS, 1)>(vbV); \
        asm volatile("s_waitcnt lgkmcnt(0)" ::: "memory"); __builtin_amdgcn_sched_barrier(0); \
        c0 = __builtin_amdgcn_mfma_f32_32x32x16_bf16(MLPK(al_, ah_), MLPK(bl0, bh0), c0, 0, 0, 0); c1 = __builtin_amdgcn_mfma_f32_32x32x16_bf16(MLPK(al_, ah_), MLPK(bl1, bh1), c1, 0, 0, 0); } while (0)
#define MLA_TILE(TL) do { MLA_STEP(TL, 0); MLA_STEP(TL, 1); MLA_STEP(TL, 2); MLA_STEP(TL, 3); } while (0)
    MLA_TILE(0); MLA_TILE(1); MLA_TILE(2); MLA_TILE(3);
#undef MLA_TILE
#undef MLA_STEP
    float* Co = Cloc + (size_t)unit * 16384;
#pragma unroll
    for (int r = 0; r < 16; ++r) { const int d = db * 32 + crow(r, hi); Co[d * 128 + eb0 * 32 + r32] = c0[r]; Co[d * 128 + eb0 * 32 + 32 + r32] = c1[r]; }
    if (tid < 128) { float s = 0.f;
#pragma unroll
        for (int w = 0; w < 8; ++w) s += npart[w * 128 + tid];
        nloc[unit * 128 + tid] = s; }
    __syncthreads();
}
__device__ __forceinline__ void mlstm_scan(const float* __restrict__ Cloc, const float* __restrict__ nloc, const float* __restrict__ sca, bf16* __restrict__ CstT, float* __restrict__ nst, float* __restrict__ bm, int gtid, int gthreads) {
    for (int item = gtid; item < 32 * 2048; item += gthreads) {
        const int seq = item >> 11, rem = item & 2047, e = rem & 127, dg = rem >> 7;
        float st[8] = {0.f, 0.f, 0.f, 0.f, 0.f, 0.f, 0.f, 0.f}; float nv = 0.f, Bst = 0.f, Mst = 0.f;
        asm volatile("" : "+v"(Bst), "+v"(Mst));
        const float* Cl0 = Cloc + (size_t)(seq * 16) * 16384 + (dg * 8) * 128 + e;
        for (int half = 0; half < 2; ++half) {
            float cl[8][8], nlv[8], mlv[8], blv[8];
#pragma unroll
            for (int jj = 0; jj < 8; ++jj) { const int lu = seq * 16 + half * 8 + jj;
#pragma unroll
                for (int i = 0; i < 8; ++i) cl[jj][i] = Cl0[(size_t)(half * 8 + jj) * 16384 + i * 128];
                nlv[jj] = nloc[lu * 128 + e]; mlv[jj] = sca[lu * 2]; blv[jj] = sca[lu * 2 + 1]; }
#pragma unroll
            for (int jj = 0; jj < 8; ++jj) { const int j = half * 8 + jj; const size_t su = (size_t)seq * 17 + j;
                u32x4 o = {cvtpk(st[0], st[1]), cvtpk(st[2], st[3]), cvtpk(st[4], st[5]), cvtpk(st[6], st[7])};
                *(u32x4*)(CstT + su * 16384 + e * 128 + dg * 8) = o;
                if (dg == 0) { nst[su * 128 + e] = nv; if (e == 0) { bm[su * 2] = Bst; bm[su * 2 + 1] = Mst; } }
                const float Mend = fmaxf(Mst, mlv[jj] - Bst), fa = __expf(Mst - Mend), fbv = __expf(mlv[jj] - Bst - Mend);
#pragma unroll
                for (int i = 0; i < 8; ++i) st[i] = fa * st[i] + fbv * cl[jj][i];
                nv = fa * nv + fbv * nlv[jj];
                Bst += blv[jj]; Mst = Mend; }
        }
        { const size_t su = (size_t)seq * 17 + 16;
          u32x4 o = {cvtpk(st[0], st[1]), cvtpk(st[2], st[3]), cvtpk(st[4], st[5]), cvtpk(st[6], st[7])};
          *(u32x4*)(CstT + su * 16384 + e * 128 + dg * 8) = o;
          if (dg == 0) { nst[su * 128 + e] = nv; if (e == 0) { bm[su * 2] = Bst; bm[su * 2 + 1] = Mst; } } }
    }
}
#define KSW(row, colB) ((row) * 256 + ((colB) ^ (((row) & 15) << 4)))
template <int D0, int KS> __device__ __forceinline__ void pv_pair(f32x16& od, int vb, bf16x8 pa, bf16x8 pb) {
    const s16x4 l0 = trr<v_rd_off(D0, KS, 0)>(vb), h0 = trr<v_rd_off(D0, KS, 1)>(vb), l1 = trr<v_rd_off(D0, KS + 1, 0)>(vb), h1 = trr<v_rd_off(D0, KS + 1, 1)>(vb);
    asm volatile("s_waitcnt lgkmcnt(0)" ::: "memory"); __builtin_amdgcn_sched_barrier(0);
    od = __builtin_amdgcn_mfma_f32_32x32x16_bf16(pa, MLPK(l0, h0), od, 0, 0, 0);
    od = __builtin_amdgcn_mfma_f32_32x32x16_bf16(pb, MLPK(l1, h1), od, 0, 0, 0);
}
__device__ __forceinline__ void mlstm_out2(const bf16* __restrict__ P, const float* __restrict__ T, const float* __restrict__ cw, const float* __restrict__ cbias, const bf16* __restrict__ CstT, const float* __restrict__ nst,
                                           const float* __restrict__ bm, const float* __restrict__ mnorm, bf16* __restrict__ MIX, int b, int h, int tb, char* lds) {
    int tid_ = threadIdx.x; asm volatile("" : "+v"(tid_));
    const int tid = tid_, wid = tid >> 6, lane = tid & 63, r32 = lane & 31, hi = lane >> 5;
    const int seqf = b * 8 + h * 2, seqb = seqf + 1; const int jb = tb == 0 ? 0 : 17 - tb; const bool zs = (tb == 0);
    const size_t suf = (size_t)seqf * 17 + tb, sub = (size_t)seqb * 17 + jb;
    const int rb = b * TBr + 256 * tb;
    float* tabs = (float*)(lds + 131072);
    float* nlf = tabs + 2048; float* nlb = tabs + 2176; float* wsc = tabs + 2304 + wid * 32;
    const int sr = tid >> 4, sc = (tid & 15) * 8;
    {
        bf16x8 xk[10], xq[10]; conv_rows_load(P, rb + 8 * sr, 512 + h * 128 + sc, xk); conv_rows_load(P, rb + 8 * sr, h * 128 + sc, xq);
        asm volatile("" ::: "memory");
        { Conv8 cp; conv8_load(cp, cw, cbias, 512 + h * 128 + sc); bf16x8 kv[8]; conv_rows_compute(xk, rb + 8 * sr, cp, 0.08838834764831845f, kv);
#pragma unroll
          for (int g = 0; g < 8; ++g) { const int i = 8 * sr + g; *(bf16x8*)(lds + KSW(i, sc * 2)) = kv[g]; } }
        { Conv8 cp; conv8_load(cp, cw, cbias, h * 128 + sc); bf16x8 qv[8]; conv_rows_compute(xq, rb + 8 * sr, cp, 1.0f, qv);
#pragma unroll
          for (int g = 0; g < 8; ++g) { const int i = 8 * sr + g; *(bf16x8*)(lds + 65536 + KSW(i, sc * 2)) = qv[g]; } } }
    bf16x8 vreg[8];
#pragma unroll
    for (int g = 0; g < 8; ++g) vreg[g] = ld8(P + (size_t)(rb + 32 * g + sr) * 2560 + 1472 + h * 128 + sc);
    asm volatile("" ::: "memory");
    {
        const int dir = tid >> 8, n = tid & 255; const size_t su = dir ? sub : suf; const size_t ti = su * 256 + (dir ? 255 - n : n);
        const float bl = T[ti], al = T[TSTRIDE + ti], pm = T[2 * TSTRIDE + ti]; float Bst = 0.f, Mst = 0.f; if (!zs) { Bst = bm[su * 2]; Mst = bm[su * 2 + 1]; }
        float* tb_ = tabs + dir * 1024; const float M = fmaxf(Mst, pm - Bst);
        tb_[n] = __expf(-(Bst + bl + M)); tb_[256 + n] = (al - Bst) * LOG2E; tb_[512 + n] = M * LOG2E; tb_[768 + n] = __expf(Mst - M); }
    if (wid == 2) { nlf[lane] = zs ? 0.f : nst[suf * 128 + lane]; nlf[64 + lane] = zs ? 0.f : nst[suf * 128 + 64 + lane]; }
    if (wid == 3) { nlb[lane] = zs ? 0.f : nst[sub * 128 + lane]; nlb[64 + lane] = zs ? 0.f : nst[sub * 128 + 64 + lane]; }
    __syncthreads();
    bf16x8 qr[8];
#pragma unroll
    for (int d0 = 0; d0 < 8; ++d0) qr[d0] = *reinterpret_cast<const bf16x8*>(lds + 65536 + KSW(wid * 32 + r32, (d0 * 16 + hi * 8) * 2));
    asm volatile("s_waitcnt lgkmcnt(0)" ::: "memory");
    __syncthreads();
#pragma unroll
    for (int g = 0; g < 8; ++g) { const int i = 32 * g + sr; *(bf16x8*)(lds + 65536 + (i >> 6) * 16384 + v_st(i & 63, sc)) = vreg[g]; }
    __syncthreads();
    const int qi = wid * 32 + r32;
    float qnf = 0.f, qnb = 0.f;
#pragma unroll
    for (int d0 = 0; d0 < 8; ++d0) {
#pragma unroll
        for (int jj = 0; jj < 8; ++jj) { const float qv = bf2f(qr[d0][jj]); qnf += qv * nlf[d0 * 16 + hi * 8 + jj]; qnb += qv * nlb[d0 * 16 + hi * 8 + jj]; }
        asm volatile("" : "+v"(qnf), "+v"(qnb)); }
    { auto rr = __builtin_amdgcn_permlane32_swap(__float_as_uint(qnf), __float_as_uint(qnf), false, false); qnf = __uint_as_float(rr[0]) + __uint_as_float(rr[1]); }
    { auto rr = __builtin_amdgcn_permlane32_swap(__float_as_uint(qnb), __float_as_uint(qnb), false, false); qnb = __uint_as_float(rr[0]) + __uint_as_float(rr[1]); }
    const int vb0 = (int)(uintptr_t)lds + 65536 + v_rd_base(lane);
    const int dtile = wid >> 1;
    unsigned hfp[32];
#define ML_PK4(Pv, BASE, OUT) do { unsigned a0 = cvtpk(Pv[BASE + 0], Pv[BASE + 1]), a1 = cvtpk(Pv[BASE + 2], Pv[BASE + 3]);   \
    unsigned b0_ = cvtpk(Pv[BASE + 4], Pv[BASE + 5]), b1_ = cvtpk(Pv[BASE + 6], Pv[BASE + 7]);                              \
    auto r0 = __builtin_amdgcn_permlane32_swap(a0, b0_, false, false); auto r1 = __builtin_amdgcn_permlane32_swap(a1, b1_, false, false); \
    u32x4 w = {r0[0], r1[0], r0[1], r1[1]}; OUT = *reinterpret_cast<bf16x8*>(&w); } while (0)
#pragma unroll
    for (int dir = 0; dir < 2; ++dir) {
        const float* tb_ = tabs + dir * 1024; const size_t su = dir ? sub : suf;
        f32x16 o[4];
        if (zs) { o[0] = f32x16{}; o[1] = f32x16{}; o[2] = f32x16{}; o[3] = f32x16{}; }
        else { const bf16* Cb = CstT + su * 16384 + (size_t)r32 * 128 + hi * 8;
#pragma unroll
          for (int ep = 0; ep < 2; ++ep) { bf16x8 cf[16];
#pragma unroll
              for (int x = 0; x < 16; ++x) cf[x] = ld8(Cb + (2 * ep + (x >> 3)) * 32 * 128 + (x & 7) * 16);
              f32x16 a0 = {}, a1 = {};
#pragma unroll
              for (int d0 = 0; d0 < 8; ++d0) { a0 = __builtin_amdgcn_mfma_f32_32x32x16_bf16(qr[d0], cf[d0], a0, 0, 0, 0); a1 = __builtin_amdgcn_mfma_f32_32x32x16_bf16(qr[d0], cf[8 + d0], a1, 0, 0, 0); }
              o[2 * ep] = a0; o[2 * ep + 1] = a1; }
#pragma unroll
          for (int r = 0; r < 16; ++r) { const float isc = tb_[768 + wid * 32 + crow(r, hi)];
#pragma unroll
              for (int eb = 0; eb < 4; ++eb) o[eb][r] *= isc; } }
        const float qn = dir ? qnb : qnf;
        const float m2q = tb_[512 + qi]; float dsum = 0.f;
        const int kt0 = dir ? dtile : 0, kt1 = dir ? 4 : dtile + 1;
        for (int kt = kt0; kt < kt1; ++kt) {
            const char* Ks = lds + kt * 64 * 256; const bool diag = (kt == dtile); const int vb = vb0 + kt * 16384;
#pragma unroll
            for (int hh = 0; hh < 2; ++hh) {
                f32x16 p = {}, p2 = {};
#pragma unroll
                for (int d0 = 0; d0 < 8; d0 += 2) { const int cb = (d0 * 16 + hi * 8) * 2;
                    const bf16x8 b0 = *reinterpret_cast<const bf16x8*>(Ks + KSW(32 * hh + r32, cb)), b1 = *reinterpret_cast<const bf16x8*>(Ks + KSW(32 * hh + r32, cb + 32));
                    p = __builtin_amdgcn_mfma_f32_32x32x16_bf16(b0, qr[d0], p, 0, 0, 0); p2 = __builtin_amdgcn_mfma_f32_32x32x16_bf16(b1, qr[d0 + 1], p2, 0, 0, 0); }
                p += p2;
#pragma unroll
                for (int g4 = 0; g4 < 4; ++g4) { const int sb = kt * 64 + 32 * hh + 8 * g4 + 4 * hi;
                    const f32x4 a4 = *(const f32x4*)(tb_ + 256 + sb);
#pragma unroll
                    for (int x = 0; x < 4; ++x) { const int r = 4 * g4 + x, s0 = sb + x;
                        float w0 = __builtin_amdgcn_exp2f(a4[x] - m2q);
                        if (diag) { if (dir ? (s0 < qi) : (s0 > qi)) w0 = 0.f; }
                        p[r] *= w0; dsum += p[r]; } }
                bf16x8 pa, pb;
                ML_PK4(p, 0, pa); ML_PK4(p, 8, pb);
                if (hh == 0) { pv_pair<0, 0>(o[0], vb, pa, pb); pv_pair<1, 0>(o[1], vb, pa, pb); pv_pair<2, 0>(o[2], vb, pa, pb); pv_pair<3, 0>(o[3], vb, pa, pb); }
                else         { pv_pair<0, 2>(o[0], vb, pa, pb); pv_pair<1, 2>(o[1], vb, pa, pb); pv_pair<2, 2>(o[2], vb, pa, pb); pv_pair<3, 2>(o[3], vb, pa, pb); }
            }
        }
        { auto rr = __builtin_amdgcn_permlane32_swap(__float_as_uint(dsum), __float_as_uint(dsum), false, false); dsum = __uint_as_float(rr[0]) + __uint_as_float(rr[1]); }
        const float den = dsum + tb_[768 + qi] * qn; const float rd = 1.0f / fmaxf(fabsf(den), tb_[qi]);
        if (hi == 0) wsc[r32] = rd; asm volatile("s_waitcnt lgkmcnt(0)" ::: "memory");
        if (dir == 0) {
#pragma unroll
            for (int r = 0; r < 16; r += 2) { const float ra = wsc[crow(r, hi)], rb_ = wsc[crow(r + 1, hi)];
#pragma unroll
                for (int eb = 0; eb < 4; ++eb) hfp[eb * 8 + (r >> 1)] = cvtpk(o[eb][r] * ra, o[eb][r + 1] * rb_); }
            asm volatile("s_waitcnt lgkmcnt(0)" ::: "memory");
        } else {
            float rdr[16];
#pragma unroll
            for (int r = 0; r < 16; ++r) rdr[r] = wsc[crow(r, hi)];
            bf16x8 og8[8];
            { const bf16* ogp = P + (size_t)(rb + wid * 32 + r32) * 2560 + 1984 + h * 128 + 64 * hi;
#pragma unroll
              for (int c8 = 0; c8 < 8; ++c8) og8[c8] = ld8(ogp + 8 * c8); }
            __syncthreads();
            float* W = (float*)(lds + wid * 16896);
#pragma unroll
            for (int r = 0; r < 16; ++r)
#pragma unroll
                for (int eb = 0; eb < 4; ++eb) { const unsigned pk = hfp[eb * 8 + (r >> 1)]; const float hf = (r & 1) ? __uint_as_float(pk & 0xffff0000u) : __uint_as_float(pk << 16);
                    W[crow(r, hi) * 132 + eb * 32 + r32] = hf + o[eb][r] * rdr[r]; }
            asm volatile("s_waitcnt lgkmcnt(0)" ::: "memory");
            const int tok = r32, eh = hi; const size_t row = (size_t)(rb + wid * 32 + tok);
            const float* mg = mnorm + h * 128 + 64 * eh;
            float v[64]; float s = 0.f;
#pragma unroll
            for (int c8 = 0; c8 < 8; ++c8) { const bf16x8 g8 = og8[c8]; const f32x4 w0 = *(const f32x4*)(W + tok * 132 + 64 * eh + 8 * c8), w1 = *(const f32x4*)(W + tok * 132 + 64 * eh + 8 * c8 + 4);
                const float hv[8] = {w0.x, w0.y, w0.z, w0.w, w1.x, w1.y, w1.z, w1.w};
#pragma unroll
                for (int x = 0; x < 8; ++x) { const float vv = hv[x] * __builtin_amdgcn_rcpf(1.0f + __builtin_amdgcn_exp2f(-LOG2E * bf2f(g8[x]))); v[8 * c8 + x] = vv; s += vv; } }
            { auto rr = __builtin_amdgcn_permlane32_swap(__float_as_uint(s), __float_as_uint(s), false, false); s = __uint_as_float(rr[0]) + __uint_as_float(rr[1]); }
            const float mu = s * (1.0f / 128.0f); float q = 0.f;
#pragma unroll
            for (int x = 0; x < 64; ++x) { v[x] -= mu; q += v[x] * v[x]; }
            { auto rr = __builtin_amdgcn_permlane32_swap(__float_as_uint(q), __float_as_uint(q), false, false); q = __uint_as_float(rr[0]) + __uint_as_float(rr[1]); }
            const float rstd = 1.0f / sqrtf(q * (1.0f / 128.0f) + 1e-6f);
            bf16* orow = MIX + row * 1024 + 512 + h * 128 + 64 * eh;
#pragma unroll
            for (int c8 = 0; c8 < 8; ++c8) { const f32x4 g0 = *(const f32x4*)(mg + 8 * c8), g1 = *(const f32x4*)(mg + 8 * c8 + 4);
                u32x4 ov = {cvtpk(v[8 * c8] * rstd * g0.x, v[8 * c8 + 1] * rstd * g0.y), cvtpk(v[8 * c8 + 2] * rstd * g0.z, v[8 * c8 + 3] * rstd * g0.w),
                            cvtpk(v[8 * c8 + 4] * rstd * g1.x, v[8 * c8 + 5] * rstd * g1.y), cvtpk(v[8 * c8 + 6] * rstd * g1.z, v[8 * c8 + 7] * rstd * g1.w)};
                *(u32x4*)(orow + 8 * c8) = ov; }
        }
    }
#undef ML_PK4
    __syncthreads();
}
#undef KSW
#undef MLPK
#undef MLAS
}

#define LAS __attribute__((address_space(3)))
typedef unsigned short bf16;
typedef float f32x4 __attribute__((ext_vector_type(4)));
typedef unsigned u32x4 __attribute__((ext_vector_type(4)));
typedef unsigned u32x2 __attribute__((ext_vector_type(2)));
typedef short bf16x8 __attribute__((ext_vector_type(8)));
constexpr int NWAVES = 8, NTHREADS = 512;
constexpr int DM = 1024, NB = 4, SEQ = 4096, CTXL = 256, TB = SEQ + CTXL  , R = NB * TB  ;
constexpr int DFF = 2752, DFFP = 2816, NW1 = 2 * DFFP  , DIN = 2512, DINP = 2560, KUP = 384, NUP = 1792;
constexpr int NMOD = 9;
constexpr float EPS = 1e-6f;
constexpr size_t MiB = 1u << 20;
constexpr size_t WS_CTL = 0, CTL_BYTES = 1 * MiB;
constexpr size_t WS_MOD = 1 * MiB;
constexpr size_t WS_TAB = WS_MOD + 512 * 1024;
constexpr size_t WS_W1 = 2 * MiB;
constexpr size_t WS_W2 = WS_W1 + (size_t)2 * NW1 * DM * 2;
constexpr size_t WS_WIN = WS_W2 + (size_t)2 * DM * DFFP * 2;
constexpr size_t WS_WUP = WS_WIN + (size_t)DINP * DM * 2;
constexpr size_t WS_WOUT = WS_WUP + (size_t)NUP * KUP * 2;
constexpr size_t WS_XC = WS_WOUT + (size_t)DM * DM * 2;
constexpr size_t WS_H = WS_XC + (size_t)NB * CTXL * DM * 4;
constexpr size_t WS_BIG = WS_H + (size_t)R * DM * 2;
constexpr size_t BIG_KR = (size_t)R * DINP * 2;
constexpr size_t BIG_G = BIG_KR + (size_t)R * 64 * 2;
constexpr size_t WS_Y = WS_BIG + (size_t)R * DFFP * 2;
constexpr size_t WS_Q = WS_Y + (size_t)R * DM * 2;
constexpr size_t WS_AUP = WS_Q + (size_t)R * 768 * 2;
constexpr size_t WS_HF = WS_AUP + (size_t)R * 512 * 2;
constexpr size_t WS_HB = WS_HF + (size_t)R * 512 * 2;
constexpr size_t WS_MS = WS_HB + (size_t)R * 512 * 2;
constexpr size_t MS_NLOC = 0, MS_SCA = 262144, MS_NST = 266240, MS_BM = 544768;
constexpr size_t MS_X1 = 3u << 20, MS_X2 = (3u << 20) + (512u << 10);
constexpr size_t MS_T = 1u << 20;
constexpr size_t WS_END = WS_MS + 4 * MiB;
static_assert(BIG_G + (size_t)R * 16 * 4 <= (size_t)R * DFFP * 2, "P + KR + G fit the hidden region");
static_assert(WS_W1 % 256 == 0 && WS_W2 % 256 == 0 && WS_WIN % 256 == 0 && WS_WUP % 256 == 0 && WS_WOUT % 256 == 0 && WS_XC % 256 == 0 && WS_H % 256 == 0 && WS_BIG % 256 == 0 && WS_Y % 256 == 0 && WS_Q % 256 == 0 && WS_AUP % 256 == 0 && WS_HF % 256 == 0, "alignment");
static_assert(WS_END <= 305u * MiB, "workspace budget");
constexpr int LDS_BYTES = 147456, LDS_MISC = 143360;

#define LDS_WAIT() asm volatile("s_waitcnt lgkmcnt(0)" ::: "memory")
__device__ __forceinline__ unsigned f2bf(float f) { unsigned u = __builtin_bit_cast(unsigned, f); return (u + 0x7fffu + ((u >> 16) & 1u)) >> 16; }
__device__ __forceinline__ unsigned pk2(float lo, float hi) { return f2bf(lo) | (f2bf(hi) << 16); }
__device__ __forceinline__ float bflo(unsigned w) { return __uint_as_float(w << 16); }
__device__ __forceinline__ float bfhi(unsigned w) { return __uint_as_float(w & 0xffff0000u); }
__device__ __forceinline__ float bf1(bf16 b) { return __uint_as_float(((unsigned)b) << 16); }
__device__ __forceinline__ float wave_sum(float v) {
#pragma unroll
    for (int o = 1; o < 64; o <<= 1) v += __shfl_xor(v, o);
    return v;
}
__device__ __forceinline__ float sigmoid_f(float x) { return __builtin_amdgcn_rcpf(1.0f + __builtin_amdgcn_exp2f(-1.4426950408889634f * x)); }
__device__ __forceinline__ float silu1(float x) { return x * sigmoid_f(x); }

struct Args { const float* in[22]; float* out; unsigned char* ws; int ph_lo, ph_hi; };
struct ArgsV { const Args* p; int z;
    __device__ __forceinline__ const float* in(int i) const { return p->in[i + z]; }
    __device__ __forceinline__ float* out() const { return (float*)p->in[22 + z]; }
    __device__ __forceinline__ unsigned char* ws() const { return (unsigned char*)p->in[23 + z]; } };
enum { I_X = 0, I_C, I_CTX, I_CCTX, I_WMOD, I_BMOD, I_NPRE, I_NPOST, I_WG, I_WU, I_WD, I_WIN, I_QN, I_WUQ, I_KVN, I_WUKV, I_AON, I_CW, I_CB, I_GB, I_MN, I_WOUT };

__device__ __forceinline__ const float* xin_row(const ArgsV& a, int r) { const int b = r / TB, t = r - b * TB; return t < CTXL ? a.in(I_CTX) + (size_t)(b * CTXL + t) * DM : a.in(I_X) + (size_t)(b * SEQ + t - CTXL) * DM; }
__device__ __forceinline__ float* xres_row(const ArgsV& a, int r) { const int b = r / TB, t = r - b * TB; return t < CTXL ? (float*)(a.ws() + WS_XC) + (size_t)(b * CTXL + t) * DM : a.out() + (size_t)(b * SEQ + t - CTXL) * DM; }
__device__ __forceinline__ const float* mod_vec(const ArgsV& a, int l, int r, int j) { const int b = r / TB, t = r - b * TB; const int bb = t < CTXL ? 4 : b; return (const float*)(a.ws() + WS_MOD) + (size_t)((l * 5 + bb) * NMOD + j) * DM; }

__device__ __forceinline__ void cvt_item(const float* src, int srcN, int k0, int c0, int ncv, bf16* dst, int dstK, int drow0, int dk0, LAS float* scr, int lane) {
    const int n4 = (lane & 15) * 4, kr = lane >> 4;
    f32x4 v[16];
    const bool ok = n4 < ncv;
    const float* sp = src + (size_t)(k0 + kr) * srcN + c0 + n4;
#pragma unroll
    for (int i = 0; i < 16; ++i) { v[i] = (f32x4){0.f, 0.f, 0.f, 0.f}; if (ok) v[i] = *(const f32x4*)(sp + (size_t)(4 * i) * srcN); }
#pragma unroll
    for (int i = 0; i < 16; ++i) { const int k = 4 * i + kr; *(LAS f32x4*)(scr + k * 68 + ((n4 + 8 * (k >> 3)) & 63)) = v[i]; }
    LDS_WAIT(); asm volatile("" ::: "memory");
    const int c = lane & 7;
#pragma unroll
    for (int j = 0; j < 8; ++j) { const int n = (lane >> 3) + 8 * j; const LAS float* s = scr + (8 * c) * 68 + ((n + 8 * c) & 63);
        u32x4 o; o.x = pk2(s[0 * 68], s[1 * 68]); o.y = pk2(s[2 * 68], s[3 * 68]); o.z = pk2(s[4 * 68], s[5 * 68]); o.w = pk2(s[6 * 68], s[7 * 68]);
        *(u32x4*)(dst + (size_t)(drow0 + n) * dstK + dk0 + 8 * c) = o; }
    LDS_WAIT(); asm volatile("" ::: "memory");
}
__device__ __forceinline__ void wconv_layer(const ArgsV& a, int l, LAS unsigned char* lds, int bid, int nbl, int wave, int lane, int parts) {
    LAS float* scr = (LAS float*)(lds + wave * 17408);
    const int gw = bid * NWAVES + wave, NGW = nbl * NWAVES;
    constexpr int I_1 = 88 * 16, I_2 = 16 * 44, I_IN = 40 * 16, I_UP = 28 * 6, I_OUT = 16 * 16;
    constexpr int NITEMS = 2 * I_1 + 2 * I_2 + I_IN + I_UP + I_OUT;
    bf16* W1 = (bf16*)(a.ws() + WS_W1); bf16* W2 = (bf16*)(a.ws() + WS_W2); bf16* WIN = (bf16*)(a.ws() + WS_WIN); bf16* WUP = (bf16*)(a.ws() + WS_WUP); bf16* WOUT = (bf16*)(a.ws() + WS_WOUT);
    const int tot = ((parts & 1) ? I_1 : 0) + ((parts & 2) ? I_1 : 0) + ((parts & 4) ? I_2 : 0) + ((parts & 8) ? I_2 : 0) + ((parts & 16) ? I_IN : 0) + ((parts & 32) ? I_UP : 0) + ((parts & 64) ? I_OUT : 0);
    for (int vi = gw; vi < tot; vi += NGW) {
        int r, v = vi;
        if ((parts & 1) && v < I_1) r = v; else { v -= (parts & 1) ? I_1 : 0;
        if ((parts & 2) && v < I_1) r = I_1 + v; else { v -= (parts & 2) ? I_1 : 0;
        if ((parts & 4) && v < I_2) r = 2 * I_1 + v; else { v -= (parts & 4) ? I_2 : 0;
        if ((parts & 8) && v < I_2) r = 2 * I_1 + I_2 + v; else { v -= (parts & 8) ? I_2 : 0;
        if ((parts & 16) && v < I_IN) r = 2 * I_1 + 2 * I_2 + v; else { v -= (parts & 16) ? I_IN : 0;
        if ((parts & 32) && v < I_UP) r = 2 * I_1 + 2 * I_2 + I_IN + v; else { v -= (parts & 32) ? I_UP : 0; r = 2 * I_1 + 2 * I_2 + I_IN + I_UP + v; } } } } } }
        if (r < 2 * I_1) { const int j = r / I_1; r -= j * I_1; const int g = r / 16, kb = r % 16; const int row0 = 64 * g, pn = row0 >> 8, i = row0 & 255; const int hc = 128 * pn + (i & 127);
            const float* src = (i < 128 ? a.in(I_WG) : a.in(I_WU)) + (size_t)(l * 2 + j) * DM * DFF;
            cvt_item(src, DFF, 64 * kb, hc < DFF ? hc : 0, hc < DFF ? 64 : 0, W1 + (size_t)j * NW1 * DM, DM, row0, 64 * kb, scr, lane); continue; }
        r -= 2 * I_1;
        if (r < 2 * I_2) { const int j = r / I_2; r -= j * I_2; const int g = r / 44, kb = r % 44;
            const float* src = a.in(I_WD) + (size_t)(l * 2 + j) * DFF * DM;
            cvt_item(src, DM, kb < 43 ? 64 * kb : 0, 64 * g, kb < 43 ? 64 : 0, W2 + (size_t)j * DM * DFFP, DFFP, 64 * g, 64 * kb, scr, lane); continue; }
        r -= 2 * I_2;
        if (r < I_IN) { const int g = r / 16, kb = r % 16; int ncv = DIN - 64 * g; ncv = ncv < 0 ? 0 : (ncv > 64 ? 64 : ncv);
            cvt_item(a.in(I_WIN) + (size_t)l * DM * DIN, DIN, 64 * kb, ncv > 0 ? 64 * g : 0, ncv, WIN, DM, 64 * g, 64 * kb, scr, lane); continue; }
        r -= I_IN;
        if (r < I_UP) { const int g = r / 6, kb = r % 6;
            if (g < 12) cvt_item(a.in(I_WUQ) + (size_t)l * 256 * 768, 768, kb < 4 ? 64 * kb : 0, 64 * g, kb < 4 ? 64 : 0, WUP, KUP, 64 * g, 64 * kb, scr, lane);
            else cvt_item(a.in(I_WUKV) + (size_t)l * 128 * 1024, 1024, kb >= 4 ? 64 * (kb - 4) : 0, 64 * (g - 12), kb >= 4 ? 64 : 0, WUP, KUP, 64 * g, 64 * kb, scr, lane);
            continue; }
        r -= I_UP;
        { const int g = r / 16, kb = r % 16; cvt_item(a.in(I_WOUT) + (size_t)l * DM * DM, DM, 64 * kb, 64 * g, 64, WOUT, DM, 64 * g, 64 * kb, scr, lane); }
    }
}
__device__ __forceinline__ void mod_phase(const ArgsV& a, LAS unsigned char* lds, int bid, int nbl, int tid, int wave, int lane) {
    LAS float* sv = (LAS float*)(lds);
    LAS float* red = (LAS float*)(lds + 20480);
    for (int i = tid; i < 5 * DM; i += NTHREADS) { const float v = i < 4 * DM ? a.in(I_C)[i] : a.in(I_CCTX)[i - 4 * DM]; sv[i] = silu1(v); }
    __syncthreads();
    float* mod = (float*)(a.ws() + WS_MOD);
    for (int u = bid; u < 256; u += nbl) {
        const int l = u >> 7, cb = (u & 127) * 72; const bool act = lane < 18;
        const float* W = a.in(I_WMOD) + (size_t)l * DM * (NMOD * DM) + cb + 4 * (act ? lane : 0);
        f32x4 acc[5];
#pragma unroll
        for (int bb = 0; bb < 5; ++bb) acc[bb] = (f32x4){0.f, 0.f, 0.f, 0.f};
        for (int k0 = wave * 128; k0 < wave * 128 + 128; k0 += 32) { f32x4 w[32];
#pragma unroll
            for (int i = 0; i < 32; ++i) w[i] = *(const f32x4*)(W + (size_t)(k0 + i) * (NMOD * DM));
#pragma unroll
            for (int i = 0; i < 32; ++i)
#pragma unroll
                for (int bb = 0; bb < 5; ++bb) acc[bb] += w[i] * sv[bb * DM + k0 + i]; }
        if (act) {
#pragma unroll
            for (int bb = 0; bb < 5; ++bb) *(LAS f32x4*)(red + (wave * 5 + bb) * 72 + 4 * lane) = acc[bb]; }
        __syncthreads();
        for (int i = tid; i < 5 * 72; i += NTHREADS) { const int bb = i / 72, cc = i % 72; float s = 0.f;
#pragma unroll
            for (int w = 0; w < 8; ++w) s += red[(w * 5 + bb) * 72 + cc];
            mod[(size_t)(l * 5 + bb) * (NMOD * DM) + cb + cc] = s + a.in(I_BMOD)[(size_t)l * NMOD * DM + cb + cc]; }
        __syncthreads();
    }
    if (bid == nbl - 1 && tid < 64) {
        constexpr float inv[16] = {1.0f, 0.5623413251903491f, 0.31622776601683794f, 0.1778279410038923f, 0.1f, 0.05623413251903491f, 0.03162277660168379f, 0.01778279410038923f,
                                   0.01f, 0.005623413251903491f, 0.0031622776601683794f, 0.001778279410038923f, 0.001f, 0.0005623413251903491f, 0.00031622776601683794f, 0.0001778279410038923f};
        float* tab = (float*)(a.ws() + WS_TAB);
#pragma unroll
        for (int f = 0; f < 16; ++f) {
            const float ang = (float)tid * inv[f];
            const double ad = (double)ang; const double kq = __builtin_rint(ad * 0.63661977236758134308); const double rd = ad - kq * 1.57079632679489661923;
            const float x = (float)rd, x2 = x * x; const int q = ((int)kq) & 3;
            const float sp = x + x * x2 * (-1.6666654611e-1f + x2 * (8.3321608736e-3f + x2 * (-1.9515295891e-4f)));
            const float cp = 1.0f - 0.5f * x2 + x2 * x2 * (4.166664568298827e-2f + x2 * (-1.388731625493765e-3f + x2 * 2.443315711809948e-5f));
            const float sn = (q == 0) ? sp : (q == 1) ? cp : (q == 2) ? -sp : -cp;
            const float cs = (q == 0) ? cp : (q == 1) ? -sp : (q == 2) ? -cp : sp;
            tab[(tid * 16 + f) * 2] = cs; tab[(tid * 16 + f) * 2 + 1] = sn; }
    }
    __syncthreads();
}

__device__ __forceinline__ void rw_pre(const f32x4 (&x)[4], const float* g, const float* sc, const float* sh, bf16* hrow, int lane) {
    float ss = 0.f;
#pragma unroll
    for (int j = 0; j < 4; ++j) ss += (x[j].x * x[j].x + x[j].y * x[j].y) + (x[j].z * x[j].z + x[j].w * x[j].w);
    const float rstd = 1.0f / sqrtf(wave_sum(ss) * (1.0f / DM) + EPS);
#pragma unroll
    for (int j = 0; j < 4; ++j) { const int c = 256 * j + 4 * lane; const f32x4 gv = *(const f32x4*)(g + c), sv = *(const f32x4*)(sc + c), hv = *(const f32x4*)(sh + c);
        f32x4 o; o.x = x[j].x * rstd * gv.x * (1.0f + sv.x) + hv.x; o.y = x[j].y * rstd * gv.y * (1.0f + sv.y) + hv.y; o.z = x[j].z * rstd * gv.z * (1.0f + sv.z) + hv.z; o.w = x[j].w * rstd * gv.w * (1.0f + sv.w) + hv.w;
        u32x2 w; w.x = pk2(o.x, o.y); w.y = pk2(o.z, o.w); *(u32x2*)(hrow + c) = w; }
}
__device__ __forceinline__ void xb_store(const ArgsV& a, int r, const f32x4 (&x)[4], int lane) {
    const int b = r / TB, t = r - b * TB; if (t < CTXL) return;
    bf16* xr = (bf16*)(a.ws() + WS_Y) + (size_t)(b * SEQ + t - CTXL) * DM;
#pragma unroll
    for (int j = 0; j < 4; ++j) { u32x2 w; w.x = pk2(x[j].x, x[j].y); w.y = pk2(x[j].z, x[j].w); *(u32x2*)(xr + 256 * j + 4 * lane) = w; }
}
__device__ __forceinline__ void phase_rw_a(const ArgsV& a, int bid, int nbl, int wave, int lane) {
    const int gw = bid * NWAVES + wave, NGW = nbl * NWAVES; bf16* H = (bf16*)(a.ws() + WS_H);
    for (int ra = gw; ra < R; ra += 2 * NGW) {
        const int rb_ = ra + NGW < R ? ra + NGW : ra; const float* xa = xin_row(a, ra); const float* xb = xin_row(a, rb_); f32x4 x0[4], x1[4];
#pragma unroll
        for (int j = 0; j < 4; ++j) { x0[j] = *(const f32x4*)(xa + 256 * j + 4 * lane); x1[j] = *(const f32x4*)(xb + 256 * j + 4 * lane); }
        xb_store(a, ra, x0, lane); if (rb_ != ra) xb_store(a, rb_, x1, lane);
        rw_pre(x0, a.in(I_NPRE) + 0, mod_vec(a, 0, ra, 1), mod_vec(a, 0, ra, 0), H + (size_t)ra * DM, lane);
        if (rb_ != ra) rw_pre(x1, a.in(I_NPRE) + 0, mod_vec(a, 0, rb_, 1), mod_vec(a, 0, rb_, 0), H + (size_t)rb_ * DM, lane); }
}
__device__ __forceinline__ void phase_rw_b(const ArgsV& a, int l, int sub, int bid, int nbl, int wave, int lane, bool dry = false) {
    const int gw = bid * NWAVES + wave, NGW = nbl * NWAVES; bf16* H = (bf16*)(a.ws() + WS_H);
    const float wgt = sub == 1 ? 1.0f : 0.5f; const float* gpost = a.in(I_NPOST) + (size_t)(l * 3 + sub) * DM;
    const int nl = sub == 2 ? l + 1 : l, nsub = sub == 2 ? 0 : sub + 1;
    const bool from_input = (l == 0 && sub == 0); const int nsl = sub == 1 ? 4 : 11;
    if (l == 1 && sub >= 1) return;
    const float* gpre = a.in(I_NPRE) + (size_t)(nl * 3 + nsub) * DM;
    for (int i0 = gw; i0 < NB * CTXL; i0 += NGW) {
        const int r0 = (i0 / CTXL) * TB + (i0 % CTXL);
        const float* xs0 = from_input ? xin_row(a, r0) : xres_row(a, r0);
        const float* gate0 = mod_vec(a, l, r0, 3 * sub + 2); const float* sc0 = mod_vec(a, nl, r0, 3 * nsub + 1); const float* sh0 = mod_vec(a, nl, r0, 3 * nsub);
        const float* sp = (const float*)(a.ws() + WS_AUP) + (size_t)((r0 / TB) * CTXL + (r0 % TB)) * DM + 4 * lane;
        f32x4 x0[4], y0[4], gp[4], gt[4], gn[4], sv[4], hv[4];
        {   f32x4 v[4][4];
#pragma unroll
            for (int j = 0; j < 4; ++j) { const int c = 256 * j + 4 * lane; x0[j] = *(const f32x4*)(xs0 + c); gp[j] = *(const f32x4*)(gpost + c); gt[j] = *(const f32x4*)(gate0 + c);
#pragma unroll
                for (int s = 0; s < 4; ++s) v[s][j] = *(const f32x4*)(sp + (size_t)s * 1024 * 1024 + 256 * j); }
            asm volatile("" ::: "memory");
#pragma unroll
            for (int j = 0; j < 4; ++j) y0[j] = (v[0][j] + v[1][j]) + (v[2][j] + v[3][j]); }
        if (nsl > 4) {
            {   f32x4 w[4][4];
#pragma unroll
                for (int j = 0; j < 4; ++j) { const int c = 256 * j + 4 * lane; gn[j] = *(const f32x4*)(gpre + c); sv[j] = *(const f32x4*)(sc0 + c); hv[j] = *(const f32x4*)(sh0 + c);
#pragma unroll
                    for (int s = 0; s < 4; ++s) w[s][j] = *(const f32x4*)(sp + (size_t)(4 + s) * 1024 * 1024 + 256 * j); }
                asm volatile("" ::: "memory");
#pragma unroll
                for (int j = 0; j < 4; ++j) y0[j] += (w[0][j] + w[1][j]) + (w[2][j] + w[3][j]); }
            {   f32x4 w[3][4];
#pragma unroll
                for (int s = 0; s < 3; ++s)
#pragma unroll
                    for (int j = 0; j < 4; ++j) w[s][j] = *(const f32x4*)(sp + (size_t)(8 + s) * 1024 * 1024 + 256 * j);
#pragma unroll
                for (int j = 0; j < 4; ++j) y0[j] += (w[0][j] + w[1][j]) + w[2][j]; }
        } else {
#pragma unroll
            for (int j = 0; j < 4; ++j) { const int c = 256 * j + 4 * lane; gn[j] = *(const f32x4*)(gpre + c); sv[j] = *(const f32x4*)(sc0 + c); hv[j] = *(const f32x4*)(sh0 + c); }
        }
        float ss0 = 0.f;
#pragma unroll
        for (int j = 0; j < 4; ++j) ss0 += (y0[j].x * y0[j].x + y0[j].y * y0[j].y) + (y0[j].z * y0[j].z + y0[j].w * y0[j].w);
        const float rs0 = 1.0f / sqrtf(wave_sum(ss0) * (1.0f / DM) + EPS);
        float* xd0 = dry ? (float*)(a.ws() + WS_BIG) + (size_t)r0 * DM : xres_row(a, r0);
        float s2 = 0.f;
#pragma unroll
        for (int j = 0; j < 4; ++j) { const int c = 256 * j + 4 * lane;
            x0[j].x += wgt * gt[j].x * (y0[j].x * rs0 * gp[j].x); x0[j].y += wgt * gt[j].y * (y0[j].y * rs0 * gp[j].y); x0[j].z += wgt * gt[j].z * (y0[j].z * rs0 * gp[j].z); x0[j].w += wgt * gt[j].w * (y0[j].w * rs0 * gp[j].w);
            *(f32x4*)(xd0 + c) = x0[j]; s2 += (x0[j].x * x0[j].x + x0[j].y * x0[j].y) + (x0[j].z * x0[j].z + x0[j].w * x0[j].w); }
        const float rstd = 1.0f / sqrtf(wave_sum(s2) * (1.0f / DM) + EPS); bf16* hrow = H + (size_t)r0 * DM;
#pragma unroll
        for (int j = 0; j < 4; ++j) { const int c = 256 * j + 4 * lane; f32x4 o;
            o.x = x0[j].x * rstd * gn[j].x * (1.0f + sv[j].x) + hv[j].x; o.y = x0[j].y * rstd * gn[j].y * (1.0f + sv[j].y) + hv[j].y; o.z = x0[j].z * rstd * gn[j].z * (1.0f + sv[j].z) + hv[j].z; o.w = x0[j].w * rstd * gn[j].w * (1.0f + sv[j].w) + hv[j].w;
            u32x2 w; w.x = pk2(o.x, o.y); w.y = pk2(o.z, o.w); *(u32x2*)(hrow + c) = w; }
    }
}
__device__ __forceinline__ void phase_rw_prep(const ArgsV& a, int l, int bid, int nbl, int wave, int lane) {
    const int gw = bid * NWAVES + wave, NGW = nbl * NWAVES;
    const bf16* P = (const bf16*)(a.ws() + WS_BIG); bf16* AUP = (bf16*)(a.ws() + WS_AUP); bf16* KR = (bf16*)(a.ws() + WS_BIG + BIG_KR);
    const float* tab = (const float*)(a.ws() + WS_TAB);
    const float* qn = a.in(I_QN) + l * 256; const float* kvn = a.in(I_KVN) + l * 128;
    for (int task = gw; task < 32 * 17; task += NGW)
        ml::gate_scan_task((const float*)(a.ws() + WS_BIG + BIG_G), a.in(I_GB) + l * 16, (float*)(a.ws() + WS_MS + MS_T), (float*)(a.ws() + WS_MS + MS_SCA), task, lane);
    for (int ra = gw; ra < R; ra += 2 * NGW) {
        const int rb_ = ra + NGW < R ? ra + NGW : ra; const bool two = rb_ != ra;
        const bf16* pa = P + (size_t)ra * DINP; const bf16* pb = P + (size_t)rb_ * DINP;
        const u32x2 wa = *(const u32x2*)(pa + 4 * lane), wb = *(const u32x2*)(pb + 4 * lane);
        const unsigned ka = *(const unsigned*)(pa + 256 + 2 * lane), kb = *(const unsigned*)(pb + 256 + 2 * lane);
        const float va = bf1(pa[384 + lane]), vb = bf1(pb[384 + lane]);
        const f32x4 g = *(const f32x4*)(qn + 4 * lane); const float kg0 = kvn[2 * lane], kg1 = kvn[2 * lane + 1];
        float a0 = bflo(wa.x), a1 = bfhi(wa.x), a2 = bflo(wa.y), a3 = bfhi(wa.y), b0 = bflo(wb.x), b1 = bfhi(wb.x), b2 = bflo(wb.y), b3 = bfhi(wb.y);
        float sa = (a0 * a0 + a1 * a1) + (a2 * a2 + a3 * a3), sb = (b0 * b0 + b1 * b1) + (b2 * b2 + b3 * b3);
        const float c0 = bflo(ka), c1 = bfhi(ka), d0 = bflo(kb), d1 = bfhi(kb); float ta = c0 * c0 + c1 * c1, tb = d0 * d0 + d1 * d1;
#pragma unroll
        for (int o = 1; o < 64; o <<= 1) { sa += __shfl_xor(sa, o); sb += __shfl_xor(sb, o); ta += __shfl_xor(ta, o); tb += __shfl_xor(tb, o); }
        const float voa = __shfl_xor(va, 16), vob = __shfl_xor(vb, 16);
        const float rqa = 1.0f / sqrtf(sa * (1.0f / 256.0f) + EPS), rqb = 1.0f / sqrtf(sb * (1.0f / 256.0f) + EPS), rka = 1.0f / sqrtf(ta * (1.0f / 128.0f) + EPS), rkb = 1.0f / sqrtf(tb * (1.0f / 128.0f) + EPS);
        { u32x2 o; o.x = pk2(a0 * rqa * g.x, a1 * rqa * g.y); o.y = pk2(a2 * rqa * g.z, a3 * rqa * g.w); *(u32x2*)(AUP + (size_t)ra * KUP + 4 * lane) = o;
          *(unsigned*)(AUP + (size_t)ra * KUP + 256 + 2 * lane) = pk2(c0 * rka * kg0, c1 * rka * kg1); }
        if (two) { u32x2 o; o.x = pk2(b0 * rqb * g.x, b1 * rqb * g.y); o.y = pk2(b2 * rqb * g.z, b3 * rqb * g.w); *(u32x2*)(AUP + (size_t)rb_ * KUP + 4 * lane) = o;
          *(unsigned*)(AUP + (size_t)rb_ * KUP + 256 + 2 * lane) = pk2(d0 * rkb * kg0, d1 * rkb * kg1); }
        const int ax = lane >> 5, half = (lane >> 4) & 1, f = lane & 15;
        { const int t = ra % TB; float o = va;
          if (t >= CTXL) { const int tt = t - CTXL; const int pos = ax == 0 ? (tt >> 6) : (tt & 63); const float cs = tab[(pos * 16 + f) * 2], sn = tab[(pos * 16 + f) * 2 + 1]; o = half == 0 ? va * cs - voa * sn : va * cs + voa * sn; }
          KR[(size_t)ra * 64 + lane] = (bf16)f2bf(o); }
        if (two) { const int t = rb_ % TB; float o = vb;
          if (t >= CTXL) { const int tt = t - CTXL; const int pos = ax == 0 ? (tt >> 6) : (tt & 63); const float cs = tab[(pos * 16 + f) * 2], sn = tab[(pos * 16 + f) * 2 + 1]; o = half == 0 ? vb * cs - vob * sn : vb * cs + vob * sn; }
          KR[(size_t)rb_ * 64 + lane] = (bf16)f2bf(o); }
    }
}
#define RLX_AGENT __ATOMIC_RELAXED, __HIP_MEMORY_SCOPE_AGENT
#define VM_WAIT() asm volatile("s_waitcnt vmcnt(0)" ::: "memory")
#define XB_TMO      128
#define XB_XCNT(j)  (256  + 64 * (j))
#define XB_XSUB(j)  (1280 + 64 * (j))
#define XB_XGEN(j)  (2304 + 64 * (j))
#define XB_TOP      3328
#define XB_TOPGEN   3392
#define XCD_BAR_WORDS 3456
#define XB_SPIN_CAP (1u << 18)

__device__ __forceinline__ unsigned xb_ld(unsigned* p)              { return __hip_atomic_load(p, __ATOMIC_RELAXED, __HIP_MEMORY_SCOPE_AGENT); }
__device__ __forceinline__ unsigned xb_add(unsigned* p, unsigned v) { return __hip_atomic_fetch_add(p, v, __ATOMIC_RELAXED, __HIP_MEMORY_SCOPE_AGENT); }
__device__ __forceinline__ unsigned xb_xcc_id() { return (unsigned)__builtin_amdgcn_s_getreg((3 << 11) | 20) & 0xFu; }
#define XB_SPIN(cond, bar) do { unsigned _sp = 0; while (cond) { __builtin_amdgcn_s_sleep(1); \
    if ((++_sp & 255u) == 0u) { if (xb_ld(&(bar)[XB_TMO])) break; if (_sp > XB_SPIN_CAP) { atomicAdd(&(bar)[XB_TMO], 1u); break; } } } } while (0)

struct XcdBarrier {
    unsigned* bar; unsigned x;
    volatile LAS unsigned* st;
};

__device__ __forceinline__ XcdBarrier xcd_barrier_post(unsigned* bar, volatile LAS unsigned* st) {
    XcdBarrier b; b.bar = bar; b.x = xb_xcc_id(); b.st = st;
    if (threadIdx.x == 0) (void)xb_add(&bar[XB_XCNT(b.x)], 1u);
    return b;
}
__device__ __forceinline__ void xcd_barrier_complete(unsigned* bar, unsigned x, unsigned& nloc, unsigned& nx) {
    const unsigned G = gridDim.x * gridDim.y * gridDim.z;
    unsigned sum, cnt, mine, sp = 0u;
    for (;;) {
        sum = 0u; cnt = 0u; mine = 0u;
#pragma unroll
        for (unsigned j = 0; j < 16; ++j) { const unsigned c = xb_ld(&bar[XB_XCNT(j)]); sum += c; cnt += (c > 0u) ? 1u : 0u; mine = (j == x) ? c : mine; }
        if (sum == G) break;
        __builtin_amdgcn_s_sleep(1);
        if ((++sp & 255u) == 0u) { if (xb_ld(&bar[XB_TMO])) break; if (sp > XB_SPIN_CAP) { atomicAdd(&bar[XB_TMO], 1u); break; } }
    }
    nloc = mine > 0u ? mine : 1u; nx = cnt > 0u ? cnt : 1u;
}

__device__ __forceinline__ void xcd_barrier(const XcdBarrier& b) {
    asm volatile("s_waitcnt vmcnt(0)" ::: "memory");
    __syncthreads();
    if (threadIdx.x == 0) {
        unsigned* bar = b.bar;
        __builtin_amdgcn_s_waitcnt(0);
        unsigned nloc = b.st[0], nx = b.st[1];
        if (nloc == 0u) { xcd_barrier_complete(bar, b.x, nloc, nx); b.st[0] = nloc; b.st[1] = nx; }
        const unsigned old = xb_add(&bar[XB_XSUB(b.x)], 1u);
        const unsigned gen = old / nloc;
        if (old + 1u == (gen + 1u) * nloc) {
            __builtin_amdgcn_fence(__ATOMIC_RELEASE, "agent");
            asm volatile("s_waitcnt vmcnt(0)" ::: "memory");
            const unsigned og = xb_add(&bar[XB_TOP], 1u);
            const unsigned tg = og / nx;
            if (og + 1u == (tg + 1u) * nx) xb_add(&bar[XB_TOPGEN], 1u);
            else XB_SPIN(xb_ld(&bar[XB_TOPGEN]) == tg, bar);
            __builtin_amdgcn_fence(__ATOMIC_ACQUIRE, "agent");
            xb_add(&bar[XB_XGEN(b.x)], 1u);
            asm volatile("s_waitcnt vmcnt(0)" ::: "memory");
        } else {
            XB_SPIN(xb_ld(&bar[XB_XGEN(b.x)]) == gen, bar);
            __builtin_amdgcn_fence(__ATOMIC_ACQUIRE, "agent");
            asm volatile("s_waitcnt vmcnt(0)" ::: "memory");
        }
    }
    __syncthreads();
}
constexpr int PPL = 15, N_PHASES = 1 + 2 * PPL, SKIP_PHASE = 1 + PPL;
__global__ void __launch_bounds__(NTHREADS, 2) mega_fwd(Args args) {
    extern __shared__ __attribute__((aligned(16))) unsigned char lds_raw[];
    LAS unsigned char* lds = (LAS unsigned char*)lds_raw;
    cg::grid_group grid = cg::this_grid();
    volatile LAS unsigned* MISC = (volatile LAS unsigned*)(lds + LDS_MISC);
    if (threadIdx.x < 16) MISC[threadIdx.x] = 0u;
    __syncthreads();
    XcdBarrier bar = xcd_barrier_post((unsigned*)(args.ws + WS_CTL), MISC + 8);
    for (int ph = args.ph_lo; ph < args.ph_hi; ++ph) {
        if (ph == SKIP_PHASE || ph == 1 + PPL + 11 || ph == 1 + PPL + 14 || ph == 1 + 9 || ph == 1 + PPL + 9) continue;
#define TID_DECL int tid_ = threadIdx.x; asm volatile("" : "+v"(tid_)); const int tid = tid_, lane = tid & 63, wave = __builtin_amdgcn_readfirstlane(tid >> 6); (void)tid; (void)lane; (void)wave
        int bid_ = blockIdx.x, nbl_ = gridDim.x; asm volatile("" : "+s"(bid_), "+s"(nbl_)); const int bid = bid_, nbl = nbl_;
        int zo_ = 0; asm volatile("" : "+s"(zo_));
        const ArgsV A_{&args, zo_}; unsigned char* ws = A_.ws();
        XcdBarrier barl = bar; asm volatile("" : "+s"(barl.x), "+s"(barl.bar));
        if (ph == 0) { TID_DECL; mod_phase(A_, lds, bid, nbl, tid, wave, lane); }
        else {
            const int l = (ph - 1) / PPL, k = (ph - 1) % PPL;
            if (k == 0) { TID_DECL; phase_rw_a(A_, bid, nbl, wave, lane); }
            else if (k == 1 || k == 12) { const int j = k == 12;
                pg8::Gemm g{(const pg8::bf16_t*)(ws + WS_H), (const pg8::bf16_t*)(ws + WS_W1) + (size_t)j * NW1 * DM, R, NW1, DM}; pg8::TileOrder S; S.init(0, NW1, DM, nbl, bid, 1);
                pg8::EpiSwiGLU E{(pg8::bf16_t*)(ws + WS_BIG), DFFP};
                pg8::gemm_phase<pg8::EpiSwiGLU, pg8::TileOrder, true, true>(lds, g, S, E); }
            else if (k == 2 || k == 13 || k == 10) { const int j = k == 13, sub = k == 2 ? 0 : (k == 10 ? 1 : 2);
                const pg8::bf16_t* A = (const pg8::bf16_t*)(ws + (k == 10 ? WS_H : WS_BIG));
                const pg8::bf16_t* Bt = k == 10 ? (const pg8::bf16_t*)(ws + WS_WOUT) : (const pg8::bf16_t*)(ws + WS_W2) + (size_t)j * DM * DFFP;
                const int K = k == 10 ? DM : DFFP;
                pg8::Gemm g{A, Bt, R, DM, K}; pg8::TileOrder S; S.init(1, DM, K, nbl, bid, 1);
                const bool has_next = !(l == 1 && sub == 2); const int nl = sub == 2 ? l + 1 : l, nsub = sub == 2 ? 0 : sub + 1;
                const float* modb = (const float*)(ws + WS_MOD); unsigned* cntb = (unsigned*)(ws + WS_CTL + 65536) + (size_t)((l * 3 + sub) * 2) * (68 * 64);
                pg8::EpiNormRes E{(pg8::bf16_t*)(ws + WS_Y), A_.out(), has_next ? (pg8::bf16_t*)(ws + WS_H) : nullptr,
                                  modb + (size_t)((l * 5) * NMOD + 3 * sub + 2) * DM, A_.in(I_NPOST) + (size_t)(l * 3 + sub) * DM,
                                  A_.in(I_NPRE) + (size_t)((has_next ? nl : 0) * 3 + nsub) * DM, modb + (size_t)(((has_next ? nl : 0) * 5) * NMOD + 3 * nsub + 1) * DM, modb + (size_t)(((has_next ? nl : 0) * 5) * NMOD + 3 * nsub) * DM,
                                  sub == 1 ? 1.0f : 0.5f, pg8::PanelSS{(unsigned*)(ws + WS_MS + MS_X1), cntb}, pg8::PanelSS{(unsigned*)(ws + WS_MS + MS_X2), cntb + 68 * 64}};
                pg8::gemm_phase<pg8::EpiNormRes, pg8::TileOrder, false, true>(lds, g, S, E);
                if (l == 0 || k == 2) { __syncthreads();
                    pg8::TileOrder S2; S2.init(2, DM, K, nbl, bid, k == 10 ? 4 : 11);
                    pg8::EpiSlab E2{(float*)(ws + WS_AUP)};
                    pg8::gemm_phase<pg8::EpiSlab, pg8::TileOrder, true, true>(lds, g, S2, E2); } }
            else if (k == 6) {
                pg8::Gemm g{(const pg8::bf16_t*)(ws + WS_AUP), (const pg8::bf16_t*)(ws + WS_WUP), R, NUP, KUP}; pg8::TileOrder S; S.init(3, NUP, KUP, nbl, bid, 1);
                pg8::EpiStore E{(pg8::bf16_t*)A_.out(), NUP};
                pg8::gemm_phase<pg8::EpiStore, pg8::TileOrder, true, true>(lds, g, S, E);
                if (k == 6) {
                    __syncthreads();
                    for (int u = bid; u < 512; u += nbl)
                        ml::mlstm_local((const ml::bf16*)(ws + WS_BIG), (const float*)(ws + WS_MS + MS_T), A_.in(I_CW) + (size_t)l * 3 * 1024, A_.in(I_CB) + (size_t)l * 1024,
                                        (float*)(ws + WS_HF), (float*)(ws + WS_MS + MS_NLOC), u, (char*)lds_raw); } }
            else if (k == 3 || k == 11 || k == 14) { TID_DECL; phase_rw_b(A_, l, k == 3 ? 0 : (k == 11 ? 1 : 2), bid, nbl, wave, lane); }
            else if (k == 4) {
                pg8::Gemm g{(const pg8::bf16_t*)(ws + WS_H), (const pg8::bf16_t*)(ws + WS_WIN), R, DINP, DM}; pg8::TileOrder S; S.init(0, DINP, DM, nbl, bid, 1);
                pg8::EpiP E{(pg8::bf16_t*)(ws + WS_BIG), DINP, (float*)(ws + WS_BIG + BIG_G)};
                pg8::gemm_phase<pg8::EpiP, pg8::TileOrder, true, true>(lds, g, S, E); }
            else if (k == 5) { TID_DECL; phase_rw_prep(A_, l, bid, nbl, wave, lane); }
            else if (k == 7 || k == 8) {
                if (k == 7) { TID_DECL; ml::mlstm_scan((const float*)(ws + WS_HF), (const float*)(ws + WS_MS + MS_NLOC), (const float*)(ws + WS_MS + MS_SCA), (ml::bf16*)(ws + WS_AUP), (float*)(ws + WS_MS + MS_NST), (float*)(ws + WS_MS + MS_BM), bid * NTHREADS + tid, nbl * NTHREADS); }
                att::bf16* QKV = (att::bf16*)A_.out(); const att::bf16* KR = (const att::bf16*)(ws + WS_BIG + BIG_KR);
                const float* tab = (const float*)(ws + WS_TAB);
                int u0, u1;
                if (k == 8) { u0 = bid; u1 = 256; } else { u0 = (l == 0 && bid >= 128) ? 256 + (bid - 128) : 272; u1 = 272; }
                for (int u = u0; u < u1; u += nbl) {
                    int b, h, seq, rope, qtok0; size_t rq;
                    if (u < 256) { b = u >> 6; h = (u >> 4) & 3; const int qb = u & 15; rq = (size_t)b * TB + CTXL + (size_t)qb * 256; seq = TB; rope = 1; qtok0 = qb * 256; }
                    else { b = (u - 256) >> 2; h = (u - 256) & 3; rq = (size_t)b * TB; seq = CTXL; rope = 0; qtok0 = 0; }
                    const size_t r0 = (size_t)b * TB;
                    const int panel = u < 256 ? (b * 16 + (u & 15)) : (64 + b);
                    att::attn_body(QKV + rq * NUP + h * 192, QKV + r0 * NUP + 768 + h * 256, QKV + r0 * NUP + 768 + h * 256 + 128, KR + r0 * 64, (att::bf16*)(ws + WS_H) + rq * DM + h * 128, seq, rope, qtok0, tab, (char*)lds_raw,
                                   (unsigned*)(ws + WS_MS + MS_X1) + rq * 4, (unsigned*)(ws + WS_CTL + 65536) + (size_t)(12 + l) * (68 * 64) + 64 * panel, A_.in(I_AON) + l * 512 + h * 128, h);
                }
                const int m0 = nbl - 1 - bid, m1 = (k == 8) ? 256 : ((l == 0) ? 16 : 0);
                for (int u = m0; u < m1; u += nbl) { const int bh = (k == 8) ? (u >> 4) : u, tbk = (k == 8) ? 1 + (u & 15) : 0;
                    ml::mlstm_out2((const ml::bf16*)(ws + WS_BIG), (const float*)(ws + WS_MS + MS_T), A_.in(I_CW) + (size_t)l * 3 * 1024, A_.in(I_CB) + (size_t)l * 1024, (const ml::bf16*)(ws + WS_AUP),
                                   (const float*)(ws + WS_MS + MS_NST), (const float*)(ws + WS_MS + MS_BM), A_.in(I_MN) + l * 512, (ml::bf16*)(ws + WS_H), bh >> 2, bh & 3, tbk, (char*)lds_raw); }
            }
        }
        {
            int wl = 0, wparts = 0, wg0 = 0;
            switch (ph) {
                case 0:       wl = 0; wparts = 0x11; wg0 = 0;   break;
                case 1 + 1:   wl = 0; wparts = 0x04; wg0 = 216; break;
                case 1 + 4:   wl = 0; wparts = 0x60; wg0 = 168; break;
                case 1 + 7:   wl = 0; wparts = 0x0a; wg0 = 144; break;
                case 1 + 12:  wl = 1; wparts = 0x04; wg0 = 216; break;
                case 1 + 14:  wl = 1; wparts = 0x61; wg0 = 0;   break;
                case 16 + 1:  wl = 1; wparts = 0x10; wg0 = 216; break;
                case 16 + 4:  wl = 1; wparts = 0x02; wg0 = 168; break;
                case 16 + 7:  wl = 1; wparts = 0x08; wg0 = 128; break;
                default: break; }
            const int wg1 = (ph == 1 + 7) ? 240 : nbl;
            if (wparts != 0 && bid >= wg0 && bid < wg1) { TID_DECL; __syncthreads(); wconv_layer(A_, wl, lds, bid - wg0, wg1 - wg0, wave, lane, wparts); } }
        if (ph + 1 < args.ph_hi) { if (args.ph_hi < 0) grid.sync(); else xcd_barrier(barl); }
    }
}

#ifndef MK_ONE_LAUNCH
#define MK_ONE_LAUNCH 1
#endif
extern "C" void kernel_launch(void* const* d_in, const int* in_sizes, int n_in, void* d_out, int out_size, void* d_ws, size_t ws_size, hipStream_t stream) {
    static int grid = 0;
    if (grid == 0) {
        if (n_in != 22 || in_sizes[0] != NB * SEQ * DM || out_size != NB * SEQ * DM || ws_size < WS_END) { fprintf(stderr, "kernel_launch: shape/workspace mismatch (n_in %d, in0 %d, out %d, ws %zu need %zu)\n", n_in, n_in > 0 ? in_sizes[0] : -1, out_size, ws_size, (size_t)WS_END); grid = -1; return; }
        int dev = 0, cus = 0, per_cu = 0;
        if (hipGetDevice(&dev) != hipSuccess || hipDeviceGetAttribute(&cus, hipDeviceAttributeMultiprocessorCount, dev) != hipSuccess) { grid = -1; return; }
        if (hipFuncSetAttribute((const void*)mega_fwd, hipFuncAttributeMaxDynamicSharedMemorySize, LDS_BYTES) != hipSuccess) { fprintf(stderr, "kernel_launch: hipFuncSetAttribute failed\n"); grid = -1; return; }
        if (hipOccupancyMaxActiveBlocksPerMultiprocessor(&per_cu, (const void*)mega_fwd, NTHREADS, LDS_BYTES) != hipSuccess || per_cu < 1) { fprintf(stderr, "kernel_launch: occupancy query says %d\n", per_cu); per_cu = 1; }
        (void)hipGetLastError();
        grid = cus * (per_cu > 1 ? 1 : per_cu);
    }
    if (grid < 0) return;
    if (hipMemsetAsync((char*)d_ws + WS_CTL, 0, 65536 + 14 * 68 * 256, stream) != hipSuccess) { fprintf(stderr, "kernel_launch: memset of the barrier words failed\n"); return; }
    Args a{};
    for (int i = 0; i < 22; ++i) a.in[i] = (const float*)d_in[i];
    a.out = (float*)d_out; a.ws = (unsigned char*)d_ws;
#if MK_ONE_LAUNCH
    a.ph_lo = 0; a.ph_hi = N_PHASES;
    void* kargs[] = {&a};
    hipError_t e = hipLaunchCooperativeKernel((const void*)mega_fwd, dim3(grid), dim3(NTHREADS), kargs, LDS_BYTES, stream);
    if (e != hipSuccess) fprintf(stderr, "kernel_launch: cooperative launch failed: %s (grid %d)\n", hipGetErrorString(e), grid);
#else
    for (int ph = 0; ph < N_PHASES; ++ph) { if (ph == SKIP_PHASE) continue; a.ph_lo = ph; a.ph_hi = ph + 1;
        hipLaunchKernelGGL(mega_fwd, dim3(grid), dim3(NTHREADS), LDS_BYTES, stream, a);
        const hipError_t le = hipPeekAtLastError(); if (le != hipSuccess) { fprintf(stderr, "kernel_launch: launch of phase %d failed: %s\n", ph, hipGetErrorName(le)); break; } }
#endif
}
```

```cpp
#include <hip/hip_runtime.h>
#include <hip/hip_cooperative_groups.h>
#include <cstdio>
#include <cstdint>
namespace cg = cooperative_groups;
namespace pg8 {
#define PG8_LAS __attribute__((address_space(3)))
typedef unsigned short bf16_t;
typedef short bf16x8 __attribute__((ext_vector_type(8)));
typedef float f32x4 __attribute__((ext_vector_type(4)));
typedef unsigned u32x4 __attribute__((ext_vector_type(4)));
constexpr int BM = 256, BK = 64, HALF = 128, HTB = HALF * BK * 2  , STAGE_BYTES = 8 * HTB, NXCD = 8, WGM = 8;

__host__ __device__ __forceinline__ int lds_byte(int r, int c) { const int st = (r >> 4) * 2 + (c >> 5), rr = r & 15, cc = c & 31, ob = rr * 64 + cc * 2; return st * 1024 + (ob ^ (((ob >> 9) & 1) << 5)); }
__host__ __device__ __forceinline__ void stage_rc(int b, int& R, int& C) { const int st = b / 1024, sb = b % 1024, swz = sb ^ (((sb >> 9) & 1) << 5); R = (st >> 1) * 16 + swz / 64; C = (st & 1) * 32 + (swz % 64) / 2; }
__host__ __device__ __forceinline__ int perm32(int rho) { const int n = rho >> 4, i = rho & 15; return 8 * (i >> 2) + 4 * n + (i & 3); }

struct Unit { int pm, pn, kt0, nkt; };
struct Gemm { const bf16_t* A; const bf16_t* Bt; int M, N, K; };

struct StaticOrder {
    int nM, nN, nwg, G, c, nkt;
    __host__ __device__ void init(int M, int N, int K, int G_, int c_) { nM = M / BM; nN = N / BM; nwg = nM * nN; G = G_; c = c_; nkt = K / BK; }
    __host__ __device__ bool next(int i, Unit& u) const {
        const long L = (long)i * G + c; if (L >= nwg) return false;
        int wgid = (int)L; { const int q = nwg / NXCD, r = nwg % NXCD, xcd = wgid % NXCD, off = wgid / NXCD; wgid = (xcd < r ? xcd * (q + 1) : r * (q + 1) + (xcd - r) * q) + off; }
        const int nig = WGM * nN, gid = wgid / nig, fm = gid * WGM, gsz = (nM - fm) < WGM ? (nM - fm) : WGM;
        u.pm = fm + ((wgid % nig) % gsz); u.pn = (wgid % nig) / gsz; u.kt0 = 0; u.nkt = nkt; return true;
    }
    __device__ __forceinline__ void a_ready(const Unit&) const {}
    __device__ __forceinline__ void done(const Unit&) const {}
};

__device__ __forceinline__ unsigned cvt_pk_bf16(float lo, float hi) { unsigned r; asm volatile("v_cvt_pk_bf16_f32 %0, %1, %2" : "=v"(r) : "v"(lo), "v"(hi)); return r; }
typedef float f32x2 __attribute__((ext_vector_type(2)));
__device__ __forceinline__ f32x2 gelu_pk(f32x2 v) {
    const f32x2 av = __builtin_elementwise_abs(v), d = av * 0.2316418882f + 1.0f;
    f32x2 t; t.x = __builtin_amdgcn_rcpf(d.x); t.y = __builtin_amdgcn_rcpf(d.y);
    f32x2 q = t * 0.5307027145f + (-0.7265760135f); q = q * t + 0.7107068705f; q = q * t + (-0.142248368f); q = q * t + 0.127414796f; q = q * t;
    const f32x2 s = (v * v) * (-0.72134752044f);
    f32x2 e; e.x = __builtin_amdgcn_exp2f(s.x); e.y = __builtin_amdgcn_exp2f(s.y);
    const f32x2 m = v * (q * e), r = v - m;
    f32x2 o; o.x = v.x < 0.f ? m.x : r.x; o.y = v.y < 0.f ? m.y : r.y; return o;
}
__device__ __forceinline__ float silu_f(float x) { return x * __builtin_amdgcn_rcpf(1.0f + __builtin_amdgcn_exp2f(-1.4426950408889634f * x)); }
__device__ __forceinline__ void st8(bf16_t* p, f32x4 v0, f32x4 v1) { u32x4 w; w.x = cvt_pk_bf16(v0[0], v0[1]); w.y = cvt_pk_bf16(v0[2], v0[3]); w.z = cvt_pk_bf16(v1[0], v1[1]); w.w = cvt_pk_bf16(v1[2], v1[3]); *(u32x4*)p = w; }
struct EpiStore {
    static constexpr bool PERM = true, AFTER_DRAIN = false;
    bf16_t* O; int ldc;
    __device__ __forceinline__ void operator()(const f32x4 (&acc)[2][2][4][2], const Unit& u, int wr, int wc, int fr, int fq) const {
        const int row0 = u.pm * BM + wr * 64 + fr, col0 = u.pn * BM + wc * 32 + 8 * fq;
#pragma unroll
        for (int ai = 0; ai < 2; ++ai)
#pragma unroll
            for (int m = 0; m < 4; ++m) { bf16_t* rowp = O + (size_t)(row0 + ai * HALF + m * 16) * ldc + col0;
#pragma unroll
                for (int bj = 0; bj < 2; ++bj) st8(rowp + bj * HALF, acc[ai][bj][m][0], acc[ai][bj][m][1]); }
    }
};
struct EpiSwiGLU {
    static constexpr bool PERM = true, AFTER_DRAIN = false;
    bf16_t* O; int ldc;
    __device__ __forceinline__ void operator()(const f32x4 (&acc)[2][2][4][2], const Unit& u, int wr, int wc, int fr, int fq) const {
        const int row0 = u.pm * BM + wr * 64 + fr, col0 = u.pn * HALF + wc * 32 + 8 * fq;
#pragma unroll
        for (int ai = 0; ai < 2; ++ai)
#pragma unroll
            for (int m = 0; m < 4; ++m) { bf16_t* rowp = O + (size_t)(row0 + ai * HALF + m * 16) * ldc + col0;
                f32x4 v0, v1;
#pragma unroll
                for (int j = 0; j < 4; ++j) { v0[j] = silu_f(acc[ai][0][m][0][j]) * acc[ai][1][m][0][j]; v1[j] = silu_f(acc[ai][0][m][1][j]) * acc[ai][1][m][1][j]; }
                st8(rowp, v0, v1); }
    }
};
struct EpiP {
    static constexpr bool PERM = true, AFTER_DRAIN = false;
    bf16_t* O; int ldc; float* G;
    __device__ __forceinline__ void operator()(const f32x4 (&acc)[2][2][4][2], const Unit& u, int wr, int wc, int fr, int fq) const {
        const int row0 = u.pm * BM + wr * 64 + fr, col0 = u.pn * BM + wc * 32 + 8 * fq;
        const bool gt = (u.pn == 9) && (wc == 2) && (fq < 2);
#pragma unroll
        for (int ai = 0; ai < 2; ++ai)
#pragma unroll
            for (int m = 0; m < 4; ++m) { const int row = row0 + ai * HALF + m * 16; bf16_t* rowp = O + (size_t)row * ldc + col0;
#pragma unroll
                for (int bj = 0; bj < 2; ++bj) st8(rowp + bj * HALF, acc[ai][bj][m][0], acc[ai][bj][m][1]);
                if (gt) { *(f32x4*)(G + (size_t)row * 16 + 8 * fq) = acc[ai][1][m][0]; *(f32x4*)(G + (size_t)row * 16 + 8 * fq + 4) = acc[ai][1][m][1]; } }
    }
};
struct EpiSlab {
    static constexpr bool PERM = false, AFTER_DRAIN = false;
    bf16_t* S;
    __device__ __forceinline__ void operator()(const f32x4 (&acc)[2][2][4][2], const Unit& u, int wr, int wc, int fr, int fq) const {
        typedef unsigned u32x2s __attribute__((ext_vector_type(2)));
        const int row0 = (u.pm / 17) * BM + wr * 64 + fr, col0 = u.pn * BM + wc * 32 + 4 * fq; const int slice = u.kt0 / u.nkt;
        bf16_t* base = S + (size_t)slice * 1024 * 1024;
#pragma unroll
        for (int ai = 0; ai < 2; ++ai)
#pragma unroll
            for (int m = 0; m < 4; ++m) { bf16_t* rowp = base + (size_t)(row0 + ai * HALF + m * 16) * 1024 + col0;
#pragma unroll
                for (int bj = 0; bj < 2; ++bj)
#pragma unroll
                    for (int n = 0; n < 2; ++n) { const f32x4 v = acc[ai][bj][m][n]; u32x2s o; o.x = cvt_pk_bf16(v[0], v[1]); o.y = cvt_pk_bf16(v[2], v[3]); *(u32x2s*)(rowp + bj * HALF + n * 16) = o; } }
    }
};
struct TileOrder {
    int mode, nM, nN, nwg, G, c, nkt, nsl;
    __device__ void init(int mode_, int N, int K, int G_, int c_, int nsl_) { mode = mode_; nN = N / BM; G = G_; c = c_; nsl = nsl_;
        if (mode == 2) { nM = 4; nwg = 4 * nN * nsl; nkt = (K / BK) / nsl; } else { nM = mode == 1 ? 64 : 68; nwg = nM * nN; nkt = K / BK; } }
    __device__ bool next(int i, Unit& u) const {
        const long L = (long)i * G + c; if (L >= nwg) return false;
        if (mode == 2) { const int sl = (int)L % nsl, t = (int)L / nsl; u.pn = t % nN; u.pm = 17 * (t / nN); u.kt0 = sl * nkt; u.nkt = nkt; return true; }
        int wgid = (int)L; { const int q = nwg / NXCD, r = nwg % NXCD, xcd = wgid % NXCD, off = wgid / NXCD; wgid = (xcd < r ? xcd * (q + 1) : r * (q + 1) + (xcd - r) * q) + off; }
        const int nig = WGM * nN, gid = wgid / nig, fm = gid * WGM, gsz = (nM - fm) < WGM ? (nM - fm) : WGM;
        int pm = fm + ((wgid % nig) % gsz); u.pn = (wgid % nig) / gsz; if (mode == 1) pm += (pm >> 4) + 1;
        u.pm = pm; u.kt0 = 0; u.nkt = nkt;
        if (mode == 3) { if (u.pn < 3) { u.kt0 = 0; u.nkt = 4; } else { u.kt0 = 4; u.nkt = 2; } }
        return true;
    }
    __device__ __forceinline__ void a_ready(const Unit&) const {}
    __device__ __forceinline__ void done(const Unit&) const {}
};

struct PanelSS {
    unsigned* xbuf;
    unsigned* cnt;
    __device__ __forceinline__ void run(const f32x4 (&v)[2][2][4][2], const Unit& u, int wr, int wc, int fr, int fq, PG8_LAS unsigned char* lds, int wid, int lane) const {
        PG8_LAS float* P = (PG8_LAS float*)lds;
        PG8_LAS float* S = (PG8_LAS float*)(lds + 8192);
#pragma unroll
        for (int ai = 0; ai < 2; ++ai)
#pragma unroll
            for (int m = 0; m < 4; ++m) { float s = 0.f;
#pragma unroll
                for (int bj = 0; bj < 2; ++bj)
#pragma unroll
                    for (int n = 0; n < 2; ++n) { const f32x4 x = v[ai][bj][m][n]; s += (x[0] * x[0] + x[1] * x[1]) + (x[2] * x[2] + x[3] * x[3]); }
                s += __shfl_xor(s, 16); s += __shfl_xor(s, 32);
                if (fq == 0) P[(ai * HALF + wr * 64 + m * 16 + fr) * 4 + wc] = s; }
        asm volatile("s_waitcnt lgkmcnt(0)" ::: "memory"); __builtin_amdgcn_s_barrier(); asm volatile("" ::: "memory");
        const int row = wid * 32 + (lane & 31);
        if (lane < 32) { const float t = (P[row * 4 + 0] + P[row * 4 + 1]) + (P[row * 4 + 2] + P[row * 4 + 3]);
            __hip_atomic_store(xbuf + (size_t)(u.pm * BM + row) * 4 + u.pn, __float_as_uint(t), __ATOMIC_RELAXED, __HIP_MEMORY_SCOPE_AGENT); }
        asm volatile("s_waitcnt vmcnt(0)" ::: "memory");
        if (lane == 0) __hip_atomic_fetch_add(cnt + 64 * u.pm, 1u, __ATOMIC_RELAXED, __HIP_MEMORY_SCOPE_AGENT);
        if (wid == 0) { unsigned sp = 0;
            while ((unsigned)__builtin_amdgcn_readfirstlane(__hip_atomic_load(cnt + 64 * u.pm, __ATOMIC_RELAXED, __HIP_MEMORY_SCOPE_AGENT)) < 32u) { __builtin_amdgcn_s_sleep(2); if (++sp > (1u << 22)) break; }
            __builtin_amdgcn_fence(__ATOMIC_ACQUIRE, "agent"); }
        asm volatile("s_waitcnt vmcnt(0) lgkmcnt(0)" ::: "memory"); __builtin_amdgcn_s_barrier(); asm volatile("" ::: "memory");
        if (lane < 32) { const unsigned* slot = xbuf + (size_t)(u.pm * BM + row) * 4; float t = 0.f;
#pragma unroll
            for (int q = 0; q < 4; ++q) t += __uint_as_float(__hip_atomic_load(slot + q, __ATOMIC_RELAXED, __HIP_MEMORY_SCOPE_AGENT));
            S[row] = t; }
        asm volatile("s_waitcnt lgkmcnt(0)" ::: "memory"); __builtin_amdgcn_s_barrier(); asm volatile("" ::: "memory");
    }
};
#ifdef EPI_PROBE
__device__ unsigned long long* g_prof_ptr; __device__ int g_prof_on;
#define EPI_CP(n) do { if (EPI_PROBE == (n) && blockIdx.x == EPI_PROBE_BLK && threadIdx.x == 0 && g_prof_on) { *g_prof_ptr += __builtin_amdgcn_s_memrealtime() - tp0_; } } while (0)
#else
#define EPI_CP(n) do { } while (0)
#endif
struct EpiNormRes {
    static constexpr bool PERM = false, AFTER_DRAIN = true;
    bf16_t* xb; float* xout;
    bf16_t* H;
    const float* gate; const float* gpost;
    const float* gpre; const float* sc; const float* sh;
    float wgt, wpad; PanelSS st;
    static constexpr int XT = 8192;
    __device__ __forceinline__ void fused(f32x4 (&acc)[2][2][4][2], const Unit& u, int wr, int wc, int fr, int fq, PG8_LAS unsigned char* lds, int wid, int lane) const {
        typedef unsigned u32x2r __attribute__((ext_vector_type(2))); typedef float f32x2r __attribute__((ext_vector_type(2)));
        PG8_LAS f32x2r* P = (PG8_LAS f32x2r*)lds;
        PG8_LAS float* S1 = (PG8_LAS float*)lds;
        PG8_LAS float* S2 = (PG8_LAS float*)(lds + 1024);
        const int b = u.pm / 17, tp = (u.pm - 17 * b - 1) * BM;
        const int col0 = u.pn * BM + wc * 32 + 4 * fq; const size_t mo = (size_t)b * 9 * 1024;
#ifdef EPI_PROBE
        const unsigned long long tp0_ = __builtin_amdgcn_s_memrealtime();
#endif
        unsigned* const xs4 = st.xbuf; unsigned* const cnt = st.cnt; bf16_t* const xb_ = xb; float* const xout_ = xout; bf16_t* const H_ = H; float wgt_ = wgt; asm volatile("" : "+v"(wgt_));
        const float* const gate_ = gate; const float* const gpost_ = gpost; const float* const gpre_ = gpre; const float* const sc_ = sc; const float* const sh_ = sh;
        {   const int rr = lane >> 5, p = lane & 31;
#pragma unroll
            for (int i = 0; i < 16; ++i) { const int r = 2 * (wid * 16 + i) + rr; const int c = p ^ (2 * (r & 15));
                __builtin_amdgcn_global_load_lds((const unsigned*)(xb_ + ((size_t)b * 4096 + tp + r) * 1024 + u.pn * BM + 8 * c), (PG8_LAS unsigned*)(lds + XT + (wid * 16 + i) * 1024), 16, 0, 0); } }
        const int xoff = XT + fr * 512 + (fq & 1) * 8, xsw = 2 * fr, cbase = wc * 4 + (fq >> 1);
        {   f32x4 cg[2][2];
#pragma unroll
            for (int bj = 0; bj < 2; ++bj)
#pragma unroll
                for (int n = 0; n < 2; ++n) cg[bj][n] = *(const f32x4*)(gate_ + mo + col0 + bj * HALF + n * 16) * *(const f32x4*)(gpost_ + col0 + bj * HALF + n * 16) * wgt_;
#pragma unroll
            for (int ai = 0; ai < 2; ++ai)
#pragma unroll
                for (int m = 0; m < 4; ++m) { float sD = 0.f, sC = 0.f;
#pragma unroll
                    for (int bj = 0; bj < 2; ++bj)
#pragma unroll
                        for (int n = 0; n < 2; ++n) { const f32x4 y = acc[ai][bj][m][n]; const f32x4 yp = cg[bj][n] * y; acc[ai][bj][m][n] = yp;
                            sD += (y[0] * y[0] + y[1] * y[1]) + (y[2] * y[2] + y[3] * y[3]); sC += (yp[0] * yp[0] + yp[1] * yp[1]) + (yp[2] * yp[2] + yp[3] * yp[3]); }
                    sD += __shfl_xor(sD, 16); sC += __shfl_xor(sC, 16); sD += __shfl_xor(sD, 32); sC += __shfl_xor(sC, 32);
                    if (fq == 0) P[(ai * HALF + wr * 64 + m * 16 + fr) * 4 + wc] = (f32x2r){sD, sC}; } }
        asm volatile("s_waitcnt vmcnt(0) lgkmcnt(0)" ::: "memory"); __builtin_amdgcn_s_barrier(); asm volatile("" ::: "memory");
        EPI_CP(1);
        const int row = wid * 32 + (lane & 31);
        f32x2r t1 = (f32x2r){0.f, 0.f}, t2 = (f32x2r){0.f, 0.f};
        if (lane < 32) t1 = (P[row * 4 + 0] + P[row * 4 + 1]) + (P[row * 4 + 2] + P[row * 4 + 3]);
        asm volatile("s_waitcnt lgkmcnt(0)" ::: "memory"); __builtin_amdgcn_s_barrier(); asm volatile("" ::: "memory");
#pragma unroll
        for (int ai = 0; ai < 2; ++ai)
#pragma unroll
            for (int m = 0; m < 4; ++m) { float sB = 0.f, sA = 0.f; const int rb = (ai * HALF + wr * 64 + m * 16) * 512;
#pragma unroll
                for (int bj = 0; bj < 2; ++bj)
#pragma unroll
                    for (int n = 0; n < 2; ++n) { const f32x4 yp = acc[ai][bj][m][n]; const u32x2r w = *(const PG8_LAS u32x2r*)(lds + xoff + rb + 16 * ((cbase + 16 * bj + 2 * n) ^ xsw));
                        const float x0 = __uint_as_float(w.x << 16), x1 = __uint_as_float(w.x & 0xffff0000u), x2 = __uint_as_float(w.y << 16), x3 = __uint_as_float(w.y & 0xffff0000u);
                        sB += (x0 * yp[0] + x1 * yp[1]) + (x2 * yp[2] + x3 * yp[3]); sA += (x0 * x0 + x1 * x1) + (x2 * x2 + x3 * x3); }
                sB += __shfl_xor(sB, 16); sA += __shfl_xor(sA, 16); sB += __shfl_xor(sB, 32); sA += __shfl_xor(sA, 32);
                if (fq == 0) P[(ai * HALF + wr * 64 + m * 16 + fr) * 4 + wc] = (f32x2r){sB, sA}; }
        asm volatile("s_waitcnt lgkmcnt(0)" ::: "memory"); __builtin_amdgcn_s_barrier(); asm volatile("" ::: "memory");
        EPI_CP(2);
        if (lane < 32) { t2 = (P[row * 4 + 0] + P[row * 4 + 1]) + (P[row * 4 + 2] + P[row * 4 + 3]); unsigned* slot = xs4 + ((size_t)(u.pm * BM + row) * 4 + u.pn) * 4;
            __hip_atomic_store(slot + 0, __float_as_uint(t1[0]), __ATOMIC_RELAXED, __HIP_MEMORY_SCOPE_AGENT); __hip_atomic_store(slot + 1, __float_as_uint(t1[1]), __ATOMIC_RELAXED, __HIP_MEMORY_SCOPE_AGENT);
            __hip_atomic_store(slot + 2, __float_as_uint(t2[0]), __ATOMIC_RELAXED, __HIP_MEMORY_SCOPE_AGENT); __hip_atomic_store(slot + 3, __float_as_uint(t2[1]), __ATOMIC_RELAXED, __HIP_MEMORY_SCOPE_AGENT); }
        asm volatile("s_waitcnt vmcnt(0)" ::: "memory");
        if (lane == 0) __hip_atomic_fetch_add(cnt + 64 * u.pm, 1u, __ATOMIC_RELAXED, __HIP_MEMORY_SCOPE_AGENT);
        if (wid == 0) { unsigned sp = 0;
            while ((unsigned)__builtin_amdgcn_readfirstlane(__hip_atomic_load(cnt + 64 * u.pm, __ATOMIC_RELAXED, __HIP_MEMORY_SCOPE_AGENT)) < 32u) { __builtin_amdgcn_s_sleep(2); if (++sp > (1u << 22)) break; }
            __builtin_amdgcn_fence(__ATOMIC_ACQUIRE, "agent"); }
        asm volatile("s_waitcnt vmcnt(0) lgkmcnt(0)" ::: "memory"); __builtin_amdgcn_s_barrier(); asm volatile("" ::: "memory");
        EPI_CP(3);
        if (lane < 32) { const unsigned* slot = xs4 + (size_t)(u.pm * BM + row) * 16; float tD = 0.f, tC = 0.f, tB = 0.f, tA = 0.f;
#pragma unroll
            for (int q = 0; q < 4; ++q) { tD += __uint_as_float(__hip_atomic_load(slot + 4 * q + 0, __ATOMIC_RELAXED, __HIP_MEMORY_SCOPE_AGENT)); tC += __uint_as_float(__hip_atomic_load(slot + 4 * q + 1, __ATOMIC_RELAXED, __HIP_MEMORY_SCOPE_AGENT));
                tB += __uint_as_float(__hip_atomic_load(slot + 4 * q + 2, __ATOMIC_RELAXED, __HIP_MEMORY_SCOPE_AGENT)); tA += __uint_as_float(__hip_atomic_load(slot + 4 * q + 3, __ATOMIC_RELAXED, __HIP_MEMORY_SCOPE_AGENT)); }
            const float r1 = 1.0f / sqrtf(tD * (1.0f / 1024.0f) + 1e-6f); const float ss = tA + r1 * (2.0f * tB + r1 * tC);
            S1[row] = r1; S2[row] = 1.0f / sqrtf(ss * (1.0f / 1024.0f) + 1e-6f); }
        asm volatile("s_waitcnt lgkmcnt(0)" ::: "memory"); __builtin_amdgcn_s_barrier(); asm volatile("" ::: "memory");
        EPI_CP(4);
        if (H_ == nullptr) {
#pragma unroll
            for (int ai = 0; ai < 2; ++ai)
#pragma unroll
                for (int m = 0; m < 4; ++m) { const int r = ai * HALF + wr * 64 + m * 16 + fr; const float r1 = S1[r]; const size_t off = ((size_t)b * 4096 + tp + r) * 1024 + col0; const int rb = (r - fr) * 512;
#pragma unroll
                    for (int bj = 0; bj < 2; ++bj)
#pragma unroll
                        for (int n = 0; n < 2; ++n) { const u32x2r w = *(const PG8_LAS u32x2r*)(lds + xoff + rb + 16 * ((cbase + 16 * bj + 2 * n) ^ xsw));
                            f32x4 xo; xo[0] = __uint_as_float(w.x << 16); xo[1] = __uint_as_float(w.x & 0xffff0000u); xo[2] = __uint_as_float(w.y << 16); xo[3] = __uint_as_float(w.y & 0xffff0000u);
                            *(f32x4*)(xout_ + off + bj * HALF + n * 16) = xo + acc[ai][bj][m][n] * r1; } }
            EPI_CP(5);
            return; }
#pragma unroll
        for (int bj = 0; bj < 2; ++bj) { f32x4 ca[2], cs[2];
#pragma unroll
            for (int n = 0; n < 2; ++n) { const int c = col0 + bj * HALF + n * 16; ca[n] = *(const f32x4*)(gpre_ + c) * (*(const f32x4*)(sc_ + mo + c) + 1.0f); cs[n] = *(const f32x4*)(sh_ + mo + c); }
#pragma unroll
            for (int ai = 0; ai < 2; ++ai)
#pragma unroll
                for (int m = 0; m < 4; ++m) { const int r = ai * HALF + wr * 64 + m * 16 + fr; const float r1 = S1[r], r2 = S2[r]; const size_t off = ((size_t)b * 4096 + tp + r) * 1024 + col0 + bj * HALF; const int rb = (r - fr) * 512;
                    bf16_t* hp = H_ + (size_t)(u.pm * BM + r) * 1024 + col0 + bj * HALF;
#pragma unroll
                    for (int n = 0; n < 2; ++n) { const u32x2r w = *(const PG8_LAS u32x2r*)(lds + xoff + rb + 16 * ((cbase + 16 * bj + 2 * n) ^ xsw));
                        f32x4 xo; xo[0] = __uint_as_float(w.x << 16); xo[1] = __uint_as_float(w.x & 0xffff0000u); xo[2] = __uint_as_float(w.y << 16); xo[3] = __uint_as_float(w.y & 0xffff0000u);
                        const f32x4 xn = xo + acc[ai][bj][m][n] * r1; u32x2r o; o.x = cvt_pk_bf16(xn[0], xn[1]); o.y = cvt_pk_bf16(xn[2], xn[3]); *(u32x2r*)(xb_ + off + n * 16) = o;
                        const f32x4 hv = xn * r2 * ca[n] + cs[n]; u32x2r q; q.x = cvt_pk_bf16(hv[0], hv[1]); q.y = cvt_pk_bf16(hv[2], hv[3]); *(u32x2r*)(hp + n * 16) = q; } } }
        EPI_CP(5);
    }
};

template <class Epi, class Sched, bool ALIGN_EPI = false, bool SP2 = false>
__device__ __forceinline__ void gemm_phase(PG8_LAS unsigned char* lds, const Gemm g, const Sched& S, const Epi& E) {
    int tid_ = threadIdx.x; asm volatile("" : "+v"(tid_));
    const int tid = tid_, wid = __builtin_amdgcn_readfirstlane(tid >> 6), lane = tid & 63, wr = wid >> 2, wc = wid & 3, fr = lane & 15, fq = lane >> 4;
    const int K = g.K;
    unsigned voffA[2], voffB[2];
#pragma unroll
    for (int i = 0; i < 2; ++i) { int R, C; stage_rc(tid * 16 + i * 8192, R, C); const int Rb = Epi::PERM ? ((R & ~31) + perm32(R & 31)) : R;
        voffA[i] = (unsigned)(R * K + C) * 2u; voffB[i] = (unsigned)(Rb * K + C) * 2u; }
    const size_t kstep = (size_t)(BK * 2);
    const size_t hstep = (size_t)HALF * K * 2;
    const size_t tstep = 2 * hstep;
    const unsigned ldsw = (unsigned)wid * 1024u;
    const int aoff = lds_byte(wr * 64 + fr, fq * 8), boff = lds_byte(wc * 32 + fr, fq * 8);
#define PG8_SA(b, h) (((b) * 2 + (h)) * HTB)
#define PG8_SB(b, h) ((4 + (b) * 2 + (h)) * HTB)
#define PG8_STAGE(bufoff, gbase, voff) do { _Pragma("unroll") for (int _i = 0; _i < 2; ++_i) \
        __builtin_amdgcn_global_load_lds((const unsigned*)((const char*)(gbase) + (voff)[_i]), (PG8_LAS unsigned*)(lds + (bufoff) + ldsw + _i * 8192), 16, 0, 0); } while (0)
#define PG8_LDA(dst, b, h) do { _Pragma("unroll") for (int m = 0; m < 4; ++m) _Pragma("unroll") for (int k = 0; k < 2; ++k) dst[m][k] = *(const PG8_LAS bf16x8*)(lds + PG8_SA(b, h) + aoff + m * 2048 + k * 1024); } while (0)
#define PG8_LDB(dst, b, h) do { _Pragma("unroll") for (int n = 0; n < 2; ++n) _Pragma("unroll") for (int k = 0; k < 2; ++k) dst[n][k] = *(const PG8_LAS bf16x8*)(lds + PG8_SB(b, h) + boff + n * 2048 + k * 1024); } while (0)
#define PG8_MMA(ai, bj, At, Bt) do { __builtin_amdgcn_s_setprio(1); _Pragma("unroll") for (int m = 0; m < 4; ++m) _Pragma("unroll") for (int n = 0; n < 2; ++n) _Pragma("unroll") for (int k = 0; k < 2; ++k) \
        acc[ai][bj][m][n] = __builtin_amdgcn_mfma_f32_16x16x32_bf16(Bt[n][k], At[m][k], acc[ai][bj][m][n], 0, 0, 0); __builtin_amdgcn_s_setprio(0); } while (0)
#define PG8_WAIT_V(n) asm volatile("s_waitcnt vmcnt(" #n ")" ::: "memory")
#define PG8_WAIT_L(n) asm volatile("s_waitcnt lgkmcnt(" #n ")" ::: "memory")
#define PG8_BAR __builtin_amdgcn_s_barrier()
#define PG8_SCHED __builtin_amdgcn_sched_barrier(0)
    Unit cur, nxt; int ui = 0;
    if (!S.next(0, cur)) return;
    f32x4 acc[2][2][4][2];
#pragma unroll
    for (int a = 0; a < 2; ++a)
#pragma unroll
        for (int b = 0; b < 2; ++b)
#pragma unroll
            for (int m = 0; m < 4; ++m)
#pragma unroll
                for (int n = 0; n < 2; ++n) acc[a][b][m][n] = (f32x4){0.f, 0.f, 0.f, 0.f};
    bf16x8 At[4][2], B0[2][2], B1[2][2];
    const char* cA = (const char*)g.A + (size_t)cur.pm * tstep + (size_t)cur.kt0 * kstep; const char* cB = (const char*)g.Bt + (size_t)cur.pn * tstep + (size_t)cur.kt0 * kstep;
    S.a_ready(cur);
    if constexpr (SP2) {
        PG8_STAGE(PG8_SB(0, 0), cB, voffB); PG8_STAGE(PG8_SB(0, 1), cB + hstep, voffB); PG8_STAGE(PG8_SA(0, 0), cA, voffA); PG8_STAGE(PG8_SA(0, 1), cA + hstep, voffA);
        if (wr == 1) PG8_BAR;
        PG8_WAIT_V(2); PG8_BAR;
        PG8_STAGE(PG8_SB(1, 0), cB + kstep, voffB); PG8_STAGE(PG8_SA(1, 0), cA + kstep, voffA); PG8_STAGE(PG8_SB(1, 1), cB + hstep + kstep, voffB);
        PG8_WAIT_V(6); PG8_BAR;
    } else {
        PG8_STAGE(PG8_SB(0, 0), cB, voffB); PG8_STAGE(PG8_SA(0, 0), cA, voffA); PG8_STAGE(PG8_SB(0, 1), cB + hstep, voffB); PG8_STAGE(PG8_SA(0, 1), cA + hstep, voffA);
        if (wr == 1) PG8_BAR;
        PG8_WAIT_V(4); PG8_BAR;
        PG8_STAGE(PG8_SB(1, 0), cB + kstep, voffB); PG8_STAGE(PG8_SA(1, 0), cA + kstep, voffA); PG8_STAGE(PG8_SB(1, 1), cB + hstep + kstep, voffB);
        PG8_WAIT_V(6); PG8_BAR;
    }
    for (;;) {
        const bool has_next = S.next(ui + 1, nxt);
        const char* nA = has_next ? (const char*)g.A + (size_t)nxt.pm * tstep + (size_t)nxt.kt0 * kstep : cA; const char* nB = has_next ? (const char*)g.Bt + (size_t)nxt.pn * tstep + (size_t)nxt.kt0 * kstep : cB;
        const int nt = cur.nkt;
        for (int t = 0; t < nt; t += 2) {
            const bool last = (t == nt - 2);
            const char* a1 = cA + (size_t)(t + 1) * kstep;
            const char* a2 = last ? nA : cA + (size_t)(t + 2) * kstep; const char* b2 = last ? nB : cB + (size_t)(t + 2) * kstep;
            const char* a3 = a2 + kstep; const char* b3 = b2 + kstep;
            if (last && has_next) S.a_ready(nxt);
            if constexpr (SP2) {
            PG8_LDB(B0, 0, 0); PG8_LDB(B1, 0, 1); PG8_SCHED; PG8_LDA(At, 0, 0); PG8_STAGE(PG8_SA(1, 1), a1 + hstep, voffA);
            PG8_WAIT_V(8); PG8_WAIT_L(0); PG8_BAR; PG8_MMA(0, 0, At, B0); PG8_MMA(0, 1, At, B1); PG8_BAR; PG8_SCHED;
            PG8_LDA(At, 0, 1); PG8_STAGE(PG8_SB(0, 0), b2, voffB); PG8_STAGE(PG8_SB(0, 1), b2 + hstep, voffB); PG8_STAGE(PG8_SA(0, 0), a2, voffA);
            PG8_WAIT_V(8); PG8_WAIT_L(0); PG8_BAR; PG8_MMA(1, 0, At, B0); PG8_MMA(1, 1, At, B1); PG8_BAR; PG8_SCHED;
            PG8_LDB(B0, 1, 0); PG8_LDB(B1, 1, 1); PG8_SCHED; PG8_LDA(At, 1, 0); PG8_STAGE(PG8_SA(0, 1), a2 + hstep, voffA);
            PG8_WAIT_V(8); PG8_WAIT_L(0); PG8_BAR; PG8_MMA(0, 0, At, B0); PG8_MMA(0, 1, At, B1); PG8_BAR; PG8_SCHED;
            PG8_LDA(At, 1, 1); PG8_STAGE(PG8_SB(1, 0), b3, voffB); PG8_STAGE(PG8_SB(1, 1), b3 + hstep, voffB); PG8_STAGE(PG8_SA(1, 0), a3, voffA);
            PG8_WAIT_V(8); PG8_WAIT_L(0); PG8_BAR; PG8_MMA(1, 0, At, B0); PG8_MMA(1, 1, At, B1); PG8_BAR; PG8_SCHED;
            } else {
            PG8_LDB(B0, 0, 0); PG8_SCHED; PG8_LDA(At, 0, 0); PG8_STAGE(PG8_SA(1, 1), a1 + hstep, voffA);
            PG8_WAIT_L(8); PG8_BAR; PG8_WAIT_L(0); PG8_MMA(0, 0, At, B0); PG8_BAR; PG8_SCHED;
            PG8_LDB(B1, 0, 1); PG8_STAGE(PG8_SB(0, 0), b2, voffB);
            PG8_BAR; PG8_WAIT_L(0); PG8_MMA(0, 1, At, B1); PG8_BAR;
            PG8_LDA(At, 0, 1); PG8_STAGE(PG8_SA(0, 0), a2, voffA);
            PG8_BAR; PG8_WAIT_L(0); PG8_MMA(1, 0, At, B0); PG8_BAR; PG8_SCHED;
            PG8_STAGE(PG8_SB(0, 1), b2 + hstep, voffB);
            PG8_WAIT_V(6); PG8_BAR; PG8_MMA(1, 1, At, B1); PG8_BAR;
            PG8_LDB(B0, 1, 0); PG8_SCHED; PG8_LDA(At, 1, 0); PG8_STAGE(PG8_SA(0, 1), a2 + hstep, voffA);
            PG8_WAIT_L(8); PG8_BAR; PG8_WAIT_L(0); PG8_MMA(0, 0, At, B0); PG8_BAR; PG8_SCHED;
            PG8_LDB(B1, 1, 1); PG8_STAGE(PG8_SB(1, 0), b3, voffB);
            PG8_BAR; PG8_WAIT_L(0); PG8_MMA(0, 1, At, B1); PG8_BAR;
            PG8_LDA(At, 1, 1); PG8_STAGE(PG8_SA(1, 0), a3, voffA);
            PG8_BAR; PG8_WAIT_L(0); PG8_MMA(1, 0, At, B0); PG8_BAR; PG8_SCHED;
            PG8_STAGE(PG8_SB(1, 1), b3 + hstep, voffB);
            PG8_WAIT_V(6); PG8_BAR; PG8_MMA(1, 1, At, B1); PG8_BAR;
            }
        }
        if constexpr (ALIGN_EPI) { if (wr == 0) PG8_BAR; }
        if constexpr (!Epi::AFTER_DRAIN) { E(acc, cur, wr, wc, fr, fq); S.done(cur); }
        if (!has_next) break;
#pragma unroll
        for (int a = 0; a < 2; ++a)
#pragma unroll
            for (int b = 0; b < 2; ++b)
#pragma unroll
                for (int m = 0; m < 4; ++m)
#pragma unroll
                    for (int n = 0; n < 2; ++n) acc[a][b][m][n] = (f32x4){0.f, 0.f, 0.f, 0.f};
        cur = nxt; cA = nA; cB = nB; ++ui;
        if constexpr (ALIGN_EPI) { if (wr == 1) PG8_BAR; }
    }
    PG8_WAIT_V(0);
    if constexpr (!ALIGN_EPI) { if (wr == 0) PG8_BAR; }
    PG8_BAR;
    if constexpr (Epi::AFTER_DRAIN) { E.fused(acc, cur, wr, wc, fr, fq, lds, wid, lane); S.done(cur); }
#undef PG8_SA
#undef PG8_SB
#undef PG8_STAGE
#undef PG8_LDA
#undef PG8_LDB
#undef PG8_MMA
#undef PG8_WAIT_V
#undef PG8_WAIT_L
#undef PG8_BAR
#undef PG8_SCHED
}
}
namespace att {
typedef unsigned short bf16;
constexpr int NW = 8, QBLK = 32, KVBLK = 64;
constexpr float SCALE = 0.07216878364870322f;
constexpr float THR = 8.f;
constexpr int SDEPTH = 1;
constexpr int LDQ = 1792, LDK = 1792, LDR = 64, LDO = 1024;
constexpr int SHM_V = KVBLK * 128 * 2, SHM_K = KVBLK * 192 * 2, SHM_QR = NW * 4 * 64 * 16, SHM_ATTN = 2 * SHM_V + 2 * SHM_K + NW * 64 * 4 + SHM_QR;
using bf16x8 = __attribute__((ext_vector_type(8))) short;
using s16x4  = __attribute__((ext_vector_type(4))) short;
using f32x16 = __attribute__((ext_vector_type(16))) float;
using u32x4  = __attribute__((ext_vector_type(4))) unsigned;
#define KSWZ(row, colB) ((row) * 384 + ((colB) ^ ((((row) >> 1) & 7) << 4)))
#define SBAR() __builtin_amdgcn_sched_barrier(0)
__device__ __forceinline__ int crow(int r, int hi) { return (r & 3) + 8 * (r >> 2) + 4 * hi; }
__device__ __forceinline__ unsigned cvtpk(float lo, float hi) { unsigned r; asm volatile("v_cvt_pk_bf16_f32 %0, %1, %2" : "=v"(r) : "v"(lo), "v"(hi)); return r; }
__device__ __forceinline__ bf16x8 ld8(const bf16* p) { return *reinterpret_cast<const bf16x8*>(p); }
__device__ __forceinline__ float bf2f(short b) { return __uint_as_float(((unsigned)(unsigned short)b) << 16); }

__device__ __forceinline__ void partialSM(f32x16& p0, f32x16& p1, float& m_reg, float& mn, float& alpha) {
  constexpr float C = SCALE * 1.4426950408889634f;
  float pmax = p0[0];
#pragma unroll
  for (int r = 1; r < 16; ++r) pmax = fmaxf(pmax, p0[r]);
#pragma unroll
  for (int r = 0; r < 16; ++r) pmax = fmaxf(pmax, p1[r]);
  { auto rr = __builtin_amdgcn_permlane32_swap(__float_as_uint(pmax), __float_as_uint(pmax), false, false);
    pmax = fmaxf(__uint_as_float(rr[0]), __uint_as_float(rr[1])); }
  if (__builtin_expect(__all(pmax - m_reg <= THR / SCALE), 1)) { mn = m_reg; alpha = 1.f; }
  else { mn = fmaxf(m_reg, pmax); alpha = __builtin_amdgcn_exp2f((m_reg - mn) * C); m_reg = mn; }
  float mnC = -mn * C;
#pragma unroll
  for (int r = 0; r < 16; ++r) p0[r] = fmaf(p0[r], C, mnC);
#pragma unroll
  for (int r = 0; r < 16; ++r) p1[r] = fmaf(p1[r], C, mnC);
#pragma unroll
  for (int r = 0; r < 16; ++r) p0[r] = __builtin_amdgcn_exp2f(p0[r]);
}
__device__ __forceinline__ void finishSM(f32x16& p0, f32x16& p1, float alpha, float& l_reg, bf16x8& pa0, bf16x8& pa1, bf16x8& pa2, bf16x8& pa3) {
#pragma unroll
  for (int r = 0; r < 16; ++r) p1[r] = __builtin_amdgcn_exp2f(p1[r]);
  float ps = 0;
#pragma unroll
  for (int r = 0; r < 16; ++r) ps += p0[r];
#pragma unroll
  for (int r = 0; r < 16; ++r) ps += p1[r];
  { auto rr = __builtin_amdgcn_permlane32_swap(__float_as_uint(ps), __float_as_uint(ps), false, false);
    ps = __uint_as_float(rr[0]) + __uint_as_float(rr[1]); }
  l_reg = l_reg * alpha + ps;
#define PK4(P, BASE, OUT) do { unsigned a0 = cvtpk(P[BASE + 0], P[BASE + 1]), a1 = cvtpk(P[BASE + 2], P[BASE + 3]);   \
    unsigned b0 = cvtpk(P[BASE + 4], P[BASE + 5]), b1 = cvtpk(P[BASE + 6], P[BASE + 7]);                              \
    auto r0 = __builtin_amdgcn_permlane32_swap(a0, b0, false, false); auto r1 = __builtin_amdgcn_permlane32_swap(a1, b1, false, false); \
    u32x4 w = {r0[0], r1[0], r0[1], r1[1]}; OUT = *reinterpret_cast<bf16x8*>(&w); } while (0)
  PK4(p0, 0, pa0); PK4(p0, 8, pa1); PK4(p1, 0, pa2); PK4(p1, 8, pa3);
#undef PK4
}
__device__ __forceinline__ void qkt(f32x16& p0, f32x16& p1, const bf16* Ks, const bf16x8 (&qr)[8], const bf16x8* qrl, int r32, int hi) {
  p0 = f32x16{}; p1 = f32x16{};
#pragma unroll
  for (int d0 = 0; d0 < 12; ++d0) { int cb = (d0 * 16 + hi * 8) * 2;
    bf16x8 b0 = *reinterpret_cast<const bf16x8*>((const char*)Ks + KSWZ(r32, cb));
    bf16x8 b1 = *reinterpret_cast<const bf16x8*>((const char*)Ks + KSWZ(32 + r32, cb));
    const bf16x8 qf = d0 < 8 ? qr[d0 < 8 ? d0 : 0] : qrl[(d0 - 8) * 64];
    p0 = __builtin_amdgcn_mfma_f32_32x32x16_bf16(b0, qf, p0, 0, 0, 0);
    p1 = __builtin_amdgcn_mfma_f32_32x32x16_bf16(b1, qf, p1, 0, 0, 0); }
}
__device__ __forceinline__ int v_st(int k, int c) { const int kk = (k & ~0xC) | ((k & 4) << 1) | ((k & 8) >> 1); return ((kk >> 3) * 4 + (c >> 5)) * 512 + ((kk & 7) * 32 + (c & 31)) * 2; }
__device__ __forceinline__ int v_rd_base(int lane) { return ((lane & 3) << 3) | (((lane >> 2) & 3) << 6) | (((lane >> 4) & 1) << 5) | (((lane >> 5) & 1) << 8); }
constexpr int v_rd_off(int d0, int ks, int half) { return d0 * 512 + ks * 4096 + half * 2048; }
template <int OFF> __device__ __forceinline__ s16x4 tr_read(int vb) {
  s16x4 r; asm volatile("ds_read_b64_tr_b16 %0, %1 offset:%2" : "=&v"(r) : "v"(vb), "i"(OFF) : "memory"); return r;
}
template <int D0> __device__ __forceinline__ void pv_one(f32x16& od, int vb, bf16x8 pa0, bf16x8 pa1, bf16x8 pa2, bf16x8 pa3) {
  const s16x4 l0 = tr_read<v_rd_off(D0, 0, 0)>(vb), h0 = tr_read<v_rd_off(D0, 0, 1)>(vb), l1 = tr_read<v_rd_off(D0, 1, 0)>(vb), h1 = tr_read<v_rd_off(D0, 1, 1)>(vb);
  const s16x4 l2 = tr_read<v_rd_off(D0, 2, 0)>(vb), h2 = tr_read<v_rd_off(D0, 2, 1)>(vb), l3 = tr_read<v_rd_off(D0, 3, 0)>(vb), h3 = tr_read<v_rd_off(D0, 3, 1)>(vb);
  asm volatile("s_waitcnt lgkmcnt(0)" ::: "memory"); SBAR();
#define PK(L, H) (bf16x8){L[0], L[1], L[2], L[3], H[0], H[1], H[2], H[3]}
  od = __builtin_amdgcn_mfma_f32_32x32x16_bf16(pa0, PK(l0, h0), od, 0, 0, 0);
  od = __builtin_amdgcn_mfma_f32_32x32x16_bf16(pa1, PK(l1, h1), od, 0, 0, 0);
  od = __builtin_amdgcn_mfma_f32_32x32x16_bf16(pa2, PK(l2, h2), od, 0, 0, 0);
  od = __builtin_amdgcn_mfma_f32_32x32x16_bf16(pa3, PK(l3, h3), od, 0, 0, 0);
#undef PK
}
__device__ __forceinline__ void pv_d0(f32x16 (&o)[4], int vb, bf16x8 pa0, bf16x8 pa1, bf16x8 pa2, bf16x8 pa3) {
  pv_one<0>(o[0], vb, pa0, pa1, pa2, pa3); pv_one<1>(o[1], vb, pa0, pa1, pa2, pa3); pv_one<2>(o[2], vb, pa0, pa1, pa2, pa3); pv_one<3>(o[3], vb, pa0, pa1, pa2, pa3);
}
__device__ __forceinline__ void attn_body(const bf16* __restrict__ Qb, const bf16* __restrict__ Kn, const bf16* __restrict__ Vh, const bf16* __restrict__ Kr,
                                          bf16* __restrict__ Ob, int seq, int rope, int qtok0, const float* __restrict__ tab, char* lds,
                                          unsigned* __restrict__ xs, unsigned* __restrict__ cnt, const float* __restrict__ gain, int head) {
  int tid_ = threadIdx.x; asm volatile("" : "+v"(tid_));
  const int tid = tid_, wid = tid >> 6, lane = tid & 63, r32 = lane & 31, hi = lane >> 5;
  bf16* V_lds = (bf16*)lds; bf16* K_lds = (bf16*)(lds + 2 * SHM_V);
  float* ws = (float*)(lds + 2 * SHM_V + 2 * SHM_K) + wid * 64; float* li_l = ws; float* al_l = ws + 32;
  float m_reg = -1e30f, l_reg = 0; f32x16 o[4] = {}; bf16x8 qr[8]; bf16x8 qx[4];
  bf16x8* qrl = (bf16x8*)(lds + 2 * SHM_V + 2 * SHM_K + NW * 64 * 4) + wid * 256 + lane;
  const int sr = tid >> 4, sc = (tid & 15) * 8, vst0 = v_st(sr, sc), vst1 = v_st(32 + sr, sc);
  const int rr = tid >> 3, rc = (tid & 7) * 8;
  const int vb0 = (int)(uintptr_t)V_lds + v_rd_base(lane);
  struct { bf16x8 vs0, vs1, ks0, ks1, kr0; } sr_[SDEPTH];
#define SLOAD(i, k0) do { sr_[i].vs0 = ld8(&Vh[(long)((k0) + sr) * LDK + sc]); sr_[i].vs1 = ld8(&Vh[(long)((k0) + 32 + sr) * LDK + sc]); \
    sr_[i].ks0 = ld8(&Kn[(long)((k0) + sr) * LDK + sc]); sr_[i].ks1 = ld8(&Kn[(long)((k0) + 32 + sr) * LDK + sc]); sr_[i].kr0 = ld8(&Kr[(long)((k0) + rr) * LDR + rc]); } while (0)
#define SWRITE(b, i) do { *(bf16x8*)((char*)V_lds + (b) * SHM_V + vst0) = sr_[i].vs0;          \
    *(bf16x8*)((char*)V_lds + (b) * SHM_V + vst1) = sr_[i].vs1; int kc = sc * 2;               \
    *(bf16x8*)((char*)K_lds + (b) * SHM_K + KSWZ(sr, kc)) = sr_[i].ks0;                       \
    *(bf16x8*)((char*)K_lds + (b) * SHM_K + KSWZ(32 + sr, kc)) = sr_[i].ks1;                  \
    *(bf16x8*)((char*)K_lds + (b) * SHM_K + KSWZ(rr, 256 + rc * 2)) = sr_[i].kr0; } while (0)
#define SWAIT() do { if constexpr (SDEPTH == 2) asm volatile("s_waitcnt vmcnt(5)" ::: "memory"); else asm volatile("s_waitcnt vmcnt(0)" ::: "memory"); } while (0)
  const bf16* Qw = Qb + (long)(wid * QBLK + r32) * LDQ + hi * 8;
#pragma unroll
  for (int d0 = 0; d0 < 8; ++d0) qr[d0] = ld8(Qw + d0 * 16);
#pragma unroll
  for (int d0 = 0; d0 < 4; ++d0) qx[d0] = ld8(Qw + 128 + d0 * 16);
  constexpr int SE = 0, SO = SDEPTH - 1;
  SLOAD(SE, 0);
  if (rope) {
    const int tt = qtok0 + wid * QBLK + r32; const int prow = tt >> 6, pcol = tt & 63;
    const float* tr = tab + (prow * 16 + hi * 8) * 2; const float* tc = tab + (pcol * 16 + hi * 8) * 2;
    unsigned a1[4], a2[4], c1[4], c2[4];
#pragma unroll
    for (int j = 0; j < 8; j += 2) {
      float o1[2], o2[2], p1[2], p2[2];
#pragma unroll
      for (int e = 0; e < 2; ++e) {
        const float cr = tr[(j + e) * 2], sr_ = tr[(j + e) * 2 + 1], cc = tc[(j + e) * 2], sc_ = tc[(j + e) * 2 + 1];
        const float x1 = bf2f(qx[0][j + e]), x2 = bf2f(qx[1][j + e]), y1 = bf2f(qx[2][j + e]), y2 = bf2f(qx[3][j + e]);
        o1[e] = x1 * cr - x2 * sr_; o2[e] = x2 * cr + x1 * sr_; p1[e] = y1 * cc - y2 * sc_; p2[e] = y2 * cc + y1 * sc_; }
      a1[j >> 1] = cvtpk(o1[0], o1[1]); a2[j >> 1] = cvtpk(o2[0], o2[1]); c1[j >> 1] = cvtpk(p1[0], p1[1]); c2[j >> 1] = cvtpk(p2[0], p2[1]); }
    { u32x4 w = {a1[0], a1[1], a1[2], a1[3]}; qx[0] = *reinterpret_cast<bf16x8*>(&w); }
    { u32x4 w = {a2[0], a2[1], a2[2], a2[3]}; qx[1] = *reinterpret_cast<bf16x8*>(&w); }
    { u32x4 w = {c1[0], c1[1], c1[2], c1[3]}; qx[2] = *reinterpret_cast<bf16x8*>(&w); }
    { u32x4 w = {c2[0], c2[1], c2[2], c2[3]}; qx[3] = *reinterpret_cast<bf16x8*>(&w); }
  }
#pragma unroll
  for (int d0 = 0; d0 < 4; ++d0) qrl[d0 * 64] = qx[d0];
#define RESC(a) do { if (__any((a) < 1.f)) { if (hi == 0) al_l[r32] = (a); asm volatile("s_waitcnt lgkmcnt(0)" ::: "memory"); \
    _Pragma("unroll") for (int d = 0; d < 4; ++d) _Pragma("unroll") for (int r = 0; r < 16; ++r) o[d][r] *= al_l[crow(r, hi)]; } } while (0)
  f32x16 pA0, pA1, pB0, pB1; float mnA, mnB, alA, alB; bf16x8 pa0, pa1, pa2, pa3; const int NT = seq / KVBLK;
  asm volatile("s_waitcnt vmcnt(0)" ::: "memory"); SWRITE(0, SE); __syncthreads();
  qkt(pA0, pA1, K_lds, qr, qrl, r32, hi); partialSM(pA0, pA1, m_reg, mnA, alA);
  SLOAD(SO, KVBLK); if constexpr (SDEPTH == 2) { if (2 < NT) SLOAD(SE, 2 * KVBLK); }
  SWAIT(); SWRITE(1, SO); __syncthreads();
  for (int j = 1; j + 1 < NT; j += 2) {
    SBAR(); qkt(pB0, pB1, (bf16*)((char*)K_lds + SHM_K), qr, qrl, r32, hi);
    finishSM(pA0, pA1, alA, l_reg, pa0, pa1, pa2, pa3); SBAR();
    SLOAD(SO, (j + SDEPTH) * KVBLK); SBAR();
    pv_d0(o, vb0, pa0, pa1, pa2, pa3); partialSM(pB0, pB1, m_reg, mnB, alB);
    __syncthreads(); SWAIT(); SWRITE(0, SE);
    RESC(alB); __syncthreads();
    SBAR(); qkt(pA0, pA1, K_lds, qr, qrl, r32, hi);
    finishSM(pB0, pB1, alB, l_reg, pa0, pa1, pa2, pa3); SBAR();
    if (SDEPTH == 1 || j + 3 < NT) SLOAD(SE, (j + 1 + SDEPTH) * KVBLK); SBAR();
    pv_d0(o, vb0 + (int)SHM_V, pa0, pa1, pa2, pa3); partialSM(pA0, pA1, m_reg, mnA, alA);
    __syncthreads(); SWAIT(); SWRITE(1, SO);
    RESC(alA); __syncthreads();
  }
  SBAR(); qkt(pB0, pB1, (bf16*)((char*)K_lds + SHM_K), qr, qrl, r32, hi);
  finishSM(pA0, pA1, alA, l_reg, pa0, pa1, pa2, pa3); SBAR();
  pv_d0(o, vb0, pa0, pa1, pa2, pa3); partialSM(pB0, pB1, m_reg, mnB, alB);
  __syncthreads(); RESC(alB);
  finishSM(pB0, pB1, alB, l_reg, pa0, pa1, pa2, pa3); SBAR();
  pv_d0(o, vb0 + (int)SHM_V, pa0, pa1, pa2, pa3);
  if (hi == 0) li_l[r32] = l_reg; asm volatile("s_waitcnt lgkmcnt(0)" ::: "memory");
  float rli[16];
#pragma unroll
  for (int r = 0; r < 16; ++r) rli[r] = __builtin_amdgcn_rcpf(li_l[crow(r, hi)]);
  float rs[16];
#pragma unroll
  for (int r = 0; r < 16; ++r) { float s = 0.f;
#pragma unroll
    for (int d0 = 0; d0 < 4; ++d0) { o[d0][r] *= rli[r]; s += o[d0][r] * o[d0][r]; }
    rs[r] = s; }
#pragma unroll
  for (int x = 1; x < 32; x <<= 1)
#pragma unroll
    for (int r = 0; r < 16; ++r) rs[r] += __shfl_xor(rs[r], x);
  asm volatile("s_waitcnt lgkmcnt(0)" ::: "memory");
  if (r32 == 0) {
#pragma unroll
    for (int r = 0; r < 16; ++r) al_l[crow(r, hi)] = rs[r]; }
  asm volatile("s_waitcnt lgkmcnt(0)" ::: "memory");
  if (lane < 32) __hip_atomic_store(xs + (size_t)(wid * QBLK + lane) * 4 + head, __float_as_uint(al_l[lane]), __ATOMIC_RELAXED, __HIP_MEMORY_SCOPE_AGENT);
  asm volatile("s_waitcnt vmcnt(0)" ::: "memory");
  if (lane == 0) __hip_atomic_fetch_add(cnt, 1u, __ATOMIC_RELAXED, __HIP_MEMORY_SCOPE_AGENT);
  if (wid == 0) { unsigned sp = 0;
    while ((unsigned)__builtin_amdgcn_readfirstlane(__hip_atomic_load(cnt, __ATOMIC_RELAXED, __HIP_MEMORY_SCOPE_AGENT)) < 32u) { __builtin_amdgcn_s_sleep(2); if (++sp > (1u << 22)) break; }
    __builtin_amdgcn_fence(__ATOMIC_ACQUIRE, "agent"); }
  asm volatile("s_waitcnt vmcnt(0) lgkmcnt(0)" ::: "memory"); __syncthreads();
  if (lane < 32) { const unsigned* sl = xs + (size_t)(wid * QBLK + lane) * 4; float t = 0.f;
#pragma unroll
    for (int q = 0; q < 4; ++q) t += __uint_as_float(__hip_atomic_load(sl + q, __ATOMIC_RELAXED, __HIP_MEMORY_SCOPE_AGENT));
    li_l[lane] = 1.0f / sqrtf(t * (1.0f / 512.0f) + 1e-6f); }
  asm volatile("s_waitcnt lgkmcnt(0)" ::: "memory");
  float g4[4];
#pragma unroll
  for (int d0 = 0; d0 < 4; ++d0) g4[d0] = gain[d0 * 32 + r32];
  char* Ol = lds + wid * 8704;
#pragma unroll
  for (int r = 0; r < 16; ++r) { const int orow = crow(r, hi); const float rn = li_l[orow];
#pragma unroll
    for (int d0 = 0; d0 < 4; ++d0) { const float v = o[d0][r] * rn * g4[d0]; *(bf16*)(Ol + orow * 272 + (d0 * 32 + r32) * 2) = (bf16)(cvtpk(v, v) & 0xffffu); } }
  asm volatile("s_waitcnt lgkmcnt(0)" ::: "memory");
  bf16* Ow = Ob + (long)(wid * QBLK) * LDO;
#pragma unroll
  for (int i = 0; i < 8; i += 2) { const int row = (lane >> 4) + 4 * i, c16 = lane & 15;
    const u32x4 w0 = *reinterpret_cast<const u32x4*>(Ol + row * 272 + c16 * 16), w1 = *reinterpret_cast<const u32x4*>(Ol + (row + 4) * 272 + c16 * 16);
    *reinterpret_cast<u32x4*>(Ow + (long)row * LDO + c16 * 8) = w0; *reinterpret_cast<u32x4*>(Ow + (long)(row + 4) * LDO + c16 * 8) = w1;
    asm volatile("" ::: "memory"); }
  __syncthreads();
#undef SLOAD
#undef SWRITE
#undef SWAIT
#undef RESC
}
#undef KSWZ
#undef SBAR
}

namespace ml {
using att::bf16; using att::bf16x8; using att::s16x4; using att::f32x16; using att::u32x4;
typedef float f32x4 __attribute__((ext_vector_type(4)));
using att::crow;
__device__ __forceinline__ unsigned cvtpk(float lo, float hi) { unsigned r; asm("v_cvt_pk_bf16_f32 %0, %1, %2" : "=v"(r) : "v"(lo), "v"(hi)); return r; }
 using att::ld8; using att::bf2f; using att::v_st; using att::v_rd_base; using att::v_rd_off;
constexpr int TBr = 4352, CTXr = 256, SEQr = 4096;
constexpr float LOG2E = 1.4426950408889634f;
constexpr int TSTRIDE = 32 * 17 * 256;
#define MLAS __attribute__((address_space(3)))
__device__ __forceinline__ float log_sigmoid_f(float x) {
    const float t = __expf(-fabsf(x));
    const float l1p = t < 0.03f ? t * (1.0f - t * (0.5f - t * (0.33333334f - 0.25f * t))) : __logf(1.0f + t);
    return fminf(x, 0.f) - l1p;
}
template <int OFF> __device__ __forceinline__ s16x4 trr(int vb) { s16x4 r; asm volatile("ds_read_b64_tr_b16 %0, %1 offset:%2" : "=&v"(r) : "v"(vb), "i"(OFF) : "memory"); return r; }
#define MLPK(L, H) (bf16x8){L[0], L[1], L[2], L[3], H[0], H[1], H[2], H[3]}
__device__ __forceinline__ void unit_rows(int b, int dir, int j, int& rb, int& sg) {
    if (dir == 0) { rb = b * TBr + 256 * j; sg = 1; }
    else { rb = (j == 0) ? b * TBr + 255 : b * TBr + TBr - 1 - 256 * (j - 1); sg = -1; }
}
struct Conv8 { float w0[8], w1[8], w2[8], bb[8]; };
__device__ __forceinline__ void conv8_load(Conv8& cp, const float* __restrict__ cw, const float* __restrict__ cb, int c) {
#pragma unroll
    for (int j = 0; j < 8; ++j) { cp.w0[j] = cw[c + j]; cp.w1[j] = cw[1024 + c + j]; cp.w2[j] = cw[2048 + c + j]; cp.bb[j] = cb[c + j]; }
}
__device__ __forceinline__ void conv8x8(const bf16* __restrict__ P, int r0, int sg, int sr, int c, const Conv8& cp, float scale, bf16x8 (&out)[8]) {
    bf16x8 x0[8], xm[8], xp[8]; float fm[8], fp[8];
#pragma unroll
    for (int g = 0; g < 8; ++g) { const int r = r0 + sg * (32 * g + sr); const int t = r % TBr; const bool hp = (t != 0) && (t != CTXr), hn = (t != CTXr - 1) && (t != TBr - 1);
        const bf16* p = P + (size_t)r * 2560 + 448 + c; x0[g] = ld8(p); xm[g] = ld8(hp ? p - 2560 : p); xp[g] = ld8(hn ? p + 2560 : p); fm[g] = hp ? 1.0f : 0.0f; fp[g] = hn ? 1.0f : 0.0f; }
    asm volatile("" ::: "memory");
#pragma unroll
    for (int g = 0; g < 8; ++g) { float u[8];
#pragma unroll
        for (int j = 0; j < 8; ++j) { const float a = cp.w0[j] * fm[g] * bf2f(xm[g][j]) + cp.w1[j] * bf2f(x0[g][j]) + cp.w2[j] * fp[g] * bf2f(xp[g][j]) + cp.bb[j];
            u[j] = a * __builtin_amdgcn_rcpf(1.0f + __builtin_amdgcn_exp2f(-LOG2E * a)) * scale; }
        u32x4 o = {cvtpk(u[0], u[1]), cvtpk(u[2], u[3]), cvtpk(u[4], u[5]), cvtpk(u[6], u[7])};
        out[g] = *reinterpret_cast<bf16x8*>(&o); }
}
__device__ __forceinline__ void conv_rows_load(const bf16* __restrict__ P, int R0, int c, bf16x8 (&x)[10]) {
    const int t0 = R0 % TBr; const bool hp0 = (t0 != 0) && (t0 != CTXr); const int t7 = t0 + 7; const bool hn7 = (t7 != CTXr - 1) && (t7 != TBr - 1);
    const bf16* p = P + (size_t)R0 * 2560 + 448 + c;
    x[0] = ld8(hp0 ? p - 2560 : p);
#pragma unroll
    for (int g = 0; g < 8; ++g) x[1 + g] = ld8(p + (size_t)g * 2560);
    x[9] = ld8(hn7 ? p + (size_t)8 * 2560 : p + (size_t)7 * 2560);
}
__device__ __forceinline__ void conv_rows_compute(const bf16x8 (&x)[10], int R0, const Conv8& cp, float scale, bf16x8 (&out)[8]) {
    const int t0 = R0 % TBr;
#pragma unroll
    for (int g = 0; g < 8; ++g) { const int t = t0 + g; const float fm = ((t != 0) && (t != CTXr)) ? 1.0f : 0.0f, fp = ((t != CTXr - 1) && (t != TBr - 1)) ? 1.0f : 0.0f; float u[8];
#pragma unroll
        for (int j = 0; j < 8; ++j) { const float a = cp.w0[j] * fm * bf2f(x[g][j]) + cp.w1[j] * bf2f(x[g + 1][j]) + cp.w2[j] * fp * bf2f(x[g + 2][j]) + cp.bb[j];
            u[j] = a * __builtin_amdgcn_rcpf(1.0f + __builtin_amdgcn_exp2f(-LOG2E * a)) * scale; }
        u32x4 o = {cvtpk(u[0], u[1]), cvtpk(u[2], u[3]), cvtpk(u[4], u[5]), cvtpk(u[6], u[7])};
        out[g] = *reinterpret_cast<bf16x8*>(&o); }
}
__device__ __forceinline__ void gate_scan_task(const float* __restrict__ G, const float* __restrict__ gate_b, float* __restrict__ T, float* __restrict__ sca, int task, int lane) {
    const int seq = task / 17, j = task - seq * 17, b = seq >> 3, h = (seq >> 1) & 3, dir = seq & 1;
    int rb, sg; unit_rows(b, dir, j, rb, sg);
    const int gi = (2 * dir) * 4 + h, gf = (2 * dir + 1) * 4 + h; const float ib = gate_b[gi], fb = gate_b[gf];
    float igv[4], fgv[4];
#pragma unroll
    for (int rnd = 0; rnd < 4; ++rnd) { const size_t r = (size_t)(rb + sg * (64 * rnd + lane)); igv[rnd] = G[r * 16 + gi] + ib; fgv[rnd] = G[r * 16 + gf] + fb; }
    float cb = 0.f, cpm = -3.0e38f; float* Tb = T + (size_t)task * 256;
#pragma unroll
    for (int rnd = 0; rnd < 4; ++rnd) { const int i = 64 * rnd + lane;
        float bc = log_sigmoid_f(fgv[rnd]);
#pragma unroll
        for (int o = 1; o < 64; o <<= 1) { const float t_ = __shfl_up(bc, o); if (lane >= o) bc += t_; }
        bc += cb;
        const float al = igv[rnd] - bc; float pm = al;
#pragma unroll
        for (int o = 1; o < 64; o <<= 1) { const float t_ = __shfl_up(pm, o); if (lane >= o) pm = fmaxf(pm, t_); }
        pm = fmaxf(pm, cpm);
        Tb[i] = bc; Tb[TSTRIDE + i] = al; Tb[2 * TSTRIDE + i] = pm;
        cb = __shfl(bc, 63); cpm = __shfl(pm, 63); }
    if (j < 16 && lane == 0) { sca[(seq * 16 + j) * 2] = cpm; sca[(seq * 16 + j) * 2 + 1] = cb; }
}
__device__ __forceinline__ void mlstm_local(const bf16* __restrict__ P, const float* __restrict__ T, const float* __restrict__ cw, const float* __restrict__ cbias,
                                            float* __restrict__ Cloc, float* __restrict__ nloc, int unit, char* lds) {
    int tid_ = threadIdx.x; asm volatile("" : "+v"(tid_));
    const int tid = tid_, wid = tid >> 6, lane = tid & 63, r32 = lane & 31, hi = lane >> 5;
    const int seq = unit >> 4, j = unit & 15, b = seq >> 3, h = (seq >> 1) & 3, dir = seq & 1;
    int rb, sg; unit_rows(b, dir, j, rb, sg);
    const float* Tal = T + TSTRIDE + (size_t)(seq * 17 + j) * 256; const float mlm = T[2 * TSTRIDE + (size_t)(seq * 17 + j) * 256 + 255];
    float* npart = (float*)(lds + 131072);
    const int sr = tid >> 4, sc = (tid & 15) * 8;
    float wv[8]; bf16x8 vreg[8];
#pragma unroll
    for (int g = 0; g < 8; ++g) { const int i = 32 * g + sr; wv[g] = Tal[i]; vreg[g] = ld8(P + (size_t)(rb + sg * i) * 2560 + 1472 + h * 128 + sc); }
    asm volatile("" ::: "memory");
    float nacc[8] = {0.f, 0.f, 0.f, 0.f, 0.f, 0.f, 0.f, 0.f};
    {
        const int R0 = sg > 0 ? rb + 8 * sr : rb - 8 * sr - 7;
        bf16x8 xk[10]; conv_rows_load(P, R0, 512 + h * 128 + sc, xk); float wk[8];
#pragma unroll
        for (int g = 0; g < 8; ++g) wk[g] = Tal[8 * sr + g];
        asm volatile("" ::: "memory");
        Conv8 cp; conv8_load(cp, cw, cbias, 512 + h * 128 + sc); bf16x8 kv[8]; conv_rows_compute(xk, R0, cp, 0.08838834764831845f, kv);
#pragma unroll
        for (int g = 0; g < 8; ++g) { const int i = 8 * sr + g; const bf16x8 kr = sg > 0 ? kv[g] : kv[7 - g];
            *(bf16x8*)(lds + (i >> 6) * 16384 + v_st(i & 63, sc)) = kr; const float w = __expf(wk[g] - mlm);
#pragma unroll
            for (int x = 0; x < 8; ++x) nacc[x] += w * bf2f(kr[x]); } }
#pragma unroll
    for (int g = 0; g < 8; ++g) wv[g] = __expf(wv[g] - mlm);
#pragma unroll
    for (int g = 0; g < 8; ++g) { const int i = 32 * g + sr; const float w = wv[g]; const bf16x8 v = vreg[g];
        u32x4 o = {cvtpk(bf2f(v[0]) * w, bf2f(v[1]) * w), cvtpk(bf2f(v[2]) * w, bf2f(v[3]) * w), cvtpk(bf2f(v[4]) * w, bf2f(v[5]) * w), cvtpk(bf2f(v[6]) * w, bf2f(v[7]) * w)};
        *(u32x4*)(lds + 65536 + (i >> 6) * 16384 + v_st(i & 63, sc)) = o; }
#pragma unroll
    for (int x = 0; x < 8; ++x) { nacc[x] += __shfl_xor(nacc[x], 16); nacc[x] += __shfl_xor(nacc[x], 32); }
    if (lane < 16) {
#pragma unroll
        for (int x = 0; x < 8; ++x) npart[wid * 128 + sc + x] = nacc[x]; }
    __syncthreads();
    const int db = wid >> 1, eb0 = 2 * (wid & 1);
    const int vbK = (int)(uintptr_t)lds + v_rd_base(lane) + db * 512, vbV = (int)(uintptr_t)lds + 65536 + v_rd_base(lane) + eb0 * 512;
    f32x16 c0 = {}, c1 = {};
#define MLA_STEP(TL, KS) do { const s16x4 al_ = trr<(TL) * 16384 + v_rd_off(0, KS, 0)>(vbK), ah_ = trr<(TL) * 16384 + v_rd_off(0, KS, 1)>(vbK); \
        const s16x4 bl0 = trr<(TL) * 16384 + v_rd_off(0, KS, 0)>(vbV), bh0 = trr<(TL) * 16384 + v_rd_off(0, KS, 1)>(vbV), bl1 = trr<(TL) * 16384 + v_rd_off(1, KS, 0)>(vbV), bh1 = trr<(TL) * 16384 + v_rd_off(1, KS, 1)>(vbV); \
        asm volatile("s_waitcnt lgkmcnt(0)" ::: "memory"); __builtin_amdgcn_sched_barrier(0); \
        c0 = __builtin_amdgcn_mfma_f32_32x32x16_bf16(MLPK(al_, ah_), MLPK(bl0, bh0), c0, 0, 0, 0); c1 = __builtin_amdgcn_mfma_f32_32x32x16_bf16(MLPK(al_, ah_), MLPK(bl1, bh1), c1, 0, 0, 0); } while (0)
#define MLA_TILE(TL) do { MLA_STEP(TL, 0); MLA_STEP(TL, 1); MLA_STEP(TL, 2); MLA_STEP(TL, 3); } while (0)
    MLA_TILE(0); MLA_TILE(1); MLA_TILE(2); MLA_TILE(3);
#undef MLA_TILE
#undef MLA_STEP
    float* Co = Cloc + (size_t)unit * 16384;
#pragma unroll
    for (int r = 0; r < 16; ++r) { const int d = db * 32 + crow(r, hi); Co[d * 128 + eb0 * 32 + r32] = c0[r]; Co[d * 128 + eb0 * 32 + 32 + r32] = c1[r]; }
    if (tid < 128) { float s = 0.f;
#pragma unroll
        for (int w = 0; w < 8; ++w) s += npart[w * 128 + tid];
        nloc[unit * 128 + tid] = s; }
    __syncthreads();
}
__device__ __forceinline__ void mlstm_scan(const float* __restrict__ Cloc, const float* __restrict__ nloc, const float* __restrict__ sca, bf16* __restrict__ CstT, float* __restrict__ nst, float* __restrict__ bm, int gtid, int gthreads) {
    for (int item = gtid; item < 32 * 2048; item += gthreads) {
        const int seq = item >> 11, rem = item & 2047, e = rem & 127, dg = rem >> 7;
        float st[8] = {0.f, 0.f, 0.f, 0.f, 0.f, 0.f, 0.f, 0.f}; float nv = 0.f, Bst = 0.f, Mst = 0.f;
        asm volatile("" : "+v"(Bst), "+v"(Mst));
        const float* Cl0 = Cloc + (size_t)(seq * 16) * 16384 + (dg * 8) * 128 + e;
        {   float cl[16][8], nlv[16], mlv[16], blv[16];
#pragma unroll
            for (int jj = 0; jj < 16; ++jj) { const int lu = seq * 16 + jj;
#pragma unroll
                for (int i = 0; i < 8; ++i) cl[jj][i] = Cl0[(size_t)jj * 16384 + i * 128];
                nlv[jj] = nloc[lu * 128 + e]; mlv[jj] = sca[lu * 2]; blv[jj] = sca[lu * 2 + 1]; }
#pragma unroll
            for (int jj = 0; jj < 16; ++jj) { const int j = jj; const size_t su = (size_t)seq * 17 + j;
                u32x4 o = {cvtpk(st[0], st[1]), cvtpk(st[2], st[3]), cvtpk(st[4], st[5]), cvtpk(st[6], st[7])};
                *(u32x4*)(CstT + su * 16384 + e * 128 + dg * 8) = o;
                if (dg == 0) { nst[su * 128 + e] = nv; if (e == 0) { bm[su * 2] = Bst; bm[su * 2 + 1] = Mst; } }
                const float Mend = fmaxf(Mst, mlv[jj] - Bst), fa = __expf(Mst - Mend), fbv = __expf(mlv[jj] - Bst - Mend);
#pragma unroll
                for (int i = 0; i < 8; ++i) st[i] = fa * st[i] + fbv * cl[jj][i];
                nv = fa * nv + fbv * nlv[jj];
                Bst += blv[jj]; Mst = Mend; }
        }
        { const size_t su = (size_t)seq * 17 + 16;
          u32x4 o = {cvtpk(st[0], st[1]), cvtpk(st[2], st[3]), cvtpk(st[4], st[5]), cvtpk(st[6], st[7])};
          *(u32x4*)(CstT + su * 16384 + e * 128 + dg * 8) = o;
          if (dg == 0) { nst[su * 128 + e] = nv; if (e == 0) { bm[su * 2] = Bst; bm[su * 2 + 1] = Mst; } } }
    }
}
#define KSW(row, colB) ((row) * 256 + ((colB) ^ (((row) & 15) << 4)))
template <int D0, int KS> __device__ __forceinline__ void pv_pair(f32x16& od, int vb, bf16x8 pa, bf16x8 pb) {
    const s16x4 l0 = trr<v_rd_off(D0, KS, 0)>(vb), h0 = trr<v_rd_off(D0, KS, 1)>(vb), l1 = trr<v_rd_off(D0, KS + 1, 0)>(vb), h1 = trr<v_rd_off(D0, KS + 1, 1)>(vb);
    asm volatile("s_waitcnt lgkmcnt(0)" ::: "memory"); __builtin_amdgcn_sched_barrier(0);
    od = __builtin_amdgcn_mfma_f32_32x32x16_bf16(pa, MLPK(l0, h0), od, 0, 0, 0);
    od = __builtin_amdgcn_mfma_f32_32x32x16_bf16(pb, MLPK(l1, h1), od, 0, 0, 0);
}
__device__ __forceinline__ void mlstm_out2(const bf16* __restrict__ P, const float* __restrict__ T, const float* __restrict__ cw, const float* __restrict__ cbias, const bf16* __restrict__ CstT, const float* __restrict__ nst,
                                           const float* __restrict__ bm, const float* __restrict__ mnorm, bf16* __restrict__ MIX, int b, int h, int tb, char* lds) {
    int tid_ = threadIdx.x; asm volatile("" : "+v"(tid_));
    const int tid = tid_, wid = tid >> 6, lane = tid & 63, r32 = lane & 31, hi = lane >> 5;
    const int seqf = b * 8 + h * 2, seqb = seqf + 1; const int jb = tb == 0 ? 0 : 17 - tb; const bool zs = (tb == 0);
    const size_t suf = (size_t)seqf * 17 + tb, sub = (size_t)seqb * 17 + jb;
    const int rb = b * TBr + 256 * tb;
    float* tabs = (float*)(lds + 131072);
    float* nlf = tabs + 2048; float* nlb = tabs + 2176; float* wsc = tabs + 2304 + wid * 32;
    const int sr = tid >> 4, sc = (tid & 15) * 8;
    bf16x8 vreg[8];
#pragma unroll
    for (int g = 0; g < 8; ++g) vreg[g] = ld8(P + (size_t)(rb + 32 * g + sr) * 2560 + 1472 + h * 128 + sc);
    const int tdir_ = tid >> 8, tn_ = tid & 255; const size_t su_ = tdir_ ? sub : suf; const size_t ti = su_ * 256 + (tdir_ ? 255 - tn_ : tn_);
    const float bl = T[ti], al = T[TSTRIDE + ti], pm = T[2 * TSTRIDE + ti]; const float bst_ = bm[su_ * 2], mst_ = bm[su_ * 2 + 1];
    {
        bf16x8 xk[10], xq[10]; conv_rows_load(P, rb + 8 * sr, 512 + h * 128 + sc, xk); conv_rows_load(P, rb + 8 * sr, h * 128 + sc, xq);
        asm volatile("" ::: "memory");
        { Conv8 cp; conv8_load(cp, cw, cbias, 512 + h * 128 + sc); bf16x8 kv[8]; conv_rows_compute(xk, rb + 8 * sr, cp, 0.08838834764831845f, kv);
#pragma unroll
          for (int g = 0; g < 8; ++g) { const int i = 8 * sr + g; *(bf16x8*)(lds + KSW(i, sc * 2)) = kv[g]; } }
        { Conv8 cp; conv8_load(cp, cw, cbias, h * 128 + sc); bf16x8 qv[8]; conv_rows_compute(xq, rb + 8 * sr, cp, 1.0f, qv);
#pragma unroll
          for (int g = 0; g < 8; ++g) { const int i = 8 * sr + g; *(bf16x8*)(lds + 65536 + KSW(i, sc * 2)) = qv[g]; } } }
    {
        const int dir = tdir_, n = tn_; const float Bst = zs ? 0.f : bst_, Mst = zs ? 0.f : mst_;
        float* tb_ = tabs + dir * 1024; const float M = fmaxf(Mst, pm - Bst);
        tb_[n] = __expf(-(Bst + bl + M)); tb_[256 + n] = (al - Bst) * LOG2E; tb_[512 + n] = M * LOG2E; tb_[768 + n] = __expf(Mst - M); }
    if (wid == 2) { nlf[lane] = zs ? 0.f : nst[suf * 128 + lane]; nlf[64 + lane] = zs ? 0.f : nst[suf * 128 + 64 + lane]; }
    if (wid == 3) { nlb[lane] = zs ? 0.f : nst[sub * 128 + lane]; nlb[64 + lane] = zs ? 0.f : nst[sub * 128 + 64 + lane]; }
    __syncthreads();
    bf16x8 qr[8];
#pragma unroll
    for (int d0 = 0; d0 < 8; ++d0) qr[d0] = *reinterpret_cast<const bf16x8*>(lds + 65536 + KSW(wid * 32 + r32, (d0 * 16 + hi * 8) * 2));
    asm volatile("s_waitcnt lgkmcnt(0)" ::: "memory");
    __syncthreads();
#pragma unroll
    for (int g = 0; g < 8; ++g) { const int i = 32 * g + sr; *(bf16x8*)(lds + 65536 + (i >> 6) * 16384 + v_st(i & 63, sc)) = vreg[g]; }
    __syncthreads();
    const int qi = wid * 32 + r32;
    float qnf = 0.f, qnb = 0.f;
#pragma unroll
    for (int d0 = 0; d0 < 8; ++d0) {
#pragma unroll
        for (int jj = 0; jj < 8; ++jj) { const float qv = bf2f(qr[d0][jj]); qnf += qv * nlf[d0 * 16 + hi * 8 + jj]; qnb += qv * nlb[d0 * 16 + hi * 8 + jj]; }
        asm volatile("" : "+v"(qnf), "+v"(qnb)); }
    { auto rr = __builtin_amdgcn_permlane32_swap(__float_as_uint(qnf), __float_as_uint(qnf), false, false); qnf = __uint_as_float(rr[0]) + __uint_as_float(rr[1]); }
    { auto rr = __builtin_amdgcn_permlane32_swap(__float_as_uint(qnb), __float_as_uint(qnb), false, false); qnb = __uint_as_float(rr[0]) + __uint_as_float(rr[1]); }
    const int vb0 = (int)(uintptr_t)lds + 65536 + v_rd_base(lane);
    const int dtile = wid >> 1;
    unsigned hfp[32];
#define ML_PK4(Pv, BASE, OUT) do { unsigned a0 = cvtpk(Pv[BASE + 0], Pv[BASE + 1]), a1 = cvtpk(Pv[BASE + 2], Pv[BASE + 3]);   \
    unsigned b0_ = cvtpk(Pv[BASE + 4], Pv[BASE + 5]), b1_ = cvtpk(Pv[BASE + 6], Pv[BASE + 7]);                              \
    auto r0 = __builtin_amdgcn_permlane32_swap(a0, b0_, false, false); auto r1 = __builtin_amdgcn_permlane32_swap(a1, b1_, false, false); \
    u32x4 w = {r0[0], r1[0], r0[1], r1[1]}; OUT = *reinterpret_cast<bf16x8*>(&w); } while (0)
#pragma unroll
    for (int dir = 0; dir < 2; ++dir) {
        const float* tb_ = tabs + dir * 1024; const size_t su = dir ? sub : suf;
        f32x16 o[4];
        if (zs) { o[0] = f32x16{}; o[1] = f32x16{}; o[2] = f32x16{}; o[3] = f32x16{}; }
        else { const bf16* Cb = CstT + su * 16384 + (size_t)r32 * 128 + hi * 8;
          bf16x8 cf[32];
#pragma unroll
          for (int x = 0; x < 32; ++x) cf[x] = ld8(Cb + (x >> 3) * 32 * 128 + (x & 7) * 16);
          asm volatile("" ::: "memory");
#pragma unroll
          for (int ep = 0; ep < 2; ++ep) {
              f32x16 a0 = {}, a1 = {};
#pragma unroll
              for (int d0 = 0; d0 < 8; ++d0) { a0 = __builtin_amdgcn_mfma_f32_32x32x16_bf16(qr[d0], cf[16 * ep + d0], a0, 0, 0, 0); a1 = __builtin_amdgcn_mfma_f32_32x32x16_bf16(qr[d0], cf[16 * ep + 8 + d0], a1, 0, 0, 0); }
              o[2 * ep] = a0; o[2 * ep + 1] = a1; }
#pragma unroll
          for (int r = 0; r < 16; ++r) { const float isc = tb_[768 + wid * 32 + crow(r, hi)];
#pragma unroll
              for (int eb = 0; eb < 4; ++eb) o[eb][r] *= isc; } }
        const float qn = dir ? qnb : qnf;
        const float m2q = tb_[512 + qi]; float dsum = 0.f;
        const int kt0 = dir ? dtile : 0, kt1 = dir ? 4 : dtile + 1;
        for (int kt = kt0; kt < kt1; ++kt) {
            const char* Ks = lds + kt * 64 * 256; const bool diag = (kt == dtile); const int vb = vb0 + kt * 16384;
#pragma unroll
            for (int hh = 0; hh < 2; ++hh) {
                f32x16 p = {}, p2 = {};
#pragma unroll
                for (int d0 = 0; d0 < 8; d0 += 2) { const int cb = (d0 * 16 + hi * 8) * 2;
                    const bf16x8 b0 = *reinterpret_cast<const bf16x8*>(Ks + KSW(32 * hh + r32, cb)), b1 = *reinterpret_cast<const bf16x8*>(Ks + KSW(32 * hh + r32, cb + 32));
                    p = __builtin_amdgcn_mfma_f32_32x32x16_bf16(b0, qr[d0], p, 0, 0, 0); p2 = __builtin_amdgcn_mfma_f32_32x32x16_bf16(b1, qr[d0 + 1], p2, 0, 0, 0); }
                p += p2;
#pragma unroll
                for (int g4 = 0; g4 < 4; ++g4) { const int sb = kt * 64 + 32 * hh + 8 * g4 + 4 * hi;
                    const f32x4 a4 = *(const f32x4*)(tb_ + 256 + sb);
#pragma unroll
                    for (int x = 0; x < 4; ++x) { const int r = 4 * g4 + x, s0 = sb + x;
                        float w0 = __builtin_amdgcn_exp2f(a4[x] - m2q);
                        if (diag) { if (dir ? (s0 < qi) : (s0 > qi)) w0 = 0.f; }
                        p[r] *= w0; dsum += p[r]; } }
                bf16x8 pa, pb;
                ML_PK4(p, 0, pa); ML_PK4(p, 8, pb);
                if (hh == 0) { pv_pair<0, 0>(o[0], vb, pa, pb); pv_pair<1, 0>(o[1], vb, pa, pb); pv_pair<2, 0>(o[2], vb, pa, pb); pv_pair<3, 0>(o[3], vb, pa, pb); }
                else         { pv_pair<0, 2>(o[0], vb, pa, pb); pv_pair<1, 2>(o[1], vb, pa, pb); pv_pair<2, 2>(o[2], vb, pa, pb); pv_pair<3, 2>(o[3], vb, pa, pb); }
            }
        }
        { auto rr = __builtin_amdgcn_permlane32_swap(__float_as_uint(dsum), __float_as_uint(dsum), false, false); dsum = __uint_as_float(rr[0]) + __uint_as_float(rr[1]); }
        const float den = dsum + tb_[768 + qi] * qn; const float rd = 1.0f / fmaxf(fabsf(den), tb_[qi]);
        if (hi == 0) wsc[r32] = rd; asm volatile("s_waitcnt lgkmcnt(0)" ::: "memory");
        if (dir == 0) {
#pragma unroll
            for (int r = 0; r < 16; r += 2) { const float ra = wsc[crow(r, hi)], rb_ = wsc[crow(r + 1, hi)];
#pragma unroll
                for (int eb = 0; eb < 4; ++eb) hfp[eb * 8 + (r >> 1)] = cvtpk(o[eb][r] * ra, o[eb][r + 1] * rb_); }
            asm volatile("s_waitcnt lgkmcnt(0)" ::: "memory");
        } else {
            float rdr[16];
#pragma unroll
            for (int r = 0; r < 16; ++r) rdr[r] = wsc[crow(r, hi)];
            bf16x8 og8[8];
            { const bf16* ogp = P + (size_t)(rb + wid * 32 + r32) * 2560 + 1984 + h * 128 + 64 * hi;
#pragma unroll
              for (int c8 = 0; c8 < 8; ++c8) og8[c8] = ld8(ogp + 8 * c8); }
            __syncthreads();
            float* W = (float*)(lds + wid * 16896);
#pragma unroll
            for (int r = 0; r < 16; ++r)
#pragma unroll
                for (int eb = 0; eb < 4; ++eb) { const unsigned pk = hfp[eb * 8 + (r >> 1)]; const float hf = (r & 1) ? __uint_as_float(pk & 0xffff0000u) : __uint_as_float(pk << 16);
                    W[crow(r, hi) * 132 + eb * 32 + r32] = hf + o[eb][r] * rdr[r]; }
            asm volatile("s_waitcnt lgkmcnt(0)" ::: "memory");
            const int tok = r32, eh = hi; const size_t row = (size_t)(rb + wid * 32 + tok);
            const float* mg = mnorm + h * 128 + 64 * eh;
            float v[64]; float s = 0.f;
#pragma unroll
            for (int c8 = 0; c8 < 8; ++c8) { const bf16x8 g8 = og8[c8]; const f32x4 w0 = *(const f32x4*)(W + tok * 132 + 64 * eh + 8 * c8), w1 = *(const f32x4*)(W + tok * 132 + 64 * eh + 8 * c8 + 4);
                const float hv[8] = {w0.x, w0.y, w0.z, w0.w, w1.x, w1.y, w1.z, w1.w};
#pragma unroll
                for (int x = 0; x < 8; ++x) { const float vv = hv[x] * __builtin_amdgcn_rcpf(1.0f + __builtin_amdgcn_exp2f(-LOG2E * bf2f(g8[x]))); v[8 * c8 + x] = vv; s += vv; } }
            { auto rr = __builtin_amdgcn_permlane32_swap(__float_as_uint(s), __float_as_uint(s), false, false); s = __uint_as_float(rr[0]) + __uint_as_float(rr[1]); }
            const float mu = s * (1.0f / 128.0f); float q = 0.f;
#pragma unroll
            for (int x = 0; x < 64; ++x) { v[x] -= mu; q += v[x] * v[x]; }
            { auto rr = __builtin_amdgcn_permlane32_swap(__float_as_uint(q), __float_as_uint(q), false, false); q = __uint_as_float(rr[0]) + __uint_as_float(rr[1]); }
            const float rstd = 1.0f / sqrtf(q * (1.0f / 128.0f) + 1e-6f);
            bf16* orow = MIX + row * 1024 + 512 + h * 128 + 64 * eh;
#pragma unroll
            for (int c8 = 0; c8 < 8; ++c8) { const f32x4 g0 = *(const f32x4*)(mg + 8 * c8), g1 = *(const f32x4*)(mg + 8 * c8 + 4);
                u32x4 ov = {cvtpk(v[8 * c8] * rstd * g0.x, v[8 * c8 + 1] * rstd * g0.y), cvtpk(v[8 * c8 + 2] * rstd * g0.z, v[8 * c8 + 3] * rstd * g0.w),
                            cvtpk(v[8 * c8 + 4] * rstd * g1.x, v[8 * c8 + 5] * rstd * g1.y), cvtpk(v[8 * c8 + 6] * rstd * g1.z, v[8 * c8 + 7] * rstd * g1.w)};
                *(u32x4*)(orow + 8 * c8) = ov; }
        }
    }
#undef ML_PK4
    __syncthreads();
}
#undef KSW
#undef MLPK
#undef MLAS
}

#define LAS __attribute__((address_space(3)))
typedef unsigned short bf16;
typedef float f32x4 __attribute__((ext_vector_type(4)));
typedef unsigned u32x4 __attribute__((ext_vector_type(4)));
typedef unsigned u32x2 __attribute__((ext_vector_type(2)));
typedef short bf16x8 __attribute__((ext_vector_type(8)));
constexpr int NWAVES = 8, NTHREADS = 512;
constexpr int DM = 1024, NB = 4, SEQ = 4096, CTXL = 256, TB = SEQ + CTXL  , R = NB * TB  ;
constexpr int DFF = 2752, DFFP = 2816, NW1 = 2 * DFFP  , DIN = 2512, DINP = 2560, KUP = 384, NUP = 1792;
constexpr int NMOD = 9;
constexpr float EPS = 1e-6f;
constexpr size_t MiB = 1u << 20;
constexpr size_t WS_CTL = 0, CTL_BYTES = 1 * MiB;
constexpr size_t WS_MOD = 1 * MiB;
constexpr size_t WS_TAB = WS_MOD + 512 * 1024;
constexpr size_t WS_W1 = 2 * MiB;
constexpr size_t WS_W2 = WS_W1 + (size_t)2 * NW1 * DM * 2;
constexpr size_t WS_WIN = WS_W2 + (size_t)2 * DM * DFFP * 2;
constexpr size_t WS_WUP = WS_WIN + (size_t)DINP * DM * 2;
constexpr size_t WS_WOUT = WS_WUP + (size_t)NUP * KUP * 2;
constexpr size_t WS_XC = WS_WOUT + (size_t)DM * DM * 2;
constexpr size_t WS_H = WS_XC + (size_t)NB * CTXL * DM * 4;
constexpr size_t WS_BIG = WS_H + (size_t)R * DM * 2;
constexpr size_t BIG_KR = (size_t)R * DINP * 2;
constexpr size_t BIG_G = BIG_KR + (size_t)R * 64 * 2;
constexpr size_t WS_Y = WS_BIG + (size_t)R * DFFP * 2;
constexpr size_t WS_Q = WS_Y + (size_t)R * DM * 2;
constexpr size_t WS_AUP = WS_Q + (size_t)R * 768 * 2;
constexpr size_t WS_HF = WS_AUP + (size_t)R * 512 * 2;
constexpr size_t WS_HB = WS_HF + (size_t)R * 512 * 2;
constexpr size_t WS_MS = WS_HB + (size_t)R * 512 * 2;
constexpr size_t MS_NLOC = 0, MS_SCA = 262144, MS_NST = 266240, MS_BM = 544768;
constexpr size_t MS_X1 = 3u << 20, MS_X2 = (3u << 20) + (512u << 10);
constexpr size_t MS_T = 1u << 20;
constexpr size_t WS_X4 = WS_MS + 4 * MiB;
constexpr size_t WS_END = WS_X4 + 2 * MiB;
static_assert(BIG_G + (size_t)R * 16 * 4 <= (size_t)R * DFFP * 2, "P + KR + G fit the hidden region");
static_assert(WS_W1 % 256 == 0 && WS_W2 % 256 == 0 && WS_WIN % 256 == 0 && WS_WUP % 256 == 0 && WS_WOUT % 256 == 0 && WS_XC % 256 == 0 && WS_H % 256 == 0 && WS_BIG % 256 == 0 && WS_Y % 256 == 0 && WS_Q % 256 == 0 && WS_AUP % 256 == 0 && WS_HF % 256 == 0, "alignment");
static_assert(WS_END <= 305u * MiB, "workspace budget");
constexpr int LDS_BYTES = 147456, LDS_MISC = 143360;

#define LDS_WAIT() asm volatile("s_waitcnt lgkmcnt(0)" ::: "memory")
__device__ __forceinline__ unsigned f2bf(float f) { unsigned u = __builtin_bit_cast(unsigned, f); return (u + 0x7fffu + ((u >> 16) & 1u)) >> 16; }
__device__ __forceinline__ unsigned pk2(float lo, float hi) { return f2bf(lo) | (f2bf(hi) << 16); }
__device__ __forceinline__ float bflo(unsigned w) { return __uint_as_float(w << 16); }
__device__ __forceinline__ float bfhi(unsigned w) { return __uint_as_float(w & 0xffff0000u); }
__device__ __forceinline__ float bf1(bf16 b) { return __uint_as_float(((unsigned)b) << 16); }
__device__ __forceinline__ float wave_sum(float v) {
#pragma unroll
    for (int o = 1; o < 64; o <<= 1) v += __shfl_xor(v, o);
    return v;
}
__device__ __forceinline__ float sigmoid_f(float x) { return __builtin_amdgcn_rcpf(1.0f + __builtin_amdgcn_exp2f(-1.4426950408889634f * x)); }
__device__ __forceinline__ float silu1(float x) { return x * sigmoid_f(x); }

struct Args { const float* in[22]; float* out; unsigned char* ws; int ph_lo, ph_hi; };
struct ArgsV { const Args* p; int z;
    __device__ __forceinline__ const float* in(int i) const { return p->in[i + z]; }
    __device__ __forceinline__ float* out() const { return (float*)p->in[22 + z]; }
    __device__ __forceinline__ unsigned char* ws() const { return (unsigned char*)p->in[23 + z]; } };
enum { I_X = 0, I_C, I_CTX, I_CCTX, I_WMOD, I_BMOD, I_NPRE, I_NPOST, I_WG, I_WU, I_WD, I_WIN, I_QN, I_WUQ, I_KVN, I_WUKV, I_AON, I_CW, I_CB, I_GB, I_MN, I_WOUT };

__device__ __forceinline__ const float* xin_row(const ArgsV& a, int r) { const int b = r / TB, t = r - b * TB; return t < CTXL ? a.in(I_CTX) + (size_t)(b * CTXL + t) * DM : a.in(I_X) + (size_t)(b * SEQ + t - CTXL) * DM; }
__device__ __forceinline__ float* xres_row(const ArgsV& a, int r) { const int b = r / TB, t = r - b * TB; return t < CTXL ? (float*)(a.ws() + WS_XC) + (size_t)(b * CTXL + t) * DM : a.out() + (size_t)(b * SEQ + t - CTXL) * DM; }
__device__ __forceinline__ const float* mod_vec(const ArgsV& a, int l, int r, int j) { const int b = r / TB, t = r - b * TB; const int bb = t < CTXL ? 4 : b; return (const float*)(a.ws() + WS_MOD) + (size_t)((l * 5 + bb) * NMOD + j) * DM; }

__device__ __forceinline__ void cvt_item(const float* src, int srcN, int k0, int c0, int ncv, bf16* dst, int dstK, int drow0, int dk0, LAS float* scr, int lane) {
    const int n4 = (lane & 15) * 4, kr = lane >> 4;
    f32x4 v[16];
    const bool ok = n4 < ncv;
    const float* sp = src + (size_t)(k0 + kr) * srcN + c0 + n4;
#pragma unroll
    for (int i = 0; i < 16; ++i) { v[i] = (f32x4){0.f, 0.f, 0.f, 0.f}; if (ok) v[i] = __builtin_nontemporal_load((const f32x4*)(sp + (size_t)(4 * i) * srcN)); }
#pragma unroll
    for (int i = 0; i < 16; ++i) { const int k = 4 * i + kr; *(LAS f32x4*)(scr + k * 68 + ((n4 + 8 * (k >> 3)) & 63)) = v[i]; }
    LDS_WAIT(); asm volatile("" ::: "memory");
    const int c = lane & 7;
#pragma unroll
    for (int j = 0; j < 8; ++j) { const int n = (lane >> 3) + 8 * j; const LAS float* s = scr + (8 * c) * 68 + ((n + 8 * c) & 63);
        u32x4 o; o.x = pk2(s[0 * 68], s[1 * 68]); o.y = pk2(s[2 * 68], s[3 * 68]); o.z = pk2(s[4 * 68], s[5 * 68]); o.w = pk2(s[6 * 68], s[7 * 68]);
        *(u32x4*)(dst + (size_t)(drow0 + n) * dstK + dk0 + 8 * c) = o; }
    LDS_WAIT(); asm volatile("" ::: "memory");
}
__device__ __forceinline__ void wconv_layer(const ArgsV& a, LAS unsigned char* lds, int bid, int nbl, int wave, int lane, int parts) {
    LAS float* scr = (LAS float*)(lds + wave * 17408);
    const int gw = bid * NWAVES + wave, NGW = nbl * NWAVES;
    constexpr int I_1 = 88 * 16, I_2 = 16 * 44, I_IN = 40 * 16, I_UP = 28 * 6, I_OUT = 16 * 16;
    constexpr int NITEMS = 2 * I_1 + 2 * I_2 + I_IN + I_UP + I_OUT;
    bf16* W1 = (bf16*)(a.ws() + WS_W1); bf16* W2 = (bf16*)(a.ws() + WS_W2); bf16* WIN = (bf16*)(a.ws() + WS_WIN); bf16* WUP = (bf16*)(a.ws() + WS_WUP); bf16* WOUT = (bf16*)(a.ws() + WS_WOUT);
    int tot = 0;
#pragma unroll
    for (int g = 0; g < 14; ++g) { const int kd = g % 7; const int sz = kd < 2 ? I_1 : (kd < 4 ? I_2 : (kd == 4 ? I_IN : (kd == 5 ? I_UP : I_OUT))); tot += ((parts >> g) & 1) ? sz : 0; }
    for (int vi = gw; vi < tot; vi += NGW) {
        int r = 0, l = 0, v = vi; bool found = false;
#pragma unroll
        for (int g = 0; g < 14; ++g) { const int kd = g % 7; const int sz = kd < 2 ? I_1 : (kd < 4 ? I_2 : (kd == 4 ? I_IN : (kd == 5 ? I_UP : I_OUT)));
            const int st = kd == 0 ? 0 : (kd == 1 ? I_1 : (kd == 2 ? 2 * I_1 : (kd == 3 ? 2 * I_1 + I_2 : (kd == 4 ? 2 * I_1 + 2 * I_2 : (kd == 5 ? 2 * I_1 + 2 * I_2 + I_IN : 2 * I_1 + 2 * I_2 + I_IN + I_UP)))));
            const bool sel = (parts >> g) & 1;
            if (!found && sel && v < sz) { r = st + v; l = g / 7; found = true; }
            if (!found && sel) v -= sz; }
        if (r < 2 * I_1) { const int j = r / I_1; r -= j * I_1; const int g = r / 16, kb = r % 16; const int row0 = 64 * g, pn = row0 >> 8, i = row0 & 255; const int hc = 128 * pn + (i & 127);
            const float* src = (i < 128 ? a.in(I_WG) : a.in(I_WU)) + (size_t)(l * 2 + j) * DM * DFF;
            cvt_item(src, DFF, 64 * kb, hc < DFF ? hc : 0, hc < DFF ? 64 : 0, W1 + (size_t)j * NW1 * DM, DM, row0, 64 * kb, scr, lane); continue; }
        r -= 2 * I_1;
        if (r < 2 * I_2) { const int j = r / I_2; r -= j * I_2; const int g = r / 44, kb = r % 44;
            const float* src = a.in(I_WD) + (size_t)(l * 2 + j) * DFF * DM;
            cvt_item(src, DM, kb < 43 ? 64 * kb : 0, 64 * g, kb < 43 ? 64 : 0, W2 + (size_t)j * DM * DFFP, DFFP, 64 * g, 64 * kb, scr, lane); continue; }
        r -= 2 * I_2;
        if (r < I_IN) { const int g = r / 16, kb = r % 16; int ncv = DIN - 64 * g; ncv = ncv < 0 ? 0 : (ncv > 64 ? 64 : ncv);
            cvt_item(a.in(I_WIN) + (size_t)l * DM * DIN, DIN, 64 * kb, ncv > 0 ? 64 * g : 0, ncv, WIN, DM, 64 * g, 64 * kb, scr, lane); continue; }
        r -= I_IN;
        if (r < I_UP) { const int g = r / 6, kb = r % 6;
            if (g < 12) cvt_item(a.in(I_WUQ) + (size_t)l * 256 * 768, 768, kb < 4 ? 64 * kb : 0, 64 * g, kb < 4 ? 64 : 0, WUP, KUP, 64 * g, 64 * kb, scr, lane);
            else cvt_item(a.in(I_WUKV) + (size_t)l * 128 * 1024, 1024, kb >= 4 ? 64 * (kb - 4) : 0, 64 * (g - 12), kb >= 4 ? 64 : 0, WUP, KUP, 64 * g, 64 * kb, scr, lane);
            continue; }
        r -= I_UP;
        { const int g = r / 16, kb = r % 16; cvt_item(a.in(I_WOUT) + (size_t)l * DM * DM, DM, 64 * kb, 64 * g, 64, WOUT, DM, 64 * g, 64 * kb, scr, lane); }
    }
}
#ifdef MOD_PROBE
#define MOD_CP(n) do { if (MOD_PROBE == (n) && blockIdx.x == 0 && threadIdx.x == 0) { *pg8::g_prof_ptr += __builtin_amdgcn_s_memrealtime() - tm0_; } } while (0)
#else
#define MOD_CP(n) do { } while (0)
#endif
__device__ __forceinline__ void mod_phase(const ArgsV& a, LAS unsigned char* lds, int bid, int nbl, int tid, int wave, int lane) {
#ifdef MOD_PROBE
    const unsigned long long tm0_ = __builtin_amdgcn_s_memrealtime();
#endif
    LAS float* sv = (LAS float*)(lds);
    LAS float* red = (LAS float*)(lds + 20480);
    for (int i = tid; i < 5 * DM; i += NTHREADS) { const float v = i < 4 * DM ? a.in(I_C)[i] : a.in(I_CCTX)[i - 4 * DM]; sv[i] = silu1(v); }
    __syncthreads();
    MOD_CP(1);
    float* mod = (float*)(a.ws() + WS_MOD);
    for (int u = bid; u < 256; u += nbl) {
        const int l = u >> 7, cb = (u & 127) * 72; const bool act = lane < 54; const int rs = act ? lane / 18 : 0, cg = act ? lane - 18 * rs : 0;
        const int r0 = wave * 128 + 43 * rs, nr = rs < 2 ? 43 : 42;
        const float* W = a.in(I_WMOD) + (size_t)l * DM * (NMOD * DM) + cb + 4 * cg + (size_t)r0 * (NMOD * DM);
        f32x4 acc[5];
#pragma unroll
        for (int bb = 0; bb < 5; ++bb) acc[bb] = (f32x4){0.f, 0.f, 0.f, 0.f};
#pragma unroll
        for (int hb = 0; hb < 2; ++hb) { f32x4 w[22];
#pragma unroll
            for (int i = 0; i < 22; ++i) { const int ri = 22 * hb + i; w[i] = __builtin_nontemporal_load((const f32x4*)(W + (size_t)(ri < nr ? ri : 0) * (NMOD * DM))); }
#pragma unroll
            for (int i = 0; i < 22; ++i) { const int ri = 22 * hb + i; const float on = ri < nr ? 1.0f : 0.0f;
#pragma unroll
                for (int bb = 0; bb < 5; ++bb) acc[bb] += w[i] * (on * sv[bb * DM + r0 + (ri < nr ? ri : 0)]); } }
        if (act) {
#pragma unroll
            for (int bb = 0; bb < 5; ++bb) *(LAS f32x4*)(red + ((wave * 3 + rs) * 5 + bb) * 72 + 4 * cg) = acc[bb]; }
        __syncthreads();
        MOD_CP(2);
        for (int i = tid; i < 5 * 72; i += NTHREADS) { const int bb = i / 72, cc = i % 72; float s = 0.f;
#pragma unroll
            for (int w = 0; w < 24; ++w) s += red[(w * 5 + bb) * 72 + cc];
            mod[(size_t)(l * 5 + bb) * (NMOD * DM) + cb + cc] = s + a.in(I_BMOD)[(size_t)l * NMOD * DM + cb + cc]; }
        __syncthreads();
    }
    if (bid == nbl - 1 && tid < 64) {
        constexpr float inv[16] = {1.0f, 0.5623413251903491f, 0.31622776601683794f, 0.1778279410038923f, 0.1f, 0.05623413251903491f, 0.03162277660168379f, 0.01778279410038923f,
                                   0.01f, 0.005623413251903491f, 0.0031622776601683794f, 0.001778279410038923f, 0.001f, 0.0005623413251903491f, 0.00031622776601683794f, 0.0001778279410038923f};
        float* tab = (float*)(a.ws() + WS_TAB);
#pragma unroll
        for (int f = 0; f < 16; ++f) {
            const float ang = (float)tid * inv[f];
            const double ad = (double)ang; const double kq = __builtin_rint(ad * 0.63661977236758134308); const double rd = ad - kq * 1.57079632679489661923;
            const float x = (float)rd, x2 = x * x; const int q = ((int)kq) & 3;
            const float sp = x + x * x2 * (-1.6666654611e-1f + x2 * (8.3321608736e-3f + x2 * (-1.9515295891e-4f)));
            const float cp = 1.0f - 0.5f * x2 + x2 * x2 * (4.166664568298827e-2f + x2 * (-1.388731625493765e-3f + x2 * 2.443315711809948e-5f));
            const float sn = (q == 0) ? sp : (q == 1) ? cp : (q == 2) ? -sp : -cp;
            const float cs = (q == 0) ? cp : (q == 1) ? -sp : (q == 2) ? -cp : sp;
            tab[(tid * 16 + f) * 2] = cs; tab[(tid * 16 + f) * 2 + 1] = sn; }
    }
    MOD_CP(3);
    __syncthreads();
}

__device__ __forceinline__ void rw_pre(const f32x4 (&x)[4], const float* g, const float* sc, const float* sh, bf16* hrow, int lane) {
    float ss = 0.f;
#pragma unroll
    for (int j = 0; j < 4; ++j) ss += (x[j].x * x[j].x + x[j].y * x[j].y) + (x[j].z * x[j].z + x[j].w * x[j].w);
    const float rstd = 1.0f / sqrtf(wave_sum(ss) * (1.0f / DM) + EPS);
#pragma unroll
    for (int j = 0; j < 4; ++j) { const int c = 256 * j + 4 * lane; const f32x4 gv = *(const f32x4*)(g + c), sv = *(const f32x4*)(sc + c), hv = *(const f32x4*)(sh + c);
        f32x4 o; o.x = x[j].x * rstd * gv.x * (1.0f + sv.x) + hv.x; o.y = x[j].y * rstd * gv.y * (1.0f + sv.y) + hv.y; o.z = x[j].z * rstd * gv.z * (1.0f + sv.z) + hv.z; o.w = x[j].w * rstd * gv.w * (1.0f + sv.w) + hv.w;
        u32x2 w; w.x = pk2(o.x, o.y); w.y = pk2(o.z, o.w); *(u32x2*)(hrow + c) = w; }
}
__device__ __forceinline__ void xb_store(const ArgsV& a, int r, const f32x4 (&x)[4], int lane) {
    const int b = r / TB, t = r - b * TB; if (t < CTXL) return;
    bf16* xr = (bf16*)(a.ws() + WS_Y) + (size_t)(b * SEQ + t - CTXL) * DM;
#pragma unroll
    for (int j = 0; j < 4; ++j) { u32x2 w; w.x = pk2(x[j].x, x[j].y); w.y = pk2(x[j].z, x[j].w); *(u32x2*)(xr + 256 * j + 4 * lane) = w; }
}
__device__ __forceinline__ void phase_rw_a(const ArgsV& a, int bid, int nbl, int wave, int lane) {
    const int gw = bid * NWAVES + wave, NGW = nbl * NWAVES; bf16* H = (bf16*)(a.ws() + WS_H);
    for (int ra = gw; ra < R; ra += 2 * NGW) {
        const int rb_ = ra + NGW < R ? ra + NGW : ra; const float* xa = xin_row(a, ra); const float* xb = xin_row(a, rb_); f32x4 x0[4], x1[4];
#pragma unroll
        for (int j = 0; j < 4; ++j) { x0[j] = __builtin_nontemporal_load((const f32x4*)(xa + 256 * j + 4 * lane)); x1[j] = __builtin_nontemporal_load((const f32x4*)(xb + 256 * j + 4 * lane)); }
        xb_store(a, ra, x0, lane); if (rb_ != ra) xb_store(a, rb_, x1, lane);
        rw_pre(x0, a.in(I_NPRE) + 0, mod_vec(a, 0, ra, 1), mod_vec(a, 0, ra, 0), H + (size_t)ra * DM, lane);
        if (rb_ != ra) rw_pre(x1, a.in(I_NPRE) + 0, mod_vec(a, 0, rb_, 1), mod_vec(a, 0, rb_, 0), H + (size_t)rb_ * DM, lane); }
}
__device__ __forceinline__ void phase_rw_b(const ArgsV& a, int l, int sub, int bid, int nbl, int wave, int lane, bool dry = false) {
    const int gw = bid * NWAVES + wave, NGW = nbl * NWAVES; bf16* H = (bf16*)(a.ws() + WS_H);
    const float wgt = sub == 1 ? 1.0f : 0.5f; const float* gpost = a.in(I_NPOST) + (size_t)(l * 3 + sub) * DM;
    const int nl = sub == 2 ? l + 1 : l, nsub = sub == 2 ? 0 : sub + 1;
    const bool from_input = (l == 0 && sub == 0); const int nsl = sub == 1 ? 4 : 11;
    if (l == 1 && sub >= 1) return;
    const float* gpre = a.in(I_NPRE) + (size_t)(nl * 3 + nsub) * DM;
    for (int i0 = gw; i0 < NB * CTXL; i0 += NGW) {
        const int r0 = (i0 / CTXL) * TB + (i0 % CTXL);
        const float* xs0 = from_input ? xin_row(a, r0) : xres_row(a, r0);
        const float* gate0 = mod_vec(a, l, r0, 3 * sub + 2); const float* sc0 = mod_vec(a, nl, r0, 3 * nsub + 1); const float* sh0 = mod_vec(a, nl, r0, 3 * nsub);
        const bf16* sp = (const bf16*)(a.ws() + WS_AUP) + (size_t)((r0 / TB) * CTXL + (r0 % TB)) * DM + 4 * lane;
        f32x4 x0[4], y0[4], gp[4], gt[4], gn[4], sv[4], hv[4];
        {   u32x2 v[11][4];
#pragma unroll
            for (int j = 0; j < 4; ++j) { const int c = 256 * j + 4 * lane; x0[j] = *(const f32x4*)(xs0 + c); gp[j] = *(const f32x4*)(gpost + c); gt[j] = *(const f32x4*)(gate0 + c);
#pragma unroll
                for (int s = 0; s < 4; ++s) v[s][j] = __builtin_nontemporal_load((const u32x2*)(sp + (size_t)s * 1024 * 1024 + 256 * j)); }
            if (nsl > 4) {
#pragma unroll
                for (int j = 0; j < 4; ++j)
#pragma unroll
                    for (int s = 4; s < 11; ++s) v[s][j] = __builtin_nontemporal_load((const u32x2*)(sp + (size_t)s * 1024 * 1024 + 256 * j)); }
#pragma unroll
            for (int j = 0; j < 4; ++j) { const int c = 256 * j + 4 * lane; gn[j] = *(const f32x4*)(gpre + c); sv[j] = *(const f32x4*)(sc0 + c); hv[j] = *(const f32x4*)(sh0 + c); }
            asm volatile("" ::: "memory");
#pragma unroll
            for (int j = 0; j < 4; ++j) { f32x4 t = (f32x4){0.f, 0.f, 0.f, 0.f};
#pragma unroll
                for (int s = 0; s < 4; ++s) { t.x += bflo(v[s][j].x); t.y += bfhi(v[s][j].x); t.z += bflo(v[s][j].y); t.w += bfhi(v[s][j].y); }
                y0[j] = t; }
            if (nsl > 4) {
#pragma unroll
                for (int j = 0; j < 4; ++j) { f32x4 t = y0[j];
#pragma unroll
                    for (int s = 4; s < 11; ++s) { t.x += bflo(v[s][j].x); t.y += bfhi(v[s][j].x); t.z += bflo(v[s][j].y); t.w += bfhi(v[s][j].y); }
                    y0[j] = t; } } }
        float ss0 = 0.f;
#pragma unroll
        for (int j = 0; j < 4; ++j) ss0 += (y0[j].x * y0[j].x + y0[j].y * y0[j].y) + (y0[j].z * y0[j].z + y0[j].w * y0[j].w);
        const float rs0 = 1.0f / sqrtf(wave_sum(ss0) * (1.0f / DM) + EPS);
        float* xd0 = dry ? (float*)(a.ws() + WS_BIG) + (size_t)r0 * DM : xres_row(a, r0);
        float s2 = 0.f;
#pragma unroll
        for (int j = 0; j < 4; ++j) { const int c = 256 * j + 4 * lane;
            x0[j].x += wgt * gt[j].x * (y0[j].x * rs0 * gp[j].x); x0[j].y += wgt * gt[j].y * (y0[j].y * rs0 * gp[j].y); x0[j].z += wgt * gt[j].z * (y0[j].z * rs0 * gp[j].z); x0[j].w += wgt * gt[j].w * (y0[j].w * rs0 * gp[j].w);
            *(f32x4*)(xd0 + c) = x0[j]; s2 += (x0[j].x * x0[j].x + x0[j].y * x0[j].y) + (x0[j].z * x0[j].z + x0[j].w * x0[j].w); }
        const float rstd = 1.0f / sqrtf(wave_sum(s2) * (1.0f / DM) + EPS); bf16* hrow = H + (size_t)r0 * DM;
#pragma unroll
        for (int j = 0; j < 4; ++j) { const int c = 256 * j + 4 * lane; f32x4 o;
            o.x = x0[j].x * rstd * gn[j].x * (1.0f + sv[j].x) + hv[j].x; o.y = x0[j].y * rstd * gn[j].y * (1.0f + sv[j].y) + hv[j].y; o.z = x0[j].z * rstd * gn[j].z * (1.0f + sv[j].z) + hv[j].z; o.w = x0[j].w * rstd * gn[j].w * (1.0f + sv[j].w) + hv[j].w;
            u32x2 w; w.x = pk2(o.x, o.y); w.y = pk2(o.z, o.w); *(u32x2*)(hrow + c) = w; }
    }
}
__device__ __forceinline__ void phase_rw_prep(const ArgsV& a, int l, int bid, int nbl, int wave, int lane) {
    const int gw = bid * NWAVES + wave, NGW = nbl * NWAVES;
    const bf16* P = (const bf16*)(a.ws() + WS_BIG); bf16* AUP = (bf16*)(a.ws() + WS_AUP); bf16* KR = (bf16*)(a.ws() + WS_BIG + BIG_KR);
    const float* tab = (const float*)(a.ws() + WS_TAB);
    const float* qn = a.in(I_QN) + l * 256; const float* kvn = a.in(I_KVN) + l * 128;
    for (int task = gw; task < 32 * 17; task += NGW)
        ml::gate_scan_task((const float*)(a.ws() + WS_BIG + BIG_G), a.in(I_GB) + l * 16, (float*)(a.ws() + WS_MS + MS_T), (float*)(a.ws() + WS_MS + MS_SCA), task, lane);
    for (int ra = gw; ra < R; ra += 2 * NGW) {
        const int rb_ = ra + NGW < R ? ra + NGW : ra; const bool two = rb_ != ra;
        const bf16* pa = P + (size_t)ra * DINP; const bf16* pb = P + (size_t)rb_ * DINP;
        const u32x2 wa = __builtin_nontemporal_load((const u32x2*)(pa + 4 * lane)), wb = __builtin_nontemporal_load((const u32x2*)(pb + 4 * lane));
        const unsigned ka = __builtin_nontemporal_load((const unsigned*)(pa + 256 + 2 * lane)), kb = __builtin_nontemporal_load((const unsigned*)(pb + 256 + 2 * lane));
        const float va = bf1(pa[384 + lane]), vb = bf1(pb[384 + lane]);
        const f32x4 g = *(const f32x4*)(qn + 4 * lane); const float kg0 = kvn[2 * lane], kg1 = kvn[2 * lane + 1];
        float a0 = bflo(wa.x), a1 = bfhi(wa.x), a2 = bflo(wa.y), a3 = bfhi(wa.y), b0 = bflo(wb.x), b1 = bfhi(wb.x), b2 = bflo(wb.y), b3 = bfhi(wb.y);
        float sa = (a0 * a0 + a1 * a1) + (a2 * a2 + a3 * a3), sb = (b0 * b0 + b1 * b1) + (b2 * b2 + b3 * b3);
        const float c0 = bflo(ka), c1 = bfhi(ka), d0 = bflo(kb), d1 = bfhi(kb); float ta = c0 * c0 + c1 * c1, tb = d0 * d0 + d1 * d1;
#pragma unroll
        for (int o = 1; o < 64; o <<= 1) { sa += __shfl_xor(sa, o); sb += __shfl_xor(sb, o); ta += __shfl_xor(ta, o); tb += __shfl_xor(tb, o); }
        const float voa = __shfl_xor(va, 16), vob = __shfl_xor(vb, 16);
        const float rqa = 1.0f / sqrtf(sa * (1.0f / 256.0f) + EPS), rqb = 1.0f / sqrtf(sb * (1.0f / 256.0f) + EPS), rka = 1.0f / sqrtf(ta * (1.0f / 128.0f) + EPS), rkb = 1.0f / sqrtf(tb * (1.0f / 128.0f) + EPS);
        { u32x2 o; o.x = pk2(a0 * rqa * g.x, a1 * rqa * g.y); o.y = pk2(a2 * rqa * g.z, a3 * rqa * g.w); *(u32x2*)(AUP + (size_t)ra * KUP + 4 * lane) = o;
          *(unsigned*)(AUP + (size_t)ra * KUP + 256 + 2 * lane) = pk2(c0 * rka * kg0, c1 * rka * kg1); }
        if (two) { u32x2 o; o.x = pk2(b0 * rqb * g.x, b1 * rqb * g.y); o.y = pk2(b2 * rqb * g.z, b3 * rqb * g.w); *(u32x2*)(AUP + (size_t)rb_ * KUP + 4 * lane) = o;
          *(unsigned*)(AUP + (size_t)rb_ * KUP + 256 + 2 * lane) = pk2(d0 * rkb * kg0, d1 * rkb * kg1); }
        const int ax = lane >> 5, half = (lane >> 4) & 1, f = lane & 15;
        { const int t = ra % TB; float o = va;
          if (t >= CTXL) { const int tt = t - CTXL; const int pos = ax == 0 ? (tt >> 6) : (tt & 63); const float cs = tab[(pos * 16 + f) * 2], sn = tab[(pos * 16 + f) * 2 + 1]; o = half == 0 ? va * cs - voa * sn : va * cs + voa * sn; }
          KR[(size_t)ra * 64 + lane] = (bf16)f2bf(o); }
        if (two) { const int t = rb_ % TB; float o = vb;
          if (t >= CTXL) { const int tt = t - CTXL; const int pos = ax == 0 ? (tt >> 6) : (tt & 63); const float cs = tab[(pos * 16 + f) * 2], sn = tab[(pos * 16 + f) * 2 + 1]; o = half == 0 ? vb * cs - vob * sn : vb * cs + vob * sn; }
          KR[(size_t)rb_ * 64 + lane] = (bf16)f2bf(o); }
    }
}
#define RLX_AGENT __ATOMIC_RELAXED, __HIP_MEMORY_SCOPE_AGENT
#define VM_WAIT() asm volatile("s_waitcnt vmcnt(0)" ::: "memory")
#define XB_TMO      128
#define XB_XCNT(j)  (256  + 64 * (j))
#define XB_XSUB(j)  (1280 + 64 * (j))
#define XB_XGEN(j)  (2304 + 64 * (j))
#define XB_TOP      3328
#define XB_TOPGEN   3392
#define XCD_BAR_WORDS 3456
#define XB_SPIN_CAP (1u << 18)

__device__ __forceinline__ unsigned xb_ld(unsigned* p)              { return __hip_atomic_load(p, __ATOMIC_RELAXED, __HIP_MEMORY_SCOPE_AGENT); }
__device__ __forceinline__ unsigned xb_add(unsigned* p, unsigned v) { return __hip_atomic_fetch_add(p, v, __ATOMIC_RELAXED, __HIP_MEMORY_SCOPE_AGENT); }
__device__ __forceinline__ unsigned xb_xcc_id() { return (unsigned)__builtin_amdgcn_s_getreg((3 << 11) | 20) & 0xFu; }
#define XB_SPIN(cond, bar) do { unsigned _sp = 0; while (cond) { __builtin_amdgcn_s_sleep(1); \
    if ((++_sp & 255u) == 0u) { if (xb_ld(&(bar)[XB_TMO])) break; if (_sp > XB_SPIN_CAP) { atomicAdd(&(bar)[XB_TMO], 1u); break; } } } } while (0)

struct XcdBarrier {
    unsigned* bar; unsigned x;
    volatile LAS unsigned* st;
};

__device__ __forceinline__ XcdBarrier xcd_barrier_post(unsigned* bar, volatile LAS unsigned* st) {
    XcdBarrier b; b.bar = bar; b.x = xb_xcc_id(); b.st = st;
    if (threadIdx.x == 0) (void)xb_add(&bar[XB_XCNT(b.x)], 1u);
    return b;
}
__device__ __forceinline__ void xcd_barrier_complete(unsigned* bar, unsigned x, unsigned& nloc, unsigned& nx) {
    const unsigned G = gridDim.x * gridDim.y * gridDim.z;
    unsigned sum, cnt, mine, sp = 0u;
    for (;;) {
        sum = 0u; cnt = 0u; mine = 0u;
#pragma unroll
        for (unsigned j = 0; j < 16; ++j) { const unsigned c = xb_ld(&bar[XB_XCNT(j)]); sum += c; cnt += (c > 0u) ? 1u : 0u; mine = (j == x) ? c : mine; }
        if (sum == G) break;
        __builtin_amdgcn_s_sleep(1);
        if ((++sp & 255u) == 0u) { if (xb_ld(&bar[XB_TMO])) break; if (sp > XB_SPIN_CAP) { atomicAdd(&bar[XB_TMO], 1u); break; } }
    }
    nloc = mine > 0u ? mine : 1u; nx = cnt > 0u ? cnt : 1u;
}

__device__ __forceinline__ void xcd_barrier(const XcdBarrier& b) {
    asm volatile("s_waitcnt vmcnt(0)" ::: "memory");
    __syncthreads();
    if (threadIdx.x == 0) {
        unsigned* bar = b.bar;
        __builtin_amdgcn_s_waitcnt(0);
        unsigned nloc = b.st[0], nx = b.st[1];
        if (nloc == 0u) { xcd_barrier_complete(bar, b.x, nloc, nx); b.st[0] = nloc; b.st[1] = nx; }
        const unsigned old = xb_add(&bar[XB_XSUB(b.x)], 1u);
        const unsigned gen = old / nloc;
        if (old + 1u == (gen + 1u) * nloc) {
            __builtin_amdgcn_fence(__ATOMIC_RELEASE, "agent");
            asm volatile("s_waitcnt vmcnt(0)" ::: "memory");
            const unsigned og = xb_add(&bar[XB_TOP], 1u);
            const unsigned tg = og / nx;
            if (og + 1u == (tg + 1u) * nx) xb_add(&bar[XB_TOPGEN], 1u);
            else XB_SPIN(xb_ld(&bar[XB_TOPGEN]) == tg, bar);
            __builtin_amdgcn_fence(__ATOMIC_ACQUIRE, "agent");
            xb_add(&bar[XB_XGEN(b.x)], 1u);
            asm volatile("s_waitcnt vmcnt(0)" ::: "memory");
        } else {
            XB_SPIN(xb_ld(&bar[XB_XGEN(b.x)]) == gen, bar);
            __builtin_amdgcn_fence(__ATOMIC_ACQUIRE, "agent");
            asm volatile("s_waitcnt vmcnt(0)" ::: "memory");
        }
    }
    __syncthreads();
}
constexpr int PPL = 15, N_PHASES = 1 + 2 * PPL, SKIP_PHASE = 1 + PPL;
__global__ void __launch_bounds__(NTHREADS, 2) mega_fwd(Args args) {
    extern __shared__ __attribute__((aligned(16))) unsigned char lds_raw[];
    LAS unsigned char* lds = (LAS unsigned char*)lds_raw;
    cg::grid_group grid = cg::this_grid();
    volatile LAS unsigned* MISC = (volatile LAS unsigned*)(lds + LDS_MISC);
    if (threadIdx.x < 16) MISC[threadIdx.x] = 0u;
    __syncthreads();
    XcdBarrier bar = xcd_barrier_post((unsigned*)(args.ws + WS_CTL), MISC + 8);
    for (int ph = args.ph_lo; ph < args.ph_hi; ++ph) {
        if (ph == SKIP_PHASE || ph == 1 + PPL + 11 || ph == 1 + PPL + 14 || ph == 1 + 9 || ph == 1 + PPL + 9 || ph == 1 + 7 || ph == 1 + PPL + 7) continue;
#define TID_DECL int tid_ = threadIdx.x; asm volatile("" : "+v"(tid_)); const int tid = tid_, lane = tid & 63, wave = __builtin_amdgcn_readfirstlane(tid >> 6); (void)tid; (void)lane; (void)wave
        int bid_ = blockIdx.x, nbl_ = gridDim.x; asm volatile("" : "+s"(bid_), "+s"(nbl_)); const int bid = bid_, nbl = nbl_;
        int zo_ = 0; asm volatile("" : "+s"(zo_));
        const ArgsV A_{&args, zo_}; unsigned char* ws = A_.ws();
        XcdBarrier barl = bar; asm volatile("" : "+s"(barl.x), "+s"(barl.bar));
        if (ph == 0) { TID_DECL; mod_phase(A_, lds, bid, nbl, tid, wave, lane); }
        else {
            const int l = (ph - 1) / PPL, k = (ph - 1) % PPL;
            if (k == 0) { TID_DECL; phase_rw_a(A_, bid, nbl, wave, lane); }
            else if (k == 1 || k == 12) { const int j = k == 12;
                pg8::Gemm g{(const pg8::bf16_t*)(ws + WS_H), (const pg8::bf16_t*)(ws + WS_W1) + (size_t)j * NW1 * DM, R, NW1, DM}; pg8::TileOrder S; S.init((l == 1 && k == 12) ? 1 : 0, NW1, DM, nbl, bid, 1);
                pg8::EpiSwiGLU E{(pg8::bf16_t*)(ws + WS_BIG), DFFP};
                pg8::gemm_phase<pg8::EpiSwiGLU, pg8::TileOrder, true, true>(lds, g, S, E); }
            else if (k == 2 || k == 13 || k == 10) { const int j = k == 13, sub = k == 2 ? 0 : (k == 10 ? 1 : 2);
                const pg8::bf16_t* A = (const pg8::bf16_t*)(ws + (k == 10 ? WS_H : WS_BIG));
                const pg8::bf16_t* Bt = k == 10 ? (const pg8::bf16_t*)(ws + WS_WOUT) : (const pg8::bf16_t*)(ws + WS_W2) + (size_t)j * DM * DFFP;
                const int K = k == 10 ? DM : DFFP;
                pg8::Gemm g{A, Bt, R, DM, K}; pg8::TileOrder S; S.init(1, DM, K, nbl, bid, 1);
                const bool has_next = !(l == 1 && sub == 2); const int nl = sub == 2 ? l + 1 : l, nsub = sub == 2 ? 0 : sub + 1;
                const float* modb = (const float*)(ws + WS_MOD); unsigned* cntb = (unsigned*)(ws + WS_CTL + 65536) + (size_t)((l * 3 + sub) * 2) * (68 * 64);
                pg8::EpiNormRes E{(pg8::bf16_t*)(ws + WS_Y), A_.out(), has_next ? (pg8::bf16_t*)(ws + WS_H) : nullptr,
                                  modb + (size_t)((l * 5) * NMOD + 3 * sub + 2) * DM, A_.in(I_NPOST) + (size_t)(l * 3 + sub) * DM,
                                  A_.in(I_NPRE) + (size_t)((has_next ? nl : 0) * 3 + nsub) * DM, modb + (size_t)(((has_next ? nl : 0) * 5) * NMOD + 3 * nsub + 1) * DM, modb + (size_t)(((has_next ? nl : 0) * 5) * NMOD + 3 * nsub) * DM,
                                  sub == 1 ? 1.0f : 0.5f, 0.0f, pg8::PanelSS{(unsigned*)(ws + WS_X4), cntb}};
                if (l == 0 || k == 2) {
                    pg8::TileOrder S2; S2.init(2, DM, K, nbl, bid, k == 10 ? 4 : 11);
                    pg8::EpiSlab E2{(pg8::bf16_t*)(ws + WS_AUP)};
                    pg8::gemm_phase<pg8::EpiSlab, pg8::TileOrder, true, true>(lds, g, S2, E2); __syncthreads(); }
                pg8::gemm_phase<pg8::EpiNormRes, pg8::TileOrder, false, true>(lds, g, S, E); }
            else if (k == 6) {
                pg8::Gemm g{(const pg8::bf16_t*)(ws + WS_AUP), (const pg8::bf16_t*)(ws + WS_WUP), R, NUP, KUP}; pg8::TileOrder S; S.init(3, NUP, KUP, nbl, bid, 1);
                pg8::EpiStore E{(pg8::bf16_t*)A_.out(), NUP};
                pg8::gemm_phase<pg8::EpiStore, pg8::TileOrder, true, true>(lds, g, S, E);
                if (k == 6) {
                    __syncthreads();
                    for (int u = bid; u < 512; u += nbl)
                        ml::mlstm_local((const ml::bf16*)(ws + WS_BIG), (const float*)(ws + WS_MS + MS_T), A_.in(I_CW) + (size_t)l * 3 * 1024, A_.in(I_CB) + (size_t)l * 1024,
                                        (float*)(ws + WS_HF), (float*)(ws + WS_MS + MS_NLOC), u, (char*)lds_raw); } }
            else if (k == 3 || k == 11 || k == 14) { TID_DECL; phase_rw_b(A_, l, k == 3 ? 0 : (k == 11 ? 1 : 2), bid, nbl, wave, lane); }
            else if (k == 4) {
                pg8::Gemm g{(const pg8::bf16_t*)(ws + WS_H), (const pg8::bf16_t*)(ws + WS_WIN), R, DINP, DM}; pg8::TileOrder S; S.init(0, DINP, DM, nbl, bid, 1);
                pg8::EpiP E{(pg8::bf16_t*)(ws + WS_BIG), DINP, (float*)(ws + WS_BIG + BIG_G)};
                pg8::gemm_phase<pg8::EpiP, pg8::TileOrder, true, true>(lds, g, S, E); }
            else if (k == 5) { TID_DECL; phase_rw_prep(A_, l, bid, nbl, wave, lane); }
            else if (k == 8) {
                unsigned* scan_done = (unsigned*)(ws + WS_CTL + 40960) + 64 * l;
                { TID_DECL; ml::mlstm_scan((const float*)(ws + WS_HF), (const float*)(ws + WS_MS + MS_NLOC), (const float*)(ws + WS_MS + MS_SCA), (ml::bf16*)(ws + WS_AUP), (float*)(ws + WS_MS + MS_NST), (float*)(ws + WS_MS + MS_BM), bid * NTHREADS + tid, nbl * NTHREADS);
                  asm volatile("s_waitcnt vmcnt(0)" ::: "memory"); __syncthreads();
                  if (tid == 0) { __builtin_amdgcn_fence(__ATOMIC_RELEASE, "agent"); asm volatile("s_waitcnt vmcnt(0)" ::: "memory"); __hip_atomic_fetch_add(scan_done, 1u, __ATOMIC_RELAXED, __HIP_MEMORY_SCOPE_AGENT); } }
                att::bf16* QKV = (att::bf16*)A_.out(); const att::bf16* KR = (const att::bf16*)(ws + WS_BIG + BIG_KR);
                const float* tab = (const float*)(ws + WS_TAB);
                int nit_ = 2; asm volatile("" : "+s"(nit_));
                for (int it = 0; it < nit_; ++it) {
                    const int cu = nbl == 256 ? ((bid >= 192 && (bid & 15) < 4) ? 256 + ((bid - 192) >> 4) * 4 + (bid & 15) : 272) : (bid >= 128 ? 256 + (bid - 128) : 272);
                    const int u0 = it == 0 ? (l == 0 ? cu : 272) : bid, u1 = it == 0 ? 272 : 256;
                for (int u = u0; u < u1; u += nbl) {
                    int b, h, seq, rope, qtok0; size_t rq;
                    if (u < 256) { b = u >> 6; h = (u >> 4) & 3; const int qb = u & 15; rq = (size_t)b * TB + CTXL + (size_t)qb * 256; seq = TB; rope = 1; qtok0 = qb * 256; }
                    else { b = (u - 256) >> 2; h = (u - 256) & 3; rq = (size_t)b * TB; seq = CTXL; rope = 0; qtok0 = 0; }
                    const size_t r0 = (size_t)b * TB;
                    const int panel = u < 256 ? (b * 16 + (u & 15)) : (64 + b);
                    att::attn_body(QKV + rq * NUP + h * 192, QKV + r0 * NUP + 768 + h * 256, QKV + r0 * NUP + 768 + h * 256 + 128, KR + r0 * 64, (att::bf16*)(ws + WS_H) + rq * DM + h * 128, seq, rope, qtok0, tab, (char*)lds_raw,
                                   (unsigned*)(ws + WS_MS + MS_X1) + rq * 4, (unsigned*)(ws + WS_CTL + 65536) + (size_t)(12 + l) * (68 * 64) + 64 * panel, A_.in(I_AON) + l * 512 + h * 128, h);
                } }
                const int m0 = nbl - 1 - bid;
                const int mc = nbl == 256 ? ((bid >= 192 && (bid & 15) >= 4 && (bid & 15) < 8) ? ((bid - 192) >> 4) * 4 + (bid & 15) - 4 : 16) : m0;
                for (int it = 0; it < nit_; ++it) {
                    const int m1 = it == 0 ? (l == 0 ? 16 : 0) : 256;
                    if (it == 1) { if (threadIdx.x == 0) { unsigned sp = 0;
                            while (__hip_atomic_load(scan_done, __ATOMIC_RELAXED, __HIP_MEMORY_SCOPE_AGENT) < (unsigned)nbl) { __builtin_amdgcn_s_sleep(4); if (++sp > (1u << 22)) break; }
                            __builtin_amdgcn_fence(__ATOMIC_ACQUIRE, "agent"); asm volatile("s_waitcnt vmcnt(0)" ::: "memory"); }
                        __syncthreads(); }
                for (int u = (it == 0 ? mc : m0); u < m1; u += nbl) { const int bh = it == 1 ? (u >> 4) : u, tbk = it == 1 ? 1 + (u & 15) : 0;
                    ml::mlstm_out2((const ml::bf16*)(ws + WS_BIG), (const float*)(ws + WS_MS + MS_T), A_.in(I_CW) + (size_t)l * 3 * 1024, A_.in(I_CB) + (size_t)l * 1024, (const ml::bf16*)(ws + WS_AUP),
                                   (const float*)(ws + WS_MS + MS_NST), (const float*)(ws + WS_MS + MS_BM), A_.in(I_MN) + l * 512, (ml::bf16*)(ws + WS_H), bh >> 2, bh & 3, tbk, (char*)lds_raw); } }
            }
        }
        {
            int wparts = 0, wg0 = 0;
            switch (ph) {
                case 0:       wparts = 0x0011;            wg0 = 0;   break;
                case 1 + 1:   wparts = 0x0024;            wg0 = 216; break;
                case 1 + 3:   wparts = 0x0048;            wg0 = 128; break;
                case 1 + 8:   wparts = 0x0002 | (0x01 << 7); wg0 = 128; break;
                case 1 + 11:  wparts = 0x24 << 7;         wg0 = 128; break;
                case 1 + 14:  wparts = 0x50 << 7;         wg0 = 128; break;
                case 16 + 3:  wparts = 0x08 << 7;         wg0 = 128; break;
                case 16 + 8:  wparts = 0x02 << 7;         wg0 = 128; break;
                default: break; }
            const int wg1 = (ph == 1 + 8) ? 192 : nbl;
            if (wparts != 0 && bid >= wg0 && bid < wg1) { TID_DECL; __syncthreads(); wconv_layer(A_, lds, bid - wg0, wg1 - wg0, wave, lane, wparts); } }
        if (ph + 1 < args.ph_hi) { if (args.ph_hi < 0) grid.sync(); else xcd_barrier(barl); }
    }
}

#ifndef MK_ONE_LAUNCH
#define MK_ONE_LAUNCH 1
#endif
extern "C" void kernel_launch(void* const* d_in, const int* in_sizes, int n_in, void* d_out, int out_size, void* d_ws, size_t ws_size, hipStream_t stream) {
    static int grid = 0;
    if (grid == 0) {
        if (n_in != 22 || in_sizes[0] != NB * SEQ * DM || out_size != NB * SEQ * DM || ws_size < WS_END) { fprintf(stderr, "kernel_launch: shape/workspace mismatch (n_in %d, in0 %d, out %d, ws %zu need %zu)\n", n_in, n_in > 0 ? in_sizes[0] : -1, out_size, ws_size, (size_t)WS_END); grid = -1; return; }
        int dev = 0, cus = 0, per_cu = 0;
        if (hipGetDevice(&dev) != hipSuccess || hipDeviceGetAttribute(&cus, hipDeviceAttributeMultiprocessorCount, dev) != hipSuccess) { grid = -1; return; }
        if (hipFuncSetAttribute((const void*)mega_fwd, hipFuncAttributeMaxDynamicSharedMemorySize, LDS_BYTES) != hipSuccess) { fprintf(stderr, "kernel_launch: hipFuncSetAttribute failed\n"); grid = -1; return; }
        if (hipOccupancyMaxActiveBlocksPerMultiprocessor(&per_cu, (const void*)mega_fwd, NTHREADS, LDS_BYTES) != hipSuccess || per_cu < 1) { fprintf(stderr, "kernel_launch: occupancy query says %d\n", per_cu); per_cu = 1; }
        (void)hipGetLastError();
        grid = cus * (per_cu > 1 ? 1 : per_cu);
    }
    if (grid < 0) return;
    if (hipMemsetAsync((char*)d_ws + WS_CTL, 0, 65536 + 14 * 68 * 256, stream) != hipSuccess) { fprintf(stderr, "kernel_launch: memset of the barrier words failed\n"); return; }
    Args a{};
    for (int i = 0; i < 22; ++i) a.in[i] = (const float*)d_in[i];
    a.out = (float*)d_out; a.ws = (unsigned char*)d_ws;
#if MK_ONE_LAUNCH
    a.ph_lo = 0; a.ph_hi = N_PHASES;
    void* kargs[] = {&a};
    hipError_t e = hipLaunchCooperativeKernel((const void*)mega_fwd, dim3(grid), dim3(NTHREADS), kargs, LDS_BYTES, stream);
    if (e != hipSuccess) fprintf(stderr, "kernel_launch: cooperative launch failed: %s (grid %d)\n", hipGetErrorString(e), grid);
#else
    for (int ph = 0; ph < N_PHASES; ++ph) { if (ph == SKIP_PHASE) continue; a.ph_lo = ph; a.ph_hi = ph + 1;
        hipLaunchKernelGGL(mega_fwd, dim3(grid), dim3(NTHREADS), LDS_BYTES, stream, a);
        const hipError_t le = hipPeekAtLastError(); if (le != hipSuccess) { fprintf(stderr, "kernel_launch: launch of phase %d failed: %s\n", ph, hipGetErrorName(le)); break; } }
#endif
}
```
